# Optimizing an MI355X kernel written in HIP

```python
import jax
import jax.numpy as jnp
from jax import lax
import numpy as np

D_MODEL = 1024
BATCH = 8
SEQ = 4096
DEPTH = 2

BRANCH_WIDTH = 512
N_BRANCH = 4
GDN_HEADS = 4
GDN_DK = 128
GDN_DV = 128
GDN_CONV = 4
GDN_CHUNK = 64
GDN_QK = GDN_HEADS * GDN_DK
GDN_V = GDN_HEADS * GDN_DV
CONF_WIDTH = BRANCH_WIDTH
CONF_KERNEL = 31
GMLP_WIDTH = BRANCH_WIDTH
GMLP_GROUPS = 4
GMLP_CHUNK = 128
SC_WIDTH = BRANCH_WIDTH
SC_KERNEL = 3
MOE_GROUPS = 8
MOE_PER_GROUP = 8
N_EXPERTS = MOE_GROUPS * MOE_PER_GROUP
MOE_TOPK = 2
D_EXPERT = 512
MOE_BLOCK = 256
EPS = 1e-6

SPLIT_SIZES = (GDN_QK, GDN_QK, GDN_V, GDN_V, GDN_HEADS, GDN_HEADS,
               2 * CONF_WIDTH, 2 * GMLP_WIDTH, 3 * SC_WIDTH, N_BRANCH * D_MODEL)
SPLIT_POINTS = tuple(int(p) for p in np.cumsum(SPLIT_SIZES)[:-1])
D_IN = int(sum(SPLIT_SIZES))

kernel_name = 'hybrid_gated_parallel_mixers_hier_moe'


def rmsnorm(x, w):
    xf = x.astype(jnp.float32)
    y = xf * lax.rsqrt(jnp.mean(xf * xf, -1, keepdims=True) + EPS)
    return (y * w.astype(jnp.float32)).astype(x.dtype)


def layernorm(x, w, b):
    xf = x.astype(jnp.float32)
    xc = xf - jnp.mean(xf, -1, keepdims=True)
    y = xc * lax.rsqrt(jnp.mean(xc * xc, -1, keepdims=True) + EPS)
    return (y * w.astype(jnp.float32) + b.astype(jnp.float32)).astype(x.dtype)


def l2norm(t):
    return t * lax.rsqrt(jnp.sum(t * t, -1, keepdims=True) + EPS)


def causal_dwconv(x, w):
    k_w, ch = w.shape
    return lax.conv_general_dilated(
        x, w[:, None, :].astype(x.dtype), window_strides=(1,), padding=[(k_w - 1, 0)],
        dimension_numbers=('NWC', 'WIO', 'NWC'), feature_group_count=ch)


def gated_delta_rule(q, k, v, g, beta):
    bsz, nh, t_len, dk = q.shape
    dv = v.shape[-1]
    c = GDN_CHUNK
    n = t_len // c
    q = q.reshape(bsz, nh, n, c, dk)
    k = k.reshape(bsz, nh, n, c, dk)
    v = v.reshape(bsz, nh, n, c, dv)
    g = jnp.cumsum(g.reshape(bsz, nh, n, c), axis=-1)
    beta = beta.reshape(bsz, nh, n, c)
    tril = jnp.tril(jnp.ones((c, c), bool))
    strict = jnp.tril(jnp.ones((c, c), bool), -1)
    diff = g[..., :, None] - g[..., None, :]
    decay = jnp.where(tril, jnp.exp(jnp.where(tril, diff, 0.0)), 0.0)
    k_beta = k * beta[..., None]
    v_beta = v * beta[..., None]
    lower = jnp.einsum('bhnid,bhnjd->bhnij', k_beta, k) * decay
    m = jnp.where(strict, lower, 0.0) + jnp.eye(c, dtype=q.dtype)
    u = lax.linalg.triangular_solve(m, v_beta, left_side=True, lower=True, unit_diagonal=True)
    w = lax.linalg.triangular_solve(m, k_beta * jnp.exp(g)[..., None], left_side=True,
                                    lower=True, unit_diagonal=True)
    attn = jnp.einsum('bhnid,bhnjd->bhnij', q, k) * decay
    q_dec = q * jnp.exp(g)[..., None]
    g_last = g[..., -1]
    k_dec = k * jnp.exp(g_last[..., None] - g)[..., None]

    def step(s, xs):
        qd, kd, uc, wc, ac, gl = xs
        v_new = uc - jnp.einsum('bhcd,bhde->bhce', wc, s)
        o = jnp.einsum('bhcd,bhde->bhce', qd, s) + jnp.einsum('bhij,bhje->bhie', ac, v_new)
        s = s * jnp.exp(gl)[..., None, None] + jnp.einsum('bhcd,bhce->bhde', kd, v_new)
        return s, o

    xs = tuple(jnp.moveaxis(t, 2, 0) for t in (q_dec, k_dec, u, w, attn, g_last))
    s0 = jnp.zeros((bsz, nh, dk, dv), jnp.float32)
    _, o = lax.scan(step, s0, xs)
    return jnp.moveaxis(o, 0, 2).reshape(bsz, nh, t_len, dv)


def gdn_branch(q, k, v, z, beta_raw, a_raw, conv_w, a_log, dt_bias, norm_w):
    bsz, t_len, _ = q.shape
    dtype = q.dtype
    qkv = jax.nn.silu(causal_dwconv(jnp.concatenate([q, k, v], -1), conv_w))
    q, k, v = jnp.split(qkv, [GDN_QK, 2 * GDN_QK], -1)

    def heads(t, d):
        return t.reshape(bsz, t_len, GDN_HEADS, d).transpose(0, 2, 1, 3).astype(jnp.float32)

    q = l2norm(heads(q, GDN_DK)) * (GDN_DK ** -0.5)
    k = l2norm(heads(k, GDN_DK))
    v = heads(v, GDN_DV)
    beta = jax.nn.sigmoid(beta_raw.astype(jnp.float32)).transpose(0, 2, 1)
    g = -jnp.exp(a_log.astype(jnp.float32)) * jax.nn.softplus(
        a_raw.astype(jnp.float32) + dt_bias.astype(jnp.float32))
    g = g.transpose(0, 2, 1)
    o = gated_delta_rule(q, k, v, g, beta).transpose(0, 2, 1, 3)
    o = o * lax.rsqrt(jnp.mean(o * o, -1, keepdims=True) + EPS) * norm_w.astype(jnp.float32)
    o = o * jax.nn.silu(z.reshape(bsz, t_len, GDN_HEADS, GDN_DV).astype(jnp.float32))
    return o.reshape(bsz, t_len, GDN_V).astype(dtype)


def conformer_branch(h, conv_w, conv_b, ln_w, ln_b):
    a, gate = jnp.split(h, 2, -1)
    y = a * jax.nn.sigmoid(gate)
    y = causal_dwconv(y, conv_w) + conv_b.astype(h.dtype)
    return jax.nn.silu(layernorm(y, ln_w, ln_b))


def gmlp_branch(h, ln_w, ln_b, w_s, b_s):
    bsz, t_len, _ = h.shape
    u, v = jnp.split(jax.nn.gelu(h), 2, -1)
    v = layernorm(v, ln_w, ln_b)
    n = t_len // GMLP_CHUNK
    gc = GMLP_WIDTH // GMLP_GROUPS
    v = v.reshape(bsz, n, GMLP_CHUNK, GMLP_GROUPS, gc)
    mask = jnp.tril(jnp.ones((GMLP_CHUNK, GMLP_CHUNK), bool))
    w_c = jnp.where(mask[None], w_s, 0.0).astype(h.dtype)
    mixed = jnp.einsum('gij,bnjgc->bnigc', w_c, v) + b_s.T.astype(h.dtype)[None, None, :, :, None]
    return u * mixed.reshape(bsz, t_len, GMLP_WIDTH)


def shortconv_branch(h, conv_w):
    b_gate, c_gate, xin = jnp.split(h, 3, -1)
    return b_gate * causal_dwconv(c_gate * xin, conv_w)


def mixer_block(x, norm_w, w_in, gdn_conv_w, gdn_a_log, gdn_dt_bias, gdn_norm_w,
                conf_conv_w, conf_conv_b, conf_ln_w, conf_ln_b, gmlp_ln_w, gmlp_ln_b,
                gmlp_w_s, gmlp_b_s, sc_conv_w, w_branch, w_out):
    bsz, t_len, _ = x.shape
    xn = rmsnorm(x, norm_w)
    h = xn @ w_in
    q, k, v, z, beta_raw, a_raw, h_conf, h_gmlp, h_sc, h_gate = jnp.split(h, SPLIT_POINTS, -1)
    ys = (gdn_branch(q, k, v, z, beta_raw, a_raw, gdn_conv_w, gdn_a_log, gdn_dt_bias, gdn_norm_w),
          conformer_branch(h_conf, conf_conv_w, conf_conv_b, conf_ln_w, conf_ln_b),
          gmlp_branch(h_gmlp, gmlp_ln_w, gmlp_ln_b, gmlp_w_s, gmlp_b_s),
          shortconv_branch(h_sc, sc_conv_w))
    gates = jax.nn.sigmoid(h_gate.reshape(bsz, t_len, N_BRANCH, D_MODEL))
    merged = gates[..., 0, :] * (ys[0] @ w_branch[0])
    for i in range(1, N_BRANCH):
        merged = merged + gates[..., i, :] * (ys[i] @ w_branch[i])
    return merged @ w_out


def hier_moe(x, router_grp, router_exp, w_gate, w_up, w_down):
    bsz, t_len, d = x.shape
    xf = x.reshape(-1, d)
    n_tok = xf.shape[0]
    p_grp = jax.nn.softmax((xf @ router_grp).astype(jnp.float32), -1)
    grp = jnp.argmax(p_grp, -1).astype(jnp.int32)
    p_sel = jnp.take_along_axis(p_grp, grp[:, None], -1)
    logits = (xf @ router_exp).astype(jnp.float32).reshape(n_tok, MOE_GROUPS, MOE_PER_GROUP)
    logits_g = jnp.take_along_axis(logits, grp[:, None, None], 1)[:, 0]
    w_top, idx_top = lax.top_k(jax.nn.softmax(logits_g, -1), MOE_TOPK)
    w_top = w_top / jnp.sum(w_top, -1, keepdims=True) * p_sel
    expert = grp[:, None] * MOE_PER_GROUP + idx_top.astype(jnp.int32)
    n_assign = n_tok * MOE_TOPK
    e_flat = expert.reshape(-1)
    tok_flat = jnp.repeat(jnp.arange(n_tok, dtype=jnp.int32), MOE_TOPK)
    w_flat = w_top.reshape(-1)
    order = jnp.argsort(e_flat)
    e_sorted = e_flat[order]
    counts = jnp.zeros((N_EXPERTS,), jnp.int32).at[e_flat].add(1)
    padded = (counts + MOE_BLOCK - 1) // MOE_BLOCK * MOE_BLOCK
    pad_end = jnp.cumsum(padded)
    pad_start = pad_end - padded
    start = jnp.cumsum(counts) - counts
    dest = pad_start[e_sorted] + jnp.arange(n_assign, dtype=jnp.int32) - start[e_sorted]
    n_blocks = (n_assign + N_EXPERTS * (MOE_BLOCK - 1)) // MOE_BLOCK + 1
    n_rows = n_blocks * MOE_BLOCK
    buf_tok = jnp.full((n_rows,), n_tok, jnp.int32).at[dest].set(tok_flat[order])
    buf_w = jnp.zeros((n_rows,), jnp.float32).at[dest].set(w_flat[order])
    blk_start = jnp.arange(n_blocks, dtype=jnp.int32) * MOE_BLOCK
    blk_expert = jnp.minimum(jnp.searchsorted(pad_end, blk_start, side='right'),
                             N_EXPERTS - 1).astype(jnp.int32)
    x_pad = jnp.concatenate([xf, jnp.zeros((1, d), xf.dtype)], 0)

    def run_block(args):
        toks, e = args
        xb = x_pad[toks]
        hb = jax.nn.silu(xb @ w_gate[e]) * (xb @ w_up[e])
        return hb @ w_down[e]

    y = lax.map(run_block, (buf_tok.reshape(n_blocks, MOE_BLOCK), blk_expert))
    y = y.reshape(n_rows, d) * buf_w[:, None].astype(x.dtype)
    out = jnp.zeros((n_tok + 1, d), x.dtype).at[buf_tok].add(y)[:n_tok]
    return out.reshape(bsz, t_len, d)


def setup_inputs(seed: int = 0) -> dict:
    key = jax.random.key(seed)
    ks = jax.random.split(key, 26)
    f32 = jnp.float32
    L = DEPTH

    def nrm(k, shape, scale):
        return jax.random.normal(k, shape, f32) * scale

    def gain(k, shape):
        return 1.0 + 0.02 * jax.random.normal(k, shape, f32)

    dt = jnp.exp(jax.random.uniform(ks[4], (L, GDN_HEADS), f32, np.float32(np.log(1e-3)),
                                    np.float32(np.log(1e-1))))
    return {
        'x': nrm(ks[0], (BATCH, SEQ, D_MODEL), 1.0),
        'mix_norm_w': gain(ks[1], (L, D_MODEL)),
        'w_in': nrm(ks[2], (L, D_MODEL, D_IN), D_MODEL ** -0.5),
        'gdn_conv_w': nrm(ks[3], (L, GDN_CONV, 2 * GDN_QK + GDN_V), GDN_CONV ** -0.5),
        'gdn_A_log': jnp.log(jax.random.uniform(ks[5], (L, GDN_HEADS), f32, 1.0, 16.0)),
        'gdn_dt_bias': dt + jnp.log(-jnp.expm1(-dt)),
        'gdn_norm_w': gain(ks[6], (L, GDN_DV)),
        'conf_conv_w': nrm(ks[7], (L, CONF_KERNEL, CONF_WIDTH), CONF_KERNEL ** -0.5),
        'conf_conv_b': nrm(ks[8], (L, CONF_WIDTH), 0.02),
        'conf_ln_w': gain(ks[9], (L, CONF_WIDTH)),
        'conf_ln_b': nrm(ks[10], (L, CONF_WIDTH), 0.02),
        'gmlp_ln_w': gain(ks[11], (L, GMLP_WIDTH)),
        'gmlp_ln_b': nrm(ks[12], (L, GMLP_WIDTH), 0.02),
        'gmlp_w_s': nrm(ks[13], (L, GMLP_GROUPS, GMLP_CHUNK, GMLP_CHUNK), GMLP_CHUNK ** -0.5),
        'gmlp_b_s': gain(ks[14], (L, GMLP_GROUPS, GMLP_CHUNK)),
        'sc_conv_w': nrm(ks[15], (L, SC_KERNEL, SC_WIDTH), SC_KERNEL ** -0.5),
        'w_branch': nrm(ks[16], (L, N_BRANCH, BRANCH_WIDTH, D_MODEL), BRANCH_WIDTH ** -0.5),
        'w_out': nrm(ks[17], (L, D_MODEL, D_MODEL), D_MODEL ** -0.5),
        'moe_norm_w': gain(ks[18], (L, D_MODEL)),
        'router_grp': nrm(ks[19], (L, D_MODEL, MOE_GROUPS), D_MODEL ** -0.5),
        'router_exp': nrm(ks[20], (L, D_MODEL, N_EXPERTS), D_MODEL ** -0.5),
        'w_gate': nrm(ks[21], (L, N_EXPERTS, D_MODEL, D_EXPERT), D_MODEL ** -0.5),
        'w_up': nrm(ks[22], (L, N_EXPERTS, D_MODEL, D_EXPERT), D_MODEL ** -0.5),
        'w_down': nrm(ks[23], (L, N_EXPERTS, D_EXPERT, D_MODEL), D_EXPERT ** -0.5),
        'final_norm_w': gain(ks[24], (D_MODEL,)),
    }


def reference(x, mix_norm_w, w_in, gdn_conv_w, gdn_A_log, gdn_dt_bias, gdn_norm_w,
              conf_conv_w, conf_conv_b, conf_ln_w, conf_ln_b, gmlp_ln_w, gmlp_ln_b,
              gmlp_w_s, gmlp_b_s, sc_conv_w, w_branch, w_out, moe_norm_w, router_grp,
              router_exp, w_gate, w_up, w_down, final_norm_w):
    for l in range(DEPTH):
        x = x + mixer_block(x, mix_norm_w[l], w_in[l], gdn_conv_w[l], gdn_A_log[l],
                            gdn_dt_bias[l], gdn_norm_w[l], conf_conv_w[l], conf_conv_b[l],
                            conf_ln_w[l], conf_ln_b[l], gmlp_ln_w[l], gmlp_ln_b[l],
                            gmlp_w_s[l], gmlp_b_s[l], sc_conv_w[l], w_branch[l], w_out[l])
        x = x + hier_moe(rmsnorm(x, moe_norm_w[l]), router_grp[l], router_exp[l],
                         w_gate[l], w_up[l], w_down[l])
    return rmsnorm(x, final_norm_w)
```

```cpp
#include <hip/hip_runtime.h>
#include <cstdio>
#include <cstdint>

#ifndef N_LAUNCH_MODE
#define N_LAUNCH_MODE 1
#endif

#define LAS __attribute__((address_space(3)))
typedef unsigned short bf16;
typedef short bf16x8 __attribute__((ext_vector_type(8)));
typedef float f32x4 __attribute__((ext_vector_type(4)));
typedef float f32x2 __attribute__((ext_vector_type(2)));
typedef unsigned u32x4 __attribute__((ext_vector_type(4)));
typedef unsigned u32x2 __attribute__((ext_vector_type(2)));

constexpr int NB = 8, T = 4096, D = 1024, M = NB * T, NLAYER = 2;
constexpr int DIN = 9736, DH = 9728;
constexpr int HQ = 0, HK = 512, HV = 1024, HZ = 1536, HCONF = 2048, HGMLP = 3072, HSC = 4096, HGATE = 5632;
constexpr int NE = 64, DE = 512;
constexpr float EPS = 1e-6f;
constexpr int NROWBLK_MAX = 320, NROWS_MAX = NROWBLK_MAX * 256;

constexpr size_t MiB = 1u << 20;
constexpr size_t WS_CTL = 0, CTL_BYTES = 1 * MiB;
constexpr size_t WS_WIN = 2 * MiB;
constexpr size_t WIN_L = (size_t)DH * D * 2;
constexpr size_t WS_WBR = 40 * MiB;
constexpr size_t WBR_L = (size_t)4 * D * 512 * 2;
constexpr size_t WS_WOUT = 48 * MiB;
constexpr size_t WOUT_L = (size_t)D * D * 2;
constexpr size_t WS_XN = 52 * MiB;
constexpr size_t WS_SMALL = 116 * MiB;
constexpr size_t WS_ROUTE = 117 * MiB;
constexpr size_t WS_MOETAB = 118 * MiB;
constexpr size_t WS_YS = 120 * MiB;
constexpr size_t WS_GQ = 248 * MiB;
constexpr size_t WS_MERGED = WS_GQ;
constexpr size_t WS_GBG = 344 * MiB;
constexpr size_t WS_OBUF = 346 * MiB;
constexpr size_t WS_H = 410 * MiB;
constexpr size_t WS_MOEW = 410 * MiB;
constexpr size_t WGU_E = (size_t)1024 * 1024 * 2, WD_E = (size_t)1024 * 512 * 2;
constexpr size_t WS_WD = WS_MOEW + 64 * WGU_E;
constexpr size_t WS_XS = 602 * MiB;
constexpr size_t WS_HB = 762 * MiB;
constexpr size_t WS_Y = 842 * MiB;
constexpr size_t WS_END = 1018 * MiB;
static_assert(WS_H + (size_t)M * DH * 2 <= WS_END && WS_Y + (size_t)2 * M * D * 2 <= WS_END, "ws map");

constexpr int CW_BAR = 4096;
constexpr int STAGE_LDS = 131072, LDSCTL_OFF = 131072, LDS_BYTES = 147456;
constexpr int LC_BAR = 0;
constexpr int LC_MISC = 64;
constexpr int LC_TAB = 1024;

__device__ __forceinline__ float bf_lo(unsigned w) { return __uint_as_float(w << 16); }
__device__ __forceinline__ float bf_hi(unsigned w) { return __uint_as_float(w & 0xffff0000u); }
__device__ __forceinline__ float bf2f(bf16 b) { return __uint_as_float(((unsigned)b) << 16); }
__device__ __forceinline__ unsigned f2bf(float f) { unsigned u = __float_as_uint(f); return (u + 0x7fffu + ((u >> 16) & 1u)) >> 16; }
__device__ __forceinline__ unsigned pk2(float lo, float hi) { return f2bf(lo) | (f2bf(hi) << 16); }
__device__ __forceinline__ void unpack8(const u32x4 v, float (&f)[8]) {
    f[0] = bf_lo(v.x); f[1] = bf_hi(v.x); f[2] = bf_lo(v.y); f[3] = bf_hi(v.y); f[4] = bf_lo(v.z); f[5] = bf_hi(v.z); f[6] = bf_lo(v.w); f[7] = bf_hi(v.w);
}
__device__ __forceinline__ u32x4 pack8(const float (&f)[8]) { u32x4 o; o.x = pk2(f[0], f[1]); o.y = pk2(f[2], f[3]); o.z = pk2(f[4], f[5]); o.w = pk2(f[6], f[7]); return o; }
__device__ __forceinline__ float wave_sum(float v) {
#pragma unroll
    for (int o = 1; o < 64; o <<= 1) v += __shfl_xor(v, o);
    return v;
}
__device__ __forceinline__ float sigmoidf_(float x) { return 1.0f / (1.0f + __expf(-x)); }
__device__ __forceinline__ float siluf_(float x) { return x / (1.0f + __expf(-x)); }
__device__ __forceinline__ float gelu_tanh(float x) { const float u = 0.7978845608028654f * (x + 0.044715f * x * x * x); return x / (1.0f + __expf(-2.0f * u)); }
__device__ __forceinline__ float softplusf_(float x) { return fmaxf(x, 0.f) + log1pf(__expf(-fabsf(x))); }

#define XB_TMO      128
#define XB_XCNT(j)  (256  + 64 * (j))
#define XB_XSUB(j)  (1280 + 64 * (j))
#define XB_XGEN(j)  (2304 + 64 * (j))
#define XB_TOP      3328
#define XB_TOPGEN   3392
#define XCD_BAR_WORDS 3456
#define XB_SPIN_CAP (1u << 18)
__device__ __forceinline__ unsigned xb_ld(unsigned* p)              { return __hip_atomic_load(p, __ATOMIC_RELAXED, __HIP_MEMORY_SCOPE_AGENT); }
__device__ __forceinline__ unsigned xb_add(unsigned* p, unsigned v) { return __hip_atomic_fetch_add(p, v, __ATOMIC_RELAXED, __HIP_MEMORY_SCOPE_AGENT); }
__device__ __forceinline__ unsigned xb_xcc_id() { return (unsigned)__builtin_amdgcn_s_getreg((3 << 11) | 20) & 0xFu; }
#define XB_SPIN(cond, bar) do { unsigned _sp = 0; while (cond) { __builtin_amdgcn_s_sleep(1); \
    if ((++_sp & 255u) == 0u) { if (xb_ld(&(bar)[XB_TMO])) break; if (_sp > XB_SPIN_CAP) { atomicAdd(&(bar)[XB_TMO], 1u); break; } } } } while (0)
struct XcdBarrier { unsigned* bar; unsigned x; volatile LAS unsigned* st; };
__device__ __forceinline__ XcdBarrier xcd_barrier_post(unsigned* bar, volatile LAS unsigned* st) {
    XcdBarrier b; b.bar = bar; b.x = xb_xcc_id(); b.st = st;
    if (threadIdx.x == 0) (void)xb_add(&bar[XB_XCNT(b.x)], 1u);
    return b;
}
__device__ __forceinline__ void xcd_barrier_complete(unsigned* bar, unsigned x, unsigned& nloc, unsigned& nx) {
    const unsigned G = gridDim.x * gridDim.y * gridDim.z;
    unsigned sum, cnt, mine, sp = 0u;
    for (;;) {
        sum = 0u; cnt = 0u; mine = 0u;
#pragma unroll
        for (unsigned j = 0; j < 16; ++j) { const unsigned c = xb_ld(&bar[XB_XCNT(j)]); sum += c; cnt += (c > 0u) ? 1u : 0u; mine = (j == x) ? c : mine; }
        if (sum == G) break;
        __builtin_amdgcn_s_sleep(1);
        if ((++sp & 255u) == 0u) { if (xb_ld(&bar[XB_TMO])) break; if (sp > XB_SPIN_CAP) { atomicAdd(&bar[XB_TMO], 1u); break; } }
    }
    nloc = mine > 0u ? mine : 1u; nx = cnt > 0u ? cnt : 1u;
}
__device__ __forceinline__ void xcd_barrier(const XcdBarrier& b) {
    asm volatile("s_waitcnt vmcnt(0)" ::: "memory");
    __syncthreads();
    if (threadIdx.x == 0) {
        unsigned* bar = b.bar;
        __builtin_amdgcn_s_waitcnt(0);
        unsigned nloc = b.st[0], nx = b.st[1];
        if (nloc == 0u) { xcd_barrier_complete(bar, b.x, nloc, nx); b.st[0] = nloc; b.st[1] = nx; }
        const unsigned old = xb_add(&bar[XB_XSUB(b.x)], 1u);
        const unsigned gen = old / nloc;
        if (old + 1u == (gen + 1u) * nloc) {
            __builtin_amdgcn_fence(__ATOMIC_RELEASE, "agent");
            asm volatile("s_waitcnt vmcnt(0)" ::: "memory");
            const unsigned og = xb_add(&bar[XB_TOP], 1u);
            const unsigned tg = og / nx;
            if (og + 1u == (tg + 1u) * nx) xb_add(&bar[XB_TOPGEN], 1u);
            else XB_SPIN(xb_ld(&bar[XB_TOPGEN]) == tg, bar);
            __builtin_amdgcn_fence(__ATOMIC_ACQUIRE, "agent");
            xb_add(&bar[XB_XGEN(b.x)], 1u);
            asm volatile("s_waitcnt vmcnt(0)" ::: "memory");
        } else {
            XB_SPIN(xb_ld(&bar[XB_XGEN(b.x)]) == gen, bar);
            __builtin_amdgcn_fence(__ATOMIC_ACQUIRE, "agent");
            asm volatile("s_waitcnt vmcnt(0)" ::: "memory");
        }
    }
    __syncthreads();
}

namespace pg8 {
constexpr int BM = 256, BK = 64, HALF = 128, HTB = HALF * BK * 2, STAGE_BYTES = 8 * HTB, NXCD = 8, WGM = 8;
__host__ __device__ __forceinline__ int lds_byte(int r, int c) { const int st = (r >> 4) * 2 + (c >> 5), rr = r & 15, cc = c & 31, ob = rr * 64 + cc * 2; return st * 1024 + (ob ^ (((ob >> 9) & 1) << 5)); }
__host__ __device__ __forceinline__ void stage_rc(int b, int& R, int& C) { const int st = b / 1024, sb = b % 1024, swz = sb ^ (((sb >> 9) & 1) << 5); R = (st >> 1) * 16 + swz / 64; C = (st & 1) * 32 + (swz % 64) / 2; }
__host__ __device__ __forceinline__ int perm32(int rho) { const int n = rho >> 4, i = rho & 15; return 8 * (i >> 2) + 4 * n + (i & 3); }

struct Unit { const char* A; const char* B; int r0, c0; };

struct TileOrder {
    int nM, nN, nwg, G, c;
    __device__ void init(int nM_, int nN_, int G_, int c_) { nM = nM_; nN = nN_; nwg = nM * nN; G = G_; c = c_; }
    __device__ bool next(int i, int& pm, int& pn) const {
        const long L = (long)i * G + c; if (L >= nwg) return false;
        int wgid = (int)L; { const int q = nwg / NXCD, r = nwg % NXCD, xcd = wgid % NXCD, off = wgid / NXCD; wgid = (xcd < r ? xcd * (q + 1) : r * (q + 1) + (xcd - r) * q) + off; }
        const int nig = WGM * nN, gid = wgid / nig, fm = gid * WGM, gsz = (nM - fm) < WGM ? (nM - fm) : WGM;
        pm = fm + ((wgid % nig) % gsz); pn = (wgid % nig) / gsz; return true;
    }
};
__device__ __forceinline__ unsigned cvt_pk_bf16(float lo, float hi) { unsigned r; asm volatile("v_cvt_pk_bf16_f32 %0, %1, %2" : "=v"(r) : "v"(lo), "v"(hi)); return r; }

template <class Epi, class Sched>
__device__ __forceinline__ void gemm_phase(LAS unsigned char* lds, const int tid, const int K, const int lda, const int ldb, const Sched& S, const Epi& E) {
    const int wid = __builtin_amdgcn_readfirstlane(tid >> 6), lane = tid & 63, wr = wid >> 2, wc = wid & 3, fr = lane & 15, fq = lane >> 4;
    const int nt = K / BK;
    unsigned voffA[2], voffB[2];
#pragma unroll
    for (int i = 0; i < 2; ++i) { int R, C; stage_rc(tid * 16 + i * 8192, R, C); const int Rb = Epi::PERM ? ((R & ~31) + perm32(R & 31)) : R;
        voffA[i] = (unsigned)(R * lda + C) * 2u; voffB[i] = (unsigned)(Rb * ldb + C) * 2u; }
    const size_t kstep = (size_t)(BK * 2);
    const size_t hstepA = (size_t)HALF * lda * 2, hstepB = (size_t)HALF * ldb * 2;
    const unsigned ldsw = (unsigned)wid * 1024u;
    const int aoff = lds_byte(wr * 64 + fr, fq * 8), boff = lds_byte(wc * 32 + fr, fq * 8);
#define PG8_SA(b, h) (((b) * 2 + (h)) * HTB)
#define PG8_SB(b, h) ((4 + (b) * 2 + (h)) * HTB)
#define PG8_STAGE(bufoff, gbase, voff) do { _Pragma("unroll") for (int _i = 0; _i < 2; ++_i) \
        __builtin_amdgcn_global_load_lds((const unsigned*)((const char*)(gbase) + (voff)[_i]), (LAS unsigned*)(lds + (bufoff) + ldsw + _i * 8192), 16, 0, 0); } while (0)
#define PG8_LDA(dst, b, h) do { _Pragma("unroll") for (int m = 0; m < 4; ++m) _Pragma("unroll") for (int k = 0; k < 2; ++k) dst[m][k] = *(const LAS bf16x8*)(lds + PG8_SA(b, h) + aoff + m * 2048 + k * 1024); } while (0)
#define PG8_LDB(dst, b, h) do { _Pragma("unroll") for (int n = 0; n < 2; ++n) _Pragma("unroll") for (int k = 0; k < 2; ++k) dst[n][k] = *(const LAS bf16x8*)(lds + PG8_SB(b, h) + boff + n * 2048 + k * 1024); } while (0)
#define PG8_MMA(ai, bj, At, Bt) do { __builtin_amdgcn_s_setprio(1); _Pragma("unroll") for (int m = 0; m < 4; ++m) _Pragma("unroll") for (int n = 0; n < 2; ++n) _Pragma("unroll") for (int k = 0; k < 2; ++k) \
        acc[ai][bj][m][n] = __builtin_amdgcn_mfma_f32_16x16x32_bf16(Bt[n][k], At[m][k], acc[ai][bj][m][n], 0, 0, 0); __builtin_amdgcn_s_setprio(0); } while (0)
#define PG8_WAIT_V(n) asm volatile("s_waitcnt vmcnt(" #n ")" ::: "memory")
#define PG8_WAIT_L(n) asm volatile("s_waitcnt lgkmcnt(" #n ")" ::: "memory")
#define PG8_BAR __builtin_amdgcn_s_barrier()
#define PG8_SCHED __builtin_amdgcn_sched_barrier(0)
    Unit cur, nxt; int ui = 0;
    if (!S.next(0, cur)) return;
    f32x4 acc[2][2][4][2];
#pragma unroll
    for (int a = 0; a < 2; ++a)
#pragma unroll
        for (int b = 0; b < 2; ++b)
#pragma unroll
            for (int m = 0; m < 4; ++m)
#pragma unroll
                for (int n = 0; n < 2; ++n) acc[a][b][m][n] = (f32x4){0.f, 0.f, 0.f, 0.f};
    bf16x8 At[4][2], B0[2][2], B1[2][2];
    const char* cA = cur.A; const char* cB = cur.B;
    PG8_STAGE(PG8_SB(0, 0), cB, voffB); PG8_STAGE(PG8_SB(0, 1), cB + hstepB, voffB); PG8_STAGE(PG8_SA(0, 0), cA, voffA); PG8_STAGE(PG8_SA(0, 1), cA + hstepA, voffA);
    if (wr == 1) PG8_BAR;
    PG8_WAIT_V(2); PG8_BAR;
    PG8_STAGE(PG8_SB(1, 0), cB + kstep, voffB); PG8_STAGE(PG8_SA(1, 0), cA + kstep, voffA); PG8_STAGE(PG8_SB(1, 1), cB + hstepB + kstep, voffB);
    PG8_WAIT_V(6); PG8_BAR;
    for (;;) {
        const bool has_next = S.next(ui + 1, nxt);
        const char* nA = has_next ? nxt.A : cA; const char* nB = has_next ? nxt.B : cB;
        for (int t = 0; t < nt; t += 2) {
            const bool last = (t == nt - 2);
            const char* a1 = cA + (size_t)(t + 1) * kstep;
            const char* a2 = last ? nA : cA + (size_t)(t + 2) * kstep; const char* b2 = last ? nB : cB + (size_t)(t + 2) * kstep;
            const char* a3 = a2 + kstep; const char* b3 = b2 + kstep;
            PG8_LDB(B0, 0, 0); PG8_LDB(B1, 0, 1); PG8_SCHED; PG8_LDA(At, 0, 0); PG8_STAGE(PG8_SA(1, 1), a1 + hstepA, voffA);
            PG8_WAIT_V(8); PG8_WAIT_L(0); PG8_BAR; PG8_MMA(0, 0, At, B0); PG8_MMA(0, 1, At, B1); PG8_BAR; PG8_SCHED;
            PG8_LDA(At, 0, 1); PG8_STAGE(PG8_SB(0, 0), b2, voffB); PG8_STAGE(PG8_SB(0, 1), b2 + hstepB, voffB); PG8_STAGE(PG8_SA(0, 0), a2, voffA);
            PG8_WAIT_V(8); PG8_WAIT_L(0); PG8_BAR; PG8_MMA(1, 0, At, B0); PG8_MMA(1, 1, At, B1); PG8_BAR; PG8_SCHED;
            PG8_LDB(B0, 1, 0); PG8_LDB(B1, 1, 1); PG8_SCHED; PG8_LDA(At, 1, 0); PG8_STAGE(PG8_SA(0, 1), a2 + hstepA, voffA);
            PG8_WAIT_V(8); PG8_WAIT_L(0); PG8_BAR; PG8_MMA(0, 0, At, B0); PG8_MMA(0, 1, At, B1); PG8_BAR; PG8_SCHED;
            PG8_LDA(At, 1, 1); PG8_STAGE(PG8_SB(1, 0), b3, voffB); PG8_STAGE(PG8_SB(1, 1), b3 + hstepB, voffB); PG8_STAGE(PG8_SA(1, 0), a3, voffA);
            PG8_WAIT_V(8); PG8_WAIT_L(0); PG8_BAR; PG8_MMA(1, 0, At, B0); PG8_MMA(1, 1, At, B1); PG8_BAR; PG8_SCHED;
        }
        if (wr == 0) PG8_BAR;
        E(acc, cur, wr, wc, fr, fq);
        if (!has_next) break;
#pragma unroll
        for (int a = 0; a < 2; ++a)
#pragma unroll
            for (int b = 0; b < 2; ++b)
#pragma unroll
                for (int m = 0; m < 4; ++m)
#pragma unroll
                    for (int n = 0; n < 2; ++n) acc[a][b][m][n] = (f32x4){0.f, 0.f, 0.f, 0.f};
        cur = nxt; cA = nA; cB = nB; ++ui;
        if (wr == 1) PG8_BAR;
    }
    PG8_WAIT_V(0);
    PG8_BAR;
#undef PG8_SA
#undef PG8_SB
#undef PG8_STAGE
#undef PG8_LDA
#undef PG8_LDB
#undef PG8_MMA
#undef PG8_WAIT_V
#undef PG8_WAIT_L
#undef PG8_BAR
#undef PG8_SCHED
}
}
using pg8::Unit;
using pg8::cvt_pk_bf16;

struct EpiStoreBf16 {
    static constexpr bool PERM = true;
    bf16* O; int ldc;
    __device__ __forceinline__ void operator()(const f32x4 (&acc)[2][2][4][2], const Unit& u, int wr, int wc, int fr, int fq) const {
        const int row0 = u.r0 + wr * 64 + fr, col0 = u.c0 + wc * 32 + 8 * fq;
#pragma unroll
        for (int ai = 0; ai < 2; ++ai)
#pragma unroll
            for (int m = 0; m < 4; ++m) { bf16* rowp = O + (size_t)(row0 + ai * 128 + m * 16) * ldc + col0;
#pragma unroll
                for (int bj = 0; bj < 2; ++bj) { const f32x4 v0 = acc[ai][bj][m][0], v1 = acc[ai][bj][m][1];
                    u32x4 w; w.x = cvt_pk_bf16(v0[0], v0[1]); w.y = cvt_pk_bf16(v0[2], v0[3]); w.z = cvt_pk_bf16(v1[0], v1[1]); w.w = cvt_pk_bf16(v1[2], v1[3]);
                    *(u32x4*)(rowp + bj * 128) = w; } }
    }
};
struct EpiGate {
    static constexpr bool PERM = true;
    bf16* G; int ldc;
    __device__ __forceinline__ void operator()(const f32x4 (&acc)[2][2][4][2], const Unit& u, int wr, int wc, int fr, int fq) const {
        const int row0 = u.r0 + wr * 64 + fr, col0 = u.c0 + wc * 32 + 8 * fq;
#pragma unroll
        for (int ai = 0; ai < 2; ++ai)
#pragma unroll
            for (int m = 0; m < 4; ++m) { bf16* rowp = G + (size_t)(row0 + ai * 128 + m * 16) * ldc + col0;
#pragma unroll
                for (int bj = 0; bj < 2; ++bj) { const f32x4 v0 = acc[ai][bj][m][0], v1 = acc[ai][bj][m][1];
                    const u32x4 gw = *(const u32x4*)(rowp + bj * 128); float g[8]; unpack8(gw, g);
                    u32x4 w; w.x = cvt_pk_bf16(sigmoidf_(g[0]) * v0[0], sigmoidf_(g[1]) * v0[1]); w.y = cvt_pk_bf16(sigmoidf_(g[2]) * v0[2], sigmoidf_(g[3]) * v0[3]);
                    w.z = cvt_pk_bf16(sigmoidf_(g[4]) * v1[0], sigmoidf_(g[5]) * v1[1]); w.w = cvt_pk_bf16(sigmoidf_(g[6]) * v1[2], sigmoidf_(g[7]) * v1[3]);
                    *(u32x4*)(rowp + bj * 128) = w; } }
    }
};
struct EpiResF32 {
    static constexpr bool PERM = false;
    const float* res; float* out;
    __device__ __forceinline__ void operator()(const f32x4 (&acc)[2][2][4][2], const Unit& u, int wr, int wc, int fr, int fq) const {
        const int row0 = u.r0 + wr * 64 + fr, col0 = u.c0 + wc * 32 + 4 * fq;
#pragma unroll
        for (int ai = 0; ai < 2; ++ai)
#pragma unroll
            for (int m = 0; m < 4; ++m) { const size_t ro = (size_t)(row0 + ai * 128 + m * 16) * D + col0;
#pragma unroll
                for (int bj = 0; bj < 2; ++bj)
#pragma unroll
                    for (int n = 0; n < 2; ++n) { const f32x4 r = *(const f32x4*)(res + ro + bj * 128 + n * 16); *(f32x4*)(out + ro + bj * 128 + n * 16) = r + acc[ai][bj][m][n]; } }
    }
};
struct EpiSwiglu {
    static constexpr bool PERM = true;
    bf16* O;
    __device__ __forceinline__ void operator()(const f32x4 (&acc)[2][2][4][2], const Unit& u, int wr, int wc, int fr, int fq) const {
        const int row0 = u.r0 + wr * 64 + fr, col0 = u.c0 + wc * 32 + 8 * fq;
#pragma unroll
        for (int ai = 0; ai < 2; ++ai)
#pragma unroll
            for (int m = 0; m < 4; ++m) { bf16* rowp = O + (size_t)(row0 + ai * 128 + m * 16) * DE + col0;
                const f32x4 g0 = acc[ai][0][m][0], g1 = acc[ai][0][m][1], u0 = acc[ai][1][m][0], u1 = acc[ai][1][m][1];
                u32x4 w; w.x = cvt_pk_bf16(siluf_(g0[0]) * u0[0], siluf_(g0[1]) * u0[1]); w.y = cvt_pk_bf16(siluf_(g0[2]) * u0[2], siluf_(g0[3]) * u0[3]);
                w.z = cvt_pk_bf16(siluf_(g1[0]) * u1[0], siluf_(g1[1]) * u1[1]); w.w = cvt_pk_bf16(siluf_(g1[2]) * u1[2], siluf_(g1[3]) * u1[3]);
                *(u32x4*)rowp = w; }
    }
};
struct EpiScatter {
    static constexpr bool PERM = true;
    bf16* Y; const int* row_code; const float* row_w;
    __device__ __forceinline__ void operator()(const f32x4 (&acc)[2][2][4][2], const Unit& u, int wr, int wc, int fr, int fq) const {
        const int row0 = u.r0 + wr * 64 + fr, col0 = u.c0 + wc * 32 + 8 * fq;
#pragma unroll
        for (int ai = 0; ai < 2; ++ai)
#pragma unroll
            for (int m = 0; m < 4; ++m) { const int row = row0 + ai * 128 + m * 16; const int code = row_code[row]; const float rw = row_w[row];
                if (code >= 0) { bf16* rowp = Y + (size_t)(code & 1) * ((size_t)M * D) + (size_t)(code >> 1) * D + col0;
#pragma unroll
                    for (int bj = 0; bj < 2; ++bj) { const f32x4 v0 = acc[ai][bj][m][0] * rw, v1 = acc[ai][bj][m][1] * rw;
                        u32x4 w; w.x = cvt_pk_bf16(v0[0], v0[1]); w.y = cvt_pk_bf16(v0[2], v0[3]); w.z = cvt_pk_bf16(v1[0], v1[1]); w.w = cvt_pk_bf16(v1[2], v1[3]);
                        *(u32x4*)(rowp + bj * 128) = w; } } }
    }
};

struct SchedH {
    pg8::TileOrder to; const char* A; const char* B;
    __device__ __forceinline__ bool next(int i, Unit& u) const { int pm, pn; if (!to.next(i, pm, pn)) return false;
        u.A = A + (size_t)pm * 256 * D * 2; u.B = B + (size_t)pn * 256 * D * 2; u.r0 = pm * 256; u.c0 = pn * 256; return true; }
};
struct SchedBranch {
    pg8::TileOrder to; const char* YS; const char* WBR;
    __device__ __forceinline__ bool next(int i, Unit& u) const { int pm, pn; if (!to.next(i, pm, pn)) return false; const int br = pn >> 2, q = pn & 3;
        u.A = YS + ((size_t)pm * 256 * 2048 + br * 512) * 2; u.B = WBR + ((size_t)br * D * 512 + (size_t)q * 256 * 512) * 2; u.r0 = pm * 256; u.c0 = HGATE + br * 1024 + q * 256; return true; }
};
struct SchedOut {
    pg8::TileOrder to; const char* A; const char* B;
    __device__ __forceinline__ bool next(int i, Unit& u) const { int pm, pn; if (!to.next(i, pm, pn)) return false;
        u.A = A + (size_t)pm * 256 * D * 2; u.B = B + (size_t)pn * 256 * D * 2; u.r0 = pm * 256; u.c0 = pn * 256; return true; }
};
struct SchedMoe {
    int nunits, G, c; const LAS int* blk_e; const char* A; size_t a_blk; const char* W; size_t w_e, w_pn; int cmul;
    __device__ __forceinline__ bool next(int i, Unit& u) const { const long L = (long)i * G + c; if (L >= nunits) return false; const int rb = (int)(L >> 2), pn = (int)(L & 3); const int e = blk_e[rb];
        u.A = A + (size_t)rb * a_blk; u.B = W + (size_t)e * w_e + (size_t)pn * w_pn; u.r0 = rb * 256; u.c0 = pn * cmul; return true; }
};

struct Params { const float* in[25]; float* out; unsigned char* ws; int ph_lo, ph_hi; };
enum { I_X = 0, I_MIXNW, I_WIN, I_GCONV, I_GALOG, I_GDT, I_GNW, I_CCW, I_CCB, I_CLNW, I_CLNB, I_GLNW, I_GLNB, I_GWS, I_GBS, I_SCW, I_WBR, I_WOUT, I_MOENW, I_RGRP, I_REXP, I_WG, I_WU, I_WD, I_FNW };
constexpr int PH_PER_LAYER = 12, PH_FINAL = 24, PH_TOTAL = 25;

__device__ __forceinline__ void transpose_item(const float* __restrict__ W, int ldw, int srccol, bf16* __restrict__ WT, int ldt, int k0, int n0, LAS float* scr, int lane) {
#pragma unroll 8
    for (int i = 0; i < 32; ++i) { const int kk = 2 * i + (lane >> 5); scr[kk * 33 + (lane & 31)] = W[(size_t)(k0 + kk) * ldw + srccol + (lane & 31)]; }
    asm volatile("s_waitcnt lgkmcnt(0)" ::: "memory");
    const int c = lane & 7;
#pragma unroll
    for (int j = 0; j < 4; ++j) { const int n = (lane >> 3) + 8 * j; const LAS float* s = scr + (8 * c) * 33 + n;
        u32x4 o; o.x = pk2(s[0 * 33], s[1 * 33]); o.y = pk2(s[2 * 33], s[3 * 33]); o.z = pk2(s[4 * 33], s[5 * 33]); o.w = pk2(s[6 * 33], s[7 * 33]);
        *(u32x4*)(WT + (size_t)(n0 + n) * ldt + k0 + 8 * c) = o; }
    asm volatile("s_waitcnt lgkmcnt(0)" ::: "memory");
}
__device__ __forceinline__ void prep_static_weights(const Params& p, LAS unsigned char* lds, int gw, int NGW, int wave, int lane) {
    LAS float* scr = (LAS float*)(lds + wave * 16384);
    constexpr int I_IN = 16 * (DH / 32), I_BR = 8 * 32, I_OUT = 16 * 32, PER_L = I_IN + 4 * I_BR + I_OUT;
    for (int it = gw; it < NLAYER * PER_L; it += NGW) {
        const int l = it / PER_L; int r = it % PER_L;
        if (r < I_IN) { const int kb = r / (DH / 32), nb = r % (DH / 32), n0 = nb * 32;
            transpose_item(p.in[I_WIN] + (size_t)l * D * DIN, DIN, n0 + (n0 >= 2048 ? 8 : 0), (bf16*)(p.ws + WS_WIN + l * WIN_L), D, kb * 64, n0, scr, lane); continue; }
        r -= I_IN;
        if (r < 4 * I_BR) { const int br = r / I_BR, q = r % I_BR, kb = q / 32, nb = q % 32;
            transpose_item(p.in[I_WBR] + ((size_t)l * 4 + br) * 512 * D, D, nb * 32, (bf16*)(p.ws + WS_WBR + l * WBR_L) + (size_t)br * D * 512, 512, kb * 64, nb * 32, scr, lane); continue; }
        r -= 4 * I_BR;
        { const int kb = r / 32, nb = r % 32;
            transpose_item(p.in[I_WOUT] + (size_t)l * D * D, D, nb * 32, (bf16*)(p.ws + WS_WOUT + l * WOUT_L), D, kb * 64, nb * 32, scr, lane); }
    }
}
__device__ __forceinline__ void prep_moe_weights(const Params& p, int layer, LAS unsigned char* lds, int gw, int NGW, int wave, int lane) {
    LAS float* scr = (LAS float*)(lds + wave * 16384);
    constexpr int I_GU = 16 * 32, I_D = 8 * 32, PER_E = I_GU + I_D;
    for (int it = gw; it < NE * PER_E; it += NGW) {
        const int e = it / PER_E; int r = it % PER_E;
        if (r < I_GU) { const int kb = r / 32, nb = r % 32, n0 = nb * 32, pn = n0 >> 8, half = (n0 >> 7) & 1, j0 = n0 & 127;
            const float* src = p.in[half ? I_WU : I_WG] + ((size_t)layer * NE + e) * D * DE;
            transpose_item(src, DE, 128 * pn + j0, (bf16*)(p.ws + WS_MOEW + e * WGU_E), D, kb * 64, n0, scr, lane); continue; }
        r -= I_GU;
        { const int kb = r / 32, nb = r % 32;
            transpose_item(p.in[I_WD] + ((size_t)layer * NE + e) * DE * D, D, nb * 32, (bf16*)(p.ws + WS_WD + e * WD_E), DE, kb * 64, nb * 32, scr, lane); }
    }
}

template <int MODE>
__device__ __forceinline__ void norm_phase(const Params& p, int layer, LAS unsigned char* lds, int gw, int NGW, int tid, int lane) {
    LAS float* wsm = (LAS float*)lds;
    if (MODE != 2) {
        const float* wi = p.in[I_WIN] + (size_t)layer * D * DIN;
        for (int i = tid; i < 8192; i += 512) wsm[i] = wi[(size_t)(i >> 3) * DIN + 2048 + (i & 7)];
    }
    __syncthreads();
    const float* nwp = (MODE == 2) ? p.in[I_FNW] : p.in[I_MIXNW] + layer * D;
    f32x4 nw[4];
#pragma unroll
    for (int j = 0; j < 4; ++j) nw[j] = *(const f32x4*)(nwp + 4 * lane + 256 * j);
    const bf16* Y0 = (const bf16*)(p.ws + WS_Y); const bf16* Y1 = Y0 + (size_t)M * D;
    bf16* XN = (bf16*)(p.ws + WS_XN); float* SMALL = (float*)(p.ws + WS_SMALL);
    for (int m = gw; m < M; m += NGW) {
        const float* xr = (MODE == 0 ? p.in[I_X] : p.out) + (size_t)m * D;
        f32x4 v[4]; float ss = 0.f;
#pragma unroll
        for (int j = 0; j < 4; ++j) { v[j] = *(const f32x4*)(xr + 4 * lane + 256 * j);
            if (MODE != 0) { const u32x2 a = *(const u32x2*)(Y0 + (size_t)m * D + 4 * lane + 256 * j), b = *(const u32x2*)(Y1 + (size_t)m * D + 4 * lane + 256 * j);
                v[j][0] += bf_lo(a.x) + bf_lo(b.x); v[j][1] += bf_hi(a.x) + bf_hi(b.x); v[j][2] += bf_lo(a.y) + bf_lo(b.y); v[j][3] += bf_hi(a.y) + bf_hi(b.y); }
            ss += (v[j][0] * v[j][0] + v[j][1] * v[j][1]) + (v[j][2] * v[j][2] + v[j][3] * v[j][3]); }
        const float rs = 1.0f / sqrtf(wave_sum(ss) * (1.0f / D) + EPS);
        if (MODE == 2) {
#pragma unroll
            for (int j = 0; j < 4; ++j) *(f32x4*)(p.out + (size_t)m * D + 4 * lane + 256 * j) = v[j] * rs * nw[j];
            continue;
        }
        if (MODE == 1) {
#pragma unroll
            for (int j = 0; j < 4; ++j) *(f32x4*)(p.out + (size_t)m * D + 4 * lane + 256 * j) = v[j];
        }
        float sm[8];
#pragma unroll
        for (int q = 0; q < 8; ++q) sm[q] = 0.f;
#pragma unroll
        for (int j = 0; j < 4; ++j) { v[j] = v[j] * rs * nw[j];
            u32x2 o; o.x = pk2(v[j][0], v[j][1]); o.y = pk2(v[j][2], v[j][3]); *(u32x2*)(XN + (size_t)m * D + 4 * lane + 256 * j) = o;
#pragma unroll
            for (int c = 0; c < 4; ++c) { const LAS float* wrow = wsm + (4 * lane + 256 * j + c) * 8; const f32x4 w0 = *(const LAS f32x4*)wrow, w1 = *(const LAS f32x4*)(wrow + 4);
                sm[0] += v[j][c] * w0[0]; sm[1] += v[j][c] * w0[1]; sm[2] += v[j][c] * w0[2]; sm[3] += v[j][c] * w0[3];
                sm[4] += v[j][c] * w1[0]; sm[5] += v[j][c] * w1[1]; sm[6] += v[j][c] * w1[2]; sm[7] += v[j][c] * w1[3]; } }
        float mine = 0.f;
#pragma unroll
        for (int q = 0; q < 8; ++q) { const float s = wave_sum(sm[q]); mine = (lane == q) ? s : mine; }
        if (lane < 8) SMALL[(size_t)m * 8 + lane] = mine;
    }
    __syncthreads();
}

__device__ __forceinline__ void gdn_prep(const Params& p, int layer, int gw, int NGW, int lane) {
    const bf16* H = (const bf16*)(p.ws + WS_H); bf16* GQ = (bf16*)(p.ws + WS_GQ);
    const float* SMALL = (const float*)(p.ws + WS_SMALL); float* GB = (float*)(p.ws + WS_GBG); float* GG = GB + (size_t)M * 4;
    const float* cw = p.in[I_GCONV] + (size_t)layer * 4 * 1536;
    for (int it = gw; it < M * 4; it += NGW) {
        const int m = it >> 2, hh = it & 3, t = m & (T - 1);
        float y[3][2];
#pragma unroll
        for (int s = 0; s < 3; ++s) { const int c = s * 512 + hh * 128 + 2 * lane; float a0 = 0.f, a1 = 0.f;
#pragma unroll
            for (int j = 0; j < 4; ++j) { if (t - 3 + j >= 0) { const unsigned w = *(const unsigned*)(H + (size_t)(m - 3 + j) * DH + c);
                    a0 += cw[j * 1536 + c] * bf_lo(w); a1 += cw[j * 1536 + c + 1] * bf_hi(w); } }
            y[s][0] = siluf_(a0); y[s][1] = siluf_(a1); }
        const float sq = wave_sum(y[0][0] * y[0][0] + y[0][1] * y[0][1]), sk = wave_sum(y[1][0] * y[1][0] + y[1][1] * y[1][1]);
        const float rq = 0.08838834764831845f / sqrtf(sq + EPS), rk = 1.0f / sqrtf(sk + EPS);
        bf16* o = GQ + (size_t)m * 1536 + hh * 128 + 2 * lane;
        *(unsigned*)(o) = pk2(y[0][0] * rq, y[0][1] * rq);
        *(unsigned*)(o + 512) = pk2(y[1][0] * rk, y[1][1] * rk);
        *(unsigned*)(o + 1024) = pk2(y[2][0], y[2][1]);
        if (lane == 0) { const float br = SMALL[(size_t)m * 8 + hh], ar = SMALL[(size_t)m * 8 + 4 + hh];
            GB[(size_t)m * 4 + hh] = sigmoidf_(br);
            GG[(size_t)m * 4 + hh] = -__expf(p.in[I_GALOG][layer * 4 + hh]) * softplusf_(ar + p.in[I_GDT][layer * 4 + hh]); }
    }
}
__device__ __forceinline__ void shortconv(const Params& p, int layer, int gtid, int NGT) {
    const bf16* H = (const bf16*)(p.ws + WS_H); bf16* YS = (bf16*)(p.ws + WS_YS);
    const float* cw = p.in[I_SCW] + (size_t)layer * 3 * 512;
    for (int it = gtid; it < M * 64; it += NGT) {
        const int m = it >> 6, c8 = (it & 63) * 8, t = m & (T - 1);
        float acc[8];
#pragma unroll
        for (int i = 0; i < 8; ++i) acc[i] = 0.f;
#pragma unroll
        for (int j = 0; j < 3; ++j) { if (t - 2 + j >= 0) { const bf16* r = H + (size_t)(m - 2 + j) * DH + HSC + c8;
                float cg[8], xv[8]; unpack8(*(const u32x4*)(r + 512), cg); unpack8(*(const u32x4*)(r + 1024), xv);
#pragma unroll
                for (int i = 0; i < 8; ++i) acc[i] += cw[j * 512 + c8 + i] * (cg[i] * xv[i]); } }
        float bg[8]; unpack8(*(const u32x4*)(H + (size_t)m * DH + HSC + c8), bg);
#pragma unroll
        for (int i = 0; i < 8; ++i) acc[i] *= bg[i];
        *(u32x4*)(YS + (size_t)m * 2048 + 1536 + c8) = pack8(acc);
    }
}
__device__ __forceinline__ void conformer(const Params& p, int layer, LAS unsigned char* lds, int tid, int wave, int lane) {
    const bf16* H = (const bf16*)(p.ws + WS_H); bf16* YS = (bf16*)(p.ws + WS_YS);
    LAS bf16* yt = (LAS bf16*)lds;
    LAS float* zt = (LAS float*)(lds + 98304);
    const float* cwp = p.in[I_CCW] + (size_t)layer * 31 * 512;
    float cw[31];
#pragma unroll
    for (int j = 0; j < 31; ++j) cw[j] = cwp[j * 512 + tid];
    const float cb = p.in[I_CCB][layer * 512 + tid];
    float lw[8], lb[8];
#pragma unroll
    for (int i = 0; i < 8; ++i) { lw[i] = p.in[I_CLNW][layer * 512 + lane * 8 + i]; lb[i] = p.in[I_CLNB][layer * 512 + lane * 8 + i]; }
    for (int unit = blockIdx.x; unit < M / 64; unit += gridDim.x) {
        const int m0 = unit * 64, t0 = m0 & (T - 1);
        for (int it = tid; it < 94 * 64; it += 512) { const int r = it >> 6, c8 = (it & 63) * 8; const int dt = r - 30;
            u32x4 o = (u32x4){0u, 0u, 0u, 0u};
            if (t0 + dt >= 0) { const bf16* src = H + (size_t)(m0 + dt) * DH + HCONF + c8; float a[8], g[8]; unpack8(*(const u32x4*)src, a); unpack8(*(const u32x4*)(src + 512), g);
#pragma unroll
                for (int i = 0; i < 8; ++i) a[i] *= sigmoidf_(g[i]);
                o = pack8(a); }
            *(LAS u32x4*)(yt + r * 512 + c8) = o; }
        __syncthreads();
        for (int sb = 0; sb < 8; ++sb) {
            float z[8];
#pragma unroll
            for (int i = 0; i < 8; ++i) z[i] = cb;
#pragma unroll
            for (int r = 0; r < 38; ++r) { const float yv = bf2f(yt[(sb * 8 + r) * 512 + tid]);
#pragma unroll
                for (int i = 0; i < 8; ++i) { const int j = r - i; if (j >= 0 && j < 31) z[i] += cw[j] * yv; } }
#pragma unroll
            for (int i = 0; i < 8; ++i) zt[i * 512 + tid] = z[i];
            __syncthreads();
            { const LAS float* zr = zt + wave * 512 + lane * 8; float v[8]; const f32x4 a = *(const LAS f32x4*)zr, b = *(const LAS f32x4*)(zr + 4);
                v[0] = a[0]; v[1] = a[1]; v[2] = a[2]; v[3] = a[3]; v[4] = b[0]; v[5] = b[1]; v[6] = b[2]; v[7] = b[3];
                float s = 0.f;
#pragma unroll
                for (int i = 0; i < 8; ++i) s += v[i];
                const float mean = wave_sum(s) * (1.0f / 512.0f); float q = 0.f;
#pragma unroll
                for (int i = 0; i < 8; ++i) { v[i] -= mean; q += v[i] * v[i]; }
                const float rstd = 1.0f / sqrtf(wave_sum(q) * (1.0f / 512.0f) + EPS);
#pragma unroll
                for (int i = 0; i < 8; ++i) v[i] = siluf_(v[i] * rstd * lw[i] + lb[i]);
                *(u32x4*)(YS + (size_t)(m0 + sb * 8 + wave) * 2048 + 512 + lane * 8) = pack8(v); }
            __syncthreads();
        }
    }
}
__device__ __forceinline__ void gmlp(const Params& p, int layer, LAS unsigned char* lds, int tid, int wave, int lane) {
    const bf16* H = (const bf16*)(p.ws + WS_H); bf16* YS = (bf16*)(p.ws + WS_YS);
    LAS float* Vg = (LAS float*)lds;
    LAS float* Wg = (LAS float*)(lds + 65536);
    LAS float* st = (LAS float*)(lds + LDSCTL_OFF + LC_TAB);
    const float* lnw = p.in[I_GLNW] + layer * 512; const float* lnb = p.in[I_GLNB] + layer * 512;
    for (int unit = blockIdx.x; unit < M / 128; unit += gridDim.x) {
        const int m0 = unit * 128;
        for (int tk = wave * 16; tk < wave * 16 + 16; ++tk) {
            float v[8]; unpack8(*(const u32x4*)(H + (size_t)(m0 + tk) * DH + HGMLP + 512 + lane * 8), v);
            float s = 0.f;
#pragma unroll
            for (int i = 0; i < 8; ++i) { v[i] = gelu_tanh(v[i]); s += v[i]; }
            const float mean = wave_sum(s) * (1.0f / 512.0f); float q = 0.f;
#pragma unroll
            for (int i = 0; i < 8; ++i) { const float d = v[i] - mean; q += d * d; }
            const float rstd = 1.0f / sqrtf(wave_sum(q) * (1.0f / 512.0f) + EPS);
            if (lane == 0) { st[tk * 2] = mean; st[tk * 2 + 1] = rstd; }
        }
        __syncthreads();
        for (int g = 0; g < 4; ++g) {
            for (int it = tid; it < 128 * 16; it += 512) { const int tk = it >> 4, c8 = (it & 15) * 8;
                float v[8]; unpack8(*(const u32x4*)(H + (size_t)(m0 + tk) * DH + HGMLP + 512 + g * 128 + c8), v);
                const float mean = st[tk * 2], rstd = st[tk * 2 + 1];
#pragma unroll
                for (int i = 0; i < 8; ++i) Vg[tk * 128 + c8 + i] = (gelu_tanh(v[i]) - mean) * rstd * lnw[g * 128 + c8 + i] + lnb[g * 128 + c8 + i]; }
            const float* ws = p.in[I_GWS] + ((size_t)layer * 4 + g) * 128 * 128;
            for (int it = tid; it < 128 * 128; it += 512) { const int i = it >> 7, j = it & 127; Wg[it] = (j <= i) ? ws[it] : 0.f; }
            __syncthreads();
            const int c = tid & 127, i0 = tid >> 7;
            for (int r = 0; r < 32; ++r) { const int i = i0 + 4 * r; float a = 0.f;
                for (int j = 0; j <= i; ++j) a += Wg[i * 128 + j] * Vg[j * 128 + c];
                a += p.in[I_GBS][((size_t)layer * 4 + g) * 128 + i];
                const float u = gelu_tanh(bf2f(H[(size_t)(m0 + i) * DH + HGMLP + g * 128 + c]));
                YS[(size_t)(m0 + i) * 2048 + 1024 + g * 128 + c] = (bf16)f2bf(u * a); }
            __syncthreads();
        }
    }
}
__device__ __forceinline__ void gdn_scan_seq(const Params& p, LAS unsigned char* lds, int tid) {
    const bf16* GQ = (const bf16*)(p.ws + WS_GQ); const float* GB = (const float*)(p.ws + WS_GBG); const float* GG = GB + (size_t)M * 4;
    float* OB = (float*)(p.ws + WS_OBUF);
    constexpr int TS = 16;
    const int sub = tid >> 8, j = (tid & 255) >> 1, hf = tid & 1, t256 = tid & 255;
    LAS float* sq = (LAS float*)(lds + sub * 32768);
    LAS float* sk = sq + TS * 128; LAS float* sv = sk + TS * 128; LAS float* sb = sv + TS * 128; LAS float* sa = sb + TS;
    for (int vb = blockIdx.x; vb < 16; vb += gridDim.x) {
        const int bh = vb * 2 + sub, b = bh >> 2, hh = bh & 3;
        float S[64];
#pragma unroll
        for (int i = 0; i < 64; ++i) S[i] = 0.f;
        for (int tc = 0; tc < T; tc += TS) {
            __syncthreads();
            for (int it = t256; it < TS * 128; it += 256) { const int tt = it >> 7, c = it & 127; const bf16* r = GQ + (size_t)(b * T + tc + tt) * 1536 + hh * 128 + c;
                sq[it] = bf2f(r[0]); sk[it] = bf2f(r[512]); sv[it] = bf2f(r[1024]); }
            if (t256 < TS) { sb[t256] = GB[(size_t)(b * T + tc + t256) * 4 + hh]; sa[t256] = __expf(GG[(size_t)(b * T + tc + t256) * 4 + hh]); }
            __syncthreads();
            for (int tt = 0; tt < TS; ++tt) {
                const float al = sa[tt], be = sb[tt];
                const LAS float* kr = sk + tt * 128 + hf * 64; const LAS float* qr = sq + tt * 128 + hf * 64;
                float ks = 0.f;
#pragma unroll
                for (int i = 0; i < 64; i += 4) { const f32x4 kk = *(const LAS f32x4*)(kr + i); ks += kk[0] * S[i] + kk[1] * S[i + 1] + kk[2] * S[i + 2] + kk[3] * S[i + 3]; }
                ks += __shfl_xor(ks, 1);
                const float un = be * (sv[tt * 128 + j] - al * ks);
                float o = 0.f;
#pragma unroll
                for (int i = 0; i < 64; i += 4) { const f32x4 kk = *(const LAS f32x4*)(kr + i), qq = *(const LAS f32x4*)(qr + i);
                    S[i] = al * S[i] + kk[0] * un; S[i + 1] = al * S[i + 1] + kk[1] * un; S[i + 2] = al * S[i + 2] + kk[2] * un; S[i + 3] = al * S[i + 3] + kk[3] * un;
                    o += qq[0] * S[i] + qq[1] * S[i + 1] + qq[2] * S[i + 2] + qq[3] * S[i + 3]; }
                o += __shfl_xor(o, 1);
                if (hf == 0) OB[(size_t)(b * T + tc + tt) * 512 + hh * 128 + j] = o;
            }
        }
    }
    __syncthreads();
}
__device__ __forceinline__ void gdn_out(const Params& p, int layer, int gw, int NGW, int lane) {
    const bf16* H = (const bf16*)(p.ws + WS_H); bf16* YS = (bf16*)(p.ws + WS_YS); const float* OB = (const float*)(p.ws + WS_OBUF);
    const float w0 = p.in[I_GNW][layer * 128 + 2 * lane], w1 = p.in[I_GNW][layer * 128 + 2 * lane + 1];
    for (int it = gw; it < M * 4; it += NGW) { const int m = it >> 2, hh = it & 3;
        const f32x2 o = *(const f32x2*)(OB + (size_t)m * 512 + hh * 128 + 2 * lane);
        const float rs = 1.0f / sqrtf(wave_sum(o[0] * o[0] + o[1] * o[1]) * (1.0f / 128.0f) + EPS);
        const unsigned zw = *(const unsigned*)(H + (size_t)m * DH + HZ + hh * 128 + 2 * lane);
        *(unsigned*)(YS + (size_t)m * 2048 + hh * 128 + 2 * lane) = pk2(o[0] * rs * w0 * siluf_(bf_lo(zw)), o[1] * rs * w1 * siluf_(bf_hi(zw)));
    }
}
__device__ __forceinline__ void sum_gated(const Params& p, int gtid, int NGT) {
    const bf16* H = (const bf16*)(p.ws + WS_H); bf16* MG = (bf16*)(p.ws + WS_MERGED);
    for (int it = gtid; it < M * 128; it += NGT) { const int m = it >> 7, c8 = (it & 127) * 8; const bf16* r = H + (size_t)m * DH + HGATE + c8;
        float a[8], b[8];
        unpack8(*(const u32x4*)r, a);
#pragma unroll
        for (int br = 1; br < 4; ++br) { unpack8(*(const u32x4*)(r + br * 1024), b);
#pragma unroll
            for (int i = 0; i < 8; ++i) a[i] += b[i]; }
        *(u32x4*)(MG + (size_t)m * D + c8) = pack8(a); }
}

__device__ __forceinline__ void moe_route(const Params& p, int layer, LAS unsigned char* lds, int tid, int wave, int lane) {
    LAS float* xs = (LAS float*)lds;
    LAS int* hist = (LAS int*)(lds + LDSCTL_OFF + LC_TAB);
    bf16* XN = (bf16*)(p.ws + WS_XN);
    int* route_e = (int*)(p.ws + WS_ROUTE); float* route_w = (float*)(p.ws + WS_ROUTE + (size_t)M * 2 * 4);
    int* cnt = (int*)(p.ws + WS_MOETAB + (size_t)NROWS_MAX * 8);
    const float* rg = p.in[I_RGRP] + (size_t)layer * D * 8; const float* re = p.in[I_REXP] + (size_t)layer * D * 64;
    f32x4 nw[4];
#pragma unroll
    for (int j = 0; j < 4; ++j) nw[j] = *(const f32x4*)(p.in[I_MOENW] + layer * D + 4 * lane + 256 * j);
    for (int vb = blockIdx.x; vb < M / 128; vb += gridDim.x) {
        if (tid < 64) hist[tid] = 0;
        for (int tile = 0; tile < 4; ++tile) {
            const int m0 = vb * 128 + tile * 32;
            __syncthreads();
            for (int r = wave * 4; r < wave * 4 + 4; ++r) { const int m = m0 + r; const float* xr = p.out + (size_t)m * D;
                f32x4 v[4]; float ss = 0.f;
#pragma unroll
                for (int j = 0; j < 4; ++j) { v[j] = *(const f32x4*)(xr + 4 * lane + 256 * j); ss += (v[j][0] * v[j][0] + v[j][1] * v[j][1]) + (v[j][2] * v[j][2] + v[j][3] * v[j][3]); }
                const float rs = 1.0f / sqrtf(wave_sum(ss) * (1.0f / D) + EPS);
#pragma unroll
                for (int j = 0; j < 4; ++j) { v[j] = v[j] * rs * nw[j]; *(LAS f32x4*)(xs + r * 1024 + 4 * lane + 256 * j) = v[j];
                    u32x2 o; o.x = pk2(v[j][0], v[j][1]); o.y = pk2(v[j][2], v[j][3]); *(u32x2*)(XN + (size_t)m * D + 4 * lane + 256 * j) = o; } }
            __syncthreads();
            float ae[32], ag[32];
#pragma unroll
            for (int r = 0; r < 32; ++r) { ae[r] = 0.f; ag[r] = 0.f; }
            for (int k = wave * 128; k < wave * 128 + 128; k += 4) {
                float we[4], wg[4];
#pragma unroll
                for (int q = 0; q < 4; ++q) { we[q] = re[(size_t)(k + q) * 64 + lane]; wg[q] = rg[(size_t)(k + q) * 8 + (lane & 7)]; }
#pragma unroll
                for (int r = 0; r < 32; ++r) { const f32x4 x = *(const LAS f32x4*)(xs + r * 1024 + k);
                    ae[r] += x[0] * we[0] + x[1] * we[1] + x[2] * we[2] + x[3] * we[3];
                    ag[r] += x[0] * wg[0] + x[1] * wg[1] + x[2] * wg[2] + x[3] * wg[3]; }
            }
            __syncthreads();
            LAS float* part = xs;
#pragma unroll
            for (int r = 0; r < 32; ++r) { part[(wave * 32 + r) * 72 + lane] = ae[r]; if (lane < 8) part[(wave * 32 + r) * 72 + 64 + lane] = ag[r]; }
            __syncthreads();
            for (int r = wave * 4; r < wave * 4 + 4; ++r) { const int m = m0 + r;
                float le = 0.f, lg = 0.f;
#pragma unroll
                for (int w = 0; w < 8; ++w) { le += part[(w * 32 + r) * 72 + lane]; lg += part[(w * 32 + r) * 72 + 64 + (lane & 7)]; }
                float gv[8];
#pragma unroll
                for (int i = 0; i < 8; ++i) gv[i] = __shfl(lg, i);
                int grp = 0; float gmax = gv[0];
#pragma unroll
                for (int i = 1; i < 8; ++i) if (gv[i] > gmax) { gmax = gv[i]; grp = i; }
                float gs = 0.f;
#pragma unroll
                for (int i = 0; i < 8; ++i) gs += __expf(gv[i] - gmax);
                const float psel = 1.0f / gs;
                float ev[8];
#pragma unroll
                for (int i = 0; i < 8; ++i) ev[i] = __shfl(le, grp * 8 + i);
                int i1 = 0; float e1 = ev[0];
#pragma unroll
                for (int i = 1; i < 8; ++i) if (ev[i] > e1) { e1 = ev[i]; i1 = i; }
                int i2 = -1; float e2 = -3.0e38f;
#pragma unroll
                for (int i = 0; i < 8; ++i) if (i != i1 && ev[i] > e2) { e2 = ev[i]; i2 = i; }
                const float x2 = __expf(e2 - e1), w1 = psel / (1.0f + x2), w2 = psel * x2 / (1.0f + x2);
                if (lane == 0) { route_e[(size_t)m * 2] = grp * 8 + i1; route_e[(size_t)m * 2 + 1] = grp * 8 + i2; route_w[(size_t)m * 2] = w1; route_w[(size_t)m * 2 + 1] = w2;
                    atomicAdd((int*)(hist + grp * 8 + i1), 1); atomicAdd((int*)(hist + grp * 8 + i2), 1); }
            }
        }
        __syncthreads();
        if (tid < 64) cnt[vb * 64 + tid] = hist[tid];
        __syncthreads();
    }
}
__device__ __forceinline__ void moe_dispatch(const Params& p, LAS unsigned char* lds, int tid, int wave, int lane) {
    LAS int* tab = (LAS int*)(lds + LDSCTL_OFF + LC_TAB);
    const bf16* XN = (const bf16*)(p.ws + WS_XN); bf16* XS = (bf16*)(p.ws + WS_XS);
    const int* route_e = (const int*)(p.ws + WS_ROUTE); const float* route_w = (const float*)(p.ws + WS_ROUTE + (size_t)M * 2 * 4);
    int* row_code = (int*)(p.ws + WS_MOETAB); float* row_w = (float*)(p.ws + WS_MOETAB + (size_t)NROWS_MAX * 4);
    const int* cnt = (const int*)(p.ws + WS_MOETAB + (size_t)NROWS_MAX * 8); int* blk_e = (int*)(p.ws + WS_MOETAB + (size_t)NROWS_MAX * 8 + 256 * 64 * 4);
    for (int vb = blockIdx.x; vb < M / 128; vb += gridDim.x) {
        __syncthreads();
        if (tid < 64) { int run = 0, base = 0; for (int v = 0; v < M / 128; ++v) { if (v == vb) base = run; run += cnt[v * 64 + tid]; } tab[64 + tid] = run; tab[128 + tid] = base; }
        __syncthreads();
        if (tid == 0) { int s = 0; for (int e = 0; e < 64; ++e) { tab[e] = s; s += (tab[64 + e] + 255) / 256 * 256; } tab[704] = s; }
        if (tid < 256) tab[192 + tid] = route_e[(size_t)vb * 256 + tid];
        __syncthreads();
        if (tid < 256) { const int e = tab[192 + tid]; int rank = 0; for (int a = 0; a < tid; ++a) rank += (tab[192 + a] == e) ? 1 : 0;
            const int pos = tab[e] + tab[128 + e] + rank; tab[448 + tid] = pos;
            row_code[pos] = ((vb * 128 + (tid >> 1)) << 1) | (tid & 1); row_w[pos] = route_w[(size_t)vb * 256 + tid]; }
        if (vb < 64) { const int ps = tab[vb], tot = tab[64 + vb], pe = ps + (tot + 255) / 256 * 256;
            for (int r = ps + tot + tid; r < pe; r += 512) row_code[r] = -1;
            for (int b = ps / 256 + tid; b < pe / 256; b += 512) blk_e[b] = vb;
            if (vb == 63 && tid == 0) blk_e[NROWBLK_MAX] = tab[704] / 256; }
        __syncthreads();
        for (int a = wave; a < 256; a += 8) { const int pos = tab[448 + a]; const int tok = vb * 128 + (a >> 1);
            const u32x4* src = (const u32x4*)(XN + (size_t)tok * D); u32x4* dst = (u32x4*)(XS + (size_t)pos * D);
            dst[lane] = src[lane]; dst[lane + 64] = src[lane + 64]; }
    }
    __syncthreads();
}

__global__ void __launch_bounds__(512, 2) fwd(Params p) {
    extern __shared__ __attribute__((aligned(16))) unsigned char lds_raw[];
    LAS unsigned char* lds = (LAS unsigned char*)lds_raw;
    const int tid0 = threadIdx.x;
    const int G = gridDim.x, NGW = G * 8, NGT = G * 512;
#define FRESH() int tid = tid0; asm volatile("" : "+v"(tid)); const int lane = tid & 63, wave = __builtin_amdgcn_readfirstlane(tid >> 6); const int gw = blockIdx.x * 8 + wave, gtid = blockIdx.x * 512 + tid; (void)lane; (void)gw; (void)gtid
    for (int u = tid0; u < (LDS_BYTES - LDSCTL_OFF) / 4; u += 512) ((LAS unsigned*)(lds + LDSCTL_OFF))[u] = 0u;
    __syncthreads();
    const int lo = p.ph_lo, hi = p.ph_hi;
    XcdBarrier bar; bar.bar = (unsigned*)(p.ws + WS_CTL) + CW_BAR; bar.x = 0; bar.st = (volatile LAS unsigned*)(lds + LDSCTL_OFF + LC_BAR);
    if (hi - lo > 1) bar = xcd_barrier_post((unsigned*)(p.ws + WS_CTL) + CW_BAR, (volatile LAS unsigned*)(lds + LDSCTL_OFF + LC_BAR));
#ifndef PHASE_MASK
#define PHASE_MASK 0x1fff
#endif
#define IN(k) (((PHASE_MASK >> ((k) == PH_FINAL ? 12 : ((k) % PH_PER_LAYER))) & 1) && lo <= (k) && (k) < hi)
#define SEAM(k) do { if (IN(k) && IN((k) + 1)) xcd_barrier(bar); } while (0)

    for (int layer = 0; layer < NLAYER; ++layer) {
        const int g0 = layer * PH_PER_LAYER;
        bf16* Hb = (bf16*)(p.ws + WS_H);
        if (IN(g0 + 0)) { FRESH();
            if (layer == 0) { prep_static_weights(p, lds, gw, NGW, wave, lane); __syncthreads(); norm_phase<0>(p, layer, lds, gw, NGW, tid, lane); }
            else norm_phase<1>(p, layer, lds, gw, NGW, tid, lane);
        }
        SEAM(g0 + 0);
        if (IN(g0 + 1)) { FRESH();
            SchedH S; S.to.init(M / 256, DH / 256, G, (int)blockIdx.x); S.A = (const char*)(p.ws + WS_XN); S.B = (const char*)(p.ws + WS_WIN + layer * WIN_L);
            EpiStoreBf16 E{Hb, DH};
            pg8::gemm_phase(lds, tid, D, D, D, S, E);
        }
        SEAM(g0 + 1);
        if (IN(g0 + 2)) { FRESH();
            gdn_prep(p, layer, gw, NGW, lane);
            shortconv(p, layer, gtid, NGT);
            conformer(p, layer, lds, tid, wave, lane);
            __syncthreads();
            gmlp(p, layer, lds, tid, wave, lane);
        }
        SEAM(g0 + 2);
        if (IN(g0 + 3)) { FRESH(); gdn_scan_seq(p, lds, tid); }
        SEAM(g0 + 3);
        if (IN(g0 + 4)) { FRESH(); gdn_out(p, layer, gw, NGW, lane); }
        SEAM(g0 + 4);
        if (IN(g0 + 5)) { FRESH();
            SchedBranch S; S.to.init(M / 256, 16, G, (int)blockIdx.x); S.YS = (const char*)(p.ws + WS_YS); S.WBR = (const char*)(p.ws + WS_WBR + layer * WBR_L);
            EpiGate E{Hb, DH};
            pg8::gemm_phase(lds, tid, 512, 2048, 512, S, E);
        }
        SEAM(g0 + 5);
        if (IN(g0 + 6)) { FRESH(); sum_gated(p, gtid, NGT); }
        SEAM(g0 + 6);
        if (IN(g0 + 7)) { FRESH();
            SchedOut S; S.to.init(M / 256, 4, G, (int)blockIdx.x); S.A = (const char*)(p.ws + WS_MERGED); S.B = (const char*)(p.ws + WS_WOUT + layer * WOUT_L);
            EpiResF32 E{layer == 0 ? p.in[I_X] : p.out, p.out};
            pg8::gemm_phase(lds, tid, D, D, D, S, E);
            __syncthreads();
            prep_moe_weights(p, layer, lds, gw, NGW, wave, lane);
        }
        SEAM(g0 + 7);
        if (IN(g0 + 8)) { FRESH(); moe_route(p, layer, lds, tid, wave, lane); }
        SEAM(g0 + 8);
        if (IN(g0 + 9)) { FRESH(); moe_dispatch(p, lds, tid, wave, lane); }
        SEAM(g0 + 9);
        if (IN(g0 + 10) || IN(g0 + 11)) { FRESH();
            LAS int* lblk = (LAS int*)(lds + LDSCTL_OFF + LC_TAB);
            const int* blk_e = (const int*)(p.ws + WS_MOETAB + (size_t)NROWS_MAX * 8 + 256 * 64 * 4);
            __syncthreads();
            for (int i = tid; i <= NROWBLK_MAX; i += 512) lblk[i] = blk_e[i];
            __syncthreads();
        }
        if (IN(g0 + 10)) { FRESH();
            LAS int* lblk = (LAS int*)(lds + LDSCTL_OFF + LC_TAB);
            SchedMoe S; S.nunits = lblk[NROWBLK_MAX] * 4; S.G = G; S.c = (int)blockIdx.x; S.blk_e = lblk; S.A = (const char*)(p.ws + WS_XS); S.a_blk = (size_t)256 * D * 2;
            S.W = (const char*)(p.ws + WS_MOEW); S.w_e = WGU_E; S.w_pn = (size_t)256 * D * 2; S.cmul = 128;
            EpiSwiglu E{(bf16*)(p.ws + WS_HB)};
            pg8::gemm_phase(lds, tid, D, D, D, S, E);
        }
        SEAM(g0 + 10);
        if (IN(g0 + 11)) { FRESH();
            LAS int* lblk = (LAS int*)(lds + LDSCTL_OFF + LC_TAB);
            SchedMoe S; S.nunits = lblk[NROWBLK_MAX] * 4; S.G = G; S.c = (int)blockIdx.x; S.blk_e = lblk; S.A = (const char*)(p.ws + WS_HB); S.a_blk = (size_t)256 * DE * 2;
            S.W = (const char*)(p.ws + WS_WD); S.w_e = WD_E; S.w_pn = (size_t)256 * DE * 2; S.cmul = 256;
            EpiScatter E{(bf16*)(p.ws + WS_Y), (const int*)(p.ws + WS_MOETAB), (const float*)(p.ws + WS_MOETAB + (size_t)NROWS_MAX * 4)};
            pg8::gemm_phase(lds, tid, DE, DE, DE, S, E);
        }
        SEAM(g0 + 11);
    }
    if (IN(PH_FINAL)) { FRESH(); norm_phase<2>(p, 0, lds, gw, NGW, tid, lane); }
#undef IN
#undef SEAM
}

extern "C" void kernel_launch(void* const* d_in, const int* in_sizes, int n_in, void* d_out, int out_size, void* d_ws, size_t ws_size, hipStream_t stream) {
    static int grid = 0;
    if (grid == 0) {
        if (n_in != 25 || out_size != M * D || ws_size < WS_END) { fprintf(stderr, "kernel_launch: unexpected shapes / workspace (n_in %d out %d ws %zu, need %zu)\n", n_in, out_size, ws_size, (size_t)WS_END); grid = -1; return; }
        int dev = 0, cus = 0, per_cu = 0;
        if (hipGetDevice(&dev) != hipSuccess || hipDeviceGetAttribute(&cus, hipDeviceAttributeMultiprocessorCount, dev) != hipSuccess) { grid = -1; return; }
        if (hipFuncSetAttribute((const void*)fwd, hipFuncAttributeMaxDynamicSharedMemorySize, LDS_BYTES) != hipSuccess) { fprintf(stderr, "kernel_launch: hipFuncSetAttribute failed\n"); grid = -1; return; }
        if (hipOccupancyMaxActiveBlocksPerMultiprocessor(&per_cu, (const void*)fwd, 512, LDS_BYTES) != hipSuccess || per_cu < 1) { fprintf(stderr, "kernel_launch: occupancy query says %d\n", per_cu); }
        (void)hipGetLastError();
        grid = cus;
    }
    if (grid < 0) return;
    hipMemsetAsync((char*)d_ws + WS_CTL, 0, CTL_BYTES, stream);
    Params p{};
    for (int i = 0; i < 25; ++i) p.in[i] = (const float*)d_in[i];
    p.out = (float*)d_out; p.ws = (unsigned char*)d_ws;
#if N_LAUNCH_MODE == 1
    p.ph_lo = 0; p.ph_hi = PH_TOTAL;
    hipLaunchKernelGGL(fwd, dim3(grid), dim3(512), LDS_BYTES, stream, p);
#else
    for (int k = 0; k < PH_TOTAL; ++k) { p.ph_lo = k; p.ph_hi = k + 1; hipLaunchKernelGGL(fwd, dim3(grid), dim3(512), LDS_BYTES, stream, p); }
#endif
}
```

```cpp
#include <hip/hip_runtime.h>
#include <cstdio>
#include <cstdint>

#ifndef N_LAUNCH_MODE
#define N_LAUNCH_MODE 1
#endif

#define LAS __attribute__((address_space(3)))
typedef unsigned short bf16;
typedef short bf16x8 __attribute__((ext_vector_type(8)));
typedef float f32x4 __attribute__((ext_vector_type(4)));
typedef float f32x2 __attribute__((ext_vector_type(2)));
typedef unsigned u32x4 __attribute__((ext_vector_type(4)));
typedef unsigned u32x2 __attribute__((ext_vector_type(2)));

constexpr int NB = 8, T = 4096, D = 1024, M = NB * T, NLAYER = 2;
constexpr int DIN = 9736, DH = 9728;
constexpr int HQ = 0, HK = 512, HV = 1024, HZ = 1536, HCONF = 2048, HGMLP = 3072, HSC = 4096, HGATE = 5632;
constexpr int NE = 64, DE = 512;
constexpr float EPS = 1e-6f;
constexpr int NROWBLK_MAX = 320, NROWS_MAX = NROWBLK_MAX * 256;

constexpr size_t MiB = 1u << 20;
constexpr size_t WS_CTL = 0, CTL_BYTES = 1 * MiB;
constexpr size_t WS_WIN = 2 * MiB;
constexpr size_t WIN_L = (size_t)DH * D * 2;
constexpr size_t WS_WBR = 40 * MiB;
constexpr size_t WBR_L = (size_t)4 * D * 512 * 2;
constexpr size_t WS_WOUT = 48 * MiB;
constexpr size_t WOUT_L = (size_t)D * D * 2;
constexpr size_t WS_XN = 52 * MiB;
constexpr size_t WS_SMALL = 116 * MiB;
constexpr size_t WS_ROUTE = 117 * MiB;
constexpr size_t WS_MOETAB = 118 * MiB;
constexpr size_t WS_YS = 120 * MiB;
constexpr size_t WS_REC = 248 * MiB;
constexpr size_t WS_MERGED = WS_REC;
constexpr size_t WS_OBUF = WS_XN;
constexpr int REC_W = 0, REC_Q = 16384, REC_ATT = 32768, REC_KT = 40960, REC_U = 57344, REC_G = 73728, REC_BYTES = 73984;
static_assert(WS_REC + (size_t)2048 * REC_BYTES <= 410 * MiB, "chunk records");
constexpr size_t WS_H = 410 * MiB;
constexpr size_t WS_MOEW = 410 * MiB;
constexpr size_t WGU_E = (size_t)1024 * 1024 * 2, WD_E = (size_t)1024 * 512 * 2;
constexpr size_t WS_WD = WS_MOEW + 64 * WGU_E;
constexpr size_t WS_XS = 602 * MiB;
constexpr size_t WS_HB = 762 * MiB;
constexpr size_t WS_Y = 842 * MiB;
constexpr size_t WS_END = 1018 * MiB;
static_assert(WS_H + (size_t)M * DH * 2 <= WS_END && WS_Y + (size_t)2 * M * D * 2 <= WS_END, "ws map");

constexpr int CW_BAR = 4096;
constexpr int STAGE_LDS = 131072, LDSCTL_OFF = 131072, LDS_BYTES = 147456;
constexpr int LC_BAR = 0;
constexpr int LC_MISC = 64;
constexpr int LC_TAB = 1024;

__device__ __forceinline__ float bf_lo(unsigned w) { return __uint_as_float(w << 16); }
__device__ __forceinline__ float bf_hi(unsigned w) { return __uint_as_float(w & 0xffff0000u); }
__device__ __forceinline__ float bf2f(bf16 b) { return __uint_as_float(((unsigned)b) << 16); }
__device__ __forceinline__ unsigned f2bf(float f) { unsigned u = __float_as_uint(f); return (u + 0x7fffu + ((u >> 16) & 1u)) >> 16; }
__device__ __forceinline__ unsigned pk2(float lo, float hi) { return f2bf(lo) | (f2bf(hi) << 16); }
__device__ __forceinline__ void unpack8(const u32x4 v, float (&f)[8]) {
    f[0] = bf_lo(v.x); f[1] = bf_hi(v.x); f[2] = bf_lo(v.y); f[3] = bf_hi(v.y); f[4] = bf_lo(v.z); f[5] = bf_hi(v.z); f[6] = bf_lo(v.w); f[7] = bf_hi(v.w);
}
__device__ __forceinline__ u32x4 pack8(const float (&f)[8]) { u32x4 o; o.x = pk2(f[0], f[1]); o.y = pk2(f[2], f[3]); o.z = pk2(f[4], f[5]); o.w = pk2(f[6], f[7]); return o; }
__device__ __forceinline__ float wave_sum(float v) {
#pragma unroll
    for (int o = 1; o < 64; o <<= 1) v += __shfl_xor(v, o);
    return v;
}
__device__ __forceinline__ float sigmoidf_(float x) { return 1.0f / (1.0f + __expf(-x)); }
__device__ __forceinline__ float siluf_(float x) { return x / (1.0f + __expf(-x)); }
__device__ __forceinline__ float gelu_tanh(float x) { const float u = 0.7978845608028654f * (x + 0.044715f * x * x * x); return x / (1.0f + __expf(-2.0f * u)); }
__device__ __forceinline__ float softplusf_(float x) { return fmaxf(x, 0.f) + log1pf(__expf(-fabsf(x))); }

#define XB_TMO      128
#define XB_XCNT(j)  (256  + 64 * (j))
#define XB_XSUB(j)  (1280 + 64 * (j))
#define XB_XGEN(j)  (2304 + 64 * (j))
#define XB_TOP      3328
#define XB_TOPGEN   3392
#define XCD_BAR_WORDS 3456
#define XB_SPIN_CAP (1u << 18)
__device__ __forceinline__ unsigned xb_ld(unsigned* p)              { return __hip_atomic_load(p, __ATOMIC_RELAXED, __HIP_MEMORY_SCOPE_AGENT); }
__device__ __forceinline__ unsigned xb_add(unsigned* p, unsigned v) { return __hip_atomic_fetch_add(p, v, __ATOMIC_RELAXED, __HIP_MEMORY_SCOPE_AGENT); }
__device__ __forceinline__ unsigned xb_xcc_id() { return (unsigned)__builtin_amdgcn_s_getreg((3 << 11) | 20) & 0xFu; }
#define XB_SPIN(cond, bar) do { unsigned _sp = 0; while (cond) { __builtin_amdgcn_s_sleep(1); \
    if ((++_sp & 255u) == 0u) { if (xb_ld(&(bar)[XB_TMO])) break; if (_sp > XB_SPIN_CAP) { atomicAdd(&(bar)[XB_TMO], 1u); break; } } } } while (0)
struct XcdBarrier { unsigned* bar; unsigned x; volatile LAS unsigned* st; };
__device__ __forceinline__ XcdBarrier xcd_barrier_post(unsigned* bar, volatile LAS unsigned* st) {
    XcdBarrier b; b.bar = bar; b.x = xb_xcc_id(); b.st = st;
    if (threadIdx.x == 0) (void)xb_add(&bar[XB_XCNT(b.x)], 1u);
    return b;
}
__device__ __forceinline__ void xcd_barrier_complete(unsigned* bar, unsigned x, unsigned& nloc, unsigned& nx) {
    const unsigned G = gridDim.x * gridDim.y * gridDim.z;
    unsigned sum, cnt, mine, sp = 0u;
    for (;;) {
        sum = 0u; cnt = 0u; mine = 0u;
#pragma unroll
        for (unsigned j = 0; j < 16; ++j) { const unsigned c = xb_ld(&bar[XB_XCNT(j)]); sum += c; cnt += (c > 0u) ? 1u : 0u; mine = (j == x) ? c : mine; }
        if (sum == G) break;
        __builtin_amdgcn_s_sleep(1);
        if ((++sp & 255u) == 0u) { if (xb_ld(&bar[XB_TMO])) break; if (sp > XB_SPIN_CAP) { atomicAdd(&bar[XB_TMO], 1u); break; } }
    }
    nloc = mine > 0u ? mine : 1u; nx = cnt > 0u ? cnt : 1u;
}
__device__ __forceinline__ void xcd_barrier(const XcdBarrier& b) {
    asm volatile("s_waitcnt vmcnt(0)" ::: "memory");
    __syncthreads();
    if (threadIdx.x == 0) {
        unsigned* bar = b.bar;
        __builtin_amdgcn_s_waitcnt(0);
        unsigned nloc = b.st[0], nx = b.st[1];
        if (nloc == 0u) { xcd_barrier_complete(bar, b.x, nloc, nx); b.st[0] = nloc; b.st[1] = nx; }
        const unsigned old = xb_add(&bar[XB_XSUB(b.x)], 1u);
        const unsigned gen = old / nloc;
        if (old + 1u == (gen + 1u) * nloc) {
            __builtin_amdgcn_fence(__ATOMIC_RELEASE, "agent");
            asm volatile("s_waitcnt vmcnt(0)" ::: "memory");
            const unsigned og = xb_add(&bar[XB_TOP], 1u);
            const unsigned tg = og / nx;
            if (og + 1u == (tg + 1u) * nx) xb_add(&bar[XB_TOPGEN], 1u);
            else XB_SPIN(xb_ld(&bar[XB_TOPGEN]) == tg, bar);
            __builtin_amdgcn_fence(__ATOMIC_ACQUIRE, "agent");
            xb_add(&bar[XB_XGEN(b.x)], 1u);
            asm volatile("s_waitcnt vmcnt(0)" ::: "memory");
        } else {
            XB_SPIN(xb_ld(&bar[XB_XGEN(b.x)]) == gen, bar);
            __builtin_amdgcn_fence(__ATOMIC_ACQUIRE, "agent");
            asm volatile("s_waitcnt vmcnt(0)" ::: "memory");
        }
    }
    __syncthreads();
}

namespace pg8 {
constexpr int BM = 256, BK = 64, HALF = 128, HTB = HALF * BK * 2, STAGE_BYTES = 8 * HTB, NXCD = 8, WGM = 8;
__host__ __device__ __forceinline__ int lds_byte(int r, int c) { const int st = (r >> 4) * 2 + (c >> 5), rr = r & 15, cc = c & 31, ob = rr * 64 + cc * 2; return st * 1024 + (ob ^ (((ob >> 9) & 1) << 5)); }
__host__ __device__ __forceinline__ void stage_rc(int b, int& R, int& C) { const int st = b / 1024, sb = b % 1024, swz = sb ^ (((sb >> 9) & 1) << 5); R = (st >> 1) * 16 + swz / 64; C = (st & 1) * 32 + (swz % 64) / 2; }
__host__ __device__ __forceinline__ int perm32(int rho) { const int n = rho >> 4, i = rho & 15; return 8 * (i >> 2) + 4 * n + (i & 3); }

struct Unit { const char* A; const char* B; int r0, c0; };

struct TileOrder {
    int nM, nN, nwg, G, c;
    __device__ void init(int nM_, int nN_, int G_, int c_) { nM = nM_; nN = nN_; nwg = nM * nN; G = G_; c = c_; }
    __device__ bool next(int i, int& pm, int& pn) const {
        const long L = (long)i * G + c; if (L >= nwg) return false;
        int wgid = (int)L; { const int q = nwg / NXCD, r = nwg % NXCD, xcd = wgid % NXCD, off = wgid / NXCD; wgid = (xcd < r ? xcd * (q + 1) : r * (q + 1) + (xcd - r) * q) + off; }
        const int nig = WGM * nN, gid = wgid / nig, fm = gid * WGM, gsz = (nM - fm) < WGM ? (nM - fm) : WGM;
        pm = fm + ((wgid % nig) % gsz); pn = (wgid % nig) / gsz; return true;
    }
};
__device__ __forceinline__ unsigned cvt_pk_bf16(float lo, float hi) { unsigned r; asm volatile("v_cvt_pk_bf16_f32 %0, %1, %2" : "=v"(r) : "v"(lo), "v"(hi)); return r; }

template <class Epi, class Sched>
__device__ __forceinline__ void gemm_phase(LAS unsigned char* lds, const int tid, const int K, const int lda, const int ldb, const Sched& S, const Epi& E) {
    const int wid = __builtin_amdgcn_readfirstlane(tid >> 6), lane = tid & 63, wr = wid >> 2, wc = wid & 3, fr = lane & 15, fq = lane >> 4;
    const int nt = K / BK;
    unsigned voffA[2], voffB[2];
#pragma unroll
    for (int i = 0; i < 2; ++i) { int R, C; stage_rc(tid * 16 + i * 8192, R, C); const int Rb = Epi::PERM ? ((R & ~31) + perm32(R & 31)) : R;
        voffA[i] = (unsigned)(R * lda + C) * 2u; voffB[i] = (unsigned)(Rb * ldb + C) * 2u; }
    const size_t kstep = (size_t)(BK * 2);
    const size_t hstepA = (size_t)HALF * lda * 2, hstepB = (size_t)HALF * ldb * 2;
    const unsigned ldsw = (unsigned)wid * 1024u;
    const int aoff = lds_byte(wr * 64 + fr, fq * 8), boff = lds_byte(wc * 32 + fr, fq * 8);
#define PG8_SA(b, h) (((b) * 2 + (h)) * HTB)
#define PG8_SB(b, h) ((4 + (b) * 2 + (h)) * HTB)
#define PG8_STAGE(bufoff, gbase, voff) do { _Pragma("unroll") for (int _i = 0; _i < 2; ++_i) \
        __builtin_amdgcn_global_load_lds((const unsigned*)((const char*)(gbase) + (voff)[_i]), (LAS unsigned*)(lds + (bufoff) + ldsw + _i * 8192), 16, 0, 0); } while (0)
#define PG8_LDA(dst, b, h) do { _Pragma("unroll") for (int m = 0; m < 4; ++m) _Pragma("unroll") for (int k = 0; k < 2; ++k) dst[m][k] = *(const LAS bf16x8*)(lds + PG8_SA(b, h) + aoff + m * 2048 + k * 1024); } while (0)
#define PG8_LDB(dst, b, h) do { _Pragma("unroll") for (int n = 0; n < 2; ++n) _Pragma("unroll") for (int k = 0; k < 2; ++k) dst[n][k] = *(const LAS bf16x8*)(lds + PG8_SB(b, h) + boff + n * 2048 + k * 1024); } while (0)
#define PG8_MMA(ai, bj, At, Bt) do { __builtin_amdgcn_s_setprio(1); _Pragma("unroll") for (int m = 0; m < 4; ++m) _Pragma("unroll") for (int n = 0; n < 2; ++n) _Pragma("unroll") for (int k = 0; k < 2; ++k) \
        acc[ai][bj][m][n] = __builtin_amdgcn_mfma_f32_16x16x32_bf16(Bt[n][k], At[m][k], acc[ai][bj][m][n], 0, 0, 0); __builtin_amdgcn_s_setprio(0); } while (0)
#define PG8_WAIT_V(n) asm volatile("s_waitcnt vmcnt(" #n ")" ::: "memory")
#define PG8_WAIT_L(n) asm volatile("s_waitcnt lgkmcnt(" #n ")" ::: "memory")
#define PG8_BAR __builtin_amdgcn_s_barrier()
#define PG8_SCHED __builtin_amdgcn_sched_barrier(0)
    Unit cur, nxt; int ui = 0;
    if (!S.next(0, cur)) return;
    f32x4 acc[2][2][4][2];
#pragma unroll
    for (int a = 0; a < 2; ++a)
#pragma unroll
        for (int b = 0; b < 2; ++b)
#pragma unroll
            for (int m = 0; m < 4; ++m)
#pragma unroll
                for (int n = 0; n < 2; ++n) acc[a][b][m][n] = (f32x4){0.f, 0.f, 0.f, 0.f};
    bf16x8 At[4][2], B0[2][2], B1[2][2];
    const char* cA = cur.A; const char* cB = cur.B;
    PG8_STAGE(PG8_SB(0, 0), cB, voffB); PG8_STAGE(PG8_SB(0, 1), cB + hstepB, voffB); PG8_STAGE(PG8_SA(0, 0), cA, voffA); PG8_STAGE(PG8_SA(0, 1), cA + hstepA, voffA);
    if (wr == 1) PG8_BAR;
    PG8_WAIT_V(2); PG8_BAR;
    PG8_STAGE(PG8_SB(1, 0), cB + kstep, voffB); PG8_STAGE(PG8_SA(1, 0), cA + kstep, voffA); PG8_STAGE(PG8_SB(1, 1), cB + hstepB + kstep, voffB);
    PG8_WAIT_V(6); PG8_BAR;
    for (;;) {
        const bool has_next = S.next(ui + 1, nxt);
        const char* nA = has_next ? nxt.A : cA; const char* nB = has_next ? nxt.B : cB;
        for (int t = 0; t < nt; t += 2) {
            const bool last = (t == nt - 2);
            const char* a1 = cA + (size_t)(t + 1) * kstep;
            const char* a2 = last ? nA : cA + (size_t)(t + 2) * kstep; const char* b2 = last ? nB : cB + (size_t)(t + 2) * kstep;
            const char* a3 = a2 + kstep; const char* b3 = b2 + kstep;
            PG8_LDB(B0, 0, 0); PG8_LDB(B1, 0, 1); PG8_SCHED; PG8_LDA(At, 0, 0); PG8_STAGE(PG8_SA(1, 1), a1 + hstepA, voffA);
            PG8_WAIT_V(8); PG8_WAIT_L(0); PG8_BAR; PG8_MMA(0, 0, At, B0); PG8_MMA(0, 1, At, B1); PG8_BAR; PG8_SCHED;
            PG8_LDA(At, 0, 1); PG8_STAGE(PG8_SB(0, 0), b2, voffB); PG8_STAGE(PG8_SB(0, 1), b2 + hstepB, voffB); PG8_STAGE(PG8_SA(0, 0), a2, voffA);
            PG8_WAIT_V(8); PG8_WAIT_L(0); PG8_BAR; PG8_MMA(1, 0, At, B0); PG8_MMA(1, 1, At, B1); PG8_BAR; PG8_SCHED;
            PG8_LDB(B0, 1, 0); PG8_LDB(B1, 1, 1); PG8_SCHED; PG8_LDA(At, 1, 0); PG8_STAGE(PG8_SA(0, 1), a2 + hstepA, voffA);
            PG8_WAIT_V(8); PG8_WAIT_L(0); PG8_BAR; PG8_MMA(0, 0, At, B0); PG8_MMA(0, 1, At, B1); PG8_BAR; PG8_SCHED;
            PG8_LDA(At, 1, 1); PG8_STAGE(PG8_SB(1, 0), b3, voffB); PG8_STAGE(PG8_SB(1, 1), b3 + hstepB, voffB); PG8_STAGE(PG8_SA(1, 0), a3, voffA);
            PG8_WAIT_V(8); PG8_WAIT_L(0); PG8_BAR; PG8_MMA(1, 0, At, B0); PG8_MMA(1, 1, At, B1); PG8_BAR; PG8_SCHED;
        }
        if (wr == 0) PG8_BAR;
        E(acc, cur, wr, wc, fr, fq);
        if (!has_next) break;
#pragma unroll
        for (int a = 0; a < 2; ++a)
#pragma unroll
            for (int b = 0; b < 2; ++b)
#pragma unroll
                for (int m = 0; m < 4; ++m)
#pragma unroll
                    for (int n = 0; n < 2; ++n) acc[a][b][m][n] = (f32x4){0.f, 0.f, 0.f, 0.f};
        cur = nxt; cA = nA; cB = nB; ++ui;
        if (wr == 1) PG8_BAR;
    }
    PG8_WAIT_V(0);
    PG8_BAR;
#undef PG8_SA
#undef PG8_SB
#undef PG8_STAGE
#undef PG8_LDA
#undef PG8_LDB
#undef PG8_MMA
#undef PG8_WAIT_V
#undef PG8_WAIT_L
#undef PG8_BAR
#undef PG8_SCHED
}
}
using pg8::Unit;
using pg8::cvt_pk_bf16;

struct EpiStoreBf16 {
    static constexpr bool PERM = true;
    bf16* O; int ldc;
    __device__ __forceinline__ void operator()(const f32x4 (&acc)[2][2][4][2], const Unit& u, int wr, int wc, int fr, int fq) const {
        const int row0 = u.r0 + wr * 64 + fr, col0 = u.c0 + wc * 32 + 8 * fq;
#pragma unroll
        for (int ai = 0; ai < 2; ++ai)
#pragma unroll
            for (int m = 0; m < 4; ++m) { bf16* rowp = O + (size_t)(row0 + ai * 128 + m * 16) * ldc + col0;
#pragma unroll
                for (int bj = 0; bj < 2; ++bj) { const f32x4 v0 = acc[ai][bj][m][0], v1 = acc[ai][bj][m][1];
                    u32x4 w; w.x = cvt_pk_bf16(v0[0], v0[1]); w.y = cvt_pk_bf16(v0[2], v0[3]); w.z = cvt_pk_bf16(v1[0], v1[1]); w.w = cvt_pk_bf16(v1[2], v1[3]);
                    *(u32x4*)(rowp + bj * 128) = w; } }
    }
};
struct EpiGate {
    static constexpr bool PERM = true;
    bf16* G; int ldc;
    __device__ __forceinline__ void operator()(const f32x4 (&acc)[2][2][4][2], const Unit& u, int wr, int wc, int fr, int fq) const {
        const int row0 = u.r0 + wr * 64 + fr, col0 = u.c0 + wc * 32 + 8 * fq;
#pragma unroll
        for (int ai = 0; ai < 2; ++ai)
#pragma unroll
            for (int m = 0; m < 4; ++m) { bf16* rowp = G + (size_t)(row0 + ai * 128 + m * 16) * ldc + col0;
#pragma unroll
                for (int bj = 0; bj < 2; ++bj) { const f32x4 v0 = acc[ai][bj][m][0], v1 = acc[ai][bj][m][1];
                    const u32x4 gw = *(const u32x4*)(rowp + bj * 128); float g[8]; unpack8(gw, g);
                    u32x4 w; w.x = cvt_pk_bf16(sigmoidf_(g[0]) * v0[0], sigmoidf_(g[1]) * v0[1]); w.y = cvt_pk_bf16(sigmoidf_(g[2]) * v0[2], sigmoidf_(g[3]) * v0[3]);
                    w.z = cvt_pk_bf16(sigmoidf_(g[4]) * v1[0], sigmoidf_(g[5]) * v1[1]); w.w = cvt_pk_bf16(sigmoidf_(g[6]) * v1[2], sigmoidf_(g[7]) * v1[3]);
                    *(u32x4*)(rowp + bj * 128) = w; } }
    }
};
struct EpiResF32 {
    static constexpr bool PERM = false;
    const float* res; float* out;
    __device__ __forceinline__ void operator()(const f32x4 (&acc)[2][2][4][2], const Unit& u, int wr, int wc, int fr, int fq) const {
        const int row0 = u.r0 + wr * 64 + fr, col0 = u.c0 + wc * 32 + 4 * fq;
#pragma unroll
        for (int ai = 0; ai < 2; ++ai)
#pragma unroll
            for (int m = 0; m < 4; ++m) { const size_t ro = (size_t)(row0 + ai * 128 + m * 16) * D + col0;
#pragma unroll
                for (int bj = 0; bj < 2; ++bj)
#pragma unroll
                    for (int n = 0; n < 2; ++n) { const f32x4 r = *(const f32x4*)(res + ro + bj * 128 + n * 16); *(f32x4*)(out + ro + bj * 128 + n * 16) = r + acc[ai][bj][m][n]; } }
    }
};
struct EpiSwiglu {
    static constexpr bool PERM = true;
    bf16* O;
    __device__ __forceinline__ void operator()(const f32x4 (&acc)[2][2][4][2], const Unit& u, int wr, int wc, int fr, int fq) const {
        const int row0 = u.r0 + wr * 64 + fr, col0 = u.c0 + wc * 32 + 8 * fq;
#pragma unroll
        for (int ai = 0; ai < 2; ++ai)
#pragma unroll
            for (int m = 0; m < 4; ++m) { bf16* rowp = O + (size_t)(row0 + ai * 128 + m * 16) * DE + col0;
                const f32x4 g0 = acc[ai][0][m][0], g1 = acc[ai][0][m][1], u0 = acc[ai][1][m][0], u1 = acc[ai][1][m][1];
                u32x4 w; w.x = cvt_pk_bf16(siluf_(g0[0]) * u0[0], siluf_(g0[1]) * u0[1]); w.y = cvt_pk_bf16(siluf_(g0[2]) * u0[2], siluf_(g0[3]) * u0[3]);
                w.z = cvt_pk_bf16(siluf_(g1[0]) * u1[0], siluf_(g1[1]) * u1[1]); w.w = cvt_pk_bf16(siluf_(g1[2]) * u1[2], siluf_(g1[3]) * u1[3]);
                *(u32x4*)rowp = w; }
    }
};
struct EpiScatter {
    static constexpr bool PERM = true;
    bf16* Y; const int* row_code; const float* row_w;
    __device__ __forceinline__ void operator()(const f32x4 (&acc)[2][2][4][2], const Unit& u, int wr, int wc, int fr, int fq) const {
        const int row0 = u.r0 + wr * 64 + fr, col0 = u.c0 + wc * 32 + 8 * fq;
#pragma unroll
        for (int ai = 0; ai < 2; ++ai)
#pragma unroll
            for (int m = 0; m < 4; ++m) { const int row = row0 + ai * 128 + m * 16; const int code = row_code[row]; const float rw = row_w[row];
                if (code >= 0) { bf16* rowp = Y + (size_t)(code & 1) * ((size_t)M * D) + (size_t)(code >> 1) * D + col0;
#pragma unroll
                    for (int bj = 0; bj < 2; ++bj) { const f32x4 v0 = acc[ai][bj][m][0] * rw, v1 = acc[ai][bj][m][1] * rw;
                        u32x4 w; w.x = cvt_pk_bf16(v0[0], v0[1]); w.y = cvt_pk_bf16(v0[2], v0[3]); w.z = cvt_pk_bf16(v1[0], v1[1]); w.w = cvt_pk_bf16(v1[2], v1[3]);
                        *(u32x4*)(rowp + bj * 128) = w; } } }
    }
};

struct SchedH {
    pg8::TileOrder to; const char* A; const char* B;
    __device__ __forceinline__ bool next(int i, Unit& u) const { int pm, pn; if (!to.next(i, pm, pn)) return false;
        u.A = A + (size_t)pm * 256 * D * 2; u.B = B + (size_t)pn * 256 * D * 2; u.r0 = pm * 256; u.c0 = pn * 256; return true; }
};
struct SchedBranch {
    pg8::TileOrder to; const char* YS; const char* WBR;
    __device__ __forceinline__ bool next(int i, Unit& u) const { int pm, pn; if (!to.next(i, pm, pn)) return false; const int br = pn >> 2, q = pn & 3;
        u.A = YS + ((size_t)pm * 256 * 2048 + br * 512) * 2; u.B = WBR + ((size_t)br * D * 512 + (size_t)q * 256 * 512) * 2; u.r0 = pm * 256; u.c0 = HGATE + br * 1024 + q * 256; return true; }
};
struct SchedOut {
    pg8::TileOrder to; const char* A; const char* B;
    __device__ __forceinline__ bool next(int i, Unit& u) const { int pm, pn; if (!to.next(i, pm, pn)) return false;
        u.A = A + (size_t)pm * 256 * D * 2; u.B = B + (size_t)pn * 256 * D * 2; u.r0 = pm * 256; u.c0 = pn * 256; return true; }
};
struct SchedMoe {
    int nunits, G, c; const LAS int* blk_e; const char* A; size_t a_blk; const char* W; size_t w_e, w_pn; int cmul;
    __device__ __forceinline__ bool next(int i, Unit& u) const { const long L = (long)i * G + c; if (L >= nunits) return false; const int rb = (int)(L >> 2), pn = (int)(L & 3); const int e = blk_e[rb];
        u.A = A + (size_t)rb * a_blk; u.B = W + (size_t)e * w_e + (size_t)pn * w_pn; u.r0 = rb * 256; u.c0 = pn * cmul; return true; }
};

struct Params { const float* in[25]; float* out; unsigned char* ws; int ph_lo, ph_hi; };
enum { I_X = 0, I_MIXNW, I_WIN, I_GCONV, I_GALOG, I_GDT, I_GNW, I_CCW, I_CCB, I_CLNW, I_CLNB, I_GLNW, I_GLNB, I_GWS, I_GBS, I_SCW, I_WBR, I_WOUT, I_MOENW, I_RGRP, I_REXP, I_WG, I_WU, I_WD, I_FNW };
constexpr int PH_PER_LAYER = 12, PH_FINAL = 24, PH_TOTAL = 25;

__device__ __forceinline__ void transpose_item(const float* __restrict__ W, int ldw, int srccol, bf16* __restrict__ WT, int ldt, int k0, int n0, LAS float* scr, int lane) {
#pragma unroll 8
    for (int i = 0; i < 32; ++i) { const int kk = 2 * i + (lane >> 5); scr[kk * 33 + (lane & 31)] = W[(size_t)(k0 + kk) * ldw + srccol + (lane & 31)]; }
    asm volatile("s_waitcnt lgkmcnt(0)" ::: "memory");
    const int c = lane & 7;
#pragma unroll
    for (int j = 0; j < 4; ++j) { const int n = (lane >> 3) + 8 * j; const LAS float* s = scr + (8 * c) * 33 + n;
        u32x4 o; o.x = pk2(s[0 * 33], s[1 * 33]); o.y = pk2(s[2 * 33], s[3 * 33]); o.z = pk2(s[4 * 33], s[5 * 33]); o.w = pk2(s[6 * 33], s[7 * 33]);
        *(u32x4*)(WT + (size_t)(n0 + n) * ldt + k0 + 8 * c) = o; }
    asm volatile("s_waitcnt lgkmcnt(0)" ::: "memory");
}
__device__ __forceinline__ void prep_static_weights(const Params& p, LAS unsigned char* lds, int gw, int NGW, int wave, int lane) {
    LAS float* scr = (LAS float*)(lds + wave * 16384);
    constexpr int I_IN = 16 * (DH / 32), I_BR = 8 * 32, I_OUT = 16 * 32, PER_L = I_IN + 4 * I_BR + I_OUT;
    for (int it = gw; it < NLAYER * PER_L; it += NGW) {
        const int l = it / PER_L; int r = it % PER_L;
        if (r < I_IN) { const int kb = r / (DH / 32), nb = r % (DH / 32), n0 = nb * 32;
            transpose_item(p.in[I_WIN] + (size_t)l * D * DIN, DIN, n0 + (n0 >= 2048 ? 8 : 0), (bf16*)(p.ws + WS_WIN + l * WIN_L), D, kb * 64, n0, scr, lane); continue; }
        r -= I_IN;
        if (r < 4 * I_BR) { const int br = r / I_BR, q = r % I_BR, kb = q / 32, nb = q % 32;
            transpose_item(p.in[I_WBR] + ((size_t)l * 4 + br) * 512 * D, D, nb * 32, (bf16*)(p.ws + WS_WBR + l * WBR_L) + (size_t)br * D * 512, 512, kb * 64, nb * 32, scr, lane); continue; }
        r -= 4 * I_BR;
        { const int kb = r / 32, nb = r % 32;
            transpose_item(p.in[I_WOUT] + (size_t)l * D * D, D, nb * 32, (bf16*)(p.ws + WS_WOUT + l * WOUT_L), D, kb * 64, nb * 32, scr, lane); }
    }
}
__device__ __forceinline__ void prep_moe_weights(const Params& p, int layer, LAS unsigned char* lds, int gw, int NGW, int wave, int lane) {
    LAS float* scr = (LAS float*)(lds + wave * 16384);
    constexpr int I_GU = 16 * 32, I_D = 8 * 32, PER_E = I_GU + I_D;
    for (int it = gw; it < NE * PER_E; it += NGW) {
        const int e = it / PER_E; int r = it % PER_E;
        if (r < I_GU) { const int kb = r / 32, nb = r % 32, n0 = nb * 32, pn = n0 >> 8, half = (n0 >> 7) & 1, j0 = n0 & 127;
            const float* src = p.in[half ? I_WU : I_WG] + ((size_t)layer * NE + e) * D * DE;
            transpose_item(src, DE, 128 * pn + j0, (bf16*)(p.ws + WS_MOEW + e * WGU_E), D, kb * 64, n0, scr, lane); continue; }
        r -= I_GU;
        { const int kb = r / 32, nb = r % 32;
            transpose_item(p.in[I_WD] + ((size_t)layer * NE + e) * DE * D, D, nb * 32, (bf16*)(p.ws + WS_WD + e * WD_E), DE, kb * 64, nb * 32, scr, lane); }
    }
}

template <int MODE>
__device__ __forceinline__ void norm_phase(const Params& p, int layer, LAS unsigned char* lds, int gw, int NGW, int tid, int lane) {
    LAS float* wsm = (LAS float*)lds;
    if (MODE != 2) {
        const float* wi = p.in[I_WIN] + (size_t)layer * D * DIN;
        for (int i = tid; i < 8192; i += 512) wsm[i] = wi[(size_t)(i >> 3) * DIN + 2048 + (i & 7)];
    }
    __syncthreads();
    const float* nwp = (MODE == 2) ? p.in[I_FNW] : p.in[I_MIXNW] + layer * D;
    f32x4 nw[4];
#pragma unroll
    for (int j = 0; j < 4; ++j) nw[j] = *(const f32x4*)(nwp + 4 * lane + 256 * j);
    const bf16* Y0 = (const bf16*)(p.ws + WS_Y); const bf16* Y1 = Y0 + (size_t)M * D;
    bf16* XN = (bf16*)(p.ws + WS_XN); float* SMALL = (float*)(p.ws + WS_SMALL);
    for (int m = gw; m < M; m += NGW) {
        const float* xr = (MODE == 0 ? p.in[I_X] : p.out) + (size_t)m * D;
        f32x4 v[4]; float ss = 0.f;
#pragma unroll
        for (int j = 0; j < 4; ++j) { v[j] = *(const f32x4*)(xr + 4 * lane + 256 * j);
            if (MODE != 0) { const u32x2 a = *(const u32x2*)(Y0 + (size_t)m * D + 4 * lane + 256 * j), b = *(const u32x2*)(Y1 + (size_t)m * D + 4 * lane + 256 * j);
                v[j][0] += bf_lo(a.x) + bf_lo(b.x); v[j][1] += bf_hi(a.x) + bf_hi(b.x); v[j][2] += bf_lo(a.y) + bf_lo(b.y); v[j][3] += bf_hi(a.y) + bf_hi(b.y); }
            ss += (v[j][0] * v[j][0] + v[j][1] * v[j][1]) + (v[j][2] * v[j][2] + v[j][3] * v[j][3]); }
        const float rs = 1.0f / sqrtf(wave_sum(ss) * (1.0f / D) + EPS);
        if (MODE == 2) {
#pragma unroll
            for (int j = 0; j < 4; ++j) *(f32x4*)(p.out + (size_t)m * D + 4 * lane + 256 * j) = v[j] * rs * nw[j];
            continue;
        }
        if (MODE == 1) {
#pragma unroll
            for (int j = 0; j < 4; ++j) *(f32x4*)(p.out + (size_t)m * D + 4 * lane + 256 * j) = v[j];
        }
        float sm[8];
#pragma unroll
        for (int q = 0; q < 8; ++q) sm[q] = 0.f;
#pragma unroll
        for (int j = 0; j < 4; ++j) { v[j] = v[j] * rs * nw[j];
            u32x2 o; o.x = pk2(v[j][0], v[j][1]); o.y = pk2(v[j][2], v[j][3]); *(u32x2*)(XN + (size_t)m * D + 4 * lane + 256 * j) = o;
#pragma unroll
            for (int c = 0; c < 4; ++c) { const LAS float* wrow = wsm + (4 * lane + 256 * j + c) * 8; const f32x4 w0 = *(const LAS f32x4*)wrow, w1 = *(const LAS f32x4*)(wrow + 4);
                sm[0] += v[j][c] * w0[0]; sm[1] += v[j][c] * w0[1]; sm[2] += v[j][c] * w0[2]; sm[3] += v[j][c] * w0[3];
                sm[4] += v[j][c] * w1[0]; sm[5] += v[j][c] * w1[1]; sm[6] += v[j][c] * w1[2]; sm[7] += v[j][c] * w1[3]; } }
        float mine = 0.f;
#pragma unroll
        for (int q = 0; q < 8; ++q) { const float s = wave_sum(sm[q]); mine = (lane == q) ? s : mine; }
        if (lane < 8) SMALL[(size_t)m * 8 + lane] = mine;
    }
    __syncthreads();
}

__device__ __forceinline__ void shortconv(const Params& p, int layer, int gtid, int NGT) {
    const bf16* H = (const bf16*)(p.ws + WS_H); bf16* YS = (bf16*)(p.ws + WS_YS);
    const float* cw = p.in[I_SCW] + (size_t)layer * 3 * 512;
    for (int it = gtid; it < M * 64; it += NGT) {
        const int m = it >> 6, c8 = (it & 63) * 8, t = m & (T - 1);
        float acc[8];
#pragma unroll
        for (int i = 0; i < 8; ++i) acc[i] = 0.f;
#pragma unroll
        for (int j = 0; j < 3; ++j) { if (t - 2 + j >= 0) { const bf16* r = H + (size_t)(m - 2 + j) * DH + HSC + c8;
                float cg[8], xv[8]; unpack8(*(const u32x4*)(r + 512), cg); unpack8(*(const u32x4*)(r + 1024), xv);
#pragma unroll
                for (int i = 0; i < 8; ++i) acc[i] += cw[j * 512 + c8 + i] * (cg[i] * xv[i]); } }
        float bg[8]; unpack8(*(const u32x4*)(H + (size_t)m * DH + HSC + c8), bg);
#pragma unroll
        for (int i = 0; i < 8; ++i) acc[i] *= bg[i];
        *(u32x4*)(YS + (size_t)m * 2048 + 1536 + c8) = pack8(acc);
    }
}
__device__ __forceinline__ void conformer(const Params& p, int layer, LAS unsigned char* lds, int tid, int wave, int lane, int vb, int nvb) {
    const bf16* H = (const bf16*)(p.ws + WS_H); bf16* YS = (bf16*)(p.ws + WS_YS);
    LAS bf16* yt = (LAS bf16*)lds;
    LAS float* zt = (LAS float*)(lds + 98304);
    const float* cwp = p.in[I_CCW] + (size_t)layer * 31 * 512;
    float cw[31];
#pragma unroll
    for (int j = 0; j < 31; ++j) cw[j] = cwp[j * 512 + tid];
    const float cb = p.in[I_CCB][layer * 512 + tid];
    float lw[8], lb[8];
#pragma unroll
    for (int i = 0; i < 8; ++i) { lw[i] = p.in[I_CLNW][layer * 512 + lane * 8 + i]; lb[i] = p.in[I_CLNB][layer * 512 + lane * 8 + i]; }
    for (int unit = vb; unit < M / 64; unit += nvb) {
        const int m0 = unit * 64, t0 = m0 & (T - 1);
        for (int it = tid; it < 94 * 64; it += 512) { const int r = it >> 6, c8 = (it & 63) * 8; const int dt = r - 30;
            u32x4 o = (u32x4){0u, 0u, 0u, 0u};
            if (t0 + dt >= 0) { const bf16* src = H + (size_t)(m0 + dt) * DH + HCONF + c8; float a[8], g[8]; unpack8(*(const u32x4*)src, a); unpack8(*(const u32x4*)(src + 512), g);
#pragma unroll
                for (int i = 0; i < 8; ++i) a[i] *= sigmoidf_(g[i]);
                o = pack8(a); }
            *(LAS u32x4*)(yt + r * 512 + c8) = o; }
        __syncthreads();
        for (int sb = 0; sb < 8; ++sb) {
            float z[8];
#pragma unroll
            for (int i = 0; i < 8; ++i) z[i] = cb;
#pragma unroll
            for (int r = 0; r < 38; ++r) { const float yv = bf2f(yt[(sb * 8 + r) * 512 + tid]);
#pragma unroll
                for (int i = 0; i < 8; ++i) { const int j = r - i; if (j >= 0 && j < 31) z[i] += cw[j] * yv; } }
#pragma unroll
            for (int i = 0; i < 8; ++i) zt[i * 512 + tid] = z[i];
            __syncthreads();
            { const LAS float* zr = zt + wave * 512 + lane * 8; float v[8]; const f32x4 a = *(const LAS f32x4*)zr, b = *(const LAS f32x4*)(zr + 4);
                v[0] = a[0]; v[1] = a[1]; v[2] = a[2]; v[3] = a[3]; v[4] = b[0]; v[5] = b[1]; v[6] = b[2]; v[7] = b[3];
                float s = 0.f;
#pragma unroll
                for (int i = 0; i < 8; ++i) s += v[i];
                const float mean = wave_sum(s) * (1.0f / 512.0f); float q = 0.f;
#pragma unroll
                for (int i = 0; i < 8; ++i) { v[i] -= mean; q += v[i] * v[i]; }
                const float rstd = 1.0f / sqrtf(wave_sum(q) * (1.0f / 512.0f) + EPS);
#pragma unroll
                for (int i = 0; i < 8; ++i) v[i] = siluf_(v[i] * rstd * lw[i] + lb[i]);
                *(u32x4*)(YS + (size_t)(m0 + sb * 8 + wave) * 2048 + 512 + lane * 8) = pack8(v); }
            __syncthreads();
        }
    }
}
__device__ __forceinline__ void gmlp(const Params& p, int layer, LAS unsigned char* lds, int tid, int wave, int lane, int vb, int nvb) {
    const bf16* H = (const bf16*)(p.ws + WS_H); bf16* YS = (bf16*)(p.ws + WS_YS);
    LAS float* Vg = (LAS float*)lds;
    LAS float* Wg = (LAS float*)(lds + 65536);
    LAS float* st = (LAS float*)(lds + LDSCTL_OFF + LC_TAB);
    const float* lnw = p.in[I_GLNW] + layer * 512; const float* lnb = p.in[I_GLNB] + layer * 512;
    for (int unit = vb; unit < M / 128; unit += nvb) {
        const int m0 = unit * 128;
        for (int tk = wave * 16; tk < wave * 16 + 16; ++tk) {
            float v[8]; unpack8(*(const u32x4*)(H + (size_t)(m0 + tk) * DH + HGMLP + 512 + lane * 8), v);
            float s = 0.f;
#pragma unroll
            for (int i = 0; i < 8; ++i) { v[i] = gelu_tanh(v[i]); s += v[i]; }
            const float mean = wave_sum(s) * (1.0f / 512.0f); float q = 0.f;
#pragma unroll
            for (int i = 0; i < 8; ++i) { const float d = v[i] - mean; q += d * d; }
            const float rstd = 1.0f / sqrtf(wave_sum(q) * (1.0f / 512.0f) + EPS);
            if (lane == 0) { st[tk * 2] = mean; st[tk * 2 + 1] = rstd; }
        }
        __syncthreads();
        for (int g = 0; g < 4; ++g) {
            for (int it = tid; it < 128 * 16; it += 512) { const int tk = it >> 4, c8 = (it & 15) * 8;
                float v[8]; unpack8(*(const u32x4*)(H + (size_t)(m0 + tk) * DH + HGMLP + 512 + g * 128 + c8), v);
                const float mean = st[tk * 2], rstd = st[tk * 2 + 1];
#pragma unroll
                for (int i = 0; i < 8; ++i) Vg[tk * 128 + c8 + i] = (gelu_tanh(v[i]) - mean) * rstd * lnw[g * 128 + c8 + i] + lnb[g * 128 + c8 + i]; }
            const float* ws = p.in[I_GWS] + ((size_t)layer * 4 + g) * 128 * 128;
            for (int it = tid; it < 128 * 128; it += 512) { const int i = it >> 7, j = it & 127; Wg[it] = (j <= i) ? ws[it] : 0.f; }
            __syncthreads();
            const int c = tid & 127, i0 = tid >> 7;
            for (int r = 0; r < 32; ++r) { const int i = i0 + 4 * r; float a = 0.f;
                for (int j = 0; j <= i; ++j) a += Wg[i * 128 + j] * Vg[j * 128 + c];
                a += p.in[I_GBS][((size_t)layer * 4 + g) * 128 + i];
                const float u = gelu_tanh(bf2f(H[(size_t)(m0 + i) * DH + HGMLP + g * 128 + c]));
                YS[(size_t)(m0 + i) * 2048 + 1024 + g * 128 + c] = (bf16)f2bf(u * a); }
            __syncthreads();
        }
    }
}
__device__ __forceinline__ f32x4 mfma16(bf16x8 a, bf16x8 b, f32x4 c) { return __builtin_amdgcn_mfma_f32_16x16x32_bf16(a, b, c, 0, 0, 0); }
typedef short bf16x4 __attribute__((ext_vector_type(4)));
__device__ __forceinline__ bf16x8 ld_frag16(const LAS unsigned char* p) { return *(const LAS bf16x8*)p; }
__device__ __forceinline__ bf16x8 ld_frag8x2(const LAS unsigned char* p) { const bf16x4 a = *(const LAS bf16x4*)p, b = *(const LAS bf16x4*)(p + 32); return __builtin_shufflevector(a, b, 0, 1, 2, 3, 4, 5, 6, 7); }
__device__ __forceinline__ bf16x8 pack_frag(const f32x4 lo, const f32x4 hi) { u32x4 w; w.x = cvt_pk_bf16(lo[0], lo[1]); w.y = cvt_pk_bf16(lo[2], lo[3]); w.z = cvt_pk_bf16(hi[0], hi[1]); w.w = cvt_pk_bf16(hi[2], hi[3]); return __builtin_bit_cast(bf16x8, w); }
constexpr int CP_QN = 0, CP_KN = 17408, CP_KT = 34816, CP_VT = 53248, CP_KGT = 71680, CP_A32 = 90112, CP_ATT = 106496, CP_T16 = 115712, CP_TAB = 124928;
__device__ __forceinline__ void gdn_chunk_prep(const Params& p, int layer, LAS unsigned char* lds, int tid, int wave, int lane) {
    const bf16* H = (const bf16*)(p.ws + WS_H); const float* SMALL = (const float*)(p.ws + WS_SMALL);
    const float* cw = p.in[I_GCONV] + (size_t)layer * 4 * 1536;
    LAS float* tab = (LAS float*)(lds + CP_TAB);
    const int q = lane >> 4, li = lane & 15;
    for (int unit = blockIdx.x; unit < 2048; unit += gridDim.x) {
        const int n = unit & 63, hh = (unit >> 6) & 3, b = unit >> 8; const int m0 = b * T + n * 64;
        unsigned char* rec = p.ws + WS_REC + (size_t)((b * 4 + hh) * 64 + n) * REC_BYTES;
        __syncthreads();
        if (wave == 0) { const int m = m0 + lane; const float br = SMALL[(size_t)m * 8 + hh], ar = SMALL[(size_t)m * 8 + 4 + hh];
            float g = -__expf(p.in[I_GALOG][layer * 4 + hh]) * softplusf_(ar + p.in[I_GDT][layer * 4 + hh]);
#pragma unroll
            for (int o = 1; o < 64; o <<= 1) { const float t = __shfl_up(g, o); if (lane >= o) g += t; }
            tab[lane] = sigmoidf_(br); tab[64 + lane] = g; tab[128 + lane] = __expf(g); }
        __syncthreads();
        for (int i = wave * 8; i < wave * 8 + 8; ++i) {
            const int m = m0 + i, t = n * 64 + i;
            float y[3][2];
#pragma unroll
            for (int s = 0; s < 3; ++s) { const int c = s * 512 + hh * 128 + 2 * lane; float a0 = 0.f, a1 = 0.f;
#pragma unroll
                for (int j = 0; j < 4; ++j) { if (t - 3 + j >= 0) { const unsigned w = *(const unsigned*)(H + (size_t)(m - 3 + j) * DH + c);
                        a0 += cw[j * 1536 + c] * bf_lo(w); a1 += cw[j * 1536 + c + 1] * bf_hi(w); } }
                y[s][0] = siluf_(a0); y[s][1] = siluf_(a1); }
            const float sq = wave_sum(y[0][0] * y[0][0] + y[0][1] * y[0][1]), sk = wave_sum(y[1][0] * y[1][0] + y[1][1] * y[1][1]);
            const float rq = 0.08838834764831845f / sqrtf(sq + EPS), rk = 1.0f / sqrtf(sk + EPS);
            const float be = tab[i], bg = be * tab[128 + i];
            const float k0 = y[1][0] * rk, k1 = y[1][1] * rk;
            *(LAS unsigned*)(lds + CP_QN + i * 272 + 4 * lane) = pk2(y[0][0] * rq, y[0][1] * rq);
            *(LAS unsigned*)(lds + CP_KN + i * 272 + 4 * lane) = pk2(k0, k1);
            *(LAS bf16*)(lds + CP_KT + (2 * lane) * 144 + 2 * i) = (bf16)f2bf(k0); *(LAS bf16*)(lds + CP_KT + (2 * lane + 1) * 144 + 2 * i) = (bf16)f2bf(k1);
            *(LAS bf16*)(lds + CP_VT + (2 * lane) * 144 + 2 * i) = (bf16)f2bf(be * y[2][0]); *(LAS bf16*)(lds + CP_VT + (2 * lane + 1) * 144 + 2 * i) = (bf16)f2bf(be * y[2][1]);
            *(LAS bf16*)(lds + CP_KGT + (2 * lane) * 144 + 2 * i) = (bf16)f2bf(bg * k0); *(LAS bf16*)(lds + CP_KGT + (2 * lane + 1) * 144 + 2 * i) = (bf16)f2bf(bg * k1);
        }
        __syncthreads();
        for (int jb = wave; jb < 32; jb += 8) { const int which = jb >> 4, mt = (jb >> 2) & 3, nt = jb & 3;
            f32x4 acc = (f32x4){0.f, 0.f, 0.f, 0.f};
            if (nt <= mt) {
#pragma unroll
                for (int ks = 0; ks < 4; ++ks) acc = mfma16(ld_frag16(lds + (which ? CP_QN : CP_KN) + (16 * mt + li) * 272 + (32 * ks + 8 * q) * 2), ld_frag16(lds + CP_KN + (16 * nt + li) * 272 + (32 * ks + 8 * q) * 2), acc);
            }
            const int j = 16 * nt + li; const float gj = tab[64 + j];
#pragma unroll
            for (int r = 0; r < 4; ++r) { const int i = 16 * mt + 4 * q + r; const float gi = tab[64 + i];
                if (which == 0) { ((LAS float*)(lds + CP_A32))[i * 64 + j] = (i > j) ? tab[i] * acc[r] * __expf(gi - gj) : 0.f; }
                else { *(LAS bf16*)(lds + CP_ATT + i * 144 + 2 * j) = (bf16)f2bf((i >= j) ? acc[r] * __expf(gi - gj) : 0.f); } }
        }
        __syncthreads();
        if (wave == 0) {
            float Tc[64]; const float lanef = (float)lane;
            const LAS float* A = (const LAS float*)(lds + CP_A32); asm volatile("" : "+v"(A));
            LAS unsigned char* Tw = lds + CP_T16 + 2 * lane; asm volatile("" : "+v"(Tw));
#pragma unroll
            for (int i = 0; i < 64; ++i) { float a = fmaxf(0.f, 1.f - fabsf((float)i - lanef));
#pragma unroll
                for (int j = 0; j < i; j += 4) { const f32x4 av = *(const LAS f32x4*)(A + i * 64 + j);
#pragma unroll
                    for (int jj = 0; jj < 4; ++jj) if (j + jj < i) a -= av[jj] * Tc[j + jj]; }
                Tc[i] = a; *(LAS bf16*)(Tw + i * 144) = (bf16)f2bf(a); }
        } else {
            const int t2 = tid - 64;
            for (int pc = t2; pc < 1024; pc += 448) { const int row = pc >> 4, seg = pc & 15; *(u32x4*)(rec + REC_Q + pc * 16) = *(const LAS u32x4*)(lds + CP_QN + row * 272 + seg * 16); }
            for (int pc = t2; pc < 512; pc += 448) { const int row = pc >> 3, seg = pc & 7; *(u32x4*)(rec + REC_ATT + pc * 16) = *(const LAS u32x4*)(lds + CP_ATT + row * 144 + seg * 16); }
            for (int pc = t2; pc < 1024; pc += 448) { const int row = pc >> 3, seg = pc & 7; *(u32x4*)(rec + REC_KT + pc * 16) = *(const LAS u32x4*)(lds + CP_KT + row * 144 + seg * 16); }
            if (t2 < 16) *(u32x4*)(rec + REC_G + t2 * 16) = *(const LAS u32x4*)(lds + CP_TAB + 256 + t2 * 16);
        }
        __syncthreads();
        for (int jb = wave; jb < 64; jb += 8) {
            f32x4 acc = (f32x4){0.f, 0.f, 0.f, 0.f};
            if (jb < 32) { const int mt = jb >> 3, nt = jb & 7;
#pragma unroll
                for (int ks = 0; ks < 2; ++ks) acc = mfma16(ld_frag16(lds + CP_T16 + (16 * mt + li) * 144 + (32 * ks + 8 * q) * 2), ld_frag16(lds + CP_VT + (16 * nt + li) * 144 + (32 * ks + 8 * q) * 2), acc);
                u32x2 o; o.x = pk2(acc[0], acc[1]); o.y = pk2(acc[2], acc[3]);
                *(u32x2*)(rec + REC_U + (size_t)((nt * 64 + lane) * 4 + mt) * 8) = o;
            } else { const int mt = (jb - 32) >> 2, nt = (jb - 32) & 3;
#pragma unroll
                for (int ks = 0; ks < 2; ++ks) acc = mfma16(ld_frag16(lds + CP_KGT + (16 * mt + li) * 144 + (32 * ks + 8 * q) * 2), ld_frag16(lds + CP_T16 + (16 * nt + li) * 144 + (32 * ks + 8 * q) * 2), acc);
                u32x2 o; o.x = pk2(acc[0], acc[1]); o.y = pk2(acc[2], acc[3]);
                *(u32x2*)(rec + REC_W + (size_t)((16 * nt + li) * 128 + 16 * mt + 4 * q) * 2) = o;
            }
        }
    }
    __syncthreads();
}
constexpr int SC_W = 0, SC_Q = 17408, SC_ATT = 34816, SC_KT = 44032, SC_G = 62464, SC_BUF = 62720;
__device__ __forceinline__ void gdn_chunk_scan(const Params& p, LAS unsigned char* lds, int tid, int wave, int lane, int bh) {
    const int b = bh >> 2, hh = bh & 3, q = lane >> 4, li = lane & 15;
    const unsigned char* rec0 = p.ws + WS_REC + (size_t)(bh * 64) * REC_BYTES;
    float* OB = (float*)(p.ws + WS_OBUF);
    u32x4 pf[7], pfg = (u32x4){0u, 0u, 0u, 0u}, pu[2];
#define SC_LOAD(nn) do { const unsigned char* r_ = rec0 + (size_t)(nn) * REC_BYTES; \
        _Pragma("unroll") for (int k_ = 0; k_ < 7; ++k_) pf[k_] = *(const u32x4*)(r_ + (size_t)(tid + 512 * k_) * 16); \
        if (tid < 16) pfg = *(const u32x4*)(r_ + REC_G + tid * 16); \
        pu[0] = *(const u32x4*)(r_ + REC_U + (size_t)(wave * 64 + lane) * 32); pu[1] = *(const u32x4*)(r_ + REC_U + (size_t)(wave * 64 + lane) * 32 + 16); } while (0)
#define SC_STORE(buf) do { LAS unsigned char* d_ = lds + (buf) * SC_BUF; \
        _Pragma("unroll") for (int k_ = 0; k_ < 4; ++k_) { const int pc_ = tid + 512 * (k_ & 1); *(LAS u32x4*)(d_ + (k_ < 2 ? SC_W : SC_Q) + (pc_ >> 4) * 272 + (pc_ & 15) * 16) = pf[k_]; } \
        { const int pc_ = tid; *(LAS u32x4*)(d_ + SC_ATT + (pc_ >> 3) * 144 + (pc_ & 7) * 16) = pf[4]; } \
        _Pragma("unroll") for (int k_ = 5; k_ < 7; ++k_) { const int pc_ = tid + 512 * (k_ - 5); *(LAS u32x4*)(d_ + SC_KT + (pc_ >> 3) * 144 + (pc_ & 7) * 16) = pf[k_]; } \
        if (tid < 16) *(LAS u32x4*)(d_ + SC_G + tid * 16) = pfg; } while (0)
    f32x4 S[8];
#pragma unroll
    for (int i = 0; i < 8; ++i) S[i] = (f32x4){0.f, 0.f, 0.f, 0.f};
    __syncthreads();
    SC_LOAD(0); SC_STORE(0);
    u32x4 cu[2]; cu[0] = pu[0]; cu[1] = pu[1];
    __syncthreads();
    for (int n = 0; n < 64; ++n) {
        const LAS unsigned char* L = lds + (n & 1) * SC_BUF;
        if (n + 1 < 64) SC_LOAD(n + 1);
        bf16x8 Sb[4];
#pragma unroll
        for (int ks = 0; ks < 4; ++ks) Sb[ks] = pack_frag(S[2 * ks], S[2 * ks + 1]);
        f32x4 a1[4], a2[4];
#pragma unroll
        for (int mt = 0; mt < 4; ++mt) { a1[mt] = (f32x4){0.f, 0.f, 0.f, 0.f}; a2[mt] = (f32x4){0.f, 0.f, 0.f, 0.f};
#pragma unroll
            for (int ks = 0; ks < 4; ++ks) { a1[mt] = mfma16(ld_frag8x2(L + SC_W + (16 * mt + li) * 272 + (32 * ks + 4 * q) * 2), Sb[ks], a1[mt]);
                a2[mt] = mfma16(ld_frag8x2(L + SC_Q + (16 * mt + li) * 272 + (32 * ks + 4 * q) * 2), Sb[ks], a2[mt]); } }
        const float g63 = *(const LAS float*)(L + SC_G + 63 * 4);
        f32x4 vn[4], vd[4], gam[4];
#pragma unroll
        for (int mt = 0; mt < 4; ++mt) { const f32x4 gi = *(const LAS f32x4*)(L + SC_G + (16 * mt + 4 * q) * 4);
            const unsigned ulo = (mt < 2) ? (mt == 0 ? cu[0].x : cu[0].z) : (mt == 2 ? cu[1].x : cu[1].z), uhi = (mt < 2) ? (mt == 0 ? cu[0].y : cu[0].w) : (mt == 2 ? cu[1].y : cu[1].w);
            const f32x4 uu = (f32x4){bf_lo(ulo), bf_hi(ulo), bf_lo(uhi), bf_hi(uhi)};
            vn[mt] = uu - a1[mt];
#pragma unroll
            for (int r = 0; r < 4; ++r) { gam[mt][r] = __expf(gi[r]); vd[mt][r] = vn[mt][r] * __expf(g63 - gi[r]); } }
        bf16x8 Vb[2], Vd[2];
#pragma unroll
        for (int ks = 0; ks < 2; ++ks) { Vb[ks] = pack_frag(vn[2 * ks], vn[2 * ks + 1]); Vd[ks] = pack_frag(vd[2 * ks], vd[2 * ks + 1]); }
#pragma unroll
        for (int mt = 0; mt < 4; ++mt) { f32x4 a3 = (f32x4){0.f, 0.f, 0.f, 0.f};
#pragma unroll
            for (int ks = 0; ks < 2; ++ks) a3 = mfma16(ld_frag8x2(L + SC_ATT + (16 * mt + li) * 144 + (32 * ks + 4 * q) * 2), Vb[ks], a3);
#pragma unroll
            for (int r = 0; r < 4; ++r) OB[(size_t)(b * T + n * 64 + 16 * mt + 4 * q + r) * 512 + hh * 128 + 16 * wave + li] = gam[mt][r] * a2[mt][r] + a3[r]; }
        const float eg = __expf(g63);
#pragma unroll
        for (int mt = 0; mt < 8; ++mt) { f32x4 a4 = (f32x4){0.f, 0.f, 0.f, 0.f};
#pragma unroll
            for (int ks = 0; ks < 2; ++ks) a4 = mfma16(ld_frag8x2(L + SC_KT + (16 * mt + li) * 144 + (32 * ks + 4 * q) * 2), Vd[ks], a4);
            S[mt] = S[mt] * eg + a4; }
        if (n + 1 < 64) { SC_STORE((n + 1) & 1); cu[0] = pu[0]; cu[1] = pu[1]; }
        __syncthreads();
    }
#undef SC_LOAD
#undef SC_STORE
}

__device__ __forceinline__ void gdn_out(const Params& p, int layer, int gw, int NGW, int lane) {
    const bf16* H = (const bf16*)(p.ws + WS_H); bf16* YS = (bf16*)(p.ws + WS_YS); const float* OB = (const float*)(p.ws + WS_OBUF);
    const float w0 = p.in[I_GNW][layer * 128 + 2 * lane], w1 = p.in[I_GNW][layer * 128 + 2 * lane + 1];
    for (int it = gw; it < M * 4; it += NGW) { const int m = it >> 2, hh = it & 3;
        f32x2 o = *(const f32x2*)(OB + (size_t)m * 512 + hh * 128 + 2 * lane);
        const float rs = 1.0f / sqrtf(wave_sum(o[0] * o[0] + o[1] * o[1]) * (1.0f / 128.0f) + EPS);
        const unsigned zw = *(const unsigned*)(H + (size_t)m * DH + HZ + hh * 128 + 2 * lane);
        *(unsigned*)(YS + (size_t)m * 2048 + hh * 128 + 2 * lane) = pk2(o[0] * rs * w0 * siluf_(bf_lo(zw)), o[1] * rs * w1 * siluf_(bf_hi(zw)));
    }
}
__device__ __forceinline__ void sum_gated(const Params& p, int gtid, int NGT) {
    const bf16* H = (const bf16*)(p.ws + WS_H); bf16* MG = (bf16*)(p.ws + WS_MERGED);
    for (int it = gtid; it < M * 128; it += NGT) { const int m = it >> 7, c8 = (it & 127) * 8; const bf16* r = H + (size_t)m * DH + HGATE + c8;
        float a[8], b[8];
        unpack8(*(const u32x4*)r, a);
#pragma unroll
        for (int br = 1; br < 4; ++br) { unpack8(*(const u32x4*)(r + br * 1024), b);
#pragma unroll
            for (int i = 0; i < 8; ++i) a[i] += b[i]; }
        *(u32x4*)(MG + (size_t)m * D + c8) = pack8(a); }
}

__device__ __forceinline__ void moe_route(const Params& p, int layer, LAS unsigned char* lds, int tid, int wave, int lane) {
    LAS float* xs = (LAS float*)lds;
    LAS int* hist = (LAS int*)(lds + LDSCTL_OFF + LC_TAB);
    bf16* XN = (bf16*)(p.ws + WS_XN);
    int* route_e = (int*)(p.ws + WS_ROUTE); float* route_w = (float*)(p.ws + WS_ROUTE + (size_t)M * 2 * 4);
    int* cnt = (int*)(p.ws + WS_MOETAB + (size_t)NROWS_MAX * 8);
    const float* rg = p.in[I_RGRP] + (size_t)layer * D * 8; const float* re = p.in[I_REXP] + (size_t)layer * D * 64;
    f32x4 nw[4];
#pragma unroll
    for (int j = 0; j < 4; ++j) nw[j] = *(const f32x4*)(p.in[I_MOENW] + layer * D + 4 * lane + 256 * j);
    for (int vb = blockIdx.x; vb < M / 128; vb += gridDim.x) {
        if (tid < 64) hist[tid] = 0;
        for (int tile = 0; tile < 4; ++tile) {
            const int m0 = vb * 128 + tile * 32;
            __syncthreads();
            for (int r = wave * 4; r < wave * 4 + 4; ++r) { const int m = m0 + r; const float* xr = p.out + (size_t)m * D;
                f32x4 v[4]; float ss = 0.f;
#pragma unroll
                for (int j = 0; j < 4; ++j) { v[j] = *(const f32x4*)(xr + 4 * lane + 256 * j); ss += (v[j][0] * v[j][0] + v[j][1] * v[j][1]) + (v[j][2] * v[j][2] + v[j][3] * v[j][3]); }
                const float rs = 1.0f / sqrtf(wave_sum(ss) * (1.0f / D) + EPS);
#pragma unroll
                for (int j = 0; j < 4; ++j) { v[j] = v[j] * rs * nw[j]; *(LAS f32x4*)(xs + r * 1024 + 4 * lane + 256 * j) = v[j];
                    u32x2 o; o.x = pk2(v[j][0], v[j][1]); o.y = pk2(v[j][2], v[j][3]); *(u32x2*)(XN + (size_t)m * D + 4 * lane + 256 * j) = o; } }
            __syncthreads();
            float ae[32], ag[32];
#pragma unroll
            for (int r = 0; r < 32; ++r) { ae[r] = 0.f; ag[r] = 0.f; }
            for (int k = wave * 128; k < wave * 128 + 128; k += 4) {
                float we[4], wg[4];
#pragma unroll
                for (int q = 0; q < 4; ++q) { we[q] = re[(size_t)(k + q) * 64 + lane]; wg[q] = rg[(size_t)(k + q) * 8 + (lane & 7)]; }
#pragma unroll
                for (int r = 0; r < 32; ++r) { const f32x4 x = *(const LAS f32x4*)(xs + r * 1024 + k);
                    ae[r] += x[0] * we[0] + x[1] * we[1] + x[2] * we[2] + x[3] * we[3];
                    ag[r] += x[0] * wg[0] + x[1] * wg[1] + x[2] * wg[2] + x[3] * wg[3]; }
            }
            __syncthreads();
            LAS float* part = xs;
#pragma unroll
            for (int r = 0; r < 32; ++r) { part[(wave * 32 + r) * 72 + lane] = ae[r]; if (lane < 8) part[(wave * 32 + r) * 72 + 64 + lane] = ag[r]; }
            __syncthreads();
            for (int r = wave * 4; r < wave * 4 + 4; ++r) { const int m = m0 + r;
                float le = 0.f, lg = 0.f;
#pragma unroll
                for (int w = 0; w < 8; ++w) { le += part[(w * 32 + r) * 72 + lane]; lg += part[(w * 32 + r) * 72 + 64 + (lane & 7)]; }
                float gv[8];
#pragma unroll
                for (int i = 0; i < 8; ++i) gv[i] = __shfl(lg, i);
                int grp = 0; float gmax = gv[0];
#pragma unroll
                for (int i = 1; i < 8; ++i) if (gv[i] > gmax) { gmax = gv[i]; grp = i; }
                float gs = 0.f;
#pragma unroll
                for (int i = 0; i < 8; ++i) gs += __expf(gv[i] - gmax);
                const float psel = 1.0f / gs;
                float ev[8];
#pragma unroll
                for (int i = 0; i < 8; ++i) ev[i] = __shfl(le, grp * 8 + i);
                int i1 = 0; float e1 = ev[0];
#pragma unroll
                for (int i = 1; i < 8; ++i) if (ev[i] > e1) { e1 = ev[i]; i1 = i; }
                int i2 = -1; float e2 = -3.0e38f;
#pragma unroll
                for (int i = 0; i < 8; ++i) if (i != i1 && ev[i] > e2) { e2 = ev[i]; i2 = i; }
                const float x2 = __expf(e2 - e1), w1 = psel / (1.0f + x2), w2 = psel * x2 / (1.0f + x2);
                if (lane == 0) { route_e[(size_t)m * 2] = grp * 8 + i1; route_e[(size_t)m * 2 + 1] = grp * 8 + i2; route_w[(size_t)m * 2] = w1; route_w[(size_t)m * 2 + 1] = w2;
                    atomicAdd((int*)(hist + grp * 8 + i1), 1); atomicAdd((int*)(hist + grp * 8 + i2), 1); }
            }
        }
        __syncthreads();
        if (tid < 64) cnt[vb * 64 + tid] = hist[tid];
        __syncthreads();
    }
}
__device__ __forceinline__ void moe_dispatch(const Params& p, LAS unsigned char* lds, int tid, int wave, int lane) {
    LAS int* tab = (LAS int*)(lds + LDSCTL_OFF + LC_TAB);
    const bf16* XN = (const bf16*)(p.ws + WS_XN); bf16* XS = (bf16*)(p.ws + WS_XS);
    const int* route_e = (const int*)(p.ws + WS_ROUTE); const float* route_w = (const float*)(p.ws + WS_ROUTE + (size_t)M * 2 * 4);
    int* row_code = (int*)(p.ws + WS_MOETAB); float* row_w = (float*)(p.ws + WS_MOETAB + (size_t)NROWS_MAX * 4);
    const int* cnt = (const int*)(p.ws + WS_MOETAB + (size_t)NROWS_MAX * 8); int* blk_e = (int*)(p.ws + WS_MOETAB + (size_t)NROWS_MAX * 8 + 256 * 64 * 4);
    for (int vb = blockIdx.x; vb < M / 128; vb += gridDim.x) {
        __syncthreads();
        if (tid < 64) { int run = 0, base = 0; for (int v = 0; v < M / 128; ++v) { if (v == vb) base = run; run += cnt[v * 64 + tid]; } tab[64 + tid] = run; tab[128 + tid] = base; }
        __syncthreads();
        if (tid == 0) { int s = 0; for (int e = 0; e < 64; ++e) { tab[e] = s; s += (tab[64 + e] + 255) / 256 * 256; } tab[704] = s; }
        if (tid < 256) tab[192 + tid] = route_e[(size_t)vb * 256 + tid];
        __syncthreads();
        if (tid < 256) { const int e = tab[192 + tid]; int rank = 0; for (int a = 0; a < tid; ++a) rank += (tab[192 + a] == e) ? 1 : 0;
            const int pos = tab[e] + tab[128 + e] + rank; tab[448 + tid] = pos;
            row_code[pos] = ((vb * 128 + (tid >> 1)) << 1) | (tid & 1); row_w[pos] = route_w[(size_t)vb * 256 + tid]; }
        if (vb < 64) { const int ps = tab[vb], tot = tab[64 + vb], pe = ps + (tot + 255) / 256 * 256;
            for (int r = ps + tot + tid; r < pe; r += 512) row_code[r] = -1;
            for (int b = ps / 256 + tid; b < pe / 256; b += 512) blk_e[b] = vb;
            if (vb == 63 && tid == 0) blk_e[NROWBLK_MAX] = tab[704] / 256; }
        __syncthreads();
        for (int a = wave; a < 256; a += 8) { const int pos = tab[448 + a]; const int tok = vb * 128 + (a >> 1);
            const u32x4* src = (const u32x4*)(XN + (size_t)tok * D); u32x4* dst = (u32x4*)(XS + (size_t)pos * D);
            dst[lane] = src[lane]; dst[lane + 64] = src[lane + 64]; }
    }
    __syncthreads();
}

__global__ void __launch_bounds__(512, 2) fwd(Params p) {
    extern __shared__ __attribute__((aligned(16))) unsigned char lds_raw[];
    LAS unsigned char* lds = (LAS unsigned char*)lds_raw;
    const int tid0 = threadIdx.x;
    const int G = gridDim.x, NGW = G * 8, NGT = G * 512;
#define FRESH() int tid = tid0; asm volatile("" : "+v"(tid)); const int lane = tid & 63, wave = __builtin_amdgcn_readfirstlane(tid >> 6); const int gw = blockIdx.x * 8 + wave, gtid = blockIdx.x * 512 + tid; (void)lane; (void)gw; (void)gtid
    for (int u = tid0; u < (LDS_BYTES - LDSCTL_OFF) / 4; u += 512) ((LAS unsigned*)(lds + LDSCTL_OFF))[u] = 0u;
    __syncthreads();
    const int lo = p.ph_lo, hi = p.ph_hi;
    XcdBarrier bar; bar.bar = (unsigned*)(p.ws + WS_CTL) + CW_BAR; bar.x = 0; bar.st = (volatile LAS unsigned*)(lds + LDSCTL_OFF + LC_BAR);
    if (hi - lo > 1) bar = xcd_barrier_post((unsigned*)(p.ws + WS_CTL) + CW_BAR, (volatile LAS unsigned*)(lds + LDSCTL_OFF + LC_BAR));
#ifndef PHASE_MASK
#define PHASE_MASK 0x1fff
#endif
#define IN(k) (((PHASE_MASK >> ((k) == PH_FINAL ? 12 : ((k) % PH_PER_LAYER))) & 1) && lo <= (k) && (k) < hi)
#define SEAM(k) do { if (IN(k) && IN((k) + 1)) xcd_barrier(bar); } while (0)

    for (int layer = 0; layer < NLAYER; ++layer) {
        const int g0 = layer * PH_PER_LAYER;
        bf16* Hb = (bf16*)(p.ws + WS_H);
        if (IN(g0 + 0)) { FRESH();
            if (layer == 0) { prep_static_weights(p, lds, gw, NGW, wave, lane); __syncthreads(); norm_phase<0>(p, layer, lds, gw, NGW, tid, lane); }
            else norm_phase<1>(p, layer, lds, gw, NGW, tid, lane);
        }
        SEAM(g0 + 0);
        if (IN(g0 + 1)) { FRESH();
            SchedH S; S.to.init(M / 256, DH / 256, G, (int)blockIdx.x); S.A = (const char*)(p.ws + WS_XN); S.B = (const char*)(p.ws + WS_WIN + layer * WIN_L);
            EpiStoreBf16 E{Hb, DH};
            pg8::gemm_phase(lds, tid, D, D, D, S, E);
        }
        SEAM(g0 + 1);
        if (IN(g0 + 2)) { FRESH(); gdn_chunk_prep(p, layer, lds, tid, wave, lane); }
        SEAM(g0 + 2);
        if (IN(g0 + 3)) { FRESH();
            if ((int)blockIdx.x < 32) gdn_chunk_scan(p, lds, tid, wave, lane, (int)blockIdx.x);
            else { const int vb = (int)blockIdx.x - 32, nvb = G - 32;
                shortconv(p, layer, vb * 512 + tid, nvb * 512);
                conformer(p, layer, lds, tid, wave, lane, vb, nvb);
                __syncthreads();
                gmlp(p, layer, lds, tid, wave, lane, vb, nvb); }
        }
        SEAM(g0 + 3);
        if (IN(g0 + 4)) { FRESH(); gdn_out(p, layer, gw, NGW, lane); }
        SEAM(g0 + 4);
        if (IN(g0 + 5)) { FRESH();
            SchedBranch S; S.to.init(M / 256, 16, G, (int)blockIdx.x); S.YS = (const char*)(p.ws + WS_YS); S.WBR = (const char*)(p.ws + WS_WBR + layer * WBR_L);
            EpiGate E{Hb, DH};
            pg8::gemm_phase(lds, tid, 512, 2048, 512, S, E);
        }
        SEAM(g0 + 5);
        if (IN(g0 + 6)) { FRESH(); sum_gated(p, gtid, NGT); }
        SEAM(g0 + 6);
        if (IN(g0 + 7)) { FRESH();
            SchedOut S; S.to.init(M / 256, 4, G, (int)blockIdx.x); S.A = (const char*)(p.ws + WS_MERGED); S.B = (const char*)(p.ws + WS_WOUT + layer * WOUT_L);
            EpiResF32 E{layer == 0 ? p.in[I_X] : p.out, p.out};
            pg8::gemm_phase(lds, tid, D, D, D, S, E);
            __syncthreads();
            prep_moe_weights(p, layer, lds, gw, NGW, wave, lane);
        }
        SEAM(g0 + 7);
        if (IN(g0 + 8)) { FRESH(); moe_route(p, layer, lds, tid, wave, lane); }
        SEAM(g0 + 8);
        if (IN(g0 + 9)) { FRESH(); moe_dispatch(p, lds, tid, wave, lane); }
        SEAM(g0 + 9);
        if (IN(g0 + 10) || IN(g0 + 11)) { FRESH();
            LAS int* lblk = (LAS int*)(lds + LDSCTL_OFF + LC_TAB);
            const int* blk_e = (const int*)(p.ws + WS_MOETAB + (size_t)NROWS_MAX * 8 + 256 * 64 * 4);
            __syncthreads();
            for (int i = tid; i <= NROWBLK_MAX; i += 512) lblk[i] = blk_e[i];
            __syncthreads();
        }
        if (IN(g0 + 10)) { FRESH();
            LAS int* lblk = (LAS int*)(lds + LDSCTL_OFF + LC_TAB);
            SchedMoe S; S.nunits = lblk[NROWBLK_MAX] * 4; S.G = G; S.c = (int)blockIdx.x; S.blk_e = lblk; S.A = (const char*)(p.ws + WS_XS); S.a_blk = (size_t)256 * D * 2;
            S.W = (const char*)(p.ws + WS_MOEW); S.w_e = WGU_E; S.w_pn = (size_t)256 * D * 2; S.cmul = 128;
            EpiSwiglu E{(bf16*)(p.ws + WS_HB)};
            pg8::gemm_phase(lds, tid, D, D, D, S, E);
        }
        SEAM(g0 + 10);
        if (IN(g0 + 11)) { FRESH();
            LAS int* lblk = (LAS int*)(lds + LDSCTL_OFF + LC_TAB);
            SchedMoe S; S.nunits = lblk[NROWBLK_MAX] * 4; S.G = G; S.c = (int)blockIdx.x; S.blk_e = lblk; S.A = (const char*)(p.ws + WS_HB); S.a_blk = (size_t)256 * DE * 2;
            S.W = (const char*)(p.ws + WS_WD); S.w_e = WD_E; S.w_pn = (size_t)256 * DE * 2; S.cmul = 256;
            EpiScatter E{(bf16*)(p.ws + WS_Y), (const int*)(p.ws + WS_MOETAB), (const float*)(p.ws + WS_MOETAB + (size_t)NROWS_MAX * 4)};
            pg8::gemm_phase(lds, tid, DE, DE, DE, S, E);
        }
        SEAM(g0 + 11);
    }
    if (IN(PH_FINAL)) { FRESH(); norm_phase<2>(p, 0, lds, gw, NGW, tid, lane); }
#undef IN
#undef SEAM
}

extern "C" void kernel_launch(void* const* d_in, const int* in_sizes, int n_in, void* d_out, int out_size, void* d_ws, size_t ws_size, hipStream_t stream) {
    static int grid = 0;
    if (grid == 0) {
        if (n_in != 25 || out_size != M * D || ws_size < WS_END) { fprintf(stderr, "kernel_launch: unexpected shapes / workspace (n_in %d out %d ws %zu, need %zu)\n", n_in, out_size, ws_size, (size_t)WS_END); grid = -1; return; }
        int dev = 0, cus = 0, per_cu = 0;
        if (hipGetDevice(&dev) != hipSuccess || hipDeviceGetAttribute(&cus, hipDeviceAttributeMultiprocessorCount, dev) != hipSuccess) { grid = -1; return; }
        if (hipFuncSetAttribute((const void*)fwd, hipFuncAttributeMaxDynamicSharedMemorySize, LDS_BYTES) != hipSuccess) { fprintf(stderr, "kernel_launch: hipFuncSetAttribute failed\n"); grid = -1; return; }
        if (hipOccupancyMaxActiveBlocksPerMultiprocessor(&per_cu, (const void*)fwd, 512, LDS_BYTES) != hipSuccess || per_cu < 1) { fprintf(stderr, "kernel_launch: occupancy query says %d\n", per_cu); }
        (void)hipGetLastError();
        grid = cus;
    }
    if (grid < 0) return;
    hipMemsetAsync((char*)d_ws + WS_CTL, 0, CTL_BYTES, stream);
    Params p{};
    for (int i = 0; i < 25; ++i) p.in[i] = (const float*)d_in[i];
    p.out = (float*)d_out; p.ws = (unsigned char*)d_ws;
#if N_LAUNCH_MODE == 1
    p.ph_lo = 0; p.ph_hi = PH_TOTAL;
    hipLaunchKernelGGL(fwd, dim3(grid), dim3(512), LDS_BYTES, stream, p);
#else
    for (int k = 0; k < PH_TOTAL; ++k) { p.ph_lo = k; p.ph_hi = k + 1; hipLaunchKernelGGL(fwd, dim3(grid), dim3(512), LDS_BYTES, stream, p); }
#endif
}
```

```cpp
#include <hip/hip_runtime.h>
#include <cstdio>
#include <cstdint>

#ifndef REPEAT_MASK
#define REPEAT_MASK 0
#endif
#ifndef N_LAUNCH_MODE
#define N_LAUNCH_MODE 1
#endif

#define LAS __attribute__((address_space(3)))
typedef unsigned short bf16;
typedef short bf16x8 __attribute__((ext_vector_type(8)));
typedef float f32x4 __attribute__((ext_vector_type(4)));
typedef float f32x2 __attribute__((ext_vector_type(2)));
typedef unsigned u32x4 __attribute__((ext_vector_type(4)));
typedef unsigned u32x2 __attribute__((ext_vector_type(2)));

constexpr int NB = 8, T = 4096, D = 1024, M = NB * T, NLAYER = 2;
constexpr int DIN = 9736, DH = 9728;
constexpr int HQ = 0, HK = 512, HV = 1024, HZ = 1536, HCONF = 2048, HGMLP = 3072, HSC = 4096, HGATE = 5632;
constexpr int NE = 64, DE = 512;
constexpr float EPS = 1e-6f;
constexpr int NROWBLK_MAX = 320, NROWS_MAX = NROWBLK_MAX * 256;

constexpr size_t MiB = 1u << 20;
constexpr size_t WS_CTL = 0, CTL_BYTES = 1 * MiB;
constexpr size_t WS_WIN = 2 * MiB;
constexpr size_t WIN_L = (size_t)DH * D * 2;
constexpr size_t WS_WBR = 40 * MiB;
constexpr size_t WBR_L = (size_t)4 * D * 512 * 2;
constexpr size_t WS_WOUT = 48 * MiB;
constexpr size_t WOUT_L = (size_t)D * D * 2;
constexpr size_t WS_XN = 52 * MiB;
constexpr size_t WS_SMALL = 116 * MiB;
constexpr size_t WS_ROUTE = 117 * MiB;
constexpr size_t WS_MOETAB = 118 * MiB;
constexpr size_t WS_YS = 120 * MiB;
constexpr size_t WS_REC = 248 * MiB;
constexpr size_t WS_MERGED = WS_REC;
constexpr size_t WS_OBUF = WS_XN;
constexpr int REC_W = 0, REC_Q = 16384, REC_ATT = 32768, REC_KT = 40960, REC_U = 57344, REC_G = 73728, REC_BYTES = 73984;
static_assert(WS_REC + (size_t)2048 * REC_BYTES <= 410 * MiB, "chunk records");
constexpr size_t WS_H = 410 * MiB;
constexpr size_t WS_MOEW = 410 * MiB;
constexpr size_t WGU_E = (size_t)1024 * 1024 * 2, WD_E = (size_t)1024 * 512 * 2;
constexpr size_t WS_WD = WS_MOEW + 64 * WGU_E;
constexpr size_t WS_XS = 602 * MiB;
constexpr size_t WS_HB = 762 * MiB;
constexpr size_t WS_Y = 842 * MiB;
constexpr size_t WS_END = 1018 * MiB;
static_assert(WS_H + (size_t)M * DH * 2 <= WS_END && WS_Y + (size_t)2 * M * D * 2 <= WS_END, "ws map");

constexpr int CW_BAR = 4096;
constexpr int STAGE_LDS = 131072, LDSCTL_OFF = 131072, LDS_BYTES = 147456;
constexpr int LC_BAR = 0;
constexpr int LC_MISC = 64;
constexpr int LC_TAB = 1024;

__device__ __forceinline__ float bf_lo(unsigned w) { return __uint_as_float(w << 16); }
__device__ __forceinline__ float bf_hi(unsigned w) { return __uint_as_float(w & 0xffff0000u); }
__device__ __forceinline__ float bf2f(bf16 b) { return __uint_as_float(((unsigned)b) << 16); }
__device__ __forceinline__ unsigned f2bf(float f) { unsigned u = __float_as_uint(f); return (u + 0x7fffu + ((u >> 16) & 1u)) >> 16; }
__device__ __forceinline__ unsigned pk2(float lo, float hi) { return f2bf(lo) | (f2bf(hi) << 16); }
__device__ __forceinline__ void unpack8(const u32x4 v, float (&f)[8]) {
    f[0] = bf_lo(v.x); f[1] = bf_hi(v.x); f[2] = bf_lo(v.y); f[3] = bf_hi(v.y); f[4] = bf_lo(v.z); f[5] = bf_hi(v.z); f[6] = bf_lo(v.w); f[7] = bf_hi(v.w);
}
__device__ __forceinline__ u32x4 pack8(const float (&f)[8]) { u32x4 o; o.x = pk2(f[0], f[1]); o.y = pk2(f[2], f[3]); o.z = pk2(f[4], f[5]); o.w = pk2(f[6], f[7]); return o; }
__device__ __forceinline__ float wave_sum(float v) {
#pragma unroll
    for (int o = 1; o < 64; o <<= 1) v += __shfl_xor(v, o);
    return v;
}
__device__ __forceinline__ float sigmoidf_(float x) { return 1.0f / (1.0f + __expf(-x)); }
__device__ __forceinline__ float siluf_(float x) { return x / (1.0f + __expf(-x)); }
__device__ __forceinline__ float gelu_tanh(float x) { const float u = 0.7978845608028654f * (x + 0.044715f * x * x * x); return x / (1.0f + __expf(-2.0f * u)); }
__device__ __forceinline__ float softplusf_(float x) { return fmaxf(x, 0.f) + log1pf(__expf(-fabsf(x))); }

#define XB_TMO      128
#define XB_XCNT(j)  (256  + 64 * (j))
#define XB_XSUB(j)  (1280 + 64 * (j))
#define XB_XGEN(j)  (2304 + 64 * (j))
#define XB_TOP      3328
#define XB_TOPGEN   3392
#define XCD_BAR_WORDS 3456
#define XB_SPIN_CAP (1u << 18)
__device__ __forceinline__ unsigned xb_ld(unsigned* p)              { return __hip_atomic_load(p, __ATOMIC_RELAXED, __HIP_MEMORY_SCOPE_AGENT); }
__device__ __forceinline__ unsigned xb_add(unsigned* p, unsigned v) { return __hip_atomic_fetch_add(p, v, __ATOMIC_RELAXED, __HIP_MEMORY_SCOPE_AGENT); }
__device__ __forceinline__ unsigned xb_xcc_id() { return (unsigned)__builtin_amdgcn_s_getreg((3 << 11) | 20) & 0xFu; }
#define XB_SPIN(cond, bar) do { unsigned _sp = 0; while (cond) { __builtin_amdgcn_s_sleep(1); \
    if ((++_sp & 255u) == 0u) { if (xb_ld(&(bar)[XB_TMO])) break; if (_sp > XB_SPIN_CAP) { atomicAdd(&(bar)[XB_TMO], 1u); break; } } } } while (0)
struct XcdBarrier { unsigned* bar; unsigned x; volatile LAS unsigned* st; };
__device__ __forceinline__ XcdBarrier xcd_barrier_post(unsigned* bar, volatile LAS unsigned* st) {
    XcdBarrier b; b.bar = bar; b.x = xb_xcc_id(); b.st = st;
    if (threadIdx.x == 0) (void)xb_add(&bar[XB_XCNT(b.x)], 1u);
    return b;
}
__device__ __forceinline__ void xcd_barrier_complete(unsigned* bar, unsigned x, unsigned& nloc, unsigned& nx) {
    const unsigned G = gridDim.x * gridDim.y * gridDim.z;
    unsigned sum, cnt, mine, sp = 0u;
    for (;;) {
        sum = 0u; cnt = 0u; mine = 0u;
#pragma unroll
        for (unsigned j = 0; j < 16; ++j) { const unsigned c = xb_ld(&bar[XB_XCNT(j)]); sum += c; cnt += (c > 0u) ? 1u : 0u; mine = (j == x) ? c : mine; }
        if (sum == G) break;
        __builtin_amdgcn_s_sleep(1);
        if ((++sp & 255u) == 0u) { if (xb_ld(&bar[XB_TMO])) break; if (sp > XB_SPIN_CAP) { atomicAdd(&bar[XB_TMO], 1u); break; } }
    }
    nloc = mine > 0u ? mine : 1u; nx = cnt > 0u ? cnt : 1u;
}
__device__ __forceinline__ void xcd_barrier(const XcdBarrier& b) {
    asm volatile("s_waitcnt vmcnt(0)" ::: "memory");
    __syncthreads();
    if (threadIdx.x == 0) {
        unsigned* bar = b.bar;
        __builtin_amdgcn_s_waitcnt(0);
        unsigned nloc = b.st[0], nx = b.st[1];
        if (nloc == 0u) { xcd_barrier_complete(bar, b.x, nloc, nx); b.st[0] = nloc; b.st[1] = nx; }
        const unsigned old = xb_add(&bar[XB_XSUB(b.x)], 1u);
        const unsigned gen = old / nloc;
        if (old + 1u == (gen + 1u) * nloc) {
            __builtin_amdgcn_fence(__ATOMIC_RELEASE, "agent");
            asm volatile("s_waitcnt vmcnt(0)" ::: "memory");
            const unsigned og = xb_add(&bar[XB_TOP], 1u);
            const unsigned tg = og / nx;
            if (og + 1u == (tg + 1u) * nx) xb_add(&bar[XB_TOPGEN], 1u);
            else XB_SPIN(xb_ld(&bar[XB_TOPGEN]) == tg, bar);
            __builtin_amdgcn_fence(__ATOMIC_ACQUIRE, "agent");
            xb_add(&bar[XB_XGEN(b.x)], 1u);
            asm volatile("s_waitcnt vmcnt(0)" ::: "memory");
        } else {
            XB_SPIN(xb_ld(&bar[XB_XGEN(b.x)]) == gen, bar);
            __builtin_amdgcn_fence(__ATOMIC_ACQUIRE, "agent");
            asm volatile("s_waitcnt vmcnt(0)" ::: "memory");
        }
    }
    __syncthreads();
}

namespace pg8 {
constexpr int BM = 256, BK = 64, HALF = 128, HTB = HALF * BK * 2, STAGE_BYTES = 8 * HTB, NXCD = 8, WGM = 8;
__host__ __device__ __forceinline__ int lds_byte(int r, int c) { const int st = (r >> 4) * 2 + (c >> 5), rr = r & 15, cc = c & 31, ob = rr * 64 + cc * 2; return st * 1024 + (ob ^ (((ob >> 9) & 1) << 5)); }
__host__ __device__ __forceinline__ void stage_rc(int b, int& R, int& C) { const int st = b / 1024, sb = b % 1024, swz = sb ^ (((sb >> 9) & 1) << 5); R = (st >> 1) * 16 + swz / 64; C = (st & 1) * 32 + (swz % 64) / 2; }
__host__ __device__ __forceinline__ int perm32(int rho) { const int n = rho >> 4, i = rho & 15; return 8 * (i >> 2) + 4 * n + (i & 3); }

struct Unit { const char* A; const char* B; int r0, c0; };

struct TileOrder {
    int nM, nN, nwg, G, c;
    __device__ void init(int nM_, int nN_, int G_, int c_) { nM = nM_; nN = nN_; nwg = nM * nN; G = G_; c = c_; }
    __device__ bool next(int i, int& pm, int& pn) const {
        const long L = (long)i * G + c; if (L >= nwg) return false;
        int wgid = (int)L; { const int q = nwg / NXCD, r = nwg % NXCD, xcd = wgid % NXCD, off = wgid / NXCD; wgid = (xcd < r ? xcd * (q + 1) : r * (q + 1) + (xcd - r) * q) + off; }
        const int nig = WGM * nN, gid = wgid / nig, fm = gid * WGM, gsz = (nM - fm) < WGM ? (nM - fm) : WGM;
        pm = fm + ((wgid % nig) % gsz); pn = (wgid % nig) / gsz; return true;
    }
};
__device__ __forceinline__ unsigned cvt_pk_bf16(float lo, float hi) { unsigned r; asm volatile("v_cvt_pk_bf16_f32 %0, %1, %2" : "=v"(r) : "v"(lo), "v"(hi)); return r; }

template <class Epi, class Sched>
__device__ __forceinline__ void gemm_phase(LAS unsigned char* lds, const int tid, const int K, const int lda, const int ldb, const Sched& S, const Epi& E) {
    const int wid = __builtin_amdgcn_readfirstlane(tid >> 6), lane = tid & 63, wr = wid >> 2, wc = wid & 3, fr = lane & 15, fq = lane >> 4;
    const int nt = K / BK;
    unsigned voffA[2], voffB[2];
#pragma unroll
    for (int i = 0; i < 2; ++i) { int R, C; stage_rc(tid * 16 + i * 8192, R, C); const int Rb = Epi::PERM ? ((R & ~31) + perm32(R & 31)) : R;
        voffA[i] = (unsigned)(R * lda + C) * 2u; voffB[i] = (unsigned)(Rb * ldb + C) * 2u; }
    const size_t kstep = (size_t)(BK * 2);
    const size_t hstepA = (size_t)HALF * lda * 2, hstepB = (size_t)HALF * ldb * 2;
    const unsigned ldsw = (unsigned)wid * 1024u;
    const int aoff = lds_byte(wr * 64 + fr, fq * 8), boff = lds_byte(wc * 32 + fr, fq * 8);
#define PG8_SA(b, h) (((b) * 2 + (h)) * HTB)
#define PG8_SB(b, h) ((4 + (b) * 2 + (h)) * HTB)
#define PG8_STAGE(bufoff, gbase, voff) do { _Pragma("unroll") for (int _i = 0; _i < 2; ++_i) \
        __builtin_amdgcn_global_load_lds((const unsigned*)((const char*)(gbase) + (voff)[_i]), (LAS unsigned*)(lds + (bufoff) + ldsw + _i * 8192), 16, 0, 0); } while (0)
#define PG8_LDA(dst, b, h) do { _Pragma("unroll") for (int m = 0; m < 4; ++m) _Pragma("unroll") for (int k = 0; k < 2; ++k) dst[m][k] = *(const LAS bf16x8*)(lds + PG8_SA(b, h) + aoff + m * 2048 + k * 1024); } while (0)
#define PG8_LDB(dst, b, h) do { _Pragma("unroll") for (int n = 0; n < 2; ++n) _Pragma("unroll") for (int k = 0; k < 2; ++k) dst[n][k] = *(const LAS bf16x8*)(lds + PG8_SB(b, h) + boff + n * 2048 + k * 1024); } while (0)
#define PG8_MMA(ai, bj, At, Bt) do { __builtin_amdgcn_s_setprio(1); _Pragma("unroll") for (int m = 0; m < 4; ++m) _Pragma("unroll") for (int n = 0; n < 2; ++n) _Pragma("unroll") for (int k = 0; k < 2; ++k) \
        acc[ai][bj][m][n] = __builtin_amdgcn_mfma_f32_16x16x32_bf16(Bt[n][k], At[m][k], acc[ai][bj][m][n], 0, 0, 0); __builtin_amdgcn_s_setprio(0); } while (0)
#define PG8_WAIT_V(n) asm volatile("s_waitcnt vmcnt(" #n ")" ::: "memory")
#define PG8_WAIT_L(n) asm volatile("s_waitcnt lgkmcnt(" #n ")" ::: "memory")
#define PG8_BAR __builtin_amdgcn_s_barrier()
#define PG8_SCHED __builtin_amdgcn_sched_barrier(0)
    Unit cur, nxt; int ui = 0;
    if (!S.next(0, cur)) return;
    f32x4 acc[2][2][4][2];
#pragma unroll
    for (int a = 0; a < 2; ++a)
#pragma unroll
        for (int b = 0; b < 2; ++b)
#pragma unroll
            for (int m = 0; m < 4; ++m)
#pragma unroll
                for (int n = 0; n < 2; ++n) acc[a][b][m][n] = (f32x4){0.f, 0.f, 0.f, 0.f};
    bf16x8 At[4][2], B0[2][2], B1[2][2];
    const char* cA = cur.A; const char* cB = cur.B;
    PG8_STAGE(PG8_SB(0, 0), cB, voffB); PG8_STAGE(PG8_SB(0, 1), cB + hstepB, voffB); PG8_STAGE(PG8_SA(0, 0), cA, voffA); PG8_STAGE(PG8_SA(0, 1), cA + hstepA, voffA);
    if (wr == 1) PG8_BAR;
    PG8_WAIT_V(2); PG8_BAR;
    PG8_STAGE(PG8_SB(1, 0), cB + kstep, voffB); PG8_STAGE(PG8_SA(1, 0), cA + kstep, voffA); PG8_STAGE(PG8_SB(1, 1), cB + hstepB + kstep, voffB);
    PG8_WAIT_V(6); PG8_BAR;
    for (;;) {
        const bool has_next = S.next(ui + 1, nxt);
        const char* nA = has_next ? nxt.A : cA; const char* nB = has_next ? nxt.B : cB;
        for (int t = 0; t < nt; t += 2) {
            const bool last = (t == nt - 2);
            const char* a1 = cA + (size_t)(t + 1) * kstep;
            const char* a2 = last ? nA : cA + (size_t)(t + 2) * kstep; const char* b2 = last ? nB : cB + (size_t)(t + 2) * kstep;
            const char* a3 = a2 + kstep; const char* b3 = b2 + kstep;
            PG8_LDB(B0, 0, 0); PG8_LDB(B1, 0, 1); PG8_SCHED; PG8_LDA(At, 0, 0); PG8_STAGE(PG8_SA(1, 1), a1 + hstepA, voffA);
            PG8_WAIT_V(8); PG8_WAIT_L(0); PG8_BAR; PG8_MMA(0, 0, At, B0); PG8_MMA(0, 1, At, B1); PG8_BAR; PG8_SCHED;
            PG8_LDA(At, 0, 1); PG8_STAGE(PG8_SB(0, 0), b2, voffB); PG8_STAGE(PG8_SB(0, 1), b2 + hstepB, voffB); PG8_STAGE(PG8_SA(0, 0), a2, voffA);
            PG8_WAIT_V(8); PG8_WAIT_L(0); PG8_BAR; PG8_MMA(1, 0, At, B0); PG8_MMA(1, 1, At, B1); PG8_BAR; PG8_SCHED;
            PG8_LDB(B0, 1, 0); PG8_LDB(B1, 1, 1); PG8_SCHED; PG8_LDA(At, 1, 0); PG8_STAGE(PG8_SA(0, 1), a2 + hstepA, voffA);
            PG8_WAIT_V(8); PG8_WAIT_L(0); PG8_BAR; PG8_MMA(0, 0, At, B0); PG8_MMA(0, 1, At, B1); PG8_BAR; PG8_SCHED;
            PG8_LDA(At, 1, 1); PG8_STAGE(PG8_SB(1, 0), b3, voffB); PG8_STAGE(PG8_SB(1, 1), b3 + hstepB, voffB); PG8_STAGE(PG8_SA(1, 0), a3, voffA);
            PG8_WAIT_V(8); PG8_WAIT_L(0); PG8_BAR; PG8_MMA(1, 0, At, B0); PG8_MMA(1, 1, At, B1); PG8_BAR; PG8_SCHED;
        }
        if (wr == 0) PG8_BAR;
        E(acc, cur, wr, wc, fr, fq);
        if (!has_next) break;
#pragma unroll
        for (int a = 0; a < 2; ++a)
#pragma unroll
            for (int b = 0; b < 2; ++b)
#pragma unroll
                for (int m = 0; m < 4; ++m)
#pragma unroll
                    for (int n = 0; n < 2; ++n) acc[a][b][m][n] = (f32x4){0.f, 0.f, 0.f, 0.f};
        cur = nxt; cA = nA; cB = nB; ++ui;
        if (wr == 1) PG8_BAR;
    }
    PG8_WAIT_V(0);
    PG8_BAR;
#undef PG8_SA
#undef PG8_SB
#undef PG8_STAGE
#undef PG8_LDA
#undef PG8_LDB
#undef PG8_MMA
#undef PG8_WAIT_V
#undef PG8_WAIT_L
#undef PG8_BAR
#undef PG8_SCHED
}
}
using pg8::Unit;
using pg8::cvt_pk_bf16;

struct EpiStoreBf16 {
    static constexpr bool PERM = true;
    bf16* O; int ldc;
    __device__ __forceinline__ void operator()(const f32x4 (&acc)[2][2][4][2], const Unit& u, int wr, int wc, int fr, int fq) const {
        const int row0 = u.r0 + wr * 64 + fr, col0 = u.c0 + wc * 32 + 8 * fq;
#pragma unroll
        for (int ai = 0; ai < 2; ++ai)
#pragma unroll
            for (int m = 0; m < 4; ++m) { bf16* rowp = O + (size_t)(row0 + ai * 128 + m * 16) * ldc + col0;
#pragma unroll
                for (int bj = 0; bj < 2; ++bj) { const f32x4 v0 = acc[ai][bj][m][0], v1 = acc[ai][bj][m][1];
                    u32x4 w; w.x = cvt_pk_bf16(v0[0], v0[1]); w.y = cvt_pk_bf16(v0[2], v0[3]); w.z = cvt_pk_bf16(v1[0], v1[1]); w.w = cvt_pk_bf16(v1[2], v1[3]);
                    *(u32x4*)(rowp + bj * 128) = w; } }
    }
};
struct EpiGate {
    static constexpr bool PERM = true;
    bf16* G; int ldc;
    __device__ __forceinline__ void operator()(const f32x4 (&acc)[2][2][4][2], const Unit& u, int wr, int wc, int fr, int fq) const {
        const int row0 = u.r0 + wr * 64 + fr, col0 = u.c0 + wc * 32 + 8 * fq;
#pragma unroll
        for (int ai = 0; ai < 2; ++ai)
#pragma unroll
            for (int m = 0; m < 4; ++m) { bf16* rowp = G + (size_t)(row0 + ai * 128 + m * 16) * ldc + col0;
#pragma unroll
                for (int bj = 0; bj < 2; ++bj) { const f32x4 v0 = acc[ai][bj][m][0], v1 = acc[ai][bj][m][1];
                    const u32x4 gw = *(const u32x4*)(rowp + bj * 128); float g[8]; unpack8(gw, g);
                    u32x4 w; w.x = cvt_pk_bf16(sigmoidf_(g[0]) * v0[0], sigmoidf_(g[1]) * v0[1]); w.y = cvt_pk_bf16(sigmoidf_(g[2]) * v0[2], sigmoidf_(g[3]) * v0[3]);
                    w.z = cvt_pk_bf16(sigmoidf_(g[4]) * v1[0], sigmoidf_(g[5]) * v1[1]); w.w = cvt_pk_bf16(sigmoidf_(g[6]) * v1[2], sigmoidf_(g[7]) * v1[3]);
                    *(u32x4*)(rowp + bj * 128) = w; } }
    }
};
struct EpiResF32 {
    static constexpr bool PERM = false;
    const float* res; float* out;
    __device__ __forceinline__ void operator()(const f32x4 (&acc)[2][2][4][2], const Unit& u, int wr, int wc, int fr, int fq) const {
        const int row0 = u.r0 + wr * 64 + fr, col0 = u.c0 + wc * 32 + 4 * fq;
#pragma unroll
        for (int ai = 0; ai < 2; ++ai)
#pragma unroll
            for (int m = 0; m < 4; ++m) { const size_t ro = (size_t)(row0 + ai * 128 + m * 16) * D + col0;
#pragma unroll
                for (int bj = 0; bj < 2; ++bj)
#pragma unroll
                    for (int n = 0; n < 2; ++n) { const f32x4 r = *(const f32x4*)(res + ro + bj * 128 + n * 16); *(f32x4*)(out + ro + bj * 128 + n * 16) = r + acc[ai][bj][m][n]; } }
    }
};
struct EpiSwiglu {
    static constexpr bool PERM = true;
    bf16* O;
    __device__ __forceinline__ void operator()(const f32x4 (&acc)[2][2][4][2], const Unit& u, int wr, int wc, int fr, int fq) const {
        const int row0 = u.r0 + wr * 64 + fr, col0 = u.c0 + wc * 32 + 8 * fq;
#pragma unroll
        for (int ai = 0; ai < 2; ++ai)
#pragma unroll
            for (int m = 0; m < 4; ++m) { bf16* rowp = O + (size_t)(row0 + ai * 128 + m * 16) * DE + col0;
                const f32x4 g0 = acc[ai][0][m][0], g1 = acc[ai][0][m][1], u0 = acc[ai][1][m][0], u1 = acc[ai][1][m][1];
                u32x4 w; w.x = cvt_pk_bf16(siluf_(g0[0]) * u0[0], siluf_(g0[1]) * u0[1]); w.y = cvt_pk_bf16(siluf_(g0[2]) * u0[2], siluf_(g0[3]) * u0[3]);
                w.z = cvt_pk_bf16(siluf_(g1[0]) * u1[0], siluf_(g1[1]) * u1[1]); w.w = cvt_pk_bf16(siluf_(g1[2]) * u1[2], siluf_(g1[3]) * u1[3]);
                *(u32x4*)rowp = w; }
    }
};
struct EpiScatter {
    static constexpr bool PERM = true;
    bf16* Y; const int* row_code; const float* row_w;
    __device__ __forceinline__ void operator()(const f32x4 (&acc)[2][2][4][2], const Unit& u, int wr, int wc, int fr, int fq) const {
        const int row0 = u.r0 + wr * 64 + fr, col0 = u.c0 + wc * 32 + 8 * fq;
#pragma unroll
        for (int ai = 0; ai < 2; ++ai)
#pragma unroll
            for (int m = 0; m < 4; ++m) { const int row = row0 + ai * 128 + m * 16; const int code = row_code[row]; const float rw = row_w[row];
                if (code >= 0) { bf16* rowp = Y + (size_t)(code & 1) * ((size_t)M * D) + (size_t)(code >> 1) * D + col0;
#pragma unroll
                    for (int bj = 0; bj < 2; ++bj) { const f32x4 v0 = acc[ai][bj][m][0] * rw, v1 = acc[ai][bj][m][1] * rw;
                        u32x4 w; w.x = cvt_pk_bf16(v0[0], v0[1]); w.y = cvt_pk_bf16(v0[2], v0[3]); w.z = cvt_pk_bf16(v1[0], v1[1]); w.w = cvt_pk_bf16(v1[2], v1[3]);
                        *(u32x4*)(rowp + bj * 128) = w; } } }
    }
};

struct SchedH {
    pg8::TileOrder to; const char* A; const char* B;
    __device__ __forceinline__ bool next(int i, Unit& u) const { int pm, pn; if (!to.next(i, pm, pn)) return false;
        u.A = A + (size_t)pm * 256 * D * 2; u.B = B + (size_t)pn * 256 * D * 2; u.r0 = pm * 256; u.c0 = pn * 256; return true; }
};
struct SchedBranch {
    pg8::TileOrder to; const char* YS; const char* WBR;
    __device__ __forceinline__ bool next(int i, Unit& u) const { int pm, pn; if (!to.next(i, pm, pn)) return false; const int br = pn >> 2, q = pn & 3;
        u.A = YS + ((size_t)pm * 256 * 2048 + br * 512) * 2; u.B = WBR + ((size_t)br * D * 512 + (size_t)q * 256 * 512) * 2; u.r0 = pm * 256; u.c0 = HGATE + br * 1024 + q * 256; return true; }
};
struct SchedOut {
    pg8::TileOrder to; const char* A; const char* B;
    __device__ __forceinline__ bool next(int i, Unit& u) const { int pm, pn; if (!to.next(i, pm, pn)) return false;
        u.A = A + (size_t)pm * 256 * D * 2; u.B = B + (size_t)pn * 256 * D * 2; u.r0 = pm * 256; u.c0 = pn * 256; return true; }
};
struct SchedMoe {
    int nunits, G, c; const LAS int* blk_e; const char* A; size_t a_blk; const char* W; size_t w_e, w_pn; int cmul;
    __device__ __forceinline__ bool next(int i, Unit& u) const { const long L = (long)i * G + c; if (L >= nunits) return false; const int rb = (int)(L >> 2), pn = (int)(L & 3); const int e = blk_e[rb];
        u.A = A + (size_t)rb * a_blk; u.B = W + (size_t)e * w_e + (size_t)pn * w_pn; u.r0 = rb * 256; u.c0 = pn * cmul; return true; }
};

struct Params { const float* in[25]; float* out; unsigned char* ws; int ph_lo, ph_hi; };
enum { I_X = 0, I_MIXNW, I_WIN, I_GCONV, I_GALOG, I_GDT, I_GNW, I_CCW, I_CCB, I_CLNW, I_CLNB, I_GLNW, I_GLNB, I_GWS, I_GBS, I_SCW, I_WBR, I_WOUT, I_MOENW, I_RGRP, I_REXP, I_WG, I_WU, I_WD, I_FNW };
constexpr int PH_PER_LAYER = 12, PH_FINAL = 24, PH_TOTAL = 25;

__device__ __forceinline__ void transpose_item(const float* __restrict__ W, int ldw, int srccol, bf16* __restrict__ WT, int ldt, int k0, int n0, LAS float* scr, int lane) {
#pragma unroll 8
    for (int i = 0; i < 32; ++i) { const int kk = 2 * i + (lane >> 5); scr[kk * 33 + (lane & 31)] = W[(size_t)(k0 + kk) * ldw + srccol + (lane & 31)]; }
    asm volatile("s_waitcnt lgkmcnt(0)" ::: "memory");
    const int c = lane & 7;
#pragma unroll
    for (int j = 0; j < 4; ++j) { const int n = (lane >> 3) + 8 * j; const LAS float* s = scr + (8 * c) * 33 + n;
        u32x4 o; o.x = pk2(s[0 * 33], s[1 * 33]); o.y = pk2(s[2 * 33], s[3 * 33]); o.z = pk2(s[4 * 33], s[5 * 33]); o.w = pk2(s[6 * 33], s[7 * 33]);
        *(u32x4*)(WT + (size_t)(n0 + n) * ldt + k0 + 8 * c) = o; }
    asm volatile("s_waitcnt lgkmcnt(0)" ::: "memory");
}
__device__ __forceinline__ void prep_static_weights(const Params& p, LAS unsigned char* lds, int gw, int NGW, int wave, int lane) {
    LAS float* scr = (LAS float*)(lds + wave * 16384);
    constexpr int I_IN = 16 * (DH / 32), I_BR = 8 * 32, I_OUT = 16 * 32, PER_L = I_IN + 4 * I_BR + I_OUT;
    for (int it = gw; it < NLAYER * PER_L; it += NGW) {
        const int l = it / PER_L; int r = it % PER_L;
        if (r < I_IN) { const int kb = r / (DH / 32), nb = r % (DH / 32), n0 = nb * 32;
            transpose_item(p.in[I_WIN] + (size_t)l * D * DIN, DIN, n0 + (n0 >= 2048 ? 8 : 0), (bf16*)(p.ws + WS_WIN + l * WIN_L), D, kb * 64, n0, scr, lane); continue; }
        r -= I_IN;
        if (r < 4 * I_BR) { const int br = r / I_BR, q = r % I_BR, kb = q / 32, nb = q % 32;
            transpose_item(p.in[I_WBR] + ((size_t)l * 4 + br) * 512 * D, D, nb * 32, (bf16*)(p.ws + WS_WBR + l * WBR_L) + (size_t)br * D * 512, 512, kb * 64, nb * 32, scr, lane); continue; }
        r -= 4 * I_BR;
        { const int kb = r / 32, nb = r % 32;
            transpose_item(p.in[I_WOUT] + (size_t)l * D * D, D, nb * 32, (bf16*)(p.ws + WS_WOUT + l * WOUT_L), D, kb * 64, nb * 32, scr, lane); }
    }
}
__device__ __forceinline__ void prep_moe_weights(const Params& p, int layer, LAS unsigned char* lds, int gw, int NGW, int wave, int lane) {
    LAS float* scr = (LAS float*)(lds + wave * 16384);
    constexpr int I_GU = 16 * 32, I_D = 8 * 32, PER_E = I_GU + I_D;
    for (int it = gw; it < NE * PER_E; it += NGW) {
        const int e = it / PER_E; int r = it % PER_E;
        if (r < I_GU) { const int kb = r / 32, nb = r % 32, n0 = nb * 32, pn = n0 >> 8, half = (n0 >> 7) & 1, j0 = n0 & 127;
            const float* src = p.in[half ? I_WU : I_WG] + ((size_t)layer * NE + e) * D * DE;
            transpose_item(src, DE, 128 * pn + j0, (bf16*)(p.ws + WS_MOEW + e * WGU_E), D, kb * 64, n0, scr, lane); continue; }
        r -= I_GU;
        { const int kb = r / 32, nb = r % 32;
            transpose_item(p.in[I_WD] + ((size_t)layer * NE + e) * DE * D, D, nb * 32, (bf16*)(p.ws + WS_WD + e * WD_E), DE, kb * 64, nb * 32, scr, lane); }
    }
}

template <int MODE>
__device__ __forceinline__ void norm_phase(const Params& p, int layer, LAS unsigned char* lds, int gw, int NGW, int tid, int lane) {
    LAS float* wsm = (LAS float*)lds;
    if (MODE != 2) {
        const float* wi = p.in[I_WIN] + (size_t)layer * D * DIN;
        for (int i = tid; i < 8192; i += 512) wsm[i] = wi[(size_t)(i >> 3) * DIN + 2048 + (i & 7)];
    }
    __syncthreads();
    const float* nwp = (MODE == 2) ? p.in[I_FNW] : p.in[I_MIXNW] + layer * D;
    f32x4 nw[4];
#pragma unroll
    for (int j = 0; j < 4; ++j) nw[j] = *(const f32x4*)(nwp + 4 * lane + 256 * j);
    const bf16* Y0 = (const bf16*)(p.ws + WS_Y); const bf16* Y1 = Y0 + (size_t)M * D;
    bf16* XN = (bf16*)(p.ws + WS_XN); float* SMALL = (float*)(p.ws + WS_SMALL);
    for (int m = gw; m < M; m += NGW) {
        const float* xr = (MODE == 0 ? p.in[I_X] : p.out) + (size_t)m * D;
        f32x4 v[4]; float ss = 0.f;
#pragma unroll
        for (int j = 0; j < 4; ++j) { v[j] = *(const f32x4*)(xr + 4 * lane + 256 * j);
            if (MODE != 0) { const u32x2 a = *(const u32x2*)(Y0 + (size_t)m * D + 4 * lane + 256 * j), b = *(const u32x2*)(Y1 + (size_t)m * D + 4 * lane + 256 * j);
                v[j][0] += bf_lo(a.x) + bf_lo(b.x); v[j][1] += bf_hi(a.x) + bf_hi(b.x); v[j][2] += bf_lo(a.y) + bf_lo(b.y); v[j][3] += bf_hi(a.y) + bf_hi(b.y); }
            ss += (v[j][0] * v[j][0] + v[j][1] * v[j][1]) + (v[j][2] * v[j][2] + v[j][3] * v[j][3]); }
        const float rs = 1.0f / sqrtf(wave_sum(ss) * (1.0f / D) + EPS);
        if (MODE == 2) {
#pragma unroll
            for (int j = 0; j < 4; ++j) *(f32x4*)(p.out + (size_t)m * D + 4 * lane + 256 * j) = v[j] * rs * nw[j];
            continue;
        }
        if (MODE == 1) {
#pragma unroll
            for (int j = 0; j < 4; ++j) *(f32x4*)(p.out + (size_t)m * D + 4 * lane + 256 * j) = v[j];
        }
        float sm[8];
#pragma unroll
        for (int q = 0; q < 8; ++q) sm[q] = 0.f;
#pragma unroll
        for (int j = 0; j < 4; ++j) { v[j] = v[j] * rs * nw[j];
            u32x2 o; o.x = pk2(v[j][0], v[j][1]); o.y = pk2(v[j][2], v[j][3]); *(u32x2*)(XN + (size_t)m * D + 4 * lane + 256 * j) = o;
#pragma unroll
            for (int c = 0; c < 4; ++c) { const LAS float* wrow = wsm + (4 * lane + 256 * j + c) * 8; const f32x4 w0 = *(const LAS f32x4*)wrow, w1 = *(const LAS f32x4*)(wrow + 4);
                sm[0] += v[j][c] * w0[0]; sm[1] += v[j][c] * w0[1]; sm[2] += v[j][c] * w0[2]; sm[3] += v[j][c] * w0[3];
                sm[4] += v[j][c] * w1[0]; sm[5] += v[j][c] * w1[1]; sm[6] += v[j][c] * w1[2]; sm[7] += v[j][c] * w1[3]; } }
        float mine = 0.f;
#pragma unroll
        for (int q = 0; q < 8; ++q) { const float s = wave_sum(sm[q]); mine = (lane == q) ? s : mine; }
        if (lane < 8) SMALL[(size_t)m * 8 + lane] = mine;
    }
    __syncthreads();
}

__device__ __forceinline__ void shortconv(const Params& p, int layer, int gtid, int NGT) {
    const bf16* H = (const bf16*)(p.ws + WS_H); bf16* YS = (bf16*)(p.ws + WS_YS);
    const float* cw = p.in[I_SCW] + (size_t)layer * 3 * 512;
    for (int it = gtid; it < M * 64; it += NGT) {
        const int m = it >> 6, c8 = (it & 63) * 8, t = m & (T - 1);
        float acc[8];
#pragma unroll
        for (int i = 0; i < 8; ++i) acc[i] = 0.f;
#pragma unroll
        for (int j = 0; j < 3; ++j) { if (t - 2 + j >= 0) { const bf16* r = H + (size_t)(m - 2 + j) * DH + HSC + c8;
                float cg[8], xv[8]; unpack8(*(const u32x4*)(r + 512), cg); unpack8(*(const u32x4*)(r + 1024), xv);
#pragma unroll
                for (int i = 0; i < 8; ++i) acc[i] += cw[j * 512 + c8 + i] * (cg[i] * xv[i]); } }
        float bg[8]; unpack8(*(const u32x4*)(H + (size_t)m * DH + HSC + c8), bg);
#pragma unroll
        for (int i = 0; i < 8; ++i) acc[i] *= bg[i];
        *(u32x4*)(YS + (size_t)m * 2048 + 1536 + c8) = pack8(acc);
    }
}
__device__ __forceinline__ void conformer(const Params& p, int layer, LAS unsigned char* lds, int tid, int wave, int lane, int vb, int nvb) {
    const bf16* H = (const bf16*)(p.ws + WS_H); bf16* YS = (bf16*)(p.ws + WS_YS);
    LAS bf16* yt = (LAS bf16*)lds;
    LAS float* zt = (LAS float*)(lds + 98304);
    const float* cwp = p.in[I_CCW] + (size_t)layer * 31 * 512;
    float cw[31];
#pragma unroll
    for (int j = 0; j < 31; ++j) cw[j] = cwp[j * 512 + tid];
    const float cb = p.in[I_CCB][layer * 512 + tid];
    float lw[8], lb[8];
#pragma unroll
    for (int i = 0; i < 8; ++i) { lw[i] = p.in[I_CLNW][layer * 512 + lane * 8 + i]; lb[i] = p.in[I_CLNB][layer * 512 + lane * 8 + i]; }
    for (int unit = vb; unit < M / 64; unit += nvb) {
        const int m0 = unit * 64, t0 = m0 & (T - 1);
        for (int it = tid; it < 94 * 64; it += 512) { const int r = it >> 6, c8 = (it & 63) * 8; const int dt = r - 30;
            u32x4 o = (u32x4){0u, 0u, 0u, 0u};
            if (t0 + dt >= 0) { const bf16* src = H + (size_t)(m0 + dt) * DH + HCONF + c8; float a[8], g[8]; unpack8(*(const u32x4*)src, a); unpack8(*(const u32x4*)(src + 512), g);
#pragma unroll
                for (int i = 0; i < 8; ++i) a[i] *= sigmoidf_(g[i]);
                o = pack8(a); }
            *(LAS u32x4*)(yt + r * 512 + c8) = o; }
        __syncthreads();
        for (int sb = 0; sb < 8; ++sb) {
            float z[8];
#pragma unroll
            for (int i = 0; i < 8; ++i) z[i] = cb;
#pragma unroll
            for (int r = 0; r < 38; ++r) { const float yv = bf2f(yt[(sb * 8 + r) * 512 + tid]);
#pragma unroll
                for (int i = 0; i < 8; ++i) { const int j = r - i; if (j >= 0 && j < 31) z[i] += cw[j] * yv; } }
#pragma unroll
            for (int i = 0; i < 8; ++i) zt[i * 512 + tid] = z[i];
            __syncthreads();
            { const LAS float* zr = zt + wave * 512 + lane * 8; float v[8]; const f32x4 a = *(const LAS f32x4*)zr, b = *(const LAS f32x4*)(zr + 4);
                v[0] = a[0]; v[1] = a[1]; v[2] = a[2]; v[3] = a[3]; v[4] = b[0]; v[5] = b[1]; v[6] = b[2]; v[7] = b[3];
                float s = 0.f;
#pragma unroll
                for (int i = 0; i < 8; ++i) s += v[i];
                const float mean = wave_sum(s) * (1.0f / 512.0f); float q = 0.f;
#pragma unroll
                for (int i = 0; i < 8; ++i) { v[i] -= mean; q += v[i] * v[i]; }
                const float rstd = 1.0f / sqrtf(wave_sum(q) * (1.0f / 512.0f) + EPS);
#pragma unroll
                for (int i = 0; i < 8; ++i) v[i] = siluf_(v[i] * rstd * lw[i] + lb[i]);
                *(u32x4*)(YS + (size_t)(m0 + sb * 8 + wave) * 2048 + 512 + lane * 8) = pack8(v); }
            __syncthreads();
        }
    }
}
__device__ __forceinline__ f32x4 mfma16(bf16x8 a, bf16x8 b, f32x4 c) { return __builtin_amdgcn_mfma_f32_16x16x32_bf16(a, b, c, 0, 0, 0); }
typedef short bf16x4 __attribute__((ext_vector_type(4)));
__device__ __forceinline__ bf16x8 ld_frag16(const LAS unsigned char* p) { return *(const LAS bf16x8*)p; }
__device__ __forceinline__ bf16x8 ld_frag8x2(const LAS unsigned char* p) { const bf16x4 a = *(const LAS bf16x4*)p, b = *(const LAS bf16x4*)(p + 32); return __builtin_shufflevector(a, b, 0, 1, 2, 3, 4, 5, 6, 7); }
__device__ __forceinline__ bf16x8 pack_frag(const f32x4 lo, const f32x4 hi) { u32x4 w; w.x = cvt_pk_bf16(lo[0], lo[1]); w.y = cvt_pk_bf16(lo[2], lo[3]); w.z = cvt_pk_bf16(hi[0], hi[1]); w.w = cvt_pk_bf16(hi[2], hi[3]); return __builtin_bit_cast(bf16x8, w); }
constexpr int GM_W = 0, GM_VT = 34816, GM_ST = 69632;
__device__ __forceinline__ void gmlp(const Params& p, int layer, LAS unsigned char* lds, int tid, int wave, int lane, int vb, int nvb) {
    const bf16* H = (const bf16*)(p.ws + WS_H); bf16* YS = (bf16*)(p.ws + WS_YS);
    LAS float* st = (LAS float*)(lds + GM_ST);
    const float* lnw = p.in[I_GLNW] + layer * 512; const float* lnb = p.in[I_GLNB] + layer * 512;
    const int q = lane >> 4, li = lane & 15;
    for (int unit = vb; unit < M / 128; unit += nvb) {
        const int m0 = unit * 128;
        __syncthreads();
        for (int tk = wave * 16; tk < wave * 16 + 16; ++tk) {
            float v[8]; unpack8(*(const u32x4*)(H + (size_t)(m0 + tk) * DH + HGMLP + 512 + lane * 8), v);
            float s = 0.f;
#pragma unroll
            for (int i = 0; i < 8; ++i) { v[i] = gelu_tanh(v[i]); s += v[i]; }
            const float mean = wave_sum(s) * (1.0f / 512.0f); float qq = 0.f;
#pragma unroll
            for (int i = 0; i < 8; ++i) { const float d = v[i] - mean; qq += d * d; }
            const float rstd = 1.0f / sqrtf(wave_sum(qq) * (1.0f / 512.0f) + EPS);
            if (lane == 0) { st[tk * 2] = mean; st[tk * 2 + 1] = rstd; }
        }
        __syncthreads();
        for (int g = 0; g < 4; ++g) {
            for (int it = tid; it < 128 * 16; it += 512) { const int tk = it >> 4, c8 = (it & 15) * 8;
                float v[8]; unpack8(*(const u32x4*)(H + (size_t)(m0 + tk) * DH + HGMLP + 512 + g * 128 + c8), v);
                const float mean = st[tk * 2], rstd = st[tk * 2 + 1];
#pragma unroll
                for (int i = 0; i < 8; ++i) *(LAS bf16*)(lds + GM_VT + (c8 + i) * 272 + 2 * tk) = (bf16)f2bf((gelu_tanh(v[i]) - mean) * rstd * lnw[g * 128 + c8 + i] + lnb[g * 128 + c8 + i]); }
            const float* ws = p.in[I_GWS] + ((size_t)layer * 4 + g) * 128 * 128;
            for (int it = tid; it < 128 * 16; it += 512) { const int i = it >> 4, j8 = (it & 15) * 8;
                const f32x4 a = *(const f32x4*)(ws + i * 128 + j8), b = *(const f32x4*)(ws + i * 128 + j8 + 4);
                float w[8] = {a[0], a[1], a[2], a[3], b[0], b[1], b[2], b[3]};
#pragma unroll
                for (int e = 0; e < 8; ++e) w[e] = (j8 + e <= i) ? w[e] : 0.f;
                *(LAS u32x4*)(lds + GM_W + i * 272 + j8 * 2) = pack8(w); }
            __syncthreads();
            {
                f32x4 acc[8];
#pragma unroll
                for (int ct = 0; ct < 8; ++ct) acc[ct] = (f32x4){0.f, 0.f, 0.f, 0.f};
                const int nks = (wave >> 1) + 1;
                for (int ks = 0; ks < nks; ++ks) { const bf16x8 wf = ld_frag16(lds + GM_W + (16 * wave + li) * 272 + (32 * ks + 8 * q) * 2);
#pragma unroll
                    for (int ct = 0; ct < 8; ++ct) acc[ct] = mfma16(ld_frag16(lds + GM_VT + (16 * ct + li) * 272 + (32 * ks + 8 * q) * 2), wf, acc[ct]); }
                const int i = 16 * wave + li; const float bs = p.in[I_GBS][((size_t)layer * 4 + g) * 128 + i];
                const bf16* urow = H + (size_t)(m0 + i) * DH + HGMLP + g * 128 + 4 * q; bf16* orow = YS + (size_t)(m0 + i) * 2048 + 1024 + g * 128 + 4 * q;
#pragma unroll
                for (int ct = 0; ct < 8; ++ct) { const u32x2 uw = *(const u32x2*)(urow + 16 * ct);
                    const float o0 = gelu_tanh(bf_lo(uw.x)) * (acc[ct][0] + bs), o1 = gelu_tanh(bf_hi(uw.x)) * (acc[ct][1] + bs), o2 = gelu_tanh(bf_lo(uw.y)) * (acc[ct][2] + bs), o3 = gelu_tanh(bf_hi(uw.y)) * (acc[ct][3] + bs);
                    u32x2 ow; ow.x = pk2(o0, o1); ow.y = pk2(o2, o3); *(u32x2*)(orow + 16 * ct) = ow; }
            }
            __syncthreads();
        }
    }
}
constexpr int CP_QN = 0, CP_KN = 17408, CP_KT = 34816, CP_VT = 53248, CP_KGT = 71680, CP_A32 = 90112, CP_ATT = 106496, CP_T16 = 115712, CP_TAB = 124928;
__device__ __forceinline__ void gdn_chunk_prep(const Params& p, int layer, LAS unsigned char* lds, int tid, int wave, int lane) {
    const bf16* H = (const bf16*)(p.ws + WS_H); const float* SMALL = (const float*)(p.ws + WS_SMALL);
    const float* cw = p.in[I_GCONV] + (size_t)layer * 4 * 1536;
    LAS float* tab = (LAS float*)(lds + CP_TAB);
    const int q = lane >> 4, li = lane & 15;
    for (int unit = blockIdx.x; unit < 2048; unit += gridDim.x) {
        const int n = unit & 63, hh = (unit >> 6) & 3, b = unit >> 8; const int m0 = b * T + n * 64;
        unsigned char* rec = p.ws + WS_REC + (size_t)((b * 4 + hh) * 64 + n) * REC_BYTES;
        __syncthreads();
        if (wave == 0) { const int m = m0 + lane; const float br = SMALL[(size_t)m * 8 + hh], ar = SMALL[(size_t)m * 8 + 4 + hh];
            float g = -__expf(p.in[I_GALOG][layer * 4 + hh]) * softplusf_(ar + p.in[I_GDT][layer * 4 + hh]);
#pragma unroll
            for (int o = 1; o < 64; o <<= 1) { const float t = __shfl_up(g, o); if (lane >= o) g += t; }
            tab[lane] = sigmoidf_(br); tab[64 + lane] = g; tab[128 + lane] = __expf(g); }
        __syncthreads();
        for (int i = wave * 8; i < wave * 8 + 8; ++i) {
            const int m = m0 + i, t = n * 64 + i;
            float y[3][2];
#pragma unroll
            for (int s = 0; s < 3; ++s) { const int c = s * 512 + hh * 128 + 2 * lane; float a0 = 0.f, a1 = 0.f;
#pragma unroll
                for (int j = 0; j < 4; ++j) { if (t - 3 + j >= 0) { const unsigned w = *(const unsigned*)(H + (size_t)(m - 3 + j) * DH + c);
                        a0 += cw[j * 1536 + c] * bf_lo(w); a1 += cw[j * 1536 + c + 1] * bf_hi(w); } }
                y[s][0] = siluf_(a0); y[s][1] = siluf_(a1); }
            const float sq = wave_sum(y[0][0] * y[0][0] + y[0][1] * y[0][1]), sk = wave_sum(y[1][0] * y[1][0] + y[1][1] * y[1][1]);
            const float rq = 0.08838834764831845f / sqrtf(sq + EPS), rk = 1.0f / sqrtf(sk + EPS);
            const float be = tab[i], bg = be * tab[128 + i];
            const float k0 = y[1][0] * rk, k1 = y[1][1] * rk;
            *(LAS unsigned*)(lds + CP_QN + i * 272 + 4 * lane) = pk2(y[0][0] * rq, y[0][1] * rq);
            *(LAS unsigned*)(lds + CP_KN + i * 272 + 4 * lane) = pk2(k0, k1);
            *(LAS bf16*)(lds + CP_KT + (2 * lane) * 144 + 2 * i) = (bf16)f2bf(k0); *(LAS bf16*)(lds + CP_KT + (2 * lane + 1) * 144 + 2 * i) = (bf16)f2bf(k1);
            *(LAS bf16*)(lds + CP_VT + (2 * lane) * 144 + 2 * i) = (bf16)f2bf(be * y[2][0]); *(LAS bf16*)(lds + CP_VT + (2 * lane + 1) * 144 + 2 * i) = (bf16)f2bf(be * y[2][1]);
            *(LAS bf16*)(lds + CP_KGT + (2 * lane) * 144 + 2 * i) = (bf16)f2bf(bg * k0); *(LAS bf16*)(lds + CP_KGT + (2 * lane + 1) * 144 + 2 * i) = (bf16)f2bf(bg * k1);
        }
        __syncthreads();
        for (int jb = wave; jb < 32; jb += 8) { const int which = jb >> 4, mt = (jb >> 2) & 3, nt = jb & 3;
            f32x4 acc = (f32x4){0.f, 0.f, 0.f, 0.f};
            if (nt <= mt) {
#pragma unroll
                for (int ks = 0; ks < 4; ++ks) acc = mfma16(ld_frag16(lds + (which ? CP_QN : CP_KN) + (16 * mt + li) * 272 + (32 * ks + 8 * q) * 2), ld_frag16(lds + CP_KN + (16 * nt + li) * 272 + (32 * ks + 8 * q) * 2), acc);
            }
            const int j = 16 * nt + li; const float gj = tab[64 + j];
#pragma unroll
            for (int r = 0; r < 4; ++r) { const int i = 16 * mt + 4 * q + r; const float gi = tab[64 + i];
                if (which == 0) { ((LAS float*)(lds + CP_A32))[i * 64 + j] = (i > j) ? tab[i] * acc[r] * __expf(gi - gj) : 0.f; }
                else { *(LAS bf16*)(lds + CP_ATT + i * 144 + 2 * j) = (bf16)f2bf((i >= j) ? acc[r] * __expf(gi - gj) : 0.f); } }
        }
        __syncthreads();
        if (wave == 0) {
            float Tc[64]; const float lanef = (float)lane;
            const LAS float* A = (const LAS float*)(lds + CP_A32); asm volatile("" : "+v"(A));
            LAS unsigned char* Tw = lds + CP_T16 + 2 * lane; asm volatile("" : "+v"(Tw));
#pragma unroll
            for (int i = 0; i < 64; ++i) { float a = fmaxf(0.f, 1.f - fabsf((float)i - lanef));
#pragma unroll
                for (int j = 0; j < i; j += 4) { const f32x4 av = *(const LAS f32x4*)(A + i * 64 + j);
#pragma unroll
                    for (int jj = 0; jj < 4; ++jj) if (j + jj < i) a -= av[jj] * Tc[j + jj]; }
                Tc[i] = a; *(LAS bf16*)(Tw + i * 144) = (bf16)f2bf(a); }
        } else {
            const int t2 = tid - 64;
            for (int pc = t2; pc < 1024; pc += 448) { const int row = pc >> 4, seg = pc & 15; *(u32x4*)(rec + REC_Q + pc * 16) = *(const LAS u32x4*)(lds + CP_QN + row * 272 + seg * 16); }
            for (int pc = t2; pc < 512; pc += 448) { const int row = pc >> 3, seg = pc & 7; *(u32x4*)(rec + REC_ATT + pc * 16) = *(const LAS u32x4*)(lds + CP_ATT + row * 144 + seg * 16); }
            for (int pc = t2; pc < 1024; pc += 448) { const int row = pc >> 3, seg = pc & 7; *(u32x4*)(rec + REC_KT + pc * 16) = *(const LAS u32x4*)(lds + CP_KT + row * 144 + seg * 16); }
            if (t2 < 16) *(u32x4*)(rec + REC_G + t2 * 16) = *(const LAS u32x4*)(lds + CP_TAB + 256 + t2 * 16);
        }
        __syncthreads();
        for (int jb = wave; jb < 64; jb += 8) {
            f32x4 acc = (f32x4){0.f, 0.f, 0.f, 0.f};
            if (jb < 32) { const int mt = jb >> 3, nt = jb & 7;
#pragma unroll
                for (int ks = 0; ks < 2; ++ks) acc = mfma16(ld_frag16(lds + CP_T16 + (16 * mt + li) * 144 + (32 * ks + 8 * q) * 2), ld_frag16(lds + CP_VT + (16 * nt + li) * 144 + (32 * ks + 8 * q) * 2), acc);
                u32x2 o; o.x = pk2(acc[0], acc[1]); o.y = pk2(acc[2], acc[3]);
                *(u32x2*)(rec + REC_U + (size_t)((nt * 64 + lane) * 4 + mt) * 8) = o;
            } else { const int mt = (jb - 32) >> 2, nt = (jb - 32) & 3;
#pragma unroll
                for (int ks = 0; ks < 2; ++ks) acc = mfma16(ld_frag16(lds + CP_KGT + (16 * mt + li) * 144 + (32 * ks + 8 * q) * 2), ld_frag16(lds + CP_T16 + (16 * nt + li) * 144 + (32 * ks + 8 * q) * 2), acc);
                u32x2 o; o.x = pk2(acc[0], acc[1]); o.y = pk2(acc[2], acc[3]);
                *(u32x2*)(rec + REC_W + (size_t)((16 * nt + li) * 128 + 16 * mt + 4 * q) * 2) = o;
            }
        }
    }
    __syncthreads();
}
constexpr int SC_W = 0, SC_Q = 17408, SC_ATT = 34816, SC_KT = 44032, SC_G = 62464, SC_BUF = 62720;
__device__ __forceinline__ void gdn_chunk_scan(const Params& p, LAS unsigned char* lds, int tid, int wave, int lane, int bh) {
    const int b = bh >> 2, hh = bh & 3, q = lane >> 4, li = lane & 15;
    const unsigned char* rec0 = p.ws + WS_REC + (size_t)(bh * 64) * REC_BYTES;
    float* OB = (float*)(p.ws + WS_OBUF);
    u32x4 pf[7], pfg = (u32x4){0u, 0u, 0u, 0u}, pu[2];
#define SC_LOAD(nn) do { const unsigned char* r_ = rec0 + (size_t)(nn) * REC_BYTES; \
        _Pragma("unroll") for (int k_ = 0; k_ < 7; ++k_) pf[k_] = *(const u32x4*)(r_ + (size_t)(tid + 512 * k_) * 16); \
        if (tid < 16) pfg = *(const u32x4*)(r_ + REC_G + tid * 16); \
        pu[0] = *(const u32x4*)(r_ + REC_U + (size_t)(wave * 64 + lane) * 32); pu[1] = *(const u32x4*)(r_ + REC_U + (size_t)(wave * 64 + lane) * 32 + 16); } while (0)
#define SC_STORE(buf) do { LAS unsigned char* d_ = lds + (buf) * SC_BUF; \
        _Pragma("unroll") for (int k_ = 0; k_ < 4; ++k_) { const int pc_ = tid + 512 * (k_ & 1); *(LAS u32x4*)(d_ + (k_ < 2 ? SC_W : SC_Q) + (pc_ >> 4) * 272 + (pc_ & 15) * 16) = pf[k_]; } \
        { const int pc_ = tid; *(LAS u32x4*)(d_ + SC_ATT + (pc_ >> 3) * 144 + (pc_ & 7) * 16) = pf[4]; } \
        _Pragma("unroll") for (int k_ = 5; k_ < 7; ++k_) { const int pc_ = tid + 512 * (k_ - 5); *(LAS u32x4*)(d_ + SC_KT + (pc_ >> 3) * 144 + (pc_ & 7) * 16) = pf[k_]; } \
        if (tid < 16) *(LAS u32x4*)(d_ + SC_G + tid * 16) = pfg; } while (0)
    f32x4 S[8];
#pragma unroll
    for (int i = 0; i < 8; ++i) S[i] = (f32x4){0.f, 0.f, 0.f, 0.f};
    __syncthreads();
    SC_LOAD(0); SC_STORE(0);
    u32x4 cu[2]; cu[0] = pu[0]; cu[1] = pu[1];
    __syncthreads();
    for (int n = 0; n < 64; ++n) {
        const LAS unsigned char* L = lds + (n & 1) * SC_BUF;
        if (n + 1 < 64) SC_LOAD(n + 1);
        bf16x8 Sb[4];
#pragma unroll
        for (int ks = 0; ks < 4; ++ks) Sb[ks] = pack_frag(S[2 * ks], S[2 * ks + 1]);
        f32x4 a1[4], a2[4];
#pragma unroll
        for (int mt = 0; mt < 4; ++mt) { a1[mt] = (f32x4){0.f, 0.f, 0.f, 0.f}; a2[mt] = (f32x4){0.f, 0.f, 0.f, 0.f};
#pragma unroll
            for (int ks = 0; ks < 4; ++ks) { a1[mt] = mfma16(ld_frag8x2(L + SC_W + (16 * mt + li) * 272 + (32 * ks + 4 * q) * 2), Sb[ks], a1[mt]);
                a2[mt] = mfma16(ld_frag8x2(L + SC_Q + (16 * mt + li) * 272 + (32 * ks + 4 * q) * 2), Sb[ks], a2[mt]); } }
        const float g63 = *(const LAS float*)(L + SC_G + 63 * 4);
        f32x4 vn[4], vd[4], gam[4];
#pragma unroll
        for (int mt = 0; mt < 4; ++mt) { const f32x4 gi = *(const LAS f32x4*)(L + SC_G + (16 * mt + 4 * q) * 4);
            const unsigned ulo = (mt < 2) ? (mt == 0 ? cu[0].x : cu[0].z) : (mt == 2 ? cu[1].x : cu[1].z), uhi = (mt < 2) ? (mt == 0 ? cu[0].y : cu[0].w) : (mt == 2 ? cu[1].y : cu[1].w);
            const f32x4 uu = (f32x4){bf_lo(ulo), bf_hi(ulo), bf_lo(uhi), bf_hi(uhi)};
            vn[mt] = uu - a1[mt];
#pragma unroll
            for (int r = 0; r < 4; ++r) { gam[mt][r] = __expf(gi[r]); vd[mt][r] = vn[mt][r] * __expf(g63 - gi[r]); } }
        bf16x8 Vb[2], Vd[2];
#pragma unroll
        for (int ks = 0; ks < 2; ++ks) { Vb[ks] = pack_frag(vn[2 * ks], vn[2 * ks + 1]); Vd[ks] = pack_frag(vd[2 * ks], vd[2 * ks + 1]); }
#pragma unroll
        for (int mt = 0; mt < 4; ++mt) { f32x4 a3 = (f32x4){0.f, 0.f, 0.f, 0.f};
#pragma unroll
            for (int ks = 0; ks < 2; ++ks) a3 = mfma16(ld_frag8x2(L + SC_ATT + (16 * mt + li) * 144 + (32 * ks + 4 * q) * 2), Vb[ks], a3);
#pragma unroll
            for (int r = 0; r < 4; ++r) OB[(size_t)(b * T + n * 64 + 16 * mt + 4 * q + r) * 512 + hh * 128 + 16 * wave + li] = gam[mt][r] * a2[mt][r] + a3[r]; }
        const float eg = __expf(g63);
#pragma unroll
        for (int mt = 0; mt < 8; ++mt) { f32x4 a4 = (f32x4){0.f, 0.f, 0.f, 0.f};
#pragma unroll
            for (int ks = 0; ks < 2; ++ks) a4 = mfma16(ld_frag8x2(L + SC_KT + (16 * mt + li) * 144 + (32 * ks + 4 * q) * 2), Vd[ks], a4);
            S[mt] = S[mt] * eg + a4; }
        if (n + 1 < 64) { SC_STORE((n + 1) & 1); cu[0] = pu[0]; cu[1] = pu[1]; }
        __syncthreads();
    }
#undef SC_LOAD
#undef SC_STORE
}

__device__ __forceinline__ void gdn_out(const Params& p, int layer, int gw, int NGW, int lane) {
    const bf16* H = (const bf16*)(p.ws + WS_H); bf16* YS = (bf16*)(p.ws + WS_YS); const float* OB = (const float*)(p.ws + WS_OBUF);
    const float w0 = p.in[I_GNW][layer * 128 + 2 * lane], w1 = p.in[I_GNW][layer * 128 + 2 * lane + 1];
    for (int it = gw; it < M * 4; it += NGW) { const int m = it >> 2, hh = it & 3;
        f32x2 o = *(const f32x2*)(OB + (size_t)m * 512 + hh * 128 + 2 * lane);
        const float rs = 1.0f / sqrtf(wave_sum(o[0] * o[0] + o[1] * o[1]) * (1.0f / 128.0f) + EPS);
        const unsigned zw = *(const unsigned*)(H + (size_t)m * DH + HZ + hh * 128 + 2 * lane);
        *(unsigned*)(YS + (size_t)m * 2048 + hh * 128 + 2 * lane) = pk2(o[0] * rs * w0 * siluf_(bf_lo(zw)), o[1] * rs * w1 * siluf_(bf_hi(zw)));
    }
}
__device__ __forceinline__ void sum_gated(const Params& p, int gtid, int NGT) {
    const bf16* H = (const bf16*)(p.ws + WS_H); bf16* MG = (bf16*)(p.ws + WS_MERGED);
    for (int it = gtid; it < M * 128; it += NGT) { const int m = it >> 7, c8 = (it & 127) * 8; const bf16* r = H + (size_t)m * DH + HGATE + c8;
        float a[8], b[8];
        unpack8(*(const u32x4*)r, a);
#pragma unroll
        for (int br = 1; br < 4; ++br) { unpack8(*(const u32x4*)(r + br * 1024), b);
#pragma unroll
            for (int i = 0; i < 8; ++i) a[i] += b[i]; }
        *(u32x4*)(MG + (size_t)m * D + c8) = pack8(a); }
}

__device__ __forceinline__ void moe_route(const Params& p, int layer, LAS unsigned char* lds, int tid, int wave, int lane) {
    LAS float* xs = (LAS float*)lds;
    LAS int* hist = (LAS int*)(lds + LDSCTL_OFF + LC_TAB);
    bf16* XN = (bf16*)(p.ws + WS_XN);
    int* route_e = (int*)(p.ws + WS_ROUTE); float* route_w = (float*)(p.ws + WS_ROUTE + (size_t)M * 2 * 4);
    int* cnt = (int*)(p.ws + WS_MOETAB + (size_t)NROWS_MAX * 8);
    const float* rg = p.in[I_RGRP] + (size_t)layer * D * 8; const float* re = p.in[I_REXP] + (size_t)layer * D * 64;
    f32x4 nw[4];
#pragma unroll
    for (int j = 0; j < 4; ++j) nw[j] = *(const f32x4*)(p.in[I_MOENW] + layer * D + 4 * lane + 256 * j);
    for (int vb = blockIdx.x; vb < M / 128; vb += gridDim.x) {
        if (tid < 64) hist[tid] = 0;
        for (int tile = 0; tile < 4; ++tile) {
            const int m0 = vb * 128 + tile * 32;
            __syncthreads();
            for (int r = wave * 4; r < wave * 4 + 4; ++r) { const int m = m0 + r; const float* xr = p.out + (size_t)m * D;
                f32x4 v[4]; float ss = 0.f;
#pragma unroll
                for (int j = 0; j < 4; ++j) { v[j] = *(const f32x4*)(xr + 4 * lane + 256 * j); ss += (v[j][0] * v[j][0] + v[j][1] * v[j][1]) + (v[j][2] * v[j][2] + v[j][3] * v[j][3]); }
                const float rs = 1.0f / sqrtf(wave_sum(ss) * (1.0f / D) + EPS);
#pragma unroll
                for (int j = 0; j < 4; ++j) { v[j] = v[j] * rs * nw[j]; *(LAS f32x4*)(xs + r * 1024 + 4 * lane + 256 * j) = v[j];
                    u32x2 o; o.x = pk2(v[j][0], v[j][1]); o.y = pk2(v[j][2], v[j][3]); *(u32x2*)(XN + (size_t)m * D + 4 * lane + 256 * j) = o; } }
            __syncthreads();
            float ae[32], ag[32];
#pragma unroll
            for (int r = 0; r < 32; ++r) { ae[r] = 0.f; ag[r] = 0.f; }
            for (int k = wave * 128; k < wave * 128 + 128; k += 4) {
                float we[4], wg[4];
#pragma unroll
                for (int q = 0; q < 4; ++q) { we[q] = re[(size_t)(k + q) * 64 + lane]; wg[q] = rg[(size_t)(k + q) * 8 + (lane & 7)]; }
#pragma unroll
                for (int r = 0; r < 32; ++r) { const f32x4 x = *(const LAS f32x4*)(xs + r * 1024 + k);
                    ae[r] += x[0] * we[0] + x[1] * we[1] + x[2] * we[2] + x[3] * we[3];
                    ag[r] += x[0] * wg[0] + x[1] * wg[1] + x[2] * wg[2] + x[3] * wg[3]; }
            }
            __syncthreads();
            LAS float* part = xs;
#pragma unroll
            for (int r = 0; r < 32; ++r) { part[(wave * 32 + r) * 72 + lane] = ae[r]; if (lane < 8) part[(wave * 32 + r) * 72 + 64 + lane] = ag[r]; }
            __syncthreads();
            for (int r = wave * 4; r < wave * 4 + 4; ++r) { const int m = m0 + r;
                float le = 0.f, lg = 0.f;
#pragma unroll
                for (int w = 0; w < 8; ++w) { le += part[(w * 32 + r) * 72 + lane]; lg += part[(w * 32 + r) * 72 + 64 + (lane & 7)]; }
                float gv[8];
#pragma unroll
                for (int i = 0; i < 8; ++i) gv[i] = __shfl(lg, i);
                int grp = 0; float gmax = gv[0];
#pragma unroll
                for (int i = 1; i < 8; ++i) if (gv[i] > gmax) { gmax = gv[i]; grp = i; }
                float gs = 0.f;
#pragma unroll
                for (int i = 0; i < 8; ++i) gs += __expf(gv[i] - gmax);
                const float psel = 1.0f / gs;
                float ev[8];
#pragma unroll
                for (int i = 0; i < 8; ++i) ev[i] = __shfl(le, grp * 8 + i);
                int i1 = 0; float e1 = ev[0];
#pragma unroll
                for (int i = 1; i < 8; ++i) if (ev[i] > e1) { e1 = ev[i]; i1 = i; }
                int i2 = -1; float e2 = -3.0e38f;
#pragma unroll
                for (int i = 0; i < 8; ++i) if (i != i1 && ev[i] > e2) { e2 = ev[i]; i2 = i; }
                const float x2 = __expf(e2 - e1), w1 = psel / (1.0f + x2), w2 = psel * x2 / (1.0f + x2);
                if (lane == 0) { route_e[(size_t)m * 2] = grp * 8 + i1; route_e[(size_t)m * 2 + 1] = grp * 8 + i2; route_w[(size_t)m * 2] = w1; route_w[(size_t)m * 2 + 1] = w2;
                    atomicAdd((int*)(hist + grp * 8 + i1), 1); atomicAdd((int*)(hist + grp * 8 + i2), 1); }
            }
        }
        __syncthreads();
        if (tid < 64) cnt[vb * 64 + tid] = hist[tid];
        __syncthreads();
    }
}
__device__ __forceinline__ void moe_dispatch(const Params& p, LAS unsigned char* lds, int tid, int wave, int lane) {
    LAS int* tab = (LAS int*)(lds + LDSCTL_OFF + LC_TAB);
    const bf16* XN = (const bf16*)(p.ws + WS_XN); bf16* XS = (bf16*)(p.ws + WS_XS);
    const int* route_e = (const int*)(p.ws + WS_ROUTE); const float* route_w = (const float*)(p.ws + WS_ROUTE + (size_t)M * 2 * 4);
    int* row_code = (int*)(p.ws + WS_MOETAB); float* row_w = (float*)(p.ws + WS_MOETAB + (size_t)NROWS_MAX * 4);
    const int* cnt = (const int*)(p.ws + WS_MOETAB + (size_t)NROWS_MAX * 8); int* blk_e = (int*)(p.ws + WS_MOETAB + (size_t)NROWS_MAX * 8 + 256 * 64 * 4);
    for (int vb = blockIdx.x; vb < M / 128; vb += gridDim.x) {
        __syncthreads();
        if (tid < 64) { int run = 0, base = 0; for (int v = 0; v < M / 128; ++v) { if (v == vb) base = run; run += cnt[v * 64 + tid]; } tab[64 + tid] = run; tab[128 + tid] = base; }
        __syncthreads();
        if (tid == 0) { int s = 0; for (int e = 0; e < 64; ++e) { tab[e] = s; s += (tab[64 + e] + 255) / 256 * 256; } tab[704] = s; }
        if (tid < 256) tab[192 + tid] = route_e[(size_t)vb * 256 + tid];
        __syncthreads();
        if (tid < 256) { const int e = tab[192 + tid]; int rank = 0; for (int a = 0; a < tid; ++a) rank += (tab[192 + a] == e) ? 1 : 0;
            const int pos = tab[e] + tab[128 + e] + rank; tab[448 + tid] = pos;
            row_code[pos] = ((vb * 128 + (tid >> 1)) << 1) | (tid & 1); row_w[pos] = route_w[(size_t)vb * 256 + tid]; }
        if (vb < 64) { const int ps = tab[vb], tot = tab[64 + vb], pe = ps + (tot + 255) / 256 * 256;
            for (int r = ps + tot + tid; r < pe; r += 512) row_code[r] = -1;
            for (int b = ps / 256 + tid; b < pe / 256; b += 512) blk_e[b] = vb;
            if (vb == 63 && tid == 0) blk_e[NROWBLK_MAX] = tab[704] / 256; }
        __syncthreads();
        for (int a = wave; a < 256; a += 8) { const int pos = tab[448 + a]; const int tok = vb * 128 + (a >> 1);
            const u32x4* src = (const u32x4*)(XN + (size_t)tok * D); u32x4* dst = (u32x4*)(XS + (size_t)pos * D);
            dst[lane] = src[lane]; dst[lane + 64] = src[lane + 64]; }
    }
    __syncthreads();
}

__global__ void __launch_bounds__(512, 2) fwd(Params p) {
    extern __shared__ __attribute__((aligned(16))) unsigned char lds_raw[];
    LAS unsigned char* lds = (LAS unsigned char*)lds_raw;
    const int tid0 = threadIdx.x;
    const int G = gridDim.x, NGW = G * 8, NGT = G * 512;
#define FRESH() int tid = tid0; asm volatile("" : "+v"(tid)); const int lane = tid & 63, wave = __builtin_amdgcn_readfirstlane(tid >> 6); const int gw = blockIdx.x * 8 + wave, gtid = blockIdx.x * 512 + tid; (void)lane; (void)gw; (void)gtid
    for (int u = tid0; u < (LDS_BYTES - LDSCTL_OFF) / 4; u += 512) ((LAS unsigned*)(lds + LDSCTL_OFF))[u] = 0u;
    __syncthreads();
    const int lo = p.ph_lo, hi = p.ph_hi;
    XcdBarrier bar; bar.bar = (unsigned*)(p.ws + WS_CTL) + CW_BAR; bar.x = 0; bar.st = (volatile LAS unsigned*)(lds + LDSCTL_OFF + LC_BAR);
    if (hi - lo > 1) bar = xcd_barrier_post((unsigned*)(p.ws + WS_CTL) + CW_BAR, (volatile LAS unsigned*)(lds + LDSCTL_OFF + LC_BAR));
#ifndef PHASE_MASK
#define PHASE_MASK 0x1fff
#endif
#define IN(k) (((PHASE_MASK >> ((k) == PH_FINAL ? 12 : ((k) % PH_PER_LAYER))) & 1) && lo <= (k) && (k) < hi)
#define REPS(k) ((((REPEAT_MASK) >> (k)) & 1) && layer == 0 ? 2 : 1)
#define SEAM(k) do { if (IN(k) && IN((k) + 1)) xcd_barrier(bar); } while (0)

    for (int layer = 0; layer < NLAYER; ++layer) {
        const int g0 = layer * PH_PER_LAYER;
        bf16* Hb = (bf16*)(p.ws + WS_H);
        for (int rep_ = 0; rep_ < REPS(0); ++rep_) if (IN(g0 + 0)) { if (rep_) __syncthreads(); FRESH();
            if (layer == 0) { prep_static_weights(p, lds, gw, NGW, wave, lane); __syncthreads(); norm_phase<0>(p, layer, lds, gw, NGW, tid, lane); }
            else norm_phase<1>(p, layer, lds, gw, NGW, tid, lane);
        }
        SEAM(g0 + 0);
        for (int rep_ = 0; rep_ < REPS(1); ++rep_) if (IN(g0 + 1)) { if (rep_) __syncthreads(); FRESH();
            SchedH S; S.to.init(M / 256, DH / 256, G, (int)blockIdx.x); S.A = (const char*)(p.ws + WS_XN); S.B = (const char*)(p.ws + WS_WIN + layer * WIN_L);
            EpiStoreBf16 E{Hb, DH};
            pg8::gemm_phase(lds, tid, D, D, D, S, E);
        }
        SEAM(g0 + 1);
        for (int rep_ = 0; rep_ < REPS(2); ++rep_) if (IN(g0 + 2)) { if (rep_) __syncthreads(); FRESH(); gdn_chunk_prep(p, layer, lds, tid, wave, lane); }
        SEAM(g0 + 2);
        for (int rep_ = 0; rep_ < REPS(3); ++rep_) if (IN(g0 + 3)) { if (rep_) __syncthreads(); FRESH();
            if ((int)blockIdx.x < 32) gdn_chunk_scan(p, lds, tid, wave, lane, (int)blockIdx.x);
            else { const int vb = (int)blockIdx.x - 32, nvb = G - 32;
                shortconv(p, layer, vb * 512 + tid, nvb * 512);
                conformer(p, layer, lds, tid, wave, lane, vb, nvb);
                __syncthreads();
                gmlp(p, layer, lds, tid, wave, lane, vb, nvb); }
        }
        SEAM(g0 + 3);
        for (int rep_ = 0; rep_ < REPS(4); ++rep_) if (IN(g0 + 4)) { if (rep_) __syncthreads(); FRESH(); gdn_out(p, layer, gw, NGW, lane); }
        SEAM(g0 + 4);
        if (IN(g0 + 5)) { FRESH();
            SchedBranch S; S.to.init(M / 256, 16, G, (int)blockIdx.x); S.YS = (const char*)(p.ws + WS_YS); S.WBR = (const char*)(p.ws + WS_WBR + layer * WBR_L);
            EpiGate E{Hb, DH};
            pg8::gemm_phase(lds, tid, 512, 2048, 512, S, E);
        }
        SEAM(g0 + 5);
        for (int rep_ = 0; rep_ < REPS(6); ++rep_) if (IN(g0 + 6)) { if (rep_) __syncthreads(); FRESH(); sum_gated(p, gtid, NGT); }
        SEAM(g0 + 6);
        for (int rep_ = 0; rep_ < REPS(7); ++rep_) if (IN(g0 + 7)) { if (rep_) __syncthreads(); FRESH();
            SchedOut S; S.to.init(M / 256, 4, G, (int)blockIdx.x); S.A = (const char*)(p.ws + WS_MERGED); S.B = (const char*)(p.ws + WS_WOUT + layer * WOUT_L);
            EpiResF32 E{layer == 0 ? p.in[I_X] : p.out, p.out};
            pg8::gemm_phase(lds, tid, D, D, D, S, E);
            __syncthreads();
            prep_moe_weights(p, layer, lds, gw, NGW, wave, lane);
        }
        SEAM(g0 + 7);
        for (int rep_ = 0; rep_ < REPS(8); ++rep_) if (IN(g0 + 8)) { if (rep_) __syncthreads(); FRESH(); moe_route(p, layer, lds, tid, wave, lane); }
        SEAM(g0 + 8);
        for (int rep_ = 0; rep_ < REPS(9); ++rep_) if (IN(g0 + 9)) { if (rep_) __syncthreads(); FRESH(); moe_dispatch(p, lds, tid, wave, lane); }
        SEAM(g0 + 9);
        if (IN(g0 + 10) || IN(g0 + 11)) { FRESH();
            LAS int* lblk = (LAS int*)(lds + LDSCTL_OFF + LC_TAB);
            const int* blk_e = (const int*)(p.ws + WS_MOETAB + (size_t)NROWS_MAX * 8 + 256 * 64 * 4);
            __syncthreads();
            for (int i = tid; i <= NROWBLK_MAX; i += 512) lblk[i] = blk_e[i];
            __syncthreads();
        }
        for (int rep_ = 0; rep_ < REPS(10); ++rep_) if (IN(g0 + 10)) { if (rep_) __syncthreads(); FRESH();
            LAS int* lblk = (LAS int*)(lds + LDSCTL_OFF + LC_TAB);
            SchedMoe S; S.nunits = lblk[NROWBLK_MAX] * 4; S.G = G; S.c = (int)blockIdx.x; S.blk_e = lblk; S.A = (const char*)(p.ws + WS_XS); S.a_blk = (size_t)256 * D * 2;
            S.W = (const char*)(p.ws + WS_MOEW); S.w_e = WGU_E; S.w_pn = (size_t)256 * D * 2; S.cmul = 128;
            EpiSwiglu E{(bf16*)(p.ws + WS_HB)};
            pg8::gemm_phase(lds, tid, D, D, D, S, E);
        }
        SEAM(g0 + 10);
        for (int rep_ = 0; rep_ < REPS(11); ++rep_) if (IN(g0 + 11)) { if (rep_) __syncthreads(); FRESH();
            LAS int* lblk = (LAS int*)(lds + LDSCTL_OFF + LC_TAB);
            SchedMoe S; S.nunits = lblk[NROWBLK_MAX] * 4; S.G = G; S.c = (int)blockIdx.x; S.blk_e = lblk; S.A = (const char*)(p.ws + WS_HB); S.a_blk = (size_t)256 * DE * 2;
            S.W = (const char*)(p.ws + WS_WD); S.w_e = WD_E; S.w_pn = (size_t)256 * DE * 2; S.cmul = 256;
            EpiScatter E{(bf16*)(p.ws + WS_Y), (const int*)(p.ws + WS_MOETAB), (const float*)(p.ws + WS_MOETAB + (size_t)NROWS_MAX * 4)};
            pg8::gemm_phase(lds, tid, DE, DE, DE, S, E);
        }
        SEAM(g0 + 11);
    }
    if (IN(PH_FINAL)) { FRESH(); norm_phase<2>(p, 0, lds, gw, NGW, tid, lane); }
#undef IN
#undef SEAM
}

extern "C" void kernel_launch(void* const* d_in, const int* in_sizes, int n_in, void* d_out, int out_size, void* d_ws, size_t ws_size, hipStream_t stream) {
    static int grid = 0;
    if (grid == 0) {
        if (n_in != 25 || out_size != M * D || ws_size < WS_END) { fprintf(stderr, "kernel_launch: unexpected shapes / workspace (n_in %d out %d ws %zu, need %zu)\n", n_in, out_size, ws_size, (size_t)WS_END); grid = -1; return; }
        int dev = 0, cus = 0, per_cu = 0;
        if (hipGetDevice(&dev) != hipSuccess || hipDeviceGetAttribute(&cus, hipDeviceAttributeMultiprocessorCount, dev) != hipSuccess) { grid = -1; return; }
        if (hipFuncSetAttribute((const void*)fwd, hipFuncAttributeMaxDynamicSharedMemorySize, LDS_BYTES) != hipSuccess) { fprintf(stderr, "kernel_launch: hipFuncSetAttribute failed\n"); grid = -1; return; }
        if (hipOccupancyMaxActiveBlocksPerMultiprocessor(&per_cu, (const void*)fwd, 512, LDS_BYTES) != hipSuccess || per_cu < 1) { fprintf(stderr, "kernel_launch: occupancy query says %d\n", per_cu); }
        (void)hipGetLastError();
        grid = cus;
    }
    if (grid < 0) return;
    hipMemsetAsync((char*)d_ws + WS_CTL, 0, CTL_BYTES, stream);
    Params p{};
    for (int i = 0; i < 25; ++i) p.in[i] = (const float*)d_in[i];
    p.out = (float*)d_out; p.ws = (unsigned char*)d_ws;
#if N_LAUNCH_MODE == 1
    p.ph_lo = 0; p.ph_hi = PH_TOTAL;
    hipLaunchKernelGGL(fwd, dim3(grid), dim3(512), LDS_BYTES, stream, p);
#else
    for (int k = 0; k < PH_TOTAL; ++k) { p.ph_lo = k; p.ph_hi = k + 1; hipLaunchKernelGGL(fwd, dim3(grid), dim3(512), LDS_BYTES, stream, p); }
#endif
}
```

```cpp
#include <hip/hip_runtime.h>
#include <cstdio>
#include <cstdint>

#ifndef REPEAT_MASK
#define REPEAT_MASK 0
#endif
#ifndef N_LAUNCH_MODE
#define N_LAUNCH_MODE 1
#endif

#define LAS __attribute__((address_space(3)))
typedef unsigned short bf16;
typedef short bf16x8 __attribute__((ext_vector_type(8)));
typedef float f32x4 __attribute__((ext_vector_type(4)));
typedef float f32x2 __attribute__((ext_vector_type(2)));
typedef unsigned u32x4 __attribute__((ext_vector_type(4)));
typedef unsigned u32x2 __attribute__((ext_vector_type(2)));

constexpr int NB = 8, T = 4096, D = 1024, M = NB * T, NLAYER = 2;
constexpr int DIN = 9736, DH = 9728;
constexpr int HQ = 0, HK = 512, HV = 1024, HZ = 1536, HCONF = 2048, HGMLP = 3072, HSC = 4096, HGATE = 5632;
constexpr int NE = 64, DE = 512;
constexpr float EPS = 1e-6f;
constexpr int NROWBLK_MAX = 320, NROWS_MAX = NROWBLK_MAX * 256;

constexpr size_t MiB = 1u << 20;
constexpr size_t WS_CTL = 0, CTL_BYTES = 1 * MiB;
constexpr size_t WS_WIN = 2 * MiB;
constexpr size_t WIN_L = (size_t)DH * D * 2;
constexpr size_t WS_WBR = 40 * MiB;
constexpr size_t WBR_L = (size_t)4 * D * 512 * 2;
constexpr size_t WS_WOUT = 48 * MiB;
constexpr size_t WOUT_L = (size_t)D * D * 2;
constexpr size_t WS_XN = 52 * MiB;
constexpr size_t WS_SMALL = 116 * MiB;
constexpr size_t WS_ROUTE = 117 * MiB;
constexpr size_t WS_MOETAB = 118 * MiB;
constexpr size_t WS_YS = 120 * MiB;
constexpr size_t WS_REC = 248 * MiB;
constexpr size_t WS_MERGED = WS_REC;
constexpr size_t WS_OBUF = WS_XN;
constexpr int REC_W = 0, REC_Q = 16384, REC_ATT = 32768, REC_KT = 40960, REC_U = 57344, REC_G = 73728, REC_BYTES = 73984;
static_assert(WS_REC + (size_t)2048 * REC_BYTES <= 410 * MiB, "chunk records");
constexpr size_t WS_H = 410 * MiB;
constexpr size_t WS_MOEW = 410 * MiB;
constexpr size_t WGU_E = (size_t)1024 * 1024 * 2, WD_E = (size_t)1024 * 512 * 2;
constexpr size_t WS_WD = WS_MOEW + 64 * WGU_E;
constexpr size_t WS_XS = 602 * MiB;
constexpr size_t WS_HB = 762 * MiB;
constexpr size_t WS_Y = 842 * MiB;
constexpr size_t WS_END = 1018 * MiB;
static_assert(WS_H + (size_t)M * DH * 2 <= WS_END && WS_Y + (size_t)2 * M * D * 2 <= WS_END, "ws map");

constexpr int CW_BAR = 4096;
constexpr int STAGE_LDS = 131072, LDSCTL_OFF = 131072, LDS_BYTES = 147456;
constexpr int LC_BAR = 0;
constexpr int LC_MISC = 64;
constexpr int LC_TAB = 1024;

__device__ __forceinline__ float bf_lo(unsigned w) { return __uint_as_float(w << 16); }
__device__ __forceinline__ float bf_hi(unsigned w) { return __uint_as_float(w & 0xffff0000u); }
__device__ __forceinline__ float bf2f(bf16 b) { return __uint_as_float(((unsigned)b) << 16); }
__device__ __forceinline__ unsigned f2bf(float f) { unsigned u = __float_as_uint(f); return (u + 0x7fffu + ((u >> 16) & 1u)) >> 16; }
__device__ __forceinline__ unsigned pk2(float lo, float hi) { return f2bf(lo) | (f2bf(hi) << 16); }
__device__ __forceinline__ void unpack8(const u32x4 v, float (&f)[8]) {
    f[0] = bf_lo(v.x); f[1] = bf_hi(v.x); f[2] = bf_lo(v.y); f[3] = bf_hi(v.y); f[4] = bf_lo(v.z); f[5] = bf_hi(v.z); f[6] = bf_lo(v.w); f[7] = bf_hi(v.w);
}
__device__ __forceinline__ u32x4 pack8(const float (&f)[8]) { u32x4 o; o.x = pk2(f[0], f[1]); o.y = pk2(f[2], f[3]); o.z = pk2(f[4], f[5]); o.w = pk2(f[6], f[7]); return o; }
__device__ __forceinline__ float wave_sum(float v) {
#pragma unroll
    for (int o = 1; o < 64; o <<= 1) v += __shfl_xor(v, o);
    return v;
}
__device__ __forceinline__ float fexp(float x) { return __builtin_amdgcn_exp2f(x * 1.4426950408889634f); }
__device__ __forceinline__ float frcp(float x) { return __builtin_amdgcn_rcpf(x); }
__device__ __forceinline__ float sigmoidf_(float x) { return frcp(1.0f + fexp(-x)); }
__device__ __forceinline__ float siluf_(float x) { return x * frcp(1.0f + fexp(-x)); }
__device__ __forceinline__ float gelu_tanh(float x) { const float u = 0.7978845608028654f * (x + 0.044715f * x * x * x); return x * frcp(1.0f + fexp(-2.0f * u)); }
__device__ __forceinline__ float softplusf_(float x) { return fmaxf(x, 0.f) + log1pf(__expf(-fabsf(x))); }

#define XB_TMO      128
#define XB_XCNT(j)  (256  + 64 * (j))
#define XB_XSUB(j)  (1280 + 64 * (j))
#define XB_XGEN(j)  (2304 + 64 * (j))
#define XB_TOP      3328
#define XB_TOPGEN   3392
#define XCD_BAR_WORDS 3456
#define XB_SPIN_CAP (1u << 18)
__device__ __forceinline__ unsigned xb_ld(unsigned* p)              { return __hip_atomic_load(p, __ATOMIC_RELAXED, __HIP_MEMORY_SCOPE_AGENT); }
__device__ __forceinline__ unsigned xb_add(unsigned* p, unsigned v) { return __hip_atomic_fetch_add(p, v, __ATOMIC_RELAXED, __HIP_MEMORY_SCOPE_AGENT); }
__device__ __forceinline__ unsigned xb_xcc_id() { return (unsigned)__builtin_amdgcn_s_getreg((3 << 11) | 20) & 0xFu; }
#define XB_SPIN(cond, bar) do { unsigned _sp = 0; while (cond) { __builtin_amdgcn_s_sleep(1); \
    if ((++_sp & 255u) == 0u) { if (xb_ld(&(bar)[XB_TMO])) break; if (_sp > XB_SPIN_CAP) { atomicAdd(&(bar)[XB_TMO], 1u); break; } } } } while (0)
struct XcdBarrier { unsigned* bar; unsigned x; volatile LAS unsigned* st; };
__device__ __forceinline__ XcdBarrier xcd_barrier_post(unsigned* bar, volatile LAS unsigned* st) {
    XcdBarrier b; b.bar = bar; b.x = xb_xcc_id(); b.st = st;
    if (threadIdx.x == 0) (void)xb_add(&bar[XB_XCNT(b.x)], 1u);
    return b;
}
__device__ __forceinline__ void xcd_barrier_complete(unsigned* bar, unsigned x, unsigned& nloc, unsigned& nx) {
    const unsigned G = gridDim.x * gridDim.y * gridDim.z;
    unsigned sum, cnt, mine, sp = 0u;
    for (;;) {
        sum = 0u; cnt = 0u; mine = 0u;
#pragma unroll
        for (unsigned j = 0; j < 16; ++j) { const unsigned c = xb_ld(&bar[XB_XCNT(j)]); sum += c; cnt += (c > 0u) ? 1u : 0u; mine = (j == x) ? c : mine; }
        if (sum == G) break;
        __builtin_amdgcn_s_sleep(1);
        if ((++sp & 255u) == 0u) { if (xb_ld(&bar[XB_TMO])) break; if (sp > XB_SPIN_CAP) { atomicAdd(&bar[XB_TMO], 1u); break; } }
    }
    nloc = mine > 0u ? mine : 1u; nx = cnt > 0u ? cnt : 1u;
}
__device__ __forceinline__ void xcd_barrier(const XcdBarrier& b) {
    asm volatile("s_waitcnt vmcnt(0)" ::: "memory");
    __syncthreads();
    if (threadIdx.x == 0) {
        unsigned* bar = b.bar;
        __builtin_amdgcn_s_waitcnt(0);
        unsigned nloc = b.st[0], nx = b.st[1];
        if (nloc == 0u) { xcd_barrier_complete(bar, b.x, nloc, nx); b.st[0] = nloc; b.st[1] = nx; }
        const unsigned old = xb_add(&bar[XB_XSUB(b.x)], 1u);
        const unsigned gen = old / nloc;
        if (old + 1u == (gen + 1u) * nloc) {
            __builtin_amdgcn_fence(__ATOMIC_RELEASE, "agent");
            asm volatile("s_waitcnt vmcnt(0)" ::: "memory");
            const unsigned og = xb_add(&bar[XB_TOP], 1u);
            const unsigned tg = og / nx;
            if (og + 1u == (tg + 1u) * nx) xb_add(&bar[XB_TOPGEN], 1u);
            else XB_SPIN(xb_ld(&bar[XB_TOPGEN]) == tg, bar);
            __builtin_amdgcn_fence(__ATOMIC_ACQUIRE, "agent");
            xb_add(&bar[XB_XGEN(b.x)], 1u);
            asm volatile("s_waitcnt vmcnt(0)" ::: "memory");
        } else {
            XB_SPIN(xb_ld(&bar[XB_XGEN(b.x)]) == gen, bar);
            __builtin_amdgcn_fence(__ATOMIC_ACQUIRE, "agent");
            asm volatile("s_waitcnt vmcnt(0)" ::: "memory");
        }
    }
    __syncthreads();
}

namespace pg8 {
constexpr int BM = 256, BK = 64, HALF = 128, HTB = HALF * BK * 2, STAGE_BYTES = 8 * HTB, NXCD = 8, WGM = 8;
__host__ __device__ __forceinline__ int lds_byte(int r, int c) { const int st = (r >> 4) * 2 + (c >> 5), rr = r & 15, cc = c & 31, ob = rr * 64 + cc * 2; return st * 1024 + (ob ^ (((ob >> 9) & 1) << 5)); }
__host__ __device__ __forceinline__ void stage_rc(int b, int& R, int& C) { const int st = b / 1024, sb = b % 1024, swz = sb ^ (((sb >> 9) & 1) << 5); R = (st >> 1) * 16 + swz / 64; C = (st & 1) * 32 + (swz % 64) / 2; }
__host__ __device__ __forceinline__ int perm32(int rho) { const int n = rho >> 4, i = rho & 15; return 8 * (i >> 2) + 4 * n + (i & 3); }

struct Unit { const char* A; const char* B; int r0, c0; };

struct TileOrder {
    int nM, nN, nwg, G, c;
    __device__ void init(int nM_, int nN_, int G_, int c_) { nM = nM_; nN = nN_; nwg = nM * nN; G = G_; c = c_; }
    __device__ bool next(int i, int& pm, int& pn) const {
        const long L = (long)i * G + c; if (L >= nwg) return false;
        int wgid = (int)L; { const int q = nwg / NXCD, r = nwg % NXCD, xcd = wgid % NXCD, off = wgid / NXCD; wgid = (xcd < r ? xcd * (q + 1) : r * (q + 1) + (xcd - r) * q) + off; }
        const int nig = WGM * nN, gid = wgid / nig, fm = gid * WGM, gsz = (nM - fm) < WGM ? (nM - fm) : WGM;
        pm = fm + ((wgid % nig) % gsz); pn = (wgid % nig) / gsz; return true;
    }
};
__device__ __forceinline__ unsigned cvt_pk_bf16(float lo, float hi) { unsigned r; asm volatile("v_cvt_pk_bf16_f32 %0, %1, %2" : "=v"(r) : "v"(lo), "v"(hi)); return r; }

template <class Epi, class Sched>
__device__ __forceinline__ void gemm_phase(LAS unsigned char* lds, const int tid, const int K, const int lda, const int ldb, const Sched& S, const Epi& E) {
    const int wid = __builtin_amdgcn_readfirstlane(tid >> 6), lane = tid & 63, wr = wid >> 2, wc = wid & 3, fr = lane & 15, fq = lane >> 4;
    const int nt = K / BK;
    unsigned voffA[2], voffB[2];
#pragma unroll
    for (int i = 0; i < 2; ++i) { int R, C; stage_rc(tid * 16 + i * 8192, R, C); const int Rb = Epi::PERM ? ((R & ~31) + perm32(R & 31)) : R;
        voffA[i] = (unsigned)(R * lda + C) * 2u; voffB[i] = (unsigned)(Rb * ldb + C) * 2u; }
    const size_t kstep = (size_t)(BK * 2);
    const size_t hstepA = (size_t)HALF * lda * 2, hstepB = (size_t)HALF * ldb * 2;
    const unsigned ldsw = (unsigned)wid * 1024u;
    const int aoff = lds_byte(wr * 64 + fr, fq * 8), boff = lds_byte(wc * 32 + fr, fq * 8);
#define PG8_SA(b, h) (((b) * 2 + (h)) * HTB)
#define PG8_SB(b, h) ((4 + (b) * 2 + (h)) * HTB)
#define PG8_STAGE(bufoff, gbase, voff) do { _Pragma("unroll") for (int _i = 0; _i < 2; ++_i) \
        __builtin_amdgcn_global_load_lds((const unsigned*)((const char*)(gbase) + (voff)[_i]), (LAS unsigned*)(lds + (bufoff) + ldsw + _i * 8192), 16, 0, 0); } while (0)
#define PG8_LDA(dst, b, h) do { _Pragma("unroll") for (int m = 0; m < 4; ++m) _Pragma("unroll") for (int k = 0; k < 2; ++k) dst[m][k] = *(const LAS bf16x8*)(lds + PG8_SA(b, h) + aoff + m * 2048 + k * 1024); } while (0)
#define PG8_LDB(dst, b, h) do { _Pragma("unroll") for (int n = 0; n < 2; ++n) _Pragma("unroll") for (int k = 0; k < 2; ++k) dst[n][k] = *(const LAS bf16x8*)(lds + PG8_SB(b, h) + boff + n * 2048 + k * 1024); } while (0)
#define PG8_MMA(ai, bj, At, Bt) do { __builtin_amdgcn_s_setprio(1); _Pragma("unroll") for (int m = 0; m < 4; ++m) _Pragma("unroll") for (int n = 0; n < 2; ++n) _Pragma("unroll") for (int k = 0; k < 2; ++k) \
        acc[ai][bj][m][n] = __builtin_amdgcn_mfma_f32_16x16x32_bf16(Bt[n][k], At[m][k], acc[ai][bj][m][n], 0, 0, 0); __builtin_amdgcn_s_setprio(0); } while (0)
#define PG8_WAIT_V(n) asm volatile("s_waitcnt vmcnt(" #n ")" ::: "memory")
#define PG8_WAIT_L(n) asm volatile("s_waitcnt lgkmcnt(" #n ")" ::: "memory")
#define PG8_BAR __builtin_amdgcn_s_barrier()
#define PG8_SCHED __builtin_amdgcn_sched_barrier(0)
    Unit cur, nxt; int ui = 0;
    if (!S.next(0, cur)) return;
    f32x4 acc[2][2][4][2];
#pragma unroll
    for (int a = 0; a < 2; ++a)
#pragma unroll
        for (int b = 0; b < 2; ++b)
#pragma unroll
            for (int m = 0; m < 4; ++m)
#pragma unroll
                for (int n = 0; n < 2; ++n) acc[a][b][m][n] = (f32x4){0.f, 0.f, 0.f, 0.f};
    bf16x8 At[4][2], B0[2][2], B1[2][2];
    const char* cA = cur.A; const char* cB = cur.B;
    PG8_STAGE(PG8_SB(0, 0), cB, voffB); PG8_STAGE(PG8_SB(0, 1), cB + hstepB, voffB); PG8_STAGE(PG8_SA(0, 0), cA, voffA); PG8_STAGE(PG8_SA(0, 1), cA + hstepA, voffA);
    if (wr == 1) PG8_BAR;
    PG8_WAIT_V(2); PG8_BAR;
    PG8_STAGE(PG8_SB(1, 0), cB + kstep, voffB); PG8_STAGE(PG8_SA(1, 0), cA + kstep, voffA); PG8_STAGE(PG8_SB(1, 1), cB + hstepB + kstep, voffB);
    PG8_WAIT_V(6); PG8_BAR;
    for (;;) {
        const bool has_next = S.next(ui + 1, nxt);
        const char* nA = has_next ? nxt.A : cA; const char* nB = has_next ? nxt.B : cB;
        for (int t = 0; t < nt; t += 2) {
            const bool last = (t == nt - 2);
            const char* a1 = cA + (size_t)(t + 1) * kstep;
            const char* a2 = last ? nA : cA + (size_t)(t + 2) * kstep; const char* b2 = last ? nB : cB + (size_t)(t + 2) * kstep;
            const char* a3 = a2 + kstep; const char* b3 = b2 + kstep;
            PG8_LDB(B0, 0, 0); PG8_LDB(B1, 0, 1); PG8_SCHED; PG8_LDA(At, 0, 0); PG8_STAGE(PG8_SA(1, 1), a1 + hstepA, voffA);
            PG8_WAIT_V(8); PG8_WAIT_L(0); PG8_BAR; PG8_MMA(0, 0, At, B0); PG8_MMA(0, 1, At, B1); PG8_BAR; PG8_SCHED;
            PG8_LDA(At, 0, 1); PG8_STAGE(PG8_SB(0, 0), b2, voffB); PG8_STAGE(PG8_SB(0, 1), b2 + hstepB, voffB); PG8_STAGE(PG8_SA(0, 0), a2, voffA);
            PG8_WAIT_V(8); PG8_WAIT_L(0); PG8_BAR; PG8_MMA(1, 0, At, B0); PG8_MMA(1, 1, At, B1); PG8_BAR; PG8_SCHED;
            PG8_LDB(B0, 1, 0); PG8_LDB(B1, 1, 1); PG8_SCHED; PG8_LDA(At, 1, 0); PG8_STAGE(PG8_SA(0, 1), a2 + hstepA, voffA);
            PG8_WAIT_V(8); PG8_WAIT_L(0); PG8_BAR; PG8_MMA(0, 0, At, B0); PG8_MMA(0, 1, At, B1); PG8_BAR; PG8_SCHED;
            PG8_LDA(At, 1, 1); PG8_STAGE(PG8_SB(1, 0), b3, voffB); PG8_STAGE(PG8_SB(1, 1), b3 + hstepB, voffB); PG8_STAGE(PG8_SA(1, 0), a3, voffA);
            PG8_WAIT_V(8); PG8_WAIT_L(0); PG8_BAR; PG8_MMA(1, 0, At, B0); PG8_MMA(1, 1, At, B1); PG8_BAR; PG8_SCHED;
        }
        if (wr == 0) PG8_BAR;
        E(acc, cur, wr, wc, fr, fq);
        if (!has_next) break;
#pragma unroll
        for (int a = 0; a < 2; ++a)
#pragma unroll
            for (int b = 0; b < 2; ++b)
#pragma unroll
                for (int m = 0; m < 4; ++m)
#pragma unroll
                    for (int n = 0; n < 2; ++n) acc[a][b][m][n] = (f32x4){0.f, 0.f, 0.f, 0.f};
        cur = nxt; cA = nA; cB = nB; ++ui;
        if (wr == 1) PG8_BAR;
    }
    PG8_WAIT_V(0);
    PG8_BAR;
#undef PG8_SA
#undef PG8_SB
#undef PG8_STAGE
#undef PG8_LDA
#undef PG8_LDB
#undef PG8_MMA
#undef PG8_WAIT_V
#undef PG8_WAIT_L
#undef PG8_BAR
#undef PG8_SCHED
}
}
using pg8::Unit;
using pg8::cvt_pk_bf16;

struct EpiStoreBf16 {
    static constexpr bool PERM = true;
    bf16* O; int ldc;
    __device__ __forceinline__ void operator()(const f32x4 (&acc)[2][2][4][2], const Unit& u, int wr, int wc, int fr, int fq) const {
        const int row0 = u.r0 + wr * 64 + fr, col0 = u.c0 + wc * 32 + 8 * fq;
#pragma unroll
        for (int ai = 0; ai < 2; ++ai)
#pragma unroll
            for (int m = 0; m < 4; ++m) { bf16* rowp = O + (size_t)(row0 + ai * 128 + m * 16) * ldc + col0;
#pragma unroll
                for (int bj = 0; bj < 2; ++bj) { const f32x4 v0 = acc[ai][bj][m][0], v1 = acc[ai][bj][m][1];
                    u32x4 w; w.x = cvt_pk_bf16(v0[0], v0[1]); w.y = cvt_pk_bf16(v0[2], v0[3]); w.z = cvt_pk_bf16(v1[0], v1[1]); w.w = cvt_pk_bf16(v1[2], v1[3]);
                    *(u32x4*)(rowp + bj * 128) = w; } }
    }
};
struct EpiGate {
    static constexpr bool PERM = true;
    bf16* G; int ldc;
    __device__ __forceinline__ void operator()(const f32x4 (&acc)[2][2][4][2], const Unit& u, int wr, int wc, int fr, int fq) const {
        const int row0 = u.r0 + wr * 64 + fr, col0 = u.c0 + wc * 32 + 8 * fq;
#pragma unroll
        for (int ai = 0; ai < 2; ++ai)
#pragma unroll
            for (int m = 0; m < 4; ++m) { bf16* rowp = G + (size_t)(row0 + ai * 128 + m * 16) * ldc + col0;
#pragma unroll
                for (int bj = 0; bj < 2; ++bj) { const f32x4 v0 = acc[ai][bj][m][0], v1 = acc[ai][bj][m][1];
                    const u32x4 gw = *(const u32x4*)(rowp + bj * 128); float g[8]; unpack8(gw, g);
                    u32x4 w; w.x = cvt_pk_bf16(sigmoidf_(g[0]) * v0[0], sigmoidf_(g[1]) * v0[1]); w.y = cvt_pk_bf16(sigmoidf_(g[2]) * v0[2], sigmoidf_(g[3]) * v0[3]);
                    w.z = cvt_pk_bf16(sigmoidf_(g[4]) * v1[0], sigmoidf_(g[5]) * v1[1]); w.w = cvt_pk_bf16(sigmoidf_(g[6]) * v1[2], sigmoidf_(g[7]) * v1[3]);
                    *(u32x4*)(rowp + bj * 128) = w; } }
    }
};
struct EpiResF32 {
    static constexpr bool PERM = false;
    const float* res; float* out;
    __device__ __forceinline__ void operator()(const f32x4 (&acc)[2][2][4][2], const Unit& u, int wr, int wc, int fr, int fq) const {
        const int row0 = u.r0 + wr * 64 + fr, col0 = u.c0 + wc * 32 + 4 * fq;
#pragma unroll
        for (int ai = 0; ai < 2; ++ai)
#pragma unroll
            for (int m = 0; m < 4; ++m) { const size_t ro = (size_t)(row0 + ai * 128 + m * 16) * D + col0;
#pragma unroll
                for (int bj = 0; bj < 2; ++bj)
#pragma unroll
                    for (int n = 0; n < 2; ++n) { const f32x4 r = *(const f32x4*)(res + ro + bj * 128 + n * 16); *(f32x4*)(out + ro + bj * 128 + n * 16) = r + acc[ai][bj][m][n]; } }
    }
};
struct EpiSwiglu {
    static constexpr bool PERM = true;
    bf16* O;
    __device__ __forceinline__ void operator()(const f32x4 (&acc)[2][2][4][2], const Unit& u, int wr, int wc, int fr, int fq) const {
        const int row0 = u.r0 + wr * 64 + fr, col0 = u.c0 + wc * 32 + 8 * fq;
#pragma unroll
        for (int ai = 0; ai < 2; ++ai)
#pragma unroll
            for (int m = 0; m < 4; ++m) { bf16* rowp = O + (size_t)(row0 + ai * 128 + m * 16) * DE + col0;
                const f32x4 g0 = acc[ai][0][m][0], g1 = acc[ai][0][m][1], u0 = acc[ai][1][m][0], u1 = acc[ai][1][m][1];
                u32x4 w; w.x = cvt_pk_bf16(siluf_(g0[0]) * u0[0], siluf_(g0[1]) * u0[1]); w.y = cvt_pk_bf16(siluf_(g0[2]) * u0[2], siluf_(g0[3]) * u0[3]);
                w.z = cvt_pk_bf16(siluf_(g1[0]) * u1[0], siluf_(g1[1]) * u1[1]); w.w = cvt_pk_bf16(siluf_(g1[2]) * u1[2], siluf_(g1[3]) * u1[3]);
                *(u32x4*)rowp = w; }
    }
};
struct EpiScatter {
    static constexpr bool PERM = true;
    bf16* Y; const int* row_code; const float* row_w;
    __device__ __forceinline__ void operator()(const f32x4 (&acc)[2][2][4][2], const Unit& u, int wr, int wc, int fr, int fq) const {
        const int row0 = u.r0 + wr * 64 + fr, col0 = u.c0 + wc * 32 + 8 * fq;
#pragma unroll
        for (int ai = 0; ai < 2; ++ai)
#pragma unroll
            for (int m = 0; m < 4; ++m) { const int row = row0 + ai * 128 + m * 16; const int code = row_code[row]; const float rw = row_w[row];
                if (code >= 0) { bf16* rowp = Y + (size_t)(code & 1) * ((size_t)M * D) + (size_t)(code >> 1) * D + col0;
#pragma unroll
                    for (int bj = 0; bj < 2; ++bj) { const f32x4 v0 = acc[ai][bj][m][0] * rw, v1 = acc[ai][bj][m][1] * rw;
                        u32x4 w; w.x = cvt_pk_bf16(v0[0], v0[1]); w.y = cvt_pk_bf16(v0[2], v0[3]); w.z = cvt_pk_bf16(v1[0], v1[1]); w.w = cvt_pk_bf16(v1[2], v1[3]);
                        *(u32x4*)(rowp + bj * 128) = w; } } }
    }
};

struct SchedH {
    pg8::TileOrder to; const char* A; const char* B;
    __device__ __forceinline__ bool next(int i, Unit& u) const { int pm, pn; if (!to.next(i, pm, pn)) return false;
        u.A = A + (size_t)pm * 256 * D * 2; u.B = B + (size_t)pn * 256 * D * 2; u.r0 = pm * 256; u.c0 = pn * 256; return true; }
};
struct SchedBranch {
    pg8::TileOrder to; const char* YS; const char* WBR;
    __device__ __forceinline__ bool next(int i, Unit& u) const { int pm, pn; if (!to.next(i, pm, pn)) return false; const int br = pn >> 2, q = pn & 3;
        u.A = YS + ((size_t)pm * 256 * 2048 + br * 512) * 2; u.B = WBR + ((size_t)br * D * 512 + (size_t)q * 256 * 512) * 2; u.r0 = pm * 256; u.c0 = HGATE + br * 1024 + q * 256; return true; }
};
struct SchedOut {
    pg8::TileOrder to; const char* A; const char* B;
    __device__ __forceinline__ bool next(int i, Unit& u) const { int pm, pn; if (!to.next(i, pm, pn)) return false;
        u.A = A + (size_t)pm * 256 * D * 2; u.B = B + (size_t)pn * 256 * D * 2; u.r0 = pm * 256; u.c0 = pn * 256; return true; }
};
struct SchedMoe {
    int nux, nrank, rank, nk, x, NX; const LAS int* cum; const LAS int* rb0; const char* A; size_t a_blk; const char* W; size_t w_e, w_pn; int cmul;
    __device__ __forceinline__ bool next(int i, Unit& u) const { const int ui = i * nrank + rank; if (ui >= nux) return false;
        int k = 0; while (k + 1 < nk && cum[k + 1] <= ui) ++k;
        const int local = ui - cum[k], rb = rb0[k] + (local >> 2), pn = local & 3, e = x + NX * k;
        u.A = A + (size_t)rb * a_blk; u.B = W + (size_t)e * w_e + (size_t)pn * w_pn; u.r0 = rb * 256; u.c0 = pn * cmul; return true; }
};

struct Params { const float* in[25]; float* out; unsigned char* ws; int ph_lo, ph_hi; };
enum { I_X = 0, I_MIXNW, I_WIN, I_GCONV, I_GALOG, I_GDT, I_GNW, I_CCW, I_CCB, I_CLNW, I_CLNB, I_GLNW, I_GLNB, I_GWS, I_GBS, I_SCW, I_WBR, I_WOUT, I_MOENW, I_RGRP, I_REXP, I_WG, I_WU, I_WD, I_FNW };
constexpr int PH_PER_LAYER = 12, PH_FINAL = 24, PH_TOTAL = 25;

__device__ __forceinline__ void transpose_item(const float* __restrict__ W, int ldw, int srccol, bf16* __restrict__ WT, int ldt, int k0, int n0, int lane) {
    const int kq = lane & 7, nq = lane >> 3;
    f32x4 v[8][2];
#pragma unroll
    for (int r = 0; r < 8; ++r) { const float* s = W + (size_t)(k0 + 8 * kq + r) * ldw + srccol + 8 * nq; v[r][0] = *(const f32x4*)s; v[r][1] = *(const f32x4*)(s + 4); }
#pragma unroll
    for (int e = 0; e < 8; ++e) { u32x4 o; o.x = pk2(v[0][e >> 2][e & 3], v[1][e >> 2][e & 3]); o.y = pk2(v[2][e >> 2][e & 3], v[3][e >> 2][e & 3]); o.z = pk2(v[4][e >> 2][e & 3], v[5][e >> 2][e & 3]); o.w = pk2(v[6][e >> 2][e & 3], v[7][e >> 2][e & 3]);
        *(u32x4*)(WT + (size_t)(n0 + 8 * nq + e) * ldt + k0 + 8 * kq) = o; }
}
__device__ __forceinline__ void prep_static_weights(const Params& p, int gw, int NGW, int lane) {
    constexpr int I_IN = 16 * (DH / 64), I_BR = 8 * 16, I_OUT = 16 * 16, PER_L = I_IN + 4 * I_BR + I_OUT;
    for (int it = gw; it < NLAYER * PER_L; it += NGW) {
        const int l = it / PER_L; int r = it % PER_L;
        if (r < I_IN) { const int kb = r / (DH / 64), nb = r % (DH / 64), n0 = nb * 64;
            transpose_item(p.in[I_WIN] + (size_t)l * D * DIN, DIN, n0 + (n0 >= 2048 ? 8 : 0), (bf16*)(p.ws + WS_WIN + l * WIN_L), D, kb * 64, n0, lane); continue; }
        r -= I_IN;
        if (r < 4 * I_BR) { const int br = r / I_BR, q = r % I_BR, kb = q / 16, nb = q % 16;
            transpose_item(p.in[I_WBR] + ((size_t)l * 4 + br) * 512 * D, D, nb * 64, (bf16*)(p.ws + WS_WBR + l * WBR_L) + (size_t)br * D * 512, 512, kb * 64, nb * 64, lane); continue; }
        r -= 4 * I_BR;
        { const int kb = r / 16, nb = r % 16;
            transpose_item(p.in[I_WOUT] + (size_t)l * D * D, D, nb * 64, (bf16*)(p.ws + WS_WOUT + l * WOUT_L), D, kb * 64, nb * 64, lane); }
    }
}
__device__ __forceinline__ void prep_moe_weights(const Params& p, int layer, int gw, int NGW, int lane) {
    constexpr int I_GU = 16 * 16, I_D = 8 * 16, PER_E = I_GU + I_D;
    for (int it = gw; it < NE * PER_E; it += NGW) {
        const int e = it / PER_E; int r = it % PER_E;
        if (r < I_GU) { const int kb = r / 16, nb = r % 16, n0 = nb * 64, pn = n0 >> 8, half = (n0 >> 7) & 1, j0 = n0 & 127;
            const float* src = p.in[half ? I_WU : I_WG] + ((size_t)layer * NE + e) * D * DE;
            transpose_item(src, DE, 128 * pn + j0, (bf16*)(p.ws + WS_MOEW + e * WGU_E), D, kb * 64, n0, lane); continue; }
        r -= I_GU;
        { const int kb = r / 16, nb = r % 16;
            transpose_item(p.in[I_WD] + ((size_t)layer * NE + e) * DE * D, D, nb * 64, (bf16*)(p.ws + WS_WD + e * WD_E), DE, kb * 64, nb * 64, lane); }
    }
}

template <int MODE>
__device__ __forceinline__ void norm_phase(const Params& p, int layer, LAS unsigned char* lds, int gw, int NGW, int tid, int lane) {
    LAS float* wsm = (LAS float*)lds;
    if (MODE != 2) {
        const float* wi = p.in[I_WIN] + (size_t)layer * D * DIN;
        for (int i = tid; i < 8192; i += 512) wsm[i] = wi[(size_t)(i >> 3) * DIN + 2048 + (i & 7)];
    }
    __syncthreads();
    const float* nwp = (MODE == 2) ? p.in[I_FNW] : p.in[I_MIXNW] + layer * D;
    f32x4 nw[4];
#pragma unroll
    for (int j = 0; j < 4; ++j) nw[j] = *(const f32x4*)(nwp + 4 * lane + 256 * j);
    const bf16* Y0 = (const bf16*)(p.ws + WS_Y); const bf16* Y1 = Y0 + (size_t)M * D;
    bf16* XN = (bf16*)(p.ws + WS_XN); float* SMALL = (float*)(p.ws + WS_SMALL);
    for (int m = gw; m < M; m += NGW) {
        const float* xr = (MODE == 0 ? p.in[I_X] : p.out) + (size_t)m * D;
        f32x4 v[4]; float ss = 0.f;
#pragma unroll
        for (int j = 0; j < 4; ++j) { v[j] = *(const f32x4*)(xr + 4 * lane + 256 * j);
            if (MODE != 0) { const u32x2 a = *(const u32x2*)(Y0 + (size_t)m * D + 4 * lane + 256 * j), b = *(const u32x2*)(Y1 + (size_t)m * D + 4 * lane + 256 * j);
                v[j][0] += bf_lo(a.x) + bf_lo(b.x); v[j][1] += bf_hi(a.x) + bf_hi(b.x); v[j][2] += bf_lo(a.y) + bf_lo(b.y); v[j][3] += bf_hi(a.y) + bf_hi(b.y); }
            ss += (v[j][0] * v[j][0] + v[j][1] * v[j][1]) + (v[j][2] * v[j][2] + v[j][3] * v[j][3]); }
        const float rs = 1.0f / sqrtf(wave_sum(ss) * (1.0f / D) + EPS);
        if (MODE == 2) {
#pragma unroll
            for (int j = 0; j < 4; ++j) *(f32x4*)(p.out + (size_t)m * D + 4 * lane + 256 * j) = v[j] * rs * nw[j];
            continue;
        }
        if (MODE == 1) {
#pragma unroll
            for (int j = 0; j < 4; ++j) *(f32x4*)(p.out + (size_t)m * D + 4 * lane + 256 * j) = v[j];
        }
        float sm[8];
#pragma unroll
        for (int q = 0; q < 8; ++q) sm[q] = 0.f;
#pragma unroll
        for (int j = 0; j < 4; ++j) { v[j] = v[j] * rs * nw[j];
            u32x2 o; o.x = pk2(v[j][0], v[j][1]); o.y = pk2(v[j][2], v[j][3]); *(u32x2*)(XN + (size_t)m * D + 4 * lane + 256 * j) = o;
#pragma unroll
            for (int c = 0; c < 4; ++c) { const LAS float* wrow = wsm + (4 * lane + 256 * j + c) * 8; const f32x4 w0 = *(const LAS f32x4*)wrow, w1 = *(const LAS f32x4*)(wrow + 4);
                sm[0] += v[j][c] * w0[0]; sm[1] += v[j][c] * w0[1]; sm[2] += v[j][c] * w0[2]; sm[3] += v[j][c] * w0[3];
                sm[4] += v[j][c] * w1[0]; sm[5] += v[j][c] * w1[1]; sm[6] += v[j][c] * w1[2]; sm[7] += v[j][c] * w1[3]; } }
        float mine = 0.f;
#pragma unroll
        for (int q = 0; q < 8; ++q) { const float s = wave_sum(sm[q]); mine = (lane == q) ? s : mine; }
        if (lane < 8) SMALL[(size_t)m * 8 + lane] = mine;
    }
    __syncthreads();
}

__device__ __forceinline__ void shortconv(const Params& p, int layer, int gtid, int NGT) {
    const bf16* H = (const bf16*)(p.ws + WS_H); bf16* YS = (bf16*)(p.ws + WS_YS);
    const float* cw = p.in[I_SCW] + (size_t)layer * 3 * 512;
    for (int it = gtid; it < M * 64; it += NGT) {
        const int m = it >> 6, c8 = (it & 63) * 8, t = m & (T - 1);
        float acc[8];
#pragma unroll
        for (int i = 0; i < 8; ++i) acc[i] = 0.f;
#pragma unroll
        for (int j = 0; j < 3; ++j) { if (t - 2 + j >= 0) { const bf16* r = H + (size_t)(m - 2 + j) * DH + HSC + c8;
                float cg[8], xv[8]; unpack8(*(const u32x4*)(r + 512), cg); unpack8(*(const u32x4*)(r + 1024), xv);
#pragma unroll
                for (int i = 0; i < 8; ++i) acc[i] += cw[j * 512 + c8 + i] * (cg[i] * xv[i]); } }
        float bg[8]; unpack8(*(const u32x4*)(H + (size_t)m * DH + HSC + c8), bg);
#pragma unroll
        for (int i = 0; i < 8; ++i) acc[i] *= bg[i];
        *(u32x4*)(YS + (size_t)m * 2048 + 1536 + c8) = pack8(acc);
    }
}
__device__ __forceinline__ void conformer(const Params& p, int layer, LAS unsigned char* lds, int tid, int wave, int lane, int vb, int nvb) {
    const bf16* H = (const bf16*)(p.ws + WS_H); bf16* YS = (bf16*)(p.ws + WS_YS);
    LAS bf16* yt = (LAS bf16*)lds;
    LAS float* zt = (LAS float*)(lds + 98304);
    const float* cwp = p.in[I_CCW] + (size_t)layer * 31 * 512;
    float cw[31];
#pragma unroll
    for (int j = 0; j < 31; ++j) cw[j] = cwp[j * 512 + tid];
    const float cb = p.in[I_CCB][layer * 512 + tid];
    float lw[8], lb[8];
#pragma unroll
    for (int i = 0; i < 8; ++i) { lw[i] = p.in[I_CLNW][layer * 512 + lane * 8 + i]; lb[i] = p.in[I_CLNB][layer * 512 + lane * 8 + i]; }
    for (int unit = vb; unit < M / 64; unit += nvb) {
        const int m0 = unit * 64, t0 = m0 & (T - 1);
        for (int it = tid; it < 94 * 64; it += 512) { const int r = it >> 6, c8 = (it & 63) * 8; const int dt = r - 30;
            u32x4 o = (u32x4){0u, 0u, 0u, 0u};
            if (t0 + dt >= 0) { const bf16* src = H + (size_t)(m0 + dt) * DH + HCONF + c8; float a[8], g[8]; unpack8(*(const u32x4*)src, a); unpack8(*(const u32x4*)(src + 512), g);
#pragma unroll
                for (int i = 0; i < 8; ++i) a[i] *= sigmoidf_(g[i]);
                o = pack8(a); }
            *(LAS u32x4*)(yt + r * 512 + c8) = o; }
        __syncthreads();
        for (int sb = 0; sb < 8; ++sb) {
            float z[8];
#pragma unroll
            for (int i = 0; i < 8; ++i) z[i] = cb;
#pragma unroll
            for (int r = 0; r < 38; ++r) { const float yv = bf2f(yt[(sb * 8 + r) * 512 + tid]);
#pragma unroll
                for (int i = 0; i < 8; ++i) { const int j = r - i; if (j >= 0 && j < 31) z[i] += cw[j] * yv; } }
#pragma unroll
            for (int i = 0; i < 8; ++i) zt[i * 512 + tid] = z[i];
            __syncthreads();
            { const LAS float* zr = zt + wave * 512 + lane * 8; float v[8]; const f32x4 a = *(const LAS f32x4*)zr, b = *(const LAS f32x4*)(zr + 4);
                v[0] = a[0]; v[1] = a[1]; v[2] = a[2]; v[3] = a[3]; v[4] = b[0]; v[5] = b[1]; v[6] = b[2]; v[7] = b[3];
                float s = 0.f;
#pragma unroll
                for (int i = 0; i < 8; ++i) s += v[i];
                const float mean = wave_sum(s) * (1.0f / 512.0f); float q = 0.f;
#pragma unroll
                for (int i = 0; i < 8; ++i) { v[i] -= mean; q += v[i] * v[i]; }
                const float rstd = 1.0f / sqrtf(wave_sum(q) * (1.0f / 512.0f) + EPS);
#pragma unroll
                for (int i = 0; i < 8; ++i) v[i] = siluf_(v[i] * rstd * lw[i] + lb[i]);
                *(u32x4*)(YS + (size_t)(m0 + sb * 8 + wave) * 2048 + 512 + lane * 8) = pack8(v); }
            __syncthreads();
        }
    }
}
__device__ __forceinline__ f32x4 mfma16(bf16x8 a, bf16x8 b, f32x4 c) { return __builtin_amdgcn_mfma_f32_16x16x32_bf16(a, b, c, 0, 0, 0); }
typedef short bf16x4 __attribute__((ext_vector_type(4)));
__device__ __forceinline__ bf16x8 ld_frag16(const LAS unsigned char* p) { return *(const LAS bf16x8*)p; }
__device__ __forceinline__ bf16x8 ld_frag8x2(const LAS unsigned char* p) { const bf16x4 a = *(const LAS bf16x4*)p, b = *(const LAS bf16x4*)(p + 32); return __builtin_shufflevector(a, b, 0, 1, 2, 3, 4, 5, 6, 7); }
__device__ __forceinline__ bf16x8 pack_frag(const f32x4 lo, const f32x4 hi) { u32x4 w; w.x = cvt_pk_bf16(lo[0], lo[1]); w.y = cvt_pk_bf16(lo[2], lo[3]); w.z = cvt_pk_bf16(hi[0], hi[1]); w.w = cvt_pk_bf16(hi[2], hi[3]); return __builtin_bit_cast(bf16x8, w); }
constexpr int GM_W = 0, GM_VT = 34816, GM_ST = 69632;
__device__ __forceinline__ void gmlp(const Params& p, int layer, LAS unsigned char* lds, int tid, int wave, int lane, int vb, int nvb) {
    const bf16* H = (const bf16*)(p.ws + WS_H); bf16* YS = (bf16*)(p.ws + WS_YS);
    LAS float* st = (LAS float*)(lds + GM_ST);
    const float* lnw = p.in[I_GLNW] + layer * 512; const float* lnb = p.in[I_GLNB] + layer * 512;
    const int q = lane >> 4, li = lane & 15;
    for (int unit = vb; unit < M / 128; unit += nvb) {
        const int m0 = unit * 128;
        __syncthreads();
        for (int tk = wave * 16; tk < wave * 16 + 16; ++tk) {
            float v[8]; unpack8(*(const u32x4*)(H + (size_t)(m0 + tk) * DH + HGMLP + 512 + lane * 8), v);
            float s = 0.f;
#pragma unroll
            for (int i = 0; i < 8; ++i) { v[i] = gelu_tanh(v[i]); s += v[i]; }
            const float mean = wave_sum(s) * (1.0f / 512.0f); float qq = 0.f;
#pragma unroll
            for (int i = 0; i < 8; ++i) { const float d = v[i] - mean; qq += d * d; }
            const float rstd = 1.0f / sqrtf(wave_sum(qq) * (1.0f / 512.0f) + EPS);
            if (lane == 0) { st[tk * 2] = mean; st[tk * 2 + 1] = rstd; }
        }
        __syncthreads();
        for (int g = 0; g < 4; ++g) {
            for (int it = tid; it < 128 * 16; it += 512) { const int tk = it >> 4, c8 = (it & 15) * 8;
                float v[8]; unpack8(*(const u32x4*)(H + (size_t)(m0 + tk) * DH + HGMLP + 512 + g * 128 + c8), v);
                const float mean = st[tk * 2], rstd = st[tk * 2 + 1];
#pragma unroll
                for (int i = 0; i < 8; ++i) *(LAS bf16*)(lds + GM_VT + (c8 + i) * 272 + 2 * tk) = (bf16)f2bf((gelu_tanh(v[i]) - mean) * rstd * lnw[g * 128 + c8 + i] + lnb[g * 128 + c8 + i]); }
            const float* ws = p.in[I_GWS] + ((size_t)layer * 4 + g) * 128 * 128;
            for (int it = tid; it < 128 * 16; it += 512) { const int i = it >> 4, j8 = (it & 15) * 8;
                const f32x4 a = *(const f32x4*)(ws + i * 128 + j8), b = *(const f32x4*)(ws + i * 128 + j8 + 4);
                float w[8] = {a[0], a[1], a[2], a[3], b[0], b[1], b[2], b[3]};
#pragma unroll
                for (int e = 0; e < 8; ++e) w[e] = (j8 + e <= i) ? w[e] : 0.f;
                *(LAS u32x4*)(lds + GM_W + i * 272 + j8 * 2) = pack8(w); }
            __syncthreads();
            {
                f32x4 acc[8];
#pragma unroll
                for (int ct = 0; ct < 8; ++ct) acc[ct] = (f32x4){0.f, 0.f, 0.f, 0.f};
                const int nks = (wave >> 1) + 1;
                for (int ks = 0; ks < nks; ++ks) { const bf16x8 wf = ld_frag16(lds + GM_W + (16 * wave + li) * 272 + (32 * ks + 8 * q) * 2);
#pragma unroll
                    for (int ct = 0; ct < 8; ++ct) acc[ct] = mfma16(ld_frag16(lds + GM_VT + (16 * ct + li) * 272 + (32 * ks + 8 * q) * 2), wf, acc[ct]); }
                const int i = 16 * wave + li; const float bs = p.in[I_GBS][((size_t)layer * 4 + g) * 128 + i];
                const bf16* urow = H + (size_t)(m0 + i) * DH + HGMLP + g * 128 + 4 * q; bf16* orow = YS + (size_t)(m0 + i) * 2048 + 1024 + g * 128 + 4 * q;
#pragma unroll
                for (int ct = 0; ct < 8; ++ct) { const u32x2 uw = *(const u32x2*)(urow + 16 * ct);
                    const float o0 = gelu_tanh(bf_lo(uw.x)) * (acc[ct][0] + bs), o1 = gelu_tanh(bf_hi(uw.x)) * (acc[ct][1] + bs), o2 = gelu_tanh(bf_lo(uw.y)) * (acc[ct][2] + bs), o3 = gelu_tanh(bf_hi(uw.y)) * (acc[ct][3] + bs);
                    u32x2 ow; ow.x = pk2(o0, o1); ow.y = pk2(o2, o3); *(u32x2*)(orow + 16 * ct) = ow; }
            }
            __syncthreads();
        }
    }
}
constexpr int CP_QN = 0, CP_KN = 17408, CP_KT = 34816, CP_VT = 53248, CP_KGT = 71680, CP_A32 = 90112, CP_ATT = 106496, CP_T16 = 115712, CP_TAB = 124928;
__device__ __forceinline__ void gdn_chunk_prep(const Params& p, int layer, LAS unsigned char* lds, int tid, int wave, int lane) {
    const bf16* H = (const bf16*)(p.ws + WS_H); const float* SMALL = (const float*)(p.ws + WS_SMALL);
    const float* cw = p.in[I_GCONV] + (size_t)layer * 4 * 1536;
    LAS float* tab = (LAS float*)(lds + CP_TAB);
    const int q = lane >> 4, li = lane & 15;
    for (int unit = blockIdx.x; unit < 2048; unit += gridDim.x) {
        const int n = unit & 63, hh = (unit >> 6) & 3, b = unit >> 8; const int m0 = b * T + n * 64;
        unsigned char* rec = p.ws + WS_REC + (size_t)((b * 4 + hh) * 64 + n) * REC_BYTES;
        __syncthreads();
        if (wave == 0) { const int m = m0 + lane; const float br = SMALL[(size_t)m * 8 + hh], ar = SMALL[(size_t)m * 8 + 4 + hh];
            float g = -__expf(p.in[I_GALOG][layer * 4 + hh]) * softplusf_(ar + p.in[I_GDT][layer * 4 + hh]);
#pragma unroll
            for (int o = 1; o < 64; o <<= 1) { const float t = __shfl_up(g, o); if (lane >= o) g += t; }
            tab[lane] = sigmoidf_(br); tab[64 + lane] = g; tab[128 + lane] = __expf(g); }
        __syncthreads();
        for (int i = wave * 8; i < wave * 8 + 8; ++i) {
            const int m = m0 + i, t = n * 64 + i;
            float y[3][2];
#pragma unroll
            for (int s = 0; s < 3; ++s) { const int c = s * 512 + hh * 128 + 2 * lane; float a0 = 0.f, a1 = 0.f;
#pragma unroll
                for (int j = 0; j < 4; ++j) { if (t - 3 + j >= 0) { const unsigned w = *(const unsigned*)(H + (size_t)(m - 3 + j) * DH + c);
                        a0 += cw[j * 1536 + c] * bf_lo(w); a1 += cw[j * 1536 + c + 1] * bf_hi(w); } }
                y[s][0] = siluf_(a0); y[s][1] = siluf_(a1); }
            const float sq = wave_sum(y[0][0] * y[0][0] + y[0][1] * y[0][1]), sk = wave_sum(y[1][0] * y[1][0] + y[1][1] * y[1][1]);
            const float rq = 0.08838834764831845f / sqrtf(sq + EPS), rk = 1.0f / sqrtf(sk + EPS);
            const float be = tab[i], bg = be * tab[128 + i];
            const float k0 = y[1][0] * rk, k1 = y[1][1] * rk;
            *(LAS unsigned*)(lds + CP_QN + i * 272 + 4 * lane) = pk2(y[0][0] * rq, y[0][1] * rq);
            *(LAS unsigned*)(lds + CP_KN + i * 272 + 4 * lane) = pk2(k0, k1);
            *(LAS bf16*)(lds + CP_KT + (2 * lane) * 144 + 2 * i) = (bf16)f2bf(k0); *(LAS bf16*)(lds + CP_KT + (2 * lane + 1) * 144 + 2 * i) = (bf16)f2bf(k1);
            *(LAS bf16*)(lds + CP_VT + (2 * lane) * 144 + 2 * i) = (bf16)f2bf(be * y[2][0]); *(LAS bf16*)(lds + CP_VT + (2 * lane + 1) * 144 + 2 * i) = (bf16)f2bf(be * y[2][1]);
            *(LAS bf16*)(lds + CP_KGT + (2 * lane) * 144 + 2 * i) = (bf16)f2bf(bg * k0); *(LAS bf16*)(lds + CP_KGT + (2 * lane + 1) * 144 + 2 * i) = (bf16)f2bf(bg * k1);
        }
        __syncthreads();
        for (int jb = wave; jb < 32; jb += 8) { const int which = jb >> 4, mt = (jb >> 2) & 3, nt = jb & 3;
            f32x4 acc = (f32x4){0.f, 0.f, 0.f, 0.f};
            if (nt <= mt) {
#pragma unroll
                for (int ks = 0; ks < 4; ++ks) acc = mfma16(ld_frag16(lds + (which ? CP_QN : CP_KN) + (16 * mt + li) * 272 + (32 * ks + 8 * q) * 2), ld_frag16(lds + CP_KN + (16 * nt + li) * 272 + (32 * ks + 8 * q) * 2), acc);
            }
            const int j = 16 * nt + li; const float gj = tab[64 + j];
#pragma unroll
            for (int r = 0; r < 4; ++r) { const int i = 16 * mt + 4 * q + r; const float gi = tab[64 + i];
                if (which == 0) { ((LAS float*)(lds + CP_A32))[i * 64 + j] = (i > j) ? tab[i] * acc[r] * __expf(gi - gj) : 0.f; }
                else { *(LAS bf16*)(lds + CP_ATT + i * 144 + 2 * j) = (bf16)f2bf((i >= j) ? acc[r] * __expf(gi - gj) : 0.f); } }
        }
        __syncthreads();
        if (wave == 0) {
            float Tc[64]; const float lanef = (float)lane;
            const LAS float* A = (const LAS float*)(lds + CP_A32); asm volatile("" : "+v"(A));
            LAS unsigned char* Tw = lds + CP_T16 + 2 * lane; asm volatile("" : "+v"(Tw));
#pragma unroll
            for (int i = 0; i < 64; ++i) { float a = fmaxf(0.f, 1.f - fabsf((float)i - lanef));
#pragma unroll
                for (int j = 0; j < i; j += 4) { const f32x4 av = *(const LAS f32x4*)(A + i * 64 + j);
#pragma unroll
                    for (int jj = 0; jj < 4; ++jj) if (j + jj < i) a -= av[jj] * Tc[j + jj]; }
                Tc[i] = a; *(LAS bf16*)(Tw + i * 144) = (bf16)f2bf(a); }
        } else {
            const int t2 = tid - 64;
            for (int pc = t2; pc < 1024; pc += 448) { const int row = pc >> 4, seg = pc & 15; *(u32x4*)(rec + REC_Q + pc * 16) = *(const LAS u32x4*)(lds + CP_QN + row * 272 + seg * 16); }
            for (int pc = t2; pc < 512; pc += 448) { const int row = pc >> 3, seg = pc & 7; *(u32x4*)(rec + REC_ATT + pc * 16) = *(const LAS u32x4*)(lds + CP_ATT + row * 144 + seg * 16); }
            for (int pc = t2; pc < 1024; pc += 448) { const int row = pc >> 3, seg = pc & 7; *(u32x4*)(rec + REC_KT + pc * 16) = *(const LAS u32x4*)(lds + CP_KT + row * 144 + seg * 16); }
            if (t2 < 16) *(u32x4*)(rec + REC_G + t2 * 16) = *(const LAS u32x4*)(lds + CP_TAB + 256 + t2 * 16);
        }
        __syncthreads();
        for (int jb = wave; jb < 64; jb += 8) {
            f32x4 acc = (f32x4){0.f, 0.f, 0.f, 0.f};
            if (jb < 32) { const int mt = jb >> 3, nt = jb & 7;
#pragma unroll
                for (int ks = 0; ks < 2; ++ks) acc = mfma16(ld_frag16(lds + CP_T16 + (16 * mt + li) * 144 + (32 * ks + 8 * q) * 2), ld_frag16(lds + CP_VT + (16 * nt + li) * 144 + (32 * ks + 8 * q) * 2), acc);
                u32x2 o; o.x = pk2(acc[0], acc[1]); o.y = pk2(acc[2], acc[3]);
                *(u32x2*)(rec + REC_U + (size_t)((nt * 64 + lane) * 4 + mt) * 8) = o;
            } else { const int mt = (jb - 32) >> 2, nt = (jb - 32) & 3;
#pragma unroll
                for (int ks = 0; ks < 2; ++ks) acc = mfma16(ld_frag16(lds + CP_KGT + (16 * mt + li) * 144 + (32 * ks + 8 * q) * 2), ld_frag16(lds + CP_T16 + (16 * nt + li) * 144 + (32 * ks + 8 * q) * 2), acc);
                u32x2 o; o.x = pk2(acc[0], acc[1]); o.y = pk2(acc[2], acc[3]);
                *(u32x2*)(rec + REC_W + (size_t)((16 * nt + li) * 128 + 16 * mt + 4 * q) * 2) = o;
            }
        }
    }
    __syncthreads();
}
constexpr int SC_W = 0, SC_Q = 17408, SC_ATT = 34816, SC_KT = 44032, SC_G = 62464, SC_BUF = 62720;
__device__ __forceinline__ void gdn_chunk_scan(const Params& p, LAS unsigned char* lds, int tid, int wave, int lane, int bh) {
    const int b = bh >> 2, hh = bh & 3, q = lane >> 4, li = lane & 15;
    const unsigned char* rec0 = p.ws + WS_REC + (size_t)(bh * 64) * REC_BYTES;
    float* OB = (float*)(p.ws + WS_OBUF);
    u32x4 pf[7], pfg = (u32x4){0u, 0u, 0u, 0u}, pu[2];
#define SC_LOAD(nn) do { const unsigned char* r_ = rec0 + (size_t)(nn) * REC_BYTES; \
        _Pragma("unroll") for (int k_ = 0; k_ < 7; ++k_) pf[k_] = *(const u32x4*)(r_ + (size_t)(tid + 512 * k_) * 16); \
        if (tid < 16) pfg = *(const u32x4*)(r_ + REC_G + tid * 16); \
        pu[0] = *(const u32x4*)(r_ + REC_U + (size_t)(wave * 64 + lane) * 32); pu[1] = *(const u32x4*)(r_ + REC_U + (size_t)(wave * 64 + lane) * 32 + 16); } while (0)
#define SC_STORE(buf) do { LAS unsigned char* d_ = lds + (buf) * SC_BUF; \
        _Pragma("unroll") for (int k_ = 0; k_ < 4; ++k_) { const int pc_ = tid + 512 * (k_ & 1); *(LAS u32x4*)(d_ + (k_ < 2 ? SC_W : SC_Q) + (pc_ >> 4) * 272 + (pc_ & 15) * 16) = pf[k_]; } \
        { const int pc_ = tid; *(LAS u32x4*)(d_ + SC_ATT + (pc_ >> 3) * 144 + (pc_ & 7) * 16) = pf[4]; } \
        _Pragma("unroll") for (int k_ = 5; k_ < 7; ++k_) { const int pc_ = tid + 512 * (k_ - 5); *(LAS u32x4*)(d_ + SC_KT + (pc_ >> 3) * 144 + (pc_ & 7) * 16) = pf[k_]; } \
        if (tid < 16) *(LAS u32x4*)(d_ + SC_G + tid * 16) = pfg; } while (0)
    f32x4 S[8];
#pragma unroll
    for (int i = 0; i < 8; ++i) S[i] = (f32x4){0.f, 0.f, 0.f, 0.f};
    __syncthreads();
    SC_LOAD(0); SC_STORE(0);
    u32x4 cu[2]; cu[0] = pu[0]; cu[1] = pu[1];
    __syncthreads();
    for (int n = 0; n < 64; ++n) {
        const LAS unsigned char* L = lds + (n & 1) * SC_BUF;
        if (n + 1 < 64) SC_LOAD(n + 1);
        bf16x8 Sb[4];
#pragma unroll
        for (int ks = 0; ks < 4; ++ks) Sb[ks] = pack_frag(S[2 * ks], S[2 * ks + 1]);
        f32x4 a1[4], a2[4];
#pragma unroll
        for (int mt = 0; mt < 4; ++mt) { a1[mt] = (f32x4){0.f, 0.f, 0.f, 0.f}; a2[mt] = (f32x4){0.f, 0.f, 0.f, 0.f};
#pragma unroll
            for (int ks = 0; ks < 4; ++ks) { a1[mt] = mfma16(ld_frag8x2(L + SC_W + (16 * mt + li) * 272 + (32 * ks + 4 * q) * 2), Sb[ks], a1[mt]);
                a2[mt] = mfma16(ld_frag8x2(L + SC_Q + (16 * mt + li) * 272 + (32 * ks + 4 * q) * 2), Sb[ks], a2[mt]); } }
        const float g63 = *(const LAS float*)(L + SC_G + 63 * 4);
        f32x4 vn[4], vd[4], gam[4];
#pragma unroll
        for (int mt = 0; mt < 4; ++mt) { const f32x4 gi = *(const LAS f32x4*)(L + SC_G + (16 * mt + 4 * q) * 4);
            const unsigned ulo = (mt < 2) ? (mt == 0 ? cu[0].x : cu[0].z) : (mt == 2 ? cu[1].x : cu[1].z), uhi = (mt < 2) ? (mt == 0 ? cu[0].y : cu[0].w) : (mt == 2 ? cu[1].y : cu[1].w);
            const f32x4 uu = (f32x4){bf_lo(ulo), bf_hi(ulo), bf_lo(uhi), bf_hi(uhi)};
            vn[mt] = uu - a1[mt];
#pragma unroll
            for (int r = 0; r < 4; ++r) { gam[mt][r] = __expf(gi[r]); vd[mt][r] = vn[mt][r] * __expf(g63 - gi[r]); } }
        bf16x8 Vb[2], Vd[2];
#pragma unroll
        for (int ks = 0; ks < 2; ++ks) { Vb[ks] = pack_frag(vn[2 * ks], vn[2 * ks + 1]); Vd[ks] = pack_frag(vd[2 * ks], vd[2 * ks + 1]); }
#pragma unroll
        for (int mt = 0; mt < 4; ++mt) { f32x4 a3 = (f32x4){0.f, 0.f, 0.f, 0.f};
#pragma unroll
            for (int ks = 0; ks < 2; ++ks) a3 = mfma16(ld_frag8x2(L + SC_ATT + (16 * mt + li) * 144 + (32 * ks + 4 * q) * 2), Vb[ks], a3);
#pragma unroll
            for (int r = 0; r < 4; ++r) OB[(size_t)(b * T + n * 64 + 16 * mt + 4 * q + r) * 512 + hh * 128 + 16 * wave + li] = gam[mt][r] * a2[mt][r] + a3[r]; }
        const float eg = __expf(g63);
#pragma unroll
        for (int mt = 0; mt < 8; ++mt) { f32x4 a4 = (f32x4){0.f, 0.f, 0.f, 0.f};
#pragma unroll
            for (int ks = 0; ks < 2; ++ks) a4 = mfma16(ld_frag8x2(L + SC_KT + (16 * mt + li) * 144 + (32 * ks + 4 * q) * 2), Vd[ks], a4);
            S[mt] = S[mt] * eg + a4; }
        if (n + 1 < 64) { SC_STORE((n + 1) & 1); cu[0] = pu[0]; cu[1] = pu[1]; }
        __syncthreads();
    }
#undef SC_LOAD
#undef SC_STORE
}

__device__ __forceinline__ void gdn_out(const Params& p, int layer, int gw, int NGW, int lane) {
    const bf16* H = (const bf16*)(p.ws + WS_H); bf16* YS = (bf16*)(p.ws + WS_YS); const float* OB = (const float*)(p.ws + WS_OBUF);
    const float w0 = p.in[I_GNW][layer * 128 + 2 * lane], w1 = p.in[I_GNW][layer * 128 + 2 * lane + 1];
    for (int it = gw; it < M * 4; it += NGW) { const int m = it >> 2, hh = it & 3;
        f32x2 o = *(const f32x2*)(OB + (size_t)m * 512 + hh * 128 + 2 * lane);
        const float rs = 1.0f / sqrtf(wave_sum(o[0] * o[0] + o[1] * o[1]) * (1.0f / 128.0f) + EPS);
        const unsigned zw = *(const unsigned*)(H + (size_t)m * DH + HZ + hh * 128 + 2 * lane);
        *(unsigned*)(YS + (size_t)m * 2048 + hh * 128 + 2 * lane) = pk2(o[0] * rs * w0 * siluf_(bf_lo(zw)), o[1] * rs * w1 * siluf_(bf_hi(zw)));
    }
}
__device__ __forceinline__ void sum_gated(const Params& p, int gtid, int NGT) {
    const bf16* H = (const bf16*)(p.ws + WS_H); bf16* MG = (bf16*)(p.ws + WS_MERGED);
    for (int it = gtid; it < M * 128; it += NGT) { const int m = it >> 7, c8 = (it & 127) * 8; const bf16* r = H + (size_t)m * DH + HGATE + c8;
        float a[8], b[8];
        unpack8(*(const u32x4*)r, a);
#pragma unroll
        for (int br = 1; br < 4; ++br) { unpack8(*(const u32x4*)(r + br * 1024), b);
#pragma unroll
            for (int i = 0; i < 8; ++i) a[i] += b[i]; }
        *(u32x4*)(MG + (size_t)m * D + c8) = pack8(a); }
}

__device__ __forceinline__ void moe_route(const Params& p, int layer, LAS unsigned char* lds, int tid, int wave, int lane) {
    LAS float* xs = (LAS float*)lds;
    LAS int* hist = (LAS int*)(lds + LDSCTL_OFF + LC_TAB);
    bf16* XN = (bf16*)(p.ws + WS_XN);
    int* route_e = (int*)(p.ws + WS_ROUTE); float* route_w = (float*)(p.ws + WS_ROUTE + (size_t)M * 2 * 4);
    int* cnt = (int*)(p.ws + WS_MOETAB + (size_t)NROWS_MAX * 8);
    const float* rg = p.in[I_RGRP] + (size_t)layer * D * 8; const float* re = p.in[I_REXP] + (size_t)layer * D * 64;
    f32x4 nw[4];
#pragma unroll
    for (int j = 0; j < 4; ++j) nw[j] = *(const f32x4*)(p.in[I_MOENW] + layer * D + 4 * lane + 256 * j);
    for (int vb = blockIdx.x; vb < M / 128; vb += gridDim.x) {
        if (tid < 64) hist[tid] = 0;
        for (int tile = 0; tile < 4; ++tile) {
            const int m0 = vb * 128 + tile * 32;
            __syncthreads();
            for (int r = wave * 4; r < wave * 4 + 4; ++r) { const int m = m0 + r; const float* xr = p.out + (size_t)m * D;
                f32x4 v[4]; float ss = 0.f;
#pragma unroll
                for (int j = 0; j < 4; ++j) { v[j] = *(const f32x4*)(xr + 4 * lane + 256 * j); ss += (v[j][0] * v[j][0] + v[j][1] * v[j][1]) + (v[j][2] * v[j][2] + v[j][3] * v[j][3]); }
                const float rs = 1.0f / sqrtf(wave_sum(ss) * (1.0f / D) + EPS);
#pragma unroll
                for (int j = 0; j < 4; ++j) { v[j] = v[j] * rs * nw[j]; *(LAS f32x4*)(xs + r * 1024 + 4 * lane + 256 * j) = v[j];
                    u32x2 o; o.x = pk2(v[j][0], v[j][1]); o.y = pk2(v[j][2], v[j][3]); *(u32x2*)(XN + (size_t)m * D + 4 * lane + 256 * j) = o; } }
            __syncthreads();
            float ae[32], ag[32];
#pragma unroll
            for (int r = 0; r < 32; ++r) { ae[r] = 0.f; ag[r] = 0.f; }
            for (int k = wave * 128; k < wave * 128 + 128; k += 4) {
                float we[4], wg[4];
#pragma unroll
                for (int q = 0; q < 4; ++q) { we[q] = re[(size_t)(k + q) * 64 + lane]; wg[q] = rg[(size_t)(k + q) * 8 + (lane & 7)]; }
#pragma unroll
                for (int r = 0; r < 32; ++r) { const f32x4 x = *(const LAS f32x4*)(xs + r * 1024 + k);
                    ae[r] += x[0] * we[0] + x[1] * we[1] + x[2] * we[2] + x[3] * we[3];
                    ag[r] += x[0] * wg[0] + x[1] * wg[1] + x[2] * wg[2] + x[3] * wg[3]; }
            }
            __syncthreads();
            LAS float* part = xs;
#pragma unroll
            for (int r = 0; r < 32; ++r) { part[(wave * 32 + r) * 72 + lane] = ae[r]; if (lane < 8) part[(wave * 32 + r) * 72 + 64 + lane] = ag[r]; }
            __syncthreads();
            for (int r = wave * 4; r < wave * 4 + 4; ++r) { const int m = m0 + r;
                float le = 0.f, lg = 0.f;
#pragma unroll
                for (int w = 0; w < 8; ++w) { le += part[(w * 32 + r) * 72 + lane]; lg += part[(w * 32 + r) * 72 + 64 + (lane & 7)]; }
                float gv[8];
#pragma unroll
                for (int i = 0; i < 8; ++i) gv[i] = __shfl(lg, i);
                int grp = 0; float gmax = gv[0];
#pragma unroll
                for (int i = 1; i < 8; ++i) if (gv[i] > gmax) { gmax = gv[i]; grp = i; }
                float gs = 0.f;
#pragma unroll
                for (int i = 0; i < 8; ++i) gs += __expf(gv[i] - gmax);
                const float psel = 1.0f / gs;
                float ev[8];
#pragma unroll
                for (int i = 0; i < 8; ++i) ev[i] = __shfl(le, grp * 8 + i);
                int i1 = 0; float e1 = ev[0];
#pragma unroll
                for (int i = 1; i < 8; ++i) if (ev[i] > e1) { e1 = ev[i]; i1 = i; }
                int i2 = -1; float e2 = -3.0e38f;
#pragma unroll
                for (int i = 0; i < 8; ++i) if (i != i1 && ev[i] > e2) { e2 = ev[i]; i2 = i; }
                const float x2 = __expf(e2 - e1), w1 = psel / (1.0f + x2), w2 = psel * x2 / (1.0f + x2);
                if (lane == 0) { route_e[(size_t)m * 2] = grp * 8 + i1; route_e[(size_t)m * 2 + 1] = grp * 8 + i2; route_w[(size_t)m * 2] = w1; route_w[(size_t)m * 2 + 1] = w2;
                    atomicAdd((int*)(hist + grp * 8 + i1), 1); atomicAdd((int*)(hist + grp * 8 + i2), 1); }
            }
        }
        __syncthreads();
        if (tid < 64) cnt[vb * 64 + tid] = hist[tid];
        __syncthreads();
    }
}
__device__ __forceinline__ void moe_dispatch(const Params& p, LAS unsigned char* lds, int tid, int wave, int lane) {
    LAS int* tab = (LAS int*)(lds + LDSCTL_OFF + LC_TAB);
    const bf16* XN = (const bf16*)(p.ws + WS_XN); bf16* XS = (bf16*)(p.ws + WS_XS);
    const int* route_e = (const int*)(p.ws + WS_ROUTE); const float* route_w = (const float*)(p.ws + WS_ROUTE + (size_t)M * 2 * 4);
    int* row_code = (int*)(p.ws + WS_MOETAB); float* row_w = (float*)(p.ws + WS_MOETAB + (size_t)NROWS_MAX * 4);
    const int* cnt = (const int*)(p.ws + WS_MOETAB + (size_t)NROWS_MAX * 8); int* blk_e = (int*)(p.ws + WS_MOETAB + (size_t)NROWS_MAX * 8 + 256 * 64 * 4);
    for (int vb = blockIdx.x; vb < M / 128; vb += gridDim.x) {
        __syncthreads();
        if (tid < 64) { int run = 0, base = 0; for (int v = 0; v < M / 128; ++v) { if (v == vb) base = run; run += cnt[v * 64 + tid]; } tab[64 + tid] = run; tab[128 + tid] = base; }
        __syncthreads();
        if (tid == 0) { int s = 0; for (int e = 0; e < 64; ++e) { tab[e] = s; s += (tab[64 + e] + 255) / 256 * 256; } tab[704] = s; }
        if (tid < 256) tab[192 + tid] = route_e[(size_t)vb * 256 + tid];
        __syncthreads();
        if (tid < 256) { const int e = tab[192 + tid]; int rank = 0; for (int a = 0; a < tid; ++a) rank += (tab[192 + a] == e) ? 1 : 0;
            const int pos = tab[e] + tab[128 + e] + rank; tab[448 + tid] = pos;
            row_code[pos] = ((vb * 128 + (tid >> 1)) << 1) | (tid & 1); row_w[pos] = route_w[(size_t)vb * 256 + tid]; }
        if (vb < 64) { const int ps = tab[vb], tot = tab[64 + vb], pe = ps + (tot + 255) / 256 * 256;
            for (int r = ps + tot + tid; r < pe; r += 512) row_code[r] = -1;
            for (int b = ps / 256 + tid; b < pe / 256; b += 512) blk_e[b] = vb;
            if (tid == 0) { blk_e[NROWBLK_MAX + 64 + vb] = ps / 256; blk_e[NROWBLK_MAX + 128 + vb] = (pe - ps) / 256; }
            if (vb == 63 && tid == 0) blk_e[NROWBLK_MAX] = tab[704] / 256; }
        __syncthreads();
        for (int a = wave; a < 256; a += 8) { const int pos = tab[448 + a]; const int tok = vb * 128 + (a >> 1);
            const u32x4* src = (const u32x4*)(XN + (size_t)tok * D); u32x4* dst = (u32x4*)(XS + (size_t)pos * D);
            dst[lane] = src[lane]; dst[lane + 64] = src[lane + 64]; }
    }
    __syncthreads();
}

__global__ void __launch_bounds__(512, 2) fwd(Params p) {
    extern __shared__ __attribute__((aligned(16))) unsigned char lds_raw[];
    LAS unsigned char* lds = (LAS unsigned char*)lds_raw;
    const int tid0 = threadIdx.x;
    const int G = gridDim.x, NGW = G * 8, NGT = G * 512;
#define FRESH() int tid = tid0; asm volatile("" : "+v"(tid)); const int lane = tid & 63, wave = __builtin_amdgcn_readfirstlane(tid >> 6); const int gw = blockIdx.x * 8 + wave, gtid = blockIdx.x * 512 + tid; (void)lane; (void)gw; (void)gtid
    for (int u = tid0; u < (LDS_BYTES - LDSCTL_OFF) / 4; u += 512) ((LAS unsigned*)(lds + LDSCTL_OFF))[u] = 0u;
    __syncthreads();
    const int lo = p.ph_lo, hi = p.ph_hi;
    XcdBarrier bar; bar.bar = (unsigned*)(p.ws + WS_CTL) + CW_BAR; bar.x = 0; bar.st = (volatile LAS unsigned*)(lds + LDSCTL_OFF + LC_BAR);
    if (hi - lo > 1) bar = xcd_barrier_post((unsigned*)(p.ws + WS_CTL) + CW_BAR, (volatile LAS unsigned*)(lds + LDSCTL_OFF + LC_BAR));
#ifndef PHASE_MASK
#define PHASE_MASK 0x1fff
#endif
#define IN(k) (((PHASE_MASK >> ((k) == PH_FINAL ? 12 : ((k) % PH_PER_LAYER))) & 1) && lo <= (k) && (k) < hi)
#define REPS(k) ((((REPEAT_MASK) >> (k)) & 1) && layer == 0 ? 2 : 1)
#define SEAM(k) do { if (IN(k) && IN((k) + 1)) xcd_barrier(bar); } while (0)

    for (int layer = 0; layer < NLAYER; ++layer) {
        const int g0 = layer * PH_PER_LAYER;
        bf16* Hb = (bf16*)(p.ws + WS_H);
        for (int rep_ = 0; rep_ < REPS(0); ++rep_) if (IN(g0 + 0)) { if (rep_) __syncthreads(); FRESH();
            if (layer == 0) { prep_static_weights(p, gw, NGW, lane); __syncthreads(); norm_phase<0>(p, layer, lds, gw, NGW, tid, lane); }
            else norm_phase<1>(p, layer, lds, gw, NGW, tid, lane);
        }
        SEAM(g0 + 0);
        for (int rep_ = 0; rep_ < REPS(1); ++rep_) if (IN(g0 + 1)) { if (rep_) __syncthreads(); FRESH();
            SchedH S; S.to.init(M / 256, DH / 256, G, (int)blockIdx.x); S.A = (const char*)(p.ws + WS_XN); S.B = (const char*)(p.ws + WS_WIN + layer * WIN_L);
            EpiStoreBf16 E{Hb, DH};
            pg8::gemm_phase(lds, tid, D, D, D, S, E);
        }
        SEAM(g0 + 1);
        for (int rep_ = 0; rep_ < REPS(2); ++rep_) if (IN(g0 + 2)) { if (rep_) __syncthreads(); FRESH(); gdn_chunk_prep(p, layer, lds, tid, wave, lane); }
        SEAM(g0 + 2);
        for (int rep_ = 0; rep_ < REPS(3); ++rep_) if (IN(g0 + 3)) { if (rep_) __syncthreads(); FRESH();
            if ((int)blockIdx.x < 32) gdn_chunk_scan(p, lds, tid, wave, lane, (int)blockIdx.x);
            else { const int vb = (int)blockIdx.x - 32, nvb = G - 32;
                shortconv(p, layer, vb * 512 + tid, nvb * 512);
                conformer(p, layer, lds, tid, wave, lane, vb, nvb);
                __syncthreads();
                gmlp(p, layer, lds, tid, wave, lane, vb, nvb); }
        }
        SEAM(g0 + 3);
        for (int rep_ = 0; rep_ < REPS(4); ++rep_) if (IN(g0 + 4)) { if (rep_) __syncthreads(); FRESH(); gdn_out(p, layer, gw, NGW, lane); }
        SEAM(g0 + 4);
        if (IN(g0 + 5)) { FRESH();
            SchedBranch S; S.to.init(M / 256, 16, G, (int)blockIdx.x); S.YS = (const char*)(p.ws + WS_YS); S.WBR = (const char*)(p.ws + WS_WBR + layer * WBR_L);
            EpiGate E{Hb, DH};
            pg8::gemm_phase(lds, tid, 512, 2048, 512, S, E);
        }
        SEAM(g0 + 5);
        for (int rep_ = 0; rep_ < REPS(6); ++rep_) if (IN(g0 + 6)) { if (rep_) __syncthreads(); FRESH(); sum_gated(p, gtid, NGT); }
        SEAM(g0 + 6);
        for (int rep_ = 0; rep_ < REPS(7); ++rep_) if (IN(g0 + 7)) { if (rep_) __syncthreads(); FRESH();
            const int NGB = G / 2;
            if ((int)blockIdx.x < NGB) {
                SchedOut S; S.to.init(M / 256, 4, NGB, (int)blockIdx.x); S.A = (const char*)(p.ws + WS_MERGED); S.B = (const char*)(p.ws + WS_WOUT + layer * WOUT_L);
                EpiResF32 E{layer == 0 ? p.in[I_X] : p.out, p.out};
                pg8::gemm_phase(lds, tid, D, D, D, S, E);
            } else prep_moe_weights(p, layer, ((int)blockIdx.x - NGB) * 8 + wave, (G - NGB) * 8, lane);
        }
        SEAM(g0 + 7);
        for (int rep_ = 0; rep_ < REPS(8); ++rep_) if (IN(g0 + 8)) { if (rep_) __syncthreads(); FRESH(); moe_route(p, layer, lds, tid, wave, lane); }
        SEAM(g0 + 8);
        for (int rep_ = 0; rep_ < REPS(9); ++rep_) if (IN(g0 + 9)) { if (rep_) __syncthreads(); FRESH(); moe_dispatch(p, lds, tid, wave, lane); }
        SEAM(g0 + 9);
        if (IN(g0 + 10) || IN(g0 + 11)) { FRESH();
            LAS int* tb = (LAS int*)(lds + LDSCTL_OFF + LC_TAB);
            const int* est = (const int*)(p.ws + WS_MOETAB + (size_t)NROWS_MAX * 8 + 256 * 64 * 4) + NROWBLK_MAX + 64;
            const int NX = (G % 8 == 0) ? 8 : 1, x = (int)blockIdx.x % NX, nk = 64 / NX;
            __syncthreads();
            if (tid < nk) { tb[160 + tid] = est[x + NX * tid]; tb[240 + tid] = est[64 + x + NX * tid]; }
            __syncthreads();
            if (tid == 0) { int s = 0; for (int k = 0; k < nk; ++k) { tb[k] = s; tb[80 + k] = tb[160 + k]; s += tb[240 + k] * 4; } tb[nk] = s; }
            __syncthreads();
        }
        for (int rep_ = 0; rep_ < REPS(10); ++rep_) if (IN(g0 + 10)) { if (rep_) __syncthreads(); FRESH();
            LAS int* tb = (LAS int*)(lds + LDSCTL_OFF + LC_TAB); const int NX = (G % 8 == 0) ? 8 : 1, nk = 64 / NX;
            SchedMoe S; S.nux = tb[nk]; S.nrank = G / NX; S.rank = (int)blockIdx.x / NX; S.nk = nk; S.x = (int)blockIdx.x % NX; S.NX = NX; S.cum = tb; S.rb0 = tb + 80;
            S.A = (const char*)(p.ws + WS_XS); S.a_blk = (size_t)256 * D * 2; S.W = (const char*)(p.ws + WS_MOEW); S.w_e = WGU_E; S.w_pn = (size_t)256 * D * 2; S.cmul = 128;
            EpiSwiglu E{(bf16*)(p.ws + WS_HB)};
            pg8::gemm_phase(lds, tid, D, D, D, S, E);
        }
        SEAM(g0 + 10);
        for (int rep_ = 0; rep_ < REPS(11); ++rep_) if (IN(g0 + 11)) { if (rep_) __syncthreads(); FRESH();
            LAS int* tb = (LAS int*)(lds + LDSCTL_OFF + LC_TAB); const int NX = (G % 8 == 0) ? 8 : 1, nk = 64 / NX;
            SchedMoe S; S.nux = tb[nk]; S.nrank = G / NX; S.rank = (int)blockIdx.x / NX; S.nk = nk; S.x = (int)blockIdx.x % NX; S.NX = NX; S.cum = tb; S.rb0 = tb + 80;
            S.A = (const char*)(p.ws + WS_HB); S.a_blk = (size_t)256 * DE * 2; S.W = (const char*)(p.ws + WS_WD); S.w_e = WD_E; S.w_pn = (size_t)256 * DE * 2; S.cmul = 256;
            EpiScatter E{(bf16*)(p.ws + WS_Y), (const int*)(p.ws + WS_MOETAB), (const float*)(p.ws + WS_MOETAB + (size_t)NROWS_MAX * 4)};
            pg8::gemm_phase(lds, tid, DE, DE, DE, S, E);
        }
        SEAM(g0 + 11);
    }
    if (IN(PH_FINAL)) { FRESH(); norm_phase<2>(p, 0, lds, gw, NGW, tid, lane); }
#undef IN
#undef SEAM
}

extern "C" void kernel_launch(void* const* d_in, const int* in_sizes, int n_in, void* d_out, int out_size, void* d_ws, size_t ws_size, hipStream_t stream) {
    static int grid = 0;
    if (grid == 0) {
        if (n_in != 25 || out_size != M * D || ws_size < WS_END) { fprintf(stderr, "kernel_launch: unexpected shapes / workspace (n_in %d out %d ws %zu, need %zu)\n", n_in, out_size, ws_size, (size_t)WS_END); grid = -1; return; }
        int dev = 0, cus = 0, per_cu = 0;
        if (hipGetDevice(&dev) != hipSuccess || hipDeviceGetAttribute(&cus, hipDeviceAttributeMultiprocessorCount, dev) != hipSuccess) { grid = -1; return; }
        if (hipFuncSetAttribute((const void*)fwd, hipFuncAttributeMaxDynamicSharedMemorySize, LDS_BYTES) != hipSuccess) { fprintf(stderr, "kernel_launch: hipFuncSetAttribute failed\n"); grid = -1; return; }
        if (hipOccupancyMaxActiveBlocksPerMultiprocessor(&per_cu, (const void*)fwd, 512, LDS_BYTES) != hipSuccess || per_cu < 1) { fprintf(stderr, "kernel_launch: occupancy query says %d\n", per_cu); }
        (void)hipGetLastError();
        grid = cus;
    }
    if (grid < 0) return;
    hipMemsetAsync((char*)d_ws + WS_CTL, 0, CTL_BYTES, stream);
    Params p{};
    for (int i = 0; i < 25; ++i) p.in[i] = (const float*)d_in[i];
    p.out = (float*)d_out; p.ws = (unsigned char*)d_ws;
#if N_LAUNCH_MODE == 1
    p.ph_lo = 0; p.ph_hi = PH_TOTAL;
    hipLaunchKernelGGL(fwd, dim3(grid), dim3(512), LDS_BYTES, stream, p);
#else
    for (int k = 0; k < PH_TOTAL; ++k) { p.ph_lo = k; p.ph_hi = k + 1; hipLaunchKernelGGL(fwd, dim3(grid), dim3(512), LDS_BYTES, stream, p); }
#endif
}
```

```cpp
#include <hip/hip_runtime.h>
#include <cstdio>
#include <cstdint>

#ifndef REPEAT_MASK
#define REPEAT_MASK 0
#endif
#ifndef N_LAUNCH_MODE
#define N_LAUNCH_MODE 1
#endif

#define LAS __attribute__((address_space(3)))
typedef unsigned short bf16;
typedef short bf16x8 __attribute__((ext_vector_type(8)));
typedef float f32x4 __attribute__((ext_vector_type(4)));
typedef float f32x2 __attribute__((ext_vector_type(2)));
typedef unsigned u32x4 __attribute__((ext_vector_type(4)));
typedef unsigned u32x2 __attribute__((ext_vector_type(2)));

constexpr int NB = 8, T = 4096, D = 1024, M = NB * T, NLAYER = 2;
constexpr int DIN = 9736, DH = 9728;
constexpr int HQ = 0, HK = 512, HV = 1024, HZ = 1536, HCONF = 2048, HGMLP = 3072, HSC = 4096, HGATE = 5632;
constexpr int NE = 64, DE = 512;
constexpr float EPS = 1e-6f;
constexpr int NROWBLK_MAX = 320, NROWS_MAX = NROWBLK_MAX * 256;

constexpr size_t MiB = 1u << 20;
constexpr size_t WS_CTL = 0, CTL_BYTES = 1 * MiB;
constexpr size_t WS_WIN = 2 * MiB;
constexpr size_t WIN_L = (size_t)DH * D * 2;
constexpr size_t WS_WBR = 40 * MiB;
constexpr size_t WBR_L = (size_t)4 * D * 512 * 2;
constexpr size_t WS_WOUT = 48 * MiB;
constexpr size_t WOUT_L = (size_t)D * D * 2;
constexpr size_t WS_XN = 52 * MiB;
constexpr size_t WS_SMALL = 116 * MiB;
constexpr size_t WS_ROUTE = 117 * MiB;
constexpr size_t WS_MOETAB = 118 * MiB;
constexpr size_t WS_YS = 120 * MiB;
constexpr size_t WS_REC = 248 * MiB;
constexpr size_t WS_MERGED = WS_REC;
constexpr size_t WS_OBUF = WS_XN;
constexpr int REC_W = 0, REC_Q = 16384, REC_ATT = 32768, REC_KT = 40960, REC_U = 57344, REC_G = 73728, REC_BYTES = 73984;
static_assert(WS_REC + (size_t)2048 * REC_BYTES <= 410 * MiB, "chunk records");
constexpr size_t WS_H = 410 * MiB;
constexpr size_t WS_MOEW = 410 * MiB;
constexpr size_t WGU_E = (size_t)1024 * 1024 * 2, WD_E = (size_t)1024 * 512 * 2;
constexpr size_t WS_WD = WS_MOEW + 64 * WGU_E;
constexpr size_t WS_XS = 602 * MiB;
constexpr size_t WS_HB = 762 * MiB;
constexpr size_t WS_Y = 842 * MiB;
constexpr size_t WS_END = 1018 * MiB;
static_assert(WS_H + (size_t)M * DH * 2 <= WS_END && WS_Y + (size_t)2 * M * D * 2 <= WS_END, "ws map");

constexpr int CW_BAR = 4096;
constexpr int STAGE_LDS = 131072, LDSCTL_OFF = 131072, LDS_BYTES = 147456;
constexpr int LC_BAR = 0;
constexpr int LC_MISC = 64;
constexpr int LC_TAB = 1024;

__device__ __forceinline__ float bf_lo(unsigned w) { return __uint_as_float(w << 16); }
__device__ __forceinline__ float bf_hi(unsigned w) { return __uint_as_float(w & 0xffff0000u); }
__device__ __forceinline__ float bf2f(bf16 b) { return __uint_as_float(((unsigned)b) << 16); }
__device__ __forceinline__ unsigned f2bf(float f) { unsigned u = __float_as_uint(f); return (u + 0x7fffu + ((u >> 16) & 1u)) >> 16; }
__device__ __forceinline__ unsigned pk2(float lo, float hi) { return f2bf(lo) | (f2bf(hi) << 16); }
__device__ __forceinline__ void unpack8(const u32x4 v, float (&f)[8]) {
    f[0] = bf_lo(v.x); f[1] = bf_hi(v.x); f[2] = bf_lo(v.y); f[3] = bf_hi(v.y); f[4] = bf_lo(v.z); f[5] = bf_hi(v.z); f[6] = bf_lo(v.w); f[7] = bf_hi(v.w);
}
__device__ __forceinline__ u32x4 pack8(const float (&f)[8]) { u32x4 o; o.x = pk2(f[0], f[1]); o.y = pk2(f[2], f[3]); o.z = pk2(f[4], f[5]); o.w = pk2(f[6], f[7]); return o; }
__device__ __forceinline__ float wave_sum(float v) {
#pragma unroll
    for (int o = 1; o < 64; o <<= 1) v += __shfl_xor(v, o);
    return v;
}
__device__ __forceinline__ float fexp(float x) { return __builtin_amdgcn_exp2f(x * 1.4426950408889634f); }
__device__ __forceinline__ float frcp(float x) { return __builtin_amdgcn_rcpf(x); }
__device__ __forceinline__ float sigmoidf_(float x) { return frcp(1.0f + fexp(-x)); }
__device__ __forceinline__ float siluf_(float x) { return x * frcp(1.0f + fexp(-x)); }
__device__ __forceinline__ float gelu_tanh(float x) { const float u = 0.7978845608028654f * (x + 0.044715f * x * x * x); return x * frcp(1.0f + fexp(-2.0f * u)); }
__device__ __forceinline__ float softplusf_(float x) { return fmaxf(x, 0.f) + log1pf(__expf(-fabsf(x))); }

#define XB_TMO      128
#define XB_XCNT(j)  (256  + 64 * (j))
#define XB_XSUB(j)  (1280 + 64 * (j))
#define XB_XGEN(j)  (2304 + 64 * (j))
#define XB_TOP      3328
#define XB_TOPGEN   3392
#define XCD_BAR_WORDS 3456
#define XB_SPIN_CAP (1u << 18)
__device__ __forceinline__ unsigned xb_ld(unsigned* p)              { return __hip_atomic_load(p, __ATOMIC_RELAXED, __HIP_MEMORY_SCOPE_AGENT); }
__device__ __forceinline__ unsigned xb_add(unsigned* p, unsigned v) { return __hip_atomic_fetch_add(p, v, __ATOMIC_RELAXED, __HIP_MEMORY_SCOPE_AGENT); }
__device__ __forceinline__ unsigned xb_xcc_id() { return (unsigned)__builtin_amdgcn_s_getreg((3 << 11) | 20) & 0xFu; }
#define XB_SPIN(cond, bar) do { unsigned _sp = 0; while (cond) { __builtin_amdgcn_s_sleep(1); \
    if ((++_sp & 255u) == 0u) { if (xb_ld(&(bar)[XB_TMO])) break; if (_sp > XB_SPIN_CAP) { atomicAdd(&(bar)[XB_TMO], 1u); break; } } } } while (0)
struct XcdBarrier { unsigned* bar; unsigned x; volatile LAS unsigned* st; };
__device__ __forceinline__ XcdBarrier xcd_barrier_post(unsigned* bar, volatile LAS unsigned* st) {
    XcdBarrier b; b.bar = bar; b.x = xb_xcc_id(); b.st = st;
    if (threadIdx.x == 0) (void)xb_add(&bar[XB_XCNT(b.x)], 1u);
    return b;
}
__device__ __forceinline__ void xcd_barrier_complete(unsigned* bar, unsigned x, unsigned& nloc, unsigned& nx) {
    const unsigned G = gridDim.x * gridDim.y * gridDim.z;
    unsigned sum, cnt, mine, sp = 0u;
    for (;;) {
        sum = 0u; cnt = 0u; mine = 0u;
#pragma unroll
        for (unsigned j = 0; j < 16; ++j) { const unsigned c = xb_ld(&bar[XB_XCNT(j)]); sum += c; cnt += (c > 0u) ? 1u : 0u; mine = (j == x) ? c : mine; }
        if (sum == G) break;
        __builtin_amdgcn_s_sleep(1);
        if ((++sp & 255u) == 0u) { if (xb_ld(&bar[XB_TMO])) break; if (sp > XB_SPIN_CAP) { atomicAdd(&bar[XB_TMO], 1u); break; } }
    }
    nloc = mine > 0u ? mine : 1u; nx = cnt > 0u ? cnt : 1u;
}
__device__ __forceinline__ void xcd_barrier(const XcdBarrier& b) {
    asm volatile("s_waitcnt vmcnt(0)" ::: "memory");
    __syncthreads();
    if (threadIdx.x == 0) {
        unsigned* bar = b.bar;
        __builtin_amdgcn_s_waitcnt(0);
        unsigned nloc = b.st[0], nx = b.st[1];
        if (nloc == 0u) { xcd_barrier_complete(bar, b.x, nloc, nx); b.st[0] = nloc; b.st[1] = nx; }
        const unsigned old = xb_add(&bar[XB_XSUB(b.x)], 1u);
        const unsigned gen = old / nloc;
        if (old + 1u == (gen + 1u) * nloc) {
            __builtin_amdgcn_fence(__ATOMIC_RELEASE, "agent");
            asm volatile("s_waitcnt vmcnt(0)" ::: "memory");
            const unsigned og = xb_add(&bar[XB_TOP], 1u);
            const unsigned tg = og / nx;
            if (og + 1u == (tg + 1u) * nx) xb_add(&bar[XB_TOPGEN], 1u);
            else XB_SPIN(xb_ld(&bar[XB_TOPGEN]) == tg, bar);
            __builtin_amdgcn_fence(__ATOMIC_ACQUIRE, "agent");
            xb_add(&bar[XB_XGEN(b.x)], 1u);
            asm volatile("s_waitcnt vmcnt(0)" ::: "memory");
        } else {
            XB_SPIN(xb_ld(&bar[XB_XGEN(b.x)]) == gen, bar);
            __builtin_amdgcn_fence(__ATOMIC_ACQUIRE, "agent");
            asm volatile("s_waitcnt vmcnt(0)" ::: "memory");
        }
    }
    __syncthreads();
}

namespace pg8 {
constexpr int BM = 256, BK = 64, HALF = 128, HTB = HALF * BK * 2, STAGE_BYTES = 8 * HTB, NXCD = 8, WGM = 8;
__host__ __device__ __forceinline__ int lds_byte(int r, int c) { const int st = (r >> 4) * 2 + (c >> 5), rr = r & 15, cc = c & 31, ob = rr * 64 + cc * 2; return st * 1024 + (ob ^ (((ob >> 9) & 1) << 5)); }
__host__ __device__ __forceinline__ void stage_rc(int b, int& R, int& C) { const int st = b / 1024, sb = b % 1024, swz = sb ^ (((sb >> 9) & 1) << 5); R = (st >> 1) * 16 + swz / 64; C = (st & 1) * 32 + (swz % 64) / 2; }
__host__ __device__ __forceinline__ int perm32(int rho) { const int n = rho >> 4, i = rho & 15; return 8 * (i >> 2) + 4 * n + (i & 3); }

struct Unit { const char* A; const char* B; int r0, c0; };

struct TileOrder {
    int nM, nN, nwg, G, c;
    __device__ void init(int nM_, int nN_, int G_, int c_) { nM = nM_; nN = nN_; nwg = nM * nN; G = G_; c = c_; }
    __device__ bool next(int i, int& pm, int& pn) const {
        const long L = (long)i * G + c; if (L >= nwg) return false;
        int wgid = (int)L; { const int q = nwg / NXCD, r = nwg % NXCD, xcd = wgid % NXCD, off = wgid / NXCD; wgid = (xcd < r ? xcd * (q + 1) : r * (q + 1) + (xcd - r) * q) + off; }
        const int nig = WGM * nN, gid = wgid / nig, fm = gid * WGM, gsz = (nM - fm) < WGM ? (nM - fm) : WGM;
        pm = fm + ((wgid % nig) % gsz); pn = (wgid % nig) / gsz; return true;
    }
};
__device__ __forceinline__ unsigned cvt_pk_bf16(float lo, float hi) { unsigned r; asm volatile("v_cvt_pk_bf16_f32 %0, %1, %2" : "=v"(r) : "v"(lo), "v"(hi)); return r; }

template <class Epi, class Sched>
__device__ __forceinline__ void gemm_phase(LAS unsigned char* lds, const int tid, const int K, const int lda, const int ldb, const Sched& S, const Epi& E) {
    const int wid = __builtin_amdgcn_readfirstlane(tid >> 6), lane = tid & 63, wr = wid >> 2, wc = wid & 3, fr = lane & 15, fq = lane >> 4;
    const int nt = K / BK;
    unsigned voffA[2], voffB[2];
#pragma unroll
    for (int i = 0; i < 2; ++i) { int R, C; stage_rc(tid * 16 + i * 8192, R, C); const int Rb = Epi::PERM ? ((R & ~31) + perm32(R & 31)) : R;
        voffA[i] = (unsigned)(R * lda + C) * 2u; voffB[i] = (unsigned)(Rb * ldb + C) * 2u; }
    const size_t kstep = (size_t)(BK * 2);
    const size_t hstepA = (size_t)HALF * lda * 2, hstepB = (size_t)HALF * ldb * 2;
    const unsigned ldsw = (unsigned)wid * 1024u;
    const int aoff = lds_byte(wr * 64 + fr, fq * 8), boff = lds_byte(wc * 32 + fr, fq * 8);
#define PG8_SA(b, h) (((b) * 2 + (h)) * HTB)
#define PG8_SB(b, h) ((4 + (b) * 2 + (h)) * HTB)
#define PG8_STAGE(bufoff, gbase, voff) do { _Pragma("unroll") for (int _i = 0; _i < 2; ++_i) \
        __builtin_amdgcn_global_load_lds((const unsigned*)((const char*)(gbase) + (voff)[_i]), (LAS unsigned*)(lds + (bufoff) + ldsw + _i * 8192), 16, 0, 0); } while (0)
#define PG8_LDA(dst, b, h) do { _Pragma("unroll") for (int m = 0; m < 4; ++m) _Pragma("unroll") for (int k = 0; k < 2; ++k) dst[m][k] = *(const LAS bf16x8*)(lds + PG8_SA(b, h) + aoff + m * 2048 + k * 1024); } while (0)
#define PG8_LDB(dst, b, h) do { _Pragma("unroll") for (int n = 0; n < 2; ++n) _Pragma("unroll") for (int k = 0; k < 2; ++k) dst[n][k] = *(const LAS bf16x8*)(lds + PG8_SB(b, h) + boff + n * 2048 + k * 1024); } while (0)
#define PG8_MMA(ai, bj, At, Bt) do { __builtin_amdgcn_s_setprio(1); _Pragma("unroll") for (int m = 0; m < 4; ++m) _Pragma("unroll") for (int n = 0; n < 2; ++n) _Pragma("unroll") for (int k = 0; k < 2; ++k) \
        acc[ai][bj][m][n] = __builtin_amdgcn_mfma_f32_16x16x32_bf16(Bt[n][k], At[m][k], acc[ai][bj][m][n], 0, 0, 0); __builtin_amdgcn_s_setprio(0); } while (0)
#define PG8_WAIT_V(n) asm volatile("s_waitcnt vmcnt(" #n ")" ::: "memory")
#define PG8_WAIT_L(n) asm volatile("s_waitcnt lgkmcnt(" #n ")" ::: "memory")
#define PG8_BAR __builtin_amdgcn_s_barrier()
#define PG8_SCHED __builtin_amdgcn_sched_barrier(0)
    Unit cur, nxt; int ui = 0;
    if (!S.next(0, cur)) return;
    f32x4 acc[2][2][4][2];
#pragma unroll
    for (int a = 0; a < 2; ++a)
#pragma unroll
        for (int b = 0; b < 2; ++b)
#pragma unroll
            for (int m = 0; m < 4; ++m)
#pragma unroll
                for (int n = 0; n < 2; ++n) acc[a][b][m][n] = (f32x4){0.f, 0.f, 0.f, 0.f};
    bf16x8 At[4][2], B0[2][2], B1[2][2];
    const char* cA = cur.A; const char* cB = cur.B;
    PG8_STAGE(PG8_SB(0, 0), cB, voffB); PG8_STAGE(PG8_SB(0, 1), cB + hstepB, voffB); PG8_STAGE(PG8_SA(0, 0), cA, voffA); PG8_STAGE(PG8_SA(0, 1), cA + hstepA, voffA);
    if (wr == 1) PG8_BAR;
    PG8_WAIT_V(2); PG8_BAR;
    PG8_STAGE(PG8_SB(1, 0), cB + kstep, voffB); PG8_STAGE(PG8_SA(1, 0), cA + kstep, voffA); PG8_STAGE(PG8_SB(1, 1), cB + hstepB + kstep, voffB);
    PG8_WAIT_V(6); PG8_BAR;
    for (;;) {
        const bool has_next = S.next(ui + 1, nxt);
        const char* nA = has_next ? nxt.A : cA; const char* nB = has_next ? nxt.B : cB;
        for (int t = 0; t < nt; t += 2) {
            const bool last = (t == nt - 2);
            const char* a1 = cA + (size_t)(t + 1) * kstep;
            const char* a2 = last ? nA : cA + (size_t)(t + 2) * kstep; const char* b2 = last ? nB : cB + (size_t)(t + 2) * kstep;
            const char* a3 = a2 + kstep; const char* b3 = b2 + kstep;
            PG8_LDB(B0, 0, 0); PG8_LDB(B1, 0, 1); PG8_SCHED; PG8_LDA(At, 0, 0); PG8_STAGE(PG8_SA(1, 1), a1 + hstepA, voffA);
            PG8_WAIT_V(8); PG8_WAIT_L(0); PG8_BAR; PG8_MMA(0, 0, At, B0); PG8_MMA(0, 1, At, B1); PG8_BAR; PG8_SCHED;
            PG8_LDA(At, 0, 1); PG8_STAGE(PG8_SB(0, 0), b2, voffB); PG8_STAGE(PG8_SB(0, 1), b2 + hstepB, voffB); PG8_STAGE(PG8_SA(0, 0), a2, voffA);
            PG8_WAIT_V(8); PG8_WAIT_L(0); PG8_BAR; PG8_MMA(1, 0, At, B0); PG8_MMA(1, 1, At, B1); PG8_BAR; PG8_SCHED;
            PG8_LDB(B0, 1, 0); PG8_LDB(B1, 1, 1); PG8_SCHED; PG8_LDA(At, 1, 0); PG8_STAGE(PG8_SA(0, 1), a2 + hstepA, voffA);
            PG8_WAIT_V(8); PG8_WAIT_L(0); PG8_BAR; PG8_MMA(0, 0, At, B0); PG8_MMA(0, 1, At, B1); PG8_BAR; PG8_SCHED;
            PG8_LDA(At, 1, 1); PG8_STAGE(PG8_SB(1, 0), b3, voffB); PG8_STAGE(PG8_SB(1, 1), b3 + hstepB, voffB); PG8_STAGE(PG8_SA(1, 0), a3, voffA);
            PG8_WAIT_V(8); PG8_WAIT_L(0); PG8_BAR; PG8_MMA(1, 0, At, B0); PG8_MMA(1, 1, At, B1); PG8_BAR; PG8_SCHED;
        }
        if (wr == 0) PG8_BAR;
        E(acc, cur, wr, wc, fr, fq);
        if (!has_next) break;
#pragma unroll
        for (int a = 0; a < 2; ++a)
#pragma unroll
            for (int b = 0; b < 2; ++b)
#pragma unroll
                for (int m = 0; m < 4; ++m)
#pragma unroll
                    for (int n = 0; n < 2; ++n) acc[a][b][m][n] = (f32x4){0.f, 0.f, 0.f, 0.f};
        cur = nxt; cA = nA; cB = nB; ++ui;
        if (wr == 1) PG8_BAR;
    }
    PG8_WAIT_V(0);
    PG8_BAR;
#undef PG8_SA
#undef PG8_SB
#undef PG8_STAGE
#undef PG8_LDA
#undef PG8_LDB
#undef PG8_MMA
#undef PG8_WAIT_V
#undef PG8_WAIT_L
#undef PG8_BAR
#undef PG8_SCHED
}
}
using pg8::Unit;
using pg8::cvt_pk_bf16;

struct EpiStoreBf16 {
    static constexpr bool PERM = true;
    bf16* O; int ldc;
    __device__ __forceinline__ void operator()(const f32x4 (&acc)[2][2][4][2], const Unit& u, int wr, int wc, int fr, int fq) const {
        const int row0 = u.r0 + wr * 64 + fr, col0 = u.c0 + wc * 32 + 8 * fq;
#pragma unroll
        for (int ai = 0; ai < 2; ++ai)
#pragma unroll
            for (int m = 0; m < 4; ++m) { bf16* rowp = O + (size_t)(row0 + ai * 128 + m * 16) * ldc + col0;
#pragma unroll
                for (int bj = 0; bj < 2; ++bj) { const f32x4 v0 = acc[ai][bj][m][0], v1 = acc[ai][bj][m][1];
                    u32x4 w; w.x = cvt_pk_bf16(v0[0], v0[1]); w.y = cvt_pk_bf16(v0[2], v0[3]); w.z = cvt_pk_bf16(v1[0], v1[1]); w.w = cvt_pk_bf16(v1[2], v1[3]);
                    *(u32x4*)(rowp + bj * 128) = w; } }
    }
};
struct EpiGate {
    static constexpr bool PERM = true;
    bf16* G; int ldc;
    __device__ __forceinline__ void operator()(const f32x4 (&acc)[2][2][4][2], const Unit& u, int wr, int wc, int fr, int fq) const {
        const int row0 = u.r0 + wr * 64 + fr, col0 = u.c0 + wc * 32 + 8 * fq;
#pragma unroll
        for (int ai = 0; ai < 2; ++ai)
#pragma unroll
            for (int m = 0; m < 4; ++m) { bf16* rowp = G + (size_t)(row0 + ai * 128 + m * 16) * ldc + col0;
#pragma unroll
                for (int bj = 0; bj < 2; ++bj) { const f32x4 v0 = acc[ai][bj][m][0], v1 = acc[ai][bj][m][1];
                    const u32x4 gw = *(const u32x4*)(rowp + bj * 128); float g[8]; unpack8(gw, g);
                    u32x4 w; w.x = cvt_pk_bf16(sigmoidf_(g[0]) * v0[0], sigmoidf_(g[1]) * v0[1]); w.y = cvt_pk_bf16(sigmoidf_(g[2]) * v0[2], sigmoidf_(g[3]) * v0[3]);
                    w.z = cvt_pk_bf16(sigmoidf_(g[4]) * v1[0], sigmoidf_(g[5]) * v1[1]); w.w = cvt_pk_bf16(sigmoidf_(g[6]) * v1[2], sigmoidf_(g[7]) * v1[3]);
                    *(u32x4*)(rowp + bj * 128) = w; } }
    }
};
struct EpiResF32 {
    static constexpr bool PERM = false;
    const float* res; float* out;
    __device__ __forceinline__ void operator()(const f32x4 (&acc)[2][2][4][2], const Unit& u, int wr, int wc, int fr, int fq) const {
        const int row0 = u.r0 + wr * 64 + fr, col0 = u.c0 + wc * 32 + 4 * fq;
#pragma unroll
        for (int ai = 0; ai < 2; ++ai)
#pragma unroll
            for (int m = 0; m < 4; ++m) { const size_t ro = (size_t)(row0 + ai * 128 + m * 16) * D + col0;
#pragma unroll
                for (int bj = 0; bj < 2; ++bj)
#pragma unroll
                    for (int n = 0; n < 2; ++n) { const f32x4 r = *(const f32x4*)(res + ro + bj * 128 + n * 16); *(f32x4*)(out + ro + bj * 128 + n * 16) = r + acc[ai][bj][m][n]; } }
    }
};
struct EpiSwiglu {
    static constexpr bool PERM = true;
    bf16* O;
    __device__ __forceinline__ void operator()(const f32x4 (&acc)[2][2][4][2], const Unit& u, int wr, int wc, int fr, int fq) const {
        const int row0 = u.r0 + wr * 64 + fr, col0 = u.c0 + wc * 32 + 8 * fq;
#pragma unroll
        for (int ai = 0; ai < 2; ++ai)
#pragma unroll
            for (int m = 0; m < 4; ++m) { bf16* rowp = O + (size_t)(row0 + ai * 128 + m * 16) * DE + col0;
                const f32x4 g0 = acc[ai][0][m][0], g1 = acc[ai][0][m][1], u0 = acc[ai][1][m][0], u1 = acc[ai][1][m][1];
                u32x4 w; w.x = cvt_pk_bf16(siluf_(g0[0]) * u0[0], siluf_(g0[1]) * u0[1]); w.y = cvt_pk_bf16(siluf_(g0[2]) * u0[2], siluf_(g0[3]) * u0[3]);
                w.z = cvt_pk_bf16(siluf_(g1[0]) * u1[0], siluf_(g1[1]) * u1[1]); w.w = cvt_pk_bf16(siluf_(g1[2]) * u1[2], siluf_(g1[3]) * u1[3]);
                *(u32x4*)rowp = w; }
    }
};
struct EpiScatter {
    static constexpr bool PERM = true;
    bf16* Y; const int* row_code; const float* row_w;
    __device__ __forceinline__ void operator()(const f32x4 (&acc)[2][2][4][2], const Unit& u, int wr, int wc, int fr, int fq) const {
        const int row0 = u.r0 + wr * 64 + fr, col0 = u.c0 + wc * 32 + 8 * fq;
#pragma unroll
        for (int ai = 0; ai < 2; ++ai)
#pragma unroll
            for (int m = 0; m < 4; ++m) { const int row = row0 + ai * 128 + m * 16; const int code = row_code[row]; const float rw = row_w[row];
                if (code >= 0) { bf16* rowp = Y + (size_t)(code & 1) * ((size_t)M * D) + (size_t)(code >> 1) * D + col0;
#pragma unroll
                    for (int bj = 0; bj < 2; ++bj) { const f32x4 v0 = acc[ai][bj][m][0] * rw, v1 = acc[ai][bj][m][1] * rw;
                        u32x4 w; w.x = cvt_pk_bf16(v0[0], v0[1]); w.y = cvt_pk_bf16(v0[2], v0[3]); w.z = cvt_pk_bf16(v1[0], v1[1]); w.w = cvt_pk_bf16(v1[2], v1[3]);
                        *(u32x4*)(rowp + bj * 128) = w; } } }
    }
};

struct SchedH {
    pg8::TileOrder to; const char* A; const char* B;
    __device__ __forceinline__ bool next(int i, Unit& u) const { int pm, pn; if (!to.next(i, pm, pn)) return false;
        u.A = A + (size_t)pm * 256 * D * 2; u.B = B + (size_t)pn * 256 * D * 2; u.r0 = pm * 256; u.c0 = pn * 256; return true; }
};
struct SchedBranch {
    pg8::TileOrder to; const char* YS; const char* WBR;
    __device__ __forceinline__ bool next(int i, Unit& u) const { int pm, pn; if (!to.next(i, pm, pn)) return false; const int br = pn >> 2, q = pn & 3;
        u.A = YS + ((size_t)pm * 256 * 2048 + br * 512) * 2; u.B = WBR + ((size_t)br * D * 512 + (size_t)q * 256 * 512) * 2; u.r0 = pm * 256; u.c0 = HGATE + br * 1024 + q * 256; return true; }
};
struct SchedOut {
    pg8::TileOrder to; const char* A; const char* B;
    __device__ __forceinline__ bool next(int i, Unit& u) const { int pm, pn; if (!to.next(i, pm, pn)) return false;
        u.A = A + (size_t)pm * 256 * D * 2; u.B = B + (size_t)pn * 256 * D * 2; u.r0 = pm * 256; u.c0 = pn * 256; return true; }
};
struct SchedMoe {
    int nux, nrank, rank, nk, x, NX; const LAS int* cum; const LAS int* rb0; const char* A; size_t a_blk; const char* W; size_t w_e, w_pn; int cmul;
    __device__ __forceinline__ bool next(int i, Unit& u) const { const int ui = i * nrank + rank; if (ui >= nux) return false;
        int k = 0; while (k + 1 < nk && cum[k + 1] <= ui) ++k;
        const int local = ui - cum[k], rb = rb0[k] + (local >> 2), pn = local & 3, e = x + NX * k;
        u.A = A + (size_t)rb * a_blk; u.B = W + (size_t)e * w_e + (size_t)pn * w_pn; u.r0 = rb * 256; u.c0 = pn * cmul; return true; }
};

struct Params { const float* in[25]; float* out; unsigned char* ws; int ph_lo, ph_hi; };
enum { I_X = 0, I_MIXNW, I_WIN, I_GCONV, I_GALOG, I_GDT, I_GNW, I_CCW, I_CCB, I_CLNW, I_CLNB, I_GLNW, I_GLNB, I_GWS, I_GBS, I_SCW, I_WBR, I_WOUT, I_MOENW, I_RGRP, I_REXP, I_WG, I_WU, I_WD, I_FNW };
constexpr int PH_PER_LAYER = 12, PH_FINAL = 24, PH_TOTAL = 25;

__device__ __forceinline__ void transpose_item(const float* __restrict__ W, int ldw, int srccol, bf16* __restrict__ WT, int ldt, int k0, int n0, int lane) {
    const int kq = lane & 7, nq = lane >> 3;
    f32x4 v[8][2];
#pragma unroll
    for (int r = 0; r < 8; ++r) { const float* s = W + (size_t)(k0 + 8 * kq + r) * ldw + srccol + 8 * nq; v[r][0] = *(const f32x4*)s; v[r][1] = *(const f32x4*)(s + 4); }
#pragma unroll
    for (int e = 0; e < 8; ++e) { u32x4 o; o.x = pk2(v[0][e >> 2][e & 3], v[1][e >> 2][e & 3]); o.y = pk2(v[2][e >> 2][e & 3], v[3][e >> 2][e & 3]); o.z = pk2(v[4][e >> 2][e & 3], v[5][e >> 2][e & 3]); o.w = pk2(v[6][e >> 2][e & 3], v[7][e >> 2][e & 3]);
        *(u32x4*)(WT + (size_t)(n0 + 8 * nq + e) * ldt + k0 + 8 * kq) = o; }
}
__device__ __forceinline__ void prep_static_weights(const Params& p, int gw, int NGW, int lane) {
    constexpr int I_IN = 16 * (DH / 64), I_BR = 8 * 16, I_OUT = 16 * 16, PER_L = I_IN + 4 * I_BR + I_OUT;
    for (int it = gw; it < NLAYER * PER_L; it += NGW) {
        const int l = it / PER_L; int r = it % PER_L;
        if (r < I_IN) { const int kb = r / (DH / 64), nb = r % (DH / 64), n0 = nb * 64;
            transpose_item(p.in[I_WIN] + (size_t)l * D * DIN, DIN, n0 + (n0 >= 2048 ? 8 : 0), (bf16*)(p.ws + WS_WIN + l * WIN_L), D, kb * 64, n0, lane); continue; }
        r -= I_IN;
        if (r < 4 * I_BR) { const int br = r / I_BR, q = r % I_BR, kb = q / 16, nb = q % 16;
            transpose_item(p.in[I_WBR] + ((size_t)l * 4 + br) * 512 * D, D, nb * 64, (bf16*)(p.ws + WS_WBR + l * WBR_L) + (size_t)br * D * 512, 512, kb * 64, nb * 64, lane); continue; }
        r -= 4 * I_BR;
        { const int kb = r / 16, nb = r % 16;
            transpose_item(p.in[I_WOUT] + (size_t)l * D * D, D, nb * 64, (bf16*)(p.ws + WS_WOUT + l * WOUT_L), D, kb * 64, nb * 64, lane); }
    }
}
__device__ __forceinline__ void prep_moe_weights(const Params& p, int layer, int gw, int NGW, int lane) {
    constexpr int I_GU = 16 * 16, I_D = 8 * 16, PER_E = I_GU + I_D;
    for (int it = gw; it < NE * PER_E; it += NGW) {
        const int e = it / PER_E; int r = it % PER_E;
        if (r < I_GU) { const int kb = r / 16, nb = r % 16, n0 = nb * 64, pn = n0 >> 8, half = (n0 >> 7) & 1, j0 = n0 & 127;
            const float* src = p.in[half ? I_WU : I_WG] + ((size_t)layer * NE + e) * D * DE;
            transpose_item(src, DE, 128 * pn + j0, (bf16*)(p.ws + WS_MOEW + e * WGU_E), D, kb * 64, n0, lane); continue; }
        r -= I_GU;
        { const int kb = r / 16, nb = r % 16;
            transpose_item(p.in[I_WD] + ((size_t)layer * NE + e) * DE * D, D, nb * 64, (bf16*)(p.ws + WS_WD + e * WD_E), DE, kb * 64, nb * 64, lane); }
    }
}

template <int MODE>
__device__ __forceinline__ void norm_phase(const Params& p, int layer, LAS unsigned char* lds, int gw, int NGW, int tid, int lane) {
    LAS float* wsm = (LAS float*)lds;
    if (MODE != 2) {
        const float* wi = p.in[I_WIN] + (size_t)layer * D * DIN;
        for (int i = tid; i < 8192; i += 512) wsm[i] = wi[(size_t)(i >> 3) * DIN + 2048 + (i & 7)];
    }
    __syncthreads();
    const float* nwp = (MODE == 2) ? p.in[I_FNW] : p.in[I_MIXNW] + layer * D;
    f32x4 nw[4];
#pragma unroll
    for (int j = 0; j < 4; ++j) nw[j] = *(const f32x4*)(nwp + 4 * lane + 256 * j);
    const bf16* Y0 = (const bf16*)(p.ws + WS_Y); const bf16* Y1 = Y0 + (size_t)M * D;
    bf16* XN = (bf16*)(p.ws + WS_XN); float* SMALL = (float*)(p.ws + WS_SMALL);
    for (int m = gw; m < M; m += NGW) {
        const float* xr = (MODE == 0 ? p.in[I_X] : p.out) + (size_t)m * D;
        f32x4 v[4]; float ss = 0.f;
#pragma unroll
        for (int j = 0; j < 4; ++j) { v[j] = *(const f32x4*)(xr + 4 * lane + 256 * j);
            if (MODE != 0) { const u32x2 a = *(const u32x2*)(Y0 + (size_t)m * D + 4 * lane + 256 * j), b = *(const u32x2*)(Y1 + (size_t)m * D + 4 * lane + 256 * j);
                v[j][0] += bf_lo(a.x) + bf_lo(b.x); v[j][1] += bf_hi(a.x) + bf_hi(b.x); v[j][2] += bf_lo(a.y) + bf_lo(b.y); v[j][3] += bf_hi(a.y) + bf_hi(b.y); }
            ss += (v[j][0] * v[j][0] + v[j][1] * v[j][1]) + (v[j][2] * v[j][2] + v[j][3] * v[j][3]); }
        const float rs = 1.0f / sqrtf(wave_sum(ss) * (1.0f / D) + EPS);
        if (MODE == 2) {
#pragma unroll
            for (int j = 0; j < 4; ++j) *(f32x4*)(p.out + (size_t)m * D + 4 * lane + 256 * j) = v[j] * rs * nw[j];
            continue;
        }
        if (MODE == 1) {
#pragma unroll
            for (int j = 0; j < 4; ++j) *(f32x4*)(p.out + (size_t)m * D + 4 * lane + 256 * j) = v[j];
        }
        float sm[8];
#pragma unroll
        for (int q = 0; q < 8; ++q) sm[q] = 0.f;
#pragma unroll
        for (int j = 0; j < 4; ++j) { v[j] = v[j] * rs * nw[j];
            u32x2 o; o.x = pk2(v[j][0], v[j][1]); o.y = pk2(v[j][2], v[j][3]); *(u32x2*)(XN + (size_t)m * D + 4 * lane + 256 * j) = o;
#pragma unroll
            for (int c = 0; c < 4; ++c) { const LAS float* wrow = wsm + (4 * lane + 256 * j + c) * 8; const f32x4 w0 = *(const LAS f32x4*)wrow, w1 = *(const LAS f32x4*)(wrow + 4);
                sm[0] += v[j][c] * w0[0]; sm[1] += v[j][c] * w0[1]; sm[2] += v[j][c] * w0[2]; sm[3] += v[j][c] * w0[3];
                sm[4] += v[j][c] * w1[0]; sm[5] += v[j][c] * w1[1]; sm[6] += v[j][c] * w1[2]; sm[7] += v[j][c] * w1[3]; } }
        float mine = 0.f;
#pragma unroll
        for (int q = 0; q < 8; ++q) { const float s = wave_sum(sm[q]); mine = (lane == q) ? s : mine; }
        if (lane < 8) SMALL[(size_t)m * 8 + lane] = mine;
    }
    __syncthreads();
}

__device__ __forceinline__ void shortconv(const Params& p, int layer, int gtid, int NGT) {
    const bf16* H = (const bf16*)(p.ws + WS_H); bf16* YS = (bf16*)(p.ws + WS_YS);
    const float* cw = p.in[I_SCW] + (size_t)layer * 3 * 512;
    for (int it = gtid; it < M * 64; it += NGT) {
        const int m = it >> 6, c8 = (it & 63) * 8, t = m & (T - 1);
        float acc[8];
#pragma unroll
        for (int i = 0; i < 8; ++i) acc[i] = 0.f;
#pragma unroll
        for (int j = 0; j < 3; ++j) { if (t - 2 + j >= 0) { const bf16* r = H + (size_t)(m - 2 + j) * DH + HSC + c8;
                float cg[8], xv[8]; unpack8(*(const u32x4*)(r + 512), cg); unpack8(*(const u32x4*)(r + 1024), xv);
#pragma unroll
                for (int i = 0; i < 8; ++i) acc[i] += cw[j * 512 + c8 + i] * (cg[i] * xv[i]); } }
        float bg[8]; unpack8(*(const u32x4*)(H + (size_t)m * DH + HSC + c8), bg);
#pragma unroll
        for (int i = 0; i < 8; ++i) acc[i] *= bg[i];
        *(u32x4*)(YS + (size_t)m * 2048 + 1536 + c8) = pack8(acc);
    }
}
__device__ __forceinline__ void conformer(const Params& p, int layer, LAS unsigned char* lds, int tid, int wave, int lane, int vb, int nvb) {
    const bf16* H = (const bf16*)(p.ws + WS_H); bf16* YS = (bf16*)(p.ws + WS_YS);
    LAS bf16* yt = (LAS bf16*)lds;
    LAS float* zt = (LAS float*)(lds + 98304);
    const float* cwp = p.in[I_CCW] + (size_t)layer * 31 * 512;
    float cw[31];
#pragma unroll
    for (int j = 0; j < 31; ++j) cw[j] = cwp[j * 512 + tid];
    const float cb = p.in[I_CCB][layer * 512 + tid];
    float lw[8], lb[8];
#pragma unroll
    for (int i = 0; i < 8; ++i) { lw[i] = p.in[I_CLNW][layer * 512 + lane * 8 + i]; lb[i] = p.in[I_CLNB][layer * 512 + lane * 8 + i]; }
    for (int unit = vb; unit < M / 64; unit += nvb) {
        const int m0 = unit * 64, t0 = m0 & (T - 1);
        for (int it = tid; it < 94 * 64; it += 512) { const int r = it >> 6, c8 = (it & 63) * 8; const int dt = r - 30;
            u32x4 o = (u32x4){0u, 0u, 0u, 0u};
            if (t0 + dt >= 0) { const bf16* src = H + (size_t)(m0 + dt) * DH + HCONF + c8; float a[8], g[8]; unpack8(*(const u32x4*)src, a); unpack8(*(const u32x4*)(src + 512), g);
#pragma unroll
                for (int i = 0; i < 8; ++i) a[i] *= sigmoidf_(g[i]);
                o = pack8(a); }
            *(LAS u32x4*)(yt + r * 512 + c8) = o; }
        __syncthreads();
        for (int sb = 0; sb < 8; ++sb) {
            float z[8];
#pragma unroll
            for (int i = 0; i < 8; ++i) z[i] = cb;
#pragma unroll
            for (int r = 0; r < 38; ++r) { const float yv = bf2f(yt[(sb * 8 + r) * 512 + tid]);
#pragma unroll
                for (int i = 0; i < 8; ++i) { const int j = r - i; if (j >= 0 && j < 31) z[i] += cw[j] * yv; } }
#pragma unroll
            for (int i = 0; i < 8; ++i) zt[i * 512 + tid] = z[i];
            __syncthreads();
            { const LAS float* zr = zt + wave * 512 + lane * 8; float v[8]; const f32x4 a = *(const LAS f32x4*)zr, b = *(const LAS f32x4*)(zr + 4);
                v[0] = a[0]; v[1] = a[1]; v[2] = a[2]; v[3] = a[3]; v[4] = b[0]; v[5] = b[1]; v[6] = b[2]; v[7] = b[3];
                float s = 0.f;
#pragma unroll
                for (int i = 0; i < 8; ++i) s += v[i];
                const float mean = wave_sum(s) * (1.0f / 512.0f); float q = 0.f;
#pragma unroll
                for (int i = 0; i < 8; ++i) { v[i] -= mean; q += v[i] * v[i]; }
                const float rstd = 1.0f / sqrtf(wave_sum(q) * (1.0f / 512.0f) + EPS);
#pragma unroll
                for (int i = 0; i < 8; ++i) v[i] = siluf_(v[i] * rstd * lw[i] + lb[i]);
                *(u32x4*)(YS + (size_t)(m0 + sb * 8 + wave) * 2048 + 512 + lane * 8) = pack8(v); }
            __syncthreads();
        }
    }
}
__device__ __forceinline__ f32x4 mfma16(bf16x8 a, bf16x8 b, f32x4 c) { return __builtin_amdgcn_mfma_f32_16x16x32_bf16(a, b, c, 0, 0, 0); }
typedef short bf16x4 __attribute__((ext_vector_type(4)));
__device__ __forceinline__ bf16x8 ld_frag16(const LAS unsigned char* p) { return *(const LAS bf16x8*)p; }
__device__ __forceinline__ bf16x8 ld_frag8x2(const LAS unsigned char* p) { const bf16x4 a = *(const LAS bf16x4*)p, b = *(const LAS bf16x4*)(p + 32); return __builtin_shufflevector(a, b, 0, 1, 2, 3, 4, 5, 6, 7); }
__device__ __forceinline__ bf16x8 pack_frag(const f32x4 lo, const f32x4 hi) { u32x4 w; w.x = cvt_pk_bf16(lo[0], lo[1]); w.y = cvt_pk_bf16(lo[2], lo[3]); w.z = cvt_pk_bf16(hi[0], hi[1]); w.w = cvt_pk_bf16(hi[2], hi[3]); return __builtin_bit_cast(bf16x8, w); }
constexpr int GM_W = 0, GM_VT = 34816, GM_ST = 69632;
__device__ __forceinline__ void gmlp(const Params& p, int layer, LAS unsigned char* lds, int tid, int wave, int lane, int vb, int nvb) {
    const bf16* H = (const bf16*)(p.ws + WS_H); bf16* YS = (bf16*)(p.ws + WS_YS);
    LAS float* st = (LAS float*)(lds + GM_ST);
    const float* lnw = p.in[I_GLNW] + layer * 512; const float* lnb = p.in[I_GLNB] + layer * 512;
    const int q = lane >> 4, li = lane & 15;
    for (int unit = vb; unit < M / 128; unit += nvb) {
        const int m0 = unit * 128;
        __syncthreads();
        for (int tk = wave * 16; tk < wave * 16 + 16; ++tk) {
            float v[8]; unpack8(*(const u32x4*)(H + (size_t)(m0 + tk) * DH + HGMLP + 512 + lane * 8), v);
            float s = 0.f;
#pragma unroll
            for (int i = 0; i < 8; ++i) { v[i] = gelu_tanh(v[i]); s += v[i]; }
            const float mean = wave_sum(s) * (1.0f / 512.0f); float qq = 0.f;
#pragma unroll
            for (int i = 0; i < 8; ++i) { const float d = v[i] - mean; qq += d * d; }
            const float rstd = 1.0f / sqrtf(wave_sum(qq) * (1.0f / 512.0f) + EPS);
            if (lane == 0) { st[tk * 2] = mean; st[tk * 2 + 1] = rstd; }
        }
        __syncthreads();
        for (int g = 0; g < 4; ++g) {
            for (int it = tid; it < 128 * 16; it += 512) { const int tk = it >> 4, c8 = (it & 15) * 8;
                float v[8]; unpack8(*(const u32x4*)(H + (size_t)(m0 + tk) * DH + HGMLP + 512 + g * 128 + c8), v);
                const float mean = st[tk * 2], rstd = st[tk * 2 + 1];
#pragma unroll
                for (int i = 0; i < 8; ++i) *(LAS bf16*)(lds + GM_VT + (c8 + i) * 272 + 2 * tk) = (bf16)f2bf((gelu_tanh(v[i]) - mean) * rstd * lnw[g * 128 + c8 + i] + lnb[g * 128 + c8 + i]); }
            const float* ws = p.in[I_GWS] + ((size_t)layer * 4 + g) * 128 * 128;
            for (int it = tid; it < 128 * 16; it += 512) { const int i = it >> 4, j8 = (it & 15) * 8;
                const f32x4 a = *(const f32x4*)(ws + i * 128 + j8), b = *(const f32x4*)(ws + i * 128 + j8 + 4);
                float w[8] = {a[0], a[1], a[2], a[3], b[0], b[1], b[2], b[3]};
#pragma unroll
                for (int e = 0; e < 8; ++e) w[e] = (j8 + e <= i) ? w[e] : 0.f;
                *(LAS u32x4*)(lds + GM_W + i * 272 + j8 * 2) = pack8(w); }
            __syncthreads();
            {
                f32x4 acc[8];
#pragma unroll
                for (int ct = 0; ct < 8; ++ct) acc[ct] = (f32x4){0.f, 0.f, 0.f, 0.f};
                const int nks = (wave >> 1) + 1;
                for (int ks = 0; ks < nks; ++ks) { const bf16x8 wf = ld_frag16(lds + GM_W + (16 * wave + li) * 272 + (32 * ks + 8 * q) * 2);
#pragma unroll
                    for (int ct = 0; ct < 8; ++ct) acc[ct] = mfma16(ld_frag16(lds + GM_VT + (16 * ct + li) * 272 + (32 * ks + 8 * q) * 2), wf, acc[ct]); }
                const int i = 16 * wave + li; const float bs = p.in[I_GBS][((size_t)layer * 4 + g) * 128 + i];
                const bf16* urow = H + (size_t)(m0 + i) * DH + HGMLP + g * 128 + 4 * q; bf16* orow = YS + (size_t)(m0 + i) * 2048 + 1024 + g * 128 + 4 * q;
#pragma unroll
                for (int ct = 0; ct < 8; ++ct) { const u32x2 uw = *(const u32x2*)(urow + 16 * ct);
                    const float o0 = gelu_tanh(bf_lo(uw.x)) * (acc[ct][0] + bs), o1 = gelu_tanh(bf_hi(uw.x)) * (acc[ct][1] + bs), o2 = gelu_tanh(bf_lo(uw.y)) * (acc[ct][2] + bs), o3 = gelu_tanh(bf_hi(uw.y)) * (acc[ct][3] + bs);
                    u32x2 ow; ow.x = pk2(o0, o1); ow.y = pk2(o2, o3); *(u32x2*)(orow + 16 * ct) = ow; }
            }
            __syncthreads();
        }
    }
}
constexpr int CP_QN = 0, CP_KN = 17408, CP_KT = 34816, CP_VT = 53248, CP_KGT = 71680, CP_A32 = 90112, CP_ATT = 106496, CP_T16 = 115712, CP_TAB = 124928;
__device__ __forceinline__ void gdn_chunk_prep(const Params& p, int layer, LAS unsigned char* lds, int tid, int wave, int lane) {
    const bf16* H = (const bf16*)(p.ws + WS_H); const float* SMALL = (const float*)(p.ws + WS_SMALL);
    const float* cw = p.in[I_GCONV] + (size_t)layer * 4 * 1536;
    LAS float* tab = (LAS float*)(lds + CP_TAB);
    const int q = lane >> 4, li = lane & 15;
    for (int unit = blockIdx.x; unit < 2048; unit += gridDim.x) {
        const int n = unit & 63, hh = (unit >> 6) & 3, b = unit >> 8; const int m0 = b * T + n * 64;
        unsigned char* rec = p.ws + WS_REC + (size_t)((b * 4 + hh) * 64 + n) * REC_BYTES;
        __syncthreads();
        if (wave == 0) { const int m = m0 + lane; const float br = SMALL[(size_t)m * 8 + hh], ar = SMALL[(size_t)m * 8 + 4 + hh];
            float g = -__expf(p.in[I_GALOG][layer * 4 + hh]) * softplusf_(ar + p.in[I_GDT][layer * 4 + hh]);
#pragma unroll
            for (int o = 1; o < 64; o <<= 1) { const float t = __shfl_up(g, o); if (lane >= o) g += t; }
            tab[lane] = sigmoidf_(br); tab[64 + lane] = g; tab[128 + lane] = __expf(g); }
        __syncthreads();
        {
            const int i0 = wave * 8, t0 = n * 64 + i0;
            unsigned raw[3][11];
#pragma unroll
            for (int s = 0; s < 3; ++s)
#pragma unroll
                for (int r = 0; r < 11; ++r) raw[s][r] = (t0 - 3 + r >= 0) ? *(const unsigned*)(H + (size_t)(m0 + i0 - 3 + r) * DH + s * 512 + hh * 128 + 2 * lane) : 0u;
            float w0[3][4], w1[3][4];
#pragma unroll
            for (int s = 0; s < 3; ++s)
#pragma unroll
                for (int j = 0; j < 4; ++j) { const f32x2 ww = *(const f32x2*)(cw + j * 1536 + s * 512 + hh * 128 + 2 * lane); w0[s][j] = ww[0]; w1[s][j] = ww[1]; }
#pragma unroll
            for (int ii = 0; ii < 8; ++ii) { const int i = i0 + ii;
                float y[3][2];
#pragma unroll
                for (int s = 0; s < 3; ++s) { float a0 = 0.f, a1 = 0.f;
#pragma unroll
                    for (int j = 0; j < 4; ++j) { a0 += w0[s][j] * bf_lo(raw[s][ii + j]); a1 += w1[s][j] * bf_hi(raw[s][ii + j]); }
                    y[s][0] = siluf_(a0); y[s][1] = siluf_(a1); }
                const float sq = wave_sum(y[0][0] * y[0][0] + y[0][1] * y[0][1]), sk = wave_sum(y[1][0] * y[1][0] + y[1][1] * y[1][1]);
                const float rq = 0.08838834764831845f * __builtin_amdgcn_rsqf(sq + EPS), rk = __builtin_amdgcn_rsqf(sk + EPS);
                const float be = tab[i], bg = be * tab[128 + i];
                const float k0 = y[1][0] * rk, k1 = y[1][1] * rk;
                *(LAS unsigned*)(lds + CP_QN + i * 272 + 4 * lane) = pk2(y[0][0] * rq, y[0][1] * rq);
                *(LAS unsigned*)(lds + CP_KN + i * 272 + 4 * lane) = pk2(k0, k1);
                *(LAS bf16*)(lds + CP_KT + (2 * lane) * 144 + 2 * i) = (bf16)f2bf(k0); *(LAS bf16*)(lds + CP_KT + (2 * lane + 1) * 144 + 2 * i) = (bf16)f2bf(k1);
                *(LAS bf16*)(lds + CP_VT + (2 * lane) * 144 + 2 * i) = (bf16)f2bf(be * y[2][0]); *(LAS bf16*)(lds + CP_VT + (2 * lane + 1) * 144 + 2 * i) = (bf16)f2bf(be * y[2][1]);
                *(LAS bf16*)(lds + CP_KGT + (2 * lane) * 144 + 2 * i) = (bf16)f2bf(bg * k0); *(LAS bf16*)(lds + CP_KGT + (2 * lane + 1) * 144 + 2 * i) = (bf16)f2bf(bg * k1);
            }
        }
        __syncthreads();
        for (int jb = wave; jb < 32; jb += 8) { const int which = jb >> 4, mt = (jb >> 2) & 3, nt = jb & 3;
            f32x4 acc = (f32x4){0.f, 0.f, 0.f, 0.f};
            if (nt <= mt) {
#pragma unroll
                for (int ks = 0; ks < 4; ++ks) acc = mfma16(ld_frag16(lds + (which ? CP_QN : CP_KN) + (16 * mt + li) * 272 + (32 * ks + 8 * q) * 2), ld_frag16(lds + CP_KN + (16 * nt + li) * 272 + (32 * ks + 8 * q) * 2), acc);
            }
            const int j = 16 * nt + li; const float gj = tab[64 + j];
#pragma unroll
            for (int r = 0; r < 4; ++r) { const int i = 16 * mt + 4 * q + r; const float gi = tab[64 + i];
                if (which == 0) { ((LAS float*)(lds + CP_A32))[i * 64 + j] = (i > j) ? tab[i] * acc[r] * __expf(gi - gj) : 0.f; }
                else { *(LAS bf16*)(lds + CP_ATT + i * 144 + 2 * j) = (bf16)f2bf((i >= j) ? acc[r] * __expf(gi - gj) : 0.f); } }
        }
        __syncthreads();
        if (wave == 0) {
            float Tc[64]; const float lanef = (float)lane;
            const LAS float* A = (const LAS float*)(lds + CP_A32); asm volatile("" : "+v"(A));
            LAS unsigned char* Tw = lds + CP_T16 + 2 * lane; asm volatile("" : "+v"(Tw));
#pragma unroll
            for (int i = 0; i < 64; ++i) { float a4[4] = {fmaxf(0.f, 1.f - fabsf((float)i - lanef)), 0.f, 0.f, 0.f};
#pragma unroll
                for (int j = 0; j < i; j += 4) { const f32x4 av = *(const LAS f32x4*)(A + i * 64 + j);
#pragma unroll
                    for (int jj = 0; jj < 4; ++jj) if (j + jj < i) a4[jj] -= av[jj] * Tc[j + jj]; }
                const float a = (a4[0] + a4[1]) + (a4[2] + a4[3]);
                Tc[i] = a; *(LAS bf16*)(Tw + i * 144) = (bf16)f2bf(a); }
        } else {
            const int t2 = tid - 64;
            for (int pc = t2; pc < 1024; pc += 448) { const int row = pc >> 4, seg = pc & 15; *(u32x4*)(rec + REC_Q + pc * 16) = *(const LAS u32x4*)(lds + CP_QN + row * 272 + seg * 16); }
            for (int pc = t2; pc < 512; pc += 448) { const int row = pc >> 3, seg = pc & 7; *(u32x4*)(rec + REC_ATT + pc * 16) = *(const LAS u32x4*)(lds + CP_ATT + row * 144 + seg * 16); }
            for (int pc = t2; pc < 1024; pc += 448) { const int row = pc >> 3, seg = pc & 7; *(u32x4*)(rec + REC_KT + pc * 16) = *(const LAS u32x4*)(lds + CP_KT + row * 144 + seg * 16); }
            if (t2 < 16) *(u32x4*)(rec + REC_G + t2 * 16) = *(const LAS u32x4*)(lds + CP_TAB + 256 + t2 * 16);
        }
        __syncthreads();
        for (int jb = wave; jb < 64; jb += 8) {
            f32x4 acc = (f32x4){0.f, 0.f, 0.f, 0.f};
            if (jb < 32) { const int mt = jb >> 3, nt = jb & 7;
#pragma unroll
                for (int ks = 0; ks < 2; ++ks) acc = mfma16(ld_frag16(lds + CP_T16 + (16 * mt + li) * 144 + (32 * ks + 8 * q) * 2), ld_frag16(lds + CP_VT + (16 * nt + li) * 144 + (32 * ks + 8 * q) * 2), acc);
                u32x2 o; o.x = pk2(acc[0], acc[1]); o.y = pk2(acc[2], acc[3]);
                *(u32x2*)(rec + REC_U + (size_t)((nt * 64 + lane) * 4 + mt) * 8) = o;
            } else { const int mt = (jb - 32) >> 2, nt = (jb - 32) & 3;
#pragma unroll
                for (int ks = 0; ks < 2; ++ks) acc = mfma16(ld_frag16(lds + CP_KGT + (16 * mt + li) * 144 + (32 * ks + 8 * q) * 2), ld_frag16(lds + CP_T16 + (16 * nt + li) * 144 + (32 * ks + 8 * q) * 2), acc);
                u32x2 o; o.x = pk2(acc[0], acc[1]); o.y = pk2(acc[2], acc[3]);
                *(u32x2*)(rec + REC_W + (size_t)((16 * nt + li) * 128 + 16 * mt + 4 * q) * 2) = o;
            }
        }
    }
    __syncthreads();
}
constexpr int SC_W = 0, SC_Q = 17408, SC_ATT = 34816, SC_KT = 44032, SC_G = 62464, SC_BUF = 62720;
__device__ __forceinline__ void gdn_chunk_scan(const Params& p, LAS unsigned char* lds, int tid, int wave, int lane, int bh) {
    const int b = bh >> 2, hh = bh & 3, q = lane >> 4, li = lane & 15;
    const unsigned char* rec0 = p.ws + WS_REC + (size_t)(bh * 64) * REC_BYTES;
    float* OB = (float*)(p.ws + WS_OBUF);
    u32x4 pf[7], pfg = (u32x4){0u, 0u, 0u, 0u}, pu[2];
#define SC_LOAD(nn) do { const unsigned char* r_ = rec0 + (size_t)(nn) * REC_BYTES; \
        _Pragma("unroll") for (int k_ = 0; k_ < 7; ++k_) pf[k_] = *(const u32x4*)(r_ + (size_t)(tid + 512 * k_) * 16); \
        if (tid < 16) pfg = *(const u32x4*)(r_ + REC_G + tid * 16); \
        pu[0] = *(const u32x4*)(r_ + REC_U + (size_t)(wave * 64 + lane) * 32); pu[1] = *(const u32x4*)(r_ + REC_U + (size_t)(wave * 64 + lane) * 32 + 16); } while (0)
#define SC_STORE(buf) do { LAS unsigned char* d_ = lds + (buf) * SC_BUF; \
        _Pragma("unroll") for (int k_ = 0; k_ < 4; ++k_) { const int pc_ = tid + 512 * (k_ & 1); *(LAS u32x4*)(d_ + (k_ < 2 ? SC_W : SC_Q) + (pc_ >> 4) * 272 + (pc_ & 15) * 16) = pf[k_]; } \
        { const int pc_ = tid; *(LAS u32x4*)(d_ + SC_ATT + (pc_ >> 3) * 144 + (pc_ & 7) * 16) = pf[4]; } \
        _Pragma("unroll") for (int k_ = 5; k_ < 7; ++k_) { const int pc_ = tid + 512 * (k_ - 5); *(LAS u32x4*)(d_ + SC_KT + (pc_ >> 3) * 144 + (pc_ & 7) * 16) = pf[k_]; } \
        if (tid < 16) *(LAS u32x4*)(d_ + SC_G + tid * 16) = pfg; } while (0)
    f32x4 S[8];
#pragma unroll
    for (int i = 0; i < 8; ++i) S[i] = (f32x4){0.f, 0.f, 0.f, 0.f};
    __syncthreads();
    SC_LOAD(0); SC_STORE(0);
    u32x4 cu[2]; cu[0] = pu[0]; cu[1] = pu[1];
    __syncthreads();
    for (int n = 0; n < 64; ++n) {
        const LAS unsigned char* L = lds + (n & 1) * SC_BUF;
        if (n + 1 < 64) SC_LOAD(n + 1);
        bf16x8 Sb[4];
#pragma unroll
        for (int ks = 0; ks < 4; ++ks) Sb[ks] = pack_frag(S[2 * ks], S[2 * ks + 1]);
        f32x4 a1[4], a2[4];
#pragma unroll
        for (int mt = 0; mt < 4; ++mt) { a1[mt] = (f32x4){0.f, 0.f, 0.f, 0.f}; a2[mt] = (f32x4){0.f, 0.f, 0.f, 0.f};
#pragma unroll
            for (int ks = 0; ks < 4; ++ks) { a1[mt] = mfma16(ld_frag8x2(L + SC_W + (16 * mt + li) * 272 + (32 * ks + 4 * q) * 2), Sb[ks], a1[mt]);
                a2[mt] = mfma16(ld_frag8x2(L + SC_Q + (16 * mt + li) * 272 + (32 * ks + 4 * q) * 2), Sb[ks], a2[mt]); } }
        const float g63 = *(const LAS float*)(L + SC_G + 63 * 4);
        f32x4 vn[4], vd[4], gam[4];
#pragma unroll
        for (int mt = 0; mt < 4; ++mt) { const f32x4 gi = *(const LAS f32x4*)(L + SC_G + (16 * mt + 4 * q) * 4);
            const unsigned ulo = (mt < 2) ? (mt == 0 ? cu[0].x : cu[0].z) : (mt == 2 ? cu[1].x : cu[1].z), uhi = (mt < 2) ? (mt == 0 ? cu[0].y : cu[0].w) : (mt == 2 ? cu[1].y : cu[1].w);
            const f32x4 uu = (f32x4){bf_lo(ulo), bf_hi(ulo), bf_lo(uhi), bf_hi(uhi)};
            vn[mt] = uu - a1[mt];
#pragma unroll
            for (int r = 0; r < 4; ++r) { gam[mt][r] = __expf(gi[r]); vd[mt][r] = vn[mt][r] * __expf(g63 - gi[r]); } }
        bf16x8 Vb[2], Vd[2];
#pragma unroll
        for (int ks = 0; ks < 2; ++ks) { Vb[ks] = pack_frag(vn[2 * ks], vn[2 * ks + 1]); Vd[ks] = pack_frag(vd[2 * ks], vd[2 * ks + 1]); }
#pragma unroll
        for (int mt = 0; mt < 4; ++mt) { f32x4 a3 = (f32x4){0.f, 0.f, 0.f, 0.f};
#pragma unroll
            for (int ks = 0; ks < 2; ++ks) a3 = mfma16(ld_frag8x2(L + SC_ATT + (16 * mt + li) * 144 + (32 * ks + 4 * q) * 2), Vb[ks], a3);
#pragma unroll
            for (int r = 0; r < 4; ++r) OB[(size_t)(b * T + n * 64 + 16 * mt + 4 * q + r) * 512 + hh * 128 + 16 * wave + li] = gam[mt][r] * a2[mt][r] + a3[r]; }
        const float eg = __expf(g63);
#pragma unroll
        for (int mt = 0; mt < 8; ++mt) { f32x4 a4 = (f32x4){0.f, 0.f, 0.f, 0.f};
#pragma unroll
            for (int ks = 0; ks < 2; ++ks) a4 = mfma16(ld_frag8x2(L + SC_KT + (16 * mt + li) * 144 + (32 * ks + 4 * q) * 2), Vd[ks], a4);
            S[mt] = S[mt] * eg + a4; }
        if (n + 1 < 64) { SC_STORE((n + 1) & 1); cu[0] = pu[0]; cu[1] = pu[1]; }
        __syncthreads();
    }
#undef SC_LOAD
#undef SC_STORE
}

__device__ __forceinline__ void gdn_out(const Params& p, int layer, int gw, int NGW, int lane) {
    const bf16* H = (const bf16*)(p.ws + WS_H); bf16* YS = (bf16*)(p.ws + WS_YS); const float* OB = (const float*)(p.ws + WS_OBUF);
    const float w0 = p.in[I_GNW][layer * 128 + 2 * lane], w1 = p.in[I_GNW][layer * 128 + 2 * lane + 1];
    for (int it = gw; it < M * 4; it += NGW) { const int m = it >> 2, hh = it & 3;
        f32x2 o = *(const f32x2*)(OB + (size_t)m * 512 + hh * 128 + 2 * lane);
        const float rs = 1.0f / sqrtf(wave_sum(o[0] * o[0] + o[1] * o[1]) * (1.0f / 128.0f) + EPS);
        const unsigned zw = *(const unsigned*)(H + (size_t)m * DH + HZ + hh * 128 + 2 * lane);
        *(unsigned*)(YS + (size_t)m * 2048 + hh * 128 + 2 * lane) = pk2(o[0] * rs * w0 * siluf_(bf_lo(zw)), o[1] * rs * w1 * siluf_(bf_hi(zw)));
    }
}
__device__ __forceinline__ void sum_gated(const Params& p, int gtid, int NGT) {
    const bf16* H = (const bf16*)(p.ws + WS_H); bf16* MG = (bf16*)(p.ws + WS_MERGED);
    for (int it = gtid; it < M * 128; it += NGT) { const int m = it >> 7, c8 = (it & 127) * 8; const bf16* r = H + (size_t)m * DH + HGATE + c8;
        float a[8], b[8];
        unpack8(*(const u32x4*)r, a);
#pragma unroll
        for (int br = 1; br < 4; ++br) { unpack8(*(const u32x4*)(r + br * 1024), b);
#pragma unroll
            for (int i = 0; i < 8; ++i) a[i] += b[i]; }
        *(u32x4*)(MG + (size_t)m * D + c8) = pack8(a); }
}

__device__ __forceinline__ void moe_route(const Params& p, int layer, LAS unsigned char* lds, int tid, int wave, int lane) {
    LAS float* xs = (LAS float*)lds;
    LAS int* hist = (LAS int*)(lds + LDSCTL_OFF + LC_TAB);
    bf16* XN = (bf16*)(p.ws + WS_XN);
    int* route_e = (int*)(p.ws + WS_ROUTE); float* route_w = (float*)(p.ws + WS_ROUTE + (size_t)M * 2 * 4);
    int* cnt = (int*)(p.ws + WS_MOETAB + (size_t)NROWS_MAX * 8);
    const float* rg = p.in[I_RGRP] + (size_t)layer * D * 8; const float* re = p.in[I_REXP] + (size_t)layer * D * 64;
    f32x4 nw[4];
#pragma unroll
    for (int j = 0; j < 4; ++j) nw[j] = *(const f32x4*)(p.in[I_MOENW] + layer * D + 4 * lane + 256 * j);
    for (int vb = blockIdx.x; vb < M / 128; vb += gridDim.x) {
        if (tid < 64) hist[tid] = 0;
        for (int tile = 0; tile < 4; ++tile) {
            const int m0 = vb * 128 + tile * 32;
            __syncthreads();
            for (int r = wave * 4; r < wave * 4 + 4; ++r) { const int m = m0 + r; const float* xr = p.out + (size_t)m * D;
                f32x4 v[4]; float ss = 0.f;
#pragma unroll
                for (int j = 0; j < 4; ++j) { v[j] = *(const f32x4*)(xr + 4 * lane + 256 * j); ss += (v[j][0] * v[j][0] + v[j][1] * v[j][1]) + (v[j][2] * v[j][2] + v[j][3] * v[j][3]); }
                const float rs = 1.0f / sqrtf(wave_sum(ss) * (1.0f / D) + EPS);
#pragma unroll
                for (int j = 0; j < 4; ++j) { v[j] = v[j] * rs * nw[j]; *(LAS f32x4*)(xs + r * 1024 + 4 * lane + 256 * j) = v[j];
                    u32x2 o; o.x = pk2(v[j][0], v[j][1]); o.y = pk2(v[j][2], v[j][3]); *(u32x2*)(XN + (size_t)m * D + 4 * lane + 256 * j) = o; } }
            __syncthreads();
            float ae[32], ag[32];
#pragma unroll
            for (int r = 0; r < 32; ++r) { ae[r] = 0.f; ag[r] = 0.f; }
            for (int k = wave * 128; k < wave * 128 + 128; k += 4) {
                float we[4], wg[4];
#pragma unroll
                for (int q = 0; q < 4; ++q) { we[q] = re[(size_t)(k + q) * 64 + lane]; wg[q] = rg[(size_t)(k + q) * 8 + (lane & 7)]; }
#pragma unroll
                for (int r = 0; r < 32; ++r) { const f32x4 x = *(const LAS f32x4*)(xs + r * 1024 + k);
                    ae[r] += x[0] * we[0] + x[1] * we[1] + x[2] * we[2] + x[3] * we[3];
                    ag[r] += x[0] * wg[0] + x[1] * wg[1] + x[2] * wg[2] + x[3] * wg[3]; }
            }
            __syncthreads();
            LAS float* part = xs;
#pragma unroll
            for (int r = 0; r < 32; ++r) { part[(wave * 32 + r) * 72 + lane] = ae[r]; if (lane < 8) part[(wave * 32 + r) * 72 + 64 + lane] = ag[r]; }
            __syncthreads();
            for (int r = wave * 4; r < wave * 4 + 4; ++r) { const int m = m0 + r;
                float le = 0.f, lg = 0.f;
#pragma unroll
                for (int w = 0; w < 8; ++w) { le += part[(w * 32 + r) * 72 + lane]; lg += part[(w * 32 + r) * 72 + 64 + (lane & 7)]; }
                float gv[8];
#pragma unroll
                for (int i = 0; i < 8; ++i) gv[i] = __shfl(lg, i);
                int grp = 0; float gmax = gv[0];
#pragma unroll
                for (int i = 1; i < 8; ++i) if (gv[i] > gmax) { gmax = gv[i]; grp = i; }
                float gs = 0.f;
#pragma unroll
                for (int i = 0; i < 8; ++i) gs += __expf(gv[i] - gmax);
                const float psel = 1.0f / gs;
                float ev[8];
#pragma unroll
                for (int i = 0; i < 8; ++i) ev[i] = __shfl(le, grp * 8 + i);
                int i1 = 0; float e1 = ev[0];
#pragma unroll
                for (int i = 1; i < 8; ++i) if (ev[i] > e1) { e1 = ev[i]; i1 = i; }
                int i2 = -1; float e2 = -3.0e38f;
#pragma unroll
                for (int i = 0; i < 8; ++i) if (i != i1 && ev[i] > e2) { e2 = ev[i]; i2 = i; }
                const float x2 = __expf(e2 - e1), w1 = psel / (1.0f + x2), w2 = psel * x2 / (1.0f + x2);
                if (lane == 0) { route_e[(size_t)m * 2] = grp * 8 + i1; route_e[(size_t)m * 2 + 1] = grp * 8 + i2; route_w[(size_t)m * 2] = w1; route_w[(size_t)m * 2 + 1] = w2;
                    atomicAdd((int*)(hist + grp * 8 + i1), 1); atomicAdd((int*)(hist + grp * 8 + i2), 1); }
            }
        }
        __syncthreads();
        if (tid < 64) cnt[vb * 64 + tid] = hist[tid];
        __syncthreads();
    }
}
__device__ __forceinline__ void moe_dispatch(const Params& p, LAS unsigned char* lds, int tid, int wave, int lane) {
    LAS int* tab = (LAS int*)(lds + LDSCTL_OFF + LC_TAB);
    const bf16* XN = (const bf16*)(p.ws + WS_XN); bf16* XS = (bf16*)(p.ws + WS_XS);
    const int* route_e = (const int*)(p.ws + WS_ROUTE); const float* route_w = (const float*)(p.ws + WS_ROUTE + (size_t)M * 2 * 4);
    int* row_code = (int*)(p.ws + WS_MOETAB); float* row_w = (float*)(p.ws + WS_MOETAB + (size_t)NROWS_MAX * 4);
    const int* cnt = (const int*)(p.ws + WS_MOETAB + (size_t)NROWS_MAX * 8); int* blk_e = (int*)(p.ws + WS_MOETAB + (size_t)NROWS_MAX * 8 + 256 * 64 * 4);
    for (int vb = blockIdx.x; vb < M / 128; vb += gridDim.x) {
        __syncthreads();
        if (tid < 64) { int run = 0, base = 0; for (int v = 0; v < M / 128; ++v) { if (v == vb) base = run; run += cnt[v * 64 + tid]; } tab[64 + tid] = run; tab[128 + tid] = base; }
        __syncthreads();
        if (tid == 0) { int s = 0; for (int e = 0; e < 64; ++e) { tab[e] = s; s += (tab[64 + e] + 255) / 256 * 256; } tab[704] = s; }
        if (tid < 256) tab[192 + tid] = route_e[(size_t)vb * 256 + tid];
        __syncthreads();
        if (tid < 256) { const int e = tab[192 + tid]; int rank = 0; for (int a = 0; a < tid; ++a) rank += (tab[192 + a] == e) ? 1 : 0;
            const int pos = tab[e] + tab[128 + e] + rank; tab[448 + tid] = pos;
            row_code[pos] = ((vb * 128 + (tid >> 1)) << 1) | (tid & 1); row_w[pos] = route_w[(size_t)vb * 256 + tid]; }
        if (vb < 64) { const int ps = tab[vb], tot = tab[64 + vb], pe = ps + (tot + 255) / 256 * 256;
            for (int r = ps + tot + tid; r < pe; r += 512) row_code[r] = -1;
            for (int b = ps / 256 + tid; b < pe / 256; b += 512) blk_e[b] = vb;
            if (tid == 0) { blk_e[NROWBLK_MAX + 64 + vb] = ps / 256; blk_e[NROWBLK_MAX + 128 + vb] = (pe - ps) / 256; }
            if (vb == 63 && tid == 0) blk_e[NROWBLK_MAX] = tab[704] / 256; }
        __syncthreads();
        for (int a = wave; a < 256; a += 8) { const int pos = tab[448 + a]; const int tok = vb * 128 + (a >> 1);
            const u32x4* src = (const u32x4*)(XN + (size_t)tok * D); u32x4* dst = (u32x4*)(XS + (size_t)pos * D);
            dst[lane] = src[lane]; dst[lane + 64] = src[lane + 64]; }
    }
    __syncthreads();
}

__global__ void __launch_bounds__(512, 2) fwd(Params p) {
    extern __shared__ __attribute__((aligned(16))) unsigned char lds_raw[];
    LAS unsigned char* lds = (LAS unsigned char*)lds_raw;
    const int tid0 = threadIdx.x;
    const int G = gridDim.x, NGW = G * 8, NGT = G * 512;
#define FRESH() int tid = tid0; asm volatile("" : "+v"(tid)); const int lane = tid & 63, wave = __builtin_amdgcn_readfirstlane(tid >> 6); const int gw = blockIdx.x * 8 + wave, gtid = blockIdx.x * 512 + tid; (void)lane; (void)gw; (void)gtid
    for (int u = tid0; u < (LDS_BYTES - LDSCTL_OFF) / 4; u += 512) ((LAS unsigned*)(lds + LDSCTL_OFF))[u] = 0u;
    __syncthreads();
    const int lo = p.ph_lo, hi = p.ph_hi;
    XcdBarrier bar; bar.bar = (unsigned*)(p.ws + WS_CTL) + CW_BAR; bar.x = 0; bar.st = (volatile LAS unsigned*)(lds + LDSCTL_OFF + LC_BAR);
    if (hi - lo > 1) bar = xcd_barrier_post((unsigned*)(p.ws + WS_CTL) + CW_BAR, (volatile LAS unsigned*)(lds + LDSCTL_OFF + LC_BAR));
#ifndef PHASE_MASK
#define PHASE_MASK 0x1fff
#endif
#define IN(k) (((PHASE_MASK >> ((k) == PH_FINAL ? 12 : ((k) % PH_PER_LAYER))) & 1) && lo <= (k) && (k) < hi)
#define REPS(k) ((((REPEAT_MASK) >> (k)) & 1) && layer == 0 ? 2 : 1)
#define SEAM(k) do { if (IN(k) && IN((k) + 1)) xcd_barrier(bar); } while (0)

    for (int layer = 0; layer < NLAYER; ++layer) {
        const int g0 = layer * PH_PER_LAYER;
        bf16* Hb = (bf16*)(p.ws + WS_H);
        for (int rep_ = 0; rep_ < REPS(0); ++rep_) if (IN(g0 + 0)) { if (rep_) __syncthreads(); FRESH();
            if (layer == 0) { prep_static_weights(p, gw, NGW, lane); __syncthreads(); norm_phase<0>(p, layer, lds, gw, NGW, tid, lane); }
            else norm_phase<1>(p, layer, lds, gw, NGW, tid, lane);
        }
        SEAM(g0 + 0);
        for (int rep_ = 0; rep_ < REPS(1); ++rep_) if (IN(g0 + 1)) { if (rep_) __syncthreads(); FRESH();
            SchedH S; S.to.init(M / 256, DH / 256, G, (int)blockIdx.x); S.A = (const char*)(p.ws + WS_XN); S.B = (const char*)(p.ws + WS_WIN + layer * WIN_L);
            EpiStoreBf16 E{Hb, DH};
            pg8::gemm_phase(lds, tid, D, D, D, S, E);
        }
        SEAM(g0 + 1);
        for (int rep_ = 0; rep_ < REPS(2); ++rep_) if (IN(g0 + 2)) { if (rep_) __syncthreads(); FRESH(); gdn_chunk_prep(p, layer, lds, tid, wave, lane); }
        SEAM(g0 + 2);
        for (int rep_ = 0; rep_ < REPS(3); ++rep_) if (IN(g0 + 3)) { if (rep_) __syncthreads(); FRESH();
            if ((int)blockIdx.x < 32) gdn_chunk_scan(p, lds, tid, wave, lane, (int)blockIdx.x);
            else { const int vb = (int)blockIdx.x - 32, nvb = G - 32;
                shortconv(p, layer, vb * 512 + tid, nvb * 512);
                conformer(p, layer, lds, tid, wave, lane, vb, nvb);
                __syncthreads();
                gmlp(p, layer, lds, tid, wave, lane, vb, nvb); }
        }
        SEAM(g0 + 3);
        for (int rep_ = 0; rep_ < REPS(4); ++rep_) if (IN(g0 + 4)) { if (rep_) __syncthreads(); FRESH(); gdn_out(p, layer, gw, NGW, lane); }
        SEAM(g0 + 4);
        if (IN(g0 + 5)) { FRESH();
            SchedBranch S; S.to.init(M / 256, 16, G, (int)blockIdx.x); S.YS = (const char*)(p.ws + WS_YS); S.WBR = (const char*)(p.ws + WS_WBR + layer * WBR_L);
            EpiGate E{Hb, DH};
            pg8::gemm_phase(lds, tid, 512, 2048, 512, S, E);
        }
        SEAM(g0 + 5);
        for (int rep_ = 0; rep_ < REPS(6); ++rep_) if (IN(g0 + 6)) { if (rep_) __syncthreads(); FRESH(); sum_gated(p, gtid, NGT); }
        SEAM(g0 + 6);
        for (int rep_ = 0; rep_ < REPS(7); ++rep_) if (IN(g0 + 7)) { if (rep_) __syncthreads(); FRESH();
            const int NGB = G / 2;
            if ((int)blockIdx.x < NGB) {
                SchedOut S; S.to.init(M / 256, 4, NGB, (int)blockIdx.x); S.A = (const char*)(p.ws + WS_MERGED); S.B = (const char*)(p.ws + WS_WOUT + layer * WOUT_L);
                EpiResF32 E{layer == 0 ? p.in[I_X] : p.out, p.out};
                pg8::gemm_phase(lds, tid, D, D, D, S, E);
            } else prep_moe_weights(p, layer, ((int)blockIdx.x - NGB) * 8 + wave, (G - NGB) * 8, lane);
        }
        SEAM(g0 + 7);
        for (int rep_ = 0; rep_ < REPS(8); ++rep_) if (IN(g0 + 8)) { if (rep_) __syncthreads(); FRESH(); moe_route(p, layer, lds, tid, wave, lane); }
        SEAM(g0 + 8);
        for (int rep_ = 0; rep_ < REPS(9); ++rep_) if (IN(g0 + 9)) { if (rep_) __syncthreads(); FRESH(); moe_dispatch(p, lds, tid, wave, lane); }
        SEAM(g0 + 9);
        if (IN(g0 + 10) || IN(g0 + 11)) { FRESH();
            LAS int* tb = (LAS int*)(lds + LDSCTL_OFF + LC_TAB);
            const int* est = (const int*)(p.ws + WS_MOETAB + (size_t)NROWS_MAX * 8 + 256 * 64 * 4) + NROWBLK_MAX + 64;
            const int NX = (G % 8 == 0) ? 8 : 1, x = (int)blockIdx.x % NX, nk = 64 / NX;
            __syncthreads();
            if (tid < nk) { tb[160 + tid] = est[x + NX * tid]; tb[240 + tid] = est[64 + x + NX * tid]; }
            __syncthreads();
            if (tid == 0) { int s = 0; for (int k = 0; k < nk; ++k) { tb[k] = s; tb[80 + k] = tb[160 + k]; s += tb[240 + k] * 4; } tb[nk] = s; }
            __syncthreads();
        }
        for (int rep_ = 0; rep_ < REPS(10); ++rep_) if (IN(g0 + 10)) { if (rep_) __syncthreads(); FRESH();
            LAS int* tb = (LAS int*)(lds + LDSCTL_OFF + LC_TAB); const int NX = (G % 8 == 0) ? 8 : 1, nk = 64 / NX;
            SchedMoe S; S.nux = tb[nk]; S.nrank = G / NX; S.rank = (int)blockIdx.x / NX; S.nk = nk; S.x = (int)blockIdx.x % NX; S.NX = NX; S.cum = tb; S.rb0 = tb + 80;
            S.A = (const char*)(p.ws + WS_XS); S.a_blk = (size_t)256 * D * 2; S.W = (const char*)(p.ws + WS_MOEW); S.w_e = WGU_E; S.w_pn = (size_t)256 * D * 2; S.cmul = 128;
            EpiSwiglu E{(bf16*)(p.ws + WS_HB)};
            pg8::gemm_phase(lds, tid, D, D, D, S, E);
        }
        SEAM(g0 + 10);
        for (int rep_ = 0; rep_ < REPS(11); ++rep_) if (IN(g0 + 11)) { if (rep_) __syncthreads(); FRESH();
            LAS int* tb = (LAS int*)(lds + LDSCTL_OFF + LC_TAB); const int NX = (G % 8 == 0) ? 8 : 1, nk = 64 / NX;
            SchedMoe S; S.nux = tb[nk]; S.nrank = G / NX; S.rank = (int)blockIdx.x / NX; S.nk = nk; S.x = (int)blockIdx.x % NX; S.NX = NX; S.cum = tb; S.rb0 = tb + 80;
            S.A = (const char*)(p.ws + WS_HB); S.a_blk = (size_t)256 * DE * 2; S.W = (const char*)(p.ws + WS_WD); S.w_e = WD_E; S.w_pn = (size_t)256 * DE * 2; S.cmul = 256;
            EpiScatter E{(bf16*)(p.ws + WS_Y), (const int*)(p.ws + WS_MOETAB), (const float*)(p.ws + WS_MOETAB + (size_t)NROWS_MAX * 4)};
            pg8::gemm_phase(lds, tid, DE, DE, DE, S, E);
        }
        SEAM(g0 + 11);
    }
    if (IN(PH_FINAL)) { FRESH(); norm_phase<2>(p, 0, lds, gw, NGW, tid, lane); }
#undef IN
#undef SEAM
}

extern "C" void kernel_launch(void* const* d_in, const int* in_sizes, int n_in, void* d_out, int out_size, void* d_ws, size_t ws_size, hipStream_t stream) {
    static int grid = 0;
    if (grid == 0) {
        if (n_in != 25 || out_size != M * D || ws_size < WS_END) { fprintf(stderr, "kernel_launch: unexpected shapes / workspace (n_in %d out %d ws %zu, need %zu)\n", n_in, out_size, ws_size, (size_t)WS_END); grid = -1; return; }
        int dev = 0, cus = 0, per_cu = 0;
        if (hipGetDevice(&dev) != hipSuccess || hipDeviceGetAttribute(&cus, hipDeviceAttributeMultiprocessorCount, dev) != hipSuccess) { grid = -1; return; }
        if (hipFuncSetAttribute((const void*)fwd, hipFuncAttributeMaxDynamicSharedMemorySize, LDS_BYTES) != hipSuccess) { fprintf(stderr, "kernel_launch: hipFuncSetAttribute failed\n"); grid = -1; return; }
        if (hipOccupancyMaxActiveBlocksPerMultiprocessor(&per_cu, (const void*)fwd, 512, LDS_BYTES) != hipSuccess || per_cu < 1) { fprintf(stderr, "kernel_launch: occupancy query says %d\n", per_cu); }
        (void)hipGetLastError();
        grid = cus;
    }
    if (grid < 0) return;
    hipMemsetAsync((char*)d_ws + WS_CTL, 0, CTL_BYTES, stream);
    Params p{};
    for (int i = 0; i < 25; ++i) p.in[i] = (const float*)d_in[i];
    p.out = (float*)d_out; p.ws = (unsigned char*)d_ws;
#if N_LAUNCH_MODE == 1
    p.ph_lo = 0; p.ph_hi = PH_TOTAL;
    hipLaunchKernelGGL(fwd, dim3(grid), dim3(512), LDS_BYTES, stream, p);
#else
    for (int k = 0; k < PH_TOTAL; ++k) { p.ph_lo = k; p.ph_hi = k + 1; hipLaunchKernelGGL(fwd, dim3(grid), dim3(512), LDS_BYTES, stream, p); }
#endif
}
```

```cpp
#include <hip/hip_runtime.h>
#include <cstdio>
#include <cstdint>

#ifndef REPEAT_MASK
#define REPEAT_MASK 0
#endif
#ifndef N_LAUNCH_MODE
#define N_LAUNCH_MODE 1
#endif

#define LAS __attribute__((address_space(3)))
typedef unsigned short bf16;
typedef short bf16x8 __attribute__((ext_vector_type(8)));
typedef float f32x4 __attribute__((ext_vector_type(4)));
typedef float f32x2 __attribute__((ext_vector_type(2)));
typedef unsigned u32x4 __attribute__((ext_vector_type(4)));
typedef unsigned u32x2 __attribute__((ext_vector_type(2)));

constexpr int NB = 8, T = 4096, D = 1024, M = NB * T, NLAYER = 2;
constexpr int DIN = 9736, DH = 9728;
constexpr int HQ = 0, HK = 512, HV = 1024, HZ = 1536, HCONF = 2048, HGMLP = 3072, HSC = 4096, HGATE = 5632;
constexpr int NE = 64, DE = 512;
constexpr float EPS = 1e-6f;
constexpr int NROWBLK_MAX = 320, NROWS_MAX = NROWBLK_MAX * 256;

constexpr size_t MiB = 1u << 20;
constexpr size_t WS_CTL = 0, CTL_BYTES = 1 * MiB;
constexpr size_t WS_WIN = 2 * MiB;
constexpr size_t WIN_L = (size_t)DH * D * 2;
constexpr size_t WS_WBR = 40 * MiB;
constexpr size_t WBR_L = (size_t)4 * D * 512 * 2;
constexpr size_t WS_WOUT = 48 * MiB;
constexpr size_t WOUT_L = (size_t)D * D * 2;
constexpr size_t WS_XN = 52 * MiB;
constexpr size_t WS_SMALL = 116 * MiB;
constexpr size_t WS_ROUTE = 117 * MiB;
constexpr size_t WS_MOETAB = 118 * MiB;
constexpr size_t WS_YS = 120 * MiB;
constexpr size_t WS_REC = 248 * MiB;
constexpr size_t WS_MERGED = WS_REC;
constexpr size_t WS_OBUF = WS_XN;
constexpr int REC_W = 0, REC_Q = 16384, REC_ATT = 32768, REC_KT = 40960, REC_U = 57344, REC_G = 73728, REC_BYTES = 73984;
static_assert(WS_REC + (size_t)2048 * REC_BYTES <= 410 * MiB, "chunk records");
constexpr size_t WS_H = 410 * MiB;
constexpr size_t WS_MOEW = 410 * MiB;
constexpr size_t WGU_E = (size_t)1024 * 1024 * 2, WD_E = (size_t)1024 * 512 * 2;
constexpr size_t WS_WD = WS_MOEW + 64 * WGU_E;
constexpr size_t WS_XS = 602 * MiB;
constexpr size_t WS_HB = 762 * MiB;
constexpr size_t WS_Y = 842 * MiB;
constexpr size_t WS_END = 1018 * MiB;
static_assert(WS_H + (size_t)M * DH * 2 <= WS_END && WS_Y + (size_t)2 * M * D * 2 <= WS_END, "ws map");

constexpr int CW_BAR = 4096;
constexpr int CW_QUEUE = 16384;
constexpr int STAGE_LDS = 131072, LDSCTL_OFF = 131072, LDS_BYTES = 147456;
constexpr int LC_BAR = 0;
constexpr int LC_MISC = 64;
constexpr int LC_TAB = 1024;

__device__ __forceinline__ float bf_lo(unsigned w) { return __uint_as_float(w << 16); }
__device__ __forceinline__ float bf_hi(unsigned w) { return __uint_as_float(w & 0xffff0000u); }
__device__ __forceinline__ float bf2f(bf16 b) { return __uint_as_float(((unsigned)b) << 16); }
__device__ __forceinline__ unsigned f2bf(float f) { unsigned u = __float_as_uint(f); return (u + 0x7fffu + ((u >> 16) & 1u)) >> 16; }
__device__ __forceinline__ unsigned pk2(float lo, float hi) { return f2bf(lo) | (f2bf(hi) << 16); }
__device__ __forceinline__ void unpack8(const u32x4 v, float (&f)[8]) {
    f[0] = bf_lo(v.x); f[1] = bf_hi(v.x); f[2] = bf_lo(v.y); f[3] = bf_hi(v.y); f[4] = bf_lo(v.z); f[5] = bf_hi(v.z); f[6] = bf_lo(v.w); f[7] = bf_hi(v.w);
}
__device__ __forceinline__ u32x4 pack8(const float (&f)[8]) { u32x4 o; o.x = pk2(f[0], f[1]); o.y = pk2(f[2], f[3]); o.z = pk2(f[4], f[5]); o.w = pk2(f[6], f[7]); return o; }
__device__ __forceinline__ float wave_sum(float v) {
#pragma unroll
    for (int o = 1; o < 64; o <<= 1) v += __shfl_xor(v, o);
    return v;
}
__device__ __forceinline__ float fexp(float x) { return __builtin_amdgcn_exp2f(x * 1.4426950408889634f); }
__device__ __forceinline__ float frcp(float x) { return __builtin_amdgcn_rcpf(x); }
__device__ __forceinline__ float sigmoidf_(float x) { return frcp(1.0f + fexp(-x)); }
__device__ __forceinline__ float siluf_(float x) { return x * frcp(1.0f + fexp(-x)); }
__device__ __forceinline__ float gelu_tanh(float x) { const float u = 0.7978845608028654f * (x + 0.044715f * x * x * x); return x * frcp(1.0f + fexp(-2.0f * u)); }
__device__ __forceinline__ float softplusf_(float x) { return fmaxf(x, 0.f) + log1pf(__expf(-fabsf(x))); }

#define XB_TMO      128
#define XB_XCNT(j)  (256  + 64 * (j))
#define XB_XSUB(j)  (1280 + 64 * (j))
#define XB_XGEN(j)  (2304 + 64 * (j))
#define XB_TOP      3328
#define XB_TOPGEN   3392
#define XCD_BAR_WORDS 3456
#define XB_SPIN_CAP (1u << 18)
__device__ __forceinline__ unsigned xb_ld(unsigned* p)              { return __hip_atomic_load(p, __ATOMIC_RELAXED, __HIP_MEMORY_SCOPE_AGENT); }
__device__ __forceinline__ unsigned xb_add(unsigned* p, unsigned v) { return __hip_atomic_fetch_add(p, v, __ATOMIC_RELAXED, __HIP_MEMORY_SCOPE_AGENT); }
__device__ __forceinline__ unsigned xb_xcc_id() { return (unsigned)__builtin_amdgcn_s_getreg((3 << 11) | 20) & 0xFu; }
#define XB_SPIN(cond, bar) do { unsigned _sp = 0; while (cond) { __builtin_amdgcn_s_sleep(1); \
    if ((++_sp & 255u) == 0u) { if (xb_ld(&(bar)[XB_TMO])) break; if (_sp > XB_SPIN_CAP) { atomicAdd(&(bar)[XB_TMO], 1u); break; } } } } while (0)
struct XcdBarrier { unsigned* bar; unsigned x; volatile LAS unsigned* st; };
__device__ __forceinline__ XcdBarrier xcd_barrier_post(unsigned* bar, volatile LAS unsigned* st) {
    XcdBarrier b; b.bar = bar; b.x = xb_xcc_id(); b.st = st;
    if (threadIdx.x == 0) (void)xb_add(&bar[XB_XCNT(b.x)], 1u);
    return b;
}
__device__ __forceinline__ void xcd_barrier_complete(unsigned* bar, unsigned x, unsigned& nloc, unsigned& nx) {
    const unsigned G = gridDim.x * gridDim.y * gridDim.z;
    unsigned sum, cnt, mine, sp = 0u;
    for (;;) {
        sum = 0u; cnt = 0u; mine = 0u;
#pragma unroll
        for (unsigned j = 0; j < 16; ++j) { const unsigned c = xb_ld(&bar[XB_XCNT(j)]); sum += c; cnt += (c > 0u) ? 1u : 0u; mine = (j == x) ? c : mine; }
        if (sum == G) break;
        __builtin_amdgcn_s_sleep(1);
        if ((++sp & 255u) == 0u) { if (xb_ld(&bar[XB_TMO])) break; if (sp > XB_SPIN_CAP) { atomicAdd(&bar[XB_TMO], 1u); break; } }
    }
    nloc = mine > 0u ? mine : 1u; nx = cnt > 0u ? cnt : 1u;
}
__device__ __forceinline__ void xcd_barrier(const XcdBarrier& b) {
    asm volatile("s_waitcnt vmcnt(0)" ::: "memory");
    __syncthreads();
    if (threadIdx.x == 0) {
        unsigned* bar = b.bar;
        __builtin_amdgcn_s_waitcnt(0);
        unsigned nloc = b.st[0], nx = b.st[1];
        if (nloc == 0u) { xcd_barrier_complete(bar, b.x, nloc, nx); b.st[0] = nloc; b.st[1] = nx; }
        const unsigned old = xb_add(&bar[XB_XSUB(b.x)], 1u);
        const unsigned gen = old / nloc;
        if (old + 1u == (gen + 1u) * nloc) {
            __builtin_amdgcn_fence(__ATOMIC_RELEASE, "agent");
            asm volatile("s_waitcnt vmcnt(0)" ::: "memory");
            const unsigned og = xb_add(&bar[XB_TOP], 1u);
            const unsigned tg = og / nx;
            if (og + 1u == (tg + 1u) * nx) xb_add(&bar[XB_TOPGEN], 1u);
            else XB_SPIN(xb_ld(&bar[XB_TOPGEN]) == tg, bar);
            __builtin_amdgcn_fence(__ATOMIC_ACQUIRE, "agent");
            xb_add(&bar[XB_XGEN(b.x)], 1u);
            asm volatile("s_waitcnt vmcnt(0)" ::: "memory");
        } else {
            XB_SPIN(xb_ld(&bar[XB_XGEN(b.x)]) == gen, bar);
            __builtin_amdgcn_fence(__ATOMIC_ACQUIRE, "agent");
            asm volatile("s_waitcnt vmcnt(0)" ::: "memory");
        }
    }
    __syncthreads();
}

namespace pg8 {
constexpr int BM = 256, BK = 64, HALF = 128, HTB = HALF * BK * 2, STAGE_BYTES = 8 * HTB, NXCD = 8, WGM = 8;
__host__ __device__ __forceinline__ int lds_byte(int r, int c) { const int st = (r >> 4) * 2 + (c >> 5), rr = r & 15, cc = c & 31, ob = rr * 64 + cc * 2; return st * 1024 + (ob ^ (((ob >> 9) & 1) << 5)); }
__host__ __device__ __forceinline__ void stage_rc(int b, int& R, int& C) { const int st = b / 1024, sb = b % 1024, swz = sb ^ (((sb >> 9) & 1) << 5); R = (st >> 1) * 16 + swz / 64; C = (st & 1) * 32 + (swz % 64) / 2; }
__host__ __device__ __forceinline__ int perm32(int rho) { const int n = rho >> 4, i = rho & 15; return 8 * (i >> 2) + 4 * n + (i & 3); }

struct Unit { const char* A; const char* B; int r0, c0; };

struct TileOrder {
    int nM, nN, nwg, G, c;
    __device__ void init(int nM_, int nN_, int G_, int c_) { nM = nM_; nN = nN_; nwg = nM * nN; G = G_; c = c_; }
    __device__ bool next(int i, int& pm, int& pn) const {
        const long L = (long)i * G + c; if (L >= nwg) return false;
        int wgid = (int)L; { const int q = nwg / NXCD, r = nwg % NXCD, xcd = wgid % NXCD, off = wgid / NXCD; wgid = (xcd < r ? xcd * (q + 1) : r * (q + 1) + (xcd - r) * q) + off; }
        const int nig = WGM * nN, gid = wgid / nig, fm = gid * WGM, gsz = (nM - fm) < WGM ? (nM - fm) : WGM;
        pm = fm + ((wgid % nig) % gsz); pn = (wgid % nig) / gsz; return true;
    }
};
__device__ __forceinline__ unsigned cvt_pk_bf16(float lo, float hi) { unsigned r; asm volatile("v_cvt_pk_bf16_f32 %0, %1, %2" : "=v"(r) : "v"(lo), "v"(hi)); return r; }

template <class Epi, class Sched>
__device__ __forceinline__ void gemm_phase(LAS unsigned char* lds, const int tid, const int K, const int lda, const int ldb, const Sched& S, const Epi& E) {
    const int wid = __builtin_amdgcn_readfirstlane(tid >> 6), lane = tid & 63, wr = wid >> 2, wc = wid & 3, fr = lane & 15, fq = lane >> 4;
    const int nt = K / BK;
    unsigned voffA[2], voffB[2];
#pragma unroll
    for (int i = 0; i < 2; ++i) { int R, C; stage_rc(tid * 16 + i * 8192, R, C); const int Rb = Epi::PERM ? ((R & ~31) + perm32(R & 31)) : R;
        voffA[i] = (unsigned)(R * lda + C) * 2u; voffB[i] = (unsigned)(Rb * ldb + C) * 2u; }
    const size_t kstep = (size_t)(BK * 2);
    const size_t hstepA = (size_t)HALF * lda * 2, hstepB = (size_t)HALF * ldb * 2;
    const unsigned ldsw = (unsigned)wid * 1024u;
    const int aoff = lds_byte(wr * 64 + fr, fq * 8), boff = lds_byte(wc * 32 + fr, fq * 8);
#define PG8_SA(b, h) (((b) * 2 + (h)) * HTB)
#define PG8_SB(b, h) ((4 + (b) * 2 + (h)) * HTB)
#define PG8_STAGE(bufoff, gbase, voff) do { _Pragma("unroll") for (int _i = 0; _i < 2; ++_i) \
        __builtin_amdgcn_global_load_lds((const unsigned*)((const char*)(gbase) + (voff)[_i]), (LAS unsigned*)(lds + (bufoff) + ldsw + _i * 8192), 16, 0, 0); } while (0)
#define PG8_LDA(dst, b, h) do { _Pragma("unroll") for (int m = 0; m < 4; ++m) _Pragma("unroll") for (int k = 0; k < 2; ++k) dst[m][k] = *(const LAS bf16x8*)(lds + PG8_SA(b, h) + aoff + m * 2048 + k * 1024); } while (0)
#define PG8_LDB(dst, b, h) do { _Pragma("unroll") for (int n = 0; n < 2; ++n) _Pragma("unroll") for (int k = 0; k < 2; ++k) dst[n][k] = *(const LAS bf16x8*)(lds + PG8_SB(b, h) + boff + n * 2048 + k * 1024); } while (0)
#define PG8_MMA(ai, bj, At, Bt) do { __builtin_amdgcn_s_setprio(1); _Pragma("unroll") for (int m = 0; m < 4; ++m) _Pragma("unroll") for (int n = 0; n < 2; ++n) _Pragma("unroll") for (int k = 0; k < 2; ++k) \
        acc[ai][bj][m][n] = __builtin_amdgcn_mfma_f32_16x16x32_bf16(Bt[n][k], At[m][k], acc[ai][bj][m][n], 0, 0, 0); __builtin_amdgcn_s_setprio(0); } while (0)
#define PG8_WAIT_V(n) asm volatile("s_waitcnt vmcnt(" #n ")" ::: "memory")
#define PG8_WAIT_L(n) asm volatile("s_waitcnt lgkmcnt(" #n ")" ::: "memory")
#define PG8_BAR __builtin_amdgcn_s_barrier()
#define PG8_SCHED __builtin_amdgcn_sched_barrier(0)
    Unit cur, nxt; int ui = 0;
    if (!S.next(0, cur)) return;
    f32x4 acc[2][2][4][2];
#pragma unroll
    for (int a = 0; a < 2; ++a)
#pragma unroll
        for (int b = 0; b < 2; ++b)
#pragma unroll
            for (int m = 0; m < 4; ++m)
#pragma unroll
                for (int n = 0; n < 2; ++n) acc[a][b][m][n] = (f32x4){0.f, 0.f, 0.f, 0.f};
    bf16x8 At[4][2], B0[2][2], B1[2][2];
    const char* cA = cur.A; const char* cB = cur.B;
    PG8_STAGE(PG8_SB(0, 0), cB, voffB); PG8_STAGE(PG8_SB(0, 1), cB + hstepB, voffB); PG8_STAGE(PG8_SA(0, 0), cA, voffA); PG8_STAGE(PG8_SA(0, 1), cA + hstepA, voffA);
    if (wr == 1) PG8_BAR;
    PG8_WAIT_V(2); PG8_BAR;
    PG8_STAGE(PG8_SB(1, 0), cB + kstep, voffB); PG8_STAGE(PG8_SA(1, 0), cA + kstep, voffA); PG8_STAGE(PG8_SB(1, 1), cB + hstepB + kstep, voffB);
    PG8_WAIT_V(6); PG8_BAR;
    for (;;) {
        const bool has_next = S.next(ui + 1, nxt);
        const char* nA = has_next ? nxt.A : cA; const char* nB = has_next ? nxt.B : cB;
        for (int t = 0; t < nt; t += 2) {
            const bool last = (t == nt - 2);
            const char* a1 = cA + (size_t)(t + 1) * kstep;
            const char* a2 = last ? nA : cA + (size_t)(t + 2) * kstep; const char* b2 = last ? nB : cB + (size_t)(t + 2) * kstep;
            const char* a3 = a2 + kstep; const char* b3 = b2 + kstep;
            PG8_LDB(B0, 0, 0); PG8_LDB(B1, 0, 1); PG8_SCHED; PG8_LDA(At, 0, 0); PG8_STAGE(PG8_SA(1, 1), a1 + hstepA, voffA);
            PG8_WAIT_V(8); PG8_WAIT_L(0); PG8_BAR; PG8_MMA(0, 0, At, B0); PG8_MMA(0, 1, At, B1); PG8_BAR; PG8_SCHED;
            PG8_LDA(At, 0, 1); PG8_STAGE(PG8_SB(0, 0), b2, voffB); PG8_STAGE(PG8_SB(0, 1), b2 + hstepB, voffB); PG8_STAGE(PG8_SA(0, 0), a2, voffA);
            PG8_WAIT_V(8); PG8_WAIT_L(0); PG8_BAR; PG8_MMA(1, 0, At, B0); PG8_MMA(1, 1, At, B1); PG8_BAR; PG8_SCHED;
            PG8_LDB(B0, 1, 0); PG8_LDB(B1, 1, 1); PG8_SCHED; PG8_LDA(At, 1, 0); PG8_STAGE(PG8_SA(0, 1), a2 + hstepA, voffA);
            PG8_WAIT_V(8); PG8_WAIT_L(0); PG8_BAR; PG8_MMA(0, 0, At, B0); PG8_MMA(0, 1, At, B1); PG8_BAR; PG8_SCHED;
            PG8_LDA(At, 1, 1); PG8_STAGE(PG8_SB(1, 0), b3, voffB); PG8_STAGE(PG8_SB(1, 1), b3 + hstepB, voffB); PG8_STAGE(PG8_SA(1, 0), a3, voffA);
            PG8_WAIT_V(8); PG8_WAIT_L(0); PG8_BAR; PG8_MMA(1, 0, At, B0); PG8_MMA(1, 1, At, B1); PG8_BAR; PG8_SCHED;
        }
        if (wr == 0) PG8_BAR;
        E(acc, cur, wr, wc, fr, fq);
        if (!has_next) break;
#pragma unroll
        for (int a = 0; a < 2; ++a)
#pragma unroll
            for (int b = 0; b < 2; ++b)
#pragma unroll
                for (int m = 0; m < 4; ++m)
#pragma unroll
                    for (int n = 0; n < 2; ++n) acc[a][b][m][n] = (f32x4){0.f, 0.f, 0.f, 0.f};
        cur = nxt; cA = nA; cB = nB; ++ui;
        if (wr == 1) PG8_BAR;
    }
    PG8_WAIT_V(0);
    PG8_BAR;
#undef PG8_SA
#undef PG8_SB
#undef PG8_STAGE
#undef PG8_LDA
#undef PG8_LDB
#undef PG8_MMA
#undef PG8_WAIT_V
#undef PG8_WAIT_L
#undef PG8_BAR
#undef PG8_SCHED
}
}
using pg8::Unit;
using pg8::cvt_pk_bf16;

struct EpiStoreBf16 {
    static constexpr bool PERM = true;
    bf16* O; int ldc;
    __device__ __forceinline__ void operator()(const f32x4 (&acc)[2][2][4][2], const Unit& u, int wr, int wc, int fr, int fq) const {
        const int row0 = u.r0 + wr * 64 + fr, col0 = u.c0 + wc * 32 + 8 * fq;
#pragma unroll
        for (int ai = 0; ai < 2; ++ai)
#pragma unroll
            for (int m = 0; m < 4; ++m) { bf16* rowp = O + (size_t)(row0 + ai * 128 + m * 16) * ldc + col0;
#pragma unroll
                for (int bj = 0; bj < 2; ++bj) { const f32x4 v0 = acc[ai][bj][m][0], v1 = acc[ai][bj][m][1];
                    u32x4 w; w.x = cvt_pk_bf16(v0[0], v0[1]); w.y = cvt_pk_bf16(v0[2], v0[3]); w.z = cvt_pk_bf16(v1[0], v1[1]); w.w = cvt_pk_bf16(v1[2], v1[3]);
                    *(u32x4*)(rowp + bj * 128) = w; } }
    }
};
struct EpiGate {
    static constexpr bool PERM = true;
    const bf16* Hg; bf16* MG;
    __device__ __forceinline__ void operator()(const f32x4 (&acc)[2][2][4][2], const Unit& u, int wr, int wc, int fr, int fq) const {
        const int row0 = u.r0 + wr * 64 + fr, gcol0 = u.c0 + wc * 32 + 8 * fq, mcol0 = (u.c0 & 1023) + wc * 32 + 8 * fq; const bool first = u.c0 < 1024;
#pragma unroll
        for (int ai = 0; ai < 2; ++ai)
#pragma unroll
            for (int m = 0; m < 4; ++m) { const bf16* grow = Hg + (size_t)(row0 + ai * 128 + m * 16) * DH + gcol0; bf16* mrow = MG + (size_t)(row0 + ai * 128 + m * 16) * D + mcol0;
#pragma unroll
                for (int bj = 0; bj < 2; ++bj) { const f32x4 v0 = acc[ai][bj][m][0], v1 = acc[ai][bj][m][1];
                    const u32x4 gw = *(const u32x4*)(grow + bj * 128); float g[8], pm[8]; unpack8(gw, g);
                    if (first) {
#pragma unroll
                        for (int e = 0; e < 8; ++e) pm[e] = 0.f; }
                    else unpack8(*(const u32x4*)(mrow + bj * 128), pm);
                    u32x4 w; w.x = cvt_pk_bf16(pm[0] + sigmoidf_(g[0]) * v0[0], pm[1] + sigmoidf_(g[1]) * v0[1]); w.y = cvt_pk_bf16(pm[2] + sigmoidf_(g[2]) * v0[2], pm[3] + sigmoidf_(g[3]) * v0[3]);
                    w.z = cvt_pk_bf16(pm[4] + sigmoidf_(g[4]) * v1[0], pm[5] + sigmoidf_(g[5]) * v1[1]); w.w = cvt_pk_bf16(pm[6] + sigmoidf_(g[6]) * v1[2], pm[7] + sigmoidf_(g[7]) * v1[3]);
                    *(u32x4*)(mrow + bj * 128) = w; } }
    }
};
struct EpiResF32 {
    static constexpr bool PERM = false;
    const float* res; float* out;
    __device__ __forceinline__ void operator()(const f32x4 (&acc)[2][2][4][2], const Unit& u, int wr, int wc, int fr, int fq) const {
        const int row0 = u.r0 + wr * 64 + fr, col0 = u.c0 + wc * 32 + 4 * fq;
#pragma unroll
        for (int ai = 0; ai < 2; ++ai)
#pragma unroll
            for (int m = 0; m < 4; ++m) { const size_t ro = (size_t)(row0 + ai * 128 + m * 16) * D + col0;
#pragma unroll
                for (int bj = 0; bj < 2; ++bj)
#pragma unroll
                    for (int n = 0; n < 2; ++n) { const f32x4 r = *(const f32x4*)(res + ro + bj * 128 + n * 16); *(f32x4*)(out + ro + bj * 128 + n * 16) = r + acc[ai][bj][m][n]; } }
    }
};
struct EpiSwiglu {
    static constexpr bool PERM = true;
    bf16* O;
    __device__ __forceinline__ void operator()(const f32x4 (&acc)[2][2][4][2], const Unit& u, int wr, int wc, int fr, int fq) const {
        const int row0 = u.r0 + wr * 64 + fr, col0 = u.c0 + wc * 32 + 8 * fq;
#pragma unroll
        for (int ai = 0; ai < 2; ++ai)
#pragma unroll
            for (int m = 0; m < 4; ++m) { bf16* rowp = O + (size_t)(row0 + ai * 128 + m * 16) * DE + col0;
                const f32x4 g0 = acc[ai][0][m][0], g1 = acc[ai][0][m][1], u0 = acc[ai][1][m][0], u1 = acc[ai][1][m][1];
                u32x4 w; w.x = cvt_pk_bf16(siluf_(g0[0]) * u0[0], siluf_(g0[1]) * u0[1]); w.y = cvt_pk_bf16(siluf_(g0[2]) * u0[2], siluf_(g0[3]) * u0[3]);
                w.z = cvt_pk_bf16(siluf_(g1[0]) * u1[0], siluf_(g1[1]) * u1[1]); w.w = cvt_pk_bf16(siluf_(g1[2]) * u1[2], siluf_(g1[3]) * u1[3]);
                *(u32x4*)rowp = w; }
    }
};
struct EpiScatter {
    static constexpr bool PERM = true;
    bf16* Y; const int* row_code; const float* row_w;
    __device__ __forceinline__ void operator()(const f32x4 (&acc)[2][2][4][2], const Unit& u, int wr, int wc, int fr, int fq) const {
        const int row0 = u.r0 + wr * 64 + fr, col0 = u.c0 + wc * 32 + 8 * fq;
#pragma unroll
        for (int ai = 0; ai < 2; ++ai)
#pragma unroll
            for (int m = 0; m < 4; ++m) { const int row = row0 + ai * 128 + m * 16; const int code = row_code[row]; const float rw = row_w[row];
                if (code >= 0) { bf16* rowp = Y + (size_t)(code & 1) * ((size_t)M * D) + (size_t)(code >> 1) * D + col0;
#pragma unroll
                    for (int bj = 0; bj < 2; ++bj) { const f32x4 v0 = acc[ai][bj][m][0] * rw, v1 = acc[ai][bj][m][1] * rw;
                        u32x4 w; w.x = cvt_pk_bf16(v0[0], v0[1]); w.y = cvt_pk_bf16(v0[2], v0[3]); w.z = cvt_pk_bf16(v1[0], v1[1]); w.w = cvt_pk_bf16(v1[2], v1[3]);
                        *(u32x4*)(rowp + bj * 128) = w; } } }
    }
};

struct SchedH {
    pg8::TileOrder to; const char* A; const char* B;
    __device__ __forceinline__ bool next(int i, Unit& u) const { int pm, pn; if (!to.next(i, pm, pn)) return false;
        u.A = A + (size_t)pm * 256 * D * 2; u.B = B + (size_t)pn * 256 * D * 2; u.r0 = pm * 256; u.c0 = pn * 256; return true; }
};
struct SchedBranch {
    pg8::TileOrder to; const char* YS; const char* WBR;
    __device__ __forceinline__ bool next(int i, Unit& u) const { int pm, q; if (!to.next(i >> 2, pm, q)) return false; const int br = i & 3;
        u.A = YS + ((size_t)pm * 256 * 2048 + br * 512) * 2; u.B = WBR + ((size_t)br * D * 512 + (size_t)q * 256 * 512) * 2; u.r0 = pm * 256; u.c0 = br * 1024 + q * 256; return true; }
};
struct SchedOut {
    pg8::TileOrder to; const char* A; const char* B;
    __device__ __forceinline__ bool next(int i, Unit& u) const { int pm, pn; if (!to.next(i, pm, pn)) return false;
        u.A = A + (size_t)pm * 256 * D * 2; u.B = B + (size_t)pn * 256 * D * 2; u.r0 = pm * 256; u.c0 = pn * 256; return true; }
};
struct SchedMoe {
    int nux, nrank, rank, nk, x, NX; const LAS int* cum; const LAS int* rb0; const char* A; size_t a_blk; const char* W; size_t w_e, w_pn; int cmul;
    __device__ __forceinline__ bool next(int i, Unit& u) const { const int ui = i * nrank + rank; if (ui >= nux) return false;
        int k = 0; while (k + 1 < nk && cum[k + 1] <= ui) ++k;
        const int local = ui - cum[k], rb = rb0[k] + (local >> 2), pn = local & 3, e = x + NX * k;
        u.A = A + (size_t)rb * a_blk; u.B = W + (size_t)e * w_e + (size_t)pn * w_pn; u.r0 = rb * 256; u.c0 = pn * cmul; return true; }
};

struct Params { const float* in[25]; float* out; unsigned char* ws; int ph_lo, ph_hi; };
enum { I_X = 0, I_MIXNW, I_WIN, I_GCONV, I_GALOG, I_GDT, I_GNW, I_CCW, I_CCB, I_CLNW, I_CLNB, I_GLNW, I_GLNB, I_GWS, I_GBS, I_SCW, I_WBR, I_WOUT, I_MOENW, I_RGRP, I_REXP, I_WG, I_WU, I_WD, I_FNW };
constexpr int PH_PER_LAYER = 12, PH_FINAL = 24, PH_TOTAL = 25;

__device__ __forceinline__ void transpose_item(const float* __restrict__ W, int ldw, int srccol, bf16* __restrict__ WT, int ldt, int k0, int n0, int lane) {
    const int kq = lane & 7, nq = lane >> 3;
    f32x4 v[8][2];
#pragma unroll
    for (int r = 0; r < 8; ++r) { const float* s = W + (size_t)(k0 + 8 * kq + r) * ldw + srccol + 8 * nq; v[r][0] = *(const f32x4*)s; v[r][1] = *(const f32x4*)(s + 4); }
#pragma unroll
    for (int e = 0; e < 8; ++e) { u32x4 o; o.x = pk2(v[0][e >> 2][e & 3], v[1][e >> 2][e & 3]); o.y = pk2(v[2][e >> 2][e & 3], v[3][e >> 2][e & 3]); o.z = pk2(v[4][e >> 2][e & 3], v[5][e >> 2][e & 3]); o.w = pk2(v[6][e >> 2][e & 3], v[7][e >> 2][e & 3]);
        *(u32x4*)(WT + (size_t)(n0 + 8 * nq + e) * ldt + k0 + 8 * kq) = o; }
}
__device__ __forceinline__ void prep_static_weights(const Params& p, int gw, int NGW, int lane) {
    constexpr int I_IN = 16 * (DH / 64), I_BR = 8 * 16, I_OUT = 16 * 16, PER_L = I_IN + 4 * I_BR + I_OUT;
    for (int it = gw; it < NLAYER * PER_L; it += NGW) {
        const int l = it / PER_L; int r = it % PER_L;
        if (r < I_IN) { const int kb = r / (DH / 64), nb = r % (DH / 64), n0 = nb * 64;
            transpose_item(p.in[I_WIN] + (size_t)l * D * DIN, DIN, n0 + (n0 >= 2048 ? 8 : 0), (bf16*)(p.ws + WS_WIN + l * WIN_L), D, kb * 64, n0, lane); continue; }
        r -= I_IN;
        if (r < 4 * I_BR) { const int br = r / I_BR, q = r % I_BR, kb = q / 16, nb = q % 16;
            transpose_item(p.in[I_WBR] + ((size_t)l * 4 + br) * 512 * D, D, nb * 64, (bf16*)(p.ws + WS_WBR + l * WBR_L) + (size_t)br * D * 512, 512, kb * 64, nb * 64, lane); continue; }
        r -= 4 * I_BR;
        { const int kb = r / 16, nb = r % 16;
            transpose_item(p.in[I_WOUT] + (size_t)l * D * D, D, nb * 64, (bf16*)(p.ws + WS_WOUT + l * WOUT_L), D, kb * 64, nb * 64, lane); }
    }
}
__device__ __forceinline__ void prep_moe_weights(const Params& p, int layer, int gw, int NGW, int lane) {
    constexpr int I_GU = 16 * 16, I_D = 8 * 16, PER_E = I_GU + I_D;
    for (int it = gw; it < NE * PER_E; it += NGW) {
        const int e = it / PER_E; int r = it % PER_E;
        if (r < I_GU) { const int kb = r / 16, nb = r % 16, n0 = nb * 64, pn = n0 >> 8, half = (n0 >> 7) & 1, j0 = n0 & 127;
            const float* src = p.in[half ? I_WU : I_WG] + ((size_t)layer * NE + e) * D * DE;
            transpose_item(src, DE, 128 * pn + j0, (bf16*)(p.ws + WS_MOEW + e * WGU_E), D, kb * 64, n0, lane); continue; }
        r -= I_GU;
        { const int kb = r / 16, nb = r % 16;
            transpose_item(p.in[I_WD] + ((size_t)layer * NE + e) * DE * D, D, nb * 64, (bf16*)(p.ws + WS_WD + e * WD_E), DE, kb * 64, nb * 64, lane); }
    }
}

template <int MODE>
__device__ __forceinline__ void norm_phase(const Params& p, int layer, LAS unsigned char* lds, int gw, int NGW, int tid, int lane) {
    LAS float* wsm = (LAS float*)lds;
    if (MODE != 2) {
        const float* wi = p.in[I_WIN] + (size_t)layer * D * DIN;
        for (int i = tid; i < 8192; i += 512) wsm[i] = wi[(size_t)(i >> 3) * DIN + 2048 + (i & 7)];
    }
    __syncthreads();
    const float* nwp = (MODE == 2) ? p.in[I_FNW] : p.in[I_MIXNW] + layer * D;
    f32x4 nw[4];
#pragma unroll
    for (int j = 0; j < 4; ++j) nw[j] = *(const f32x4*)(nwp + 4 * lane + 256 * j);
    const bf16* Y0 = (const bf16*)(p.ws + WS_Y); const bf16* Y1 = Y0 + (size_t)M * D;
    bf16* XN = (bf16*)(p.ws + WS_XN); float* SMALL = (float*)(p.ws + WS_SMALL);
    for (int m = gw; m < M; m += NGW) {
        const float* xr = (MODE == 0 ? p.in[I_X] : p.out) + (size_t)m * D;
        f32x4 v[4]; float ss = 0.f;
#pragma unroll
        for (int j = 0; j < 4; ++j) { v[j] = *(const f32x4*)(xr + 4 * lane + 256 * j);
            if (MODE != 0) { const u32x2 a = *(const u32x2*)(Y0 + (size_t)m * D + 4 * lane + 256 * j), b = *(const u32x2*)(Y1 + (size_t)m * D + 4 * lane + 256 * j);
                v[j][0] += bf_lo(a.x) + bf_lo(b.x); v[j][1] += bf_hi(a.x) + bf_hi(b.x); v[j][2] += bf_lo(a.y) + bf_lo(b.y); v[j][3] += bf_hi(a.y) + bf_hi(b.y); }
            ss += (v[j][0] * v[j][0] + v[j][1] * v[j][1]) + (v[j][2] * v[j][2] + v[j][3] * v[j][3]); }
        const float rs = 1.0f / sqrtf(wave_sum(ss) * (1.0f / D) + EPS);
        if (MODE == 2) {
#pragma unroll
            for (int j = 0; j < 4; ++j) *(f32x4*)(p.out + (size_t)m * D + 4 * lane + 256 * j) = v[j] * rs * nw[j];
            continue;
        }
        if (MODE == 1) {
#pragma unroll
            for (int j = 0; j < 4; ++j) *(f32x4*)(p.out + (size_t)m * D + 4 * lane + 256 * j) = v[j];
        }
        float sm[8];
#pragma unroll
        for (int q = 0; q < 8; ++q) sm[q] = 0.f;
#pragma unroll
        for (int j = 0; j < 4; ++j) { v[j] = v[j] * rs * nw[j];
            u32x2 o; o.x = pk2(v[j][0], v[j][1]); o.y = pk2(v[j][2], v[j][3]); *(u32x2*)(XN + (size_t)m * D + 4 * lane + 256 * j) = o;
#pragma unroll
            for (int c = 0; c < 4; ++c) { const LAS float* wrow = wsm + (4 * lane + 256 * j + c) * 8; const f32x4 w0 = *(const LAS f32x4*)wrow, w1 = *(const LAS f32x4*)(wrow + 4);
                sm[0] += v[j][c] * w0[0]; sm[1] += v[j][c] * w0[1]; sm[2] += v[j][c] * w0[2]; sm[3] += v[j][c] * w0[3];
                sm[4] += v[j][c] * w1[0]; sm[5] += v[j][c] * w1[1]; sm[6] += v[j][c] * w1[2]; sm[7] += v[j][c] * w1[3]; } }
        float mine = 0.f;
#pragma unroll
        for (int q = 0; q < 8; ++q) { const float s = wave_sum(sm[q]); mine = (lane == q) ? s : mine; }
        if (lane < 8) SMALL[(size_t)m * 8 + lane] = mine;
    }
    __syncthreads();
}

__device__ __forceinline__ void shortconv_unit(const Params& p, int layer, int tid, int unit) {
    const bf16* H = (const bf16*)(p.ws + WS_H); bf16* YS = (bf16*)(p.ws + WS_YS);
    const float* cw = p.in[I_SCW] + (size_t)layer * 3 * 512;
#pragma unroll 2
    for (int k = 0; k < 16; ++k) { const int it = unit * 8192 + k * 512 + tid;
        const int m = it >> 6, c8 = (it & 63) * 8, t = m & (T - 1);
        u32x4 rc[3], rx[3];
#pragma unroll
        for (int j = 0; j < 3; ++j) { const bool ok = (t - 2 + j >= 0); const bf16* r = H + (size_t)(ok ? m - 2 + j : m) * DH + HSC + c8; rc[j] = *(const u32x4*)(r + 512); rx[j] = *(const u32x4*)(r + 1024); if (!ok) rc[j] = (u32x4){0u, 0u, 0u, 0u}; }
        const u32x4 rb = *(const u32x4*)(H + (size_t)m * DH + HSC + c8);
        float acc[8];
#pragma unroll
        for (int i = 0; i < 8; ++i) acc[i] = 0.f;
#pragma unroll
        for (int j = 0; j < 3; ++j) { float cg[8], xv[8]; unpack8(rc[j], cg); unpack8(rx[j], xv);
#pragma unroll
            for (int i = 0; i < 8; ++i) acc[i] += cw[j * 512 + c8 + i] * (cg[i] * xv[i]); }
        float bg[8]; unpack8(rb, bg);
#pragma unroll
        for (int i = 0; i < 8; ++i) acc[i] *= bg[i];
        *(u32x4*)(YS + (size_t)m * 2048 + 1536 + c8) = pack8(acc);
    }
}
__device__ __forceinline__ int queue_pop(unsigned* counter, LAS unsigned char* lds, int tid) {
    LAS int* slot = (LAS int*)(lds + LDSCTL_OFF + LC_MISC);
    __syncthreads();
    if (tid == 0) slot[0] = (int)__hip_atomic_fetch_add(counter, 1u, __ATOMIC_RELAXED, __HIP_MEMORY_SCOPE_AGENT);
    __syncthreads();
    return slot[0];
}
__device__ __forceinline__ void conformer(const Params& p, int layer, LAS unsigned char* lds, int tid, int wave, int lane, unsigned* counter) {
    const bf16* H = (const bf16*)(p.ws + WS_H); bf16* YS = (bf16*)(p.ws + WS_YS);
    LAS bf16* yt = (LAS bf16*)lds;
    LAS float* zt = (LAS float*)(lds + 98304);
    const float* cwp = p.in[I_CCW] + (size_t)layer * 31 * 512;
    float cw[31];
#pragma unroll
    for (int j = 0; j < 31; ++j) cw[j] = cwp[j * 512 + tid];
    const float cb = p.in[I_CCB][layer * 512 + tid];
    float lw[8], lb[8];
#pragma unroll
    for (int i = 0; i < 8; ++i) { lw[i] = p.in[I_CLNW][layer * 512 + lane * 8 + i]; lb[i] = p.in[I_CLNB][layer * 512 + lane * 8 + i]; }
    for (;;) {
        const int unit = queue_pop(counter, lds, tid); if (unit >= M / 64) break;
        const int m0 = unit * 64, t0 = m0 & (T - 1);
        for (int base = 0; base < 94 * 64; base += 512 * 4) {
            u32x4 ra[4], rg[4];
#pragma unroll
            for (int k = 0; k < 4; ++k) { const int it = base + k * 512 + tid; const int r = it >> 6, c8 = (it & 63) * 8, dt = r - 30; const bool ok = (it < 94 * 64) && (t0 + dt >= 0);
                const bf16* s = H + (size_t)(ok ? m0 + dt : m0) * DH + HCONF + c8; ra[k] = *(const u32x4*)s; rg[k] = *(const u32x4*)(s + 512); }
#pragma unroll
            for (int k = 0; k < 4; ++k) { const int it = base + k * 512 + tid; const int r = it >> 6, c8 = (it & 63) * 8, dt = r - 30;
                if (it < 94 * 64) { u32x4 o = (u32x4){0u, 0u, 0u, 0u};
                    if (t0 + dt >= 0) { float a[8], g[8]; unpack8(ra[k], a); unpack8(rg[k], g);
#pragma unroll
                        for (int i = 0; i < 8; ++i) a[i] *= sigmoidf_(g[i]);
                        o = pack8(a); }
                    *(LAS u32x4*)(yt + r * 512 + c8) = o; } }
        }
        __syncthreads();
        for (int sb = 0; sb < 8; ++sb) {
            LAS float* zb = zt + (sb & 1) * 4096;
            float z[8];
#pragma unroll
            for (int i = 0; i < 8; ++i) z[i] = cb;
#pragma unroll
            for (int r = 0; r < 38; ++r) { const float yv = bf2f(yt[(sb * 8 + r) * 512 + tid]);
#pragma unroll
                for (int i = 0; i < 8; ++i) { const int j = r - i; if (j >= 0 && j < 31) z[i] += cw[j] * yv; } }
#pragma unroll
            for (int i = 0; i < 8; ++i) zb[i * 512 + tid] = z[i];
            __syncthreads();
            { const LAS float* zr = zb + wave * 512 + lane * 8; float v[8]; const f32x4 a = *(const LAS f32x4*)zr, b = *(const LAS f32x4*)(zr + 4);
                v[0] = a[0]; v[1] = a[1]; v[2] = a[2]; v[3] = a[3]; v[4] = b[0]; v[5] = b[1]; v[6] = b[2]; v[7] = b[3];
                float s = 0.f;
#pragma unroll
                for (int i = 0; i < 8; ++i) s += v[i];
                const float mean = wave_sum(s) * (1.0f / 512.0f); float q = 0.f;
#pragma unroll
                for (int i = 0; i < 8; ++i) { v[i] -= mean; q += v[i] * v[i]; }
                const float rstd = __builtin_amdgcn_rsqf(wave_sum(q) * (1.0f / 512.0f) + EPS);
#pragma unroll
                for (int i = 0; i < 8; ++i) v[i] = siluf_(v[i] * rstd * lw[i] + lb[i]);
                *(u32x4*)(YS + (size_t)(m0 + sb * 8 + wave) * 2048 + 512 + lane * 8) = pack8(v); }
        }
    }
}
__device__ __forceinline__ f32x4 mfma16(bf16x8 a, bf16x8 b, f32x4 c) { return __builtin_amdgcn_mfma_f32_16x16x32_bf16(a, b, c, 0, 0, 0); }
typedef short bf16x4 __attribute__((ext_vector_type(4)));
__device__ __forceinline__ bf16x8 ld_frag16(const LAS unsigned char* p) { return *(const LAS bf16x8*)p; }
__device__ __forceinline__ bf16x8 ld_frag8x2(const LAS unsigned char* p) { const bf16x4 a = *(const LAS bf16x4*)p, b = *(const LAS bf16x4*)(p + 32); return __builtin_shufflevector(a, b, 0, 1, 2, 3, 4, 5, 6, 7); }
__device__ __forceinline__ bf16x8 pack_frag(const f32x4 lo, const f32x4 hi) { u32x4 w; w.x = cvt_pk_bf16(lo[0], lo[1]); w.y = cvt_pk_bf16(lo[2], lo[3]); w.z = cvt_pk_bf16(hi[0], hi[1]); w.w = cvt_pk_bf16(hi[2], hi[3]); return __builtin_bit_cast(bf16x8, w); }
constexpr int GM_W = 0, GM_VT = 34816, GM_ST = 69632;
__device__ __forceinline__ void gmlp(const Params& p, int layer, LAS unsigned char* lds, int tid, int wave, int lane, unsigned* counter) {
    const bf16* H = (const bf16*)(p.ws + WS_H); bf16* YS = (bf16*)(p.ws + WS_YS);
    LAS float* st = (LAS float*)(lds + GM_ST);
    const float* lnw = p.in[I_GLNW] + layer * 512; const float* lnb = p.in[I_GLNB] + layer * 512;
    const int q = lane >> 4, li = lane & 15;
    for (;;) {
        const int unit = queue_pop(counter, lds, tid); if (unit >= M / 128) break;
        const int m0 = unit * 128;
        u32x4 rv[16];
#pragma unroll
        for (int k = 0; k < 16; ++k) rv[k] = *(const u32x4*)(H + (size_t)(m0 + wave * 16 + k) * DH + HGMLP + 512 + lane * 8);
#pragma unroll
        for (int k = 0; k < 16; ++k) { const int tk = wave * 16 + k;
            float v[8]; unpack8(rv[k], v);
            float s = 0.f;
#pragma unroll
            for (int i = 0; i < 8; ++i) { v[i] = gelu_tanh(v[i]); s += v[i]; }
            const float mean = wave_sum(s) * (1.0f / 512.0f); float qq = 0.f;
#pragma unroll
            for (int i = 0; i < 8; ++i) { const float d = v[i] - mean; qq += d * d; }
            const float rstd = 1.0f / sqrtf(wave_sum(qq) * (1.0f / 512.0f) + EPS);
            if (lane == 0) { st[tk * 2] = mean; st[tk * 2 + 1] = rstd; }
        }
        __syncthreads();
        for (int g = 0; g < 4; ++g) {
            u32x4 rg[4];
#pragma unroll
            for (int k = 0; k < 4; ++k) { const int it = tid + 512 * k; rg[k] = *(const u32x4*)(H + (size_t)(m0 + (it >> 4)) * DH + HGMLP + 512 + g * 128 + (it & 15) * 8); }
#pragma unroll
            for (int k = 0; k < 4; ++k) { const int it = tid + 512 * k; const int tk = it >> 4, c8 = (it & 15) * 8;
                float v[8]; unpack8(rg[k], v);
                const float mean = st[tk * 2], rstd = st[tk * 2 + 1];
#pragma unroll
                for (int i = 0; i < 8; ++i) *(LAS bf16*)(lds + GM_VT + (c8 + i) * 272 + 2 * tk) = (bf16)f2bf((gelu_tanh(v[i]) - mean) * rstd * lnw[g * 128 + c8 + i] + lnb[g * 128 + c8 + i]); }
            const float* ws = p.in[I_GWS] + ((size_t)layer * 4 + g) * 128 * 128;
            f32x4 wa[4], wb[4];
#pragma unroll
            for (int k = 0; k < 4; ++k) { const int it = tid + 512 * k; wa[k] = *(const f32x4*)(ws + (it >> 4) * 128 + (it & 15) * 8); wb[k] = *(const f32x4*)(ws + (it >> 4) * 128 + (it & 15) * 8 + 4); }
#pragma unroll
            for (int k = 0; k < 4; ++k) { const int it = tid + 512 * k; const int i = it >> 4, j8 = (it & 15) * 8;
                const f32x4 a = wa[k], b = wb[k];
                float w[8] = {a[0], a[1], a[2], a[3], b[0], b[1], b[2], b[3]};
#pragma unroll
                for (int e = 0; e < 8; ++e) w[e] = (j8 + e <= i) ? w[e] : 0.f;
                *(LAS u32x4*)(lds + GM_W + i * 272 + j8 * 2) = pack8(w); }
            __syncthreads();
            {
                f32x4 acc[8];
#pragma unroll
                for (int ct = 0; ct < 8; ++ct) acc[ct] = (f32x4){0.f, 0.f, 0.f, 0.f};
                const int nks = (wave >> 1) + 1;
                for (int ks = 0; ks < nks; ++ks) { const bf16x8 wf = ld_frag16(lds + GM_W + (16 * wave + li) * 272 + (32 * ks + 8 * q) * 2);
#pragma unroll
                    for (int ct = 0; ct < 8; ++ct) acc[ct] = mfma16(ld_frag16(lds + GM_VT + (16 * ct + li) * 272 + (32 * ks + 8 * q) * 2), wf, acc[ct]); }
                const int i = 16 * wave + li; const float bs = p.in[I_GBS][((size_t)layer * 4 + g) * 128 + i];
                const bf16* urow = H + (size_t)(m0 + i) * DH + HGMLP + g * 128 + 4 * q; bf16* orow = YS + (size_t)(m0 + i) * 2048 + 1024 + g * 128 + 4 * q;
#pragma unroll
                for (int ct = 0; ct < 8; ++ct) { const u32x2 uw = *(const u32x2*)(urow + 16 * ct);
                    const float o0 = gelu_tanh(bf_lo(uw.x)) * (acc[ct][0] + bs), o1 = gelu_tanh(bf_hi(uw.x)) * (acc[ct][1] + bs), o2 = gelu_tanh(bf_lo(uw.y)) * (acc[ct][2] + bs), o3 = gelu_tanh(bf_hi(uw.y)) * (acc[ct][3] + bs);
                    u32x2 ow; ow.x = pk2(o0, o1); ow.y = pk2(o2, o3); *(u32x2*)(orow + 16 * ct) = ow; }
            }
            __syncthreads();
        }
    }
}
constexpr int CP_QN = 0, CP_KN = 17408, CP_KT = 34816, CP_VT = 53248, CP_KGT = 71680, CP_A32 = 90112, CP_ATT = 106496, CP_T16 = 115712, CP_TAB = 124928;
__device__ __forceinline__ void gdn_chunk_prep(const Params& p, int layer, LAS unsigned char* lds, int tid, int wave, int lane) {
    const bf16* H = (const bf16*)(p.ws + WS_H); const float* SMALL = (const float*)(p.ws + WS_SMALL);
    const float* cw = p.in[I_GCONV] + (size_t)layer * 4 * 1536;
    LAS float* tab = (LAS float*)(lds + CP_TAB);
    const int q = lane >> 4, li = lane & 15;
    for (int unit = blockIdx.x; unit < 2048; unit += gridDim.x) {
        const int n = unit & 63, hh = (unit >> 6) & 3, b = unit >> 8; const int m0 = b * T + n * 64;
        unsigned char* rec = p.ws + WS_REC + (size_t)((b * 4 + hh) * 64 + n) * REC_BYTES;
        __syncthreads();
        if (wave == 0) { const int m = m0 + lane; const float br = SMALL[(size_t)m * 8 + hh], ar = SMALL[(size_t)m * 8 + 4 + hh];
            float g = -__expf(p.in[I_GALOG][layer * 4 + hh]) * softplusf_(ar + p.in[I_GDT][layer * 4 + hh]);
#pragma unroll
            for (int o = 1; o < 64; o <<= 1) { const float t = __shfl_up(g, o); if (lane >= o) g += t; }
            tab[lane] = sigmoidf_(br); tab[64 + lane] = g; tab[128 + lane] = __expf(g); }
        __syncthreads();
        {
            const int i0 = wave * 8, t0 = n * 64 + i0;
            unsigned raw[3][11];
#pragma unroll
            for (int s = 0; s < 3; ++s)
#pragma unroll
                for (int r = 0; r < 11; ++r) raw[s][r] = (t0 - 3 + r >= 0) ? *(const unsigned*)(H + (size_t)(m0 + i0 - 3 + r) * DH + s * 512 + hh * 128 + 2 * lane) : 0u;
            float w0[3][4], w1[3][4];
#pragma unroll
            for (int s = 0; s < 3; ++s)
#pragma unroll
                for (int j = 0; j < 4; ++j) { const f32x2 ww = *(const f32x2*)(cw + j * 1536 + s * 512 + hh * 128 + 2 * lane); w0[s][j] = ww[0]; w1[s][j] = ww[1]; }
#pragma unroll
            for (int ii = 0; ii < 8; ++ii) { const int i = i0 + ii;
                float y[3][2];
#pragma unroll
                for (int s = 0; s < 3; ++s) { float a0 = 0.f, a1 = 0.f;
#pragma unroll
                    for (int j = 0; j < 4; ++j) { a0 += w0[s][j] * bf_lo(raw[s][ii + j]); a1 += w1[s][j] * bf_hi(raw[s][ii + j]); }
                    y[s][0] = siluf_(a0); y[s][1] = siluf_(a1); }
                const float sq = wave_sum(y[0][0] * y[0][0] + y[0][1] * y[0][1]), sk = wave_sum(y[1][0] * y[1][0] + y[1][1] * y[1][1]);
                const float rq = 0.08838834764831845f * __builtin_amdgcn_rsqf(sq + EPS), rk = __builtin_amdgcn_rsqf(sk + EPS);
                const float be = tab[i], bg = be * tab[128 + i];
                const float k0 = y[1][0] * rk, k1 = y[1][1] * rk;
                *(LAS unsigned*)(lds + CP_QN + i * 272 + 4 * lane) = pk2(y[0][0] * rq, y[0][1] * rq);
                *(LAS unsigned*)(lds + CP_KN + i * 272 + 4 * lane) = pk2(k0, k1);
                *(LAS bf16*)(lds + CP_KT + (2 * lane) * 144 + 2 * i) = (bf16)f2bf(k0); *(LAS bf16*)(lds + CP_KT + (2 * lane + 1) * 144 + 2 * i) = (bf16)f2bf(k1);
                *(LAS bf16*)(lds + CP_VT + (2 * lane) * 144 + 2 * i) = (bf16)f2bf(be * y[2][0]); *(LAS bf16*)(lds + CP_VT + (2 * lane + 1) * 144 + 2 * i) = (bf16)f2bf(be * y[2][1]);
                *(LAS bf16*)(lds + CP_KGT + (2 * lane) * 144 + 2 * i) = (bf16)f2bf(bg * k0); *(LAS bf16*)(lds + CP_KGT + (2 * lane + 1) * 144 + 2 * i) = (bf16)f2bf(bg * k1);
            }
        }
        __syncthreads();
        for (int jb = wave; jb < 32; jb += 8) { const int which = jb >> 4, mt = (jb >> 2) & 3, nt = jb & 3;
            f32x4 acc = (f32x4){0.f, 0.f, 0.f, 0.f};
            if (nt <= mt) {
#pragma unroll
                for (int ks = 0; ks < 4; ++ks) acc = mfma16(ld_frag16(lds + (which ? CP_QN : CP_KN) + (16 * mt + li) * 272 + (32 * ks + 8 * q) * 2), ld_frag16(lds + CP_KN + (16 * nt + li) * 272 + (32 * ks + 8 * q) * 2), acc);
            }
            const int j = 16 * nt + li; const float gj = tab[64 + j];
#pragma unroll
            for (int r = 0; r < 4; ++r) { const int i = 16 * mt + 4 * q + r; const float gi = tab[64 + i];
                if (which == 0) { ((LAS float*)(lds + CP_A32))[i * 64 + j] = (i > j) ? tab[i] * acc[r] * __expf(gi - gj) : 0.f; }
                else { *(LAS bf16*)(lds + CP_ATT + i * 144 + 2 * j) = (bf16)f2bf((i >= j) ? acc[r] * __expf(gi - gj) : 0.f); } }
        }
        __syncthreads();
        if (wave == 0) {
            float Tc[64]; const float lanef = (float)lane;
            const LAS float* A = (const LAS float*)(lds + CP_A32); asm volatile("" : "+v"(A));
            LAS unsigned char* Tw = lds + CP_T16 + 2 * lane; asm volatile("" : "+v"(Tw));
#pragma unroll
            for (int i = 0; i < 64; ++i) { float a4[4] = {fmaxf(0.f, 1.f - fabsf((float)i - lanef)), 0.f, 0.f, 0.f};
#pragma unroll
                for (int j = 0; j < i; j += 4) { const f32x4 av = *(const LAS f32x4*)(A + i * 64 + j);
#pragma unroll
                    for (int jj = 0; jj < 4; ++jj) if (j + jj < i) a4[jj] -= av[jj] * Tc[j + jj]; }
                const float a = (a4[0] + a4[1]) + (a4[2] + a4[3]);
                Tc[i] = a; *(LAS bf16*)(Tw + i * 144) = (bf16)f2bf(a); }
        } else {
            const int t2 = tid - 64;
            for (int pc = t2; pc < 1024; pc += 448) { const int row = pc >> 4, seg = pc & 15; *(u32x4*)(rec + REC_Q + pc * 16) = *(const LAS u32x4*)(lds + CP_QN + row * 272 + seg * 16); }
            for (int pc = t2; pc < 512; pc += 448) { const int row = pc >> 3, seg = pc & 7; *(u32x4*)(rec + REC_ATT + pc * 16) = *(const LAS u32x4*)(lds + CP_ATT + row * 144 + seg * 16); }
            for (int pc = t2; pc < 1024; pc += 448) { const int row = pc >> 3, seg = pc & 7; *(u32x4*)(rec + REC_KT + pc * 16) = *(const LAS u32x4*)(lds + CP_KT + row * 144 + seg * 16); }
            if (t2 < 16) *(u32x4*)(rec + REC_G + t2 * 16) = *(const LAS u32x4*)(lds + CP_TAB + 256 + t2 * 16);
        }
        __syncthreads();
        for (int jb = wave; jb < 64; jb += 8) {
            f32x4 acc = (f32x4){0.f, 0.f, 0.f, 0.f};
            if (jb < 32) { const int mt = jb >> 3, nt = jb & 7;
#pragma unroll
                for (int ks = 0; ks < 2; ++ks) acc = mfma16(ld_frag16(lds + CP_T16 + (16 * mt + li) * 144 + (32 * ks + 8 * q) * 2), ld_frag16(lds + CP_VT + (16 * nt + li) * 144 + (32 * ks + 8 * q) * 2), acc);
                u32x2 o; o.x = pk2(acc[0], acc[1]); o.y = pk2(acc[2], acc[3]);
                *(u32x2*)(rec + REC_U + (size_t)((nt * 64 + lane) * 4 + mt) * 8) = o;
            } else { const int mt = (jb - 32) >> 2, nt = (jb - 32) & 3;
#pragma unroll
                for (int ks = 0; ks < 2; ++ks) acc = mfma16(ld_frag16(lds + CP_KGT + (16 * mt + li) * 144 + (32 * ks + 8 * q) * 2), ld_frag16(lds + CP_T16 + (16 * nt + li) * 144 + (32 * ks + 8 * q) * 2), acc);
                u32x2 o; o.x = pk2(acc[0], acc[1]); o.y = pk2(acc[2], acc[3]);
                *(u32x2*)(rec + REC_W + (size_t)((16 * nt + li) * 128 + 16 * mt + 4 * q) * 2) = o;
            }
        }
    }
    __syncthreads();
}
constexpr int SC_W = 0, SC_KT = 17408, SC_G = 35840, SC_BUF = 36096;
__device__ __forceinline__ void gdn_chunk_scan(const Params& p, LAS unsigned char* lds, int tid, int wave, int lane, int bh, int half) {
    const int q = lane >> 4, li = lane & 15, sl = half * 4 + (wave & 3);
    unsigned char* rec0 = p.ws + WS_REC + (size_t)(bh * 64) * REC_BYTES;
    u32x4* S0F = (u32x4*)(p.ws + WS_OBUF) + (size_t)(bh * 64) * 8 * 4 * 64;
    u32x4 pf[4], pfg = (u32x4){0u, 0u, 0u, 0u}, pu[2];
#define SC_LOAD(nn) do { const unsigned char* r_ = rec0 + (size_t)(nn) * REC_BYTES; \
        pf[0] = *(const u32x4*)(r_ + REC_W + (size_t)tid * 16); pf[1] = *(const u32x4*)(r_ + REC_W + (size_t)(tid + 512) * 16); \
        pf[2] = *(const u32x4*)(r_ + REC_KT + (size_t)tid * 16); pf[3] = *(const u32x4*)(r_ + REC_KT + (size_t)(tid + 512) * 16); \
        if (tid < 16) pfg = *(const u32x4*)(r_ + REC_G + tid * 16); \
        pu[0] = *(const u32x4*)(r_ + REC_U + (size_t)(sl * 64 + lane) * 32); pu[1] = *(const u32x4*)(r_ + REC_U + (size_t)(sl * 64 + lane) * 32 + 16); } while (0)
#define SC_STORE(buf) do { LAS unsigned char* d_ = lds + (buf) * SC_BUF; \
        _Pragma("unroll") for (int k_ = 0; k_ < 2; ++k_) { const int pc_ = tid + 512 * k_; *(LAS u32x4*)(d_ + SC_W + (pc_ >> 4) * 272 + (pc_ & 15) * 16) = pf[k_]; \
            *(LAS u32x4*)(d_ + SC_KT + (pc_ >> 3) * 144 + (pc_ & 7) * 16) = pf[2 + k_]; } \
        if (tid < 16) *(LAS u32x4*)(d_ + SC_G + tid * 16) = pfg; } while (0)
    f32x4 S[8];
#pragma unroll
    for (int i = 0; i < 8; ++i) S[i] = (f32x4){0.f, 0.f, 0.f, 0.f};
    __syncthreads();
    SC_LOAD(0); SC_STORE(0);
    u32x4 cu[2]; cu[0] = pu[0]; cu[1] = pu[1];
    __syncthreads();
    for (int n = 0; n < 64; ++n) {
        const LAS unsigned char* L = lds + (n & 1) * SC_BUF;
        if (n + 1 < 64) SC_LOAD(n + 1);
        if (wave < 4) {
            bf16x8 Sb[4];
#pragma unroll
            for (int ks = 0; ks < 4; ++ks) { Sb[ks] = pack_frag(S[2 * ks], S[2 * ks + 1]); S0F[(size_t)((n * 8 + sl) * 4 + ks) * 64 + lane] = __builtin_bit_cast(u32x4, Sb[ks]); }
            f32x4 a1[4];
#pragma unroll
            for (int mt = 0; mt < 4; ++mt) { a1[mt] = (f32x4){0.f, 0.f, 0.f, 0.f};
#pragma unroll
                for (int ks = 0; ks < 4; ++ks) a1[mt] = mfma16(ld_frag8x2(L + SC_W + (16 * mt + li) * 272 + (32 * ks + 4 * q) * 2), Sb[ks], a1[mt]); }
            const float g63 = *(const LAS float*)(L + SC_G + 63 * 4);
            f32x4 vn[4], vd[4];
#pragma unroll
            for (int mt = 0; mt < 4; ++mt) { const f32x4 gi = *(const LAS f32x4*)(L + SC_G + (16 * mt + 4 * q) * 4);
                const unsigned ulo = (mt < 2) ? (mt == 0 ? cu[0].x : cu[0].z) : (mt == 2 ? cu[1].x : cu[1].z), uhi = (mt < 2) ? (mt == 0 ? cu[0].y : cu[0].w) : (mt == 2 ? cu[1].y : cu[1].w);
                const f32x4 uu = (f32x4){bf_lo(ulo), bf_hi(ulo), bf_lo(uhi), bf_hi(uhi)};
                vn[mt] = uu - a1[mt];
#pragma unroll
                for (int r = 0; r < 4; ++r) vd[mt][r] = vn[mt][r] * fexp(g63 - gi[r]); }
            bf16x8 Vb[2], Vd[2];
#pragma unroll
            for (int ks = 0; ks < 2; ++ks) { Vb[ks] = pack_frag(vn[2 * ks], vn[2 * ks + 1]); Vd[ks] = pack_frag(vd[2 * ks], vd[2 * ks + 1]); }
            { unsigned char* ru = rec0 + (size_t)n * REC_BYTES + REC_U + (size_t)(sl * 64 + lane) * 32;
                *(u32x4*)ru = __builtin_bit_cast(u32x4, Vb[0]); *(u32x4*)(ru + 16) = __builtin_bit_cast(u32x4, Vb[1]); }
            const float eg = fexp(g63);
#pragma unroll
            for (int mt = 0; mt < 8; ++mt) { f32x4 a4 = (f32x4){0.f, 0.f, 0.f, 0.f};
#pragma unroll
                for (int ks = 0; ks < 2; ++ks) a4 = mfma16(ld_frag8x2(L + SC_KT + (16 * mt + li) * 144 + (32 * ks + 4 * q) * 2), Vd[ks], a4);
                S[mt] = S[mt] * eg + a4; }
        }
        if (n + 1 < 64) { SC_STORE((n + 1) & 1); cu[0] = pu[0]; cu[1] = pu[1]; }
        __syncthreads();
    }
#undef SC_LOAD
#undef SC_STORE
}
constexpr int CO_Q = 0, CO_ATT = 17408, CO_G = 26624, CO_PART = 26880;
__device__ __forceinline__ void gdn_chunk_out(const Params& p, int layer, LAS unsigned char* lds, int tid, int wave, int lane) {
    const bf16* H = (const bf16*)(p.ws + WS_H); bf16* YS = (bf16*)(p.ws + WS_YS);
    const int q = lane >> 4, li = lane & 15;
    const f32x4 nw = *(const f32x4*)(p.in[I_GNW] + layer * 128 + 16 * wave + 4 * q);
    LAS float* part = (LAS float*)(lds + CO_PART);
    for (int unit = blockIdx.x; unit < 2048; unit += gridDim.x) {
        const int n = unit & 63, bh = unit >> 6, hh = bh & 3, b = bh >> 2; const int m0 = b * T + n * 64;
        const unsigned char* rec = p.ws + WS_REC + (size_t)(bh * 64 + n) * REC_BYTES;
        const u32x4* S0F = (const u32x4*)(p.ws + WS_OBUF) + (size_t)((bh * 64 + n) * 8 + wave) * 4 * 64;
        const u32x4 rq0 = *(const u32x4*)(rec + REC_Q + (size_t)tid * 16), rq1 = *(const u32x4*)(rec + REC_Q + (size_t)(tid + 512) * 16), ra = *(const u32x4*)(rec + REC_ATT + (size_t)tid * 16);
        u32x4 rg = (u32x4){0u, 0u, 0u, 0u}; if (tid < 16) rg = *(const u32x4*)(rec + REC_G + tid * 16);
        bf16x8 sf[4], vf[2];
#pragma unroll
        for (int ks = 0; ks < 4; ++ks) sf[ks] = __builtin_bit_cast(bf16x8, S0F[ks * 64 + lane]);
        vf[0] = __builtin_bit_cast(bf16x8, *(const u32x4*)(rec + REC_U + (size_t)(wave * 64 + lane) * 32)); vf[1] = __builtin_bit_cast(bf16x8, *(const u32x4*)(rec + REC_U + (size_t)(wave * 64 + lane) * 32 + 16));
        u32x2 zr[4];
#pragma unroll
        for (int mt = 0; mt < 4; ++mt) zr[mt] = *(const u32x2*)(H + (size_t)(m0 + 16 * mt + li) * DH + HZ + hh * 128 + 16 * wave + 4 * q);
        __syncthreads();
        *(LAS u32x4*)(lds + CO_Q + (tid >> 4) * 272 + (tid & 15) * 16) = rq0; *(LAS u32x4*)(lds + CO_Q + ((tid + 512) >> 4) * 272 + (tid & 15) * 16) = rq1;
        *(LAS u32x4*)(lds + CO_ATT + (tid >> 3) * 144 + (tid & 7) * 16) = ra;
        if (tid < 16) *(LAS u32x4*)(lds + CO_G + tid * 16) = rg;
        __syncthreads();
        f32x4 o[4]; float ss[4];
#pragma unroll
        for (int mt = 0; mt < 4; ++mt) { f32x4 a2 = (f32x4){0.f, 0.f, 0.f, 0.f}, a3 = (f32x4){0.f, 0.f, 0.f, 0.f};
#pragma unroll
            for (int ks = 0; ks < 4; ++ks) a2 = mfma16(sf[ks], ld_frag8x2(lds + CO_Q + (16 * mt + li) * 272 + (32 * ks + 4 * q) * 2), a2);
#pragma unroll
            for (int ks = 0; ks < 2; ++ks) a3 = mfma16(vf[ks], ld_frag8x2(lds + CO_ATT + (16 * mt + li) * 144 + (32 * ks + 4 * q) * 2), a3);
            const float gam = fexp(*(const LAS float*)(lds + CO_G + (16 * mt + li) * 4));
            o[mt] = a2 * gam + a3;
            float s = (o[mt][0] * o[mt][0] + o[mt][1] * o[mt][1]) + (o[mt][2] * o[mt][2] + o[mt][3] * o[mt][3]);
            s += __shfl_xor(s, 16); s += __shfl_xor(s, 32);
            if (q == 0) part[(16 * mt + li) * 8 + wave] = s; }
        __syncthreads();
#pragma unroll
        for (int mt = 0; mt < 4; ++mt) { const f32x4 pa = *(const LAS f32x4*)(part + (16 * mt + li) * 8), pb = *(const LAS f32x4*)(part + (16 * mt + li) * 8 + 4);
            ss[mt] = ((pa[0] + pa[1]) + (pa[2] + pa[3])) + ((pb[0] + pb[1]) + (pb[2] + pb[3]));
            const float rs = __builtin_amdgcn_rsqf(ss[mt] * (1.0f / 128.0f) + EPS);
            u32x2 w; w.x = pk2(o[mt][0] * rs * nw[0] * siluf_(bf_lo(zr[mt].x)), o[mt][1] * rs * nw[1] * siluf_(bf_hi(zr[mt].x)));
            w.y = pk2(o[mt][2] * rs * nw[2] * siluf_(bf_lo(zr[mt].y)), o[mt][3] * rs * nw[3] * siluf_(bf_hi(zr[mt].y)));
            *(u32x2*)(YS + (size_t)(m0 + 16 * mt + li) * 2048 + hh * 128 + 16 * wave + 4 * q) = w; }
    }
    __syncthreads();
}
__device__ __forceinline__ void sum_gated(const Params& p, int gtid, int NGT) {
    const bf16* H = (const bf16*)(p.ws + WS_H); bf16* MG = (bf16*)(p.ws + WS_MERGED);
    for (int it = gtid; it < M * 128; it += NGT) { const int m = it >> 7, c8 = (it & 127) * 8; const bf16* r = H + (size_t)m * DH + HGATE + c8;
        float a[8], b[8];
        unpack8(*(const u32x4*)r, a);
#pragma unroll
        for (int br = 1; br < 4; ++br) { unpack8(*(const u32x4*)(r + br * 1024), b);
#pragma unroll
            for (int i = 0; i < 8; ++i) a[i] += b[i]; }
        *(u32x4*)(MG + (size_t)m * D + c8) = pack8(a); }
}

__device__ __forceinline__ void moe_route(const Params& p, int layer, LAS unsigned char* lds, int tid, int wave, int lane) {
    LAS float* xs = (LAS float*)lds;
    LAS int* hist = (LAS int*)(lds + LDSCTL_OFF + LC_TAB);
    bf16* XN = (bf16*)(p.ws + WS_XN);
    int* route_e = (int*)(p.ws + WS_ROUTE); float* route_w = (float*)(p.ws + WS_ROUTE + (size_t)M * 2 * 4);
    int* cnt = (int*)(p.ws + WS_MOETAB + (size_t)NROWS_MAX * 8);
    const float* rg = p.in[I_RGRP] + (size_t)layer * D * 8; const float* re = p.in[I_REXP] + (size_t)layer * D * 64;
    f32x4 nw[4];
#pragma unroll
    for (int j = 0; j < 4; ++j) nw[j] = *(const f32x4*)(p.in[I_MOENW] + layer * D + 4 * lane + 256 * j);
    for (int vb = blockIdx.x; vb < M / 128; vb += gridDim.x) {
        if (tid < 64) hist[tid] = 0;
        for (int tile = 0; tile < 4; ++tile) {
            const int m0 = vb * 128 + tile * 32;
            __syncthreads();
            for (int r = wave * 4; r < wave * 4 + 4; ++r) { const int m = m0 + r; const float* xr = p.out + (size_t)m * D;
                f32x4 v[4]; float ss = 0.f;
#pragma unroll
                for (int j = 0; j < 4; ++j) { v[j] = *(const f32x4*)(xr + 4 * lane + 256 * j); ss += (v[j][0] * v[j][0] + v[j][1] * v[j][1]) + (v[j][2] * v[j][2] + v[j][3] * v[j][3]); }
                const float rs = 1.0f / sqrtf(wave_sum(ss) * (1.0f / D) + EPS);
#pragma unroll
                for (int j = 0; j < 4; ++j) { v[j] = v[j] * rs * nw[j]; *(LAS f32x4*)(xs + r * 1024 + 4 * lane + 256 * j) = v[j];
                    u32x2 o; o.x = pk2(v[j][0], v[j][1]); o.y = pk2(v[j][2], v[j][3]); *(u32x2*)(XN + (size_t)m * D + 4 * lane + 256 * j) = o; } }
            __syncthreads();
            float ae[32], ag[32];
#pragma unroll
            for (int r = 0; r < 32; ++r) { ae[r] = 0.f; ag[r] = 0.f; }
            for (int k = wave * 128; k < wave * 128 + 128; k += 4) {
                float we[4], wg[4];
#pragma unroll
                for (int q = 0; q < 4; ++q) { we[q] = re[(size_t)(k + q) * 64 + lane]; wg[q] = rg[(size_t)(k + q) * 8 + (lane & 7)]; }
#pragma unroll
                for (int r = 0; r < 32; ++r) { const f32x4 x = *(const LAS f32x4*)(xs + r * 1024 + k);
                    ae[r] += x[0] * we[0] + x[1] * we[1] + x[2] * we[2] + x[3] * we[3];
                    ag[r] += x[0] * wg[0] + x[1] * wg[1] + x[2] * wg[2] + x[3] * wg[3]; }
            }
            __syncthreads();
            LAS float* part = xs;
#pragma unroll
            for (int r = 0; r < 32; ++r) { part[(wave * 32 + r) * 72 + lane] = ae[r]; if (lane < 8) part[(wave * 32 + r) * 72 + 64 + lane] = ag[r]; }
            __syncthreads();
            for (int r = wave * 4; r < wave * 4 + 4; ++r) { const int m = m0 + r;
                float le = 0.f, lg = 0.f;
#pragma unroll
                for (int w = 0; w < 8; ++w) { le += part[(w * 32 + r) * 72 + lane]; lg += part[(w * 32 + r) * 72 + 64 + (lane & 7)]; }
                float gv[8];
#pragma unroll
                for (int i = 0; i < 8; ++i) gv[i] = __shfl(lg, i);
                int grp = 0; float gmax = gv[0];
#pragma unroll
                for (int i = 1; i < 8; ++i) if (gv[i] > gmax) { gmax = gv[i]; grp = i; }
                float gs = 0.f;
#pragma unroll
                for (int i = 0; i < 8; ++i) gs += __expf(gv[i] - gmax);
                const float psel = 1.0f / gs;
                float ev[8];
#pragma unroll
                for (int i = 0; i < 8; ++i) ev[i] = __shfl(le, grp * 8 + i);
                int i1 = 0; float e1 = ev[0];
#pragma unroll
                for (int i = 1; i < 8; ++i) if (ev[i] > e1) { e1 = ev[i]; i1 = i; }
                int i2 = -1; float e2 = -3.0e38f;
#pragma unroll
                for (int i = 0; i < 8; ++i) if (i != i1 && ev[i] > e2) { e2 = ev[i]; i2 = i; }
                const float x2 = __expf(e2 - e1), w1 = psel / (1.0f + x2), w2 = psel * x2 / (1.0f + x2);
                if (lane == 0) { route_e[(size_t)m * 2] = grp * 8 + i1; route_e[(size_t)m * 2 + 1] = grp * 8 + i2; route_w[(size_t)m * 2] = w1; route_w[(size_t)m * 2 + 1] = w2;
                    atomicAdd((int*)(hist + grp * 8 + i1), 1); atomicAdd((int*)(hist + grp * 8 + i2), 1); }
            }
        }
        __syncthreads();
        if (tid < 64) cnt[vb * 64 + tid] = hist[tid];
        __syncthreads();
    }
}
__device__ __forceinline__ void moe_dispatch(const Params& p, LAS unsigned char* lds, int tid, int wave, int lane) {
    LAS int* tab = (LAS int*)(lds + LDSCTL_OFF + LC_TAB);
    const bf16* XN = (const bf16*)(p.ws + WS_XN); bf16* XS = (bf16*)(p.ws + WS_XS);
    const int* route_e = (const int*)(p.ws + WS_ROUTE); const float* route_w = (const float*)(p.ws + WS_ROUTE + (size_t)M * 2 * 4);
    int* row_code = (int*)(p.ws + WS_MOETAB); float* row_w = (float*)(p.ws + WS_MOETAB + (size_t)NROWS_MAX * 4);
    const int* cnt = (const int*)(p.ws + WS_MOETAB + (size_t)NROWS_MAX * 8); int* blk_e = (int*)(p.ws + WS_MOETAB + (size_t)NROWS_MAX * 8 + 256 * 64 * 4);
    for (int vb = blockIdx.x; vb < M / 128; vb += gridDim.x) {
        __syncthreads();
        if (tid < 64) { int run = 0, base = 0; for (int v = 0; v < M / 128; ++v) { if (v == vb) base = run; run += cnt[v * 64 + tid]; } tab[64 + tid] = run; tab[128 + tid] = base; }
        __syncthreads();
        if (tid == 0) { int s = 0; for (int e = 0; e < 64; ++e) { tab[e] = s; s += (tab[64 + e] + 255) / 256 * 256; } tab[704] = s; }
        if (tid < 256) tab[192 + tid] = route_e[(size_t)vb * 256 + tid];
        __syncthreads();
        if (tid < 256) { const int e = tab[192 + tid]; int rank = 0; for (int a = 0; a < tid; ++a) rank += (tab[192 + a] == e) ? 1 : 0;
            const int pos = tab[e] + tab[128 + e] + rank; tab[448 + tid] = pos;
            row_code[pos] = ((vb * 128 + (tid >> 1)) << 1) | (tid & 1); row_w[pos] = route_w[(size_t)vb * 256 + tid]; }
        if (vb < 64) { const int ps = tab[vb], tot = tab[64 + vb], pe = ps + (tot + 255) / 256 * 256;
            for (int r = ps + tot + tid; r < pe; r += 512) row_code[r] = -1;
            for (int b = ps / 256 + tid; b < pe / 256; b += 512) blk_e[b] = vb;
            if (tid == 0) { blk_e[NROWBLK_MAX + 64 + vb] = ps / 256; blk_e[NROWBLK_MAX + 128 + vb] = (pe - ps) / 256; }
            if (vb == 63 && tid == 0) blk_e[NROWBLK_MAX] = tab[704] / 256; }
        __syncthreads();
        for (int a = wave; a < 256; a += 8) { const int pos = tab[448 + a]; const int tok = vb * 128 + (a >> 1);
            const u32x4* src = (const u32x4*)(XN + (size_t)tok * D); u32x4* dst = (u32x4*)(XS + (size_t)pos * D);
            dst[lane] = src[lane]; dst[lane + 64] = src[lane + 64]; }
    }
    __syncthreads();
}

__global__ void __launch_bounds__(512, 2) fwd(Params p) {
    extern __shared__ __attribute__((aligned(16))) unsigned char lds_raw[];
    LAS unsigned char* lds = (LAS unsigned char*)lds_raw;
    const int tid0 = threadIdx.x;
    const int G = gridDim.x, NGW = G * 8, NGT = G * 512;
#define FRESH() int tid = tid0; asm volatile("" : "+v"(tid)); const int lane = tid & 63, wave = __builtin_amdgcn_readfirstlane(tid >> 6); const int gw = blockIdx.x * 8 + wave, gtid = blockIdx.x * 512 + tid; (void)lane; (void)gw; (void)gtid
    for (int u = tid0; u < (LDS_BYTES - LDSCTL_OFF) / 4; u += 512) ((LAS unsigned*)(lds + LDSCTL_OFF))[u] = 0u;
    __syncthreads();
    const int lo = p.ph_lo, hi = p.ph_hi;
    XcdBarrier bar; bar.bar = (unsigned*)(p.ws + WS_CTL) + CW_BAR; bar.x = 0; bar.st = (volatile LAS unsigned*)(lds + LDSCTL_OFF + LC_BAR);
    if (hi - lo > 1) bar = xcd_barrier_post((unsigned*)(p.ws + WS_CTL) + CW_BAR, (volatile LAS unsigned*)(lds + LDSCTL_OFF + LC_BAR));
#ifndef PHASE_MASK
#define PHASE_MASK 0x1fff
#endif
#define IN(k) (((PHASE_MASK >> ((k) == PH_FINAL ? 12 : ((k) % PH_PER_LAYER))) & 1) && lo <= (k) && (k) < hi)
#define REPS(k) ((((REPEAT_MASK) >> (k)) & 1) && layer == 0 ? 2 : 1)
#define SEAM(k) do { if (IN(k) && IN((k) + 1)) xcd_barrier(bar); } while (0)

    for (int layer = 0; layer < NLAYER; ++layer) {
        const int g0 = layer * PH_PER_LAYER;
        bf16* Hb = (bf16*)(p.ws + WS_H);
        for (int rep_ = 0; rep_ < REPS(0); ++rep_) if (IN(g0 + 0)) { if (rep_) __syncthreads(); FRESH();
            if (layer == 0) { prep_static_weights(p, gw, NGW, lane); __syncthreads(); norm_phase<0>(p, layer, lds, gw, NGW, tid, lane); }
            else norm_phase<1>(p, layer, lds, gw, NGW, tid, lane);
        }
        SEAM(g0 + 0);
        for (int rep_ = 0; rep_ < REPS(1); ++rep_) if (IN(g0 + 1)) { if (rep_) __syncthreads(); FRESH();
            SchedH S; S.to.init(M / 256, DH / 256, G, (int)blockIdx.x); S.A = (const char*)(p.ws + WS_XN); S.B = (const char*)(p.ws + WS_WIN + layer * WIN_L);
            EpiStoreBf16 E{Hb, DH};
            pg8::gemm_phase(lds, tid, D, D, D, S, E);
        }
        SEAM(g0 + 1);
        for (int rep_ = 0; rep_ < REPS(2); ++rep_) if (IN(g0 + 2)) { if (rep_) __syncthreads(); FRESH(); gdn_chunk_prep(p, layer, lds, tid, wave, lane); }
        SEAM(g0 + 2);
        for (int rep_ = 0; rep_ < REPS(3); ++rep_) if (IN(g0 + 3)) { if (rep_) __syncthreads(); FRESH();
            if ((int)blockIdx.x < 64) gdn_chunk_scan(p, lds, tid, wave, lane, (int)blockIdx.x >> 1, (int)blockIdx.x & 1);
            {
                unsigned* qc = (unsigned*)(p.ws + WS_CTL) + CW_QUEUE + layer * 256;
                gmlp(p, layer, lds, tid, wave, lane, qc);
                conformer(p, layer, lds, tid, wave, lane, qc + 64);
                for (;;) { const int unit = queue_pop(qc + 128, lds, tid); if (unit >= M / 128) break; shortconv_unit(p, layer, tid, unit); }
            }
        }
        SEAM(g0 + 3);
        for (int rep_ = 0; rep_ < REPS(4); ++rep_) if (IN(g0 + 4)) { if (rep_) __syncthreads(); FRESH(); gdn_chunk_out(p, layer, lds, tid, wave, lane); }
        SEAM(g0 + 4);
        if (IN(g0 + 5)) { FRESH();
            SchedBranch S; S.to.init(M / 256, 4, G, (int)blockIdx.x); S.YS = (const char*)(p.ws + WS_YS); S.WBR = (const char*)(p.ws + WS_WBR + layer * WBR_L);
            EpiGate E{Hb + HGATE, (bf16*)(p.ws + WS_MERGED)};
            pg8::gemm_phase(lds, tid, 512, 2048, 512, S, E);
        }
        for (int rep_ = 0; rep_ < REPS(6); ++rep_) if (IN(g0 + 6)) { if (rep_) __syncthreads(); FRESH();   }
        SEAM(g0 + 6);
        for (int rep_ = 0; rep_ < REPS(7); ++rep_) if (IN(g0 + 7)) { if (rep_) __syncthreads(); FRESH();
            const int NGB = G / 2;
            if ((int)blockIdx.x < NGB) {
                SchedOut S; S.to.init(M / 256, 4, NGB, (int)blockIdx.x); S.A = (const char*)(p.ws + WS_MERGED); S.B = (const char*)(p.ws + WS_WOUT + layer * WOUT_L);
                EpiResF32 E{layer == 0 ? p.in[I_X] : p.out, p.out};
                pg8::gemm_phase(lds, tid, D, D, D, S, E);
            } else prep_moe_weights(p, layer, ((int)blockIdx.x - NGB) * 8 + wave, (G - NGB) * 8, lane);
        }
        SEAM(g0 + 7);
        for (int rep_ = 0; rep_ < REPS(8); ++rep_) if (IN(g0 + 8)) { if (rep_) __syncthreads(); FRESH(); moe_route(p, layer, lds, tid, wave, lane); }
        SEAM(g0 + 8);
        for (int rep_ = 0; rep_ < REPS(9); ++rep_) if (IN(g0 + 9)) { if (rep_) __syncthreads(); FRESH(); moe_dispatch(p, lds, tid, wave, lane); }
        SEAM(g0 + 9);
        if (IN(g0 + 10) || IN(g0 + 11)) { FRESH();
            LAS int* tb = (LAS int*)(lds + LDSCTL_OFF + LC_TAB);
            const int* est = (const int*)(p.ws + WS_MOETAB + (size_t)NROWS_MAX * 8 + 256 * 64 * 4) + NROWBLK_MAX + 64;
            const int NX = (G % 8 == 0) ? 8 : 1, x = (int)blockIdx.x % NX, nk = 64 / NX;
            __syncthreads();
            if (tid < nk) { tb[160 + tid] = est[x + NX * tid]; tb[240 + tid] = est[64 + x + NX * tid]; }
            __syncthreads();
            if (tid == 0) { int s = 0; for (int k = 0; k < nk; ++k) { tb[k] = s; tb[80 + k] = tb[160 + k]; s += tb[240 + k] * 4; } tb[nk] = s; }
            __syncthreads();
        }
        for (int rep_ = 0; rep_ < REPS(10); ++rep_) if (IN(g0 + 10)) { if (rep_) __syncthreads(); FRESH();
            LAS int* tb = (LAS int*)(lds + LDSCTL_OFF + LC_TAB); const int NX = (G % 8 == 0) ? 8 : 1, nk = 64 / NX;
            SchedMoe S; S.nux = tb[nk]; S.nrank = G / NX; S.rank = (int)blockIdx.x / NX; S.nk = nk; S.x = (int)blockIdx.x % NX; S.NX = NX; S.cum = tb; S.rb0 = tb + 80;
            S.A = (const char*)(p.ws + WS_XS); S.a_blk = (size_t)256 * D * 2; S.W = (const char*)(p.ws + WS_MOEW); S.w_e = WGU_E; S.w_pn = (size_t)256 * D * 2; S.cmul = 128;
            EpiSwiglu E{(bf16*)(p.ws + WS_HB)};
            pg8::gemm_phase(lds, tid, D, D, D, S, E);
        }
        SEAM(g0 + 10);
        for (int rep_ = 0; rep_ < REPS(11); ++rep_) if (IN(g0 + 11)) { if (rep_) __syncthreads(); FRESH();
            LAS int* tb = (LAS int*)(lds + LDSCTL_OFF + LC_TAB); const int NX = (G % 8 == 0) ? 8 : 1, nk = 64 / NX;
            SchedMoe S; S.nux = tb[nk]; S.nrank = G / NX; S.rank = (int)blockIdx.x / NX; S.nk = nk; S.x = (int)blockIdx.x % NX; S.NX = NX; S.cum = tb; S.rb0 = tb + 80;
            S.A = (const char*)(p.ws + WS_HB); S.a_blk = (size_t)256 * DE * 2; S.W = (const char*)(p.ws + WS_WD); S.w_e = WD_E; S.w_pn = (size_t)256 * DE * 2; S.cmul = 256;
            EpiScatter E{(bf16*)(p.ws + WS_Y), (const int*)(p.ws + WS_MOETAB), (const float*)(p.ws + WS_MOETAB + (size_t)NROWS_MAX * 4)};
            pg8::gemm_phase(lds, tid, DE, DE, DE, S, E);
        }
        SEAM(g0 + 11);
    }
    if (IN(PH_FINAL)) { FRESH(); norm_phase<2>(p, 0, lds, gw, NGW, tid, lane); }
#undef IN
#undef SEAM
}

extern "C" void kernel_launch(void* const* d_in, const int* in_sizes, int n_in, void* d_out, int out_size, void* d_ws, size_t ws_size, hipStream_t stream) {
    static int grid = 0;
    if (grid == 0) {
        if (n_in != 25 || out_size != M * D || ws_size < WS_END) { fprintf(stderr, "kernel_launch: unexpected shapes / workspace (n_in %d out %d ws %zu, need %zu)\n", n_in, out_size, ws_size, (size_t)WS_END); grid = -1; return; }
        int dev = 0, cus = 0, per_cu = 0;
        if (hipGetDevice(&dev) != hipSuccess || hipDeviceGetAttribute(&cus, hipDeviceAttributeMultiprocessorCount, dev) != hipSuccess) { grid = -1; return; }
        if (hipFuncSetAttribute((const void*)fwd, hipFuncAttributeMaxDynamicSharedMemorySize, LDS_BYTES) != hipSuccess) { fprintf(stderr, "kernel_launch: hipFuncSetAttribute failed\n"); grid = -1; return; }
        if (hipOccupancyMaxActiveBlocksPerMultiprocessor(&per_cu, (const void*)fwd, 512, LDS_BYTES) != hipSuccess || per_cu < 1) { fprintf(stderr, "kernel_launch: occupancy query says %d\n", per_cu); }
        (void)hipGetLastError();
        grid = cus;
    }
    if (grid < 0) return;
    hipMemsetAsync((char*)d_ws + WS_CTL, 0, CTL_BYTES, stream);
    Params p{};
    for (int i = 0; i < 25; ++i) p.in[i] = (const float*)d_in[i];
    p.out = (float*)d_out; p.ws = (unsigned char*)d_ws;
#if N_LAUNCH_MODE == 1
    p.ph_lo = 0; p.ph_hi = PH_TOTAL;
    hipLaunchKernelGGL(fwd, dim3(grid), dim3(512), LDS_BYTES, stream, p);
#else
    for (int k = 0; k < PH_TOTAL; ++k) { p.ph_lo = k; p.ph_hi = k + 1; hipLaunchKernelGGL(fwd, dim3(grid), dim3(512), LDS_BYTES, stream, p); }
#endif
}
```

```cpp
#include <hip/hip_runtime.h>
#include <cstdio>
#include <cstdint>

#ifndef REPEAT_MASK
#define REPEAT_MASK 0
#endif
#ifndef N_LAUNCH_MODE
#define N_LAUNCH_MODE 1
#endif

#define LAS __attribute__((address_space(3)))
typedef unsigned short bf16;
typedef short bf16x8 __attribute__((ext_vector_type(8)));
typedef float f32x4 __attribute__((ext_vector_type(4)));
typedef float f32x2 __attribute__((ext_vector_type(2)));
typedef unsigned u32x4 __attribute__((ext_vector_type(4)));
typedef unsigned u32x2 __attribute__((ext_vector_type(2)));

constexpr int NB = 8, T = 4096, D = 1024, M = NB * T, NLAYER = 2;
constexpr int DIN = 9736, DH = 9728;
constexpr int HQ = 0, HK = 512, HV = 1024, HZ = 1536, HCONF = 2048, HGMLP = 3072, HSC = 4096, HGATE = 5632;
constexpr int NE = 64, DE = 512;
constexpr float EPS = 1e-6f;
constexpr int NROWBLK_MAX = 320, NROWS_MAX = NROWBLK_MAX * 256;

constexpr size_t MiB = 1u << 20;
constexpr size_t WS_CTL = 0, CTL_BYTES = 1 * MiB;
constexpr size_t WS_WIN = 2 * MiB;
constexpr size_t WIN_L = (size_t)DH * D * 2;
constexpr size_t WS_WBR = 40 * MiB;
constexpr size_t WBR_L = (size_t)4 * D * 512 * 2;
constexpr size_t WS_WOUT = 48 * MiB;
constexpr size_t WOUT_L = (size_t)D * D * 2;
constexpr size_t WS_XN = 52 * MiB;
constexpr size_t WS_SMALL = 116 * MiB;
constexpr size_t WS_ROUTE = 117 * MiB;
constexpr size_t WS_MOETAB = 118 * MiB;
constexpr size_t WS_YS = 120 * MiB;
constexpr size_t WS_REC = 248 * MiB;
constexpr size_t WS_MERGED = WS_REC;
constexpr size_t WS_OBUF = WS_XN;
constexpr int REC_W = 0, REC_Q = 16384, REC_ATT = 32768, REC_KT = 40960, REC_U = 57344, REC_G = 73728, REC_BYTES = 73984;
static_assert(WS_REC + (size_t)2048 * REC_BYTES <= 410 * MiB, "chunk records");
constexpr size_t WS_H = 410 * MiB;
constexpr size_t WS_MOEW = 410 * MiB;
constexpr size_t WGU_E = (size_t)1024 * 1024 * 2, WD_E = (size_t)1024 * 512 * 2;
constexpr size_t WS_WD = WS_MOEW + 64 * WGU_E;
constexpr size_t WS_XS = 602 * MiB;
constexpr size_t WS_HB = 762 * MiB;
constexpr size_t WS_Y = 842 * MiB;
constexpr size_t WS_END = 1018 * MiB;
static_assert(WS_H + (size_t)M * DH * 2 <= WS_END && WS_Y + (size_t)2 * M * D * 2 <= WS_END, "ws map");

constexpr int CW_BAR = 4096;
constexpr int CW_QUEUE = 16384;
constexpr int STAGE_LDS = 131072, LDSCTL_OFF = 131072, LDS_BYTES = 147456;
constexpr int LC_BAR = 0;
constexpr int LC_MISC = 64;
constexpr int LC_TAB = 1024;

__device__ __forceinline__ float bf_lo(unsigned w) { return __uint_as_float(w << 16); }
__device__ __forceinline__ float bf_hi(unsigned w) { return __uint_as_float(w & 0xffff0000u); }
__device__ __forceinline__ float bf2f(bf16 b) { return __uint_as_float(((unsigned)b) << 16); }
__device__ __forceinline__ unsigned f2bf(float f) { unsigned u = __float_as_uint(f); return (u + 0x7fffu + ((u >> 16) & 1u)) >> 16; }
__device__ __forceinline__ unsigned pk2(float lo, float hi) { return f2bf(lo) | (f2bf(hi) << 16); }
__device__ __forceinline__ void unpack8(const u32x4 v, float (&f)[8]) {
    f[0] = bf_lo(v.x); f[1] = bf_hi(v.x); f[2] = bf_lo(v.y); f[3] = bf_hi(v.y); f[4] = bf_lo(v.z); f[5] = bf_hi(v.z); f[6] = bf_lo(v.w); f[7] = bf_hi(v.w);
}
__device__ __forceinline__ u32x4 pack8(const float (&f)[8]) { u32x4 o; o.x = pk2(f[0], f[1]); o.y = pk2(f[2], f[3]); o.z = pk2(f[4], f[5]); o.w = pk2(f[6], f[7]); return o; }
__device__ __forceinline__ float wave_sum(float v) {
#pragma unroll
    for (int o = 1; o < 64; o <<= 1) v += __shfl_xor(v, o);
    return v;
}
__device__ __forceinline__ float fexp(float x) { return __builtin_amdgcn_exp2f(x * 1.4426950408889634f); }
__device__ __forceinline__ float frcp(float x) { return __builtin_amdgcn_rcpf(x); }
__device__ __forceinline__ float sigmoidf_(float x) { return frcp(1.0f + fexp(-x)); }
__device__ __forceinline__ float siluf_(float x) { return x * frcp(1.0f + fexp(-x)); }
__device__ __forceinline__ float gelu_tanh(float x) { const float u = 0.7978845608028654f * (x + 0.044715f * x * x * x); return x * frcp(1.0f + fexp(-2.0f * u)); }
__device__ __forceinline__ float softplusf_(float x) { return fmaxf(x, 0.f) + log1pf(__expf(-fabsf(x))); }

#define XB_TMO      128
#define XB_XCNT(j)  (256  + 64 * (j))
#define XB_XSUB(j)  (1280 + 64 * (j))
#define XB_XGEN(j)  (2304 + 64 * (j))
#define XB_TOP      3328
#define XB_TOPGEN   3392
#define XCD_BAR_WORDS 3456
#define XB_SPIN_CAP (1u << 18)
__device__ __forceinline__ unsigned xb_ld(unsigned* p)              { return __hip_atomic_load(p, __ATOMIC_RELAXED, __HIP_MEMORY_SCOPE_AGENT); }
__device__ __forceinline__ unsigned xb_add(unsigned* p, unsigned v) { return __hip_atomic_fetch_add(p, v, __ATOMIC_RELAXED, __HIP_MEMORY_SCOPE_AGENT); }
__device__ __forceinline__ unsigned xb_xcc_id() { return (unsigned)__builtin_amdgcn_s_getreg((3 << 11) | 20) & 0xFu; }
#define XB_SPIN(cond, bar) do { unsigned _sp = 0; while (cond) { __builtin_amdgcn_s_sleep(1); \
    if ((++_sp & 255u) == 0u) { if (xb_ld(&(bar)[XB_TMO])) break; if (_sp > XB_SPIN_CAP) { atomicAdd(&(bar)[XB_TMO], 1u); break; } } } } while (0)
struct XcdBarrier { unsigned* bar; unsigned x; volatile LAS unsigned* st; };
__device__ __forceinline__ XcdBarrier xcd_barrier_post(unsigned* bar, volatile LAS unsigned* st) {
    XcdBarrier b; b.bar = bar; b.x = xb_xcc_id(); b.st = st;
    if (threadIdx.x == 0) (void)xb_add(&bar[XB_XCNT(b.x)], 1u);
    return b;
}
__device__ __forceinline__ void xcd_barrier_complete(unsigned* bar, unsigned x, unsigned& nloc, unsigned& nx) {
    const unsigned G = gridDim.x * gridDim.y * gridDim.z;
    unsigned sum, cnt, mine, sp = 0u;
    for (;;) {
        sum = 0u; cnt = 0u; mine = 0u;
#pragma unroll
        for (unsigned j = 0; j < 16; ++j) { const unsigned c = xb_ld(&bar[XB_XCNT(j)]); sum += c; cnt += (c > 0u) ? 1u : 0u; mine = (j == x) ? c : mine; }
        if (sum == G) break;
        __builtin_amdgcn_s_sleep(1);
        if ((++sp & 255u) == 0u) { if (xb_ld(&bar[XB_TMO])) break; if (sp > XB_SPIN_CAP) { atomicAdd(&bar[XB_TMO], 1u); break; } }
    }
    nloc = mine > 0u ? mine : 1u; nx = cnt > 0u ? cnt : 1u;
}
__device__ __forceinline__ void xcd_barrier(const XcdBarrier& b) {
    asm volatile("s_waitcnt vmcnt(0)" ::: "memory");
    __syncthreads();
    if (threadIdx.x == 0) {
        unsigned* bar = b.bar;
        __builtin_amdgcn_s_waitcnt(0);
        unsigned nloc = b.st[0], nx = b.st[1];
        if (nloc == 0u) { xcd_barrier_complete(bar, b.x, nloc, nx); b.st[0] = nloc; b.st[1] = nx; }
        const unsigned old = xb_add(&bar[XB_XSUB(b.x)], 1u);
        const unsigned gen = old / nloc;
        if (old + 1u == (gen + 1u) * nloc) {
            __builtin_amdgcn_fence(__ATOMIC_RELEASE, "agent");
            asm volatile("s_waitcnt vmcnt(0)" ::: "memory");
            const unsigned og = xb_add(&bar[XB_TOP], 1u);
            const unsigned tg = og / nx;
            if (og + 1u == (tg + 1u) * nx) xb_add(&bar[XB_TOPGEN], 1u);
            else XB_SPIN(xb_ld(&bar[XB_TOPGEN]) == tg, bar);
            __builtin_amdgcn_fence(__ATOMIC_ACQUIRE, "agent");
            xb_add(&bar[XB_XGEN(b.x)], 1u);
            asm volatile("s_waitcnt vmcnt(0)" ::: "memory");
        } else {
            XB_SPIN(xb_ld(&bar[XB_XGEN(b.x)]) == gen, bar);
            __builtin_amdgcn_fence(__ATOMIC_ACQUIRE, "agent");
            asm volatile("s_waitcnt vmcnt(0)" ::: "memory");
        }
    }
    __syncthreads();
}

namespace pg8 {
constexpr int BM = 256, BK = 64, HALF = 128, HTB = HALF * BK * 2, STAGE_BYTES = 8 * HTB, NXCD = 8, WGM = 8;
__host__ __device__ __forceinline__ int lds_byte(int r, int c) { const int st = (r >> 4) * 2 + (c >> 5), rr = r & 15, cc = c & 31, ob = rr * 64 + cc * 2; return st * 1024 + (ob ^ (((ob >> 9) & 1) << 5)); }
__host__ __device__ __forceinline__ void stage_rc(int b, int& R, int& C) { const int st = b / 1024, sb = b % 1024, swz = sb ^ (((sb >> 9) & 1) << 5); R = (st >> 1) * 16 + swz / 64; C = (st & 1) * 32 + (swz % 64) / 2; }
__host__ __device__ __forceinline__ int perm32(int rho) { const int n = rho >> 4, i = rho & 15; return 8 * (i >> 2) + 4 * n + (i & 3); }

struct Unit { const char* A; const char* B; int r0, c0; };

struct TileOrder {
    int nM, nN, nwg, G, c;
    __device__ void init(int nM_, int nN_, int G_, int c_) { nM = nM_; nN = nN_; nwg = nM * nN; G = G_; c = c_; }
    __device__ bool next(int i, int& pm, int& pn) const {
        const long L = (long)i * G + c; if (L >= nwg) return false;
        int wgid = (int)L; { const int q = nwg / NXCD, r = nwg % NXCD, xcd = wgid % NXCD, off = wgid / NXCD; wgid = (xcd < r ? xcd * (q + 1) : r * (q + 1) + (xcd - r) * q) + off; }
        const int nig = WGM * nN, gid = wgid / nig, fm = gid * WGM, gsz = (nM - fm) < WGM ? (nM - fm) : WGM;
        pm = fm + ((wgid % nig) % gsz); pn = (wgid % nig) / gsz; return true;
    }
};
__device__ __forceinline__ unsigned cvt_pk_bf16(float lo, float hi) { unsigned r; asm volatile("v_cvt_pk_bf16_f32 %0, %1, %2" : "=v"(r) : "v"(lo), "v"(hi)); return r; }

template <class Epi, class Sched>
__device__ __forceinline__ void gemm_phase(LAS unsigned char* lds, const int tid, const int K, const int lda, const int ldb, const Sched& S, const Epi& E) {
    const int wid = __builtin_amdgcn_readfirstlane(tid >> 6), lane = tid & 63, wr = wid >> 2, wc = wid & 3, fr = lane & 15, fq = lane >> 4;
    const int nt = K / BK;
    unsigned voffA[2], voffB[2];
#pragma unroll
    for (int i = 0; i < 2; ++i) { int R, C; stage_rc(tid * 16 + i * 8192, R, C); const int Rb = Epi::PERM ? ((R & ~31) + perm32(R & 31)) : R;
        voffA[i] = (unsigned)(R * lda + C) * 2u; voffB[i] = (unsigned)(Rb * ldb + C) * 2u; }
    const size_t kstep = (size_t)(BK * 2);
    const size_t hstepA = (size_t)HALF * lda * 2, hstepB = (size_t)HALF * ldb * 2;
    const unsigned ldsw = (unsigned)wid * 1024u;
    const int aoff = lds_byte(wr * 64 + fr, fq * 8), boff = lds_byte(wc * 32 + fr, fq * 8);
#define PG8_SA(b, h) (((b) * 2 + (h)) * HTB)
#define PG8_SB(b, h) ((4 + (b) * 2 + (h)) * HTB)
#define PG8_STAGE(bufoff, gbase, voff) do { _Pragma("unroll") for (int _i = 0; _i < 2; ++_i) \
        __builtin_amdgcn_global_load_lds((const unsigned*)((const char*)(gbase) + (voff)[_i]), (LAS unsigned*)(lds + (bufoff) + ldsw + _i * 8192), 16, 0, 0); } while (0)
#define PG8_LDA(dst, b, h) do { _Pragma("unroll") for (int m = 0; m < 4; ++m) _Pragma("unroll") for (int k = 0; k < 2; ++k) dst[m][k] = *(const LAS bf16x8*)(lds + PG8_SA(b, h) + aoff + m * 2048 + k * 1024); } while (0)
#define PG8_LDB(dst, b, h) do { _Pragma("unroll") for (int n = 0; n < 2; ++n) _Pragma("unroll") for (int k = 0; k < 2; ++k) dst[n][k] = *(const LAS bf16x8*)(lds + PG8_SB(b, h) + boff + n * 2048 + k * 1024); } while (0)
#define PG8_MMA(ai, bj, At, Bt) do { __builtin_amdgcn_s_setprio(1); _Pragma("unroll") for (int m = 0; m < 4; ++m) _Pragma("unroll") for (int n = 0; n < 2; ++n) _Pragma("unroll") for (int k = 0; k < 2; ++k) \
        acc[ai][bj][m][n] = __builtin_amdgcn_mfma_f32_16x16x32_bf16(Bt[n][k], At[m][k], acc[ai][bj][m][n], 0, 0, 0); __builtin_amdgcn_s_setprio(0); } while (0)
#define PG8_WAIT_V(n) asm volatile("s_waitcnt vmcnt(" #n ")" ::: "memory")
#define PG8_WAIT_L(n) asm volatile("s_waitcnt lgkmcnt(" #n ")" ::: "memory")
#define PG8_BAR __builtin_amdgcn_s_barrier()
#define PG8_SCHED __builtin_amdgcn_sched_barrier(0)
    Unit cur, nxt; int ui = 0;
    if (!S.next(0, cur)) return;
    f32x4 acc[2][2][4][2];
#pragma unroll
    for (int a = 0; a < 2; ++a)
#pragma unroll
        for (int b = 0; b < 2; ++b)
#pragma unroll
            for (int m = 0; m < 4; ++m)
#pragma unroll
                for (int n = 0; n < 2; ++n) acc[a][b][m][n] = (f32x4){0.f, 0.f, 0.f, 0.f};
    bf16x8 At[4][2], B0[2][2], B1[2][2];
    const char* cA = cur.A; const char* cB = cur.B;
    PG8_STAGE(PG8_SB(0, 0), cB, voffB); PG8_STAGE(PG8_SB(0, 1), cB + hstepB, voffB); PG8_STAGE(PG8_SA(0, 0), cA, voffA); PG8_STAGE(PG8_SA(0, 1), cA + hstepA, voffA);
    if (wr == 1) PG8_BAR;
    PG8_WAIT_V(2); PG8_BAR;
    PG8_STAGE(PG8_SB(1, 0), cB + kstep, voffB); PG8_STAGE(PG8_SA(1, 0), cA + kstep, voffA); PG8_STAGE(PG8_SB(1, 1), cB + hstepB + kstep, voffB);
    PG8_WAIT_V(6); PG8_BAR;
    for (;;) {
        const bool has_next = S.next(ui + 1, nxt);
        const char* nA = has_next ? nxt.A : cA; const char* nB = has_next ? nxt.B : cB;
        for (int t = 0; t < nt; t += 2) {
            const bool last = (t == nt - 2);
            const char* a1 = cA + (size_t)(t + 1) * kstep;
            const char* a2 = last ? nA : cA + (size_t)(t + 2) * kstep; const char* b2 = last ? nB : cB + (size_t)(t + 2) * kstep;
            const char* a3 = a2 + kstep; const char* b3 = b2 + kstep;
            PG8_LDB(B0, 0, 0); PG8_LDB(B1, 0, 1); PG8_SCHED; PG8_LDA(At, 0, 0); PG8_STAGE(PG8_SA(1, 1), a1 + hstepA, voffA);
            PG8_WAIT_V(8); PG8_WAIT_L(0); PG8_BAR; PG8_MMA(0, 0, At, B0); PG8_MMA(0, 1, At, B1); PG8_BAR; PG8_SCHED;
            PG8_LDA(At, 0, 1); PG8_STAGE(PG8_SB(0, 0), b2, voffB); PG8_STAGE(PG8_SB(0, 1), b2 + hstepB, voffB); PG8_STAGE(PG8_SA(0, 0), a2, voffA);
            PG8_WAIT_V(8); PG8_WAIT_L(0); PG8_BAR; PG8_MMA(1, 0, At, B0); PG8_MMA(1, 1, At, B1); PG8_BAR; PG8_SCHED;
            PG8_LDB(B0, 1, 0); PG8_LDB(B1, 1, 1); PG8_SCHED; PG8_LDA(At, 1, 0); PG8_STAGE(PG8_SA(0, 1), a2 + hstepA, voffA);
            PG8_WAIT_V(8); PG8_WAIT_L(0); PG8_BAR; PG8_MMA(0, 0, At, B0); PG8_MMA(0, 1, At, B1); PG8_BAR; PG8_SCHED;
            PG8_LDA(At, 1, 1); PG8_STAGE(PG8_SB(1, 0), b3, voffB); PG8_STAGE(PG8_SB(1, 1), b3 + hstepB, voffB); PG8_STAGE(PG8_SA(1, 0), a3, voffA);
            PG8_WAIT_V(8); PG8_WAIT_L(0); PG8_BAR; PG8_MMA(1, 0, At, B0); PG8_MMA(1, 1, At, B1); PG8_BAR; PG8_SCHED;
        }
        if (wr == 0) PG8_BAR;
        E(acc, cur, wr, wc, fr, fq);
        if (!has_next) break;
#pragma unroll
        for (int a = 0; a < 2; ++a)
#pragma unroll
            for (int b = 0; b < 2; ++b)
#pragma unroll
                for (int m = 0; m < 4; ++m)
#pragma unroll
                    for (int n = 0; n < 2; ++n) acc[a][b][m][n] = (f32x4){0.f, 0.f, 0.f, 0.f};
        cur = nxt; cA = nA; cB = nB; ++ui;
        if (wr == 1) PG8_BAR;
    }
    PG8_WAIT_V(0);
    PG8_BAR;
#undef PG8_SA
#undef PG8_SB
#undef PG8_STAGE
#undef PG8_LDA
#undef PG8_LDB
#undef PG8_MMA
#undef PG8_WAIT_V
#undef PG8_WAIT_L
#undef PG8_BAR
#undef PG8_SCHED
}
}
using pg8::Unit;
using pg8::cvt_pk_bf16;

struct EpiStoreBf16 {
    static constexpr bool PERM = true;
    bf16* O; int ldc;
    __device__ __forceinline__ void operator()(const f32x4 (&acc)[2][2][4][2], const Unit& u, int wr, int wc, int fr, int fq) const {
        const int row0 = u.r0 + wr * 64 + fr, col0 = u.c0 + wc * 32 + 8 * fq;
#pragma unroll
        for (int ai = 0; ai < 2; ++ai)
#pragma unroll
            for (int m = 0; m < 4; ++m) { bf16* rowp = O + (size_t)(row0 + ai * 128 + m * 16) * ldc + col0;
#pragma unroll
                for (int bj = 0; bj < 2; ++bj) { const f32x4 v0 = acc[ai][bj][m][0], v1 = acc[ai][bj][m][1];
                    u32x4 w; w.x = cvt_pk_bf16(v0[0], v0[1]); w.y = cvt_pk_bf16(v0[2], v0[3]); w.z = cvt_pk_bf16(v1[0], v1[1]); w.w = cvt_pk_bf16(v1[2], v1[3]);
                    *(u32x4*)(rowp + bj * 128) = w; } }
    }
};
struct EpiGate {
    static constexpr bool PERM = true;
    const bf16* Hg; bf16* MG;
    __device__ __forceinline__ void operator()(const f32x4 (&acc)[2][2][4][2], const Unit& u, int wr, int wc, int fr, int fq) const {
        const int row0 = u.r0 + wr * 64 + fr, gcol0 = u.c0 + wc * 32 + 8 * fq, mcol0 = (u.c0 & 1023) + wc * 32 + 8 * fq; const bool first = u.c0 < 1024;
#pragma unroll
        for (int ai = 0; ai < 2; ++ai)
#pragma unroll
            for (int m = 0; m < 4; ++m) { const bf16* grow = Hg + (size_t)(row0 + ai * 128 + m * 16) * DH + gcol0; bf16* mrow = MG + (size_t)(row0 + ai * 128 + m * 16) * D + mcol0;
#pragma unroll
                for (int bj = 0; bj < 2; ++bj) { const f32x4 v0 = acc[ai][bj][m][0], v1 = acc[ai][bj][m][1];
                    const u32x4 gw = *(const u32x4*)(grow + bj * 128); float g[8], pm[8]; unpack8(gw, g);
                    if (first) {
#pragma unroll
                        for (int e = 0; e < 8; ++e) pm[e] = 0.f; }
                    else unpack8(*(const u32x4*)(mrow + bj * 128), pm);
                    u32x4 w; w.x = cvt_pk_bf16(pm[0] + sigmoidf_(g[0]) * v0[0], pm[1] + sigmoidf_(g[1]) * v0[1]); w.y = cvt_pk_bf16(pm[2] + sigmoidf_(g[2]) * v0[2], pm[3] + sigmoidf_(g[3]) * v0[3]);
                    w.z = cvt_pk_bf16(pm[4] + sigmoidf_(g[4]) * v1[0], pm[5] + sigmoidf_(g[5]) * v1[1]); w.w = cvt_pk_bf16(pm[6] + sigmoidf_(g[6]) * v1[2], pm[7] + sigmoidf_(g[7]) * v1[3]);
                    *(u32x4*)(mrow + bj * 128) = w; } }
    }
};
struct EpiResF32 {
    static constexpr bool PERM = false;
    const float* res; float* out;
    __device__ __forceinline__ void operator()(const f32x4 (&acc)[2][2][4][2], const Unit& u, int wr, int wc, int fr, int fq) const {
        const int row0 = u.r0 + wr * 64 + fr, col0 = u.c0 + wc * 32 + 4 * fq;
#pragma unroll
        for (int ai = 0; ai < 2; ++ai)
#pragma unroll
            for (int m = 0; m < 4; ++m) { const size_t ro = (size_t)(row0 + ai * 128 + m * 16) * D + col0;
#pragma unroll
                for (int bj = 0; bj < 2; ++bj)
#pragma unroll
                    for (int n = 0; n < 2; ++n) { const f32x4 r = *(const f32x4*)(res + ro + bj * 128 + n * 16); *(f32x4*)(out + ro + bj * 128 + n * 16) = r + acc[ai][bj][m][n]; } }
    }
};
struct EpiSwiglu {
    static constexpr bool PERM = true;
    bf16* O;
    __device__ __forceinline__ void operator()(const f32x4 (&acc)[2][2][4][2], const Unit& u, int wr, int wc, int fr, int fq) const {
        const int row0 = u.r0 + wr * 64 + fr, col0 = u.c0 + wc * 32 + 8 * fq;
#pragma unroll
        for (int ai = 0; ai < 2; ++ai)
#pragma unroll
            for (int m = 0; m < 4; ++m) { bf16* rowp = O + (size_t)(row0 + ai * 128 + m * 16) * DE + col0;
                const f32x4 g0 = acc[ai][0][m][0], g1 = acc[ai][0][m][1], u0 = acc[ai][1][m][0], u1 = acc[ai][1][m][1];
                u32x4 w; w.x = cvt_pk_bf16(siluf_(g0[0]) * u0[0], siluf_(g0[1]) * u0[1]); w.y = cvt_pk_bf16(siluf_(g0[2]) * u0[2], siluf_(g0[3]) * u0[3]);
                w.z = cvt_pk_bf16(siluf_(g1[0]) * u1[0], siluf_(g1[1]) * u1[1]); w.w = cvt_pk_bf16(siluf_(g1[2]) * u1[2], siluf_(g1[3]) * u1[3]);
                *(u32x4*)rowp = w; }
    }
};
struct EpiScatter {
    static constexpr bool PERM = true;
    bf16* Y; const int* row_code; const float* row_w;
    __device__ __forceinline__ void operator()(const f32x4 (&acc)[2][2][4][2], const Unit& u, int wr, int wc, int fr, int fq) const {
        const int row0 = u.r0 + wr * 64 + fr, col0 = u.c0 + wc * 32 + 8 * fq;
#pragma unroll
        for (int ai = 0; ai < 2; ++ai)
#pragma unroll
            for (int m = 0; m < 4; ++m) { const int row = row0 + ai * 128 + m * 16; const int code = row_code[row]; const float rw = row_w[row];
                if (code >= 0) { bf16* rowp = Y + (size_t)(code & 1) * ((size_t)M * D) + (size_t)(code >> 1) * D + col0;
#pragma unroll
                    for (int bj = 0; bj < 2; ++bj) { const f32x4 v0 = acc[ai][bj][m][0] * rw, v1 = acc[ai][bj][m][1] * rw;
                        u32x4 w; w.x = cvt_pk_bf16(v0[0], v0[1]); w.y = cvt_pk_bf16(v0[2], v0[3]); w.z = cvt_pk_bf16(v1[0], v1[1]); w.w = cvt_pk_bf16(v1[2], v1[3]);
                        *(u32x4*)(rowp + bj * 128) = w; } } }
    }
};

struct SchedH {
    pg8::TileOrder to; const char* A; const char* B;
    __device__ __forceinline__ bool next(int i, Unit& u) const { int pm, pn; if (!to.next(i, pm, pn)) return false;
        u.A = A + (size_t)pm * 256 * D * 2; u.B = B + (size_t)pn * 256 * D * 2; u.r0 = pm * 256; u.c0 = pn * 256; return true; }
};
struct SchedBranch {
    pg8::TileOrder to; const char* YS; const char* WBR;
    __device__ __forceinline__ bool next(int i, Unit& u) const { int pm, q; if (!to.next(i >> 2, pm, q)) return false; const int br = i & 3;
        u.A = YS + ((size_t)pm * 256 * 2048 + br * 512) * 2; u.B = WBR + ((size_t)br * D * 512 + (size_t)q * 256 * 512) * 2; u.r0 = pm * 256; u.c0 = br * 1024 + q * 256; return true; }
};
struct SchedOut {
    pg8::TileOrder to; const char* A; const char* B;
    __device__ __forceinline__ bool next(int i, Unit& u) const { int pm, pn; if (!to.next(i, pm, pn)) return false;
        u.A = A + (size_t)pm * 256 * D * 2; u.B = B + (size_t)pn * 256 * D * 2; u.r0 = pm * 256; u.c0 = pn * 256; return true; }
};
struct SchedMoe {
    int nux, nrank, rank, nk, x, NX; const LAS int* cum; const LAS int* rb0; const char* A; size_t a_blk; const char* W; size_t w_e, w_pn; int cmul;
    __device__ __forceinline__ bool next(int i, Unit& u) const { const int ui = i * nrank + rank; if (ui >= nux) return false;
        int k = 0; while (k + 1 < nk && cum[k + 1] <= ui) ++k;
        const int local = ui - cum[k], rb = rb0[k] + (local >> 2), pn = local & 3, e = x + NX * k;
        u.A = A + (size_t)rb * a_blk; u.B = W + (size_t)e * w_e + (size_t)pn * w_pn; u.r0 = rb * 256; u.c0 = pn * cmul; return true; }
};

struct Params { const float* in[25]; float* out; unsigned char* ws; int ph_lo, ph_hi; };
enum { I_X = 0, I_MIXNW, I_WIN, I_GCONV, I_GALOG, I_GDT, I_GNW, I_CCW, I_CCB, I_CLNW, I_CLNB, I_GLNW, I_GLNB, I_GWS, I_GBS, I_SCW, I_WBR, I_WOUT, I_MOENW, I_RGRP, I_REXP, I_WG, I_WU, I_WD, I_FNW };
constexpr int PH_PER_LAYER = 12, PH_FINAL = 24, PH_TOTAL = 25;

__device__ __forceinline__ void transpose_item(const float* __restrict__ W, int ldw, int srccol, bf16* __restrict__ WT, int ldt, int k0, int n0, int lane) {
    const int kq = lane & 7, nq = lane >> 3;
    f32x4 v[8][2];
#pragma unroll
    for (int r = 0; r < 8; ++r) { const float* s = W + (size_t)(k0 + 8 * kq + r) * ldw + srccol + 8 * nq; v[r][0] = *(const f32x4*)s; v[r][1] = *(const f32x4*)(s + 4); }
#pragma unroll
    for (int e = 0; e < 8; ++e) { u32x4 o; o.x = pk2(v[0][e >> 2][e & 3], v[1][e >> 2][e & 3]); o.y = pk2(v[2][e >> 2][e & 3], v[3][e >> 2][e & 3]); o.z = pk2(v[4][e >> 2][e & 3], v[5][e >> 2][e & 3]); o.w = pk2(v[6][e >> 2][e & 3], v[7][e >> 2][e & 3]);
        *(u32x4*)(WT + (size_t)(n0 + 8 * nq + e) * ldt + k0 + 8 * kq) = o; }
}
__device__ __forceinline__ void prep_static_weights(const Params& p, int gw, int NGW, int lane) {
    constexpr int I_IN = 16 * (DH / 64), I_BR = 8 * 16, I_OUT = 16 * 16, PER_L = I_IN + 4 * I_BR + I_OUT;
    for (int it = gw; it < NLAYER * PER_L; it += NGW) {
        const int l = it / PER_L; int r = it % PER_L;
        if (r < I_IN) { const int kb = r / (DH / 64), nb = r % (DH / 64), n0 = nb * 64;
            transpose_item(p.in[I_WIN] + (size_t)l * D * DIN, DIN, n0 + (n0 >= 2048 ? 8 : 0), (bf16*)(p.ws + WS_WIN + l * WIN_L), D, kb * 64, n0, lane); continue; }
        r -= I_IN;
        if (r < 4 * I_BR) { const int br = r / I_BR, q = r % I_BR, kb = q / 16, nb = q % 16;
            transpose_item(p.in[I_WBR] + ((size_t)l * 4 + br) * 512 * D, D, nb * 64, (bf16*)(p.ws + WS_WBR + l * WBR_L) + (size_t)br * D * 512, 512, kb * 64, nb * 64, lane); continue; }
        r -= 4 * I_BR;
        { const int kb = r / 16, nb = r % 16;
            transpose_item(p.in[I_WOUT] + (size_t)l * D * D, D, nb * 64, (bf16*)(p.ws + WS_WOUT + l * WOUT_L), D, kb * 64, nb * 64, lane); }
    }
}
__device__ __forceinline__ void prep_moe_weights(const Params& p, int layer, int gw, int NGW, int lane) {
    constexpr int I_GU = 16 * 16, I_D = 8 * 16, PER_E = I_GU + I_D;
    for (int it = gw; it < NE * PER_E; it += NGW) {
        const int e = it / PER_E; int r = it % PER_E;
        if (r < I_GU) { const int kb = r / 16, nb = r % 16, n0 = nb * 64, pn = n0 >> 8, half = (n0 >> 7) & 1, j0 = n0 & 127;
            const float* src = p.in[half ? I_WU : I_WG] + ((size_t)layer * NE + e) * D * DE;
            transpose_item(src, DE, 128 * pn + j0, (bf16*)(p.ws + WS_MOEW + e * WGU_E), D, kb * 64, n0, lane); continue; }
        r -= I_GU;
        { const int kb = r / 16, nb = r % 16;
            transpose_item(p.in[I_WD] + ((size_t)layer * NE + e) * DE * D, D, nb * 64, (bf16*)(p.ws + WS_WD + e * WD_E), DE, kb * 64, nb * 64, lane); }
    }
}

template <int MODE>
__device__ __forceinline__ void norm_phase(const Params& p, int layer, LAS unsigned char* lds, int gw, int NGW, int tid, int lane) {
    LAS float* wsm = (LAS float*)lds;
    if (MODE != 2) {
        const float* wi = p.in[I_WIN] + (size_t)layer * D * DIN;
        for (int i = tid; i < 8192; i += 512) wsm[i] = wi[(size_t)(i >> 3) * DIN + 2048 + (i & 7)];
    }
    __syncthreads();
    const float* nwp = (MODE == 2) ? p.in[I_FNW] : p.in[I_MIXNW] + layer * D;
    f32x4 nw[4];
#pragma unroll
    for (int j = 0; j < 4; ++j) nw[j] = *(const f32x4*)(nwp + 4 * lane + 256 * j);
    const bf16* Y0 = (const bf16*)(p.ws + WS_Y); const bf16* Y1 = Y0 + (size_t)M * D;
    bf16* XN = (bf16*)(p.ws + WS_XN); float* SMALL = (float*)(p.ws + WS_SMALL);
    for (int m = gw; m < M; m += NGW) {
        const float* xr = (MODE == 0 ? p.in[I_X] : p.out) + (size_t)m * D;
        f32x4 v[4]; float ss = 0.f;
#pragma unroll
        for (int j = 0; j < 4; ++j) { v[j] = *(const f32x4*)(xr + 4 * lane + 256 * j);
            if (MODE != 0) { const u32x2 a = *(const u32x2*)(Y0 + (size_t)m * D + 4 * lane + 256 * j), b = *(const u32x2*)(Y1 + (size_t)m * D + 4 * lane + 256 * j);
                v[j][0] += bf_lo(a.x) + bf_lo(b.x); v[j][1] += bf_hi(a.x) + bf_hi(b.x); v[j][2] += bf_lo(a.y) + bf_lo(b.y); v[j][3] += bf_hi(a.y) + bf_hi(b.y); }
            ss += (v[j][0] * v[j][0] + v[j][1] * v[j][1]) + (v[j][2] * v[j][2] + v[j][3] * v[j][3]); }
        const float rs = 1.0f / sqrtf(wave_sum(ss) * (1.0f / D) + EPS);
        if (MODE == 2) {
#pragma unroll
            for (int j = 0; j < 4; ++j) *(f32x4*)(p.out + (size_t)m * D + 4 * lane + 256 * j) = v[j] * rs * nw[j];
            continue;
        }
        if (MODE == 1) {
#pragma unroll
            for (int j = 0; j < 4; ++j) *(f32x4*)(p.out + (size_t)m * D + 4 * lane + 256 * j) = v[j];
        }
        float sm[8];
#pragma unroll
        for (int q = 0; q < 8; ++q) sm[q] = 0.f;
#pragma unroll
        for (int j = 0; j < 4; ++j) { v[j] = v[j] * rs * nw[j];
            u32x2 o; o.x = pk2(v[j][0], v[j][1]); o.y = pk2(v[j][2], v[j][3]); *(u32x2*)(XN + (size_t)m * D + 4 * lane + 256 * j) = o;
#pragma unroll
            for (int c = 0; c < 4; ++c) { const LAS float* wrow = wsm + (4 * lane + 256 * j + c) * 8; const f32x4 w0 = *(const LAS f32x4*)wrow, w1 = *(const LAS f32x4*)(wrow + 4);
                sm[0] += v[j][c] * w0[0]; sm[1] += v[j][c] * w0[1]; sm[2] += v[j][c] * w0[2]; sm[3] += v[j][c] * w0[3];
                sm[4] += v[j][c] * w1[0]; sm[5] += v[j][c] * w1[1]; sm[6] += v[j][c] * w1[2]; sm[7] += v[j][c] * w1[3]; } }
        float mine = 0.f;
#pragma unroll
        for (int q = 0; q < 8; ++q) { const float s = wave_sum(sm[q]); mine = (lane == q) ? s : mine; }
        if (lane < 8) SMALL[(size_t)m * 8 + lane] = mine;
    }
    __syncthreads();
}

__device__ __forceinline__ void shortconv_unit(const Params& p, int layer, int tid, int unit) {
    const bf16* H = (const bf16*)(p.ws + WS_H); bf16* YS = (bf16*)(p.ws + WS_YS);
    const float* cw = p.in[I_SCW] + (size_t)layer * 3 * 512;
#pragma unroll 2
    for (int k = 0; k < 16; ++k) { const int it = unit * 8192 + k * 512 + tid;
        const int m = it >> 6, c8 = (it & 63) * 8, t = m & (T - 1);
        u32x4 rc[3], rx[3];
#pragma unroll
        for (int j = 0; j < 3; ++j) { const bool ok = (t - 2 + j >= 0); const bf16* r = H + (size_t)(ok ? m - 2 + j : m) * DH + HSC + c8; rc[j] = *(const u32x4*)(r + 512); rx[j] = *(const u32x4*)(r + 1024); if (!ok) rc[j] = (u32x4){0u, 0u, 0u, 0u}; }
        const u32x4 rb = *(const u32x4*)(H + (size_t)m * DH + HSC + c8);
        float acc[8];
#pragma unroll
        for (int i = 0; i < 8; ++i) acc[i] = 0.f;
#pragma unroll
        for (int j = 0; j < 3; ++j) { float cg[8], xv[8]; unpack8(rc[j], cg); unpack8(rx[j], xv);
#pragma unroll
            for (int i = 0; i < 8; ++i) acc[i] += cw[j * 512 + c8 + i] * (cg[i] * xv[i]); }
        float bg[8]; unpack8(rb, bg);
#pragma unroll
        for (int i = 0; i < 8; ++i) acc[i] *= bg[i];
        *(u32x4*)(YS + (size_t)m * 2048 + 1536 + c8) = pack8(acc);
    }
}
__device__ __forceinline__ int queue_pop(unsigned* counter, LAS unsigned char* lds, int tid) {
    LAS int* slot = (LAS int*)(lds + LDSCTL_OFF + LC_MISC);
    __syncthreads();
    if (tid == 0) slot[0] = (int)__hip_atomic_fetch_add(counter, 1u, __ATOMIC_RELAXED, __HIP_MEMORY_SCOPE_AGENT);
    __syncthreads();
    return slot[0];
}
__device__ __forceinline__ void conformer(const Params& p, int layer, LAS unsigned char* lds, int tid, int wave, int lane, unsigned* counter) {
    const bf16* H = (const bf16*)(p.ws + WS_H); bf16* YS = (bf16*)(p.ws + WS_YS);
    LAS bf16* yt = (LAS bf16*)lds;
    LAS float* zt = (LAS float*)(lds + 98304);
    const float* cwp = p.in[I_CCW] + (size_t)layer * 31 * 512;
    float cw[31];
#pragma unroll
    for (int j = 0; j < 31; ++j) cw[j] = cwp[j * 512 + tid];
    const float cb = p.in[I_CCB][layer * 512 + tid];
    float lw[8], lb[8];
#pragma unroll
    for (int i = 0; i < 8; ++i) { lw[i] = p.in[I_CLNW][layer * 512 + lane * 8 + i]; lb[i] = p.in[I_CLNB][layer * 512 + lane * 8 + i]; }
    for (;;) {
        const int unit = queue_pop(counter, lds, tid); if (unit >= M / 64) break;
        const int m0 = unit * 64, t0 = m0 & (T - 1);
        for (int base = 0; base < 94 * 64; base += 512 * 4) {
            u32x4 ra[4], rg[4];
#pragma unroll
            for (int k = 0; k < 4; ++k) { const int it = base + k * 512 + tid; const int r = it >> 6, c8 = (it & 63) * 8, dt = r - 30; const bool ok = (it < 94 * 64) && (t0 + dt >= 0);
                const bf16* s = H + (size_t)(ok ? m0 + dt : m0) * DH + HCONF + c8; ra[k] = *(const u32x4*)s; rg[k] = *(const u32x4*)(s + 512); }
#pragma unroll
            for (int k = 0; k < 4; ++k) { const int it = base + k * 512 + tid; const int r = it >> 6, c8 = (it & 63) * 8, dt = r - 30;
                if (it < 94 * 64) { u32x4 o = (u32x4){0u, 0u, 0u, 0u};
                    if (t0 + dt >= 0) { float a[8], g[8]; unpack8(ra[k], a); unpack8(rg[k], g);
#pragma unroll
                        for (int i = 0; i < 8; ++i) a[i] *= sigmoidf_(g[i]);
                        o = pack8(a); }
                    *(LAS u32x4*)(yt + r * 512 + c8) = o; } }
        }
        __syncthreads();
        for (int sb = 0; sb < 8; ++sb) {
            LAS float* zb = zt + (sb & 1) * 4096;
            float z[8];
#pragma unroll
            for (int i = 0; i < 8; ++i) z[i] = cb;
#pragma unroll
            for (int r = 0; r < 38; ++r) { const float yv = bf2f(yt[(sb * 8 + r) * 512 + tid]);
#pragma unroll
                for (int i = 0; i < 8; ++i) { const int j = r - i; if (j >= 0 && j < 31) z[i] += cw[j] * yv; } }
#pragma unroll
            for (int i = 0; i < 8; ++i) zb[i * 512 + tid] = z[i];
            __syncthreads();
            { const LAS float* zr = zb + wave * 512 + lane * 8; float v[8]; const f32x4 a = *(const LAS f32x4*)zr, b = *(const LAS f32x4*)(zr + 4);
                v[0] = a[0]; v[1] = a[1]; v[2] = a[2]; v[3] = a[3]; v[4] = b[0]; v[5] = b[1]; v[6] = b[2]; v[7] = b[3];
                float s = 0.f;
#pragma unroll
                for (int i = 0; i < 8; ++i) s += v[i];
                const float mean = wave_sum(s) * (1.0f / 512.0f); float q = 0.f;
#pragma unroll
                for (int i = 0; i < 8; ++i) { v[i] -= mean; q += v[i] * v[i]; }
                const float rstd = __builtin_amdgcn_rsqf(wave_sum(q) * (1.0f / 512.0f) + EPS);
#pragma unroll
                for (int i = 0; i < 8; ++i) v[i] = siluf_(v[i] * rstd * lw[i] + lb[i]);
                *(u32x4*)(YS + (size_t)(m0 + sb * 8 + wave) * 2048 + 512 + lane * 8) = pack8(v); }
        }
    }
}
__device__ __forceinline__ f32x4 mfma16(bf16x8 a, bf16x8 b, f32x4 c) { return __builtin_amdgcn_mfma_f32_16x16x32_bf16(a, b, c, 0, 0, 0); }
typedef short bf16x4 __attribute__((ext_vector_type(4)));
__device__ __forceinline__ bf16x8 ld_frag16(const LAS unsigned char* p) { return *(const LAS bf16x8*)p; }
__device__ __forceinline__ bf16x8 ld_frag8x2(const LAS unsigned char* p) { const bf16x4 a = *(const LAS bf16x4*)p, b = *(const LAS bf16x4*)(p + 32); return __builtin_shufflevector(a, b, 0, 1, 2, 3, 4, 5, 6, 7); }
__device__ __forceinline__ bf16x8 pack_frag(const f32x4 lo, const f32x4 hi) { u32x4 w; w.x = cvt_pk_bf16(lo[0], lo[1]); w.y = cvt_pk_bf16(lo[2], lo[3]); w.z = cvt_pk_bf16(hi[0], hi[1]); w.w = cvt_pk_bf16(hi[2], hi[3]); return __builtin_bit_cast(bf16x8, w); }
constexpr int GM_W = 0, GM_VT = 34816, GM_ST = 69632;
__device__ __forceinline__ void gmlp(const Params& p, int layer, LAS unsigned char* lds, int tid, int wave, int lane, unsigned* counter) {
    const bf16* H = (const bf16*)(p.ws + WS_H); bf16* YS = (bf16*)(p.ws + WS_YS);
    LAS float* st = (LAS float*)(lds + GM_ST);
    const float* lnw = p.in[I_GLNW] + layer * 512; const float* lnb = p.in[I_GLNB] + layer * 512;
    const int q = lane >> 4, li = lane & 15;
    for (;;) {
        const int unit = queue_pop(counter, lds, tid); if (unit >= M / 128) break;
        const int m0 = unit * 128;
        u32x4 rv[16];
#pragma unroll
        for (int k = 0; k < 16; ++k) rv[k] = *(const u32x4*)(H + (size_t)(m0 + wave * 16 + k) * DH + HGMLP + 512 + lane * 8);
#pragma unroll
        for (int k = 0; k < 16; ++k) { const int tk = wave * 16 + k;
            float v[8]; unpack8(rv[k], v);
            float s = 0.f;
#pragma unroll
            for (int i = 0; i < 8; ++i) { v[i] = gelu_tanh(v[i]); s += v[i]; }
            const float mean = wave_sum(s) * (1.0f / 512.0f); float qq = 0.f;
#pragma unroll
            for (int i = 0; i < 8; ++i) { const float d = v[i] - mean; qq += d * d; }
            const float rstd = 1.0f / sqrtf(wave_sum(qq) * (1.0f / 512.0f) + EPS);
            if (lane == 0) { st[tk * 2] = mean; st[tk * 2 + 1] = rstd; }
        }
        __syncthreads();
        for (int g = 0; g < 4; ++g) {
            u32x4 rg[4];
#pragma unroll
            for (int k = 0; k < 4; ++k) { const int it = tid + 512 * k; rg[k] = *(const u32x4*)(H + (size_t)(m0 + (it >> 4)) * DH + HGMLP + 512 + g * 128 + (it & 15) * 8); }
#pragma unroll
            for (int k = 0; k < 4; ++k) { const int it = tid + 512 * k; const int tk = it >> 4, c8 = (it & 15) * 8;
                float v[8]; unpack8(rg[k], v);
                const float mean = st[tk * 2], rstd = st[tk * 2 + 1];
#pragma unroll
                for (int i = 0; i < 8; ++i) *(LAS bf16*)(lds + GM_VT + (c8 + i) * 272 + 2 * tk) = (bf16)f2bf((gelu_tanh(v[i]) - mean) * rstd * lnw[g * 128 + c8 + i] + lnb[g * 128 + c8 + i]); }
            const float* ws = p.in[I_GWS] + ((size_t)layer * 4 + g) * 128 * 128;
            f32x4 wa[4], wb[4];
#pragma unroll
            for (int k = 0; k < 4; ++k) { const int it = tid + 512 * k; wa[k] = *(const f32x4*)(ws + (it >> 4) * 128 + (it & 15) * 8); wb[k] = *(const f32x4*)(ws + (it >> 4) * 128 + (it & 15) * 8 + 4); }
#pragma unroll
            for (int k = 0; k < 4; ++k) { const int it = tid + 512 * k; const int i = it >> 4, j8 = (it & 15) * 8;
                const f32x4 a = wa[k], b = wb[k];
                float w[8] = {a[0], a[1], a[2], a[3], b[0], b[1], b[2], b[3]};
#pragma unroll
                for (int e = 0; e < 8; ++e) w[e] = (j8 + e <= i) ? w[e] : 0.f;
                *(LAS u32x4*)(lds + GM_W + i * 272 + j8 * 2) = pack8(w); }
            __syncthreads();
            {
                f32x4 acc[8];
#pragma unroll
                for (int ct = 0; ct < 8; ++ct) acc[ct] = (f32x4){0.f, 0.f, 0.f, 0.f};
                const int nks = (wave >> 1) + 1;
                for (int ks = 0; ks < nks; ++ks) { const bf16x8 wf = ld_frag16(lds + GM_W + (16 * wave + li) * 272 + (32 * ks + 8 * q) * 2);
#pragma unroll
                    for (int ct = 0; ct < 8; ++ct) acc[ct] = mfma16(ld_frag16(lds + GM_VT + (16 * ct + li) * 272 + (32 * ks + 8 * q) * 2), wf, acc[ct]); }
                const int i = 16 * wave + li; const float bs = p.in[I_GBS][((size_t)layer * 4 + g) * 128 + i];
                const bf16* urow = H + (size_t)(m0 + i) * DH + HGMLP + g * 128 + 4 * q; bf16* orow = YS + (size_t)(m0 + i) * 2048 + 1024 + g * 128 + 4 * q;
#pragma unroll
                for (int ct = 0; ct < 8; ++ct) { const u32x2 uw = *(const u32x2*)(urow + 16 * ct);
                    const float o0 = gelu_tanh(bf_lo(uw.x)) * (acc[ct][0] + bs), o1 = gelu_tanh(bf_hi(uw.x)) * (acc[ct][1] + bs), o2 = gelu_tanh(bf_lo(uw.y)) * (acc[ct][2] + bs), o3 = gelu_tanh(bf_hi(uw.y)) * (acc[ct][3] + bs);
                    u32x2 ow; ow.x = pk2(o0, o1); ow.y = pk2(o2, o3); *(u32x2*)(orow + 16 * ct) = ow; }
            }
            __syncthreads();
        }
    }
}
constexpr int CP_QN = 0, CP_KN = 17408, CP_KT = 34816, CP_VT = 53248, CP_KGT = 71680, CP_A32 = 90112, CP_ATT = 106496, CP_T16 = 115712, CP_TAB = 124928;
__device__ __forceinline__ void gdn_chunk_prep(const Params& p, int layer, LAS unsigned char* lds, int tid, int wave, int lane) {
    const bf16* H = (const bf16*)(p.ws + WS_H); const float* SMALL = (const float*)(p.ws + WS_SMALL);
    const float* cw = p.in[I_GCONV] + (size_t)layer * 4 * 1536;
    LAS float* tab = (LAS float*)(lds + CP_TAB);
    const int q = lane >> 4, li = lane & 15;
    for (int unit = blockIdx.x; unit < 2048; unit += gridDim.x) {
        const int n = unit & 63, hh = (unit >> 6) & 3, b = unit >> 8; const int m0 = b * T + n * 64;
        unsigned char* rec = p.ws + WS_REC + (size_t)((b * 4 + hh) * 64 + n) * REC_BYTES;
        __syncthreads();
        if (wave == 0) { const int m = m0 + lane; const float br = SMALL[(size_t)m * 8 + hh], ar = SMALL[(size_t)m * 8 + 4 + hh];
            float g = -__expf(p.in[I_GALOG][layer * 4 + hh]) * softplusf_(ar + p.in[I_GDT][layer * 4 + hh]);
#pragma unroll
            for (int o = 1; o < 64; o <<= 1) { const float t = __shfl_up(g, o); if (lane >= o) g += t; }
            tab[lane] = sigmoidf_(br); tab[64 + lane] = g; tab[128 + lane] = __expf(g); }
        __syncthreads();
        {
            const int i0 = wave * 8, t0 = n * 64 + i0;
            unsigned raw[3][11];
#pragma unroll
            for (int s = 0; s < 3; ++s)
#pragma unroll
                for (int r = 0; r < 11; ++r) raw[s][r] = (t0 - 3 + r >= 0) ? *(const unsigned*)(H + (size_t)(m0 + i0 - 3 + r) * DH + s * 512 + hh * 128 + 2 * lane) : 0u;
            float w0[3][4], w1[3][4];
#pragma unroll
            for (int s = 0; s < 3; ++s)
#pragma unroll
                for (int j = 0; j < 4; ++j) { const f32x2 ww = *(const f32x2*)(cw + j * 1536 + s * 512 + hh * 128 + 2 * lane); w0[s][j] = ww[0]; w1[s][j] = ww[1]; }
#pragma unroll
            for (int ii = 0; ii < 8; ++ii) { const int i = i0 + ii;
                float y[3][2];
#pragma unroll
                for (int s = 0; s < 3; ++s) { float a0 = 0.f, a1 = 0.f;
#pragma unroll
                    for (int j = 0; j < 4; ++j) { a0 += w0[s][j] * bf_lo(raw[s][ii + j]); a1 += w1[s][j] * bf_hi(raw[s][ii + j]); }
                    y[s][0] = siluf_(a0); y[s][1] = siluf_(a1); }
                const float sq = wave_sum(y[0][0] * y[0][0] + y[0][1] * y[0][1]), sk = wave_sum(y[1][0] * y[1][0] + y[1][1] * y[1][1]);
                const float rq = 0.08838834764831845f * __builtin_amdgcn_rsqf(sq + EPS), rk = __builtin_amdgcn_rsqf(sk + EPS);
                const float be = tab[i], bg = be * tab[128 + i];
                const float k0 = y[1][0] * rk, k1 = y[1][1] * rk;
                *(LAS unsigned*)(lds + CP_QN + i * 272 + 4 * lane) = pk2(y[0][0] * rq, y[0][1] * rq);
                *(LAS unsigned*)(lds + CP_KN + i * 272 + 4 * lane) = pk2(k0, k1);
                *(LAS bf16*)(lds + CP_KT + (2 * lane) * 144 + 2 * i) = (bf16)f2bf(k0); *(LAS bf16*)(lds + CP_KT + (2 * lane + 1) * 144 + 2 * i) = (bf16)f2bf(k1);
                *(LAS bf16*)(lds + CP_VT + (2 * lane) * 144 + 2 * i) = (bf16)f2bf(be * y[2][0]); *(LAS bf16*)(lds + CP_VT + (2 * lane + 1) * 144 + 2 * i) = (bf16)f2bf(be * y[2][1]);
                *(LAS bf16*)(lds + CP_KGT + (2 * lane) * 144 + 2 * i) = (bf16)f2bf(bg * k0); *(LAS bf16*)(lds + CP_KGT + (2 * lane + 1) * 144 + 2 * i) = (bf16)f2bf(bg * k1);
            }
        }
        __syncthreads();
        for (int jb = wave; jb < 32; jb += 8) { const int which = jb >> 4, mt = (jb >> 2) & 3, nt = jb & 3;
            f32x4 acc = (f32x4){0.f, 0.f, 0.f, 0.f};
            if (nt <= mt) {
#pragma unroll
                for (int ks = 0; ks < 4; ++ks) acc = mfma16(ld_frag16(lds + (which ? CP_QN : CP_KN) + (16 * mt + li) * 272 + (32 * ks + 8 * q) * 2), ld_frag16(lds + CP_KN + (16 * nt + li) * 272 + (32 * ks + 8 * q) * 2), acc);
            }
            const int j = 16 * nt + li; const float gj = tab[64 + j];
#pragma unroll
            for (int r = 0; r < 4; ++r) { const int i = 16 * mt + 4 * q + r; const float gi = tab[64 + i];
                if (which == 0) { ((LAS float*)(lds + CP_A32))[i * 64 + j] = (i > j) ? tab[i] * acc[r] * __expf(gi - gj) : 0.f; }
                else { *(LAS bf16*)(lds + CP_ATT + i * 144 + 2 * j) = (bf16)f2bf((i >= j) ? acc[r] * __expf(gi - gj) : 0.f); } }
        }
        __syncthreads();
        if (wave == 0) {
            float Tc[64]; const float lanef = (float)lane;
            const LAS float* A = (const LAS float*)(lds + CP_A32); asm volatile("" : "+v"(A));
            LAS unsigned char* Tw = lds + CP_T16 + 2 * lane; asm volatile("" : "+v"(Tw));
#pragma unroll
            for (int i = 0; i < 64; ++i) { float a4[4] = {fmaxf(0.f, 1.f - fabsf((float)i - lanef)), 0.f, 0.f, 0.f};
#pragma unroll
                for (int j = 0; j < i; j += 4) { const f32x4 av = *(const LAS f32x4*)(A + i * 64 + j);
#pragma unroll
                    for (int jj = 0; jj < 4; ++jj) if (j + jj < i) a4[jj] -= av[jj] * Tc[j + jj]; }
                const float a = (a4[0] + a4[1]) + (a4[2] + a4[3]);
                Tc[i] = a; *(LAS bf16*)(Tw + i * 144) = (bf16)f2bf(a); }
        } else {
            const int t2 = tid - 64;
            for (int pc = t2; pc < 1024; pc += 448) { const int row = pc >> 4, seg = pc & 15; *(u32x4*)(rec + REC_Q + pc * 16) = *(const LAS u32x4*)(lds + CP_QN + row * 272 + seg * 16); }
            for (int pc = t2; pc < 512; pc += 448) { const int row = pc >> 3, seg = pc & 7; *(u32x4*)(rec + REC_ATT + pc * 16) = *(const LAS u32x4*)(lds + CP_ATT + row * 144 + seg * 16); }
            for (int pc = t2; pc < 1024; pc += 448) { const int row = pc >> 3, seg = pc & 7; *(u32x4*)(rec + REC_KT + pc * 16) = *(const LAS u32x4*)(lds + CP_KT + row * 144 + seg * 16); }
            if (t2 < 16) *(u32x4*)(rec + REC_G + t2 * 16) = *(const LAS u32x4*)(lds + CP_TAB + 256 + t2 * 16);
        }
        __syncthreads();
        for (int jb = wave; jb < 64; jb += 8) {
            f32x4 acc = (f32x4){0.f, 0.f, 0.f, 0.f};
            if (jb < 32) { const int mt = jb >> 3, nt = jb & 7;
#pragma unroll
                for (int ks = 0; ks < 2; ++ks) acc = mfma16(ld_frag16(lds + CP_T16 + (16 * mt + li) * 144 + (32 * ks + 8 * q) * 2), ld_frag16(lds + CP_VT + (16 * nt + li) * 144 + (32 * ks + 8 * q) * 2), acc);
                u32x2 o; o.x = pk2(acc[0], acc[1]); o.y = pk2(acc[2], acc[3]);
                *(u32x2*)(rec + REC_U + (size_t)((nt * 64 + lane) * 4 + mt) * 8) = o;
            } else { const int mt = (jb - 32) >> 2, nt = (jb - 32) & 3;
#pragma unroll
                for (int ks = 0; ks < 2; ++ks) acc = mfma16(ld_frag16(lds + CP_KGT + (16 * mt + li) * 144 + (32 * ks + 8 * q) * 2), ld_frag16(lds + CP_T16 + (16 * nt + li) * 144 + (32 * ks + 8 * q) * 2), acc);
                u32x2 o; o.x = pk2(acc[0], acc[1]); o.y = pk2(acc[2], acc[3]);
                *(u32x2*)(rec + REC_W + (size_t)((16 * nt + li) * 128 + 16 * mt + 4 * q) * 2) = o;
            }
        }
    }
    __syncthreads();
}
constexpr int SC_W = 0, SC_KT = 17408, SC_G = 35840, SC_BUF = 36096;
__device__ __forceinline__ void gdn_chunk_scan(const Params& p, LAS unsigned char* lds, int tid, int wave, int lane, int bh, int half) {
    const int q = lane >> 4, li = lane & 15, sl = half * 4 + (wave & 3);
    unsigned char* rec0 = p.ws + WS_REC + (size_t)(bh * 64) * REC_BYTES;
    u32x4* S0F = (u32x4*)(p.ws + WS_OBUF) + (size_t)(bh * 64) * 8 * 4 * 64;
    u32x4 pf[4], pfg = (u32x4){0u, 0u, 0u, 0u}, pu[2];
#define SC_LOAD(nn) do { const unsigned char* r_ = rec0 + (size_t)(nn) * REC_BYTES; \
        pf[0] = *(const u32x4*)(r_ + REC_W + (size_t)tid * 16); pf[1] = *(const u32x4*)(r_ + REC_W + (size_t)(tid + 512) * 16); \
        pf[2] = *(const u32x4*)(r_ + REC_KT + (size_t)tid * 16); pf[3] = *(const u32x4*)(r_ + REC_KT + (size_t)(tid + 512) * 16); \
        if (tid < 16) pfg = *(const u32x4*)(r_ + REC_G + tid * 16); \
        pu[0] = *(const u32x4*)(r_ + REC_U + (size_t)(sl * 64 + lane) * 32); pu[1] = *(const u32x4*)(r_ + REC_U + (size_t)(sl * 64 + lane) * 32 + 16); } while (0)
#define SC_STORE(buf) do { LAS unsigned char* d_ = lds + (buf) * SC_BUF; \
        _Pragma("unroll") for (int k_ = 0; k_ < 2; ++k_) { const int pc_ = tid + 512 * k_; *(LAS u32x4*)(d_ + SC_W + (pc_ >> 4) * 272 + (pc_ & 15) * 16) = pf[k_]; \
            *(LAS u32x4*)(d_ + SC_KT + (pc_ >> 3) * 144 + (pc_ & 7) * 16) = pf[2 + k_]; } \
        if (tid < 16) *(LAS u32x4*)(d_ + SC_G + tid * 16) = pfg; } while (0)
    f32x4 S[8];
#pragma unroll
    for (int i = 0; i < 8; ++i) S[i] = (f32x4){0.f, 0.f, 0.f, 0.f};
    __syncthreads();
    SC_LOAD(0); SC_STORE(0);
    u32x4 cu[2]; cu[0] = pu[0]; cu[1] = pu[1];
    __syncthreads();
    for (int n = 0; n < 64; ++n) {
        const LAS unsigned char* L = lds + (n & 1) * SC_BUF;
        if (n + 1 < 64) SC_LOAD(n + 1);
        if (wave < 4) {
            bf16x8 Sb[4];
#pragma unroll
            for (int ks = 0; ks < 4; ++ks) { Sb[ks] = pack_frag(S[2 * ks], S[2 * ks + 1]); S0F[(size_t)((n * 8 + sl) * 4 + ks) * 64 + lane] = __builtin_bit_cast(u32x4, Sb[ks]); }
            f32x4 a1[4];
#pragma unroll
            for (int mt = 0; mt < 4; ++mt) { a1[mt] = (f32x4){0.f, 0.f, 0.f, 0.f};
#pragma unroll
                for (int ks = 0; ks < 4; ++ks) a1[mt] = mfma16(ld_frag8x2(L + SC_W + (16 * mt + li) * 272 + (32 * ks + 4 * q) * 2), Sb[ks], a1[mt]); }
            const float g63 = *(const LAS float*)(L + SC_G + 63 * 4);
            f32x4 vn[4], vd[4];
#pragma unroll
            for (int mt = 0; mt < 4; ++mt) { const f32x4 gi = *(const LAS f32x4*)(L + SC_G + (16 * mt + 4 * q) * 4);
                const unsigned ulo = (mt < 2) ? (mt == 0 ? cu[0].x : cu[0].z) : (mt == 2 ? cu[1].x : cu[1].z), uhi = (mt < 2) ? (mt == 0 ? cu[0].y : cu[0].w) : (mt == 2 ? cu[1].y : cu[1].w);
                const f32x4 uu = (f32x4){bf_lo(ulo), bf_hi(ulo), bf_lo(uhi), bf_hi(uhi)};
                vn[mt] = uu - a1[mt];
#pragma unroll
                for (int r = 0; r < 4; ++r) vd[mt][r] = vn[mt][r] * fexp(g63 - gi[r]); }
            bf16x8 Vb[2], Vd[2];
#pragma unroll
            for (int ks = 0; ks < 2; ++ks) { Vb[ks] = pack_frag(vn[2 * ks], vn[2 * ks + 1]); Vd[ks] = pack_frag(vd[2 * ks], vd[2 * ks + 1]); }
            { unsigned char* ru = rec0 + (size_t)n * REC_BYTES + REC_U + (size_t)(sl * 64 + lane) * 32;
                *(u32x4*)ru = __builtin_bit_cast(u32x4, Vb[0]); *(u32x4*)(ru + 16) = __builtin_bit_cast(u32x4, Vb[1]); }
            const float eg = fexp(g63);
#pragma unroll
            for (int mt = 0; mt < 8; ++mt) { f32x4 a4 = (f32x4){0.f, 0.f, 0.f, 0.f};
#pragma unroll
                for (int ks = 0; ks < 2; ++ks) a4 = mfma16(ld_frag8x2(L + SC_KT + (16 * mt + li) * 144 + (32 * ks + 4 * q) * 2), Vd[ks], a4);
                S[mt] = S[mt] * eg + a4; }
        }
        if (n + 1 < 64) { SC_STORE((n + 1) & 1); cu[0] = pu[0]; cu[1] = pu[1]; }
        __syncthreads();
    }
#undef SC_LOAD
#undef SC_STORE
}
constexpr int CO_Q = 0, CO_ATT = 17408, CO_G = 26624, CO_PART = 26880;
__device__ __forceinline__ void gdn_chunk_out(const Params& p, int layer, LAS unsigned char* lds, int tid, int wave, int lane) {
    const bf16* H = (const bf16*)(p.ws + WS_H); bf16* YS = (bf16*)(p.ws + WS_YS);
    const int q = lane >> 4, li = lane & 15;
    const f32x4 nw = *(const f32x4*)(p.in[I_GNW] + layer * 128 + 16 * wave + 4 * q);
    LAS float* part = (LAS float*)(lds + CO_PART);
    for (int unit = blockIdx.x; unit < 2048; unit += gridDim.x) {
        const int n = unit & 63, bh = unit >> 6, hh = bh & 3, b = bh >> 2; const int m0 = b * T + n * 64;
        const unsigned char* rec = p.ws + WS_REC + (size_t)(bh * 64 + n) * REC_BYTES;
        const u32x4* S0F = (const u32x4*)(p.ws + WS_OBUF) + (size_t)((bh * 64 + n) * 8 + wave) * 4 * 64;
        const u32x4 rq0 = *(const u32x4*)(rec + REC_Q + (size_t)tid * 16), rq1 = *(const u32x4*)(rec + REC_Q + (size_t)(tid + 512) * 16), ra = *(const u32x4*)(rec + REC_ATT + (size_t)tid * 16);
        u32x4 rg = (u32x4){0u, 0u, 0u, 0u}; if (tid < 16) rg = *(const u32x4*)(rec + REC_G + tid * 16);
        bf16x8 sf[4], vf[2];
#pragma unroll
        for (int ks = 0; ks < 4; ++ks) sf[ks] = __builtin_bit_cast(bf16x8, S0F[ks * 64 + lane]);
        vf[0] = __builtin_bit_cast(bf16x8, *(const u32x4*)(rec + REC_U + (size_t)(wave * 64 + lane) * 32)); vf[1] = __builtin_bit_cast(bf16x8, *(const u32x4*)(rec + REC_U + (size_t)(wave * 64 + lane) * 32 + 16));
        u32x2 zr[4];
#pragma unroll
        for (int mt = 0; mt < 4; ++mt) zr[mt] = *(const u32x2*)(H + (size_t)(m0 + 16 * mt + li) * DH + HZ + hh * 128 + 16 * wave + 4 * q);
        __syncthreads();
        *(LAS u32x4*)(lds + CO_Q + (tid >> 4) * 272 + (tid & 15) * 16) = rq0; *(LAS u32x4*)(lds + CO_Q + ((tid + 512) >> 4) * 272 + (tid & 15) * 16) = rq1;
        *(LAS u32x4*)(lds + CO_ATT + (tid >> 3) * 144 + (tid & 7) * 16) = ra;
        if (tid < 16) *(LAS u32x4*)(lds + CO_G + tid * 16) = rg;
        __syncthreads();
        f32x4 o[4]; float ss[4];
#pragma unroll
        for (int mt = 0; mt < 4; ++mt) { f32x4 a2 = (f32x4){0.f, 0.f, 0.f, 0.f}, a3 = (f32x4){0.f, 0.f, 0.f, 0.f};
#pragma unroll
            for (int ks = 0; ks < 4; ++ks) a2 = mfma16(sf[ks], ld_frag8x2(lds + CO_Q + (16 * mt + li) * 272 + (32 * ks + 4 * q) * 2), a2);
#pragma unroll
            for (int ks = 0; ks < 2; ++ks) a3 = mfma16(vf[ks], ld_frag8x2(lds + CO_ATT + (16 * mt + li) * 144 + (32 * ks + 4 * q) * 2), a3);
            const float gam = fexp(*(const LAS float*)(lds + CO_G + (16 * mt + li) * 4));
            o[mt] = a2 * gam + a3;
            float s = (o[mt][0] * o[mt][0] + o[mt][1] * o[mt][1]) + (o[mt][2] * o[mt][2] + o[mt][3] * o[mt][3]);
            s += __shfl_xor(s, 16); s += __shfl_xor(s, 32);
            if (q == 0) part[(16 * mt + li) * 8 + wave] = s; }
        __syncthreads();
#pragma unroll
        for (int mt = 0; mt < 4; ++mt) { const f32x4 pa = *(const LAS f32x4*)(part + (16 * mt + li) * 8), pb = *(const LAS f32x4*)(part + (16 * mt + li) * 8 + 4);
            ss[mt] = ((pa[0] + pa[1]) + (pa[2] + pa[3])) + ((pb[0] + pb[1]) + (pb[2] + pb[3]));
            const float rs = __builtin_amdgcn_rsqf(ss[mt] * (1.0f / 128.0f) + EPS);
            u32x2 w; w.x = pk2(o[mt][0] * rs * nw[0] * siluf_(bf_lo(zr[mt].x)), o[mt][1] * rs * nw[1] * siluf_(bf_hi(zr[mt].x)));
            w.y = pk2(o[mt][2] * rs * nw[2] * siluf_(bf_lo(zr[mt].y)), o[mt][3] * rs * nw[3] * siluf_(bf_hi(zr[mt].y)));
            *(u32x2*)(YS + (size_t)(m0 + 16 * mt + li) * 2048 + hh * 128 + 16 * wave + 4 * q) = w; }
    }
    __syncthreads();
}
__device__ __forceinline__ void sum_gated(const Params& p, int gtid, int NGT) {
    const bf16* H = (const bf16*)(p.ws + WS_H); bf16* MG = (bf16*)(p.ws + WS_MERGED);
    for (int it = gtid; it < M * 128; it += NGT) { const int m = it >> 7, c8 = (it & 127) * 8; const bf16* r = H + (size_t)m * DH + HGATE + c8;
        float a[8], b[8];
        unpack8(*(const u32x4*)r, a);
#pragma unroll
        for (int br = 1; br < 4; ++br) { unpack8(*(const u32x4*)(r + br * 1024), b);
#pragma unroll
            for (int i = 0; i < 8; ++i) a[i] += b[i]; }
        *(u32x4*)(MG + (size_t)m * D + c8) = pack8(a); }
}

constexpr size_t WS_WRT = WS_MOETAB + MiB; constexpr int WRT_N = 80 * 1024;
__device__ __forceinline__ void prep_router_tables(const Params& p, int gtid, int NGT) {
    bf16* WRT = (bf16*)(p.ws + WS_WRT);
    for (int idx = gtid; idx < NLAYER * WRT_N; idx += NGT) { const int l = idx / WRT_N, n = (idx % WRT_N) >> 10, k = idx & 1023;
        const float w = (n < 64) ? p.in[I_REXP][((size_t)l * D + k) * 64 + n] : (n < 72 ? p.in[I_RGRP][((size_t)l * D + k) * 8 + (n - 64)] : 0.f);
        const unsigned hi = f2bf(w); const float wl = w - __uint_as_float(hi << 16);
        WRT[(size_t)(l * 2) * WRT_N + (idx % WRT_N)] = (bf16)hi; WRT[(size_t)(l * 2 + 1) * WRT_N + (idx % WRT_N)] = (bf16)f2bf(wl); }
}
__device__ __forceinline__ void moe_route_vb(const Params& p, int layer, LAS unsigned char* lds, int tid, int wave, int lane, int vb, const f32x4 (&nw)[4]) {
    LAS int* hist = (LAS int*)(lds + LDSCTL_OFF + LC_TAB);
    bf16* XN = (bf16*)(p.ws + WS_XN);
    int* route_e = (int*)(p.ws + WS_ROUTE); float* route_w = (float*)(p.ws + WS_ROUTE + (size_t)M * 2 * 4);
    int* cnt = (int*)(p.ws + WS_MOETAB + (size_t)NROWS_MAX * 8);
    const bf16* Wh = (const bf16*)(p.ws + WS_WRT) + (size_t)(layer * 2) * WRT_N; const bf16* Wl = Wh + WRT_N;
    const int q = lane >> 4, li = lane & 15;
    __syncthreads();
    if (tid < 64) hist[tid] = 0;
    for (int tile = 0; tile < 4; ++tile) {
        const int m0 = vb * 128 + tile * 32;
        __syncthreads();
        for (int hb = 0; hb < 2; ++hb) {
        f32x4 v[2][4];
#pragma unroll
        for (int rr = 0; rr < 2; ++rr)
#pragma unroll
            for (int j = 0; j < 4; ++j) v[rr][j] = *(const f32x4*)(p.out + (size_t)(m0 + wave * 4 + hb * 2 + rr) * D + 4 * lane + 256 * j);
#pragma unroll
        for (int rr = 0; rr < 2; ++rr) { const int r = wave * 4 + hb * 2 + rr, m = m0 + r; float ss = 0.f;
#pragma unroll
            for (int j = 0; j < 4; ++j) ss += (v[rr][j][0] * v[rr][j][0] + v[rr][j][1] * v[rr][j][1]) + (v[rr][j][2] * v[rr][j][2] + v[rr][j][3] * v[rr][j][3]);
            const float rs = __builtin_amdgcn_rsqf(wave_sum(ss) * (1.0f / D) + EPS);
#pragma unroll
            for (int j = 0; j < 4; ++j) { const f32x4 x = v[rr][j] * rs * nw[j];
                u32x2 h; h.x = pk2(x[0], x[1]); h.y = pk2(x[2], x[3]);
                u32x2 l; l.x = pk2(x[0] - bf_lo(h.x), x[1] - bf_hi(h.x)); l.y = pk2(x[2] - bf_lo(h.y), x[3] - bf_hi(h.y));
                *(u32x2*)(XN + (size_t)m * D + 4 * lane + 256 * j) = h;
                const int off = r * 2048 + ((((lane >> 1) + 32 * j) ^ (r & 15)) << 4) + (lane & 1) * 8;
                *(LAS u32x2*)(lds + off) = h; *(LAS u32x2*)(lds + 65536 + off) = l; } }
        }
        __syncthreads();
        f32x4 acc[2][5];
#pragma unroll
        for (int mt = 0; mt < 2; ++mt)
#pragma unroll
            for (int nt = 0; nt < 5; ++nt) acc[mt][nt] = (f32x4){0.f, 0.f, 0.f, 0.f};
        {
            const bf16* bp = Wh + (size_t)li * 1024 + 128 * wave + 8 * q;
#pragma unroll
            for (int ks = 0; ks < 4; ++ks) {
                bf16x8 ah[2], al[2];
#pragma unroll
                for (int mt = 0; mt < 2; ++mt) { const int off = (16 * mt + li) * 2048 + (((16 * wave + 4 * ks + q) ^ li) << 4); ah[mt] = ld_frag16(lds + off); al[mt] = ld_frag16(lds + 65536 + off); }
#pragma unroll
                for (int nt = 0; nt < 5; ++nt) { const bf16x8 bh = *(const bf16x8*)(bp + nt * 16384 + 32 * ks), bl = *(const bf16x8*)(bp + WRT_N + nt * 16384 + 32 * ks);
#pragma unroll
                    for (int mt = 0; mt < 2; ++mt) { acc[mt][nt] = mfma16(ah[mt], bh, acc[mt][nt]); acc[mt][nt] = mfma16(al[mt], bh, acc[mt][nt]); acc[mt][nt] = mfma16(ah[mt], bl, acc[mt][nt]); } }
            }
        }
        __syncthreads();
        LAS float* part = (LAS float*)lds;
#pragma unroll
        for (int mt = 0; mt < 2; ++mt)
#pragma unroll
            for (int nt = 0; nt < 5; ++nt) { if (16 * nt + li < 72) {
#pragma unroll
                for (int r = 0; r < 4; ++r) part[(wave * 32 + 16 * mt + 4 * q + r) * 72 + 16 * nt + li] = acc[mt][nt][r]; } }
        __syncthreads();
        for (int r = wave * 4; r < wave * 4 + 4; ++r) { const int m = m0 + r;
            float le = 0.f, lg = 0.f;
#pragma unroll
            for (int w = 0; w < 8; ++w) { le += part[(w * 32 + r) * 72 + lane]; lg += part[(w * 32 + r) * 72 + 64 + (lane & 7)]; }
            float gv[8];
#pragma unroll
            for (int i = 0; i < 8; ++i) gv[i] = __shfl(lg, i);
            int grp = 0; float gmax = gv[0];
#pragma unroll
            for (int i = 1; i < 8; ++i) if (gv[i] > gmax) { gmax = gv[i]; grp = i; }
            float gs = 0.f;
#pragma unroll
            for (int i = 0; i < 8; ++i) gs += __expf(gv[i] - gmax);
            const float psel = 1.0f / gs;
            float ev[8];
#pragma unroll
            for (int i = 0; i < 8; ++i) ev[i] = __shfl(le, grp * 8 + i);
            int i1 = 0; float e1 = ev[0];
#pragma unroll
            for (int i = 1; i < 8; ++i) if (ev[i] > e1) { e1 = ev[i]; i1 = i; }
            int i2 = -1; float e2 = -3.0e38f;
#pragma unroll
            for (int i = 0; i < 8; ++i) if (i != i1 && ev[i] > e2) { e2 = ev[i]; i2 = i; }
            const float x2 = __expf(e2 - e1), w1 = psel / (1.0f + x2), w2 = psel * x2 / (1.0f + x2);
            if (lane == 0) { route_e[(size_t)m * 2] = grp * 8 + i1; route_e[(size_t)m * 2 + 1] = grp * 8 + i2; route_w[(size_t)m * 2] = w1; route_w[(size_t)m * 2 + 1] = w2;
                atomicAdd((int*)(hist + grp * 8 + i1), 1); atomicAdd((int*)(hist + grp * 8 + i2), 1); }
        }
    }
    __syncthreads();
    if (tid < 64) cnt[vb * 64 + tid] = hist[tid];
}
__device__ __forceinline__ void moe_route(const Params& p, int layer, LAS unsigned char* lds, int tid, int wave, int lane) {
    f32x4 nw[4];
#pragma unroll
    for (int j = 0; j < 4; ++j) nw[j] = *(const f32x4*)(p.in[I_MOENW] + layer * D + 4 * lane + 256 * j);
    for (int vb = blockIdx.x; vb < M / 128; vb += gridDim.x) moe_route_vb(p, layer, lds, tid, wave, lane, vb, nw);
    __syncthreads();
}
__device__ __forceinline__ void moe_dispatch(const Params& p, LAS unsigned char* lds, int tid, int wave, int lane) {
    LAS int* tab = (LAS int*)(lds + LDSCTL_OFF + LC_TAB);
    const bf16* XN = (const bf16*)(p.ws + WS_XN); bf16* XS = (bf16*)(p.ws + WS_XS);
    const int* route_e = (const int*)(p.ws + WS_ROUTE); const float* route_w = (const float*)(p.ws + WS_ROUTE + (size_t)M * 2 * 4);
    int* row_code = (int*)(p.ws + WS_MOETAB); float* row_w = (float*)(p.ws + WS_MOETAB + (size_t)NROWS_MAX * 4);
    const int* cnt = (const int*)(p.ws + WS_MOETAB + (size_t)NROWS_MAX * 8); int* blk_e = (int*)(p.ws + WS_MOETAB + (size_t)NROWS_MAX * 8 + 256 * 64 * 4);
    for (int vb = blockIdx.x; vb < M / 128; vb += gridDim.x) {
        __syncthreads();
        if (tid < 64) { int run = 0, base = 0; for (int v = 0; v < M / 128; ++v) { if (v == vb) base = run; run += cnt[v * 64 + tid]; } tab[64 + tid] = run; tab[128 + tid] = base; }
        __syncthreads();
        if (tid == 0) { int s = 0; for (int e = 0; e < 64; ++e) { tab[e] = s; s += (tab[64 + e] + 255) / 256 * 256; } tab[704] = s; }
        if (tid < 256) tab[192 + tid] = route_e[(size_t)vb * 256 + tid];
        __syncthreads();
        if (tid < 256) { const int e = tab[192 + tid]; int rank = 0; for (int a = 0; a < tid; ++a) rank += (tab[192 + a] == e) ? 1 : 0;
            const int pos = tab[e] + tab[128 + e] + rank; tab[448 + tid] = pos;
            row_code[pos] = ((vb * 128 + (tid >> 1)) << 1) | (tid & 1); row_w[pos] = route_w[(size_t)vb * 256 + tid]; }
        if (vb < 64) { const int ps = tab[vb], tot = tab[64 + vb], pe = ps + (tot + 255) / 256 * 256;
            for (int r = ps + tot + tid; r < pe; r += 512) row_code[r] = -1;
            for (int b = ps / 256 + tid; b < pe / 256; b += 512) blk_e[b] = vb;
            if (tid == 0) { blk_e[NROWBLK_MAX + 64 + vb] = ps / 256; blk_e[NROWBLK_MAX + 128 + vb] = (pe - ps) / 256; }
            if (vb == 63 && tid == 0) blk_e[NROWBLK_MAX] = tab[704] / 256; }
        __syncthreads();
        for (int a = wave; a < 256; a += 8) { const int pos = tab[448 + a]; const int tok = vb * 128 + (a >> 1);
            const u32x4* src = (const u32x4*)(XN + (size_t)tok * D); u32x4* dst = (u32x4*)(XS + (size_t)pos * D);
            dst[lane] = src[lane]; dst[lane + 64] = src[lane + 64]; }
    }
    __syncthreads();
}

__global__ void __launch_bounds__(512, 2) fwd(Params p) {
    extern __shared__ __attribute__((aligned(16))) unsigned char lds_raw[];
    LAS unsigned char* lds = (LAS unsigned char*)lds_raw;
    const int tid0 = threadIdx.x;
    const int G = gridDim.x, NGW = G * 8, NGT = G * 512;
#define FRESH() Params pl = p; { unsigned char* w_ = pl.ws; float* o_ = pl.out; asm volatile("" : "+s"(w_), "+s"(o_)); pl.ws = w_; pl.out = o_; } int tid = tid0; asm volatile("" : "+v"(tid)); const int lane = tid & 63, wave = __builtin_amdgcn_readfirstlane(tid >> 6); const int gw = blockIdx.x * 8 + wave, gtid = blockIdx.x * 512 + tid; (void)lane; (void)gw; (void)gtid
    for (int u = tid0; u < (LDS_BYTES - LDSCTL_OFF) / 4; u += 512) ((LAS unsigned*)(lds + LDSCTL_OFF))[u] = 0u;
    __syncthreads();
    const int lo = p.ph_lo, hi = p.ph_hi;
    XcdBarrier bar; bar.bar = (unsigned*)(p.ws + WS_CTL) + CW_BAR; bar.x = 0; bar.st = (volatile LAS unsigned*)(lds + LDSCTL_OFF + LC_BAR);
    if (hi - lo > 1) bar = xcd_barrier_post((unsigned*)(p.ws + WS_CTL) + CW_BAR, (volatile LAS unsigned*)(lds + LDSCTL_OFF + LC_BAR));
#ifndef PHASE_MASK
#define PHASE_MASK 0x1fff
#endif
#define IN(k) (((PHASE_MASK >> ((k) == PH_FINAL ? 12 : ((k) % PH_PER_LAYER))) & 1) && lo <= (k) && (k) < hi)
#define REPS(k) ((((REPEAT_MASK) >> (k)) & 1) && layer == 0 ? 2 : 1)
#define SEAM(k) do { if (IN(k) && IN((k) + 1)) xcd_barrier(bar); } while (0)

    for (int layer = 0; layer < NLAYER; ++layer) {
        const int g0 = layer * PH_PER_LAYER;

        for (int rep_ = 0; rep_ < REPS(0); ++rep_) if (IN(g0 + 0)) { if (rep_) __syncthreads(); FRESH();
            if (layer == 0) { prep_static_weights(pl, gw, NGW, lane); prep_router_tables(pl, gtid, NGT); __syncthreads(); norm_phase<0>(pl, layer, lds, gw, NGW, tid, lane); }
            else norm_phase<1>(pl, layer, lds, gw, NGW, tid, lane);
        }
        SEAM(g0 + 0);
        for (int rep_ = 0; rep_ < REPS(1); ++rep_) if (IN(g0 + 1)) { if (rep_) __syncthreads(); FRESH();
            SchedH S; S.to.init(M / 256, DH / 256, G, (int)blockIdx.x); S.A = (const char*)(pl.ws + WS_XN); S.B = (const char*)(pl.ws + WS_WIN + layer * WIN_L);
            EpiStoreBf16 E{(bf16*)(pl.ws + WS_H), DH};
            pg8::gemm_phase(lds, tid, D, D, D, S, E);
        }
        SEAM(g0 + 1);
        for (int rep_ = 0; rep_ < REPS(2); ++rep_) if (IN(g0 + 2)) { if (rep_) __syncthreads(); FRESH(); gdn_chunk_prep(pl, layer, lds, tid, wave, lane); }
        SEAM(g0 + 2);
        for (int rep_ = 0; rep_ < REPS(3); ++rep_) if (IN(g0 + 3)) { if (rep_) __syncthreads(); FRESH();
            if ((int)blockIdx.x < 64) gdn_chunk_scan(pl, lds, tid, wave, lane, (int)blockIdx.x >> 1, (int)blockIdx.x & 1);
            {
                unsigned* qc = (unsigned*)(pl.ws + WS_CTL) + CW_QUEUE + layer * 256;
                gmlp(pl, layer, lds, tid, wave, lane, qc);
                conformer(pl, layer, lds, tid, wave, lane, qc + 64);
                for (;;) { const int unit = queue_pop(qc + 128, lds, tid); if (unit >= M / 128) break; shortconv_unit(pl, layer, tid, unit); }
            }
        }
        SEAM(g0 + 3);
        for (int rep_ = 0; rep_ < REPS(4); ++rep_) if (IN(g0 + 4)) { if (rep_) __syncthreads(); FRESH(); gdn_chunk_out(pl, layer, lds, tid, wave, lane); }
        SEAM(g0 + 4);
        for (int rep_ = 0; rep_ < REPS(5); ++rep_) if (IN(g0 + 5)) { if (rep_) __syncthreads(); FRESH();
            SchedBranch S; S.to.init(M / 256, 4, G, (int)blockIdx.x); S.YS = (const char*)(pl.ws + WS_YS); S.WBR = (const char*)(pl.ws + WS_WBR + layer * WBR_L);
            EpiGate E{(bf16*)(pl.ws + WS_H) + HGATE, (bf16*)(pl.ws + WS_MERGED)};
            pg8::gemm_phase(lds, tid, 512, 2048, 512, S, E);
        }
        for (int rep_ = 0; rep_ < REPS(6); ++rep_) if (IN(g0 + 6)) { if (rep_) __syncthreads(); FRESH();   }
        SEAM(g0 + 6);
        for (int rep_ = 0; rep_ < REPS(7); ++rep_) if (IN(g0 + 7)) { if (rep_) __syncthreads(); FRESH();
            const int NGB = G / 2;
            if ((int)blockIdx.x < NGB) {
                SchedOut S; S.to.init(M / 256, 4, NGB, (int)blockIdx.x); S.A = (const char*)(pl.ws + WS_MERGED); S.B = (const char*)(pl.ws + WS_WOUT + layer * WOUT_L);
                EpiResF32 E{layer == 0 ? pl.in[I_X] : pl.out, pl.out};
                pg8::gemm_phase(lds, tid, D, D, D, S, E);
            } else prep_moe_weights(pl, layer, ((int)blockIdx.x - NGB) * 8 + wave, (G - NGB) * 8, lane);
        }
        SEAM(g0 + 7);
        for (int rep_ = 0; rep_ < REPS(8); ++rep_) if (IN(g0 + 8)) { if (rep_) __syncthreads(); FRESH(); moe_route(pl, layer, lds, tid, wave, lane); }
        SEAM(g0 + 8);
        for (int rep_ = 0; rep_ < REPS(9); ++rep_) if (IN(g0 + 9)) { if (rep_) __syncthreads(); FRESH(); moe_dispatch(pl, lds, tid, wave, lane); }
        SEAM(g0 + 9);
        if (IN(g0 + 10) || IN(g0 + 11)) { FRESH();
            LAS int* tb = (LAS int*)(lds + LDSCTL_OFF + LC_TAB);
            const int* est = (const int*)(pl.ws + WS_MOETAB + (size_t)NROWS_MAX * 8 + 256 * 64 * 4) + NROWBLK_MAX + 64;
            const int NX = (G % 8 == 0) ? 8 : 1, x = (int)blockIdx.x % NX, nk = 64 / NX;
            __syncthreads();
            if (tid < nk) { tb[160 + tid] = est[x + NX * tid]; tb[240 + tid] = est[64 + x + NX * tid]; }
            __syncthreads();
            if (tid == 0) { int s = 0; for (int k = 0; k < nk; ++k) { tb[k] = s; tb[80 + k] = tb[160 + k]; s += tb[240 + k] * 4; } tb[nk] = s; }
            __syncthreads();
        }
        for (int rep_ = 0; rep_ < REPS(10); ++rep_) if (IN(g0 + 10)) { if (rep_) __syncthreads(); FRESH();
            LAS int* tb = (LAS int*)(lds + LDSCTL_OFF + LC_TAB); const int NX = (G % 8 == 0) ? 8 : 1, nk = 64 / NX;
            SchedMoe S; S.nux = tb[nk]; S.nrank = G / NX; S.rank = (int)blockIdx.x / NX; S.nk = nk; S.x = (int)blockIdx.x % NX; S.NX = NX; S.cum = tb; S.rb0 = tb + 80;
            S.A = (const char*)(pl.ws + WS_XS); S.a_blk = (size_t)256 * D * 2; S.W = (const char*)(pl.ws + WS_MOEW); S.w_e = WGU_E; S.w_pn = (size_t)256 * D * 2; S.cmul = 128;
            EpiSwiglu E{(bf16*)(pl.ws + WS_HB)};
            pg8::gemm_phase(lds, tid, D, D, D, S, E);
        }
        SEAM(g0 + 10);
        for (int rep_ = 0; rep_ < REPS(11); ++rep_) if (IN(g0 + 11)) { if (rep_) __syncthreads(); FRESH();
            LAS int* tb = (LAS int*)(lds + LDSCTL_OFF + LC_TAB); const int NX = (G % 8 == 0) ? 8 : 1, nk = 64 / NX;
            SchedMoe S; S.nux = tb[nk]; S.nrank = G / NX; S.rank = (int)blockIdx.x / NX; S.nk = nk; S.x = (int)blockIdx.x % NX; S.NX = NX; S.cum = tb; S.rb0 = tb + 80;
            S.A = (const char*)(pl.ws + WS_HB); S.a_blk = (size_t)256 * DE * 2; S.W = (const char*)(pl.ws + WS_WD); S.w_e = WD_E; S.w_pn = (size_t)256 * DE * 2; S.cmul = 256;
            EpiScatter E{(bf16*)(pl.ws + WS_Y), (const int*)(pl.ws + WS_MOETAB), (const float*)(pl.ws + WS_MOETAB + (size_t)NROWS_MAX * 4)};
            pg8::gemm_phase(lds, tid, DE, DE, DE, S, E);
        }
        SEAM(g0 + 11);
    }
    if (IN(PH_FINAL)) { FRESH(); norm_phase<2>(pl, 0, lds, gw, NGW, tid, lane); }
#undef IN
#undef SEAM
}

extern "C" void kernel_launch(void* const* d_in, const int* in_sizes, int n_in, void* d_out, int out_size, void* d_ws, size_t ws_size, hipStream_t stream) {
    static int grid = 0;
    if (grid == 0) {
        if (n_in != 25 || out_size != M * D || ws_size < WS_END) { fprintf(stderr, "kernel_launch: unexpected shapes / workspace (n_in %d out %d ws %zu, need %zu)\n", n_in, out_size, ws_size, (size_t)WS_END); grid = -1; return; }
        int dev = 0, cus = 0, per_cu = 0;
        if (hipGetDevice(&dev) != hipSuccess || hipDeviceGetAttribute(&cus, hipDeviceAttributeMultiprocessorCount, dev) != hipSuccess) { grid = -1; return; }
        if (hipFuncSetAttribute((const void*)fwd, hipFuncAttributeMaxDynamicSharedMemorySize, LDS_BYTES) != hipSuccess) { fprintf(stderr, "kernel_launch: hipFuncSetAttribute failed\n"); grid = -1; return; }
        if (hipOccupancyMaxActiveBlocksPerMultiprocessor(&per_cu, (const void*)fwd, 512, LDS_BYTES) != hipSuccess || per_cu < 1) { fprintf(stderr, "kernel_launch: occupancy query says %d\n", per_cu); }
        (void)hipGetLastError();
        grid = cus;
    }
    if (grid < 0) return;
    hipMemsetAsync((char*)d_ws + WS_CTL, 0, CTL_BYTES, stream);
    Params p{};
    for (int i = 0; i < 25; ++i) p.in[i] = (const float*)d_in[i];
    p.out = (float*)d_out; p.ws = (unsigned char*)d_ws;
#if N_LAUNCH_MODE == 1
    p.ph_lo = 0; p.ph_hi = PH_TOTAL;
    hipLaunchKernelGGL(fwd, dim3(grid), dim3(512), LDS_BYTES, stream, p);
#else
    for (int k = 0; k < PH_TOTAL; ++k) { p.ph_lo = k; p.ph_hi = k + 1; hipLaunchKernelGGL(fwd, dim3(grid), dim3(512), LDS_BYTES, stream, p); }
#endif
}
```

```cpp
#include <hip/hip_runtime.h>
#include <cstdio>
#include <cstdint>

#ifndef REPEAT_MASK
#define REPEAT_MASK 0
#endif
#ifndef N_LAUNCH_MODE
#define N_LAUNCH_MODE 1
#endif

#define LAS __attribute__((address_space(3)))
typedef unsigned short bf16;
typedef short bf16x8 __attribute__((ext_vector_type(8)));
typedef float f32x4 __attribute__((ext_vector_type(4)));
typedef float f32x2 __attribute__((ext_vector_type(2)));
typedef unsigned u32x4 __attribute__((ext_vector_type(4)));
typedef unsigned u32x2 __attribute__((ext_vector_type(2)));

constexpr int NB = 8, T = 4096, D = 1024, M = NB * T, NLAYER = 2;
constexpr int DIN = 9736, DH = 9728;
constexpr int HQ = 0, HK = 512, HV = 1024, HZ = 1536, HCONF = 2048, HGMLP = 3072, HSC = 4096, HGATE = 5632;
constexpr int NE = 64, DE = 512;
constexpr float EPS = 1e-6f;
constexpr int NROWBLK_MAX = 320, NROWS_MAX = NROWBLK_MAX * 256;

constexpr size_t MiB = 1u << 20;
constexpr size_t WS_CTL = 0, CTL_BYTES = 1 * MiB;
constexpr size_t WS_WIN = 2 * MiB;
constexpr size_t WIN_L = (size_t)DH * D * 2;
constexpr size_t WS_WBR = 40 * MiB;
constexpr size_t WBR_L = (size_t)4 * D * 512 * 2;
constexpr size_t WS_WOUT = 48 * MiB;
constexpr size_t WOUT_L = (size_t)D * D * 2;
constexpr size_t WS_XN = 52 * MiB;
constexpr size_t WS_SMALL = 116 * MiB;
constexpr size_t WS_ROUTE = 117 * MiB;
constexpr size_t WS_MOETAB = 118 * MiB;
constexpr size_t WS_YS = 120 * MiB;
constexpr size_t WS_REC = 248 * MiB;
constexpr size_t WS_MERGED = WS_REC;
constexpr size_t WS_OBUF = WS_XN;
constexpr int REC_W = 0, REC_Q = 16384, REC_ATT = 32768, REC_KT = 40960, REC_U = 57344, REC_G = 73728, REC_BYTES = 73984;
static_assert(WS_REC + (size_t)2048 * REC_BYTES <= 410 * MiB, "chunk records");
constexpr size_t WS_H = 410 * MiB;
constexpr size_t WS_MOEW = 410 * MiB;
constexpr size_t WGU_E = (size_t)1024 * 1024 * 2, WD_E = (size_t)1024 * 512 * 2;
constexpr size_t WS_WD = WS_MOEW + 64 * WGU_E;
constexpr size_t WS_XS = 602 * MiB;
constexpr size_t WS_HB = 762 * MiB;
constexpr size_t WS_Y = 842 * MiB;
constexpr size_t WS_END = 1018 * MiB;
static_assert(WS_H + (size_t)M * DH * 2 <= WS_END && WS_Y + (size_t)2 * M * D * 2 <= WS_END, "ws map");

constexpr int CW_BAR = 4096;
constexpr int CW_QUEUE = 16384;
constexpr int STAGE_LDS = 131072, LDSCTL_OFF = 131072, LDS_BYTES = 147456;
constexpr int LC_BAR = 0;
constexpr int LC_MISC = 64;
constexpr int LC_TAB = 1024;

__device__ __forceinline__ float bf_lo(unsigned w) { return __uint_as_float(w << 16); }
__device__ __forceinline__ float bf_hi(unsigned w) { return __uint_as_float(w & 0xffff0000u); }
__device__ __forceinline__ float bf2f(bf16 b) { return __uint_as_float(((unsigned)b) << 16); }
__device__ __forceinline__ unsigned f2bf(float f) { unsigned u = __float_as_uint(f); return (u + 0x7fffu + ((u >> 16) & 1u)) >> 16; }
__device__ __forceinline__ unsigned pk2(float lo, float hi) { return f2bf(lo) | (f2bf(hi) << 16); }
__device__ __forceinline__ void unpack8(const u32x4 v, float (&f)[8]) {
    f[0] = bf_lo(v.x); f[1] = bf_hi(v.x); f[2] = bf_lo(v.y); f[3] = bf_hi(v.y); f[4] = bf_lo(v.z); f[5] = bf_hi(v.z); f[6] = bf_lo(v.w); f[7] = bf_hi(v.w);
}
__device__ __forceinline__ u32x4 pack8(const float (&f)[8]) { u32x4 o; o.x = pk2(f[0], f[1]); o.y = pk2(f[2], f[3]); o.z = pk2(f[4], f[5]); o.w = pk2(f[6], f[7]); return o; }
__device__ __forceinline__ float wave_sum(float v) {
#pragma unroll
    for (int o = 1; o < 64; o <<= 1) v += __shfl_xor(v, o);
    return v;
}
__device__ __forceinline__ float fexp(float x) { return __builtin_amdgcn_exp2f(x * 1.4426950408889634f); }
__device__ __forceinline__ float frcp(float x) { return __builtin_amdgcn_rcpf(x); }
__device__ __forceinline__ float sigmoidf_(float x) { return frcp(1.0f + fexp(-x)); }
__device__ __forceinline__ float siluf_(float x) { return x * frcp(1.0f + fexp(-x)); }
__device__ __forceinline__ float gelu_tanh(float x) { const float u = 0.7978845608028654f * (x + 0.044715f * x * x * x); return x * frcp(1.0f + fexp(-2.0f * u)); }
__device__ __forceinline__ float softplusf_(float x) { return fmaxf(x, 0.f) + log1pf(__expf(-fabsf(x))); }

#define XB_TMO      128
#define XB_XCNT(j)  (256  + 64 * (j))
#define XB_XSUB(j)  (1280 + 64 * (j))
#define XB_XGEN(j)  (2304 + 64 * (j))
#define XB_TOP      3328
#define XB_TOPGEN   3392
#define XCD_BAR_WORDS 3456
#define XB_SPIN_CAP (1u << 18)
__device__ __forceinline__ unsigned xb_ld(unsigned* p)              { return __hip_atomic_load(p, __ATOMIC_RELAXED, __HIP_MEMORY_SCOPE_AGENT); }
__device__ __forceinline__ unsigned xb_add(unsigned* p, unsigned v) { return __hip_atomic_fetch_add(p, v, __ATOMIC_RELAXED, __HIP_MEMORY_SCOPE_AGENT); }
__device__ __forceinline__ unsigned xb_xcc_id() { return (unsigned)__builtin_amdgcn_s_getreg((3 << 11) | 20) & 0xFu; }
#define XB_SPIN(cond, bar) do { unsigned _sp = 0; while (cond) { __builtin_amdgcn_s_sleep(1); \
    if ((++_sp & 255u) == 0u) { if (xb_ld(&(bar)[XB_TMO])) break; if (_sp > XB_SPIN_CAP) { atomicAdd(&(bar)[XB_TMO], 1u); break; } } } } while (0)
struct XcdBarrier { unsigned* bar; unsigned x; volatile LAS unsigned* st; };
__device__ __forceinline__ XcdBarrier xcd_barrier_post(unsigned* bar, volatile LAS unsigned* st) {
    XcdBarrier b; b.bar = bar; b.x = xb_xcc_id(); b.st = st;
    if (threadIdx.x == 0) (void)xb_add(&bar[XB_XCNT(b.x)], 1u);
    return b;
}
__device__ __forceinline__ void xcd_barrier_complete(unsigned* bar, unsigned x, unsigned& nloc, unsigned& nx) {
    const unsigned G = gridDim.x * gridDim.y * gridDim.z;
    unsigned sum, cnt, mine, sp = 0u;
    for (;;) {
        sum = 0u; cnt = 0u; mine = 0u;
#pragma unroll
        for (unsigned j = 0; j < 16; ++j) { const unsigned c = xb_ld(&bar[XB_XCNT(j)]); sum += c; cnt += (c > 0u) ? 1u : 0u; mine = (j == x) ? c : mine; }
        if (sum == G) break;
        __builtin_amdgcn_s_sleep(1);
        if ((++sp & 255u) == 0u) { if (xb_ld(&bar[XB_TMO])) break; if (sp > XB_SPIN_CAP) { atomicAdd(&bar[XB_TMO], 1u); break; } }
    }
    nloc = mine > 0u ? mine : 1u; nx = cnt > 0u ? cnt : 1u;
}
__device__ __forceinline__ void xcd_barrier(const XcdBarrier& b) {
    asm volatile("s_waitcnt vmcnt(0)" ::: "memory");
    __syncthreads();
    if (threadIdx.x == 0) {
        unsigned* bar = b.bar;
        __builtin_amdgcn_s_waitcnt(0);
        unsigned nloc = b.st[0], nx = b.st[1];
        if (nloc == 0u) { xcd_barrier_complete(bar, b.x, nloc, nx); b.st[0] = nloc; b.st[1] = nx; }
        const unsigned old = xb_add(&bar[XB_XSUB(b.x)], 1u);
        const unsigned gen = old / nloc;
        if (old + 1u == (gen + 1u) * nloc) {
            __builtin_amdgcn_fence(__ATOMIC_RELEASE, "agent");
            asm volatile("s_waitcnt vmcnt(0)" ::: "memory");
            const unsigned og = xb_add(&bar[XB_TOP], 1u);
            const unsigned tg = og / nx;
            if (og + 1u == (tg + 1u) * nx) xb_add(&bar[XB_TOPGEN], 1u);
            else XB_SPIN(xb_ld(&bar[XB_TOPGEN]) == tg, bar);
            __builtin_amdgcn_fence(__ATOMIC_ACQUIRE, "agent");
            xb_add(&bar[XB_XGEN(b.x)], 1u);
            asm volatile("s_waitcnt vmcnt(0)" ::: "memory");
        } else {
            XB_SPIN(xb_ld(&bar[XB_XGEN(b.x)]) == gen, bar);
            __builtin_amdgcn_fence(__ATOMIC_ACQUIRE, "agent");
            asm volatile("s_waitcnt vmcnt(0)" ::: "memory");
        }
    }
    __syncthreads();
}

namespace pg8 {
constexpr int BM = 256, BK = 64, HALF = 128, HTB = HALF * BK * 2, STAGE_BYTES = 8 * HTB, NXCD = 8, WGM = 8;
__host__ __device__ __forceinline__ int lds_byte(int r, int c) { const int st = (r >> 4) * 2 + (c >> 5), rr = r & 15, cc = c & 31, ob = rr * 64 + cc * 2; return st * 1024 + (ob ^ (((ob >> 9) & 1) << 5)); }
__host__ __device__ __forceinline__ void stage_rc(int b, int& R, int& C) { const int st = b / 1024, sb = b % 1024, swz = sb ^ (((sb >> 9) & 1) << 5); R = (st >> 1) * 16 + swz / 64; C = (st & 1) * 32 + (swz % 64) / 2; }
__host__ __device__ __forceinline__ int perm32(int rho) { const int n = rho >> 4, i = rho & 15; return 8 * (i >> 2) + 4 * n + (i & 3); }

struct Unit { const char* A; const char* B; int r0, c0; };

struct TileOrder {
    int nM, nN, nwg, G, c;
    __device__ void init(int nM_, int nN_, int G_, int c_) { nM = nM_; nN = nN_; nwg = nM * nN; G = G_; c = c_; }
    __device__ bool next(int i, int& pm, int& pn) const {
        const long L = (long)i * G + c; if (L >= nwg) return false;
        int wgid = (int)L; { const int q = nwg / NXCD, r = nwg % NXCD, xcd = wgid % NXCD, off = wgid / NXCD; wgid = (xcd < r ? xcd * (q + 1) : r * (q + 1) + (xcd - r) * q) + off; }
        const int nig = WGM * nN, gid = wgid / nig, fm = gid * WGM, gsz = (nM - fm) < WGM ? (nM - fm) : WGM;
        pm = fm + ((wgid % nig) % gsz); pn = (wgid % nig) / gsz; return true;
    }
};
__device__ __forceinline__ unsigned cvt_pk_bf16(float lo, float hi) { unsigned r; asm volatile("v_cvt_pk_bf16_f32 %0, %1, %2" : "=v"(r) : "v"(lo), "v"(hi)); return r; }

template <class Epi, class Sched>
__device__ __forceinline__ void gemm_phase(LAS unsigned char* lds, const int tid, const int K, const int lda, const int ldb, const Sched& S, const Epi& E) {
    const int wid = __builtin_amdgcn_readfirstlane(tid >> 6), lane = tid & 63, wr = wid >> 2, wc = wid & 3, fr = lane & 15, fq = lane >> 4;
    const int nt = K / BK;
    unsigned voffA[2], voffB[2];
#pragma unroll
    for (int i = 0; i < 2; ++i) { int R, C; stage_rc(tid * 16 + i * 8192, R, C); const int Rb = Epi::PERM ? ((R & ~31) + perm32(R & 31)) : R;
        voffA[i] = (unsigned)(R * lda + C) * 2u; voffB[i] = (unsigned)(Rb * ldb + C) * 2u; }
    const size_t kstep = (size_t)(BK * 2);
    const size_t hstepA = (size_t)HALF * lda * 2, hstepB = (size_t)HALF * ldb * 2;
    const unsigned ldsw = (unsigned)wid * 1024u;
    const int aoff = lds_byte(wr * 64 + fr, fq * 8), boff = lds_byte(wc * 32 + fr, fq * 8);
#define PG8_SA(b, h) (((b) * 2 + (h)) * HTB)
#define PG8_SB(b, h) ((4 + (b) * 2 + (h)) * HTB)
#define PG8_STAGE(bufoff, gbase, voff) do { _Pragma("unroll") for (int _i = 0; _i < 2; ++_i) \
        __builtin_amdgcn_global_load_lds((const unsigned*)((const char*)(gbase) + (voff)[_i]), (LAS unsigned*)(lds + (bufoff) + ldsw + _i * 8192), 16, 0, 0); } while (0)
#define PG8_LDA(dst, b, h) do { _Pragma("unroll") for (int m = 0; m < 4; ++m) _Pragma("unroll") for (int k = 0; k < 2; ++k) dst[m][k] = *(const LAS bf16x8*)(lds + PG8_SA(b, h) + aoff + m * 2048 + k * 1024); } while (0)
#define PG8_LDB(dst, b, h) do { _Pragma("unroll") for (int n = 0; n < 2; ++n) _Pragma("unroll") for (int k = 0; k < 2; ++k) dst[n][k] = *(const LAS bf16x8*)(lds + PG8_SB(b, h) + boff + n * 2048 + k * 1024); } while (0)
#define PG8_MMA(ai, bj, At, Bt) do { __builtin_amdgcn_s_setprio(1); _Pragma("unroll") for (int m = 0; m < 4; ++m) _Pragma("unroll") for (int n = 0; n < 2; ++n) _Pragma("unroll") for (int k = 0; k < 2; ++k) \
        acc[ai][bj][m][n] = __builtin_amdgcn_mfma_f32_16x16x32_bf16(Bt[n][k], At[m][k], acc[ai][bj][m][n], 0, 0, 0); __builtin_amdgcn_s_setprio(0); } while (0)
#define PG8_WAIT_V(n) asm volatile("s_waitcnt vmcnt(" #n ")" ::: "memory")
#define PG8_WAIT_L(n) asm volatile("s_waitcnt lgkmcnt(" #n ")" ::: "memory")
#define PG8_BAR __builtin_amdgcn_s_barrier()
#define PG8_SCHED __builtin_amdgcn_sched_barrier(0)
    Unit cur, nxt; int ui = 0;
    if (!S.next(0, cur)) return;
    f32x4 acc[2][2][4][2];
#pragma unroll
    for (int a = 0; a < 2; ++a)
#pragma unroll
        for (int b = 0; b < 2; ++b)
#pragma unroll
            for (int m = 0; m < 4; ++m)
#pragma unroll
                for (int n = 0; n < 2; ++n) acc[a][b][m][n] = (f32x4){0.f, 0.f, 0.f, 0.f};
    bf16x8 At[4][2], B0[2][2], B1[2][2];
    const char* cA = cur.A; const char* cB = cur.B;
    PG8_STAGE(PG8_SB(0, 0), cB, voffB); PG8_STAGE(PG8_SB(0, 1), cB + hstepB, voffB); PG8_STAGE(PG8_SA(0, 0), cA, voffA); PG8_STAGE(PG8_SA(0, 1), cA + hstepA, voffA);
    if (wr == 1) PG8_BAR;
    PG8_WAIT_V(2); PG8_BAR;
    PG8_STAGE(PG8_SB(1, 0), cB + kstep, voffB); PG8_STAGE(PG8_SA(1, 0), cA + kstep, voffA); PG8_STAGE(PG8_SB(1, 1), cB + hstepB + kstep, voffB);
    PG8_WAIT_V(6); PG8_BAR;
    for (;;) {
        const bool has_next = S.next(ui + 1, nxt);
        const char* nA = has_next ? nxt.A : cA; const char* nB = has_next ? nxt.B : cB;
        for (int t = 0; t < nt; t += 2) {
            const bool last = (t == nt - 2);
            const char* a1 = cA + (size_t)(t + 1) * kstep;
            const char* a2 = last ? nA : cA + (size_t)(t + 2) * kstep; const char* b2 = last ? nB : cB + (size_t)(t + 2) * kstep;
            const char* a3 = a2 + kstep; const char* b3 = b2 + kstep;
            PG8_LDB(B0, 0, 0); PG8_LDB(B1, 0, 1); PG8_SCHED; PG8_LDA(At, 0, 0); PG8_STAGE(PG8_SA(1, 1), a1 + hstepA, voffA);
            PG8_WAIT_V(8); PG8_WAIT_L(0); PG8_BAR; PG8_MMA(0, 0, At, B0); PG8_MMA(0, 1, At, B1); PG8_BAR; PG8_SCHED;
            PG8_LDA(At, 0, 1); PG8_STAGE(PG8_SB(0, 0), b2, voffB); PG8_STAGE(PG8_SB(0, 1), b2 + hstepB, voffB); PG8_STAGE(PG8_SA(0, 0), a2, voffA);
            PG8_WAIT_V(8); PG8_WAIT_L(0); PG8_BAR; PG8_MMA(1, 0, At, B0); PG8_MMA(1, 1, At, B1); PG8_BAR; PG8_SCHED;
            PG8_LDB(B0, 1, 0); PG8_LDB(B1, 1, 1); PG8_SCHED; PG8_LDA(At, 1, 0); PG8_STAGE(PG8_SA(0, 1), a2 + hstepA, voffA);
            PG8_WAIT_V(8); PG8_WAIT_L(0); PG8_BAR; PG8_MMA(0, 0, At, B0); PG8_MMA(0, 1, At, B1); PG8_BAR; PG8_SCHED;
            PG8_LDA(At, 1, 1); PG8_STAGE(PG8_SB(1, 0), b3, voffB); PG8_STAGE(PG8_SB(1, 1), b3 + hstepB, voffB); PG8_STAGE(PG8_SA(1, 0), a3, voffA);
            PG8_WAIT_V(8); PG8_WAIT_L(0); PG8_BAR; PG8_MMA(1, 0, At, B0); PG8_MMA(1, 1, At, B1); PG8_BAR; PG8_SCHED;
        }
        if (wr == 0) PG8_BAR;
        E(acc, cur, wr, wc, fr, fq);
        if (!has_next) break;
#pragma unroll
        for (int a = 0; a < 2; ++a)
#pragma unroll
            for (int b = 0; b < 2; ++b)
#pragma unroll
                for (int m = 0; m < 4; ++m)
#pragma unroll
                    for (int n = 0; n < 2; ++n) acc[a][b][m][n] = (f32x4){0.f, 0.f, 0.f, 0.f};
        cur = nxt; cA = nA; cB = nB; ++ui;
        if (wr == 1) PG8_BAR;
    }
    PG8_WAIT_V(0);
    PG8_BAR;
#undef PG8_SA
#undef PG8_SB
#undef PG8_STAGE
#undef PG8_LDA
#undef PG8_LDB
#undef PG8_MMA
#undef PG8_WAIT_V
#undef PG8_WAIT_L
#undef PG8_BAR
#undef PG8_SCHED
}
}
using pg8::Unit;
using pg8::cvt_pk_bf16;

struct EpiStoreBf16 {
    static constexpr bool PERM = true;
    bf16* O; int ldc;
    __device__ __forceinline__ void operator()(const f32x4 (&acc)[2][2][4][2], const Unit& u, int wr, int wc, int fr, int fq) const {
        const int row0 = u.r0 + wr * 64 + fr, col0 = u.c0 + wc * 32 + 8 * fq;
#pragma unroll
        for (int ai = 0; ai < 2; ++ai)
#pragma unroll
            for (int m = 0; m < 4; ++m) { bf16* rowp = O + (size_t)(row0 + ai * 128 + m * 16) * ldc + col0;
#pragma unroll
                for (int bj = 0; bj < 2; ++bj) { const f32x4 v0 = acc[ai][bj][m][0], v1 = acc[ai][bj][m][1];
                    u32x4 w; w.x = cvt_pk_bf16(v0[0], v0[1]); w.y = cvt_pk_bf16(v0[2], v0[3]); w.z = cvt_pk_bf16(v1[0], v1[1]); w.w = cvt_pk_bf16(v1[2], v1[3]);
                    *(u32x4*)(rowp + bj * 128) = w; } }
    }
};
struct EpiGate {
    static constexpr bool PERM = true;
    const bf16* Hg; bf16* MG;
    __device__ __forceinline__ void operator()(const f32x4 (&acc)[2][2][4][2], const Unit& u, int wr, int wc, int fr, int fq) const {
        const int row0 = u.r0 + wr * 64 + fr, gcol0 = u.c0 + wc * 32 + 8 * fq, mcol0 = (u.c0 & 1023) + wc * 32 + 8 * fq; const bool first = u.c0 < 1024;
#pragma unroll
        for (int ai = 0; ai < 2; ++ai)
#pragma unroll
            for (int m = 0; m < 4; ++m) { const bf16* grow = Hg + (size_t)(row0 + ai * 128 + m * 16) * DH + gcol0; bf16* mrow = MG + (size_t)(row0 + ai * 128 + m * 16) * D + mcol0;
#pragma unroll
                for (int bj = 0; bj < 2; ++bj) { const f32x4 v0 = acc[ai][bj][m][0], v1 = acc[ai][bj][m][1];
                    const u32x4 gw = *(const u32x4*)(grow + bj * 128); float g[8], pm[8]; unpack8(gw, g);
                    if (first) {
#pragma unroll
                        for (int e = 0; e < 8; ++e) pm[e] = 0.f; }
                    else unpack8(*(const u32x4*)(mrow + bj * 128), pm);
                    u32x4 w; w.x = cvt_pk_bf16(pm[0] + sigmoidf_(g[0]) * v0[0], pm[1] + sigmoidf_(g[1]) * v0[1]); w.y = cvt_pk_bf16(pm[2] + sigmoidf_(g[2]) * v0[2], pm[3] + sigmoidf_(g[3]) * v0[3]);
                    w.z = cvt_pk_bf16(pm[4] + sigmoidf_(g[4]) * v1[0], pm[5] + sigmoidf_(g[5]) * v1[1]); w.w = cvt_pk_bf16(pm[6] + sigmoidf_(g[6]) * v1[2], pm[7] + sigmoidf_(g[7]) * v1[3]);
                    *(u32x4*)(mrow + bj * 128) = w; } }
    }
};
struct EpiResF32 {
    static constexpr bool PERM = false;
    const float* res; float* out;
    __device__ __forceinline__ void operator()(const f32x4 (&acc)[2][2][4][2], const Unit& u, int wr, int wc, int fr, int fq) const {
        const int row0 = u.r0 + wr * 64 + fr, col0 = u.c0 + wc * 32 + 4 * fq;
#pragma unroll
        for (int ai = 0; ai < 2; ++ai)
#pragma unroll
            for (int m = 0; m < 4; ++m) { const size_t ro = (size_t)(row0 + ai * 128 + m * 16) * D + col0;
#pragma unroll
                for (int bj = 0; bj < 2; ++bj)
#pragma unroll
                    for (int n = 0; n < 2; ++n) { const f32x4 r = *(const f32x4*)(res + ro + bj * 128 + n * 16); *(f32x4*)(out + ro + bj * 128 + n * 16) = r + acc[ai][bj][m][n]; } }
    }
};
struct EpiSwiglu {
    static constexpr bool PERM = true;
    bf16* O;
    __device__ __forceinline__ void operator()(const f32x4 (&acc)[2][2][4][2], const Unit& u, int wr, int wc, int fr, int fq) const {
        const int row0 = u.r0 + wr * 64 + fr, col0 = u.c0 + wc * 32 + 8 * fq;
#pragma unroll
        for (int ai = 0; ai < 2; ++ai)
#pragma unroll
            for (int m = 0; m < 4; ++m) { bf16* rowp = O + (size_t)(row0 + ai * 128 + m * 16) * DE + col0;
                const f32x4 g0 = acc[ai][0][m][0], g1 = acc[ai][0][m][1], u0 = acc[ai][1][m][0], u1 = acc[ai][1][m][1];
                u32x4 w; w.x = cvt_pk_bf16(siluf_(g0[0]) * u0[0], siluf_(g0[1]) * u0[1]); w.y = cvt_pk_bf16(siluf_(g0[2]) * u0[2], siluf_(g0[3]) * u0[3]);
                w.z = cvt_pk_bf16(siluf_(g1[0]) * u1[0], siluf_(g1[1]) * u1[1]); w.w = cvt_pk_bf16(siluf_(g1[2]) * u1[2], siluf_(g1[3]) * u1[3]);
                *(u32x4*)rowp = w; }
    }
};
struct EpiScatter {
    static constexpr bool PERM = true;
    bf16* Y; const int* row_code; const float* row_w;
    __device__ __forceinline__ void operator()(const f32x4 (&acc)[2][2][4][2], const Unit& u, int wr, int wc, int fr, int fq) const {
        const int row0 = u.r0 + wr * 64 + fr, col0 = u.c0 + wc * 32 + 8 * fq;
#pragma unroll
        for (int ai = 0; ai < 2; ++ai)
#pragma unroll
            for (int m = 0; m < 4; ++m) { const int row = row0 + ai * 128 + m * 16; const int code = row_code[row]; const float rw = row_w[row];
                if (code >= 0) { bf16* rowp = Y + (size_t)(code & 1) * ((size_t)M * D) + (size_t)(code >> 1) * D + col0;
#pragma unroll
                    for (int bj = 0; bj < 2; ++bj) { const f32x4 v0 = acc[ai][bj][m][0] * rw, v1 = acc[ai][bj][m][1] * rw;
                        u32x4 w; w.x = cvt_pk_bf16(v0[0], v0[1]); w.y = cvt_pk_bf16(v0[2], v0[3]); w.z = cvt_pk_bf16(v1[0], v1[1]); w.w = cvt_pk_bf16(v1[2], v1[3]);
                        *(u32x4*)(rowp + bj * 128) = w; } } }
    }
};

struct SchedH {
    pg8::TileOrder to; const char* A; const char* B;
    __device__ __forceinline__ bool next(int i, Unit& u) const { int pm, pn; if (!to.next(i, pm, pn)) return false;
        u.A = A + (size_t)pm * 256 * D * 2; u.B = B + (size_t)pn * 256 * D * 2; u.r0 = pm * 256; u.c0 = pn * 256; return true; }
};
struct SchedBranch {
    pg8::TileOrder to; const char* YS; const char* WBR;
    __device__ __forceinline__ bool next(int i, Unit& u) const { int pm, q; if (!to.next(i >> 2, pm, q)) return false; const int br = i & 3;
        u.A = YS + ((size_t)pm * 256 * 2048 + br * 512) * 2; u.B = WBR + ((size_t)br * D * 512 + (size_t)q * 256 * 512) * 2; u.r0 = pm * 256; u.c0 = br * 1024 + q * 256; return true; }
};
struct SchedOut {
    pg8::TileOrder to; const char* A; const char* B;
    __device__ __forceinline__ bool next(int i, Unit& u) const { int pm, pn; if (!to.next(i, pm, pn)) return false;
        u.A = A + (size_t)pm * 256 * D * 2; u.B = B + (size_t)pn * 256 * D * 2; u.r0 = pm * 256; u.c0 = pn * 256; return true; }
};
struct SchedMoe {
    int nux, nrank, rank, nk, x, NX; const LAS int* cum; const LAS int* rb0; const char* A; size_t a_blk; const char* W; size_t w_e, w_pn; int cmul;
    __device__ __forceinline__ bool next(int i, Unit& u) const { const int ui = i * nrank + rank; if (ui >= nux) return false;
        int k = 0; while (k + 1 < nk && cum[k + 1] <= ui) ++k;
        const int local = ui - cum[k], rb = rb0[k] + (local >> 2), pn = local & 3, e = x + NX * k;
        u.A = A + (size_t)rb * a_blk; u.B = W + (size_t)e * w_e + (size_t)pn * w_pn; u.r0 = rb * 256; u.c0 = pn * cmul; return true; }
};

struct Params { const float* in[25]; float* out; unsigned char* ws; int ph_lo, ph_hi; };
enum { I_X = 0, I_MIXNW, I_WIN, I_GCONV, I_GALOG, I_GDT, I_GNW, I_CCW, I_CCB, I_CLNW, I_CLNB, I_GLNW, I_GLNB, I_GWS, I_GBS, I_SCW, I_WBR, I_WOUT, I_MOENW, I_RGRP, I_REXP, I_WG, I_WU, I_WD, I_FNW };
constexpr int PH_PER_LAYER = 12, PH_FINAL = 24, PH_TOTAL = 25;

__device__ __forceinline__ void transpose_item(const float* __restrict__ W, int ldw, int srccol, bf16* __restrict__ WT, int ldt, int k0, int n0, int lane) {
    const int kq = lane & 7, nq = lane >> 3;
    f32x4 v[8][2];
#pragma unroll
    for (int r = 0; r < 8; ++r) { const float* s = W + (size_t)(k0 + 8 * kq + r) * ldw + srccol + 8 * nq; v[r][0] = *(const f32x4*)s; v[r][1] = *(const f32x4*)(s + 4); }
#pragma unroll
    for (int e = 0; e < 8; ++e) { u32x4 o; o.x = pk2(v[0][e >> 2][e & 3], v[1][e >> 2][e & 3]); o.y = pk2(v[2][e >> 2][e & 3], v[3][e >> 2][e & 3]); o.z = pk2(v[4][e >> 2][e & 3], v[5][e >> 2][e & 3]); o.w = pk2(v[6][e >> 2][e & 3], v[7][e >> 2][e & 3]);
        *(u32x4*)(WT + (size_t)(n0 + 8 * nq + e) * ldt + k0 + 8 * kq) = o; }
}
__device__ __forceinline__ void prep_static_weights(const Params& p, int gw, int NGW, int lane) {
    constexpr int I_IN = 16 * (DH / 64), I_BR = 8 * 16, I_OUT = 16 * 16, PER_L = I_IN + 4 * I_BR + I_OUT;
    for (int it = gw; it < NLAYER * PER_L; it += NGW) {
        const int l = it / PER_L; int r = it % PER_L;
        if (r < I_IN) { const int kb = r / (DH / 64), nb = r % (DH / 64), n0 = nb * 64;
            transpose_item(p.in[I_WIN] + (size_t)l * D * DIN, DIN, n0 + (n0 >= 2048 ? 8 : 0), (bf16*)(p.ws + WS_WIN + l * WIN_L), D, kb * 64, n0, lane); continue; }
        r -= I_IN;
        if (r < 4 * I_BR) { const int br = r / I_BR, q = r % I_BR, kb = q / 16, nb = q % 16;
            transpose_item(p.in[I_WBR] + ((size_t)l * 4 + br) * 512 * D, D, nb * 64, (bf16*)(p.ws + WS_WBR + l * WBR_L) + (size_t)br * D * 512, 512, kb * 64, nb * 64, lane); continue; }
        r -= 4 * I_BR;
        { const int kb = r / 16, nb = r % 16;
            transpose_item(p.in[I_WOUT] + (size_t)l * D * D, D, nb * 64, (bf16*)(p.ws + WS_WOUT + l * WOUT_L), D, kb * 64, nb * 64, lane); }
    }
}
__device__ __forceinline__ void prep_moe_weights(const Params& p, int layer, int gw, int NGW, int lane) {
    constexpr int I_GU = 16 * 16, I_D = 8 * 16, PER_E = I_GU + I_D;
    for (int it = gw; it < NE * PER_E; it += NGW) {
        const int e = it / PER_E; int r = it % PER_E;
        if (r < I_GU) { const int kb = r / 16, nb = r % 16, n0 = nb * 64, pn = n0 >> 8, half = (n0 >> 7) & 1, j0 = n0 & 127;
            const float* src = p.in[half ? I_WU : I_WG] + ((size_t)layer * NE + e) * D * DE;
            transpose_item(src, DE, 128 * pn + j0, (bf16*)(p.ws + WS_MOEW + e * WGU_E), D, kb * 64, n0, lane); continue; }
        r -= I_GU;
        { const int kb = r / 16, nb = r % 16;
            transpose_item(p.in[I_WD] + ((size_t)layer * NE + e) * DE * D, D, nb * 64, (bf16*)(p.ws + WS_WD + e * WD_E), DE, kb * 64, nb * 64, lane); }
    }
}

template <int MODE>
__device__ __forceinline__ void norm_phase(const Params& p, int layer, LAS unsigned char* lds, int gw, int NGW, int tid, int lane) {
    const float* nwp = (MODE == 2) ? p.in[I_FNW] : p.in[I_MIXNW] + layer * D;
    f32x4 nw[4];
#pragma unroll
    for (int j = 0; j < 4; ++j) nw[j] = *(const f32x4*)(nwp + 4 * lane + 256 * j);
    f32x4 ws0[16], ws1[16];
    if (MODE != 2) { const float* wi = p.in[I_WIN] + (size_t)layer * D * DIN + 2048;
#pragma unroll
        for (int j = 0; j < 4; ++j)
#pragma unroll
            for (int c = 0; c < 4; ++c) { const float* wr = wi + (size_t)(4 * lane + 256 * j + c) * DIN; ws0[j * 4 + c] = *(const f32x4*)wr; ws1[j * 4 + c] = *(const f32x4*)(wr + 4); } }
    const bf16* Y0 = (const bf16*)(p.ws + WS_Y); const bf16* Y1 = Y0 + (size_t)M * D;
    bf16* XN = (bf16*)(p.ws + WS_XN); float* SMALL = (float*)(p.ws + WS_SMALL);
    const float* xbase = (MODE == 0 ? p.in[I_X] : p.out);
    f32x4 vn[4]; u32x2 an[4], bn[4];
#define NP_LOAD(mm) do { _Pragma("unroll") for (int j = 0; j < 4; ++j) { vn[j] = *(const f32x4*)(xbase + (size_t)(mm) * D + 4 * lane + 256 * j); \
        if (MODE != 0) { an[j] = *(const u32x2*)(Y0 + (size_t)(mm) * D + 4 * lane + 256 * j); bn[j] = *(const u32x2*)(Y1 + (size_t)(mm) * D + 4 * lane + 256 * j); } } } while (0)
    if (gw < M) NP_LOAD(gw);
    for (int m = gw; m < M; m += NGW) {
        f32x4 v[4]; float ss = 0.f;
#pragma unroll
        for (int j = 0; j < 4; ++j) { v[j] = vn[j];
            if (MODE != 0) { v[j][0] += bf_lo(an[j].x) + bf_lo(bn[j].x); v[j][1] += bf_hi(an[j].x) + bf_hi(bn[j].x); v[j][2] += bf_lo(an[j].y) + bf_lo(bn[j].y); v[j][3] += bf_hi(an[j].y) + bf_hi(bn[j].y); } }
        if (m + NGW < M) NP_LOAD(m + NGW);
#pragma unroll
        for (int j = 0; j < 4; ++j) ss += (v[j][0] * v[j][0] + v[j][1] * v[j][1]) + (v[j][2] * v[j][2] + v[j][3] * v[j][3]);
        const float rs = __builtin_amdgcn_rsqf(wave_sum(ss) * (1.0f / D) + EPS);
        if (MODE == 2) {
#pragma unroll
            for (int j = 0; j < 4; ++j) *(f32x4*)(p.out + (size_t)m * D + 4 * lane + 256 * j) = v[j] * rs * nw[j];
            continue;
        }
        if (MODE == 1) {
#pragma unroll
            for (int j = 0; j < 4; ++j) *(f32x4*)(p.out + (size_t)m * D + 4 * lane + 256 * j) = v[j];
        }
        f32x4 s0 = (f32x4){0.f, 0.f, 0.f, 0.f}, s1 = s0;
#pragma unroll
        for (int j = 0; j < 4; ++j) { v[j] = v[j] * rs * nw[j];
            u32x2 o; o.x = pk2(v[j][0], v[j][1]); o.y = pk2(v[j][2], v[j][3]); *(u32x2*)(XN + (size_t)m * D + 4 * lane + 256 * j) = o;
#pragma unroll
            for (int c = 0; c < 4; ++c) { s0 += ws0[j * 4 + c] * v[j][c]; s1 += ws1[j * 4 + c] * v[j][c]; } }
        const bool b0 = lane & 1, b1 = lane & 2, b2 = lane & 4;
        f32x4 a;
#pragma unroll
        for (int i = 0; i < 4; ++i) { const float send = b0 ? s0[i] : s1[i]; const float recv = __shfl_xor(send, 1); a[i] = (b0 ? s1[i] : s0[i]) + recv; }
        float bb[2];
#pragma unroll
        for (int i = 0; i < 2; ++i) { const float send = b1 ? a[i] : a[2 + i]; const float recv = __shfl_xor(send, 2); bb[i] = (b1 ? a[2 + i] : a[i]) + recv; }
        float cc; { const float send = b2 ? bb[0] : bb[1]; const float recv = __shfl_xor(send, 4); cc = (b2 ? bb[1] : bb[0]) + recv; }
        cc += __shfl_xor(cc, 8); cc += __shfl_xor(cc, 16); cc += __shfl_xor(cc, 32);
        if (lane < 8) SMALL[(size_t)m * 8 + ((lane >> 2) & 1) + 2 * ((lane >> 1) & 1) + 4 * (lane & 1)] = cc;
    }
#undef NP_LOAD
    __syncthreads();
}

__device__ __forceinline__ void shortconv_unit(const Params& p, int layer, int tid, int unit) {
    const bf16* H = (const bf16*)(p.ws + WS_H); bf16* YS = (bf16*)(p.ws + WS_YS);
    const float* cw = p.in[I_SCW] + (size_t)layer * 3 * 512;
#pragma unroll 2
    for (int k = 0; k < 16; ++k) { const int it = unit * 8192 + k * 512 + tid;
        const int m = it >> 6, c8 = (it & 63) * 8, t = m & (T - 1);
        u32x4 rc[3], rx[3];
#pragma unroll
        for (int j = 0; j < 3; ++j) { const bool ok = (t - 2 + j >= 0); const bf16* r = H + (size_t)(ok ? m - 2 + j : m) * DH + HSC + c8; rc[j] = *(const u32x4*)(r + 512); rx[j] = *(const u32x4*)(r + 1024); if (!ok) rc[j] = (u32x4){0u, 0u, 0u, 0u}; }
        const u32x4 rb = *(const u32x4*)(H + (size_t)m * DH + HSC + c8);
        float acc[8];
#pragma unroll
        for (int i = 0; i < 8; ++i) acc[i] = 0.f;
#pragma unroll
        for (int j = 0; j < 3; ++j) { float cg[8], xv[8]; unpack8(rc[j], cg); unpack8(rx[j], xv);
#pragma unroll
            for (int i = 0; i < 8; ++i) acc[i] += cw[j * 512 + c8 + i] * (cg[i] * xv[i]); }
        float bg[8]; unpack8(rb, bg);
#pragma unroll
        for (int i = 0; i < 8; ++i) acc[i] *= bg[i];
        *(u32x4*)(YS + (size_t)m * 2048 + 1536 + c8) = pack8(acc);
    }
}
__device__ __forceinline__ int queue_pop(unsigned* counter, LAS unsigned char* lds, int tid) {
    LAS int* slot = (LAS int*)(lds + LDSCTL_OFF + LC_MISC);
    __syncthreads();
    if (tid == 0) slot[0] = (int)__hip_atomic_fetch_add(counter, 1u, __ATOMIC_RELAXED, __HIP_MEMORY_SCOPE_AGENT);
    __syncthreads();
    return slot[0];
}
__device__ __forceinline__ void conformer(const Params& p, int layer, LAS unsigned char* lds, int tid, int wave, int lane, unsigned* counter) {
    const bf16* H = (const bf16*)(p.ws + WS_H); bf16* YS = (bf16*)(p.ws + WS_YS);
    LAS bf16* yt = (LAS bf16*)lds;
    LAS float* zt = (LAS float*)(lds + 98304);
    const float* cwp = p.in[I_CCW] + (size_t)layer * 31 * 512;
    float cw[31];
#pragma unroll
    for (int j = 0; j < 31; ++j) cw[j] = cwp[j * 512 + tid];
    const float cb = p.in[I_CCB][layer * 512 + tid];
    float lw[8], lb[8];
#pragma unroll
    for (int i = 0; i < 8; ++i) { lw[i] = p.in[I_CLNW][layer * 512 + lane * 8 + i]; lb[i] = p.in[I_CLNB][layer * 512 + lane * 8 + i]; }
    for (;;) {
        const int unit = queue_pop(counter, lds, tid); if (unit >= M / 64) break;
        const int m0 = unit * 64, t0 = m0 & (T - 1);
        for (int base = 0; base < 94 * 64; base += 512 * 4) {
            u32x4 ra[4], rg[4];
#pragma unroll
            for (int k = 0; k < 4; ++k) { const int it = base + k * 512 + tid; const int r = it >> 6, c8 = (it & 63) * 8, dt = r - 30; const bool ok = (it < 94 * 64) && (t0 + dt >= 0);
                const bf16* s = H + (size_t)(ok ? m0 + dt : m0) * DH + HCONF + c8; ra[k] = *(const u32x4*)s; rg[k] = *(const u32x4*)(s + 512); }
#pragma unroll
            for (int k = 0; k < 4; ++k) { const int it = base + k * 512 + tid; const int r = it >> 6, c8 = (it & 63) * 8, dt = r - 30;
                if (it < 94 * 64) { u32x4 o = (u32x4){0u, 0u, 0u, 0u};
                    if (t0 + dt >= 0) { float a[8], g[8]; unpack8(ra[k], a); unpack8(rg[k], g);
#pragma unroll
                        for (int i = 0; i < 8; ++i) a[i] *= sigmoidf_(g[i]);
                        o = pack8(a); }
                    *(LAS u32x4*)(yt + r * 512 + c8) = o; } }
        }
        __syncthreads();
        for (int sb = 0; sb < 8; ++sb) {
            LAS float* zb = zt + (sb & 1) * 4096;
            float z[8];
#pragma unroll
            for (int i = 0; i < 8; ++i) z[i] = cb;
#pragma unroll
            for (int r = 0; r < 38; ++r) { const float yv = bf2f(yt[(sb * 8 + r) * 512 + tid]);
#pragma unroll
                for (int i = 0; i < 8; ++i) { const int j = r - i; if (j >= 0 && j < 31) z[i] += cw[j] * yv; } }
#pragma unroll
            for (int i = 0; i < 8; ++i) zb[i * 512 + tid] = z[i];
            __syncthreads();
            { const LAS float* zr = zb + wave * 512 + lane * 8; float v[8]; const f32x4 a = *(const LAS f32x4*)zr, b = *(const LAS f32x4*)(zr + 4);
                v[0] = a[0]; v[1] = a[1]; v[2] = a[2]; v[3] = a[3]; v[4] = b[0]; v[5] = b[1]; v[6] = b[2]; v[7] = b[3];
                float s = 0.f;
#pragma unroll
                for (int i = 0; i < 8; ++i) s += v[i];
                const float mean = wave_sum(s) * (1.0f / 512.0f); float q = 0.f;
#pragma unroll
                for (int i = 0; i < 8; ++i) { v[i] -= mean; q += v[i] * v[i]; }
                const float rstd = __builtin_amdgcn_rsqf(wave_sum(q) * (1.0f / 512.0f) + EPS);
#pragma unroll
                for (int i = 0; i < 8; ++i) v[i] = siluf_(v[i] * rstd * lw[i] + lb[i]);
                *(u32x4*)(YS + (size_t)(m0 + sb * 8 + wave) * 2048 + 512 + lane * 8) = pack8(v); }
        }
    }
}
__device__ __forceinline__ f32x4 mfma16(bf16x8 a, bf16x8 b, f32x4 c) { return __builtin_amdgcn_mfma_f32_16x16x32_bf16(a, b, c, 0, 0, 0); }
typedef short bf16x4 __attribute__((ext_vector_type(4)));
__device__ __forceinline__ bf16x8 ld_frag16(const LAS unsigned char* p) { return *(const LAS bf16x8*)p; }
__device__ __forceinline__ bf16x8 ld_frag8x2(const LAS unsigned char* p) { const bf16x4 a = *(const LAS bf16x4*)p, b = *(const LAS bf16x4*)(p + 32); return __builtin_shufflevector(a, b, 0, 1, 2, 3, 4, 5, 6, 7); }
__device__ __forceinline__ bf16x8 pack_frag(const f32x4 lo, const f32x4 hi) { u32x4 w; w.x = cvt_pk_bf16(lo[0], lo[1]); w.y = cvt_pk_bf16(lo[2], lo[3]); w.z = cvt_pk_bf16(hi[0], hi[1]); w.w = cvt_pk_bf16(hi[2], hi[3]); return __builtin_bit_cast(bf16x8, w); }
constexpr int GM_W = 0, GM_VT = 34816, GM_ST = 69632;
__device__ __forceinline__ void gmlp(const Params& p, int layer, LAS unsigned char* lds, int tid, int wave, int lane, unsigned* counter) {
    const bf16* H = (const bf16*)(p.ws + WS_H); bf16* YS = (bf16*)(p.ws + WS_YS);
    LAS float* st = (LAS float*)(lds + GM_ST);
    const float* lnw = p.in[I_GLNW] + layer * 512; const float* lnb = p.in[I_GLNB] + layer * 512;
    const int q = lane >> 4, li = lane & 15;
    for (;;) {
        const int unit = queue_pop(counter, lds, tid); if (unit >= M / 128) break;
        const int m0 = unit * 128;
        u32x4 rv[16];
#pragma unroll
        for (int k = 0; k < 16; ++k) rv[k] = *(const u32x4*)(H + (size_t)(m0 + wave * 16 + k) * DH + HGMLP + 512 + lane * 8);
#pragma unroll
        for (int k = 0; k < 16; ++k) { const int tk = wave * 16 + k;
            float v[8]; unpack8(rv[k], v);
            float s = 0.f;
#pragma unroll
            for (int i = 0; i < 8; ++i) { v[i] = gelu_tanh(v[i]); s += v[i]; }
            const float mean = wave_sum(s) * (1.0f / 512.0f); float qq = 0.f;
#pragma unroll
            for (int i = 0; i < 8; ++i) { const float d = v[i] - mean; qq += d * d; }
            const float rstd = 1.0f / sqrtf(wave_sum(qq) * (1.0f / 512.0f) + EPS);
            if (lane == 0) { st[tk * 2] = mean; st[tk * 2 + 1] = rstd; }
        }
        __syncthreads();
        for (int g = 0; g < 4; ++g) {
            u32x4 rg[4];
#pragma unroll
            for (int k = 0; k < 4; ++k) { const int it = tid + 512 * k; rg[k] = *(const u32x4*)(H + (size_t)(m0 + (it >> 4)) * DH + HGMLP + 512 + g * 128 + (it & 15) * 8); }
#pragma unroll
            for (int k = 0; k < 4; ++k) { const int it = tid + 512 * k; const int tk = it >> 4, c8 = (it & 15) * 8;
                float v[8]; unpack8(rg[k], v);
                const float mean = st[tk * 2], rstd = st[tk * 2 + 1];
#pragma unroll
                for (int i = 0; i < 8; ++i) *(LAS bf16*)(lds + GM_VT + (c8 + i) * 272 + 2 * tk) = (bf16)f2bf((gelu_tanh(v[i]) - mean) * rstd * lnw[g * 128 + c8 + i] + lnb[g * 128 + c8 + i]); }
            const float* ws = p.in[I_GWS] + ((size_t)layer * 4 + g) * 128 * 128;
            f32x4 wa[4], wb[4];
#pragma unroll
            for (int k = 0; k < 4; ++k) { const int it = tid + 512 * k; wa[k] = *(const f32x4*)(ws + (it >> 4) * 128 + (it & 15) * 8); wb[k] = *(const f32x4*)(ws + (it >> 4) * 128 + (it & 15) * 8 + 4); }
#pragma unroll
            for (int k = 0; k < 4; ++k) { const int it = tid + 512 * k; const int i = it >> 4, j8 = (it & 15) * 8;
                const f32x4 a = wa[k], b = wb[k];
                float w[8] = {a[0], a[1], a[2], a[3], b[0], b[1], b[2], b[3]};
#pragma unroll
                for (int e = 0; e < 8; ++e) w[e] = (j8 + e <= i) ? w[e] : 0.f;
                *(LAS u32x4*)(lds + GM_W + i * 272 + j8 * 2) = pack8(w); }
            __syncthreads();
            {
                f32x4 acc[8];
#pragma unroll
                for (int ct = 0; ct < 8; ++ct) acc[ct] = (f32x4){0.f, 0.f, 0.f, 0.f};
                const int nks = (wave >> 1) + 1;
                for (int ks = 0; ks < nks; ++ks) { const bf16x8 wf = ld_frag16(lds + GM_W + (16 * wave + li) * 272 + (32 * ks + 8 * q) * 2);
#pragma unroll
                    for (int ct = 0; ct < 8; ++ct) acc[ct] = mfma16(ld_frag16(lds + GM_VT + (16 * ct + li) * 272 + (32 * ks + 8 * q) * 2), wf, acc[ct]); }
                const int i = 16 * wave + li; const float bs = p.in[I_GBS][((size_t)layer * 4 + g) * 128 + i];
                const bf16* urow = H + (size_t)(m0 + i) * DH + HGMLP + g * 128 + 4 * q; bf16* orow = YS + (size_t)(m0 + i) * 2048 + 1024 + g * 128 + 4 * q;
#pragma unroll
                for (int ct = 0; ct < 8; ++ct) { const u32x2 uw = *(const u32x2*)(urow + 16 * ct);
                    const float o0 = gelu_tanh(bf_lo(uw.x)) * (acc[ct][0] + bs), o1 = gelu_tanh(bf_hi(uw.x)) * (acc[ct][1] + bs), o2 = gelu_tanh(bf_lo(uw.y)) * (acc[ct][2] + bs), o3 = gelu_tanh(bf_hi(uw.y)) * (acc[ct][3] + bs);
                    u32x2 ow; ow.x = pk2(o0, o1); ow.y = pk2(o2, o3); *(u32x2*)(orow + 16 * ct) = ow; }
            }
            __syncthreads();
        }
    }
}
constexpr int CP_QN = 0, CP_KN = 17408, CP_KT = 34816, CP_VT = 53248, CP_KGT = 71680, CP_A32 = 90112, CP_ATT = 106496, CP_T16 = 115712, CP_TAB = 124928;
__device__ __forceinline__ void gdn_chunk_prep(const Params& p, int layer, LAS unsigned char* lds, int tid, int wave, int lane) {
    const bf16* H = (const bf16*)(p.ws + WS_H); const float* SMALL = (const float*)(p.ws + WS_SMALL);
    const float* cw = p.in[I_GCONV] + (size_t)layer * 4 * 1536;
    LAS float* tab = (LAS float*)(lds + CP_TAB);
    const int q = lane >> 4, li = lane & 15;
    for (int unit = blockIdx.x; unit < 2048; unit += gridDim.x) {
        const int n = unit & 63, hh = (unit >> 6) & 3, b = unit >> 8; const int m0 = b * T + n * 64;
        unsigned char* rec = p.ws + WS_REC + (size_t)((b * 4 + hh) * 64 + n) * REC_BYTES;
        __syncthreads();
        if (wave == 0) { const int m = m0 + lane; const float br = SMALL[(size_t)m * 8 + hh], ar = SMALL[(size_t)m * 8 + 4 + hh];
            float g = -__expf(p.in[I_GALOG][layer * 4 + hh]) * softplusf_(ar + p.in[I_GDT][layer * 4 + hh]);
#pragma unroll
            for (int o = 1; o < 64; o <<= 1) { const float t = __shfl_up(g, o); if (lane >= o) g += t; }
            tab[lane] = sigmoidf_(br); tab[64 + lane] = g; tab[128 + lane] = __expf(g); }
        __syncthreads();
        {
            const int i0 = wave * 8, t0 = n * 64 + i0;
            unsigned raw[3][11];
#pragma unroll
            for (int s = 0; s < 3; ++s)
#pragma unroll
                for (int r = 0; r < 11; ++r) raw[s][r] = (t0 - 3 + r >= 0) ? *(const unsigned*)(H + (size_t)(m0 + i0 - 3 + r) * DH + s * 512 + hh * 128 + 2 * lane) : 0u;
            float w0[3][4], w1[3][4];
#pragma unroll
            for (int s = 0; s < 3; ++s)
#pragma unroll
                for (int j = 0; j < 4; ++j) { const f32x2 ww = *(const f32x2*)(cw + j * 1536 + s * 512 + hh * 128 + 2 * lane); w0[s][j] = ww[0]; w1[s][j] = ww[1]; }
#pragma unroll
            for (int ii = 0; ii < 8; ++ii) { const int i = i0 + ii;
                float y[3][2];
#pragma unroll
                for (int s = 0; s < 3; ++s) { float a0 = 0.f, a1 = 0.f;
#pragma unroll
                    for (int j = 0; j < 4; ++j) { a0 += w0[s][j] * bf_lo(raw[s][ii + j]); a1 += w1[s][j] * bf_hi(raw[s][ii + j]); }
                    y[s][0] = siluf_(a0); y[s][1] = siluf_(a1); }
                const float sq = wave_sum(y[0][0] * y[0][0] + y[0][1] * y[0][1]), sk = wave_sum(y[1][0] * y[1][0] + y[1][1] * y[1][1]);
                const float rq = 0.08838834764831845f * __builtin_amdgcn_rsqf(sq + EPS), rk = __builtin_amdgcn_rsqf(sk + EPS);
                const float be = tab[i], bg = be * tab[128 + i];
                const float k0 = y[1][0] * rk, k1 = y[1][1] * rk;
                *(LAS unsigned*)(lds + CP_QN + i * 272 + 4 * lane) = pk2(y[0][0] * rq, y[0][1] * rq);
                *(LAS unsigned*)(lds + CP_KN + i * 272 + 4 * lane) = pk2(k0, k1);
                *(LAS bf16*)(lds + CP_KT + (2 * lane) * 144 + 2 * i) = (bf16)f2bf(k0); *(LAS bf16*)(lds + CP_KT + (2 * lane + 1) * 144 + 2 * i) = (bf16)f2bf(k1);
                *(LAS bf16*)(lds + CP_VT + (2 * lane) * 144 + 2 * i) = (bf16)f2bf(be * y[2][0]); *(LAS bf16*)(lds + CP_VT + (2 * lane + 1) * 144 + 2 * i) = (bf16)f2bf(be * y[2][1]);
                *(LAS bf16*)(lds + CP_KGT + (2 * lane) * 144 + 2 * i) = (bf16)f2bf(bg * k0); *(LAS bf16*)(lds + CP_KGT + (2 * lane + 1) * 144 + 2 * i) = (bf16)f2bf(bg * k1);
            }
        }
        __syncthreads();
        for (int jb = wave; jb < 32; jb += 8) { const int which = jb >> 4, mt = (jb >> 2) & 3, nt = jb & 3;
            f32x4 acc = (f32x4){0.f, 0.f, 0.f, 0.f};
            if (nt <= mt) {
#pragma unroll
                for (int ks = 0; ks < 4; ++ks) acc = mfma16(ld_frag16(lds + (which ? CP_QN : CP_KN) + (16 * mt + li) * 272 + (32 * ks + 8 * q) * 2), ld_frag16(lds + CP_KN + (16 * nt + li) * 272 + (32 * ks + 8 * q) * 2), acc);
            }
            const int j = 16 * nt + li; const float gj = tab[64 + j];
#pragma unroll
            for (int r = 0; r < 4; ++r) { const int i = 16 * mt + 4 * q + r; const float gi = tab[64 + i];
                if (which == 0) { ((LAS float*)(lds + CP_A32))[i * 64 + j] = (i > j) ? tab[i] * acc[r] * __expf(gi - gj) : 0.f; }
                else { *(LAS bf16*)(lds + CP_ATT + i * 144 + 2 * j) = (bf16)f2bf((i >= j) ? acc[r] * __expf(gi - gj) : 0.f); } }
        }
        __syncthreads();
        if (wave == 0) {
            float Tc[64]; const float lanef = (float)lane;
            const LAS float* A = (const LAS float*)(lds + CP_A32); asm volatile("" : "+v"(A));
            LAS unsigned char* Tw = lds + CP_T16 + 2 * lane; asm volatile("" : "+v"(Tw));
#pragma unroll
            for (int i = 0; i < 64; ++i) { float a4[4] = {fmaxf(0.f, 1.f - fabsf((float)i - lanef)), 0.f, 0.f, 0.f};
#pragma unroll
                for (int j = 0; j < i; j += 4) { const f32x4 av = *(const LAS f32x4*)(A + i * 64 + j);
#pragma unroll
                    for (int jj = 0; jj < 4; ++jj) if (j + jj < i) a4[jj] -= av[jj] * Tc[j + jj]; }
                const float a = (a4[0] + a4[1]) + (a4[2] + a4[3]);
                Tc[i] = a; *(LAS bf16*)(Tw + i * 144) = (bf16)f2bf(a); }
        } else {
            const int t2 = tid - 64;
            for (int pc = t2; pc < 1024; pc += 448) { const int row = pc >> 4, seg = pc & 15; *(u32x4*)(rec + REC_Q + pc * 16) = *(const LAS u32x4*)(lds + CP_QN + row * 272 + seg * 16); }
            for (int pc = t2; pc < 512; pc += 448) { const int row = pc >> 3, seg = pc & 7; *(u32x4*)(rec + REC_ATT + pc * 16) = *(const LAS u32x4*)(lds + CP_ATT + row * 144 + seg * 16); }
            for (int pc = t2; pc < 1024; pc += 448) { const int row = pc >> 3, seg = pc & 7; *(u32x4*)(rec + REC_KT + pc * 16) = *(const LAS u32x4*)(lds + CP_KT + row * 144 + seg * 16); }
            if (t2 < 16) *(u32x4*)(rec + REC_G + t2 * 16) = *(const LAS u32x4*)(lds + CP_TAB + 256 + t2 * 16);
        }
        __syncthreads();
        for (int jb = wave; jb < 64; jb += 8) {
            f32x4 acc = (f32x4){0.f, 0.f, 0.f, 0.f};
            if (jb < 32) { const int mt = jb >> 3, nt = jb & 7;
#pragma unroll
                for (int ks = 0; ks < 2; ++ks) acc = mfma16(ld_frag16(lds + CP_T16 + (16 * mt + li) * 144 + (32 * ks + 8 * q) * 2), ld_frag16(lds + CP_VT + (16 * nt + li) * 144 + (32 * ks + 8 * q) * 2), acc);
                u32x2 o; o.x = pk2(acc[0], acc[1]); o.y = pk2(acc[2], acc[3]);
                *(u32x2*)(rec + REC_U + (size_t)((nt * 64 + lane) * 4 + mt) * 8) = o;
            } else { const int mt = (jb - 32) >> 2, nt = (jb - 32) & 3;
#pragma unroll
                for (int ks = 0; ks < 2; ++ks) acc = mfma16(ld_frag16(lds + CP_KGT + (16 * mt + li) * 144 + (32 * ks + 8 * q) * 2), ld_frag16(lds + CP_T16 + (16 * nt + li) * 144 + (32 * ks + 8 * q) * 2), acc);
                u32x2 o; o.x = pk2(acc[0], acc[1]); o.y = pk2(acc[2], acc[3]);
                *(u32x2*)(rec + REC_W + (size_t)((16 * nt + li) * 128 + 16 * mt + 4 * q) * 2) = o;
            }
        }
    }
    __syncthreads();
}
constexpr int SC_W = 0, SC_KT = 17408, SC_G = 35840, SC_BUF = 36096;
__device__ __forceinline__ void gdn_chunk_scan(const Params& p, LAS unsigned char* lds, int tid, int wave, int lane, int bh, int half) {
    const int q = lane >> 4, li = lane & 15, sl = half * 4 + (wave & 3);
    unsigned char* rec0 = p.ws + WS_REC + (size_t)(bh * 64) * REC_BYTES;
    u32x4* S0F = (u32x4*)(p.ws + WS_OBUF) + (size_t)(bh * 64) * 8 * 4 * 64;
    u32x4 pf[4], pfg = (u32x4){0u, 0u, 0u, 0u}, pu[2];
#define SC_LOAD(nn) do { const unsigned char* r_ = rec0 + (size_t)(nn) * REC_BYTES; \
        pf[0] = *(const u32x4*)(r_ + REC_W + (size_t)tid * 16); pf[1] = *(const u32x4*)(r_ + REC_W + (size_t)(tid + 512) * 16); \
        pf[2] = *(const u32x4*)(r_ + REC_KT + (size_t)tid * 16); pf[3] = *(const u32x4*)(r_ + REC_KT + (size_t)(tid + 512) * 16); \
        if (tid < 16) pfg = *(const u32x4*)(r_ + REC_G + tid * 16); \
        pu[0] = *(const u32x4*)(r_ + REC_U + (size_t)(sl * 64 + lane) * 32); pu[1] = *(const u32x4*)(r_ + REC_U + (size_t)(sl * 64 + lane) * 32 + 16); } while (0)
#define SC_STORE(buf) do { LAS unsigned char* d_ = lds + (buf) * SC_BUF; \
        _Pragma("unroll") for (int k_ = 0; k_ < 2; ++k_) { const int pc_ = tid + 512 * k_; *(LAS u32x4*)(d_ + SC_W + (pc_ >> 4) * 272 + (pc_ & 15) * 16) = pf[k_]; \
            *(LAS u32x4*)(d_ + SC_KT + (pc_ >> 3) * 144 + (pc_ & 7) * 16) = pf[2 + k_]; } \
        if (tid < 16) *(LAS u32x4*)(d_ + SC_G + tid * 16) = pfg; } while (0)
    f32x4 S[8];
#pragma unroll
    for (int i = 0; i < 8; ++i) S[i] = (f32x4){0.f, 0.f, 0.f, 0.f};
    __syncthreads();
    SC_LOAD(0); SC_STORE(0);
    u32x4 cu[2]; cu[0] = pu[0]; cu[1] = pu[1];
    __syncthreads();
    for (int n = 0; n < 64; ++n) {
        const LAS unsigned char* L = lds + (n & 1) * SC_BUF;
        if (n + 1 < 64) SC_LOAD(n + 1);
        if (wave < 4) {
            bf16x8 Sb[4];
#pragma unroll
            for (int ks = 0; ks < 4; ++ks) { Sb[ks] = pack_frag(S[2 * ks], S[2 * ks + 1]); S0F[(size_t)((n * 8 + sl) * 4 + ks) * 64 + lane] = __builtin_bit_cast(u32x4, Sb[ks]); }
            f32x4 a1[4];
#pragma unroll
            for (int mt = 0; mt < 4; ++mt) { a1[mt] = (f32x4){0.f, 0.f, 0.f, 0.f};
#pragma unroll
                for (int ks = 0; ks < 4; ++ks) a1[mt] = mfma16(ld_frag8x2(L + SC_W + (16 * mt + li) * 272 + (32 * ks + 4 * q) * 2), Sb[ks], a1[mt]); }
            const float g63 = *(const LAS float*)(L + SC_G + 63 * 4);
            f32x4 vn[4], vd[4];
#pragma unroll
            for (int mt = 0; mt < 4; ++mt) { const f32x4 gi = *(const LAS f32x4*)(L + SC_G + (16 * mt + 4 * q) * 4);
                const unsigned ulo = (mt < 2) ? (mt == 0 ? cu[0].x : cu[0].z) : (mt == 2 ? cu[1].x : cu[1].z), uhi = (mt < 2) ? (mt == 0 ? cu[0].y : cu[0].w) : (mt == 2 ? cu[1].y : cu[1].w);
                const f32x4 uu = (f32x4){bf_lo(ulo), bf_hi(ulo), bf_lo(uhi), bf_hi(uhi)};
                vn[mt] = uu - a1[mt];
#pragma unroll
                for (int r = 0; r < 4; ++r) vd[mt][r] = vn[mt][r] * fexp(g63 - gi[r]); }
            bf16x8 Vb[2], Vd[2];
#pragma unroll
            for (int ks = 0; ks < 2; ++ks) { Vb[ks] = pack_frag(vn[2 * ks], vn[2 * ks + 1]); Vd[ks] = pack_frag(vd[2 * ks], vd[2 * ks + 1]); }
            { unsigned char* ru = rec0 + (size_t)n * REC_BYTES + REC_U + (size_t)(sl * 64 + lane) * 32;
                *(u32x4*)ru = __builtin_bit_cast(u32x4, Vb[0]); *(u32x4*)(ru + 16) = __builtin_bit_cast(u32x4, Vb[1]); }
            const float eg = fexp(g63);
#pragma unroll
            for (int mt = 0; mt < 8; ++mt) { f32x4 a4 = (f32x4){0.f, 0.f, 0.f, 0.f};
#pragma unroll
                for (int ks = 0; ks < 2; ++ks) a4 = mfma16(ld_frag8x2(L + SC_KT + (16 * mt + li) * 144 + (32 * ks + 4 * q) * 2), Vd[ks], a4);
                S[mt] = S[mt] * eg + a4; }
        }
        if (n + 1 < 64) { SC_STORE((n + 1) & 1); cu[0] = pu[0]; cu[1] = pu[1]; }
        __syncthreads();
    }
#undef SC_LOAD
#undef SC_STORE
}
constexpr int CO_Q = 0, CO_ATT = 17408, CO_G = 26624, CO_PART = 26880;
__device__ __forceinline__ void gdn_chunk_out(const Params& p, int layer, LAS unsigned char* lds, int tid, int wave, int lane) {
    const bf16* H = (const bf16*)(p.ws + WS_H); bf16* YS = (bf16*)(p.ws + WS_YS);
    const int q = lane >> 4, li = lane & 15;
    const f32x4 nw = *(const f32x4*)(p.in[I_GNW] + layer * 128 + 16 * wave + 4 * q);
    LAS float* part = (LAS float*)(lds + CO_PART);
    for (int unit = blockIdx.x; unit < 2048; unit += gridDim.x) {
        const int n = unit & 63, bh = unit >> 6, hh = bh & 3, b = bh >> 2; const int m0 = b * T + n * 64;
        const unsigned char* rec = p.ws + WS_REC + (size_t)(bh * 64 + n) * REC_BYTES;
        const u32x4* S0F = (const u32x4*)(p.ws + WS_OBUF) + (size_t)((bh * 64 + n) * 8 + wave) * 4 * 64;
        const u32x4 rq0 = *(const u32x4*)(rec + REC_Q + (size_t)tid * 16), rq1 = *(const u32x4*)(rec + REC_Q + (size_t)(tid + 512) * 16), ra = *(const u32x4*)(rec + REC_ATT + (size_t)tid * 16);
        u32x4 rg = (u32x4){0u, 0u, 0u, 0u}; if (tid < 16) rg = *(const u32x4*)(rec + REC_G + tid * 16);
        bf16x8 sf[4], vf[2];
#pragma unroll
        for (int ks = 0; ks < 4; ++ks) sf[ks] = __builtin_bit_cast(bf16x8, S0F[ks * 64 + lane]);
        vf[0] = __builtin_bit_cast(bf16x8, *(const u32x4*)(rec + REC_U + (size_t)(wave * 64 + lane) * 32)); vf[1] = __builtin_bit_cast(bf16x8, *(const u32x4*)(rec + REC_U + (size_t)(wave * 64 + lane) * 32 + 16));
        u32x2 zr[4];
#pragma unroll
        for (int mt = 0; mt < 4; ++mt) zr[mt] = *(const u32x2*)(H + (size_t)(m0 + 16 * mt + li) * DH + HZ + hh * 128 + 16 * wave + 4 * q);
        __syncthreads();
        *(LAS u32x4*)(lds + CO_Q + (tid >> 4) * 272 + (tid & 15) * 16) = rq0; *(LAS u32x4*)(lds + CO_Q + ((tid + 512) >> 4) * 272 + (tid & 15) * 16) = rq1;
        *(LAS u32x4*)(lds + CO_ATT + (tid >> 3) * 144 + (tid & 7) * 16) = ra;
        if (tid < 16) *(LAS u32x4*)(lds + CO_G + tid * 16) = rg;
        __syncthreads();
        f32x4 o[4]; float ss[4];
#pragma unroll
        for (int mt = 0; mt < 4; ++mt) { f32x4 a2 = (f32x4){0.f, 0.f, 0.f, 0.f}, a3 = (f32x4){0.f, 0.f, 0.f, 0.f};
#pragma unroll
            for (int ks = 0; ks < 4; ++ks) a2 = mfma16(sf[ks], ld_frag8x2(lds + CO_Q + (16 * mt + li) * 272 + (32 * ks + 4 * q) * 2), a2);
#pragma unroll
            for (int ks = 0; ks < 2; ++ks) a3 = mfma16(vf[ks], ld_frag8x2(lds + CO_ATT + (16 * mt + li) * 144 + (32 * ks + 4 * q) * 2), a3);
            const float gam = fexp(*(const LAS float*)(lds + CO_G + (16 * mt + li) * 4));
            o[mt] = a2 * gam + a3;
            float s = (o[mt][0] * o[mt][0] + o[mt][1] * o[mt][1]) + (o[mt][2] * o[mt][2] + o[mt][3] * o[mt][3]);
            s += __shfl_xor(s, 16); s += __shfl_xor(s, 32);
            if (q == 0) part[(16 * mt + li) * 8 + wave] = s; }
        __syncthreads();
#pragma unroll
        for (int mt = 0; mt < 4; ++mt) { const f32x4 pa = *(const LAS f32x4*)(part + (16 * mt + li) * 8), pb = *(const LAS f32x4*)(part + (16 * mt + li) * 8 + 4);
            ss[mt] = ((pa[0] + pa[1]) + (pa[2] + pa[3])) + ((pb[0] + pb[1]) + (pb[2] + pb[3]));
            const float rs = __builtin_amdgcn_rsqf(ss[mt] * (1.0f / 128.0f) + EPS);
            u32x2 w; w.x = pk2(o[mt][0] * rs * nw[0] * siluf_(bf_lo(zr[mt].x)), o[mt][1] * rs * nw[1] * siluf_(bf_hi(zr[mt].x)));
            w.y = pk2(o[mt][2] * rs * nw[2] * siluf_(bf_lo(zr[mt].y)), o[mt][3] * rs * nw[3] * siluf_(bf_hi(zr[mt].y)));
            *(u32x2*)(YS + (size_t)(m0 + 16 * mt + li) * 2048 + hh * 128 + 16 * wave + 4 * q) = w; }
    }
    __syncthreads();
}
__device__ __forceinline__ void sum_gated(const Params& p, int gtid, int NGT) {
    const bf16* H = (const bf16*)(p.ws + WS_H); bf16* MG = (bf16*)(p.ws + WS_MERGED);
    for (int it = gtid; it < M * 128; it += NGT) { const int m = it >> 7, c8 = (it & 127) * 8; const bf16* r = H + (size_t)m * DH + HGATE + c8;
        float a[8], b[8];
        unpack8(*(const u32x4*)r, a);
#pragma unroll
        for (int br = 1; br < 4; ++br) { unpack8(*(const u32x4*)(r + br * 1024), b);
#pragma unroll
            for (int i = 0; i < 8; ++i) a[i] += b[i]; }
        *(u32x4*)(MG + (size_t)m * D + c8) = pack8(a); }
}

constexpr size_t WS_WRT = WS_MOETAB + MiB; constexpr int WRT_N = 80 * 1024;
__device__ __forceinline__ void prep_router_tables(const Params& p, int gtid, int NGT) {
    bf16* WRT = (bf16*)(p.ws + WS_WRT);
    for (int idx = gtid; idx < NLAYER * WRT_N; idx += NGT) { const int l = idx / WRT_N, n = (idx % WRT_N) >> 10, k = idx & 1023;
        const float w = (n < 64) ? p.in[I_REXP][((size_t)l * D + k) * 64 + n] : (n < 72 ? p.in[I_RGRP][((size_t)l * D + k) * 8 + (n - 64)] : 0.f);
        const unsigned hi = f2bf(w); const float wl = w - __uint_as_float(hi << 16);
        WRT[(size_t)(l * 2) * WRT_N + (idx % WRT_N)] = (bf16)hi; WRT[(size_t)(l * 2 + 1) * WRT_N + (idx % WRT_N)] = (bf16)f2bf(wl); }
}
__device__ __forceinline__ void moe_route_vb(const Params& p, int layer, LAS unsigned char* lds, int tid, int wave, int lane, int vb, const f32x4 (&nw)[4]) {
    LAS int* hist = (LAS int*)(lds + LDSCTL_OFF + LC_TAB);
    bf16* XN = (bf16*)(p.ws + WS_XN);
    int* route_e = (int*)(p.ws + WS_ROUTE); float* route_w = (float*)(p.ws + WS_ROUTE + (size_t)M * 2 * 4);
    int* cnt = (int*)(p.ws + WS_MOETAB + (size_t)NROWS_MAX * 8);
    const bf16* Wh = (const bf16*)(p.ws + WS_WRT) + (size_t)(layer * 2) * WRT_N; const bf16* Wl = Wh + WRT_N;
    const int q = lane >> 4, li = lane & 15;
    __syncthreads();
    if (tid < 64) hist[tid] = 0;
    for (int tile = 0; tile < 4; ++tile) {
        const int m0 = vb * 128 + tile * 32;
        __syncthreads();
        for (int hb = 0; hb < 2; ++hb) {
        f32x4 v[2][4];
#pragma unroll
        for (int rr = 0; rr < 2; ++rr)
#pragma unroll
            for (int j = 0; j < 4; ++j) v[rr][j] = *(const f32x4*)(p.out + (size_t)(m0 + wave * 4 + hb * 2 + rr) * D + 4 * lane + 256 * j);
#pragma unroll
        for (int rr = 0; rr < 2; ++rr) { const int r = wave * 4 + hb * 2 + rr, m = m0 + r; float ss = 0.f;
#pragma unroll
            for (int j = 0; j < 4; ++j) ss += (v[rr][j][0] * v[rr][j][0] + v[rr][j][1] * v[rr][j][1]) + (v[rr][j][2] * v[rr][j][2] + v[rr][j][3] * v[rr][j][3]);
            const float rs = __builtin_amdgcn_rsqf(wave_sum(ss) * (1.0f / D) + EPS);
#pragma unroll
            for (int j = 0; j < 4; ++j) { const f32x4 x = v[rr][j] * rs * nw[j];
                u32x2 h; h.x = pk2(x[0], x[1]); h.y = pk2(x[2], x[3]);
                u32x2 l; l.x = pk2(x[0] - bf_lo(h.x), x[1] - bf_hi(h.x)); l.y = pk2(x[2] - bf_lo(h.y), x[3] - bf_hi(h.y));
                *(u32x2*)(XN + (size_t)m * D + 4 * lane + 256 * j) = h;
                const int off = r * 2048 + ((((lane >> 1) + 32 * j) ^ (r & 15)) << 4) + (lane & 1) * 8;
                *(LAS u32x2*)(lds + off) = h; *(LAS u32x2*)(lds + 65536 + off) = l; } }
        }
        __syncthreads();
        f32x4 acc[2][5];
#pragma unroll
        for (int mt = 0; mt < 2; ++mt)
#pragma unroll
            for (int nt = 0; nt < 5; ++nt) acc[mt][nt] = (f32x4){0.f, 0.f, 0.f, 0.f};
        {
            const bf16* bp = Wh + (size_t)li * 1024 + 128 * wave + 8 * q;
#pragma unroll
            for (int ks = 0; ks < 4; ++ks) {
                bf16x8 ah[2], al[2];
#pragma unroll
                for (int mt = 0; mt < 2; ++mt) { const int off = (16 * mt + li) * 2048 + (((16 * wave + 4 * ks + q) ^ li) << 4); ah[mt] = ld_frag16(lds + off); al[mt] = ld_frag16(lds + 65536 + off); }
#pragma unroll
                for (int nt = 0; nt < 5; ++nt) { const bf16x8 bh = *(const bf16x8*)(bp + nt * 16384 + 32 * ks), bl = *(const bf16x8*)(bp + WRT_N + nt * 16384 + 32 * ks);
#pragma unroll
                    for (int mt = 0; mt < 2; ++mt) { acc[mt][nt] = mfma16(ah[mt], bh, acc[mt][nt]); acc[mt][nt] = mfma16(al[mt], bh, acc[mt][nt]); acc[mt][nt] = mfma16(ah[mt], bl, acc[mt][nt]); } }
            }
        }
        __syncthreads();
        LAS float* part = (LAS float*)lds;
#pragma unroll
        for (int mt = 0; mt < 2; ++mt)
#pragma unroll
            for (int nt = 0; nt < 5; ++nt) { if (16 * nt + li < 72) {
#pragma unroll
                for (int r = 0; r < 4; ++r) part[(wave * 32 + 16 * mt + 4 * q + r) * 72 + 16 * nt + li] = acc[mt][nt][r]; } }
        __syncthreads();
        for (int r = wave * 4; r < wave * 4 + 4; ++r) { const int m = m0 + r;
            float le = 0.f, lg = 0.f;
#pragma unroll
            for (int w = 0; w < 8; ++w) { le += part[(w * 32 + r) * 72 + lane]; lg += part[(w * 32 + r) * 72 + 64 + (lane & 7)]; }
            float gv[8];
#pragma unroll
            for (int i = 0; i < 8; ++i) gv[i] = __shfl(lg, i);
            int grp = 0; float gmax = gv[0];
#pragma unroll
            for (int i = 1; i < 8; ++i) if (gv[i] > gmax) { gmax = gv[i]; grp = i; }
            float gs = 0.f;
#pragma unroll
            for (int i = 0; i < 8; ++i) gs += __expf(gv[i] - gmax);
            const float psel = 1.0f / gs;
            float ev[8];
#pragma unroll
            for (int i = 0; i < 8; ++i) ev[i] = __shfl(le, grp * 8 + i);
            int i1 = 0; float e1 = ev[0];
#pragma unroll
            for (int i = 1; i < 8; ++i) if (ev[i] > e1) { e1 = ev[i]; i1 = i; }
            int i2 = -1; float e2 = -3.0e38f;
#pragma unroll
            for (int i = 0; i < 8; ++i) if (i != i1 && ev[i] > e2) { e2 = ev[i]; i2 = i; }
            const float x2 = __expf(e2 - e1), w1 = psel / (1.0f + x2), w2 = psel * x2 / (1.0f + x2);
            if (lane == 0) { route_e[(size_t)m * 2] = grp * 8 + i1; route_e[(size_t)m * 2 + 1] = grp * 8 + i2; route_w[(size_t)m * 2] = w1; route_w[(size_t)m * 2 + 1] = w2;
                atomicAdd((int*)(hist + grp * 8 + i1), 1); atomicAdd((int*)(hist + grp * 8 + i2), 1); }
        }
    }
    __syncthreads();
    if (tid < 64) cnt[vb * 64 + tid] = hist[tid];
}
__device__ __forceinline__ void moe_route(const Params& p, int layer, LAS unsigned char* lds, int tid, int wave, int lane) {
    f32x4 nw[4];
#pragma unroll
    for (int j = 0; j < 4; ++j) nw[j] = *(const f32x4*)(p.in[I_MOENW] + layer * D + 4 * lane + 256 * j);
    for (int vb = blockIdx.x; vb < M / 128; vb += gridDim.x) moe_route_vb(p, layer, lds, tid, wave, lane, vb, nw);
    __syncthreads();
}
__device__ __forceinline__ void moe_dispatch(const Params& p, LAS unsigned char* lds, int tid, int wave, int lane) {
    LAS int* tab = (LAS int*)(lds + LDSCTL_OFF + LC_TAB);
    const bf16* XN = (const bf16*)(p.ws + WS_XN); bf16* XS = (bf16*)(p.ws + WS_XS);
    const int* route_e = (const int*)(p.ws + WS_ROUTE); const float* route_w = (const float*)(p.ws + WS_ROUTE + (size_t)M * 2 * 4);
    int* row_code = (int*)(p.ws + WS_MOETAB); float* row_w = (float*)(p.ws + WS_MOETAB + (size_t)NROWS_MAX * 4);
    const int* cnt = (const int*)(p.ws + WS_MOETAB + (size_t)NROWS_MAX * 8); int* blk_e = (int*)(p.ws + WS_MOETAB + (size_t)NROWS_MAX * 8 + 256 * 64 * 4);
    for (int vb = blockIdx.x; vb < M / 128; vb += gridDim.x) {
        __syncthreads();
        if (tid < 64) { int run = 0, base = 0; for (int v = 0; v < M / 128; ++v) { if (v == vb) base = run; run += cnt[v * 64 + tid]; } tab[64 + tid] = run; tab[128 + tid] = base; }
        __syncthreads();
        if (tid == 0) { int s = 0; for (int e = 0; e < 64; ++e) { tab[e] = s; s += (tab[64 + e] + 255) / 256 * 256; } tab[704] = s; }
        if (tid < 256) tab[192 + tid] = route_e[(size_t)vb * 256 + tid];
        __syncthreads();
        if (tid < 256) { const int e = tab[192 + tid]; int rank = 0; for (int a = 0; a < tid; ++a) rank += (tab[192 + a] == e) ? 1 : 0;
            const int pos = tab[e] + tab[128 + e] + rank; tab[448 + tid] = pos;
            row_code[pos] = ((vb * 128 + (tid >> 1)) << 1) | (tid & 1); row_w[pos] = route_w[(size_t)vb * 256 + tid]; }
        if (vb < 64) { const int ps = tab[vb], tot = tab[64 + vb], pe = ps + (tot + 255) / 256 * 256;
            for (int r = ps + tot + tid; r < pe; r += 512) row_code[r] = -1;
            for (int b = ps / 256 + tid; b < pe / 256; b += 512) blk_e[b] = vb;
            if (tid == 0) { blk_e[NROWBLK_MAX + 64 + vb] = ps / 256; blk_e[NROWBLK_MAX + 128 + vb] = (pe - ps) / 256; }
            if (vb == 63 && tid == 0) blk_e[NROWBLK_MAX] = tab[704] / 256; }
        __syncthreads();
        for (int a = wave; a < 256; a += 8) { const int pos = tab[448 + a]; const int tok = vb * 128 + (a >> 1);
            const u32x4* src = (const u32x4*)(XN + (size_t)tok * D); u32x4* dst = (u32x4*)(XS + (size_t)pos * D);
            dst[lane] = src[lane]; dst[lane + 64] = src[lane + 64]; }
    }
    __syncthreads();
}

__global__ void __launch_bounds__(512, 2) fwd(Params p) {
    extern __shared__ __attribute__((aligned(16))) unsigned char lds_raw[];
    LAS unsigned char* lds = (LAS unsigned char*)lds_raw;
    const int tid0 = threadIdx.x;
    const int G = gridDim.x, NGW = G * 8, NGT = G * 512;
#define FRESH() Params pl = p; { unsigned char* w_ = pl.ws; float* o_ = pl.out; asm volatile("" : "+s"(w_), "+s"(o_)); pl.ws = w_; pl.out = o_; } int tid = tid0; asm volatile("" : "+v"(tid)); const int lane = tid & 63, wave = __builtin_amdgcn_readfirstlane(tid >> 6); const int gw = blockIdx.x * 8 + wave, gtid = blockIdx.x * 512 + tid; (void)lane; (void)gw; (void)gtid
    for (int u = tid0; u < (LDS_BYTES - LDSCTL_OFF) / 4; u += 512) ((LAS unsigned*)(lds + LDSCTL_OFF))[u] = 0u;
    __syncthreads();
    const int lo = p.ph_lo, hi = p.ph_hi;
    XcdBarrier bar; bar.bar = (unsigned*)(p.ws + WS_CTL) + CW_BAR; bar.x = 0; bar.st = (volatile LAS unsigned*)(lds + LDSCTL_OFF + LC_BAR);
    if (hi - lo > 1) bar = xcd_barrier_post((unsigned*)(p.ws + WS_CTL) + CW_BAR, (volatile LAS unsigned*)(lds + LDSCTL_OFF + LC_BAR));
#ifndef PHASE_MASK
#define PHASE_MASK 0x1fff
#endif
#define IN(k) (((PHASE_MASK >> ((k) == PH_FINAL ? 12 : ((k) % PH_PER_LAYER))) & 1) && lo <= (k) && (k) < hi)
#define REPS(k) ((((REPEAT_MASK) >> (k)) & 1) && layer == 0 ? 2 : 1)
#define SEAM(k) do { if (IN(k) && IN((k) + 1)) xcd_barrier(bar); } while (0)

    for (int layer = 0; layer < NLAYER; ++layer) {
        const int g0 = layer * PH_PER_LAYER;

        for (int rep_ = 0; rep_ < REPS(0); ++rep_) if (IN(g0 + 0)) { if (rep_) __syncthreads(); FRESH();
            if (layer == 0) { prep_static_weights(pl, gw, NGW, lane); prep_router_tables(pl, gtid, NGT); __syncthreads(); norm_phase<0>(pl, layer, lds, gw, NGW, tid, lane); }
            else norm_phase<1>(pl, layer, lds, gw, NGW, tid, lane);
        }
        SEAM(g0 + 0);
        for (int rep_ = 0; rep_ < REPS(1); ++rep_) if (IN(g0 + 1)) { if (rep_) __syncthreads(); FRESH();
            SchedH S; S.to.init(M / 256, DH / 256, G, (int)blockIdx.x); S.A = (const char*)(pl.ws + WS_XN); S.B = (const char*)(pl.ws + WS_WIN + layer * WIN_L);
            EpiStoreBf16 E{(bf16*)(pl.ws + WS_H), DH};
            pg8::gemm_phase(lds, tid, D, D, D, S, E);
        }
        SEAM(g0 + 1);
        for (int rep_ = 0; rep_ < REPS(2); ++rep_) if (IN(g0 + 2)) { if (rep_) __syncthreads(); FRESH(); gdn_chunk_prep(pl, layer, lds, tid, wave, lane); }
        SEAM(g0 + 2);
        for (int rep_ = 0; rep_ < REPS(3); ++rep_) if (IN(g0 + 3)) { if (rep_) __syncthreads(); FRESH();
            if ((int)blockIdx.x < 64) gdn_chunk_scan(pl, lds, tid, wave, lane, (int)blockIdx.x >> 1, (int)blockIdx.x & 1);
            {
                unsigned* qc = (unsigned*)(pl.ws + WS_CTL) + CW_QUEUE + layer * 256;
                gmlp(pl, layer, lds, tid, wave, lane, qc);
                conformer(pl, layer, lds, tid, wave, lane, qc + 64);
                for (;;) { const int unit = queue_pop(qc + 128, lds, tid); if (unit >= M / 128) break; shortconv_unit(pl, layer, tid, unit); }
            }
        }
        SEAM(g0 + 3);
        for (int rep_ = 0; rep_ < REPS(4); ++rep_) if (IN(g0 + 4)) { if (rep_) __syncthreads(); FRESH(); gdn_chunk_out(pl, layer, lds, tid, wave, lane); }
        SEAM(g0 + 4);
        for (int rep_ = 0; rep_ < REPS(5); ++rep_) if (IN(g0 + 5)) { if (rep_) __syncthreads(); FRESH();
            SchedBranch S; S.to.init(M / 256, 4, G, (int)blockIdx.x); S.YS = (const char*)(pl.ws + WS_YS); S.WBR = (const char*)(pl.ws + WS_WBR + layer * WBR_L);
            EpiGate E{(bf16*)(pl.ws + WS_H) + HGATE, (bf16*)(pl.ws + WS_MERGED)};
            pg8::gemm_phase(lds, tid, 512, 2048, 512, S, E);
        }
        for (int rep_ = 0; rep_ < REPS(6); ++rep_) if (IN(g0 + 6)) { if (rep_) __syncthreads(); FRESH();   }
        SEAM(g0 + 6);
        for (int rep_ = 0; rep_ < REPS(7); ++rep_) if (IN(g0 + 7)) { if (rep_) __syncthreads(); FRESH();
            const int NGB = G / 2;
            if ((int)blockIdx.x < NGB) {
                SchedOut S; S.to.init(M / 256, 4, NGB, (int)blockIdx.x); S.A = (const char*)(pl.ws + WS_MERGED); S.B = (const char*)(pl.ws + WS_WOUT + layer * WOUT_L);
                EpiResF32 E{layer == 0 ? pl.in[I_X] : pl.out, pl.out};
                pg8::gemm_phase(lds, tid, D, D, D, S, E);
            } else prep_moe_weights(pl, layer, ((int)blockIdx.x - NGB) * 8 + wave, (G - NGB) * 8, lane);
        }
        SEAM(g0 + 7);
        for (int rep_ = 0; rep_ < REPS(8); ++rep_) if (IN(g0 + 8)) { if (rep_) __syncthreads(); FRESH(); moe_route(pl, layer, lds, tid, wave, lane); }
        SEAM(g0 + 8);
        for (int rep_ = 0; rep_ < REPS(9); ++rep_) if (IN(g0 + 9)) { if (rep_) __syncthreads(); FRESH(); moe_dispatch(pl, lds, tid, wave, lane); }
        SEAM(g0 + 9);
        if (IN(g0 + 10) || IN(g0 + 11)) { FRESH();
            LAS int* tb = (LAS int*)(lds + LDSCTL_OFF + LC_TAB);
            const int* est = (const int*)(pl.ws + WS_MOETAB + (size_t)NROWS_MAX * 8 + 256 * 64 * 4) + NROWBLK_MAX + 64;
            const int NX = (G % 8 == 0) ? 8 : 1, x = (int)blockIdx.x % NX, nk = 64 / NX;
            __syncthreads();
            if (tid < nk) { tb[160 + tid] = est[x + NX * tid]; tb[240 + tid] = est[64 + x + NX * tid]; }
            __syncthreads();
            if (tid == 0) { int s = 0; for (int k = 0; k < nk; ++k) { tb[k] = s; tb[80 + k] = tb[160 + k]; s += tb[240 + k] * 4; } tb[nk] = s; }
            __syncthreads();
        }
        for (int rep_ = 0; rep_ < REPS(10); ++rep_) if (IN(g0 + 10)) { if (rep_) __syncthreads(); FRESH();
            LAS int* tb = (LAS int*)(lds + LDSCTL_OFF + LC_TAB); const int NX = (G % 8 == 0) ? 8 : 1, nk = 64 / NX;
            SchedMoe S; S.nux = tb[nk]; S.nrank = G / NX; S.rank = (int)blockIdx.x / NX; S.nk = nk; S.x = (int)blockIdx.x % NX; S.NX = NX; S.cum = tb; S.rb0 = tb + 80;
            S.A = (const char*)(pl.ws + WS_XS); S.a_blk = (size_t)256 * D * 2; S.W = (const char*)(pl.ws + WS_MOEW); S.w_e = WGU_E; S.w_pn = (size_t)256 * D * 2; S.cmul = 128;
            EpiSwiglu E{(bf16*)(pl.ws + WS_HB)};
            pg8::gemm_phase(lds, tid, D, D, D, S, E);
        }
        SEAM(g0 + 10);
        for (int rep_ = 0; rep_ < REPS(11); ++rep_) if (IN(g0 + 11)) { if (rep_) __syncthreads(); FRESH();
            LAS int* tb = (LAS int*)(lds + LDSCTL_OFF + LC_TAB); const int NX = (G % 8 == 0) ? 8 : 1, nk = 64 / NX;
            SchedMoe S; S.nux = tb[nk]; S.nrank = G / NX; S.rank = (int)blockIdx.x / NX; S.nk = nk; S.x = (int)blockIdx.x % NX; S.NX = NX; S.cum = tb; S.rb0 = tb + 80;
            S.A = (const char*)(pl.ws + WS_HB); S.a_blk = (size_t)256 * DE * 2; S.W = (const char*)(pl.ws + WS_WD); S.w_e = WD_E; S.w_pn = (size_t)256 * DE * 2; S.cmul = 256;
            EpiScatter E{(bf16*)(pl.ws + WS_Y), (const int*)(pl.ws + WS_MOETAB), (const float*)(pl.ws + WS_MOETAB + (size_t)NROWS_MAX * 4)};
            pg8::gemm_phase(lds, tid, DE, DE, DE, S, E);
        }
        SEAM(g0 + 11);
    }
    if (IN(PH_FINAL)) { FRESH(); norm_phase<2>(pl, 0, lds, gw, NGW, tid, lane); }
#undef IN
#undef SEAM
}

extern "C" void kernel_launch(void* const* d_in, const int* in_sizes, int n_in, void* d_out, int out_size, void* d_ws, size_t ws_size, hipStream_t stream) {
    static int grid = 0;
    if (grid == 0) {
        if (n_in != 25 || out_size != M * D || ws_size < WS_END) { fprintf(stderr, "kernel_launch: unexpected shapes / workspace (n_in %d out %d ws %zu, need %zu)\n", n_in, out_size, ws_size, (size_t)WS_END); grid = -1; return; }
        int dev = 0, cus = 0, per_cu = 0;
        if (hipGetDevice(&dev) != hipSuccess || hipDeviceGetAttribute(&cus, hipDeviceAttributeMultiprocessorCount, dev) != hipSuccess) { grid = -1; return; }
        if (hipFuncSetAttribute((const void*)fwd, hipFuncAttributeMaxDynamicSharedMemorySize, LDS_BYTES) != hipSuccess) { fprintf(stderr, "kernel_launch: hipFuncSetAttribute failed\n"); grid = -1; return; }
        if (hipOccupancyMaxActiveBlocksPerMultiprocessor(&per_cu, (const void*)fwd, 512, LDS_BYTES) != hipSuccess || per_cu < 1) { fprintf(stderr, "kernel_launch: occupancy query says %d\n", per_cu); }
        (void)hipGetLastError();
        grid = cus;
    }
    if (grid < 0) return;
    hipMemsetAsync((char*)d_ws + WS_CTL, 0, CTL_BYTES, stream);
    Params p{};
    for (int i = 0; i < 25; ++i) p.in[i] = (const float*)d_in[i];
    p.out = (float*)d_out; p.ws = (unsigned char*)d_ws;
#if N_LAUNCH_MODE == 1
    p.ph_lo = 0; p.ph_hi = PH_TOTAL;
    hipLaunchKernelGGL(fwd, dim3(grid), dim3(512), LDS_BYTES, stream, p);
#else
    for (int k = 0; k < PH_TOTAL; ++k) { p.ph_lo = k; p.ph_hi = k + 1; hipLaunchKernelGGL(fwd, dim3(grid), dim3(512), LDS_BYTES, stream, p); }
#endif
}
```

```cpp
#include <hip/hip_runtime.h>
#include <cstdio>
#include <cstdint>

#ifndef REPEAT_MASK
#define REPEAT_MASK 0
#endif
#ifndef N_LAUNCH_MODE
#define N_LAUNCH_MODE 1
#endif

#define LAS __attribute__((address_space(3)))
#define GAS __attribute__((address_space(1)))
typedef unsigned short bf16;
typedef short bf16x8 __attribute__((ext_vector_type(8)));
typedef float f32x4 __attribute__((ext_vector_type(4)));
typedef float f32x2 __attribute__((ext_vector_type(2)));
typedef unsigned u32x4 __attribute__((ext_vector_type(4)));
typedef unsigned u32x2 __attribute__((ext_vector_type(2)));

constexpr int NB = 8, T = 4096, D = 1024, M = NB * T, NLAYER = 2;
constexpr int DIN = 9736, DH = 9728;
constexpr int HQ = 0, HK = 512, HV = 1024, HZ = 1536, HCONF = 2048, HGMLP = 3072, HSC = 4096, HGATE = 5632;
constexpr int NE = 64, DE = 512;
constexpr float EPS = 1e-6f;
constexpr int NROWBLK_MAX = 320, NROWS_MAX = NROWBLK_MAX * 256;

constexpr size_t MiB = 1u << 20;
constexpr size_t WS_CTL = 0, CTL_BYTES = 1 * MiB;
constexpr size_t WS_WIN = 2 * MiB;
constexpr size_t WIN_L = (size_t)DH * D * 2;
constexpr size_t WS_WBR = 40 * MiB;
constexpr size_t WBR_L = (size_t)4 * D * 512 * 2;
constexpr size_t WS_WOUT = 48 * MiB;
constexpr size_t WOUT_L = (size_t)D * D * 2;
constexpr size_t WS_XN = 52 * MiB;
constexpr size_t WS_SMALL = 116 * MiB;
constexpr size_t WS_ROUTE = 117 * MiB;
constexpr size_t WS_MOETAB = 118 * MiB;
constexpr size_t WS_YS = 120 * MiB;
constexpr size_t WS_REC = 248 * MiB;
constexpr size_t WS_MERGED = WS_REC;
constexpr size_t WS_OBUF = WS_XN;
constexpr int REC_W = 0, REC_Q = 16384, REC_ATT = 32768, REC_KT = 40960, REC_U = 57344, REC_G = 73728, REC_BYTES = 73984;
static_assert(WS_REC + (size_t)2048 * REC_BYTES <= 410 * MiB, "chunk records");
constexpr size_t WS_H = 410 * MiB;
constexpr size_t WS_MOEW = 410 * MiB;
constexpr size_t WGU_E = (size_t)1024 * 1024 * 2, WD_E = (size_t)1024 * 512 * 2;
constexpr size_t WS_WD = WS_MOEW + 64 * WGU_E;
constexpr size_t WS_XS = 602 * MiB;
constexpr size_t WS_HB = 762 * MiB;
constexpr size_t WS_Y = 842 * MiB;
constexpr size_t WS_END = 1018 * MiB;
static_assert(WS_H + (size_t)M * DH * 2 <= WS_END && WS_Y + (size_t)2 * M * D * 2 <= WS_END, "ws map");

constexpr int CW_BAR = 4096;
constexpr int CW_QUEUE = 16384;
constexpr int STAGE_LDS = 131072, LDSCTL_OFF = 131072, LDS_BYTES = 147456;
constexpr int LC_BAR = 0;
constexpr int LC_MISC = 64;
constexpr int LC_TAB = 1024;

__device__ __forceinline__ float bf_lo(unsigned w) { return __uint_as_float(w << 16); }
__device__ __forceinline__ float bf_hi(unsigned w) { return __uint_as_float(w & 0xffff0000u); }
__device__ __forceinline__ float bf2f(bf16 b) { return __uint_as_float(((unsigned)b) << 16); }
__device__ __forceinline__ unsigned f2bf(float f) { unsigned u = __float_as_uint(f); return (u + 0x7fffu + ((u >> 16) & 1u)) >> 16; }
__device__ __forceinline__ unsigned pk2(float lo, float hi) { return f2bf(lo) | (f2bf(hi) << 16); }
__device__ __forceinline__ void unpack8(const u32x4 v, float (&f)[8]) {
    f[0] = bf_lo(v.x); f[1] = bf_hi(v.x); f[2] = bf_lo(v.y); f[3] = bf_hi(v.y); f[4] = bf_lo(v.z); f[5] = bf_hi(v.z); f[6] = bf_lo(v.w); f[7] = bf_hi(v.w);
}
__device__ __forceinline__ u32x4 pack8(const float (&f)[8]) { u32x4 o; o.x = pk2(f[0], f[1]); o.y = pk2(f[2], f[3]); o.z = pk2(f[4], f[5]); o.w = pk2(f[6], f[7]); return o; }
__device__ __forceinline__ float wave_sum(float v) {
#pragma unroll
    for (int o = 1; o < 64; o <<= 1) v += __shfl_xor(v, o);
    return v;
}
__device__ __forceinline__ float fexp(float x) { return __builtin_amdgcn_exp2f(x * 1.4426950408889634f); }
__device__ __forceinline__ float frcp(float x) { return __builtin_amdgcn_rcpf(x); }
__device__ __forceinline__ float sigmoidf_(float x) { return frcp(1.0f + fexp(-x)); }
__device__ __forceinline__ float siluf_(float x) { return x * frcp(1.0f + fexp(-x)); }
__device__ __forceinline__ float gelu_tanh(float x) { const float u = 0.7978845608028654f * (x + 0.044715f * x * x * x); return x * frcp(1.0f + fexp(-2.0f * u)); }
__device__ __forceinline__ float softplusf_(float x) { return fmaxf(x, 0.f) + log1pf(__expf(-fabsf(x))); }

#define XB_TMO      128
#define XB_XCNT(j)  (256  + 64 * (j))
#define XB_XSUB(j)  (1280 + 64 * (j))
#define XB_XGEN(j)  (2304 + 64 * (j))
#define XB_TOP      3328
#define XB_TOPGEN   3392
#define XCD_BAR_WORDS 3456
#define XB_SPIN_CAP (1u << 18)
__device__ __forceinline__ unsigned xb_ld(unsigned* p)              { return __hip_atomic_load(p, __ATOMIC_RELAXED, __HIP_MEMORY_SCOPE_AGENT); }
__device__ __forceinline__ unsigned xb_add(unsigned* p, unsigned v) { return __hip_atomic_fetch_add(p, v, __ATOMIC_RELAXED, __HIP_MEMORY_SCOPE_AGENT); }
__device__ __forceinline__ unsigned xb_xcc_id() { return (unsigned)__builtin_amdgcn_s_getreg((3 << 11) | 20) & 0xFu; }
#define XB_SPIN(cond, bar) do { unsigned _sp = 0; while (cond) { __builtin_amdgcn_s_sleep(1); \
    if ((++_sp & 255u) == 0u) { if (xb_ld(&(bar)[XB_TMO])) break; if (_sp > XB_SPIN_CAP) { atomicAdd(&(bar)[XB_TMO], 1u); break; } } } } while (0)
struct XcdBarrier { unsigned* bar; unsigned x; volatile LAS unsigned* st; };
__device__ __forceinline__ XcdBarrier xcd_barrier_post(unsigned* bar, volatile LAS unsigned* st) {
    XcdBarrier b; b.bar = bar; b.x = xb_xcc_id(); b.st = st;
    if (threadIdx.x == 0) (void)xb_add(&bar[XB_XCNT(b.x)], 1u);
    return b;
}
__device__ __forceinline__ void xcd_barrier_complete(unsigned* bar, unsigned x, unsigned& nloc, unsigned& nx) {
    const unsigned G = gridDim.x * gridDim.y * gridDim.z;
    unsigned sum, cnt, mine, sp = 0u;
    for (;;) {
        sum = 0u; cnt = 0u; mine = 0u;
#pragma unroll
        for (unsigned j = 0; j < 16; ++j) { const unsigned c = xb_ld(&bar[XB_XCNT(j)]); sum += c; cnt += (c > 0u) ? 1u : 0u; mine = (j == x) ? c : mine; }
        if (sum == G) break;
        __builtin_amdgcn_s_sleep(1);
        if ((++sp & 255u) == 0u) { if (xb_ld(&bar[XB_TMO])) break; if (sp > XB_SPIN_CAP) { atomicAdd(&bar[XB_TMO], 1u); break; } }
    }
    nloc = mine > 0u ? mine : 1u; nx = cnt > 0u ? cnt : 1u;
}
__device__ __forceinline__ void xcd_barrier(const XcdBarrier& b) {
    asm volatile("s_waitcnt vmcnt(0)" ::: "memory");
    __syncthreads();
    if (threadIdx.x == 0) {
        unsigned* bar = b.bar;
        __builtin_amdgcn_s_waitcnt(0);
        unsigned nloc = b.st[0], nx = b.st[1];
        if (nloc == 0u) { xcd_barrier_complete(bar, b.x, nloc, nx); b.st[0] = nloc; b.st[1] = nx; }
        const unsigned old = xb_add(&bar[XB_XSUB(b.x)], 1u);
        const unsigned gen = old / nloc;
        if (old + 1u == (gen + 1u) * nloc) {
            __builtin_amdgcn_fence(__ATOMIC_RELEASE, "agent");
            asm volatile("s_waitcnt vmcnt(0)" ::: "memory");
            const unsigned og = xb_add(&bar[XB_TOP], 1u);
            const unsigned tg = og / nx;
            if (og + 1u == (tg + 1u) * nx) xb_add(&bar[XB_TOPGEN], 1u);
            else XB_SPIN(xb_ld(&bar[XB_TOPGEN]) == tg, bar);
            __builtin_amdgcn_fence(__ATOMIC_ACQUIRE, "agent");
            xb_add(&bar[XB_XGEN(b.x)], 1u);
            asm volatile("s_waitcnt vmcnt(0)" ::: "memory");
        } else {
            XB_SPIN(xb_ld(&bar[XB_XGEN(b.x)]) == gen, bar);
            __builtin_amdgcn_fence(__ATOMIC_ACQUIRE, "agent");
            asm volatile("s_waitcnt vmcnt(0)" ::: "memory");
        }
    }
    __syncthreads();
}

namespace pg8 {
constexpr int BM = 256, BK = 64, HALF = 128, HTB = HALF * BK * 2, STAGE_BYTES = 8 * HTB, NXCD = 8, WGM = 8;
__host__ __device__ __forceinline__ int lds_byte(int r, int c) { const int st = (r >> 4) * 2 + (c >> 5), rr = r & 15, cc = c & 31, ob = rr * 64 + cc * 2; return st * 1024 + (ob ^ (((ob >> 9) & 1) << 5)); }
__host__ __device__ __forceinline__ void stage_rc(int b, int& R, int& C) { const int st = b / 1024, sb = b % 1024, swz = sb ^ (((sb >> 9) & 1) << 5); R = (st >> 1) * 16 + swz / 64; C = (st & 1) * 32 + (swz % 64) / 2; }
__host__ __device__ __forceinline__ int perm32(int rho) { const int n = rho >> 4, i = rho & 15; return 8 * (i >> 2) + 4 * n + (i & 3); }

struct Unit { const char* A; const char* B; int r0, c0; };

struct TileOrder {
    int nM, nN, nwg, G, c;
    __device__ void init(int nM_, int nN_, int G_, int c_) { nM = nM_; nN = nN_; nwg = nM * nN; G = G_; c = c_; }
    __device__ bool next(int i, int& pm, int& pn) const {
        const long L = (long)i * G + c; if (L >= nwg) return false;
        int wgid = (int)L; { const int q = nwg / NXCD, r = nwg % NXCD, xcd = wgid % NXCD, off = wgid / NXCD; wgid = (xcd < r ? xcd * (q + 1) : r * (q + 1) + (xcd - r) * q) + off; }
        const int nig = WGM * nN, gid = wgid / nig, fm = gid * WGM, gsz = (nM - fm) < WGM ? (nM - fm) : WGM;
        pm = fm + ((wgid % nig) % gsz); pn = (wgid % nig) / gsz; return true;
    }
};
__device__ __forceinline__ unsigned cvt_pk_bf16(float lo, float hi) { unsigned r; asm volatile("v_cvt_pk_bf16_f32 %0, %1, %2" : "=v"(r) : "v"(lo), "v"(hi)); return r; }

template <class Epi, class Sched>
__device__ __forceinline__ void gemm_phase(LAS unsigned char* lds, const int tid, const int K, const int lda, const int ldb, const Sched& S, const Epi& E) {
    const int wid = __builtin_amdgcn_readfirstlane(tid >> 6), lane = tid & 63, wr = wid >> 2, wc = wid & 3, fr = lane & 15, fq = lane >> 4;
    const int nt = K / BK;
    unsigned voffA[2], voffB[2];
#pragma unroll
    for (int i = 0; i < 2; ++i) { int R, C; stage_rc(tid * 16 + i * 8192, R, C); const int Rb = Epi::PERM ? ((R & ~31) + perm32(R & 31)) : R;
        voffA[i] = (unsigned)(R * lda + C) * 2u; voffB[i] = (unsigned)(Rb * ldb + C) * 2u; }
    const size_t kstep = (size_t)(BK * 2);
    const size_t hstepA = (size_t)HALF * lda * 2, hstepB = (size_t)HALF * ldb * 2;
    const unsigned ldsw = (unsigned)wid * 1024u;
    const int aoff = lds_byte(wr * 64 + fr, fq * 8), boff = lds_byte(wc * 32 + fr, fq * 8);
#define PG8_SA(b, h) (((b) * 2 + (h)) * HTB)
#define PG8_SB(b, h) ((4 + (b) * 2 + (h)) * HTB)
#define PG8_STAGE(bufoff, gbase, voff) do { _Pragma("unroll") for (int _i = 0; _i < 2; ++_i) \
        __builtin_amdgcn_global_load_lds((const unsigned*)((const char*)(gbase) + (voff)[_i]), (LAS unsigned*)(lds + (bufoff) + ldsw + _i * 8192), 16, 0, 0); } while (0)
#define PG8_LDA(dst, b, h) do { _Pragma("unroll") for (int m = 0; m < 4; ++m) _Pragma("unroll") for (int k = 0; k < 2; ++k) dst[m][k] = *(const LAS bf16x8*)(lds + PG8_SA(b, h) + aoff + m * 2048 + k * 1024); } while (0)
#define PG8_LDB(dst, b, h) do { _Pragma("unroll") for (int n = 0; n < 2; ++n) _Pragma("unroll") for (int k = 0; k < 2; ++k) dst[n][k] = *(const LAS bf16x8*)(lds + PG8_SB(b, h) + boff + n * 2048 + k * 1024); } while (0)
#define PG8_MMA(ai, bj, At, Bt) do { __builtin_amdgcn_s_setprio(1); _Pragma("unroll") for (int m = 0; m < 4; ++m) _Pragma("unroll") for (int n = 0; n < 2; ++n) _Pragma("unroll") for (int k = 0; k < 2; ++k) \
        acc[ai][bj][m][n] = __builtin_amdgcn_mfma_f32_16x16x32_bf16(Bt[n][k], At[m][k], acc[ai][bj][m][n], 0, 0, 0); __builtin_amdgcn_s_setprio(0); } while (0)
#define PG8_WAIT_V(n) asm volatile("s_waitcnt vmcnt(" #n ")" ::: "memory")
#define PG8_WAIT_L(n) asm volatile("s_waitcnt lgkmcnt(" #n ")" ::: "memory")
#define PG8_BAR __builtin_amdgcn_s_barrier()
#define PG8_SCHED __builtin_amdgcn_sched_barrier(0)
    Unit cur, nxt; int ui = 0;
    if (!S.next(0, cur)) return;
    f32x4 acc[2][2][4][2];
#pragma unroll
    for (int a = 0; a < 2; ++a)
#pragma unroll
        for (int b = 0; b < 2; ++b)
#pragma unroll
            for (int m = 0; m < 4; ++m)
#pragma unroll
                for (int n = 0; n < 2; ++n) acc[a][b][m][n] = (f32x4){0.f, 0.f, 0.f, 0.f};
    bf16x8 At[4][2], B0[2][2], B1[2][2];
    const char* cA = cur.A; const char* cB = cur.B;
    PG8_STAGE(PG8_SB(0, 0), cB, voffB); PG8_STAGE(PG8_SB(0, 1), cB + hstepB, voffB); PG8_STAGE(PG8_SA(0, 0), cA, voffA); PG8_STAGE(PG8_SA(0, 1), cA + hstepA, voffA);
    if (wr == 1) PG8_BAR;
    PG8_WAIT_V(2); PG8_BAR;
    PG8_STAGE(PG8_SB(1, 0), cB + kstep, voffB); PG8_STAGE(PG8_SA(1, 0), cA + kstep, voffA); PG8_STAGE(PG8_SB(1, 1), cB + hstepB + kstep, voffB);
    PG8_WAIT_V(6); PG8_BAR;
    for (;;) {
        const bool has_next = S.next(ui + 1, nxt);
        const char* nA = has_next ? nxt.A : cA; const char* nB = has_next ? nxt.B : cB;
        for (int t = 0; t < nt; t += 2) {
            const bool last = (t == nt - 2);
            const char* a1 = cA + (size_t)(t + 1) * kstep;
            const char* a2 = last ? nA : cA + (size_t)(t + 2) * kstep; const char* b2 = last ? nB : cB + (size_t)(t + 2) * kstep;
            const char* a3 = a2 + kstep; const char* b3 = b2 + kstep;
            PG8_LDB(B0, 0, 0); PG8_LDB(B1, 0, 1); PG8_SCHED; PG8_LDA(At, 0, 0); PG8_STAGE(PG8_SA(1, 1), a1 + hstepA, voffA);
            PG8_WAIT_V(8); PG8_WAIT_L(0); PG8_BAR; PG8_MMA(0, 0, At, B0); PG8_MMA(0, 1, At, B1); PG8_BAR; PG8_SCHED;
            PG8_LDA(At, 0, 1); PG8_STAGE(PG8_SB(0, 0), b2, voffB); PG8_STAGE(PG8_SB(0, 1), b2 + hstepB, voffB); PG8_STAGE(PG8_SA(0, 0), a2, voffA);
            PG8_WAIT_V(8); PG8_WAIT_L(0); PG8_BAR; PG8_MMA(1, 0, At, B0); PG8_MMA(1, 1, At, B1); PG8_BAR; PG8_SCHED;
            PG8_LDB(B0, 1, 0); PG8_LDB(B1, 1, 1); PG8_SCHED; PG8_LDA(At, 1, 0); PG8_STAGE(PG8_SA(0, 1), a2 + hstepA, voffA);
            PG8_WAIT_V(8); PG8_WAIT_L(0); PG8_BAR; PG8_MMA(0, 0, At, B0); PG8_MMA(0, 1, At, B1); PG8_BAR; PG8_SCHED;
            PG8_LDA(At, 1, 1); PG8_STAGE(PG8_SB(1, 0), b3, voffB); PG8_STAGE(PG8_SB(1, 1), b3 + hstepB, voffB); PG8_STAGE(PG8_SA(1, 0), a3, voffA);
            PG8_WAIT_V(8); PG8_WAIT_L(0); PG8_BAR; PG8_MMA(1, 0, At, B0); PG8_MMA(1, 1, At, B1); PG8_BAR; PG8_SCHED;
        }
        if (wr == 0) PG8_BAR;
        E(acc, cur, wr, wc, fr, fq);
        if (!has_next) break;
#pragma unroll
        for (int a = 0; a < 2; ++a)
#pragma unroll
            for (int b = 0; b < 2; ++b)
#pragma unroll
                for (int m = 0; m < 4; ++m)
#pragma unroll
                    for (int n = 0; n < 2; ++n) acc[a][b][m][n] = (f32x4){0.f, 0.f, 0.f, 0.f};
        cur = nxt; cA = nA; cB = nB; ++ui;
        if (wr == 1) PG8_BAR;
    }
    PG8_WAIT_V(0);
    PG8_BAR;
#undef PG8_SA
#undef PG8_SB
#undef PG8_STAGE
#undef PG8_LDA
#undef PG8_LDB
#undef PG8_MMA
#undef PG8_WAIT_V
#undef PG8_WAIT_L
#undef PG8_BAR
#undef PG8_SCHED
}
}
using pg8::Unit;
using pg8::cvt_pk_bf16;

struct EpiStoreBf16 {
    static constexpr bool PERM = true;
    bf16* O; int ldc;
    __device__ __forceinline__ void operator()(const f32x4 (&acc)[2][2][4][2], const Unit& u, int wr, int wc, int fr, int fq) const {
        const int row0 = u.r0 + wr * 64 + fr, col0 = u.c0 + wc * 32 + 8 * fq;
#pragma unroll
        for (int ai = 0; ai < 2; ++ai)
#pragma unroll
            for (int m = 0; m < 4; ++m) { bf16* rowp = O + (size_t)(row0 + ai * 128 + m * 16) * ldc + col0;
#pragma unroll
                for (int bj = 0; bj < 2; ++bj) { const f32x4 v0 = acc[ai][bj][m][0], v1 = acc[ai][bj][m][1];
                    u32x4 w; w.x = cvt_pk_bf16(v0[0], v0[1]); w.y = cvt_pk_bf16(v0[2], v0[3]); w.z = cvt_pk_bf16(v1[0], v1[1]); w.w = cvt_pk_bf16(v1[2], v1[3]);
                    *(u32x4*)(rowp + bj * 128) = w; } }
    }
};
struct EpiGate {
    static constexpr bool PERM = true;
    const bf16* Hg; bf16* MG;
    __device__ __forceinline__ void operator()(const f32x4 (&acc)[2][2][4][2], const Unit& u, int wr, int wc, int fr, int fq) const {
        const int row0 = u.r0 + wr * 64 + fr, gcol0 = u.c0 + wc * 32 + 8 * fq, mcol0 = (u.c0 & 1023) + wc * 32 + 8 * fq; const bool first = u.c0 < 1024;
#pragma unroll
        for (int ai = 0; ai < 2; ++ai) {
            u32x4 gw[4][2], mw[4][2];
#pragma unroll
            for (int m = 0; m < 4; ++m)
#pragma unroll
                for (int bj = 0; bj < 2; ++bj) { gw[m][bj] = *(const u32x4*)(Hg + (size_t)(row0 + ai * 128 + m * 16) * DH + gcol0 + bj * 128);
                    mw[m][bj] = first ? (u32x4){0u, 0u, 0u, 0u} : *(const u32x4*)(MG + (size_t)(row0 + ai * 128 + m * 16) * D + mcol0 + bj * 128); }
#pragma unroll
            for (int m = 0; m < 4; ++m) { bf16* mrow = MG + (size_t)(row0 + ai * 128 + m * 16) * D + mcol0;
#pragma unroll
                for (int bj = 0; bj < 2; ++bj) { const f32x4 v0 = acc[ai][bj][m][0], v1 = acc[ai][bj][m][1];
                    float g[8], pm[8]; unpack8(gw[m][bj], g); unpack8(mw[m][bj], pm);
                    u32x4 w; w.x = cvt_pk_bf16(pm[0] + sigmoidf_(g[0]) * v0[0], pm[1] + sigmoidf_(g[1]) * v0[1]); w.y = cvt_pk_bf16(pm[2] + sigmoidf_(g[2]) * v0[2], pm[3] + sigmoidf_(g[3]) * v0[3]);
                    w.z = cvt_pk_bf16(pm[4] + sigmoidf_(g[4]) * v1[0], pm[5] + sigmoidf_(g[5]) * v1[1]); w.w = cvt_pk_bf16(pm[6] + sigmoidf_(g[6]) * v1[2], pm[7] + sigmoidf_(g[7]) * v1[3]);
                    *(u32x4*)(mrow + bj * 128) = w; } }
        }
    }
};
struct EpiResF32 {
    static constexpr bool PERM = false;
    const float* res; float* out;
    __device__ __forceinline__ void operator()(const f32x4 (&acc)[2][2][4][2], const Unit& u, int wr, int wc, int fr, int fq) const {
        const int row0 = u.r0 + wr * 64 + fr, col0 = u.c0 + wc * 32 + 4 * fq;
#pragma unroll
        for (int ai = 0; ai < 2; ++ai)
#pragma unroll
            for (int m = 0; m < 4; ++m) { const size_t ro = (size_t)(row0 + ai * 128 + m * 16) * D + col0;
#pragma unroll
                for (int bj = 0; bj < 2; ++bj)
#pragma unroll
                    for (int n = 0; n < 2; ++n) { const f32x4 r = *(const f32x4*)(res + ro + bj * 128 + n * 16); *(f32x4*)(out + ro + bj * 128 + n * 16) = r + acc[ai][bj][m][n]; } }
    }
};
struct EpiSwiglu {
    static constexpr bool PERM = true;
    bf16* O;
    __device__ __forceinline__ void operator()(const f32x4 (&acc)[2][2][4][2], const Unit& u, int wr, int wc, int fr, int fq) const {
        const int row0 = u.r0 + wr * 64 + fr, col0 = u.c0 + wc * 32 + 8 * fq;
#pragma unroll
        for (int ai = 0; ai < 2; ++ai)
#pragma unroll
            for (int m = 0; m < 4; ++m) { bf16* rowp = O + (size_t)(row0 + ai * 128 + m * 16) * DE + col0;
                const f32x4 g0 = acc[ai][0][m][0], g1 = acc[ai][0][m][1], u0 = acc[ai][1][m][0], u1 = acc[ai][1][m][1];
                u32x4 w; w.x = cvt_pk_bf16(siluf_(g0[0]) * u0[0], siluf_(g0[1]) * u0[1]); w.y = cvt_pk_bf16(siluf_(g0[2]) * u0[2], siluf_(g0[3]) * u0[3]);
                w.z = cvt_pk_bf16(siluf_(g1[0]) * u1[0], siluf_(g1[1]) * u1[1]); w.w = cvt_pk_bf16(siluf_(g1[2]) * u1[2], siluf_(g1[3]) * u1[3]);
                *(u32x4*)rowp = w; }
    }
};
struct EpiScatter {
    static constexpr bool PERM = true;
    bf16* Y; const int* row_code; const float* row_w;
    __device__ __forceinline__ void operator()(const f32x4 (&acc)[2][2][4][2], const Unit& u, int wr, int wc, int fr, int fq) const {
        const int row0 = u.r0 + wr * 64 + fr, col0 = u.c0 + wc * 32 + 8 * fq;
#pragma unroll
        for (int ai = 0; ai < 2; ++ai)
#pragma unroll
            for (int m = 0; m < 4; ++m) { const int row = row0 + ai * 128 + m * 16; const int code = row_code[row]; const float rw = row_w[row];
                if (code >= 0) { bf16* rowp = Y + (size_t)(code & 1) * ((size_t)M * D) + (size_t)(code >> 1) * D + col0;
#pragma unroll
                    for (int bj = 0; bj < 2; ++bj) { const f32x4 v0 = acc[ai][bj][m][0] * rw, v1 = acc[ai][bj][m][1] * rw;
                        u32x4 w; w.x = cvt_pk_bf16(v0[0], v0[1]); w.y = cvt_pk_bf16(v0[2], v0[3]); w.z = cvt_pk_bf16(v1[0], v1[1]); w.w = cvt_pk_bf16(v1[2], v1[3]);
                        *(u32x4*)(rowp + bj * 128) = w; } } }
    }
};

struct SchedH {
    pg8::TileOrder to; const char* A; const char* B;
    __device__ __forceinline__ bool next(int i, Unit& u) const { int pm, pn; if (!to.next(i, pm, pn)) return false;
        u.A = A + (size_t)pm * 256 * D * 2; u.B = B + (size_t)pn * 256 * D * 2; u.r0 = pm * 256; u.c0 = pn * 256; return true; }
};
struct SchedBranch {
    pg8::TileOrder to; const char* YS; const char* WBR;
    __device__ __forceinline__ bool next(int i, Unit& u) const { int pm, q; if (!to.next(i >> 2, pm, q)) return false; const int br = i & 3;
        u.A = YS + ((size_t)pm * 256 * 2048 + br * 512) * 2; u.B = WBR + ((size_t)br * D * 512 + (size_t)q * 256 * 512) * 2; u.r0 = pm * 256; u.c0 = br * 1024 + q * 256; return true; }
};
struct SchedOut {
    pg8::TileOrder to; const char* A; const char* B;
    __device__ __forceinline__ bool next(int i, Unit& u) const { int pm, pn; if (!to.next(i, pm, pn)) return false;
        u.A = A + (size_t)pm * 256 * D * 2; u.B = B + (size_t)pn * 256 * D * 2; u.r0 = pm * 256; u.c0 = pn * 256; return true; }
};
struct SchedMoe {
    int nux, nrank, rank, nk, x, NX; const LAS int* cum; const LAS int* rb0; const char* A; size_t a_blk; const char* W; size_t w_e, w_pn; int cmul;
    __device__ __forceinline__ bool next(int i, Unit& u) const { const int ui = i * nrank + rank; if (ui >= nux) return false;
        int k = 0; while (k + 1 < nk && cum[k + 1] <= ui) ++k;
        const int local = ui - cum[k], rb = rb0[k] + (local >> 2), pn = local & 3, e = x + NX * k;
        u.A = A + (size_t)rb * a_blk; u.B = W + (size_t)e * w_e + (size_t)pn * w_pn; u.r0 = rb * 256; u.c0 = pn * cmul; return true; }
};

struct Params { const float* in[25]; float* out; unsigned char* ws; int ph_lo, ph_hi; };
enum { I_X = 0, I_MIXNW, I_WIN, I_GCONV, I_GALOG, I_GDT, I_GNW, I_CCW, I_CCB, I_CLNW, I_CLNB, I_GLNW, I_GLNB, I_GWS, I_GBS, I_SCW, I_WBR, I_WOUT, I_MOENW, I_RGRP, I_REXP, I_WG, I_WU, I_WD, I_FNW };
constexpr int PH_PER_LAYER = 12, PH_FINAL = 24, PH_TOTAL = 25;

__device__ __forceinline__ void transpose_item(const float* __restrict__ W, int ldw, int srccol, bf16* __restrict__ WT, int ldt, int k0, int n0, int lane) {
    const int kq = lane & 7, nq = lane >> 3;
    f32x4 v[8][2];
#pragma unroll
    for (int r = 0; r < 8; ++r) { const float* s = W + (size_t)(k0 + 8 * kq + r) * ldw + srccol + 8 * nq; v[r][0] = *(const f32x4*)s; v[r][1] = *(const f32x4*)(s + 4); }
#pragma unroll
    for (int e = 0; e < 8; ++e) { u32x4 o; o.x = pk2(v[0][e >> 2][e & 3], v[1][e >> 2][e & 3]); o.y = pk2(v[2][e >> 2][e & 3], v[3][e >> 2][e & 3]); o.z = pk2(v[4][e >> 2][e & 3], v[5][e >> 2][e & 3]); o.w = pk2(v[6][e >> 2][e & 3], v[7][e >> 2][e & 3]);
        *(u32x4*)(WT + (size_t)(n0 + 8 * nq + e) * ldt + k0 + 8 * kq) = o; }
}
__device__ __forceinline__ void prep_static_weights(const Params& p, int gw, int NGW, int lane) {
    constexpr int I_IN = 16 * (DH / 64), I_BR = 8 * 16, I_OUT = 16 * 16, PER_L = I_IN + 4 * I_BR + I_OUT;
    for (int it = gw; it < NLAYER * PER_L; it += NGW) {
        const int l = it / PER_L; int r = it % PER_L;
        if (r < I_IN) { const int kb = r / (DH / 64), nb = r % (DH / 64), n0 = nb * 64;
            transpose_item(p.in[I_WIN] + (size_t)l * D * DIN, DIN, n0 + (n0 >= 2048 ? 8 : 0), (bf16*)(p.ws + WS_WIN + l * WIN_L), D, kb * 64, n0, lane); continue; }
        r -= I_IN;
        if (r < 4 * I_BR) { const int br = r / I_BR, q = r % I_BR, kb = q / 16, nb = q % 16;
            transpose_item(p.in[I_WBR] + ((size_t)l * 4 + br) * 512 * D, D, nb * 64, (bf16*)(p.ws + WS_WBR + l * WBR_L) + (size_t)br * D * 512, 512, kb * 64, nb * 64, lane); continue; }
        r -= 4 * I_BR;
        { const int kb = r / 16, nb = r % 16;
            transpose_item(p.in[I_WOUT] + (size_t)l * D * D, D, nb * 64, (bf16*)(p.ws + WS_WOUT + l * WOUT_L), D, kb * 64, nb * 64, lane); }
    }
}
__device__ __forceinline__ void prep_moe_weights(const Params& p, int layer, int gw, int NGW, int lane) {
    constexpr int I_GU = 16 * 16, I_D = 8 * 16, PER_E = I_GU + I_D;
    for (int it = gw; it < NE * PER_E; it += NGW) {
        const int e = it / PER_E; int r = it % PER_E;
        if (r < I_GU) { const int kb = r / 16, nb = r % 16, n0 = nb * 64, pn = n0 >> 8, half = (n0 >> 7) & 1, j0 = n0 & 127;
            const float* src = p.in[half ? I_WU : I_WG] + ((size_t)layer * NE + e) * D * DE;
            transpose_item(src, DE, 128 * pn + j0, (bf16*)(p.ws + WS_MOEW + e * WGU_E), D, kb * 64, n0, lane); continue; }
        r -= I_GU;
        { const int kb = r / 16, nb = r % 16;
            transpose_item(p.in[I_WD] + ((size_t)layer * NE + e) * DE * D, D, nb * 64, (bf16*)(p.ws + WS_WD + e * WD_E), DE, kb * 64, nb * 64, lane); }
    }
}

template <int MODE>
__device__ __forceinline__ void norm_phase(const Params& p, int layer, LAS unsigned char* lds, int gw, int NGW, int tid, int lane) {
    const float* nwp = (MODE == 2) ? p.in[I_FNW] : p.in[I_MIXNW] + layer * D;
    f32x4 nw[4];
#pragma unroll
    for (int j = 0; j < 4; ++j) nw[j] = *(const f32x4*)(nwp + 4 * lane + 256 * j);
    f32x4 ws0[16], ws1[16];
    if (MODE != 2) { const float* wi = p.in[I_WIN] + (size_t)layer * D * DIN + 2048;
#pragma unroll
        for (int j = 0; j < 4; ++j)
#pragma unroll
            for (int c = 0; c < 4; ++c) { const float* wr = wi + (size_t)(4 * lane + 256 * j + c) * DIN; ws0[j * 4 + c] = *(const f32x4*)wr; ws1[j * 4 + c] = *(const f32x4*)(wr + 4); } }
    const bf16* Y0 = (const bf16*)(p.ws + WS_Y); const bf16* Y1 = Y0 + (size_t)M * D;
    bf16* XN = (bf16*)(p.ws + WS_XN); float* SMALL = (float*)(p.ws + WS_SMALL);
    const float* xbase = (MODE == 0 ? p.in[I_X] : p.out);
    f32x4 vn[4]; u32x2 an[4], bn[4];
#define NP_LOAD(mm) do { _Pragma("unroll") for (int j = 0; j < 4; ++j) { vn[j] = *(const f32x4*)(xbase + (size_t)(mm) * D + 4 * lane + 256 * j); \
        if (MODE != 0) { an[j] = *(const u32x2*)(Y0 + (size_t)(mm) * D + 4 * lane + 256 * j); bn[j] = *(const u32x2*)(Y1 + (size_t)(mm) * D + 4 * lane + 256 * j); } } } while (0)
    if (gw < M) NP_LOAD(gw);
    for (int m = gw; m < M; m += NGW) {
        f32x4 v[4]; float ss = 0.f;
#pragma unroll
        for (int j = 0; j < 4; ++j) { v[j] = vn[j];
            if (MODE != 0) { v[j][0] += bf_lo(an[j].x) + bf_lo(bn[j].x); v[j][1] += bf_hi(an[j].x) + bf_hi(bn[j].x); v[j][2] += bf_lo(an[j].y) + bf_lo(bn[j].y); v[j][3] += bf_hi(an[j].y) + bf_hi(bn[j].y); } }
        if (m + NGW < M) NP_LOAD(m + NGW);
#pragma unroll
        for (int j = 0; j < 4; ++j) ss += (v[j][0] * v[j][0] + v[j][1] * v[j][1]) + (v[j][2] * v[j][2] + v[j][3] * v[j][3]);
        const float rs = __builtin_amdgcn_rsqf(wave_sum(ss) * (1.0f / D) + EPS);
        if (MODE == 2) {
#pragma unroll
            for (int j = 0; j < 4; ++j) *(f32x4*)(p.out + (size_t)m * D + 4 * lane + 256 * j) = v[j] * rs * nw[j];
            continue;
        }
        if (MODE == 1) {
#pragma unroll
            for (int j = 0; j < 4; ++j) *(f32x4*)(p.out + (size_t)m * D + 4 * lane + 256 * j) = v[j];
        }
        f32x4 s0 = (f32x4){0.f, 0.f, 0.f, 0.f}, s1 = s0;
#pragma unroll
        for (int j = 0; j < 4; ++j) { v[j] = v[j] * rs * nw[j];
            u32x2 o; o.x = pk2(v[j][0], v[j][1]); o.y = pk2(v[j][2], v[j][3]); *(u32x2*)(XN + (size_t)m * D + 4 * lane + 256 * j) = o;
#pragma unroll
            for (int c = 0; c < 4; ++c) { s0 += ws0[j * 4 + c] * v[j][c]; s1 += ws1[j * 4 + c] * v[j][c]; } }
        const bool b0 = lane & 1, b1 = lane & 2, b2 = lane & 4;
        f32x4 a;
#pragma unroll
        for (int i = 0; i < 4; ++i) { const float send = b0 ? s0[i] : s1[i]; const float recv = __shfl_xor(send, 1); a[i] = (b0 ? s1[i] : s0[i]) + recv; }
        float bb[2];
#pragma unroll
        for (int i = 0; i < 2; ++i) { const float send = b1 ? a[i] : a[2 + i]; const float recv = __shfl_xor(send, 2); bb[i] = (b1 ? a[2 + i] : a[i]) + recv; }
        float cc; { const float send = b2 ? bb[0] : bb[1]; const float recv = __shfl_xor(send, 4); cc = (b2 ? bb[1] : bb[0]) + recv; }
        cc += __shfl_xor(cc, 8); cc += __shfl_xor(cc, 16); cc += __shfl_xor(cc, 32);
        if (lane < 8) SMALL[(size_t)m * 8 + ((lane >> 2) & 1) + 2 * ((lane >> 1) & 1) + 4 * (lane & 1)] = cc;
    }
#undef NP_LOAD
    __syncthreads();
}

__device__ __forceinline__ void shortconv_unit(const Params& p, int layer, int tid, int unit) {
    const bf16* H = (const bf16*)(p.ws + WS_H); bf16* YS = (bf16*)(p.ws + WS_YS);
    const float* cw = p.in[I_SCW] + (size_t)layer * 3 * 512;
#pragma unroll 2
    for (int k = 0; k < 16; ++k) { const int it = unit * 8192 + k * 512 + tid;
        const int m = it >> 6, c8 = (it & 63) * 8, t = m & (T - 1);
        u32x4 rc[3], rx[3];
#pragma unroll
        for (int j = 0; j < 3; ++j) { const bool ok = (t - 2 + j >= 0); const bf16* r = H + (size_t)(ok ? m - 2 + j : m) * DH + HSC + c8; rc[j] = *(const u32x4*)(r + 512); rx[j] = *(const u32x4*)(r + 1024); if (!ok) rc[j] = (u32x4){0u, 0u, 0u, 0u}; }
        const u32x4 rb = *(const u32x4*)(H + (size_t)m * DH + HSC + c8);
        float acc[8];
#pragma unroll
        for (int i = 0; i < 8; ++i) acc[i] = 0.f;
#pragma unroll
        for (int j = 0; j < 3; ++j) { float cg[8], xv[8]; unpack8(rc[j], cg); unpack8(rx[j], xv);
#pragma unroll
            for (int i = 0; i < 8; ++i) acc[i] += cw[j * 512 + c8 + i] * (cg[i] * xv[i]); }
        float bg[8]; unpack8(rb, bg);
#pragma unroll
        for (int i = 0; i < 8; ++i) acc[i] *= bg[i];
        *(u32x4*)(YS + (size_t)m * 2048 + 1536 + c8) = pack8(acc);
    }
}
__device__ __forceinline__ int queue_pop(unsigned* counter, LAS unsigned char* lds, int tid) {
    LAS int* slot = (LAS int*)(lds + LDSCTL_OFF + LC_MISC);
    __syncthreads();
    if (tid == 0) slot[0] = (int)__hip_atomic_fetch_add(counter, 1u, __ATOMIC_RELAXED, __HIP_MEMORY_SCOPE_AGENT);
    __syncthreads();
    return slot[0];
}
__device__ __forceinline__ void conformer(const Params& p, int layer, LAS unsigned char* lds, int tid, int wave, int lane, unsigned* counter) {
    const bf16* H = (const bf16*)(p.ws + WS_H); bf16* YS = (bf16*)(p.ws + WS_YS);
    LAS bf16* yt = (LAS bf16*)lds;
    LAS float* zt = (LAS float*)(lds + 98304);
    const float* cwp = p.in[I_CCW] + (size_t)layer * 31 * 512;
    float cw[31];
#pragma unroll
    for (int j = 0; j < 31; ++j) cw[j] = cwp[j * 512 + tid];
    const float cb = p.in[I_CCB][layer * 512 + tid];
    float lw[8], lb[8];
#pragma unroll
    for (int i = 0; i < 8; ++i) { lw[i] = p.in[I_CLNW][layer * 512 + lane * 8 + i]; lb[i] = p.in[I_CLNB][layer * 512 + lane * 8 + i]; }
    for (;;) {
        const int unit = queue_pop(counter, lds, tid); if (unit >= M / 64) break;
        const int m0 = unit * 64, t0 = m0 & (T - 1);
        for (int base = 0; base < 94 * 64; base += 512 * 4) {
            u32x4 ra[4], rg[4];
#pragma unroll
            for (int k = 0; k < 4; ++k) { const int it = base + k * 512 + tid; const int r = it >> 6, c8 = (it & 63) * 8, dt = r - 30; const bool ok = (it < 94 * 64) && (t0 + dt >= 0);
                const bf16* s = H + (size_t)(ok ? m0 + dt : m0) * DH + HCONF + c8; ra[k] = *(const u32x4*)s; rg[k] = *(const u32x4*)(s + 512); }
#pragma unroll
            for (int k = 0; k < 4; ++k) { const int it = base + k * 512 + tid; const int r = it >> 6, c8 = (it & 63) * 8, dt = r - 30;
                if (it < 94 * 64) { u32x4 o = (u32x4){0u, 0u, 0u, 0u};
                    if (t0 + dt >= 0) { float a[8], g[8]; unpack8(ra[k], a); unpack8(rg[k], g);
#pragma unroll
                        for (int i = 0; i < 8; ++i) a[i] *= sigmoidf_(g[i]);
                        o = pack8(a); }
                    *(LAS u32x4*)(yt + r * 512 + c8) = o; } }
        }
        __syncthreads();
        for (int sb = 0; sb < 8; ++sb) {
            LAS float* zb = zt + (sb & 1) * 4096;
            float z[8];
#pragma unroll
            for (int i = 0; i < 8; ++i) z[i] = cb;
#pragma unroll
            for (int r = 0; r < 38; ++r) { const float yv = bf2f(yt[(sb * 8 + r) * 512 + tid]);
#pragma unroll
                for (int i = 0; i < 8; ++i) { const int j = r - i; if (j >= 0 && j < 31) z[i] += cw[j] * yv; } }
#pragma unroll
            for (int i = 0; i < 8; ++i) zb[i * 512 + tid] = z[i];
            __syncthreads();
            { const LAS float* zr = zb + wave * 512 + lane * 8; float v[8]; const f32x4 a = *(const LAS f32x4*)zr, b = *(const LAS f32x4*)(zr + 4);
                v[0] = a[0]; v[1] = a[1]; v[2] = a[2]; v[3] = a[3]; v[4] = b[0]; v[5] = b[1]; v[6] = b[2]; v[7] = b[3];
                float s = 0.f;
#pragma unroll
                for (int i = 0; i < 8; ++i) s += v[i];
                const float mean = wave_sum(s) * (1.0f / 512.0f); float q = 0.f;
#pragma unroll
                for (int i = 0; i < 8; ++i) { v[i] -= mean; q += v[i] * v[i]; }
                const float rstd = __builtin_amdgcn_rsqf(wave_sum(q) * (1.0f / 512.0f) + EPS);
#pragma unroll
                for (int i = 0; i < 8; ++i) v[i] = siluf_(v[i] * rstd * lw[i] + lb[i]);
                *(u32x4*)(YS + (size_t)(m0 + sb * 8 + wave) * 2048 + 512 + lane * 8) = pack8(v); }
        }
    }
}
__device__ __forceinline__ f32x4 mfma16(bf16x8 a, bf16x8 b, f32x4 c) { return __builtin_amdgcn_mfma_f32_16x16x32_bf16(a, b, c, 0, 0, 0); }
typedef short bf16x4 __attribute__((ext_vector_type(4)));
__device__ __forceinline__ bf16x8 ld_frag16(const LAS unsigned char* p) { return *(const LAS bf16x8*)p; }
__device__ __forceinline__ bf16x8 ld_frag8x2(const LAS unsigned char* p) { const bf16x4 a = *(const LAS bf16x4*)p, b = *(const LAS bf16x4*)(p + 32); return __builtin_shufflevector(a, b, 0, 1, 2, 3, 4, 5, 6, 7); }
__device__ __forceinline__ bf16x8 pack_frag(const f32x4 lo, const f32x4 hi) { u32x4 w; w.x = cvt_pk_bf16(lo[0], lo[1]); w.y = cvt_pk_bf16(lo[2], lo[3]); w.z = cvt_pk_bf16(hi[0], hi[1]); w.w = cvt_pk_bf16(hi[2], hi[3]); return __builtin_bit_cast(bf16x8, w); }
constexpr int GM_W = 0, GM_VT = 34816, GM_ST = 69632;
__device__ __forceinline__ void gmlp(const Params& p, int layer, LAS unsigned char* lds, int tid, int wave, int lane, unsigned* counter) {
    const bf16* H = (const bf16*)(p.ws + WS_H); bf16* YS = (bf16*)(p.ws + WS_YS);
    LAS float* st = (LAS float*)(lds + GM_ST);
    const float* lnw = p.in[I_GLNW] + layer * 512; const float* lnb = p.in[I_GLNB] + layer * 512;
    const int q = lane >> 4, li = lane & 15;
    for (;;) {
        const int unit = queue_pop(counter, lds, tid); if (unit >= M / 128) break;
        const int m0 = unit * 128;
        u32x4 rv[16];
#pragma unroll
        for (int k = 0; k < 16; ++k) rv[k] = *(const u32x4*)(H + (size_t)(m0 + wave * 16 + k) * DH + HGMLP + 512 + lane * 8);
#pragma unroll
        for (int k = 0; k < 16; ++k) { const int tk = wave * 16 + k;
            float v[8]; unpack8(rv[k], v);
            float s = 0.f;
#pragma unroll
            for (int i = 0; i < 8; ++i) { v[i] = gelu_tanh(v[i]); s += v[i]; }
            const float mean = wave_sum(s) * (1.0f / 512.0f); float qq = 0.f;
#pragma unroll
            for (int i = 0; i < 8; ++i) { const float d = v[i] - mean; qq += d * d; }
            const float rstd = 1.0f / sqrtf(wave_sum(qq) * (1.0f / 512.0f) + EPS);
            if (lane == 0) { st[tk * 2] = mean; st[tk * 2 + 1] = rstd; }
        }
        __syncthreads();
        for (int g = 0; g < 4; ++g) {
            u32x4 rg[4];
#pragma unroll
            for (int k = 0; k < 4; ++k) { const int it = tid + 512 * k; rg[k] = *(const u32x4*)(H + (size_t)(m0 + (it >> 4)) * DH + HGMLP + 512 + g * 128 + (it & 15) * 8); }
#pragma unroll
            for (int k = 0; k < 4; ++k) { const int it = tid + 512 * k; const int tk = it >> 4, c8 = (it & 15) * 8;
                float v[8]; unpack8(rg[k], v);
                const float mean = st[tk * 2], rstd = st[tk * 2 + 1];
#pragma unroll
                for (int i = 0; i < 8; ++i) *(LAS bf16*)(lds + GM_VT + (c8 + i) * 272 + 2 * tk) = (bf16)f2bf((gelu_tanh(v[i]) - mean) * rstd * lnw[g * 128 + c8 + i] + lnb[g * 128 + c8 + i]); }
            const float* ws = p.in[I_GWS] + ((size_t)layer * 4 + g) * 128 * 128;
            f32x4 wa[4], wb[4];
#pragma unroll
            for (int k = 0; k < 4; ++k) { const int it = tid + 512 * k; wa[k] = *(const f32x4*)(ws + (it >> 4) * 128 + (it & 15) * 8); wb[k] = *(const f32x4*)(ws + (it >> 4) * 128 + (it & 15) * 8 + 4); }
#pragma unroll
            for (int k = 0; k < 4; ++k) { const int it = tid + 512 * k; const int i = it >> 4, j8 = (it & 15) * 8;
                const f32x4 a = wa[k], b = wb[k];
                float w[8] = {a[0], a[1], a[2], a[3], b[0], b[1], b[2], b[3]};
#pragma unroll
                for (int e = 0; e < 8; ++e) w[e] = (j8 + e <= i) ? w[e] : 0.f;
                *(LAS u32x4*)(lds + GM_W + i * 272 + j8 * 2) = pack8(w); }
            __syncthreads();
            {
                f32x4 acc[8];
#pragma unroll
                for (int ct = 0; ct < 8; ++ct) acc[ct] = (f32x4){0.f, 0.f, 0.f, 0.f};
                const int nks = (wave >> 1) + 1;
                for (int ks = 0; ks < nks; ++ks) { const bf16x8 wf = ld_frag16(lds + GM_W + (16 * wave + li) * 272 + (32 * ks + 8 * q) * 2);
#pragma unroll
                    for (int ct = 0; ct < 8; ++ct) acc[ct] = mfma16(ld_frag16(lds + GM_VT + (16 * ct + li) * 272 + (32 * ks + 8 * q) * 2), wf, acc[ct]); }
                const int i = 16 * wave + li; const float bs = p.in[I_GBS][((size_t)layer * 4 + g) * 128 + i];
                const bf16* urow = H + (size_t)(m0 + i) * DH + HGMLP + g * 128 + 4 * q; bf16* orow = YS + (size_t)(m0 + i) * 2048 + 1024 + g * 128 + 4 * q;
#pragma unroll
                for (int ct = 0; ct < 8; ++ct) { const u32x2 uw = *(const u32x2*)(urow + 16 * ct);
                    const float o0 = gelu_tanh(bf_lo(uw.x)) * (acc[ct][0] + bs), o1 = gelu_tanh(bf_hi(uw.x)) * (acc[ct][1] + bs), o2 = gelu_tanh(bf_lo(uw.y)) * (acc[ct][2] + bs), o3 = gelu_tanh(bf_hi(uw.y)) * (acc[ct][3] + bs);
                    u32x2 ow; ow.x = pk2(o0, o1); ow.y = pk2(o2, o3); *(u32x2*)(orow + 16 * ct) = ow; }
            }
            __syncthreads();
        }
    }
}
constexpr int CP_QN = 0, CP_KN = 17408, CP_KT = 34816, CP_VT = 53248, CP_KGT = 71680, CP_A32 = 90112, CP_ATT = 106496, CP_T16 = 115712, CP_TAB = 124928;
__device__ __forceinline__ void gdn_chunk_prep(const Params& p, int layer, LAS unsigned char* lds, int tid, int wave, int lane) {
    const bf16* H = (const bf16*)(p.ws + WS_H); const float* SMALL = (const float*)(p.ws + WS_SMALL);
    const float* cw = p.in[I_GCONV] + (size_t)layer * 4 * 1536;
    LAS float* tab = (LAS float*)(lds + CP_TAB);
    const int q = lane >> 4, li = lane & 15;
    for (int unit = blockIdx.x; unit < 2048; unit += gridDim.x) {
        const int n = unit & 63, hh = (unit >> 6) & 3, b = unit >> 8; const int m0 = b * T + n * 64;
        unsigned char* rec = p.ws + WS_REC + (size_t)((b * 4 + hh) * 64 + n) * REC_BYTES;
        __syncthreads();
        if (wave == 0) { const int m = m0 + lane; const float br = SMALL[(size_t)m * 8 + hh], ar = SMALL[(size_t)m * 8 + 4 + hh];
            float g = -__expf(p.in[I_GALOG][layer * 4 + hh]) * softplusf_(ar + p.in[I_GDT][layer * 4 + hh]);
#pragma unroll
            for (int o = 1; o < 64; o <<= 1) { const float t = __shfl_up(g, o); if (lane >= o) g += t; }
            tab[lane] = sigmoidf_(br); tab[64 + lane] = g; tab[128 + lane] = __expf(g); }
        __syncthreads();
        {
            const int i0 = wave * 8, t0 = n * 64 + i0;
            unsigned raw[3][11];
#pragma unroll
            for (int s = 0; s < 3; ++s)
#pragma unroll
                for (int r = 0; r < 11; ++r) raw[s][r] = (t0 - 3 + r >= 0) ? *(const unsigned*)(H + (size_t)(m0 + i0 - 3 + r) * DH + s * 512 + hh * 128 + 2 * lane) : 0u;
            float w0[3][4], w1[3][4];
#pragma unroll
            for (int s = 0; s < 3; ++s)
#pragma unroll
                for (int j = 0; j < 4; ++j) { const f32x2 ww = *(const f32x2*)(cw + j * 1536 + s * 512 + hh * 128 + 2 * lane); w0[s][j] = ww[0]; w1[s][j] = ww[1]; }
#pragma unroll
            for (int ii = 0; ii < 8; ++ii) { const int i = i0 + ii;
                float y[3][2];
#pragma unroll
                for (int s = 0; s < 3; ++s) { float a0 = 0.f, a1 = 0.f;
#pragma unroll
                    for (int j = 0; j < 4; ++j) { a0 += w0[s][j] * bf_lo(raw[s][ii + j]); a1 += w1[s][j] * bf_hi(raw[s][ii + j]); }
                    y[s][0] = siluf_(a0); y[s][1] = siluf_(a1); }
                const float sq = wave_sum(y[0][0] * y[0][0] + y[0][1] * y[0][1]), sk = wave_sum(y[1][0] * y[1][0] + y[1][1] * y[1][1]);
                const float rq = 0.08838834764831845f * __builtin_amdgcn_rsqf(sq + EPS), rk = __builtin_amdgcn_rsqf(sk + EPS);
                const float be = tab[i], bg = be * tab[128 + i];
                const float k0 = y[1][0] * rk, k1 = y[1][1] * rk;
                *(LAS unsigned*)(lds + CP_QN + i * 272 + 4 * lane) = pk2(y[0][0] * rq, y[0][1] * rq);
                *(LAS unsigned*)(lds + CP_KN + i * 272 + 4 * lane) = pk2(k0, k1);
                *(LAS bf16*)(lds + CP_KT + (2 * lane) * 144 + 2 * i) = (bf16)f2bf(k0); *(LAS bf16*)(lds + CP_KT + (2 * lane + 1) * 144 + 2 * i) = (bf16)f2bf(k1);
                *(LAS bf16*)(lds + CP_VT + (2 * lane) * 144 + 2 * i) = (bf16)f2bf(be * y[2][0]); *(LAS bf16*)(lds + CP_VT + (2 * lane + 1) * 144 + 2 * i) = (bf16)f2bf(be * y[2][1]);
                *(LAS bf16*)(lds + CP_KGT + (2 * lane) * 144 + 2 * i) = (bf16)f2bf(bg * k0); *(LAS bf16*)(lds + CP_KGT + (2 * lane + 1) * 144 + 2 * i) = (bf16)f2bf(bg * k1);
            }
        }
        __syncthreads();
        for (int jb = wave; jb < 32; jb += 8) { const int which = jb >> 4, mt = (jb >> 2) & 3, nt = jb & 3;
            f32x4 acc = (f32x4){0.f, 0.f, 0.f, 0.f};
            if (nt <= mt) {
#pragma unroll
                for (int ks = 0; ks < 4; ++ks) acc = mfma16(ld_frag16(lds + (which ? CP_QN : CP_KN) + (16 * mt + li) * 272 + (32 * ks + 8 * q) * 2), ld_frag16(lds + CP_KN + (16 * nt + li) * 272 + (32 * ks + 8 * q) * 2), acc);
            }
            const int j = 16 * nt + li; const float gj = tab[64 + j];
#pragma unroll
            for (int r = 0; r < 4; ++r) { const int i = 16 * mt + 4 * q + r; const float gi = tab[64 + i];
                if (which == 0) { ((LAS float*)(lds + CP_A32))[i * 64 + j] = (i > j) ? tab[i] * acc[r] * __expf(gi - gj) : 0.f; }
                else { *(LAS bf16*)(lds + CP_ATT + i * 144 + 2 * j) = (bf16)f2bf((i >= j) ? acc[r] * __expf(gi - gj) : 0.f); } }
        }
        __syncthreads();
        if (wave == 0) {
            float Tc[64]; const float lanef = (float)lane;
            const LAS float* A = (const LAS float*)(lds + CP_A32); asm volatile("" : "+v"(A));
            LAS unsigned char* Tw = lds + CP_T16 + 2 * lane; asm volatile("" : "+v"(Tw));
#pragma unroll
            for (int i = 0; i < 64; ++i) { float a4[4] = {fmaxf(0.f, 1.f - fabsf((float)i - lanef)), 0.f, 0.f, 0.f};
#pragma unroll
                for (int j = 0; j < i; j += 4) { const f32x4 av = *(const LAS f32x4*)(A + i * 64 + j);
#pragma unroll
                    for (int jj = 0; jj < 4; ++jj) if (j + jj < i) a4[jj] -= av[jj] * Tc[j + jj]; }
                const float a = (a4[0] + a4[1]) + (a4[2] + a4[3]);
                Tc[i] = a; *(LAS bf16*)(Tw + i * 144) = (bf16)f2bf(a); }
        } else {
            const int t2 = tid - 64;
            for (int pc = t2; pc < 1024; pc += 448) { const int row = pc >> 4, seg = pc & 15; *(u32x4*)(rec + REC_Q + pc * 16) = *(const LAS u32x4*)(lds + CP_QN + row * 272 + seg * 16); }
            for (int pc = t2; pc < 512; pc += 448) { const int row = pc >> 3, seg = pc & 7; *(u32x4*)(rec + REC_ATT + pc * 16) = *(const LAS u32x4*)(lds + CP_ATT + row * 144 + seg * 16); }
            for (int pc = t2; pc < 1024; pc += 448) { const int row = pc >> 3, seg = pc & 7; *(u32x4*)(rec + REC_KT + pc * 16) = *(const LAS u32x4*)(lds + CP_KT + row * 144 + seg * 16); }
            if (t2 < 16) *(u32x4*)(rec + REC_G + t2 * 16) = *(const LAS u32x4*)(lds + CP_TAB + 256 + t2 * 16);
        }
        __syncthreads();
        for (int jb = wave; jb < 64; jb += 8) {
            f32x4 acc = (f32x4){0.f, 0.f, 0.f, 0.f};
            if (jb < 32) { const int mt = jb >> 3, nt = jb & 7;
#pragma unroll
                for (int ks = 0; ks < 2; ++ks) acc = mfma16(ld_frag16(lds + CP_T16 + (16 * mt + li) * 144 + (32 * ks + 8 * q) * 2), ld_frag16(lds + CP_VT + (16 * nt + li) * 144 + (32 * ks + 8 * q) * 2), acc);
                u32x2 o; o.x = pk2(acc[0], acc[1]); o.y = pk2(acc[2], acc[3]);
                *(u32x2*)(rec + REC_U + (size_t)((nt * 64 + lane) * 4 + mt) * 8) = o;
            } else { const int mt = (jb - 32) >> 2, nt = (jb - 32) & 3;
#pragma unroll
                for (int ks = 0; ks < 2; ++ks) acc = mfma16(ld_frag16(lds + CP_KGT + (16 * mt + li) * 144 + (32 * ks + 8 * q) * 2), ld_frag16(lds + CP_T16 + (16 * nt + li) * 144 + (32 * ks + 8 * q) * 2), acc);
                u32x2 o; o.x = pk2(acc[0], acc[1]); o.y = pk2(acc[2], acc[3]);
                *(u32x2*)(rec + REC_W + (size_t)((16 * nt + li) * 128 + 16 * mt + 4 * q) * 2) = o;
            }
        }
    }
    __syncthreads();
}
constexpr int SC_W = 0, SC_KT = 17408, SC_G = 35840, SC_BUF = 36096;
__device__ __forceinline__ void gdn_chunk_scan(const Params& p, LAS unsigned char* lds, int tid, int wave, int lane, int bh, int half) {
    const int q = lane >> 4, li = lane & 15, sl = half * 4 + (wave & 3);
    unsigned char* rec0 = p.ws + WS_REC + (size_t)(bh * 64) * REC_BYTES;
    u32x4* S0F = (u32x4*)(p.ws + WS_OBUF) + (size_t)(bh * 64) * 8 * 4 * 64;
    u32x4 pf[4], pfg = (u32x4){0u, 0u, 0u, 0u}, pu[2];
#define SC_LOAD(nn) do { const unsigned char* r_ = rec0 + (size_t)(nn) * REC_BYTES; \
        pf[0] = *(const u32x4*)(r_ + REC_W + (size_t)tid * 16); pf[1] = *(const u32x4*)(r_ + REC_W + (size_t)(tid + 512) * 16); \
        pf[2] = *(const u32x4*)(r_ + REC_KT + (size_t)tid * 16); pf[3] = *(const u32x4*)(r_ + REC_KT + (size_t)(tid + 512) * 16); \
        if (tid < 16) pfg = *(const u32x4*)(r_ + REC_G + tid * 16); \
        pu[0] = *(const u32x4*)(r_ + REC_U + (size_t)(sl * 64 + lane) * 32); pu[1] = *(const u32x4*)(r_ + REC_U + (size_t)(sl * 64 + lane) * 32 + 16); } while (0)
#define SC_STORE(buf) do { LAS unsigned char* d_ = lds + (buf) * SC_BUF; \
        _Pragma("unroll") for (int k_ = 0; k_ < 2; ++k_) { const int pc_ = tid + 512 * k_; *(LAS u32x4*)(d_ + SC_W + (pc_ >> 4) * 272 + (pc_ & 15) * 16) = pf[k_]; \
            *(LAS u32x4*)(d_ + SC_KT + (pc_ >> 3) * 144 + (pc_ & 7) * 16) = pf[2 + k_]; } \
        if (tid < 16) *(LAS u32x4*)(d_ + SC_G + tid * 16) = pfg; } while (0)
    f32x4 S[8];
#pragma unroll
    for (int i = 0; i < 8; ++i) S[i] = (f32x4){0.f, 0.f, 0.f, 0.f};
    __syncthreads();
    SC_LOAD(0); SC_STORE(0);
    u32x4 cu[2]; cu[0] = pu[0]; cu[1] = pu[1];
    __syncthreads();
    for (int n = 0; n < 64; ++n) {
        const LAS unsigned char* L = lds + (n & 1) * SC_BUF;
        if (n + 1 < 64) SC_LOAD(n + 1);
        if (wave < 4) {
            bf16x8 Sb[4];
#pragma unroll
            for (int ks = 0; ks < 4; ++ks) { Sb[ks] = pack_frag(S[2 * ks], S[2 * ks + 1]); S0F[(size_t)((n * 8 + sl) * 4 + ks) * 64 + lane] = __builtin_bit_cast(u32x4, Sb[ks]); }
            f32x4 a1[4];
#pragma unroll
            for (int mt = 0; mt < 4; ++mt) { a1[mt] = (f32x4){0.f, 0.f, 0.f, 0.f};
#pragma unroll
                for (int ks = 0; ks < 4; ++ks) a1[mt] = mfma16(ld_frag8x2(L + SC_W + (16 * mt + li) * 272 + (32 * ks + 4 * q) * 2), Sb[ks], a1[mt]); }
            const float g63 = *(const LAS float*)(L + SC_G + 63 * 4);
            f32x4 vn[4], vd[4];
#pragma unroll
            for (int mt = 0; mt < 4; ++mt) { const f32x4 gi = *(const LAS f32x4*)(L + SC_G + (16 * mt + 4 * q) * 4);
                const unsigned ulo = (mt < 2) ? (mt == 0 ? cu[0].x : cu[0].z) : (mt == 2 ? cu[1].x : cu[1].z), uhi = (mt < 2) ? (mt == 0 ? cu[0].y : cu[0].w) : (mt == 2 ? cu[1].y : cu[1].w);
                const f32x4 uu = (f32x4){bf_lo(ulo), bf_hi(ulo), bf_lo(uhi), bf_hi(uhi)};
                vn[mt] = uu - a1[mt];
#pragma unroll
                for (int r = 0; r < 4; ++r) vd[mt][r] = vn[mt][r] * fexp(g63 - gi[r]); }
            bf16x8 Vb[2], Vd[2];
#pragma unroll
            for (int ks = 0; ks < 2; ++ks) { Vb[ks] = pack_frag(vn[2 * ks], vn[2 * ks + 1]); Vd[ks] = pack_frag(vd[2 * ks], vd[2 * ks + 1]); }
            { unsigned char* ru = rec0 + (size_t)n * REC_BYTES + REC_U + (size_t)(sl * 64 + lane) * 32;
                *(u32x4*)ru = __builtin_bit_cast(u32x4, Vb[0]); *(u32x4*)(ru + 16) = __builtin_bit_cast(u32x4, Vb[1]); }
            const float eg = fexp(g63);
#pragma unroll
            for (int mt = 0; mt < 8; ++mt) { f32x4 a4 = (f32x4){0.f, 0.f, 0.f, 0.f};
#pragma unroll
                for (int ks = 0; ks < 2; ++ks) a4 = mfma16(ld_frag8x2(L + SC_KT + (16 * mt + li) * 144 + (32 * ks + 4 * q) * 2), Vd[ks], a4);
                S[mt] = S[mt] * eg + a4; }
        }
        if (n + 1 < 64) { SC_STORE((n + 1) & 1); cu[0] = pu[0]; cu[1] = pu[1]; }
        __syncthreads();
    }
#undef SC_LOAD
#undef SC_STORE
}
constexpr int CO_Q = 0, CO_ATT = 17408, CO_G = 26624, CO_PART = 26880;
__device__ __forceinline__ void gdn_chunk_out(const Params& p, int layer, LAS unsigned char* lds, int tid, int wave, int lane) {
    const bf16* H = (const bf16*)(p.ws + WS_H); bf16* YS = (bf16*)(p.ws + WS_YS);
    const int q = lane >> 4, li = lane & 15;
    const f32x4 nw = *(const f32x4*)(p.in[I_GNW] + layer * 128 + 16 * wave + 4 * q);
    LAS float* part = (LAS float*)(lds + CO_PART);
    for (int unit = blockIdx.x; unit < 2048; unit += gridDim.x) {
        const int n = unit & 63, bh = unit >> 6, hh = bh & 3, b = bh >> 2; const int m0 = b * T + n * 64;
        const unsigned char* rec = p.ws + WS_REC + (size_t)(bh * 64 + n) * REC_BYTES;
        const u32x4* S0F = (const u32x4*)(p.ws + WS_OBUF) + (size_t)((bh * 64 + n) * 8 + wave) * 4 * 64;
        const u32x4 rq0 = *(const u32x4*)(rec + REC_Q + (size_t)tid * 16), rq1 = *(const u32x4*)(rec + REC_Q + (size_t)(tid + 512) * 16), ra = *(const u32x4*)(rec + REC_ATT + (size_t)tid * 16);
        u32x4 rg = (u32x4){0u, 0u, 0u, 0u}; if (tid < 16) rg = *(const u32x4*)(rec + REC_G + tid * 16);
        bf16x8 sf[4], vf[2];
#pragma unroll
        for (int ks = 0; ks < 4; ++ks) sf[ks] = __builtin_bit_cast(bf16x8, S0F[ks * 64 + lane]);
        vf[0] = __builtin_bit_cast(bf16x8, *(const u32x4*)(rec + REC_U + (size_t)(wave * 64 + lane) * 32)); vf[1] = __builtin_bit_cast(bf16x8, *(const u32x4*)(rec + REC_U + (size_t)(wave * 64 + lane) * 32 + 16));
        u32x2 zr[4];
#pragma unroll
        for (int mt = 0; mt < 4; ++mt) zr[mt] = *(const u32x2*)(H + (size_t)(m0 + 16 * mt + li) * DH + HZ + hh * 128 + 16 * wave + 4 * q);
        __syncthreads();
        *(LAS u32x4*)(lds + CO_Q + (tid >> 4) * 272 + (tid & 15) * 16) = rq0; *(LAS u32x4*)(lds + CO_Q + ((tid + 512) >> 4) * 272 + (tid & 15) * 16) = rq1;
        *(LAS u32x4*)(lds + CO_ATT + (tid >> 3) * 144 + (tid & 7) * 16) = ra;
        if (tid < 16) *(LAS u32x4*)(lds + CO_G + tid * 16) = rg;
        __syncthreads();
        f32x4 o[4]; float ss[4];
#pragma unroll
        for (int mt = 0; mt < 4; ++mt) { f32x4 a2 = (f32x4){0.f, 0.f, 0.f, 0.f}, a3 = (f32x4){0.f, 0.f, 0.f, 0.f};
#pragma unroll
            for (int ks = 0; ks < 4; ++ks) a2 = mfma16(sf[ks], ld_frag8x2(lds + CO_Q + (16 * mt + li) * 272 + (32 * ks + 4 * q) * 2), a2);
#pragma unroll
            for (int ks = 0; ks < 2; ++ks) a3 = mfma16(vf[ks], ld_frag8x2(lds + CO_ATT + (16 * mt + li) * 144 + (32 * ks + 4 * q) * 2), a3);
            const float gam = fexp(*(const LAS float*)(lds + CO_G + (16 * mt + li) * 4));
            o[mt] = a2 * gam + a3;
            float s = (o[mt][0] * o[mt][0] + o[mt][1] * o[mt][1]) + (o[mt][2] * o[mt][2] + o[mt][3] * o[mt][3]);
            s += __shfl_xor(s, 16); s += __shfl_xor(s, 32);
            if (q == 0) part[(16 * mt + li) * 8 + wave] = s; }
        __syncthreads();
#pragma unroll
        for (int mt = 0; mt < 4; ++mt) { const f32x4 pa = *(const LAS f32x4*)(part + (16 * mt + li) * 8), pb = *(const LAS f32x4*)(part + (16 * mt + li) * 8 + 4);
            ss[mt] = ((pa[0] + pa[1]) + (pa[2] + pa[3])) + ((pb[0] + pb[1]) + (pb[2] + pb[3]));
            const float rs = __builtin_amdgcn_rsqf(ss[mt] * (1.0f / 128.0f) + EPS);
            u32x2 w; w.x = pk2(o[mt][0] * rs * nw[0] * siluf_(bf_lo(zr[mt].x)), o[mt][1] * rs * nw[1] * siluf_(bf_hi(zr[mt].x)));
            w.y = pk2(o[mt][2] * rs * nw[2] * siluf_(bf_lo(zr[mt].y)), o[mt][3] * rs * nw[3] * siluf_(bf_hi(zr[mt].y)));
            *(u32x2*)(YS + (size_t)(m0 + 16 * mt + li) * 2048 + hh * 128 + 16 * wave + 4 * q) = w; }
    }
    __syncthreads();
}
__device__ __forceinline__ void sum_gated(const Params& p, int gtid, int NGT) {
    const bf16* H = (const bf16*)(p.ws + WS_H); bf16* MG = (bf16*)(p.ws + WS_MERGED);
    for (int it = gtid; it < M * 128; it += NGT) { const int m = it >> 7, c8 = (it & 127) * 8; const bf16* r = H + (size_t)m * DH + HGATE + c8;
        float a[8], b[8];
        unpack8(*(const u32x4*)r, a);
#pragma unroll
        for (int br = 1; br < 4; ++br) { unpack8(*(const u32x4*)(r + br * 1024), b);
#pragma unroll
            for (int i = 0; i < 8; ++i) a[i] += b[i]; }
        *(u32x4*)(MG + (size_t)m * D + c8) = pack8(a); }
}

constexpr size_t WS_WRT = WS_MOETAB + MiB; constexpr int WRT_N = 80 * 1024;
__device__ __forceinline__ void prep_router_tables(const Params& p, int gtid, int NGT) {
    bf16* WRT = (bf16*)(p.ws + WS_WRT);
    for (int idx = gtid; idx < NLAYER * WRT_N; idx += NGT) { const int l = idx / WRT_N, n = (idx % WRT_N) >> 10, k = idx & 1023;
        const float w = (n < 64) ? p.in[I_REXP][((size_t)l * D + k) * 64 + n] : (n < 72 ? p.in[I_RGRP][((size_t)l * D + k) * 8 + (n - 64)] : 0.f);
        const unsigned hi = f2bf(w); const float wl = w - __uint_as_float(hi << 16);
        WRT[(size_t)(l * 2) * WRT_N + (idx % WRT_N)] = (bf16)hi; WRT[(size_t)(l * 2 + 1) * WRT_N + (idx % WRT_N)] = (bf16)f2bf(wl); }
}
__device__ __forceinline__ void moe_route_vb(const Params& p, int layer, LAS unsigned char* lds, int tid, int wave, int lane, int vb, const f32x4 (&nw)[4]) {
    LAS int* hist = (LAS int*)(lds + LDSCTL_OFF + LC_TAB);
    bf16* XN = (bf16*)(p.ws + WS_XN);
    int* route_e = (int*)(p.ws + WS_ROUTE); float* route_w = (float*)(p.ws + WS_ROUTE + (size_t)M * 2 * 4);
    int* cnt = (int*)(p.ws + WS_MOETAB + (size_t)NROWS_MAX * 8);
    const bf16* Wh = (const bf16*)(p.ws + WS_WRT) + (size_t)(layer * 2) * WRT_N; const bf16* Wl = Wh + WRT_N;
    const int q = lane >> 4, li = lane & 15;
    __syncthreads();
    if (tid < 64) hist[tid] = 0;
    for (int tile = 0; tile < 4; ++tile) {
        const int m0 = vb * 128 + tile * 32;
        __syncthreads();
        for (int hb = 0; hb < 2; ++hb) {
        f32x4 v[2][4];
#pragma unroll
        for (int rr = 0; rr < 2; ++rr)
#pragma unroll
            for (int j = 0; j < 4; ++j) v[rr][j] = *(const f32x4*)(p.out + (size_t)(m0 + wave * 4 + hb * 2 + rr) * D + 4 * lane + 256 * j);
#pragma unroll
        for (int rr = 0; rr < 2; ++rr) { const int r = wave * 4 + hb * 2 + rr, m = m0 + r; float ss = 0.f;
#pragma unroll
            for (int j = 0; j < 4; ++j) ss += (v[rr][j][0] * v[rr][j][0] + v[rr][j][1] * v[rr][j][1]) + (v[rr][j][2] * v[rr][j][2] + v[rr][j][3] * v[rr][j][3]);
            const float rs = __builtin_amdgcn_rsqf(wave_sum(ss) * (1.0f / D) + EPS);
#pragma unroll
            for (int j = 0; j < 4; ++j) { const f32x4 x = v[rr][j] * rs * nw[j];
                u32x2 h; h.x = pk2(x[0], x[1]); h.y = pk2(x[2], x[3]);
                u32x2 l; l.x = pk2(x[0] - bf_lo(h.x), x[1] - bf_hi(h.x)); l.y = pk2(x[2] - bf_lo(h.y), x[3] - bf_hi(h.y));
                *(u32x2*)(XN + (size_t)m * D + 4 * lane + 256 * j) = h;
                const int off = r * 2048 + ((((lane >> 1) + 32 * j) ^ (r & 15)) << 4) + (lane & 1) * 8;
                *(LAS u32x2*)(lds + off) = h; *(LAS u32x2*)(lds + 65536 + off) = l; } }
        }
        __syncthreads();
        f32x4 acc[2][5];
#pragma unroll
        for (int mt = 0; mt < 2; ++mt)
#pragma unroll
            for (int nt = 0; nt < 5; ++nt) acc[mt][nt] = (f32x4){0.f, 0.f, 0.f, 0.f};
        {
            const bf16* bp = Wh + (size_t)li * 1024 + 128 * wave + 8 * q;
#pragma unroll
            for (int ks = 0; ks < 4; ++ks) {
                bf16x8 ah[2], al[2];
#pragma unroll
                for (int mt = 0; mt < 2; ++mt) { const int off = (16 * mt + li) * 2048 + (((16 * wave + 4 * ks + q) ^ li) << 4); ah[mt] = ld_frag16(lds + off); al[mt] = ld_frag16(lds + 65536 + off); }
#pragma unroll
                for (int nt = 0; nt < 5; ++nt) { const bf16x8 bh = *(const bf16x8*)(bp + nt * 16384 + 32 * ks), bl = *(const bf16x8*)(bp + WRT_N + nt * 16384 + 32 * ks);
#pragma unroll
                    for (int mt = 0; mt < 2; ++mt) { acc[mt][nt] = mfma16(ah[mt], bh, acc[mt][nt]); acc[mt][nt] = mfma16(al[mt], bh, acc[mt][nt]); acc[mt][nt] = mfma16(ah[mt], bl, acc[mt][nt]); } }
            }
        }
        __syncthreads();
        LAS float* part = (LAS float*)lds;
#pragma unroll
        for (int mt = 0; mt < 2; ++mt)
#pragma unroll
            for (int nt = 0; nt < 5; ++nt) { if (16 * nt + li < 72) {
#pragma unroll
                for (int r = 0; r < 4; ++r) part[(wave * 32 + 16 * mt + 4 * q + r) * 72 + 16 * nt + li] = acc[mt][nt][r]; } }
        __syncthreads();
        for (int r = wave * 4; r < wave * 4 + 4; ++r) { const int m = m0 + r;
            float le = 0.f, lg = 0.f;
#pragma unroll
            for (int w = 0; w < 8; ++w) { le += part[(w * 32 + r) * 72 + lane]; lg += part[(w * 32 + r) * 72 + 64 + (lane & 7)]; }
            float gv[8];
#pragma unroll
            for (int i = 0; i < 8; ++i) gv[i] = __shfl(lg, i);
            int grp = 0; float gmax = gv[0];
#pragma unroll
            for (int i = 1; i < 8; ++i) if (gv[i] > gmax) { gmax = gv[i]; grp = i; }
            float gs = 0.f;
#pragma unroll
            for (int i = 0; i < 8; ++i) gs += __expf(gv[i] - gmax);
            const float psel = 1.0f / gs;
            float ev[8];
#pragma unroll
            for (int i = 0; i < 8; ++i) ev[i] = __shfl(le, grp * 8 + i);
            int i1 = 0; float e1 = ev[0];
#pragma unroll
            for (int i = 1; i < 8; ++i) if (ev[i] > e1) { e1 = ev[i]; i1 = i; }
            int i2 = -1; float e2 = -3.0e38f;
#pragma unroll
            for (int i = 0; i < 8; ++i) if (i != i1 && ev[i] > e2) { e2 = ev[i]; i2 = i; }
            const float x2 = __expf(e2 - e1), w1 = psel / (1.0f + x2), w2 = psel * x2 / (1.0f + x2);
            if (lane == 0) { route_e[(size_t)m * 2] = grp * 8 + i1; route_e[(size_t)m * 2 + 1] = grp * 8 + i2; route_w[(size_t)m * 2] = w1; route_w[(size_t)m * 2 + 1] = w2;
                atomicAdd((int*)(hist + grp * 8 + i1), 1); atomicAdd((int*)(hist + grp * 8 + i2), 1); }
        }
    }
    __syncthreads();
    if (tid < 64) cnt[vb * 64 + tid] = hist[tid];
}
__device__ __forceinline__ void moe_route(const Params& p, int layer, LAS unsigned char* lds, int tid, int wave, int lane) {
    f32x4 nw[4];
#pragma unroll
    for (int j = 0; j < 4; ++j) nw[j] = *(const f32x4*)(p.in[I_MOENW] + layer * D + 4 * lane + 256 * j);
    for (int vb = blockIdx.x; vb < M / 128; vb += gridDim.x) moe_route_vb(p, layer, lds, tid, wave, lane, vb, nw);
    __syncthreads();
}
__device__ __forceinline__ void moe_dispatch(const Params& p, LAS unsigned char* lds, int tid, int wave, int lane) {
    LAS int* tab = (LAS int*)(lds + LDSCTL_OFF + LC_TAB);
    const bf16* XN = (const bf16*)(p.ws + WS_XN); bf16* XS = (bf16*)(p.ws + WS_XS);
    const int* route_e = (const int*)(p.ws + WS_ROUTE); const float* route_w = (const float*)(p.ws + WS_ROUTE + (size_t)M * 2 * 4);
    int* row_code = (int*)(p.ws + WS_MOETAB); float* row_w = (float*)(p.ws + WS_MOETAB + (size_t)NROWS_MAX * 4);
    const int* cnt = (const int*)(p.ws + WS_MOETAB + (size_t)NROWS_MAX * 8); int* blk_e = (int*)(p.ws + WS_MOETAB + (size_t)NROWS_MAX * 8 + 256 * 64 * 4);
    for (int vb = blockIdx.x; vb < M / 128; vb += gridDim.x) {
        __syncthreads();
        {
            const int e = tid & 63, part = tid >> 6; int run = 0, base = 0;
#pragma unroll 8
            for (int v = part * 32; v < part * 32 + 32; ++v) { const int c = cnt[v * 64 + e]; if (v < vb) base += c; run += c; }
            tab[720 + part * 64 + e] = run; tab[1240 + part * 64 + e] = base;
        }
        __syncthreads();
        if (tid < 64) { int run = 0, base = 0;
#pragma unroll
            for (int k = 0; k < 8; ++k) { run += tab[720 + k * 64 + tid]; base += tab[1240 + k * 64 + tid]; }
            tab[64 + tid] = run; tab[128 + tid] = base; }
        __syncthreads();
        if (tid == 0) { int s = 0; for (int e = 0; e < 64; ++e) { tab[e] = s; s += (tab[64 + e] + 255) / 256 * 256; } tab[704] = s; }
        if (tid < 256) tab[192 + tid] = route_e[(size_t)vb * 256 + tid];
        __syncthreads();
        if (tid < 256) { const int e = tab[192 + tid]; int rank = 0; for (int a = 0; a < tid; ++a) rank += (tab[192 + a] == e) ? 1 : 0;
            const int pos = tab[e] + tab[128 + e] + rank; tab[448 + tid] = pos;
            row_code[pos] = ((vb * 128 + (tid >> 1)) << 1) | (tid & 1); row_w[pos] = route_w[(size_t)vb * 256 + tid]; }
        if (vb < 64) { const int ps = tab[vb], tot = tab[64 + vb], pe = ps + (tot + 255) / 256 * 256;
            for (int r = ps + tot + tid; r < pe; r += 512) row_code[r] = -1;
            for (int b = ps / 256 + tid; b < pe / 256; b += 512) blk_e[b] = vb;
            if (tid == 0) { blk_e[NROWBLK_MAX + 64 + vb] = ps / 256; blk_e[NROWBLK_MAX + 128 + vb] = (pe - ps) / 256; }
            if (vb == 63 && tid == 0) blk_e[NROWBLK_MAX] = tab[704] / 256; }
        __syncthreads();
        for (int a0 = wave * 32; a0 < wave * 32 + 32; a0 += 8) {
            u32x4 r0[8], r1[8];
#pragma unroll
            for (int k = 0; k < 8; ++k) { const u32x4* src = (const u32x4*)(XN + (size_t)(vb * 128 + ((a0 + k) >> 1)) * D); r0[k] = src[lane]; r1[k] = src[lane + 64]; }
#pragma unroll
            for (int k = 0; k < 8; ++k) { u32x4* dst = (u32x4*)(XS + (size_t)tab[448 + a0 + k] * D); dst[lane] = r0[k]; dst[lane + 64] = r1[k]; } }
    }
    __syncthreads();
}

__global__ void __launch_bounds__(512, 2) fwd(Params p) {
    extern __shared__ __attribute__((aligned(16))) unsigned char lds_raw[];
    LAS unsigned char* lds = (LAS unsigned char*)lds_raw;
    const int tid0 = threadIdx.x;
    const int G = gridDim.x, NGW = G * 8, NGT = G * 512;
#define FRESH() Params pl = p; { GAS unsigned char* w_ = (GAS unsigned char*)pl.ws; GAS float* o_ = (GAS float*)pl.out; asm volatile("" : "+s"(w_), "+s"(o_)); pl.ws = (unsigned char*)w_; pl.out = (float*)o_; }     int tid = tid0; asm volatile("" : "+v"(tid)); const int lane = tid & 63, wave = __builtin_amdgcn_readfirstlane(tid >> 6); const int gw = blockIdx.x * 8 + wave, gtid = blockIdx.x * 512 + tid; (void)lane; (void)gw; (void)gtid
    for (int u = tid0; u < (LDS_BYTES - LDSCTL_OFF) / 4; u += 512) ((LAS unsigned*)(lds + LDSCTL_OFF))[u] = 0u;
    __syncthreads();
    const int lo = p.ph_lo, hi = p.ph_hi;
    XcdBarrier bar; bar.bar = (unsigned*)(p.ws + WS_CTL) + CW_BAR; bar.x = 0; bar.st = (volatile LAS unsigned*)(lds + LDSCTL_OFF + LC_BAR);
    if (hi - lo > 1) bar = xcd_barrier_post((unsigned*)(p.ws + WS_CTL) + CW_BAR, (volatile LAS unsigned*)(lds + LDSCTL_OFF + LC_BAR));
#ifndef PHASE_MASK
#define PHASE_MASK 0x1fff
#endif
#define IN(k) (((PHASE_MASK >> ((k) == PH_FINAL ? 12 : ((k) % PH_PER_LAYER))) & 1) && lo <= (k) && (k) < hi)
#define REPS(k) ((((REPEAT_MASK) >> (k)) & 1) && layer == 0 ? 2 : 1)
#define SEAM(k) do { if (IN(k) && IN((k) + 1)) xcd_barrier(bar); } while (0)

    for (int layer = 0; layer < NLAYER; ++layer) {
        const int g0 = layer * PH_PER_LAYER;

        for (int rep_ = 0; rep_ < REPS(0); ++rep_) if (IN(g0 + 0)) { if (rep_) __syncthreads(); FRESH();
            if (layer == 0) { prep_static_weights(pl, gw, NGW, lane); prep_router_tables(pl, gtid, NGT); __syncthreads(); norm_phase<0>(pl, layer, lds, gw, NGW, tid, lane); }
            else norm_phase<1>(pl, layer, lds, gw, NGW, tid, lane);
        }
        SEAM(g0 + 0);
        for (int rep_ = 0; rep_ < REPS(1); ++rep_) if (IN(g0 + 1)) { if (rep_) __syncthreads(); FRESH();
            SchedH S; S.to.init(M / 256, DH / 256, G, (int)blockIdx.x); S.A = (const char*)(pl.ws + WS_XN); S.B = (const char*)(pl.ws + WS_WIN + layer * WIN_L);
            EpiStoreBf16 E{(bf16*)(pl.ws + WS_H), DH};
            pg8::gemm_phase(lds, tid, D, D, D, S, E);
        }
        SEAM(g0 + 1);
        for (int rep_ = 0; rep_ < REPS(2); ++rep_) if (IN(g0 + 2)) { if (rep_) __syncthreads(); FRESH(); gdn_chunk_prep(pl, layer, lds, tid, wave, lane); }
        SEAM(g0 + 2);
        for (int rep_ = 0; rep_ < REPS(3); ++rep_) if (IN(g0 + 3)) { if (rep_) __syncthreads(); FRESH();
            if ((int)blockIdx.x < 64) gdn_chunk_scan(pl, lds, tid, wave, lane, (int)blockIdx.x >> 1, (int)blockIdx.x & 1);
            {
                unsigned* qc = (unsigned*)(pl.ws + WS_CTL) + CW_QUEUE + layer * 256;
                gmlp(pl, layer, lds, tid, wave, lane, qc);
                conformer(pl, layer, lds, tid, wave, lane, qc + 64);
                for (;;) { const int unit = queue_pop(qc + 128, lds, tid); if (unit >= M / 128) break; shortconv_unit(pl, layer, tid, unit); }
            }
        }
        SEAM(g0 + 3);
        for (int rep_ = 0; rep_ < REPS(4); ++rep_) if (IN(g0 + 4)) { if (rep_) __syncthreads(); FRESH(); gdn_chunk_out(pl, layer, lds, tid, wave, lane); }
        SEAM(g0 + 4);
        for (int rep_ = 0; rep_ < REPS(5); ++rep_) if (IN(g0 + 5)) { if (rep_) __syncthreads(); FRESH();
            SchedBranch S; S.to.init(M / 256, 4, G, (int)blockIdx.x); S.YS = (const char*)(pl.ws + WS_YS); S.WBR = (const char*)(pl.ws + WS_WBR + layer * WBR_L);
            EpiGate E{(bf16*)(pl.ws + WS_H) + HGATE, (bf16*)(pl.ws + WS_MERGED)};
            pg8::gemm_phase(lds, tid, 512, 2048, 512, S, E);
        }
        for (int rep_ = 0; rep_ < REPS(6); ++rep_) if (IN(g0 + 6)) { if (rep_) __syncthreads(); FRESH();   }
        SEAM(g0 + 6);
        for (int rep_ = 0; rep_ < REPS(7); ++rep_) if (IN(g0 + 7)) { if (rep_) __syncthreads(); FRESH();
            const int NGB = G / 2;
            if ((int)blockIdx.x < NGB) {
                SchedOut S; S.to.init(M / 256, 4, NGB, (int)blockIdx.x); S.A = (const char*)(pl.ws + WS_MERGED); S.B = (const char*)(pl.ws + WS_WOUT + layer * WOUT_L);
                EpiResF32 E{layer == 0 ? pl.in[I_X] : pl.out, pl.out};
                pg8::gemm_phase(lds, tid, D, D, D, S, E);
            } else prep_moe_weights(pl, layer, ((int)blockIdx.x - NGB) * 8 + wave, (G - NGB) * 8, lane);
        }
        SEAM(g0 + 7);
        for (int rep_ = 0; rep_ < REPS(8); ++rep_) if (IN(g0 + 8)) { if (rep_) __syncthreads(); FRESH(); moe_route(pl, layer, lds, tid, wave, lane); }
        SEAM(g0 + 8);
        for (int rep_ = 0; rep_ < REPS(9); ++rep_) if (IN(g0 + 9)) { if (rep_) __syncthreads(); FRESH(); moe_dispatch(pl, lds, tid, wave, lane); }
        SEAM(g0 + 9);
        if (IN(g0 + 10) || IN(g0 + 11)) { FRESH();
            LAS int* tb = (LAS int*)(lds + LDSCTL_OFF + LC_TAB);
            const int* est = (const int*)(pl.ws + WS_MOETAB + (size_t)NROWS_MAX * 8 + 256 * 64 * 4) + NROWBLK_MAX + 64;
            const int NX = (G % 8 == 0) ? 8 : 1, x = (int)blockIdx.x % NX, nk = 64 / NX;
            __syncthreads();
            if (tid < nk) { tb[160 + tid] = est[x + NX * tid]; tb[240 + tid] = est[64 + x + NX * tid]; }
            __syncthreads();
            if (tid == 0) { int s = 0; for (int k = 0; k < nk; ++k) { tb[k] = s; tb[80 + k] = tb[160 + k]; s += tb[240 + k] * 4; } tb[nk] = s; }
            __syncthreads();
        }
        for (int rep_ = 0; rep_ < REPS(10); ++rep_) if (IN(g0 + 10)) { if (rep_) __syncthreads(); FRESH();
            LAS int* tb = (LAS int*)(lds + LDSCTL_OFF + LC_TAB); const int NX = (G % 8 == 0) ? 8 : 1, nk = 64 / NX;
            SchedMoe S; S.nux = tb[nk]; S.nrank = G / NX; S.rank = (int)blockIdx.x / NX; S.nk = nk; S.x = (int)blockIdx.x % NX; S.NX = NX; S.cum = tb; S.rb0 = tb + 80;
            S.A = (const char*)(pl.ws + WS_XS); S.a_blk = (size_t)256 * D * 2; S.W = (const char*)(pl.ws + WS_MOEW); S.w_e = WGU_E; S.w_pn = (size_t)256 * D * 2; S.cmul = 128;
            EpiSwiglu E{(bf16*)(pl.ws + WS_HB)};
            pg8::gemm_phase(lds, tid, D, D, D, S, E);
        }
        SEAM(g0 + 10);
        for (int rep_ = 0; rep_ < REPS(11); ++rep_) if (IN(g0 + 11)) { if (rep_) __syncthreads(); FRESH();
            LAS int* tb = (LAS int*)(lds + LDSCTL_OFF + LC_TAB); const int NX = (G % 8 == 0) ? 8 : 1, nk = 64 / NX;
            SchedMoe S; S.nux = tb[nk]; S.nrank = G / NX; S.rank = (int)blockIdx.x / NX; S.nk = nk; S.x = (int)blockIdx.x % NX; S.NX = NX; S.cum = tb; S.rb0 = tb + 80;
            S.A = (const char*)(pl.ws + WS_HB); S.a_blk = (size_t)256 * DE * 2; S.W = (const char*)(pl.ws + WS_WD); S.w_e = WD_E; S.w_pn = (size_t)256 * DE * 2; S.cmul = 256;
            EpiScatter E{(bf16*)(pl.ws + WS_Y), (const int*)(pl.ws + WS_MOETAB), (const float*)(pl.ws + WS_MOETAB + (size_t)NROWS_MAX * 4)};
            pg8::gemm_phase(lds, tid, DE, DE, DE, S, E);
        }
        SEAM(g0 + 11);
    }
    if (IN(PH_FINAL)) { FRESH(); norm_phase<2>(pl, 0, lds, gw, NGW, tid, lane); }
#undef IN
#undef SEAM
}

extern "C" void kernel_launch(void* const* d_in, const int* in_sizes, int n_in, void* d_out, int out_size, void* d_ws, size_t ws_size, hipStream_t stream) {
    static int grid = 0;
    if (grid == 0) {
        if (n_in != 25 || out_size != M * D || ws_size < WS_END) { fprintf(stderr, "kernel_launch: unexpected shapes / workspace (n_in %d out %d ws %zu, need %zu)\n", n_in, out_size, ws_size, (size_t)WS_END); grid = -1; return; }
        int dev = 0, cus = 0, per_cu = 0;
        if (hipGetDevice(&dev) != hipSuccess || hipDeviceGetAttribute(&cus, hipDeviceAttributeMultiprocessorCount, dev) != hipSuccess) { grid = -1; return; }
        if (hipFuncSetAttribute((const void*)fwd, hipFuncAttributeMaxDynamicSharedMemorySize, LDS_BYTES) != hipSuccess) { fprintf(stderr, "kernel_launch: hipFuncSetAttribute failed\n"); grid = -1; return; }
        if (hipOccupancyMaxActiveBlocksPerMultiprocessor(&per_cu, (const void*)fwd, 512, LDS_BYTES) != hipSuccess || per_cu < 1) { fprintf(stderr, "kernel_launch: occupancy query says %d\n", per_cu); }
        (void)hipGetLastError();
        grid = cus;
    }
    if (grid < 0) return;
    hipMemsetAsync((char*)d_ws + WS_CTL, 0, CTL_BYTES, stream);
    Params p{};
    for (int i = 0; i < 25; ++i) p.in[i] = (const float*)d_in[i];
    p.out = (float*)d_out; p.ws = (unsigned char*)d_ws;
#if N_LAUNCH_MODE == 1
    p.ph_lo = 0; p.ph_hi = PH_TOTAL;
    hipLaunchKernelGGL(fwd, dim3(grid), dim3(512), LDS_BYTES, stream, p);
#else
    for (int k = 0; k < PH_TOTAL; ++k) { p.ph_lo = k; p.ph_hi = k + 1; hipLaunchKernelGGL(fwd, dim3(grid), dim3(512), LDS_BYTES, stream, p); }
#endif
}
```

```cpp
#include <hip/hip_runtime.h>
#include <cstdio>
#include <cstdint>

#ifndef REPEAT_MASK
#define REPEAT_MASK 0
#endif
#ifndef N_LAUNCH_MODE
#define N_LAUNCH_MODE 1
#endif

#define LAS __attribute__((address_space(3)))
#define GAS __attribute__((address_space(1)))
typedef unsigned short bf16;
typedef short bf16x8 __attribute__((ext_vector_type(8)));
typedef float f32x4 __attribute__((ext_vector_type(4)));
typedef float f32x2 __attribute__((ext_vector_type(2)));
typedef unsigned u32x4 __attribute__((ext_vector_type(4)));
typedef unsigned u32x2 __attribute__((ext_vector_type(2)));

constexpr int NB = 8, T = 4096, D = 1024, M = NB * T, NLAYER = 2;
constexpr int DIN = 9736, DH = 9728;
constexpr int HQ = 0, HK = 512, HV = 1024, HZ = 1536, HCONF = 2048, HGMLP = 3072, HSC = 4096, HGATE = 5632;
constexpr int NE = 64, DE = 512;
constexpr float EPS = 1e-6f;
constexpr int NROWBLK_MAX = 320, NROWS_MAX = NROWBLK_MAX * 256;

constexpr size_t MiB = 1u << 20;
constexpr size_t WS_CTL = 0, CTL_BYTES = 1 * MiB;
constexpr size_t WS_WIN = 2 * MiB;
constexpr size_t WIN_L = (size_t)DH * D * 2;
constexpr size_t WS_WBR = 40 * MiB;
constexpr size_t WBR_L = (size_t)4 * D * 512 * 2;
constexpr size_t WS_WOUT = 48 * MiB;
constexpr size_t WOUT_L = (size_t)D * D * 2;
constexpr size_t WS_XN = 52 * MiB;
constexpr size_t WS_SMALL = 116 * MiB;
constexpr size_t WS_ROUTE = 117 * MiB;
constexpr size_t WS_MOETAB = 118 * MiB;
constexpr size_t WS_YS = 120 * MiB;
constexpr size_t WS_X1B = 120 * MiB;
constexpr size_t WS_REC = 248 * MiB;
constexpr size_t WS_MERGED = WS_REC;
constexpr size_t WS_OBUF = WS_XN;
constexpr int REC_W = 0, REC_Q = 16384, REC_ATT = 32768, REC_KT = 40960, REC_U = 57344, REC_G = 73728, REC_BYTES = 73984;
static_assert(WS_REC + (size_t)2048 * REC_BYTES <= 410 * MiB, "chunk records");
constexpr size_t WS_H = 410 * MiB;
constexpr size_t WS_MOEW = 410 * MiB;
constexpr size_t WGU_E = (size_t)1024 * 1024 * 2, WD_E = (size_t)1024 * 512 * 2;
constexpr size_t WS_WD = WS_MOEW + 64 * WGU_E;
constexpr size_t WS_XS = 602 * MiB;
constexpr size_t WS_HB = 762 * MiB;
constexpr size_t WS_Y = 842 * MiB;
constexpr size_t WS_END = 1018 * MiB;
static_assert(WS_H + (size_t)M * DH * 2 <= WS_END && WS_Y + (size_t)2 * M * D * 2 <= WS_END, "ws map");

constexpr int CW_BAR = 4096;
constexpr int CW_QUEUE = 16384;
constexpr int STAGE_LDS = 131072, LDSCTL_OFF = 131072, LDS_BYTES = 147456;
constexpr int LC_BAR = 0;
constexpr int LC_MISC = 64;
constexpr int LC_TAB = 1024;

__device__ __forceinline__ float bf_lo(unsigned w) { return __uint_as_float(w << 16); }
__device__ __forceinline__ float bf_hi(unsigned w) { return __uint_as_float(w & 0xffff0000u); }
__device__ __forceinline__ float bf2f(bf16 b) { return __uint_as_float(((unsigned)b) << 16); }
__device__ __forceinline__ unsigned f2bf(float f) { unsigned u = __float_as_uint(f); return (u + 0x7fffu + ((u >> 16) & 1u)) >> 16; }
__device__ __forceinline__ unsigned pk2(float lo, float hi) { return f2bf(lo) | (f2bf(hi) << 16); }
__device__ __forceinline__ void unpack8(const u32x4 v, float (&f)[8]) {
    f[0] = bf_lo(v.x); f[1] = bf_hi(v.x); f[2] = bf_lo(v.y); f[3] = bf_hi(v.y); f[4] = bf_lo(v.z); f[5] = bf_hi(v.z); f[6] = bf_lo(v.w); f[7] = bf_hi(v.w);
}
__device__ __forceinline__ u32x4 pack8(const float (&f)[8]) { u32x4 o; o.x = pk2(f[0], f[1]); o.y = pk2(f[2], f[3]); o.z = pk2(f[4], f[5]); o.w = pk2(f[6], f[7]); return o; }
__device__ __forceinline__ float wave_sum(float v) {
#pragma unroll
    for (int o = 1; o < 64; o <<= 1) v += __shfl_xor(v, o);
    return v;
}
__device__ __forceinline__ float fexp(float x) { return __builtin_amdgcn_exp2f(x * 1.4426950408889634f); }
__device__ __forceinline__ float frcp(float x) { return __builtin_amdgcn_rcpf(x); }
__device__ __forceinline__ float sigmoidf_(float x) { return frcp(1.0f + fexp(-x)); }
__device__ __forceinline__ float siluf_(float x) { return x * frcp(1.0f + fexp(-x)); }
__device__ __forceinline__ float gelu_tanh(float x) { const float u = 0.7978845608028654f * (x + 0.044715f * x * x * x); return x * frcp(1.0f + fexp(-2.0f * u)); }
__device__ __forceinline__ float softplusf_(float x) { return fmaxf(x, 0.f) + log1pf(__expf(-fabsf(x))); }

#define XB_TMO      128
#define XB_XCNT(j)  (256  + 64 * (j))
#define XB_XSUB(j)  (1280 + 64 * (j))
#define XB_XGEN(j)  (2304 + 64 * (j))
#define XB_TOP      3328
#define XB_TOPGEN   3392
#define XCD_BAR_WORDS 3456
#define XB_SPIN_CAP (1u << 18)
__device__ __forceinline__ unsigned xb_ld(unsigned* p)              { return __hip_atomic_load(p, __ATOMIC_RELAXED, __HIP_MEMORY_SCOPE_AGENT); }
__device__ __forceinline__ unsigned xb_add(unsigned* p, unsigned v) { return __hip_atomic_fetch_add(p, v, __ATOMIC_RELAXED, __HIP_MEMORY_SCOPE_AGENT); }
__device__ __forceinline__ unsigned xb_xcc_id() { return (unsigned)__builtin_amdgcn_s_getreg((3 << 11) | 20) & 0xFu; }
#define XB_SPIN(cond, bar) do { unsigned _sp = 0; while (cond) { __builtin_amdgcn_s_sleep(1); \
    if ((++_sp & 255u) == 0u) { if (xb_ld(&(bar)[XB_TMO])) break; if (_sp > XB_SPIN_CAP) { atomicAdd(&(bar)[XB_TMO], 1u); break; } } } } while (0)
struct XcdBarrier { unsigned* bar; unsigned x; volatile LAS unsigned* st; };
__device__ __forceinline__ XcdBarrier xcd_barrier_post(unsigned* bar, volatile LAS unsigned* st) {
    XcdBarrier b; b.bar = bar; b.x = xb_xcc_id(); b.st = st;
    if (threadIdx.x == 0) (void)xb_add(&bar[XB_XCNT(b.x)], 1u);
    return b;
}
__device__ __forceinline__ void xcd_barrier_complete(unsigned* bar, unsigned x, unsigned& nloc, unsigned& nx) {
    const unsigned G = gridDim.x * gridDim.y * gridDim.z;
    unsigned sum, cnt, mine, sp = 0u;
    for (;;) {
        sum = 0u; cnt = 0u; mine = 0u;
#pragma unroll
        for (unsigned j = 0; j < 16; ++j) { const unsigned c = xb_ld(&bar[XB_XCNT(j)]); sum += c; cnt += (c > 0u) ? 1u : 0u; mine = (j == x) ? c : mine; }
        if (sum == G) break;
        __builtin_amdgcn_s_sleep(1);
        if ((++sp & 255u) == 0u) { if (xb_ld(&bar[XB_TMO])) break; if (sp > XB_SPIN_CAP) { atomicAdd(&bar[XB_TMO], 1u); break; } }
    }
    nloc = mine > 0u ? mine : 1u; nx = cnt > 0u ? cnt : 1u;
}
__device__ __forceinline__ void xcd_barrier(const XcdBarrier& b) {
    asm volatile("s_waitcnt vmcnt(0)" ::: "memory");
    __syncthreads();
    if (threadIdx.x == 0) {
        unsigned* bar = b.bar;
        __builtin_amdgcn_s_waitcnt(0);
        unsigned nloc = b.st[0], nx = b.st[1];
        if (nloc == 0u) { xcd_barrier_complete(bar, b.x, nloc, nx); b.st[0] = nloc; b.st[1] = nx; }
        const unsigned old = xb_add(&bar[XB_XSUB(b.x)], 1u);
        const unsigned gen = old / nloc;
        if (old + 1u == (gen + 1u) * nloc) {
            __builtin_amdgcn_fence(__ATOMIC_RELEASE, "agent");
            asm volatile("s_waitcnt vmcnt(0)" ::: "memory");
            const unsigned og = xb_add(&bar[XB_TOP], 1u);
            const unsigned tg = og / nx;
            if (og + 1u == (tg + 1u) * nx) xb_add(&bar[XB_TOPGEN], 1u);
            else XB_SPIN(xb_ld(&bar[XB_TOPGEN]) == tg, bar);
            __builtin_amdgcn_fence(__ATOMIC_ACQUIRE, "agent");
            xb_add(&bar[XB_XGEN(b.x)], 1u);
            asm volatile("s_waitcnt vmcnt(0)" ::: "memory");
        } else {
            XB_SPIN(xb_ld(&bar[XB_XGEN(b.x)]) == gen, bar);
            __builtin_amdgcn_fence(__ATOMIC_ACQUIRE, "agent");
            asm volatile("s_waitcnt vmcnt(0)" ::: "memory");
        }
    }
    __syncthreads();
}

namespace pg8 {
constexpr int BM = 256, BK = 64, HALF = 128, HTB = HALF * BK * 2, STAGE_BYTES = 8 * HTB, NXCD = 8, WGM = 8;
__host__ __device__ __forceinline__ int lds_byte(int r, int c) { const int st = (r >> 4) * 2 + (c >> 5), rr = r & 15, cc = c & 31, ob = rr * 64 + cc * 2; return st * 1024 + (ob ^ (((ob >> 9) & 1) << 5)); }
__host__ __device__ __forceinline__ void stage_rc(int b, int& R, int& C) { const int st = b / 1024, sb = b % 1024, swz = sb ^ (((sb >> 9) & 1) << 5); R = (st >> 1) * 16 + swz / 64; C = (st & 1) * 32 + (swz % 64) / 2; }
__host__ __device__ __forceinline__ int perm32(int rho) { const int n = rho >> 4, i = rho & 15; return 8 * (i >> 2) + 4 * n + (i & 3); }

struct Unit { const char* A; const char* B; int r0, c0; };

struct TileOrder {
    int nM, nN, nwg, G, c;
    __device__ void init(int nM_, int nN_, int G_, int c_) { nM = nM_; nN = nN_; nwg = nM * nN; G = G_; c = c_; }
    __device__ bool next(int i, int& pm, int& pn) const {
        const long L = (long)i * G + c; if (L >= nwg) return false;
        int wgid = (int)L; { const int q = nwg / NXCD, r = nwg % NXCD, xcd = wgid % NXCD, off = wgid / NXCD; wgid = (xcd < r ? xcd * (q + 1) : r * (q + 1) + (xcd - r) * q) + off; }
        const int nig = WGM * nN, gid = wgid / nig, fm = gid * WGM, gsz = (nM - fm) < WGM ? (nM - fm) : WGM;
        pm = fm + ((wgid % nig) % gsz); pn = (wgid % nig) / gsz; return true;
    }
};
__device__ __forceinline__ unsigned cvt_pk_bf16(float lo, float hi) { unsigned r; asm volatile("v_cvt_pk_bf16_f32 %0, %1, %2" : "=v"(r) : "v"(lo), "v"(hi)); return r; }

template <class Epi, class Sched>
__device__ __forceinline__ void gemm_phase(LAS unsigned char* lds, const int tid, const int K, const int lda, const int ldb, const Sched& S, const Epi& E) {
    const int wid = __builtin_amdgcn_readfirstlane(tid >> 6), lane = tid & 63, wr = wid >> 2, wc = wid & 3, fr = lane & 15, fq = lane >> 4;
    const int nt = K / BK;
    unsigned voffA[2], voffB[2];
#pragma unroll
    for (int i = 0; i < 2; ++i) { int R, C; stage_rc(tid * 16 + i * 8192, R, C); const int Rb = Epi::PERM ? ((R & ~31) + perm32(R & 31)) : R;
        voffA[i] = (unsigned)(R * lda + C) * 2u; voffB[i] = (unsigned)(Rb * ldb + C) * 2u; }
    const size_t kstep = (size_t)(BK * 2);
    const size_t hstepA = (size_t)HALF * lda * 2, hstepB = (size_t)HALF * ldb * 2;
    const unsigned ldsw = (unsigned)wid * 1024u;
    const int aoff = lds_byte(wr * 64 + fr, fq * 8), boff = lds_byte(wc * 32 + fr, fq * 8);
#define PG8_SA(b, h) (((b) * 2 + (h)) * HTB)
#define PG8_SB(b, h) ((4 + (b) * 2 + (h)) * HTB)
#define PG8_STAGE(bufoff, gbase, voff) do { _Pragma("unroll") for (int _i = 0; _i < 2; ++_i) \
        __builtin_amdgcn_global_load_lds((const unsigned*)((const char*)(gbase) + (voff)[_i]), (LAS unsigned*)(lds + (bufoff) + ldsw + _i * 8192), 16, 0, 0); } while (0)
#define PG8_LDA(dst, b, h) do { _Pragma("unroll") for (int m = 0; m < 4; ++m) _Pragma("unroll") for (int k = 0; k < 2; ++k) dst[m][k] = *(const LAS bf16x8*)(lds + PG8_SA(b, h) + aoff + m * 2048 + k * 1024); } while (0)
#define PG8_LDB(dst, b, h) do { _Pragma("unroll") for (int n = 0; n < 2; ++n) _Pragma("unroll") for (int k = 0; k < 2; ++k) dst[n][k] = *(const LAS bf16x8*)(lds + PG8_SB(b, h) + boff + n * 2048 + k * 1024); } while (0)
#define PG8_MMA(ai, bj, At, Bt) do { __builtin_amdgcn_s_setprio(1); _Pragma("unroll") for (int m = 0; m < 4; ++m) _Pragma("unroll") for (int n = 0; n < 2; ++n) _Pragma("unroll") for (int k = 0; k < 2; ++k) \
        acc[ai][bj][m][n] = __builtin_amdgcn_mfma_f32_16x16x32_bf16(Bt[n][k], At[m][k], acc[ai][bj][m][n], 0, 0, 0); __builtin_amdgcn_s_setprio(0); } while (0)
#define PG8_WAIT_V(n) asm volatile("s_waitcnt vmcnt(" #n ")" ::: "memory")
#define PG8_WAIT_L(n) asm volatile("s_waitcnt lgkmcnt(" #n ")" ::: "memory")
#define PG8_BAR __builtin_amdgcn_s_barrier()
#define PG8_SCHED __builtin_amdgcn_sched_barrier(0)
    Unit cur, nxt; int ui = 0;
    if (!S.next(0, cur)) return;
    f32x4 acc[2][2][4][2];
#pragma unroll
    for (int a = 0; a < 2; ++a)
#pragma unroll
        for (int b = 0; b < 2; ++b)
#pragma unroll
            for (int m = 0; m < 4; ++m)
#pragma unroll
                for (int n = 0; n < 2; ++n) acc[a][b][m][n] = (f32x4){0.f, 0.f, 0.f, 0.f};
    bf16x8 At[4][2], B0[2][2], B1[2][2];
    const char* cA = cur.A; const char* cB = cur.B;
    PG8_STAGE(PG8_SB(0, 0), cB, voffB); PG8_STAGE(PG8_SB(0, 1), cB + hstepB, voffB); PG8_STAGE(PG8_SA(0, 0), cA, voffA); PG8_STAGE(PG8_SA(0, 1), cA + hstepA, voffA);
    if (wr == 1) PG8_BAR;
    PG8_WAIT_V(2); PG8_BAR;
    PG8_STAGE(PG8_SB(1, 0), cB + kstep, voffB); PG8_STAGE(PG8_SA(1, 0), cA + kstep, voffA); PG8_STAGE(PG8_SB(1, 1), cB + hstepB + kstep, voffB);
    PG8_WAIT_V(6); PG8_BAR;
    for (;;) {
        const bool has_next = S.next(ui + 1, nxt);
        const char* nA = has_next ? nxt.A : cA; const char* nB = has_next ? nxt.B : cB;
        for (int t = 0; t < nt; t += 2) {
            const bool last = (t == nt - 2);
            const char* a1 = cA + (size_t)(t + 1) * kstep;
            const char* a2 = last ? nA : cA + (size_t)(t + 2) * kstep; const char* b2 = last ? nB : cB + (size_t)(t + 2) * kstep;
            const char* a3 = a2 + kstep; const char* b3 = b2 + kstep;
            PG8_LDB(B0, 0, 0); PG8_LDB(B1, 0, 1); PG8_SCHED; PG8_LDA(At, 0, 0); PG8_STAGE(PG8_SA(1, 1), a1 + hstepA, voffA);
            PG8_WAIT_V(8); PG8_WAIT_L(0); PG8_BAR; PG8_MMA(0, 0, At, B0); PG8_MMA(0, 1, At, B1); PG8_BAR; PG8_SCHED;
            PG8_LDA(At, 0, 1); PG8_STAGE(PG8_SB(0, 0), b2, voffB); PG8_STAGE(PG8_SB(0, 1), b2 + hstepB, voffB); PG8_STAGE(PG8_SA(0, 0), a2, voffA);
            PG8_WAIT_V(8); PG8_WAIT_L(0); PG8_BAR; PG8_MMA(1, 0, At, B0); PG8_MMA(1, 1, At, B1); PG8_BAR; PG8_SCHED;
            PG8_LDB(B0, 1, 0); PG8_LDB(B1, 1, 1); PG8_SCHED; PG8_LDA(At, 1, 0); PG8_STAGE(PG8_SA(0, 1), a2 + hstepA, voffA);
            PG8_WAIT_V(8); PG8_WAIT_L(0); PG8_BAR; PG8_MMA(0, 0, At, B0); PG8_MMA(0, 1, At, B1); PG8_BAR; PG8_SCHED;
            PG8_LDA(At, 1, 1); PG8_STAGE(PG8_SB(1, 0), b3, voffB); PG8_STAGE(PG8_SB(1, 1), b3 + hstepB, voffB); PG8_STAGE(PG8_SA(1, 0), a3, voffA);
            PG8_WAIT_V(8); PG8_WAIT_L(0); PG8_BAR; PG8_MMA(1, 0, At, B0); PG8_MMA(1, 1, At, B1); PG8_BAR; PG8_SCHED;
        }
        if (wr == 0) PG8_BAR;
        E(acc, cur, wr, wc, fr, fq);
        if (!has_next) break;
#pragma unroll
        for (int a = 0; a < 2; ++a)
#pragma unroll
            for (int b = 0; b < 2; ++b)
#pragma unroll
                for (int m = 0; m < 4; ++m)
#pragma unroll
                    for (int n = 0; n < 2; ++n) acc[a][b][m][n] = (f32x4){0.f, 0.f, 0.f, 0.f};
        cur = nxt; cA = nA; cB = nB; ++ui;
        if (wr == 1) PG8_BAR;
    }
    PG8_WAIT_V(0);
    PG8_BAR;
#undef PG8_SA
#undef PG8_SB
#undef PG8_STAGE
#undef PG8_LDA
#undef PG8_LDB
#undef PG8_MMA
#undef PG8_WAIT_V
#undef PG8_WAIT_L
#undef PG8_BAR
#undef PG8_SCHED
}
}
using pg8::Unit;
using pg8::cvt_pk_bf16;

struct EpiStoreBf16 {
    static constexpr bool PERM = true;
    bf16* O; int ldc;
    __device__ __forceinline__ void operator()(const f32x4 (&acc)[2][2][4][2], const Unit& u, int wr, int wc, int fr, int fq) const {
        const int row0 = u.r0 + wr * 64 + fr, col0 = u.c0 + wc * 32 + 8 * fq;
#pragma unroll
        for (int ai = 0; ai < 2; ++ai)
#pragma unroll
            for (int m = 0; m < 4; ++m) { bf16* rowp = O + (size_t)(row0 + ai * 128 + m * 16) * ldc + col0;
#pragma unroll
                for (int bj = 0; bj < 2; ++bj) { const f32x4 v0 = acc[ai][bj][m][0], v1 = acc[ai][bj][m][1];
                    u32x4 w; w.x = cvt_pk_bf16(v0[0], v0[1]); w.y = cvt_pk_bf16(v0[2], v0[3]); w.z = cvt_pk_bf16(v1[0], v1[1]); w.w = cvt_pk_bf16(v1[2], v1[3]);
                    *(u32x4*)(rowp + bj * 128) = w; } }
    }
};
struct EpiGate {
    static constexpr bool PERM = true;
    const bf16* Hg; bf16* MG;
    __device__ __forceinline__ void operator()(const f32x4 (&acc)[2][2][4][2], const Unit& u, int wr, int wc, int fr, int fq) const {
        const int row0 = u.r0 + wr * 64 + fr, gcol0 = u.c0 + wc * 32 + 8 * fq, mcol0 = (u.c0 & 1023) + wc * 32 + 8 * fq; const bool first = u.c0 < 1024;
#pragma unroll
        for (int ai = 0; ai < 2; ++ai) {
            u32x4 gw[4][2], mw[4][2];
#pragma unroll
            for (int m = 0; m < 4; ++m)
#pragma unroll
                for (int bj = 0; bj < 2; ++bj) { gw[m][bj] = *(const u32x4*)(Hg + (size_t)(row0 + ai * 128 + m * 16) * DH + gcol0 + bj * 128);
                    mw[m][bj] = first ? (u32x4){0u, 0u, 0u, 0u} : *(const u32x4*)(MG + (size_t)(row0 + ai * 128 + m * 16) * D + mcol0 + bj * 128); }
#pragma unroll
            for (int m = 0; m < 4; ++m) { bf16* mrow = MG + (size_t)(row0 + ai * 128 + m * 16) * D + mcol0;
#pragma unroll
                for (int bj = 0; bj < 2; ++bj) { const f32x4 v0 = acc[ai][bj][m][0], v1 = acc[ai][bj][m][1];
                    float g[8], pm[8]; unpack8(gw[m][bj], g); unpack8(mw[m][bj], pm);
                    u32x4 w; w.x = cvt_pk_bf16(pm[0] + sigmoidf_(g[0]) * v0[0], pm[1] + sigmoidf_(g[1]) * v0[1]); w.y = cvt_pk_bf16(pm[2] + sigmoidf_(g[2]) * v0[2], pm[3] + sigmoidf_(g[3]) * v0[3]);
                    w.z = cvt_pk_bf16(pm[4] + sigmoidf_(g[4]) * v1[0], pm[5] + sigmoidf_(g[5]) * v1[1]); w.w = cvt_pk_bf16(pm[6] + sigmoidf_(g[6]) * v1[2], pm[7] + sigmoidf_(g[7]) * v1[3]);
                    *(u32x4*)(mrow + bj * 128) = w; } }
        }
    }
};
struct EpiRes {
    static constexpr bool PERM = true;
    const float* res32; const bf16* res16; bf16* out;
    __device__ __forceinline__ void operator()(const f32x4 (&acc)[2][2][4][2], const Unit& u, int wr, int wc, int fr, int fq) const {
        const int row0 = u.r0 + wr * 64 + fr, col0 = u.c0 + wc * 32 + 8 * fq;
#pragma unroll
        for (int ai = 0; ai < 2; ++ai) {
            float r[4][2][8];
#pragma unroll
            for (int m = 0; m < 4; ++m)
#pragma unroll
                for (int bj = 0; bj < 2; ++bj) { const size_t ro = (size_t)(row0 + ai * 128 + m * 16) * D + col0 + bj * 128;
                    if (res32) { const f32x4 a = *(const f32x4*)(res32 + ro), b = *(const f32x4*)(res32 + ro + 4); r[m][bj][0] = a[0]; r[m][bj][1] = a[1]; r[m][bj][2] = a[2]; r[m][bj][3] = a[3]; r[m][bj][4] = b[0]; r[m][bj][5] = b[1]; r[m][bj][6] = b[2]; r[m][bj][7] = b[3]; }
                    else unpack8(*(const u32x4*)(res16 + ro), r[m][bj]); }
#pragma unroll
            for (int m = 0; m < 4; ++m)
#pragma unroll
                for (int bj = 0; bj < 2; ++bj) { const size_t ro = (size_t)(row0 + ai * 128 + m * 16) * D + col0 + bj * 128; const f32x4 v0 = acc[ai][bj][m][0], v1 = acc[ai][bj][m][1];
                    u32x4 w; w.x = cvt_pk_bf16(r[m][bj][0] + v0[0], r[m][bj][1] + v0[1]); w.y = cvt_pk_bf16(r[m][bj][2] + v0[2], r[m][bj][3] + v0[3]);
                    w.z = cvt_pk_bf16(r[m][bj][4] + v1[0], r[m][bj][5] + v1[1]); w.w = cvt_pk_bf16(r[m][bj][6] + v1[2], r[m][bj][7] + v1[3]);
                    *(u32x4*)(out + ro) = w; }
        }
    }
};
struct EpiSwiglu {
    static constexpr bool PERM = true;
    bf16* O;
    __device__ __forceinline__ void operator()(const f32x4 (&acc)[2][2][4][2], const Unit& u, int wr, int wc, int fr, int fq) const {
        const int row0 = u.r0 + wr * 64 + fr, col0 = u.c0 + wc * 32 + 8 * fq;
#pragma unroll
        for (int ai = 0; ai < 2; ++ai)
#pragma unroll
            for (int m = 0; m < 4; ++m) { bf16* rowp = O + (size_t)(row0 + ai * 128 + m * 16) * DE + col0;
                const f32x4 g0 = acc[ai][0][m][0], g1 = acc[ai][0][m][1], u0 = acc[ai][1][m][0], u1 = acc[ai][1][m][1];
                u32x4 w; w.x = cvt_pk_bf16(siluf_(g0[0]) * u0[0], siluf_(g0[1]) * u0[1]); w.y = cvt_pk_bf16(siluf_(g0[2]) * u0[2], siluf_(g0[3]) * u0[3]);
                w.z = cvt_pk_bf16(siluf_(g1[0]) * u1[0], siluf_(g1[1]) * u1[1]); w.w = cvt_pk_bf16(siluf_(g1[2]) * u1[2], siluf_(g1[3]) * u1[3]);
                *(u32x4*)rowp = w; }
    }
};
struct EpiScatter {
    static constexpr bool PERM = true;
    bf16* Y; const int* row_code; const float* row_w;
    __device__ __forceinline__ void operator()(const f32x4 (&acc)[2][2][4][2], const Unit& u, int wr, int wc, int fr, int fq) const {
        const int row0 = u.r0 + wr * 64 + fr, col0 = u.c0 + wc * 32 + 8 * fq;
#pragma unroll
        for (int ai = 0; ai < 2; ++ai)
#pragma unroll
            for (int m = 0; m < 4; ++m) { const int row = row0 + ai * 128 + m * 16; const int code = row_code[row]; const float rw = row_w[row];
                if (code >= 0) { bf16* rowp = Y + (size_t)(code & 1) * ((size_t)M * D) + (size_t)(code >> 1) * D + col0;
#pragma unroll
                    for (int bj = 0; bj < 2; ++bj) { const f32x4 v0 = acc[ai][bj][m][0] * rw, v1 = acc[ai][bj][m][1] * rw;
                        u32x4 w; w.x = cvt_pk_bf16(v0[0], v0[1]); w.y = cvt_pk_bf16(v0[2], v0[3]); w.z = cvt_pk_bf16(v1[0], v1[1]); w.w = cvt_pk_bf16(v1[2], v1[3]);
                        *(u32x4*)(rowp + bj * 128) = w; } } }
    }
};

struct SchedH {
    pg8::TileOrder to; const char* A; const char* B;
    __device__ __forceinline__ bool next(int i, Unit& u) const { int pm, pn; if (!to.next(i, pm, pn)) return false;
        u.A = A + (size_t)pm * 256 * D * 2; u.B = B + (size_t)pn * 256 * D * 2; u.r0 = pm * 256; u.c0 = pn * 256; return true; }
};
struct SchedBranch {
    pg8::TileOrder to; const char* YS; const char* WBR;
    __device__ __forceinline__ bool next(int i, Unit& u) const { int pm, q; if (!to.next(i >> 2, pm, q)) return false; const int br = i & 3;
        u.A = YS + ((size_t)pm * 256 * 2048 + br * 512) * 2; u.B = WBR + ((size_t)br * D * 512 + (size_t)q * 256 * 512) * 2; u.r0 = pm * 256; u.c0 = br * 1024 + q * 256; return true; }
};
struct SchedOut {
    pg8::TileOrder to; const char* A; const char* B;
    __device__ __forceinline__ bool next(int i, Unit& u) const { int pm, pn; if (!to.next(i, pm, pn)) return false;
        u.A = A + (size_t)pm * 256 * D * 2; u.B = B + (size_t)pn * 256 * D * 2; u.r0 = pm * 256; u.c0 = pn * 256; return true; }
};
struct SchedMoe {
    int nux, nrank, rank, nk, x, NX; const LAS int* cum; const LAS int* rb0; const char* A; size_t a_blk; const char* W; size_t w_e, w_pn; int cmul;
    __device__ __forceinline__ bool next(int i, Unit& u) const { const int ui = i * nrank + rank; if (ui >= nux) return false;
        int k = 0; while (k + 1 < nk && cum[k + 1] <= ui) ++k;
        const int local = ui - cum[k], rb = rb0[k] + (local >> 2), pn = local & 3, e = x + NX * k;
        u.A = A + (size_t)rb * a_blk; u.B = W + (size_t)e * w_e + (size_t)pn * w_pn; u.r0 = rb * 256; u.c0 = pn * cmul; return true; }
};

struct Params { const float* in[25]; float* out; unsigned char* ws; int ph_lo, ph_hi; };
enum { I_X = 0, I_MIXNW, I_WIN, I_GCONV, I_GALOG, I_GDT, I_GNW, I_CCW, I_CCB, I_CLNW, I_CLNB, I_GLNW, I_GLNB, I_GWS, I_GBS, I_SCW, I_WBR, I_WOUT, I_MOENW, I_RGRP, I_REXP, I_WG, I_WU, I_WD, I_FNW };
constexpr int PH_PER_LAYER = 12, PH_FINAL = 24, PH_TOTAL = 25;

__device__ __forceinline__ void transpose_item(const float* __restrict__ W, int ldw, int srccol, bf16* __restrict__ WT, int ldt, int k0, int n0, int lane) {
    const int kq = lane & 7, nq = lane >> 3;
    f32x4 v[8][2];
#pragma unroll
    for (int r = 0; r < 8; ++r) { const float* s = W + (size_t)(k0 + 8 * kq + r) * ldw + srccol + 8 * nq; v[r][0] = *(const f32x4*)s; v[r][1] = *(const f32x4*)(s + 4); }
#pragma unroll
    for (int e = 0; e < 8; ++e) { u32x4 o; o.x = pk2(v[0][e >> 2][e & 3], v[1][e >> 2][e & 3]); o.y = pk2(v[2][e >> 2][e & 3], v[3][e >> 2][e & 3]); o.z = pk2(v[4][e >> 2][e & 3], v[5][e >> 2][e & 3]); o.w = pk2(v[6][e >> 2][e & 3], v[7][e >> 2][e & 3]);
        *(u32x4*)(WT + (size_t)(n0 + 8 * nq + e) * ldt + k0 + 8 * kq) = o; }
}
__device__ __forceinline__ void prep_static_weights(const Params& p, int gw, int NGW, int lane) {
    constexpr int I_IN = 16 * (DH / 64), I_BR = 8 * 16, I_OUT = 16 * 16, PER_L = I_IN + 4 * I_BR + I_OUT;
    for (int it = gw; it < NLAYER * PER_L; it += NGW) {
        const int l = it / PER_L; int r = it % PER_L;
        if (r < I_IN) { const int kb = r / (DH / 64), nb = r % (DH / 64), n0 = nb * 64;
            transpose_item(p.in[I_WIN] + (size_t)l * D * DIN, DIN, n0 + (n0 >= 2048 ? 8 : 0), (bf16*)(p.ws + WS_WIN + l * WIN_L), D, kb * 64, n0, lane); continue; }
        r -= I_IN;
        if (r < 4 * I_BR) { const int br = r / I_BR, q = r % I_BR, kb = q / 16, nb = q % 16;
            transpose_item(p.in[I_WBR] + ((size_t)l * 4 + br) * 512 * D, D, nb * 64, (bf16*)(p.ws + WS_WBR + l * WBR_L) + (size_t)br * D * 512, 512, kb * 64, nb * 64, lane); continue; }
        r -= 4 * I_BR;
        { const int kb = r / 16, nb = r % 16;
            transpose_item(p.in[I_WOUT] + (size_t)l * D * D, D, nb * 64, (bf16*)(p.ws + WS_WOUT + l * WOUT_L), D, kb * 64, nb * 64, lane); }
    }
}
__device__ __forceinline__ void prep_moe_weights(const Params& p, int layer, int gw, int NGW, int lane) {
    constexpr int I_GU = 16 * 16, I_D = 8 * 16, PER_E = I_GU + I_D;
    for (int it = gw; it < NE * PER_E; it += NGW) {
        const int e = it / PER_E; int r = it % PER_E;
        if (r < I_GU) { const int kb = r / 16, nb = r % 16, n0 = nb * 64, pn = n0 >> 8, half = (n0 >> 7) & 1, j0 = n0 & 127;
            const float* src = p.in[half ? I_WU : I_WG] + ((size_t)layer * NE + e) * D * DE;
            transpose_item(src, DE, 128 * pn + j0, (bf16*)(p.ws + WS_MOEW + e * WGU_E), D, kb * 64, n0, lane); continue; }
        r -= I_GU;
        { const int kb = r / 16, nb = r % 16;
            transpose_item(p.in[I_WD] + ((size_t)layer * NE + e) * DE * D, D, nb * 64, (bf16*)(p.ws + WS_WD + e * WD_E), DE, kb * 64, nb * 64, lane); }
    }
}

template <int MODE>
__device__ __forceinline__ void norm_phase(const Params& p, int layer, LAS unsigned char* lds, int gw, int NGW, int tid, int lane) {
    const float* nwp = (MODE == 2) ? p.in[I_FNW] : p.in[I_MIXNW] + layer * D;
    f32x4 nw[4];
#pragma unroll
    for (int j = 0; j < 4; ++j) nw[j] = *(const f32x4*)(nwp + 4 * lane + 256 * j);
    f32x4 ws0[16], ws1[16];
    if (MODE != 2) { const float* wi = p.in[I_WIN] + (size_t)layer * D * DIN + 2048;
#pragma unroll
        for (int j = 0; j < 4; ++j)
#pragma unroll
            for (int c = 0; c < 4; ++c) { const float* wr = wi + (size_t)(4 * lane + 256 * j + c) * DIN; ws0[j * 4 + c] = *(const f32x4*)wr; ws1[j * 4 + c] = *(const f32x4*)(wr + 4); } }
    const bf16* Y0 = (const bf16*)(p.ws + WS_Y); const bf16* Y1 = Y0 + (size_t)M * D;
    bf16* XN = (bf16*)(p.ws + WS_XN); float* SMALL = (float*)(p.ws + WS_SMALL);
    const float* xbase = p.in[I_X]; const bf16* xb16 = (const bf16*)(p.ws + WS_X1B); bf16* x2b = (bf16*)p.out;
    f32x4 vn[4]; u32x2 an[4], bn[4], xn16[4];
#define NP_LOAD(mm) do { _Pragma("unroll") for (int j = 0; j < 4; ++j) { \
        if (MODE == 0) vn[j] = *(const f32x4*)(xbase + (size_t)(mm) * D + 4 * lane + 256 * j); \
        else { xn16[j] = *(const u32x2*)(xb16 + (size_t)(mm) * D + 4 * lane + 256 * j); an[j] = *(const u32x2*)(Y0 + (size_t)(mm) * D + 4 * lane + 256 * j); bn[j] = *(const u32x2*)(Y1 + (size_t)(mm) * D + 4 * lane + 256 * j); } } } while (0)
    if (gw < M) NP_LOAD(gw);
    for (int m = gw; m < M; m += NGW) {
        f32x4 v[4]; float ss = 0.f;
#pragma unroll
        for (int j = 0; j < 4; ++j) {
            if (MODE == 0) v[j] = vn[j];
            else { v[j][0] = bf_lo(xn16[j].x) + bf_lo(an[j].x) + bf_lo(bn[j].x); v[j][1] = bf_hi(xn16[j].x) + bf_hi(an[j].x) + bf_hi(bn[j].x); v[j][2] = bf_lo(xn16[j].y) + bf_lo(an[j].y) + bf_lo(bn[j].y); v[j][3] = bf_hi(xn16[j].y) + bf_hi(an[j].y) + bf_hi(bn[j].y); } }
        if (m + NGW < M) NP_LOAD(m + NGW);
#pragma unroll
        for (int j = 0; j < 4; ++j) ss += (v[j][0] * v[j][0] + v[j][1] * v[j][1]) + (v[j][2] * v[j][2] + v[j][3] * v[j][3]);
        const float rs = __builtin_amdgcn_rsqf(wave_sum(ss) * (1.0f / D) + EPS);
        if (MODE == 2) {
#pragma unroll
            for (int j = 0; j < 4; ++j) *(f32x4*)(p.out + (size_t)m * D + 4 * lane + 256 * j) = v[j] * rs * nw[j];
            continue;
        }
        if (MODE == 1) {
#pragma unroll
            for (int j = 0; j < 4; ++j) { u32x2 o; o.x = pk2(v[j][0], v[j][1]); o.y = pk2(v[j][2], v[j][3]); *(u32x2*)(x2b + (size_t)m * D + 4 * lane + 256 * j) = o; }
        }
        f32x4 s0 = (f32x4){0.f, 0.f, 0.f, 0.f}, s1 = s0;
#pragma unroll
        for (int j = 0; j < 4; ++j) { v[j] = v[j] * rs * nw[j];
            u32x2 o; o.x = pk2(v[j][0], v[j][1]); o.y = pk2(v[j][2], v[j][3]); *(u32x2*)(XN + (size_t)m * D + 4 * lane + 256 * j) = o;
#pragma unroll
            for (int c = 0; c < 4; ++c) { s0 += ws0[j * 4 + c] * v[j][c]; s1 += ws1[j * 4 + c] * v[j][c]; } }
        const bool b0 = lane & 1, b1 = lane & 2, b2 = lane & 4;
        f32x4 a;
#pragma unroll
        for (int i = 0; i < 4; ++i) { const float send = b0 ? s0[i] : s1[i]; const float recv = __shfl_xor(send, 1); a[i] = (b0 ? s1[i] : s0[i]) + recv; }
        float bb[2];
#pragma unroll
        for (int i = 0; i < 2; ++i) { const float send = b1 ? a[i] : a[2 + i]; const float recv = __shfl_xor(send, 2); bb[i] = (b1 ? a[2 + i] : a[i]) + recv; }
        float cc; { const float send = b2 ? bb[0] : bb[1]; const float recv = __shfl_xor(send, 4); cc = (b2 ? bb[1] : bb[0]) + recv; }
        cc += __shfl_xor(cc, 8); cc += __shfl_xor(cc, 16); cc += __shfl_xor(cc, 32);
        if (lane < 8) SMALL[(size_t)m * 8 + ((lane >> 2) & 1) + 2 * ((lane >> 1) & 1) + 4 * (lane & 1)] = cc;
    }
#undef NP_LOAD
    __syncthreads();
}

__device__ __forceinline__ void shortconv_unit(const Params& p, int layer, int tid, int unit) {
    const bf16* H = (const bf16*)(p.ws + WS_H); bf16* YS = (bf16*)(p.ws + WS_YS);
    const float* cw = p.in[I_SCW] + (size_t)layer * 3 * 512;
#pragma unroll 2
    for (int k = 0; k < 16; ++k) { const int it = unit * 8192 + k * 512 + tid;
        const int m = it >> 6, c8 = (it & 63) * 8, t = m & (T - 1);
        u32x4 rc[3], rx[3];
#pragma unroll
        for (int j = 0; j < 3; ++j) { const bool ok = (t - 2 + j >= 0); const bf16* r = H + (size_t)(ok ? m - 2 + j : m) * DH + HSC + c8; rc[j] = *(const u32x4*)(r + 512); rx[j] = *(const u32x4*)(r + 1024); if (!ok) rc[j] = (u32x4){0u, 0u, 0u, 0u}; }
        const u32x4 rb = *(const u32x4*)(H + (size_t)m * DH + HSC + c8);
        float acc[8];
#pragma unroll
        for (int i = 0; i < 8; ++i) acc[i] = 0.f;
#pragma unroll
        for (int j = 0; j < 3; ++j) { float cg[8], xv[8]; unpack8(rc[j], cg); unpack8(rx[j], xv);
#pragma unroll
            for (int i = 0; i < 8; ++i) acc[i] += cw[j * 512 + c8 + i] * (cg[i] * xv[i]); }
        float bg[8]; unpack8(rb, bg);
#pragma unroll
        for (int i = 0; i < 8; ++i) acc[i] *= bg[i];
        *(u32x4*)(YS + (size_t)m * 2048 + 1536 + c8) = pack8(acc);
    }
}
__device__ __forceinline__ int queue_pop(unsigned* counter, LAS unsigned char* lds, int tid) {
    LAS int* slot = (LAS int*)(lds + LDSCTL_OFF + LC_MISC);
    __syncthreads();
    if (tid == 0) slot[0] = (int)__hip_atomic_fetch_add(counter, 1u, __ATOMIC_RELAXED, __HIP_MEMORY_SCOPE_AGENT);
    __syncthreads();
    return slot[0];
}
__device__ __forceinline__ void conformer(const Params& p, int layer, LAS unsigned char* lds, int tid, int wave, int lane, unsigned* counter) {
    const bf16* H = (const bf16*)(p.ws + WS_H); bf16* YS = (bf16*)(p.ws + WS_YS);
    LAS bf16* yt = (LAS bf16*)lds;
    LAS float* zt = (LAS float*)(lds + 98304);
    const float* cwp = p.in[I_CCW] + (size_t)layer * 31 * 512;
    float cw[31];
#pragma unroll
    for (int j = 0; j < 31; ++j) cw[j] = cwp[j * 512 + tid];
    const float cb = p.in[I_CCB][layer * 512 + tid];
    float lw[8], lb[8];
#pragma unroll
    for (int i = 0; i < 8; ++i) { lw[i] = p.in[I_CLNW][layer * 512 + lane * 8 + i]; lb[i] = p.in[I_CLNB][layer * 512 + lane * 8 + i]; }
    for (;;) {
        const int unit = queue_pop(counter, lds, tid); if (unit >= M / 64) break;
        const int m0 = unit * 64, t0 = m0 & (T - 1);
        for (int base = 0; base < 94 * 64; base += 512 * 4) {
            u32x4 ra[4], rg[4];
#pragma unroll
            for (int k = 0; k < 4; ++k) { const int it = base + k * 512 + tid; const int r = it >> 6, c8 = (it & 63) * 8, dt = r - 30; const bool ok = (it < 94 * 64) && (t0 + dt >= 0);
                const bf16* s = H + (size_t)(ok ? m0 + dt : m0) * DH + HCONF + c8; ra[k] = *(const u32x4*)s; rg[k] = *(const u32x4*)(s + 512); }
#pragma unroll
            for (int k = 0; k < 4; ++k) { const int it = base + k * 512 + tid; const int r = it >> 6, c8 = (it & 63) * 8, dt = r - 30;
                if (it < 94 * 64) { u32x4 o = (u32x4){0u, 0u, 0u, 0u};
                    if (t0 + dt >= 0) { float a[8], g[8]; unpack8(ra[k], a); unpack8(rg[k], g);
#pragma unroll
                        for (int i = 0; i < 8; ++i) a[i] *= sigmoidf_(g[i]);
                        o = pack8(a); }
                    *(LAS u32x4*)(yt + r * 512 + c8) = o; } }
        }
        __syncthreads();
        for (int sb = 0; sb < 8; ++sb) {
            LAS float* zb = zt + (sb & 1) * 4096;
            float z[8];
#pragma unroll
            for (int i = 0; i < 8; ++i) z[i] = cb;
#pragma unroll
            for (int r = 0; r < 38; ++r) { const float yv = bf2f(yt[(sb * 8 + r) * 512 + tid]);
#pragma unroll
                for (int i = 0; i < 8; ++i) { const int j = r - i; if (j >= 0 && j < 31) z[i] += cw[j] * yv; } }
#pragma unroll
            for (int i = 0; i < 8; ++i) zb[i * 512 + tid] = z[i];
            __syncthreads();
            { const LAS float* zr = zb + wave * 512 + lane * 8; float v[8]; const f32x4 a = *(const LAS f32x4*)zr, b = *(const LAS f32x4*)(zr + 4);
                v[0] = a[0]; v[1] = a[1]; v[2] = a[2]; v[3] = a[3]; v[4] = b[0]; v[5] = b[1]; v[6] = b[2]; v[7] = b[3];
                float s = 0.f;
#pragma unroll
                for (int i = 0; i < 8; ++i) s += v[i];
                const float mean = wave_sum(s) * (1.0f / 512.0f); float q = 0.f;
#pragma unroll
                for (int i = 0; i < 8; ++i) { v[i] -= mean; q += v[i] * v[i]; }
                const float rstd = __builtin_amdgcn_rsqf(wave_sum(q) * (1.0f / 512.0f) + EPS);
#pragma unroll
                for (int i = 0; i < 8; ++i) v[i] = siluf_(v[i] * rstd * lw[i] + lb[i]);
                *(u32x4*)(YS + (size_t)(m0 + sb * 8 + wave) * 2048 + 512 + lane * 8) = pack8(v); }
        }
    }
}
__device__ __forceinline__ f32x4 mfma16(bf16x8 a, bf16x8 b, f32x4 c) { return __builtin_amdgcn_mfma_f32_16x16x32_bf16(a, b, c, 0, 0, 0); }
typedef short bf16x4 __attribute__((ext_vector_type(4)));
__device__ __forceinline__ bf16x8 ld_frag16(const LAS unsigned char* p) { return *(const LAS bf16x8*)p; }
__device__ __forceinline__ bf16x8 ld_frag8x2(const LAS unsigned char* p) { const bf16x4 a = *(const LAS bf16x4*)p, b = *(const LAS bf16x4*)(p + 32); return __builtin_shufflevector(a, b, 0, 1, 2, 3, 4, 5, 6, 7); }
__device__ __forceinline__ bf16x8 pack_frag(const f32x4 lo, const f32x4 hi) { u32x4 w; w.x = cvt_pk_bf16(lo[0], lo[1]); w.y = cvt_pk_bf16(lo[2], lo[3]); w.z = cvt_pk_bf16(hi[0], hi[1]); w.w = cvt_pk_bf16(hi[2], hi[3]); return __builtin_bit_cast(bf16x8, w); }
constexpr int GM_W = 0, GM_VT = 34816, GM_ST = 69632;
__device__ __forceinline__ void gmlp(const Params& p, int layer, LAS unsigned char* lds, int tid, int wave, int lane, unsigned* counter) {
    const bf16* H = (const bf16*)(p.ws + WS_H); bf16* YS = (bf16*)(p.ws + WS_YS);
    LAS float* st = (LAS float*)(lds + GM_ST);
    const float* lnw = p.in[I_GLNW] + layer * 512; const float* lnb = p.in[I_GLNB] + layer * 512;
    const int q = lane >> 4, li = lane & 15;
    for (;;) {
        const int unit = queue_pop(counter, lds, tid); if (unit >= M / 128) break;
        const int m0 = unit * 128;
        u32x4 rv[16];
#pragma unroll
        for (int k = 0; k < 16; ++k) rv[k] = *(const u32x4*)(H + (size_t)(m0 + wave * 16 + k) * DH + HGMLP + 512 + lane * 8);
#pragma unroll
        for (int k = 0; k < 16; ++k) { const int tk = wave * 16 + k;
            float v[8]; unpack8(rv[k], v);
            float s = 0.f;
#pragma unroll
            for (int i = 0; i < 8; ++i) { v[i] = gelu_tanh(v[i]); s += v[i]; }
            const float mean = wave_sum(s) * (1.0f / 512.0f); float qq = 0.f;
#pragma unroll
            for (int i = 0; i < 8; ++i) { const float d = v[i] - mean; qq += d * d; }
            const float rstd = 1.0f / sqrtf(wave_sum(qq) * (1.0f / 512.0f) + EPS);
            if (lane == 0) { st[tk * 2] = mean; st[tk * 2 + 1] = rstd; }
        }
        __syncthreads();
        for (int g = 0; g < 4; ++g) {
            u32x4 rg[4];
#pragma unroll
            for (int k = 0; k < 4; ++k) { const int it = tid + 512 * k; rg[k] = *(const u32x4*)(H + (size_t)(m0 + (it >> 4)) * DH + HGMLP + 512 + g * 128 + (it & 15) * 8); }
#pragma unroll
            for (int k = 0; k < 4; ++k) { const int it = tid + 512 * k; const int tk = it >> 4, c8 = (it & 15) * 8;
                float v[8]; unpack8(rg[k], v);
                const float mean = st[tk * 2], rstd = st[tk * 2 + 1];
#pragma unroll
                for (int i = 0; i < 8; ++i) *(LAS bf16*)(lds + GM_VT + (c8 + i) * 272 + 2 * tk) = (bf16)f2bf((gelu_tanh(v[i]) - mean) * rstd * lnw[g * 128 + c8 + i] + lnb[g * 128 + c8 + i]); }
            const float* ws = p.in[I_GWS] + ((size_t)layer * 4 + g) * 128 * 128;
            f32x4 wa[4], wb[4];
#pragma unroll
            for (int k = 0; k < 4; ++k) { const int it = tid + 512 * k; wa[k] = *(const f32x4*)(ws + (it >> 4) * 128 + (it & 15) * 8); wb[k] = *(const f32x4*)(ws + (it >> 4) * 128 + (it & 15) * 8 + 4); }
#pragma unroll
            for (int k = 0; k < 4; ++k) { const int it = tid + 512 * k; const int i = it >> 4, j8 = (it & 15) * 8;
                const f32x4 a = wa[k], b = wb[k];
                float w[8] = {a[0], a[1], a[2], a[3], b[0], b[1], b[2], b[3]};
#pragma unroll
                for (int e = 0; e < 8; ++e) w[e] = (j8 + e <= i) ? w[e] : 0.f;
                *(LAS u32x4*)(lds + GM_W + i * 272 + j8 * 2) = pack8(w); }
            __syncthreads();
            {
                f32x4 acc[8];
#pragma unroll
                for (int ct = 0; ct < 8; ++ct) acc[ct] = (f32x4){0.f, 0.f, 0.f, 0.f};
                const int nks = (wave >> 1) + 1;
                for (int ks = 0; ks < nks; ++ks) { const bf16x8 wf = ld_frag16(lds + GM_W + (16 * wave + li) * 272 + (32 * ks + 8 * q) * 2);
#pragma unroll
                    for (int ct = 0; ct < 8; ++ct) acc[ct] = mfma16(ld_frag16(lds + GM_VT + (16 * ct + li) * 272 + (32 * ks + 8 * q) * 2), wf, acc[ct]); }
                const int i = 16 * wave + li; const float bs = p.in[I_GBS][((size_t)layer * 4 + g) * 128 + i];
                const bf16* urow = H + (size_t)(m0 + i) * DH + HGMLP + g * 128 + 4 * q; bf16* orow = YS + (size_t)(m0 + i) * 2048 + 1024 + g * 128 + 4 * q;
#pragma unroll
                for (int ct = 0; ct < 8; ++ct) { const u32x2 uw = *(const u32x2*)(urow + 16 * ct);
                    const float o0 = gelu_tanh(bf_lo(uw.x)) * (acc[ct][0] + bs), o1 = gelu_tanh(bf_hi(uw.x)) * (acc[ct][1] + bs), o2 = gelu_tanh(bf_lo(uw.y)) * (acc[ct][2] + bs), o3 = gelu_tanh(bf_hi(uw.y)) * (acc[ct][3] + bs);
                    u32x2 ow; ow.x = pk2(o0, o1); ow.y = pk2(o2, o3); *(u32x2*)(orow + 16 * ct) = ow; }
            }
            __syncthreads();
        }
    }
}
constexpr int CP_QN = 0, CP_KN = 17408, CP_KT = 34816, CP_VT = 53248, CP_KGT = 71680, CP_A32 = 90112, CP_ATT = 106496, CP_T16 = 115712, CP_TAB = 124928;
__device__ __forceinline__ void gdn_chunk_prep(const Params& p, int layer, LAS unsigned char* lds, int tid, int wave, int lane) {
    const bf16* H = (const bf16*)(p.ws + WS_H); const float* SMALL = (const float*)(p.ws + WS_SMALL);
    const float* cw = p.in[I_GCONV] + (size_t)layer * 4 * 1536;
    LAS float* tab = (LAS float*)(lds + CP_TAB);
    const int q = lane >> 4, li = lane & 15;
    for (int unit = blockIdx.x; unit < 2048; unit += gridDim.x) {
        const int n = unit & 63, hh = (unit >> 6) & 3, b = unit >> 8; const int m0 = b * T + n * 64;
        unsigned char* rec = p.ws + WS_REC + (size_t)((b * 4 + hh) * 64 + n) * REC_BYTES;
        const int i0 = wave * 8, t0 = n * 64 + i0;
        unsigned raw[3][11];
#pragma unroll
        for (int s = 0; s < 3; ++s)
#pragma unroll
            for (int r = 0; r < 11; ++r) raw[s][r] = (t0 - 3 + r >= 0) ? *(const unsigned*)(H + (size_t)(m0 + i0 - 3 + r) * DH + s * 512 + hh * 128 + 2 * lane) : 0u;
        float w0[3][4], w1[3][4];
#pragma unroll
        for (int s = 0; s < 3; ++s)
#pragma unroll
            for (int j = 0; j < 4; ++j) { const f32x2 ww = *(const f32x2*)(cw + j * 1536 + s * 512 + hh * 128 + 2 * lane); w0[s][j] = ww[0]; w1[s][j] = ww[1]; }
        __syncthreads();
        if (wave == 0) { const int m = m0 + lane; const float br = SMALL[(size_t)m * 8 + hh], ar = SMALL[(size_t)m * 8 + 4 + hh];
            float g = -__expf(p.in[I_GALOG][layer * 4 + hh]) * softplusf_(ar + p.in[I_GDT][layer * 4 + hh]);
#pragma unroll
            for (int o = 1; o < 64; o <<= 1) { const float t = __shfl_up(g, o); if (lane >= o) g += t; }
            tab[lane] = sigmoidf_(br); tab[64 + lane] = g; tab[128 + lane] = __expf(g); }
        __syncthreads();
        {
#pragma unroll
            for (int ii = 0; ii < 8; ++ii) { const int i = i0 + ii;
                float y[3][2];
#pragma unroll
                for (int s = 0; s < 3; ++s) { float a0 = 0.f, a1 = 0.f;
#pragma unroll
                    for (int j = 0; j < 4; ++j) { a0 += w0[s][j] * bf_lo(raw[s][ii + j]); a1 += w1[s][j] * bf_hi(raw[s][ii + j]); }
                    y[s][0] = siluf_(a0); y[s][1] = siluf_(a1); }
                const float sq = wave_sum(y[0][0] * y[0][0] + y[0][1] * y[0][1]), sk = wave_sum(y[1][0] * y[1][0] + y[1][1] * y[1][1]);
                const float rq = 0.08838834764831845f * __builtin_amdgcn_rsqf(sq + EPS), rk = __builtin_amdgcn_rsqf(sk + EPS);
                const float be = tab[i], bg = be * tab[128 + i];
                const float k0 = y[1][0] * rk, k1 = y[1][1] * rk;
                *(LAS unsigned*)(lds + CP_QN + i * 272 + 4 * lane) = pk2(y[0][0] * rq, y[0][1] * rq);
                *(LAS unsigned*)(lds + CP_KN + i * 272 + 4 * lane) = pk2(k0, k1);
                *(LAS bf16*)(lds + CP_KT + (2 * lane) * 144 + 2 * i) = (bf16)f2bf(k0); *(LAS bf16*)(lds + CP_KT + (2 * lane + 1) * 144 + 2 * i) = (bf16)f2bf(k1);
                *(LAS bf16*)(lds + CP_VT + (2 * lane) * 144 + 2 * i) = (bf16)f2bf(be * y[2][0]); *(LAS bf16*)(lds + CP_VT + (2 * lane + 1) * 144 + 2 * i) = (bf16)f2bf(be * y[2][1]);
                *(LAS bf16*)(lds + CP_KGT + (2 * lane) * 144 + 2 * i) = (bf16)f2bf(bg * k0); *(LAS bf16*)(lds + CP_KGT + (2 * lane + 1) * 144 + 2 * i) = (bf16)f2bf(bg * k1);
            }
        }
        __syncthreads();
        for (int jb = wave; jb < 32; jb += 8) { const int which = jb >> 4, mt = (jb >> 2) & 3, nt = jb & 3;
            f32x4 acc = (f32x4){0.f, 0.f, 0.f, 0.f};
            if (nt <= mt) {
#pragma unroll
                for (int ks = 0; ks < 4; ++ks) acc = mfma16(ld_frag16(lds + (which ? CP_QN : CP_KN) + (16 * mt + li) * 272 + (32 * ks + 8 * q) * 2), ld_frag16(lds + CP_KN + (16 * nt + li) * 272 + (32 * ks + 8 * q) * 2), acc);
            }
            const int j = 16 * nt + li; const float gj = tab[64 + j];
#pragma unroll
            for (int r = 0; r < 4; ++r) { const int i = 16 * mt + 4 * q + r; const float gi = tab[64 + i];
                if (which == 0) { ((LAS float*)(lds + CP_A32))[i * 64 + j] = (i > j) ? tab[i] * acc[r] * __expf(gi - gj) : 0.f; }
                else { *(LAS bf16*)(lds + CP_ATT + i * 144 + 2 * j) = (bf16)f2bf((i >= j) ? acc[r] * __expf(gi - gj) : 0.f); } }
        }
        __syncthreads();
        if (wave == 0) {
            float Tc[64]; const float lanef = (float)lane;
            const LAS float* A = (const LAS float*)(lds + CP_A32); asm volatile("" : "+v"(A));
            LAS unsigned char* Tw = lds + CP_T16 + 2 * lane; asm volatile("" : "+v"(Tw));
#pragma unroll
            for (int i = 0; i < 64; ++i) { float a4[4] = {fmaxf(0.f, 1.f - fabsf((float)i - lanef)), 0.f, 0.f, 0.f};
#pragma unroll
                for (int j = 0; j < i; j += 4) { const f32x4 av = *(const LAS f32x4*)(A + i * 64 + j);
#pragma unroll
                    for (int jj = 0; jj < 4; ++jj) if (j + jj < i) a4[jj] -= av[jj] * Tc[j + jj]; }
                const float a = (a4[0] + a4[1]) + (a4[2] + a4[3]);
                Tc[i] = a; *(LAS bf16*)(Tw + i * 144) = (bf16)f2bf(a); }
        } else {
            const int t2 = tid - 64;
            for (int pc = t2; pc < 1024; pc += 448) { const int row = pc >> 4, seg = pc & 15; *(u32x4*)(rec + REC_Q + pc * 16) = *(const LAS u32x4*)(lds + CP_QN + row * 272 + seg * 16); }
            for (int pc = t2; pc < 512; pc += 448) { const int row = pc >> 3, seg = pc & 7; *(u32x4*)(rec + REC_ATT + pc * 16) = *(const LAS u32x4*)(lds + CP_ATT + row * 144 + seg * 16); }
            for (int pc = t2; pc < 1024; pc += 448) { const int row = pc >> 3, seg = pc & 7; *(u32x4*)(rec + REC_KT + pc * 16) = *(const LAS u32x4*)(lds + CP_KT + row * 144 + seg * 16); }
            if (t2 < 16) *(u32x4*)(rec + REC_G + t2 * 16) = *(const LAS u32x4*)(lds + CP_TAB + 256 + t2 * 16);
        }
        __syncthreads();
        for (int jb = wave; jb < 64; jb += 8) {
            f32x4 acc = (f32x4){0.f, 0.f, 0.f, 0.f};
            if (jb < 32) { const int mt = jb >> 3, nt = jb & 7;
#pragma unroll
                for (int ks = 0; ks < 2; ++ks) acc = mfma16(ld_frag16(lds + CP_T16 + (16 * mt + li) * 144 + (32 * ks + 8 * q) * 2), ld_frag16(lds + CP_VT + (16 * nt + li) * 144 + (32 * ks + 8 * q) * 2), acc);
                u32x2 o; o.x = pk2(acc[0], acc[1]); o.y = pk2(acc[2], acc[3]);
                *(u32x2*)(rec + REC_U + (size_t)((nt * 64 + lane) * 4 + mt) * 8) = o;
            } else { const int mt = (jb - 32) >> 2, nt = (jb - 32) & 3;
#pragma unroll
                for (int ks = 0; ks < 2; ++ks) acc = mfma16(ld_frag16(lds + CP_KGT + (16 * mt + li) * 144 + (32 * ks + 8 * q) * 2), ld_frag16(lds + CP_T16 + (16 * nt + li) * 144 + (32 * ks + 8 * q) * 2), acc);
                u32x2 o; o.x = pk2(acc[0], acc[1]); o.y = pk2(acc[2], acc[3]);
                *(u32x2*)(rec + REC_W + (size_t)((16 * nt + li) * 128 + 16 * mt + 4 * q) * 2) = o;
            }
        }
    }
    __syncthreads();
}
constexpr int SC_W = 0, SC_KT = 17408, SC_G = 35840, SC_BUF = 36096;
__device__ __forceinline__ void gdn_chunk_scan(const Params& p, LAS unsigned char* lds, int tid, int wave, int lane, int bh, int half) {
    const int q = lane >> 4, li = lane & 15, sl = half * 4 + (wave & 3);
    unsigned char* rec0 = p.ws + WS_REC + (size_t)(bh * 64) * REC_BYTES;
    u32x4* S0F = (u32x4*)(p.ws + WS_OBUF) + (size_t)(bh * 64) * 8 * 4 * 64;
    u32x4 pf[4], pfg = (u32x4){0u, 0u, 0u, 0u}, pu[2];
#define SC_LOAD(nn) do { const unsigned char* r_ = rec0 + (size_t)(nn) * REC_BYTES; \
        pf[0] = *(const u32x4*)(r_ + REC_W + (size_t)tid * 16); pf[1] = *(const u32x4*)(r_ + REC_W + (size_t)(tid + 512) * 16); \
        pf[2] = *(const u32x4*)(r_ + REC_KT + (size_t)tid * 16); pf[3] = *(const u32x4*)(r_ + REC_KT + (size_t)(tid + 512) * 16); \
        if (tid < 16) pfg = *(const u32x4*)(r_ + REC_G + tid * 16); \
        pu[0] = *(const u32x4*)(r_ + REC_U + (size_t)(sl * 64 + lane) * 32); pu[1] = *(const u32x4*)(r_ + REC_U + (size_t)(sl * 64 + lane) * 32 + 16); } while (0)
#define SC_STORE(buf) do { LAS unsigned char* d_ = lds + (buf) * SC_BUF; \
        _Pragma("unroll") for (int k_ = 0; k_ < 2; ++k_) { const int pc_ = tid + 512 * k_; *(LAS u32x4*)(d_ + SC_W + (pc_ >> 4) * 272 + (pc_ & 15) * 16) = pf[k_]; \
            *(LAS u32x4*)(d_ + SC_KT + (pc_ >> 3) * 144 + (pc_ & 7) * 16) = pf[2 + k_]; } \
        if (tid < 16) *(LAS u32x4*)(d_ + SC_G + tid * 16) = pfg; } while (0)
    f32x4 S[8];
#pragma unroll
    for (int i = 0; i < 8; ++i) S[i] = (f32x4){0.f, 0.f, 0.f, 0.f};
    __syncthreads();
    SC_LOAD(0); SC_STORE(0);
    u32x4 cu[2]; cu[0] = pu[0]; cu[1] = pu[1];
    __syncthreads();
    for (int n = 0; n < 64; ++n) {
        const LAS unsigned char* L = lds + (n & 1) * SC_BUF;
        if (n + 1 < 64) SC_LOAD(n + 1);
        if (wave < 4) {
            bf16x8 Sb[4];
#pragma unroll
            for (int ks = 0; ks < 4; ++ks) { Sb[ks] = pack_frag(S[2 * ks], S[2 * ks + 1]); S0F[(size_t)((n * 8 + sl) * 4 + ks) * 64 + lane] = __builtin_bit_cast(u32x4, Sb[ks]); }
            f32x4 a1[4];
#pragma unroll
            for (int mt = 0; mt < 4; ++mt) { a1[mt] = (f32x4){0.f, 0.f, 0.f, 0.f};
#pragma unroll
                for (int ks = 0; ks < 4; ++ks) a1[mt] = mfma16(ld_frag8x2(L + SC_W + (16 * mt + li) * 272 + (32 * ks + 4 * q) * 2), Sb[ks], a1[mt]); }
            const float g63 = *(const LAS float*)(L + SC_G + 63 * 4);
            f32x4 vn[4], vd[4];
#pragma unroll
            for (int mt = 0; mt < 4; ++mt) { const f32x4 gi = *(const LAS f32x4*)(L + SC_G + (16 * mt + 4 * q) * 4);
                const unsigned ulo = (mt < 2) ? (mt == 0 ? cu[0].x : cu[0].z) : (mt == 2 ? cu[1].x : cu[1].z), uhi = (mt < 2) ? (mt == 0 ? cu[0].y : cu[0].w) : (mt == 2 ? cu[1].y : cu[1].w);
                const f32x4 uu = (f32x4){bf_lo(ulo), bf_hi(ulo), bf_lo(uhi), bf_hi(uhi)};
                vn[mt] = uu - a1[mt];
#pragma unroll
                for (int r = 0; r < 4; ++r) vd[mt][r] = vn[mt][r] * fexp(g63 - gi[r]); }
            bf16x8 Vb[2], Vd[2];
#pragma unroll
            for (int ks = 0; ks < 2; ++ks) { Vb[ks] = pack_frag(vn[2 * ks], vn[2 * ks + 1]); Vd[ks] = pack_frag(vd[2 * ks], vd[2 * ks + 1]); }
            { unsigned char* ru = rec0 + (size_t)n * REC_BYTES + REC_U + (size_t)(sl * 64 + lane) * 32;
                *(u32x4*)ru = __builtin_bit_cast(u32x4, Vb[0]); *(u32x4*)(ru + 16) = __builtin_bit_cast(u32x4, Vb[1]); }
            const float eg = fexp(g63);
#pragma unroll
            for (int mt = 0; mt < 8; ++mt) { f32x4 a4 = (f32x4){0.f, 0.f, 0.f, 0.f};
#pragma unroll
                for (int ks = 0; ks < 2; ++ks) a4 = mfma16(ld_frag8x2(L + SC_KT + (16 * mt + li) * 144 + (32 * ks + 4 * q) * 2), Vd[ks], a4);
                S[mt] = S[mt] * eg + a4; }
        }
        if (n + 1 < 64) { SC_STORE((n + 1) & 1); cu[0] = pu[0]; cu[1] = pu[1]; }
        __syncthreads();
    }
#undef SC_LOAD
#undef SC_STORE
}
constexpr int CO_Q = 0, CO_ATT = 17408, CO_G = 26624, CO_PART = 26880;
__device__ __forceinline__ void gdn_chunk_out(const Params& p, int layer, LAS unsigned char* lds, int tid, int wave, int lane) {
    const bf16* H = (const bf16*)(p.ws + WS_H); bf16* YS = (bf16*)(p.ws + WS_YS);
    const int q = lane >> 4, li = lane & 15;
    const f32x4 nw = *(const f32x4*)(p.in[I_GNW] + layer * 128 + 16 * wave + 4 * q);
    LAS float* part = (LAS float*)(lds + CO_PART);
    for (int unit = blockIdx.x; unit < 2048; unit += gridDim.x) {
        const int n = unit & 63, bh = unit >> 6, hh = bh & 3, b = bh >> 2; const int m0 = b * T + n * 64;
        const unsigned char* rec = p.ws + WS_REC + (size_t)(bh * 64 + n) * REC_BYTES;
        const u32x4* S0F = (const u32x4*)(p.ws + WS_OBUF) + (size_t)((bh * 64 + n) * 8 + wave) * 4 * 64;
        const u32x4 rq0 = *(const u32x4*)(rec + REC_Q + (size_t)tid * 16), rq1 = *(const u32x4*)(rec + REC_Q + (size_t)(tid + 512) * 16), ra = *(const u32x4*)(rec + REC_ATT + (size_t)tid * 16);
        u32x4 rg = (u32x4){0u, 0u, 0u, 0u}; if (tid < 16) rg = *(const u32x4*)(rec + REC_G + tid * 16);
        bf16x8 sf[4], vf[2];
#pragma unroll
        for (int ks = 0; ks < 4; ++ks) sf[ks] = __builtin_bit_cast(bf16x8, S0F[ks * 64 + lane]);
        vf[0] = __builtin_bit_cast(bf16x8, *(const u32x4*)(rec + REC_U + (size_t)(wave * 64 + lane) * 32)); vf[1] = __builtin_bit_cast(bf16x8, *(const u32x4*)(rec + REC_U + (size_t)(wave * 64 + lane) * 32 + 16));
        u32x2 zr[4];
#pragma unroll
        for (int mt = 0; mt < 4; ++mt) zr[mt] = *(const u32x2*)(H + (size_t)(m0 + 16 * mt + li) * DH + HZ + hh * 128 + 16 * wave + 4 * q);
        __syncthreads();
        *(LAS u32x4*)(lds + CO_Q + (tid >> 4) * 272 + (tid & 15) * 16) = rq0; *(LAS u32x4*)(lds + CO_Q + ((tid + 512) >> 4) * 272 + (tid & 15) * 16) = rq1;
        *(LAS u32x4*)(lds + CO_ATT + (tid >> 3) * 144 + (tid & 7) * 16) = ra;
        if (tid < 16) *(LAS u32x4*)(lds + CO_G + tid * 16) = rg;
        __syncthreads();
        f32x4 o[4]; float ss[4];
#pragma unroll
        for (int mt = 0; mt < 4; ++mt) { f32x4 a2 = (f32x4){0.f, 0.f, 0.f, 0.f}, a3 = (f32x4){0.f, 0.f, 0.f, 0.f};
#pragma unroll
            for (int ks = 0; ks < 4; ++ks) a2 = mfma16(sf[ks], ld_frag8x2(lds + CO_Q + (16 * mt + li) * 272 + (32 * ks + 4 * q) * 2), a2);
#pragma unroll
            for (int ks = 0; ks < 2; ++ks) a3 = mfma16(vf[ks], ld_frag8x2(lds + CO_ATT + (16 * mt + li) * 144 + (32 * ks + 4 * q) * 2), a3);
            const float gam = fexp(*(const LAS float*)(lds + CO_G + (16 * mt + li) * 4));
            o[mt] = a2 * gam + a3;
            float s = (o[mt][0] * o[mt][0] + o[mt][1] * o[mt][1]) + (o[mt][2] * o[mt][2] + o[mt][3] * o[mt][3]);
            s += __shfl_xor(s, 16); s += __shfl_xor(s, 32);
            if (q == 0) part[(16 * mt + li) * 8 + wave] = s; }
        __syncthreads();
#pragma unroll
        for (int mt = 0; mt < 4; ++mt) { const f32x4 pa = *(const LAS f32x4*)(part + (16 * mt + li) * 8), pb = *(const LAS f32x4*)(part + (16 * mt + li) * 8 + 4);
            ss[mt] = ((pa[0] + pa[1]) + (pa[2] + pa[3])) + ((pb[0] + pb[1]) + (pb[2] + pb[3]));
            const float rs = __builtin_amdgcn_rsqf(ss[mt] * (1.0f / 128.0f) + EPS);
            u32x2 w; w.x = pk2(o[mt][0] * rs * nw[0] * siluf_(bf_lo(zr[mt].x)), o[mt][1] * rs * nw[1] * siluf_(bf_hi(zr[mt].x)));
            w.y = pk2(o[mt][2] * rs * nw[2] * siluf_(bf_lo(zr[mt].y)), o[mt][3] * rs * nw[3] * siluf_(bf_hi(zr[mt].y)));
            *(u32x2*)(YS + (size_t)(m0 + 16 * mt + li) * 2048 + hh * 128 + 16 * wave + 4 * q) = w; }
    }
    __syncthreads();
}
__device__ __forceinline__ void sum_gated(const Params& p, int gtid, int NGT) {
    const bf16* H = (const bf16*)(p.ws + WS_H); bf16* MG = (bf16*)(p.ws + WS_MERGED);
    for (int it = gtid; it < M * 128; it += NGT) { const int m = it >> 7, c8 = (it & 127) * 8; const bf16* r = H + (size_t)m * DH + HGATE + c8;
        float a[8], b[8];
        unpack8(*(const u32x4*)r, a);
#pragma unroll
        for (int br = 1; br < 4; ++br) { unpack8(*(const u32x4*)(r + br * 1024), b);
#pragma unroll
            for (int i = 0; i < 8; ++i) a[i] += b[i]; }
        *(u32x4*)(MG + (size_t)m * D + c8) = pack8(a); }
}

constexpr size_t WS_WRT = WS_MOETAB + MiB; constexpr int WRT_N = 80 * 1024;
__device__ __forceinline__ void prep_router_tables(const Params& p, int gtid, int NGT) {
    bf16* WRT = (bf16*)(p.ws + WS_WRT);
    for (int idx = gtid; idx < NLAYER * WRT_N; idx += NGT) { const int l = idx / WRT_N, n = (idx % WRT_N) >> 10, k = idx & 1023;
        const float w = (n < 64) ? p.in[I_REXP][((size_t)l * D + k) * 64 + n] : (n < 72 ? p.in[I_RGRP][((size_t)l * D + k) * 8 + (n - 64)] : 0.f);
        const unsigned hi = f2bf(w); const float wl = w - __uint_as_float(hi << 16);
        WRT[(size_t)(l * 2) * WRT_N + (idx % WRT_N)] = (bf16)hi; WRT[(size_t)(l * 2 + 1) * WRT_N + (idx % WRT_N)] = (bf16)f2bf(wl); }
}
__device__ __forceinline__ void moe_route_vb(const Params& p, int layer, LAS unsigned char* lds, int tid, int wave, int lane, int vb, const f32x4 (&nw)[4]) {
    LAS int* hist = (LAS int*)(lds + LDSCTL_OFF + LC_TAB);
    bf16* XN = (bf16*)(p.ws + WS_XN);
    int* route_e = (int*)(p.ws + WS_ROUTE); float* route_w = (float*)(p.ws + WS_ROUTE + (size_t)M * 2 * 4);
    int* cnt = (int*)(p.ws + WS_MOETAB + (size_t)NROWS_MAX * 8);
    const bf16* Wh = (const bf16*)(p.ws + WS_WRT) + (size_t)(layer * 2) * WRT_N; const bf16* Wl = Wh + WRT_N;
    const int q = lane >> 4, li = lane & 15;
    __syncthreads();
    if (tid < 64) hist[tid] = 0;
    for (int tile = 0; tile < 4; ++tile) {
        const int m0 = vb * 128 + tile * 32;
        __syncthreads();
        for (int hb = 0; hb < 2; ++hb) {
        f32x4 v[2][4];
#pragma unroll
        for (int rr = 0; rr < 2; ++rr)
#pragma unroll
            for (int j = 0; j < 4; ++j) { const u32x2 xw = *(const u32x2*)((const bf16*)(p.ws + WS_X1B) + (size_t)(m0 + wave * 4 + hb * 2 + rr) * D + 4 * lane + 256 * j); v[rr][j] = (f32x4){bf_lo(xw.x), bf_hi(xw.x), bf_lo(xw.y), bf_hi(xw.y)}; }
#pragma unroll
        for (int rr = 0; rr < 2; ++rr) { const int r = wave * 4 + hb * 2 + rr, m = m0 + r; float ss = 0.f;
#pragma unroll
            for (int j = 0; j < 4; ++j) ss += (v[rr][j][0] * v[rr][j][0] + v[rr][j][1] * v[rr][j][1]) + (v[rr][j][2] * v[rr][j][2] + v[rr][j][3] * v[rr][j][3]);
            const float rs = __builtin_amdgcn_rsqf(wave_sum(ss) * (1.0f / D) + EPS);
#pragma unroll
            for (int j = 0; j < 4; ++j) { const f32x4 x = v[rr][j] * rs * nw[j];
                u32x2 h; h.x = pk2(x[0], x[1]); h.y = pk2(x[2], x[3]);
                u32x2 l; l.x = pk2(x[0] - bf_lo(h.x), x[1] - bf_hi(h.x)); l.y = pk2(x[2] - bf_lo(h.y), x[3] - bf_hi(h.y));
                *(u32x2*)(XN + (size_t)m * D + 4 * lane + 256 * j) = h;
                const int off = r * 2048 + ((((lane >> 1) + 32 * j) ^ (r & 15)) << 4) + (lane & 1) * 8;
                *(LAS u32x2*)(lds + off) = h; *(LAS u32x2*)(lds + 65536 + off) = l; } }
        }
        __syncthreads();
        f32x4 acc[2][5];
#pragma unroll
        for (int mt = 0; mt < 2; ++mt)
#pragma unroll
            for (int nt = 0; nt < 5; ++nt) acc[mt][nt] = (f32x4){0.f, 0.f, 0.f, 0.f};
        {
            const bf16* bp = Wh + (size_t)li * 1024 + 128 * wave + 8 * q;
#pragma unroll
            for (int ks = 0; ks < 4; ++ks) {
                bf16x8 ah[2], al[2];
#pragma unroll
                for (int mt = 0; mt < 2; ++mt) { const int off = (16 * mt + li) * 2048 + (((16 * wave + 4 * ks + q) ^ li) << 4); ah[mt] = ld_frag16(lds + off); al[mt] = ld_frag16(lds + 65536 + off); }
#pragma unroll
                for (int nt = 0; nt < 5; ++nt) { const bf16x8 bh = *(const bf16x8*)(bp + nt * 16384 + 32 * ks), bl = *(const bf16x8*)(bp + WRT_N + nt * 16384 + 32 * ks);
#pragma unroll
                    for (int mt = 0; mt < 2; ++mt) { acc[mt][nt] = mfma16(ah[mt], bh, acc[mt][nt]); acc[mt][nt] = mfma16(al[mt], bh, acc[mt][nt]); acc[mt][nt] = mfma16(ah[mt], bl, acc[mt][nt]); } }
            }
        }
        __syncthreads();
        LAS float* part = (LAS float*)lds;
#pragma unroll
        for (int mt = 0; mt < 2; ++mt)
#pragma unroll
            for (int nt = 0; nt < 5; ++nt) { if (16 * nt + li < 72) {
#pragma unroll
                for (int r = 0; r < 4; ++r) part[(wave * 32 + 16 * mt + 4 * q + r) * 72 + 16 * nt + li] = acc[mt][nt][r]; } }
        __syncthreads();
        for (int r = wave * 4; r < wave * 4 + 4; ++r) { const int m = m0 + r;
            float le = 0.f, lg = 0.f;
#pragma unroll
            for (int w = 0; w < 8; ++w) { le += part[(w * 32 + r) * 72 + lane]; lg += part[(w * 32 + r) * 72 + 64 + (lane & 7)]; }
            float gv[8];
#pragma unroll
            for (int i = 0; i < 8; ++i) gv[i] = __shfl(lg, i);
            int grp = 0; float gmax = gv[0];
#pragma unroll
            for (int i = 1; i < 8; ++i) if (gv[i] > gmax) { gmax = gv[i]; grp = i; }
            float gs = 0.f;
#pragma unroll
            for (int i = 0; i < 8; ++i) gs += __expf(gv[i] - gmax);
            const float psel = 1.0f / gs;
            float ev[8];
#pragma unroll
            for (int i = 0; i < 8; ++i) ev[i] = __shfl(le, grp * 8 + i);
            int i1 = 0; float e1 = ev[0];
#pragma unroll
            for (int i = 1; i < 8; ++i) if (ev[i] > e1) { e1 = ev[i]; i1 = i; }
            int i2 = -1; float e2 = -3.0e38f;
#pragma unroll
            for (int i = 0; i < 8; ++i) if (i != i1 && ev[i] > e2) { e2 = ev[i]; i2 = i; }
            const float x2 = __expf(e2 - e1), w1 = psel / (1.0f + x2), w2 = psel * x2 / (1.0f + x2);
            if (lane == 0) { route_e[(size_t)m * 2] = grp * 8 + i1; route_e[(size_t)m * 2 + 1] = grp * 8 + i2; route_w[(size_t)m * 2] = w1; route_w[(size_t)m * 2 + 1] = w2;
                atomicAdd((int*)(hist + grp * 8 + i1), 1); atomicAdd((int*)(hist + grp * 8 + i2), 1); }
        }
    }
    __syncthreads();
    if (tid < 64) cnt[vb * 64 + tid] = hist[tid];
}
__device__ __forceinline__ void moe_route(const Params& p, int layer, LAS unsigned char* lds, int tid, int wave, int lane) {
    f32x4 nw[4];
#pragma unroll
    for (int j = 0; j < 4; ++j) nw[j] = *(const f32x4*)(p.in[I_MOENW] + layer * D + 4 * lane + 256 * j);
    for (int vb = blockIdx.x; vb < M / 128; vb += gridDim.x) moe_route_vb(p, layer, lds, tid, wave, lane, vb, nw);
    __syncthreads();
}
__device__ __forceinline__ void moe_dispatch(const Params& p, LAS unsigned char* lds, int tid, int wave, int lane) {
    LAS int* tab = (LAS int*)(lds + LDSCTL_OFF + LC_TAB);
    const bf16* XN = (const bf16*)(p.ws + WS_XN); bf16* XS = (bf16*)(p.ws + WS_XS);
    const int* route_e = (const int*)(p.ws + WS_ROUTE); const float* route_w = (const float*)(p.ws + WS_ROUTE + (size_t)M * 2 * 4);
    int* row_code = (int*)(p.ws + WS_MOETAB); float* row_w = (float*)(p.ws + WS_MOETAB + (size_t)NROWS_MAX * 4);
    const int* cnt = (const int*)(p.ws + WS_MOETAB + (size_t)NROWS_MAX * 8); int* blk_e = (int*)(p.ws + WS_MOETAB + (size_t)NROWS_MAX * 8 + 256 * 64 * 4);
    for (int vb = blockIdx.x; vb < M / 128; vb += gridDim.x) {
        __syncthreads();
        {
            const int e = tid & 63, part = tid >> 6; int run = 0, base = 0;
#pragma unroll 8
            for (int v = part * 32; v < part * 32 + 32; ++v) { const int c = cnt[v * 64 + e]; if (v < vb) base += c; run += c; }
            tab[720 + part * 64 + e] = run; tab[1240 + part * 64 + e] = base;
        }
        __syncthreads();
        if (tid < 64) { int run = 0, base = 0;
#pragma unroll
            for (int k = 0; k < 8; ++k) { run += tab[720 + k * 64 + tid]; base += tab[1240 + k * 64 + tid]; }
            tab[64 + tid] = run; tab[128 + tid] = base; }
        __syncthreads();
        if (tid == 0) { int s = 0; for (int e = 0; e < 64; ++e) { tab[e] = s; s += (tab[64 + e] + 255) / 256 * 256; } tab[704] = s; }
        if (tid < 256) tab[192 + tid] = route_e[(size_t)vb * 256 + tid];
        __syncthreads();
        if (tid < 256) { const int e = tab[192 + tid]; int rank = 0; for (int a = 0; a < tid; ++a) rank += (tab[192 + a] == e) ? 1 : 0;
            const int pos = tab[e] + tab[128 + e] + rank; tab[448 + tid] = pos;
            row_code[pos] = ((vb * 128 + (tid >> 1)) << 1) | (tid & 1); row_w[pos] = route_w[(size_t)vb * 256 + tid]; }
        if (vb < 64) { const int ps = tab[vb], tot = tab[64 + vb], pe = ps + (tot + 255) / 256 * 256;
            for (int r = ps + tot + tid; r < pe; r += 512) row_code[r] = -1;
            for (int b = ps / 256 + tid; b < pe / 256; b += 512) blk_e[b] = vb;
            if (tid == 0) { blk_e[NROWBLK_MAX + 64 + vb] = ps / 256; blk_e[NROWBLK_MAX + 128 + vb] = (pe - ps) / 256; }
            if (vb == 63 && tid == 0) blk_e[NROWBLK_MAX] = tab[704] / 256; }
        __syncthreads();
        for (int a0 = wave * 32; a0 < wave * 32 + 32; a0 += 8) {
            u32x4 r0[8], r1[8];
#pragma unroll
            for (int k = 0; k < 8; ++k) { const u32x4* src = (const u32x4*)(XN + (size_t)(vb * 128 + ((a0 + k) >> 1)) * D); r0[k] = src[lane]; r1[k] = src[lane + 64]; }
#pragma unroll
            for (int k = 0; k < 8; ++k) { u32x4* dst = (u32x4*)(XS + (size_t)tab[448 + a0 + k] * D); dst[lane] = r0[k]; dst[lane + 64] = r1[k]; } }
    }
    __syncthreads();
}

__global__ void __launch_bounds__(512, 2) fwd(Params p) {
    extern __shared__ __attribute__((aligned(16))) unsigned char lds_raw[];
    LAS unsigned char* lds = (LAS unsigned char*)lds_raw;
    const int tid0 = threadIdx.x;
    const int G = gridDim.x, NGW = G * 8, NGT = G * 512;
#define FRESH() Params pl = p; { GAS unsigned char* w_ = (GAS unsigned char*)pl.ws; GAS float* o_ = (GAS float*)pl.out; asm volatile("" : "+s"(w_), "+s"(o_)); pl.ws = (unsigned char*)w_; pl.out = (float*)o_; }     int tid = tid0; asm volatile("" : "+v"(tid)); const int lane = tid & 63, wave = __builtin_amdgcn_readfirstlane(tid >> 6); const int gw = blockIdx.x * 8 + wave, gtid = blockIdx.x * 512 + tid; (void)lane; (void)gw; (void)gtid
    for (int u = tid0; u < (LDS_BYTES - LDSCTL_OFF) / 4; u += 512) ((LAS unsigned*)(lds + LDSCTL_OFF))[u] = 0u;
    __syncthreads();
    const int lo = p.ph_lo, hi = p.ph_hi;
    XcdBarrier bar; bar.bar = (unsigned*)(p.ws + WS_CTL) + CW_BAR; bar.x = 0; bar.st = (volatile LAS unsigned*)(lds + LDSCTL_OFF + LC_BAR);
    if (hi - lo > 1) bar = xcd_barrier_post((unsigned*)(p.ws + WS_CTL) + CW_BAR, (volatile LAS unsigned*)(lds + LDSCTL_OFF + LC_BAR));
#ifndef PHASE_MASK
#define PHASE_MASK 0x1fff
#endif
#define IN(k) (((PHASE_MASK >> ((k) == PH_FINAL ? 12 : ((k) % PH_PER_LAYER))) & 1) && lo <= (k) && (k) < hi)
#define REPS(k) ((((REPEAT_MASK) >> (k)) & 1) && layer == 0 ? 2 : 1)
#define SEAM(k) do { if (IN(k) && IN((k) + 1)) xcd_barrier(bar); } while (0)

    for (int layer = 0; layer < NLAYER; ++layer) {
        const int g0 = layer * PH_PER_LAYER;

        for (int rep_ = 0; rep_ < REPS(0); ++rep_) if (IN(g0 + 0)) { if (rep_) __syncthreads(); FRESH();
            if (layer == 0) { prep_static_weights(pl, gw, NGW, lane); prep_router_tables(pl, gtid, NGT); __syncthreads(); norm_phase<0>(pl, layer, lds, gw, NGW, tid, lane); }
            else norm_phase<1>(pl, layer, lds, gw, NGW, tid, lane);
        }
        SEAM(g0 + 0);
        for (int rep_ = 0; rep_ < REPS(1); ++rep_) if (IN(g0 + 1)) { if (rep_) __syncthreads(); FRESH();
            SchedH S; S.to.init(M / 256, DH / 256, G, (int)blockIdx.x); S.A = (const char*)(pl.ws + WS_XN); S.B = (const char*)(pl.ws + WS_WIN + layer * WIN_L);
            EpiStoreBf16 E{(bf16*)(pl.ws + WS_H), DH};
            pg8::gemm_phase(lds, tid, D, D, D, S, E);
        }
        SEAM(g0 + 1);
        for (int rep_ = 0; rep_ < REPS(2); ++rep_) if (IN(g0 + 2)) { if (rep_) __syncthreads(); FRESH(); gdn_chunk_prep(pl, layer, lds, tid, wave, lane); }
        SEAM(g0 + 2);
        for (int rep_ = 0; rep_ < REPS(3); ++rep_) if (IN(g0 + 3)) { if (rep_) __syncthreads(); FRESH();
            if ((int)blockIdx.x < 64) gdn_chunk_scan(pl, lds, tid, wave, lane, (int)blockIdx.x >> 1, (int)blockIdx.x & 1);
            {
                unsigned* qc = (unsigned*)(pl.ws + WS_CTL) + CW_QUEUE + layer * 256;
                gmlp(pl, layer, lds, tid, wave, lane, qc);
                conformer(pl, layer, lds, tid, wave, lane, qc + 64);
                for (;;) { const int unit = queue_pop(qc + 128, lds, tid); if (unit >= M / 128) break; shortconv_unit(pl, layer, tid, unit); }
            }
        }
        SEAM(g0 + 3);
        for (int rep_ = 0; rep_ < REPS(4); ++rep_) if (IN(g0 + 4)) { if (rep_) __syncthreads(); FRESH(); gdn_chunk_out(pl, layer, lds, tid, wave, lane); }
        SEAM(g0 + 4);
        for (int rep_ = 0; rep_ < REPS(5); ++rep_) if (IN(g0 + 5)) { if (rep_) __syncthreads(); FRESH();
            SchedBranch S; S.to.init(M / 256, 4, G, (int)blockIdx.x); S.YS = (const char*)(pl.ws + WS_YS); S.WBR = (const char*)(pl.ws + WS_WBR + layer * WBR_L);
            EpiGate E{(bf16*)(pl.ws + WS_H) + HGATE, (bf16*)(pl.ws + WS_MERGED)};
            pg8::gemm_phase(lds, tid, 512, 2048, 512, S, E);
        }
        for (int rep_ = 0; rep_ < REPS(6); ++rep_) if (IN(g0 + 6)) { if (rep_) __syncthreads(); FRESH();   }
        SEAM(g0 + 6);
        for (int rep_ = 0; rep_ < REPS(7); ++rep_) if (IN(g0 + 7)) { if (rep_) __syncthreads(); FRESH();
            const int NGB = G / 2;
            if ((int)blockIdx.x < NGB) {
                SchedOut S; S.to.init(M / 256, 4, NGB, (int)blockIdx.x); S.A = (const char*)(pl.ws + WS_MERGED); S.B = (const char*)(pl.ws + WS_WOUT + layer * WOUT_L);
                EpiRes E{layer == 0 ? pl.in[I_X] : nullptr, (const bf16*)pl.out, (bf16*)(pl.ws + WS_X1B)};
                pg8::gemm_phase(lds, tid, D, D, D, S, E);
            } else prep_moe_weights(pl, layer, ((int)blockIdx.x - NGB) * 8 + wave, (G - NGB) * 8, lane);
        }
        SEAM(g0 + 7);
        for (int rep_ = 0; rep_ < REPS(8); ++rep_) if (IN(g0 + 8)) { if (rep_) __syncthreads(); FRESH(); moe_route(pl, layer, lds, tid, wave, lane); }
        SEAM(g0 + 8);
        for (int rep_ = 0; rep_ < REPS(9); ++rep_) if (IN(g0 + 9)) { if (rep_) __syncthreads(); FRESH(); moe_dispatch(pl, lds, tid, wave, lane); }
        SEAM(g0 + 9);
        if (IN(g0 + 10) || IN(g0 + 11)) { FRESH();
            LAS int* tb = (LAS int*)(lds + LDSCTL_OFF + LC_TAB);
            const int* est = (const int*)(pl.ws + WS_MOETAB + (size_t)NROWS_MAX * 8 + 256 * 64 * 4) + NROWBLK_MAX + 64;
            const int NX = (G % 8 == 0) ? 8 : 1, x = (int)blockIdx.x % NX, nk = 64 / NX;
            __syncthreads();
            if (tid < nk) { tb[160 + tid] = est[x + NX * tid]; tb[240 + tid] = est[64 + x + NX * tid]; }
            __syncthreads();
            if (tid == 0) { int s = 0; for (int k = 0; k < nk; ++k) { tb[k] = s; tb[80 + k] = tb[160 + k]; s += tb[240 + k] * 4; } tb[nk] = s; }
            __syncthreads();
        }
        for (int rep_ = 0; rep_ < REPS(10); ++rep_) if (IN(g0 + 10)) { if (rep_) __syncthreads(); FRESH();
            LAS int* tb = (LAS int*)(lds + LDSCTL_OFF + LC_TAB); const int NX = (G % 8 == 0) ? 8 : 1, nk = 64 / NX;
            SchedMoe S; S.nux = tb[nk]; S.nrank = G / NX; S.rank = (int)blockIdx.x / NX; S.nk = nk; S.x = (int)blockIdx.x % NX; S.NX = NX; S.cum = tb; S.rb0 = tb + 80;
            S.A = (const char*)(pl.ws + WS_XS); S.a_blk = (size_t)256 * D * 2; S.W = (const char*)(pl.ws + WS_MOEW); S.w_e = WGU_E; S.w_pn = (size_t)256 * D * 2; S.cmul = 128;
            EpiSwiglu E{(bf16*)(pl.ws + WS_HB)};
            pg8::gemm_phase(lds, tid, D, D, D, S, E);
        }
        SEAM(g0 + 10);
        for (int rep_ = 0; rep_ < REPS(11); ++rep_) if (IN(g0 + 11)) { if (rep_) __syncthreads(); FRESH();
            LAS int* tb = (LAS int*)(lds + LDSCTL_OFF + LC_TAB); const int NX = (G % 8 == 0) ? 8 : 1, nk = 64 / NX;
            SchedMoe S; S.nux = tb[nk]; S.nrank = G / NX; S.rank = (int)blockIdx.x / NX; S.nk = nk; S.x = (int)blockIdx.x % NX; S.NX = NX; S.cum = tb; S.rb0 = tb + 80;
            S.A = (const char*)(pl.ws + WS_HB); S.a_blk = (size_t)256 * DE * 2; S.W = (const char*)(pl.ws + WS_WD); S.w_e = WD_E; S.w_pn = (size_t)256 * DE * 2; S.cmul = 256;
            EpiScatter E{(bf16*)(pl.ws + WS_Y), (const int*)(pl.ws + WS_MOETAB), (const float*)(pl.ws + WS_MOETAB + (size_t)NROWS_MAX * 4)};
            pg8::gemm_phase(lds, tid, DE, DE, DE, S, E);
        }
        SEAM(g0 + 11);
    }
    if (IN(PH_FINAL)) { FRESH(); norm_phase<2>(pl, 0, lds, gw, NGW, tid, lane); }
#undef IN
#undef SEAM
}

extern "C" void kernel_launch(void* const* d_in, const int* in_sizes, int n_in, void* d_out, int out_size, void* d_ws, size_t ws_size, hipStream_t stream) {
    static int grid = 0;
    if (grid == 0) {
        if (n_in != 25 || out_size != M * D || ws_size < WS_END) { fprintf(stderr, "kernel_launch: unexpected shapes / workspace (n_in %d out %d ws %zu, need %zu)\n", n_in, out_size, ws_size, (size_t)WS_END); grid = -1; return; }
        int dev = 0, cus = 0, per_cu = 0;
        if (hipGetDevice(&dev) != hipSuccess || hipDeviceGetAttribute(&cus, hipDeviceAttributeMultiprocessorCount, dev) != hipSuccess) { grid = -1; return; }
        if (hipFuncSetAttribute((const void*)fwd, hipFuncAttributeMaxDynamicSharedMemorySize, LDS_BYTES) != hipSuccess) { fprintf(stderr, "kernel_launch: hipFuncSetAttribute failed\n"); grid = -1; return; }
        if (hipOccupancyMaxActiveBlocksPerMultiprocessor(&per_cu, (const void*)fwd, 512, LDS_BYTES) != hipSuccess || per_cu < 1) { fprintf(stderr, "kernel_launch: occupancy query says %d\n", per_cu); }
        (void)hipGetLastError();
        grid = cus;
    }
    if (grid < 0) return;
    hipMemsetAsync((char*)d_ws + WS_CTL, 0, CTL_BYTES, stream);
    Params p{};
    for (int i = 0; i < 25; ++i) p.in[i] = (const float*)d_in[i];
    p.out = (float*)d_out; p.ws = (unsigned char*)d_ws;
#if N_LAUNCH_MODE == 1
    p.ph_lo = 0; p.ph_hi = PH_TOTAL;
    hipLaunchKernelGGL(fwd, dim3(grid), dim3(512), LDS_BYTES, stream, p);
#else
    for (int k = 0; k < PH_TOTAL; ++k) { p.ph_lo = k; p.ph_hi = k + 1; hipLaunchKernelGGL(fwd, dim3(grid), dim3(512), LDS_BYTES, stream, p); }
#endif
}
```

```cpp
#include <hip/hip_runtime.h>
#include <cstdio>
#include <cstdint>

#ifndef REPEAT_MASK
#define REPEAT_MASK 0
#endif
#ifndef WGM_H
#define WGM_H 4
#endif
#ifndef WGM_BR
#define WGM_BR 4
#endif
#ifndef WGM_OUT
#define WGM_OUT 4
#endif
#ifndef N_LAUNCH_MODE
#define N_LAUNCH_MODE 1
#endif

#define LAS __attribute__((address_space(3)))
#define GAS __attribute__((address_space(1)))
typedef unsigned short bf16;
typedef short bf16x8 __attribute__((ext_vector_type(8)));
typedef float f32x4 __attribute__((ext_vector_type(4)));
typedef float f32x2 __attribute__((ext_vector_type(2)));
typedef unsigned u32x4 __attribute__((ext_vector_type(4)));
typedef unsigned u32x2 __attribute__((ext_vector_type(2)));

constexpr int NB = 8, T = 4096, D = 1024, M = NB * T, NLAYER = 2;
constexpr int DIN = 9736, DH = 9728;
constexpr int HQ = 0, HK = 512, HV = 1024, HZ = 1536, HCONF = 2048, HGMLP = 3072, HSC = 4096, HGATE = 5632;
constexpr int NE = 64, DE = 512;
constexpr float EPS = 1e-6f;
constexpr int NROWBLK_MAX = 320, NROWS_MAX = NROWBLK_MAX * 256;

constexpr size_t MiB = 1u << 20;
constexpr size_t WS_CTL = 0, CTL_BYTES = 1 * MiB;
constexpr size_t WS_WIN = 2 * MiB;
constexpr size_t WIN_L = (size_t)DH * D * 2;
constexpr size_t WS_WBR = 40 * MiB;
constexpr size_t WBR_L = (size_t)4 * D * 512 * 2;
constexpr size_t WS_WOUT = 48 * MiB;
constexpr size_t WOUT_L = (size_t)D * D * 2;
constexpr size_t WS_XN = 52 * MiB;
constexpr size_t WS_SMALL = 116 * MiB;
constexpr size_t WS_ROUTE = 117 * MiB;
constexpr size_t WS_MOETAB = 118 * MiB;
constexpr size_t WS_YS = 120 * MiB;
constexpr size_t WS_X1B = 120 * MiB;
constexpr size_t WS_REC = 248 * MiB;
constexpr size_t WS_MERGED = WS_REC;
constexpr size_t WS_OBUF = WS_XN;
constexpr int REC_W = 0, REC_Q = 16384, REC_ATT = 32768, REC_KT = 40960, REC_U = 57344, REC_G = 73728, REC_BYTES = 73984;
static_assert(WS_REC + (size_t)2048 * REC_BYTES <= 410 * MiB, "chunk records");
constexpr size_t WS_H = 410 * MiB;
constexpr size_t WS_MOEW = 410 * MiB;
constexpr size_t WGU_E = (size_t)1024 * 1024 * 2, WD_E = (size_t)1024 * 512 * 2;
constexpr size_t WS_WD = WS_MOEW + 64 * WGU_E;
constexpr size_t WS_XS = 602 * MiB;
constexpr size_t WS_HB = 762 * MiB;
constexpr size_t WS_Y = 842 * MiB;
constexpr size_t WS_END = 1018 * MiB;
static_assert(WS_H + (size_t)M * DH * 2 <= WS_END && WS_Y + (size_t)2 * M * D * 2 <= WS_END, "ws map");

constexpr int CW_BAR = 4096;
constexpr int CW_QUEUE = 16384;
constexpr int STAGE_LDS = 131072, LDSCTL_OFF = 131072, LDS_BYTES = 147456;
constexpr int LC_BAR = 0;
constexpr int LC_MISC = 64;
constexpr int LC_TAB = 1024;

__device__ __forceinline__ float bf_lo(unsigned w) { return __uint_as_float(w << 16); }
__device__ __forceinline__ float bf_hi(unsigned w) { return __uint_as_float(w & 0xffff0000u); }
__device__ __forceinline__ float bf2f(bf16 b) { return __uint_as_float(((unsigned)b) << 16); }
__device__ __forceinline__ unsigned f2bf(float f) { unsigned u = __float_as_uint(f); return (u + 0x7fffu + ((u >> 16) & 1u)) >> 16; }
__device__ __forceinline__ unsigned pk2(float lo, float hi) { return f2bf(lo) | (f2bf(hi) << 16); }
__device__ __forceinline__ void unpack8(const u32x4 v, float (&f)[8]) {
    f[0] = bf_lo(v.x); f[1] = bf_hi(v.x); f[2] = bf_lo(v.y); f[3] = bf_hi(v.y); f[4] = bf_lo(v.z); f[5] = bf_hi(v.z); f[6] = bf_lo(v.w); f[7] = bf_hi(v.w);
}
__device__ __forceinline__ u32x4 pack8(const float (&f)[8]) { u32x4 o; o.x = pk2(f[0], f[1]); o.y = pk2(f[2], f[3]); o.z = pk2(f[4], f[5]); o.w = pk2(f[6], f[7]); return o; }
__device__ __forceinline__ float wave_sum(float v) {
#pragma unroll
    for (int o = 1; o < 64; o <<= 1) v += __shfl_xor(v, o);
    return v;
}
__device__ __forceinline__ float fexp(float x) { return __builtin_amdgcn_exp2f(x * 1.4426950408889634f); }
__device__ __forceinline__ float frcp(float x) { return __builtin_amdgcn_rcpf(x); }
__device__ __forceinline__ float sigmoidf_(float x) { return frcp(1.0f + fexp(-x)); }
__device__ __forceinline__ float siluf_(float x) { return x * frcp(1.0f + fexp(-x)); }
__device__ __forceinline__ float gelu_tanh(float x) { const float u = 0.7978845608028654f * (x + 0.044715f * x * x * x); return x * frcp(1.0f + fexp(-2.0f * u)); }
__device__ __forceinline__ float softplusf_(float x) { return fmaxf(x, 0.f) + log1pf(__expf(-fabsf(x))); }

#define XB_TMO      128
#define XB_XCNT(j)  (256  + 64 * (j))
#define XB_XSUB(j)  (1280 + 64 * (j))
#define XB_XGEN(j)  (2304 + 64 * (j))
#define XB_TOP      3328
#define XB_TOPGEN   3392
#define XCD_BAR_WORDS 3456
#define XB_SPIN_CAP (1u << 18)
__device__ __forceinline__ unsigned xb_ld(unsigned* p)              { return __hip_atomic_load(p, __ATOMIC_RELAXED, __HIP_MEMORY_SCOPE_AGENT); }
__device__ __forceinline__ unsigned xb_add(unsigned* p, unsigned v) { return __hip_atomic_fetch_add(p, v, __ATOMIC_RELAXED, __HIP_MEMORY_SCOPE_AGENT); }
__device__ __forceinline__ unsigned xb_xcc_id() { return (unsigned)__builtin_amdgcn_s_getreg((3 << 11) | 20) & 0xFu; }
#define XB_SPIN(cond, bar) do { unsigned _sp = 0; while (cond) { __builtin_amdgcn_s_sleep(1); \
    if ((++_sp & 255u) == 0u) { if (xb_ld(&(bar)[XB_TMO])) break; if (_sp > XB_SPIN_CAP) { atomicAdd(&(bar)[XB_TMO], 1u); break; } } } } while (0)
struct XcdBarrier { unsigned* bar; unsigned x; volatile LAS unsigned* st; };
__device__ __forceinline__ XcdBarrier xcd_barrier_post(unsigned* bar, volatile LAS unsigned* st) {
    XcdBarrier b; b.bar = bar; b.x = xb_xcc_id(); b.st = st;
    if (threadIdx.x == 0) (void)xb_add(&bar[XB_XCNT(b.x)], 1u);
    return b;
}
__device__ __forceinline__ void xcd_barrier_complete(unsigned* bar, unsigned x, unsigned& nloc, unsigned& nx) {
    const unsigned G = gridDim.x * gridDim.y * gridDim.z;
    unsigned sum, cnt, mine, sp = 0u;
    for (;;) {
        sum = 0u; cnt = 0u; mine = 0u;
#pragma unroll
        for (unsigned j = 0; j < 16; ++j) { const unsigned c = xb_ld(&bar[XB_XCNT(j)]); sum += c; cnt += (c > 0u) ? 1u : 0u; mine = (j == x) ? c : mine; }
        if (sum == G) break;
        __builtin_amdgcn_s_sleep(1);
        if ((++sp & 255u) == 0u) { if (xb_ld(&bar[XB_TMO])) break; if (sp > XB_SPIN_CAP) { atomicAdd(&bar[XB_TMO], 1u); break; } }
    }
    nloc = mine > 0u ? mine : 1u; nx = cnt > 0u ? cnt : 1u;
}
__device__ __forceinline__ void xcd_barrier(const XcdBarrier& b) {
    asm volatile("s_waitcnt vmcnt(0)" ::: "memory");
    __syncthreads();
    if (threadIdx.x == 0) {
        unsigned* bar = b.bar;
        __builtin_amdgcn_s_waitcnt(0);
        unsigned nloc = b.st[0], nx = b.st[1];
        if (nloc == 0u) { xcd_barrier_complete(bar, b.x, nloc, nx); b.st[0] = nloc; b.st[1] = nx; }
        const unsigned old = xb_add(&bar[XB_XSUB(b.x)], 1u);
        const unsigned gen = old / nloc;
        if (old + 1u == (gen + 1u) * nloc) {
            __builtin_amdgcn_fence(__ATOMIC_RELEASE, "agent");
            asm volatile("s_waitcnt vmcnt(0)" ::: "memory");
            const unsigned og = xb_add(&bar[XB_TOP], 1u);
            const unsigned tg = og / nx;
            if (og + 1u == (tg + 1u) * nx) xb_add(&bar[XB_TOPGEN], 1u);
            else XB_SPIN(xb_ld(&bar[XB_TOPGEN]) == tg, bar);
            __builtin_amdgcn_fence(__ATOMIC_ACQUIRE, "agent");
            xb_add(&bar[XB_XGEN(b.x)], 1u);
            asm volatile("s_waitcnt vmcnt(0)" ::: "memory");
        } else {
            XB_SPIN(xb_ld(&bar[XB_XGEN(b.x)]) == gen, bar);
            __builtin_amdgcn_fence(__ATOMIC_ACQUIRE, "agent");
            asm volatile("s_waitcnt vmcnt(0)" ::: "memory");
        }
    }
    __syncthreads();
}

namespace pg8 {
constexpr int BM = 256, BK = 64, HALF = 128, HTB = HALF * BK * 2, STAGE_BYTES = 8 * HTB, NXCD = 8, WGM = 8;
__host__ __device__ __forceinline__ int lds_byte(int r, int c) { const int st = (r >> 4) * 2 + (c >> 5), rr = r & 15, cc = c & 31, ob = rr * 64 + cc * 2; return st * 1024 + (ob ^ (((ob >> 9) & 1) << 5)); }
__host__ __device__ __forceinline__ void stage_rc(int b, int& R, int& C) { const int st = b / 1024, sb = b % 1024, swz = sb ^ (((sb >> 9) & 1) << 5); R = (st >> 1) * 16 + swz / 64; C = (st & 1) * 32 + (swz % 64) / 2; }
__host__ __device__ __forceinline__ int perm32(int rho) { const int n = rho >> 4, i = rho & 15; return 8 * (i >> 2) + 4 * n + (i & 3); }

struct Unit { const char* A; const char* B; int r0, c0; };

struct TileOrder {
    int nM, nN, nwg, G, c, wgm;
    __device__ void init(int nM_, int nN_, int G_, int c_, int wgm_ = WGM) { nM = nM_; nN = nN_; nwg = nM * nN; G = G_; c = c_; wgm = wgm_; }
    __device__ bool next(int i, int& pm, int& pn) const {
        const long L = (long)i * G + c; if (L >= nwg) return false;
        int wgid = (int)L; { const int q = nwg / NXCD, r = nwg % NXCD, xcd = wgid % NXCD, off = wgid / NXCD; wgid = (xcd < r ? xcd * (q + 1) : r * (q + 1) + (xcd - r) * q) + off; }
        const int nig = wgm * nN, gid = wgid / nig, fm = gid * wgm, gsz = (nM - fm) < wgm ? (nM - fm) : wgm;
        pm = fm + ((wgid % nig) % gsz); pn = (wgid % nig) / gsz; return true;
    }
};
__device__ __forceinline__ unsigned cvt_pk_bf16(float lo, float hi) { unsigned r; asm volatile("v_cvt_pk_bf16_f32 %0, %1, %2" : "=v"(r) : "v"(lo), "v"(hi)); return r; }

template <class Epi, class Sched>
__device__ __forceinline__ void gemm_phase(LAS unsigned char* lds, const int tid, const int K, const int lda, const int ldb, const Sched& S, const Epi& E) {
    const int wid = __builtin_amdgcn_readfirstlane(tid >> 6), lane = tid & 63, wr = wid >> 2, wc = wid & 3, fr = lane & 15, fq = lane >> 4;
    const int nt = K / BK;
    unsigned voffA[2], voffB[2];
#pragma unroll
    for (int i = 0; i < 2; ++i) { int R, C; stage_rc(tid * 16 + i * 8192, R, C); const int Rb = Epi::PERM ? ((R & ~31) + perm32(R & 31)) : R;
        voffA[i] = (unsigned)(R * lda + C) * 2u; voffB[i] = (unsigned)(Rb * ldb + C) * 2u; }
    const size_t kstep = (size_t)(BK * 2);
    const size_t hstepA = (size_t)HALF * lda * 2, hstepB = (size_t)HALF * ldb * 2;
    const unsigned ldsw = (unsigned)wid * 1024u;
    const int aoff = lds_byte(wr * 64 + fr, fq * 8), boff = lds_byte(wc * 32 + fr, fq * 8);
#define PG8_SA(b, h) (((b) * 2 + (h)) * HTB)
#define PG8_SB(b, h) ((4 + (b) * 2 + (h)) * HTB)
#define PG8_STAGE(bufoff, gbase, voff) do { _Pragma("unroll") for (int _i = 0; _i < 2; ++_i) \
        __builtin_amdgcn_global_load_lds((const unsigned*)((const char*)(gbase) + (voff)[_i]), (LAS unsigned*)(lds + (bufoff) + ldsw + _i * 8192), 16, 0, 0); } while (0)
#define PG8_LDA(dst, b, h) do { _Pragma("unroll") for (int m = 0; m < 4; ++m) _Pragma("unroll") for (int k = 0; k < 2; ++k) dst[m][k] = *(const LAS bf16x8*)(lds + PG8_SA(b, h) + aoff + m * 2048 + k * 1024); } while (0)
#define PG8_LDB(dst, b, h) do { _Pragma("unroll") for (int n = 0; n < 2; ++n) _Pragma("unroll") for (int k = 0; k < 2; ++k) dst[n][k] = *(const LAS bf16x8*)(lds + PG8_SB(b, h) + boff + n * 2048 + k * 1024); } while (0)
#define PG8_MMA(ai, bj, At, Bt) do { __builtin_amdgcn_s_setprio(1); _Pragma("unroll") for (int m = 0; m < 4; ++m) _Pragma("unroll") for (int n = 0; n < 2; ++n) _Pragma("unroll") for (int k = 0; k < 2; ++k) \
        acc[ai][bj][m][n] = __builtin_amdgcn_mfma_f32_16x16x32_bf16(Bt[n][k], At[m][k], acc[ai][bj][m][n], 0, 0, 0); __builtin_amdgcn_s_setprio(0); } while (0)
#define PG8_WAIT_V(n) asm volatile("s_waitcnt vmcnt(" #n ")" ::: "memory")
#define PG8_WAIT_L(n) asm volatile("s_waitcnt lgkmcnt(" #n ")" ::: "memory")
#define PG8_BAR __builtin_amdgcn_s_barrier()
#define PG8_SCHED __builtin_amdgcn_sched_barrier(0)
    Unit cur, nxt; int ui = 0;
    if (!S.next(0, cur)) return;
    f32x4 acc[2][2][4][2];
#pragma unroll
    for (int a = 0; a < 2; ++a)
#pragma unroll
        for (int b = 0; b < 2; ++b)
#pragma unroll
            for (int m = 0; m < 4; ++m)
#pragma unroll
                for (int n = 0; n < 2; ++n) acc[a][b][m][n] = (f32x4){0.f, 0.f, 0.f, 0.f};
    bf16x8 At[4][2], B0[2][2], B1[2][2];
    const char* cA = cur.A; const char* cB = cur.B;
    PG8_STAGE(PG8_SB(0, 0), cB, voffB); PG8_STAGE(PG8_SB(0, 1), cB + hstepB, voffB); PG8_STAGE(PG8_SA(0, 0), cA, voffA); PG8_STAGE(PG8_SA(0, 1), cA + hstepA, voffA);
    if (wr == 1) PG8_BAR;
    PG8_WAIT_V(2); PG8_BAR;
    PG8_STAGE(PG8_SB(1, 0), cB + kstep, voffB); PG8_STAGE(PG8_SA(1, 0), cA + kstep, voffA); PG8_STAGE(PG8_SB(1, 1), cB + hstepB + kstep, voffB);
    PG8_WAIT_V(6); PG8_BAR;
    for (;;) {
        const bool has_next = S.next(ui + 1, nxt);
        const char* nA = has_next ? nxt.A : cA; const char* nB = has_next ? nxt.B : cB;
        for (int t = 0; t < nt; t += 2) {
            const bool last = (t == nt - 2);
            const char* a1 = cA + (size_t)(t + 1) * kstep;
            const char* a2 = last ? nA : cA + (size_t)(t + 2) * kstep; const char* b2 = last ? nB : cB + (size_t)(t + 2) * kstep;
            const char* a3 = a2 + kstep; const char* b3 = b2 + kstep;
            PG8_LDB(B0, 0, 0); PG8_LDB(B1, 0, 1); PG8_SCHED; PG8_LDA(At, 0, 0); PG8_STAGE(PG8_SA(1, 1), a1 + hstepA, voffA);
            PG8_WAIT_V(8); PG8_WAIT_L(0); PG8_BAR; PG8_MMA(0, 0, At, B0); PG8_MMA(0, 1, At, B1); PG8_BAR; PG8_SCHED;
            PG8_LDA(At, 0, 1); PG8_STAGE(PG8_SB(0, 0), b2, voffB); PG8_STAGE(PG8_SB(0, 1), b2 + hstepB, voffB); PG8_STAGE(PG8_SA(0, 0), a2, voffA);
            PG8_WAIT_V(8); PG8_WAIT_L(0); PG8_BAR; PG8_MMA(1, 0, At, B0); PG8_MMA(1, 1, At, B1); PG8_BAR; PG8_SCHED;
            PG8_LDB(B0, 1, 0); PG8_LDB(B1, 1, 1); PG8_SCHED; PG8_LDA(At, 1, 0); PG8_STAGE(PG8_SA(0, 1), a2 + hstepA, voffA);
            PG8_WAIT_V(8); PG8_WAIT_L(0); PG8_BAR; PG8_MMA(0, 0, At, B0); PG8_MMA(0, 1, At, B1); PG8_BAR; PG8_SCHED;
            PG8_LDA(At, 1, 1); PG8_STAGE(PG8_SB(1, 0), b3, voffB); PG8_STAGE(PG8_SB(1, 1), b3 + hstepB, voffB); PG8_STAGE(PG8_SA(1, 0), a3, voffA);
            PG8_WAIT_V(8); PG8_WAIT_L(0); PG8_BAR; PG8_MMA(1, 0, At, B0); PG8_MMA(1, 1, At, B1); PG8_BAR; PG8_SCHED;
        }
        if (wr == 0) PG8_BAR;
        E(acc, cur, wr, wc, fr, fq);
        if (!has_next) break;
#pragma unroll
        for (int a = 0; a < 2; ++a)
#pragma unroll
            for (int b = 0; b < 2; ++b)
#pragma unroll
                for (int m = 0; m < 4; ++m)
#pragma unroll
                    for (int n = 0; n < 2; ++n) acc[a][b][m][n] = (f32x4){0.f, 0.f, 0.f, 0.f};
        cur = nxt; cA = nA; cB = nB; ++ui;
        if (wr == 1) PG8_BAR;
    }
    PG8_WAIT_V(0);
    PG8_BAR;
#undef PG8_SA
#undef PG8_SB
#undef PG8_STAGE
#undef PG8_LDA
#undef PG8_LDB
#undef PG8_MMA
#undef PG8_WAIT_V
#undef PG8_WAIT_L
#undef PG8_BAR
#undef PG8_SCHED
}
}
using pg8::Unit;
using pg8::cvt_pk_bf16;

struct EpiStoreBf16 {
    static constexpr bool PERM = true;
    bf16* O; int ldc;
    __device__ __forceinline__ void operator()(const f32x4 (&acc)[2][2][4][2], const Unit& u, int wr, int wc, int fr, int fq) const {
        const int row0 = u.r0 + wr * 64 + fr, col0 = u.c0 + wc * 32 + 8 * fq;
#pragma unroll
        for (int ai = 0; ai < 2; ++ai)
#pragma unroll
            for (int m = 0; m < 4; ++m) { bf16* rowp = O + (size_t)(row0 + ai * 128 + m * 16) * ldc + col0;
#pragma unroll
                for (int bj = 0; bj < 2; ++bj) { const f32x4 v0 = acc[ai][bj][m][0], v1 = acc[ai][bj][m][1];
                    u32x4 w; w.x = cvt_pk_bf16(v0[0], v0[1]); w.y = cvt_pk_bf16(v0[2], v0[3]); w.z = cvt_pk_bf16(v1[0], v1[1]); w.w = cvt_pk_bf16(v1[2], v1[3]);
                    *(u32x4*)(rowp + bj * 128) = w; } }
    }
};
struct EpiGate {
    static constexpr bool PERM = true;
    const bf16* Hg; bf16* MG;
    __device__ __forceinline__ void operator()(const f32x4 (&acc)[2][2][4][2], const Unit& u, int wr, int wc, int fr, int fq) const {
        const int row0 = u.r0 + wr * 64 + fr, gcol0 = u.c0 + wc * 32 + 8 * fq, mcol0 = (u.c0 & 1023) + wc * 32 + 8 * fq; const bool first = u.c0 < 1024;
#pragma unroll
        for (int ai = 0; ai < 2; ++ai) {
            u32x4 gw[4][2], mw[4][2];
#pragma unroll
            for (int m = 0; m < 4; ++m)
#pragma unroll
                for (int bj = 0; bj < 2; ++bj) { gw[m][bj] = *(const u32x4*)(Hg + (size_t)(row0 + ai * 128 + m * 16) * DH + gcol0 + bj * 128);
                    mw[m][bj] = first ? (u32x4){0u, 0u, 0u, 0u} : *(const u32x4*)(MG + (size_t)(row0 + ai * 128 + m * 16) * D + mcol0 + bj * 128); }
#pragma unroll
            for (int m = 0; m < 4; ++m) { bf16* mrow = MG + (size_t)(row0 + ai * 128 + m * 16) * D + mcol0;
#pragma unroll
                for (int bj = 0; bj < 2; ++bj) { const f32x4 v0 = acc[ai][bj][m][0], v1 = acc[ai][bj][m][1];
                    float g[8], pm[8]; unpack8(gw[m][bj], g); unpack8(mw[m][bj], pm);
                    u32x4 w; w.x = cvt_pk_bf16(pm[0] + sigmoidf_(g[0]) * v0[0], pm[1] + sigmoidf_(g[1]) * v0[1]); w.y = cvt_pk_bf16(pm[2] + sigmoidf_(g[2]) * v0[2], pm[3] + sigmoidf_(g[3]) * v0[3]);
                    w.z = cvt_pk_bf16(pm[4] + sigmoidf_(g[4]) * v1[0], pm[5] + sigmoidf_(g[5]) * v1[1]); w.w = cvt_pk_bf16(pm[6] + sigmoidf_(g[6]) * v1[2], pm[7] + sigmoidf_(g[7]) * v1[3]);
                    *(u32x4*)(mrow + bj * 128) = w; } }
        }
    }
};
struct EpiRes {
    static constexpr bool PERM = true;
    const float* res32; const bf16* res16; bf16* out;
    __device__ __forceinline__ void operator()(const f32x4 (&acc)[2][2][4][2], const Unit& u, int wr, int wc, int fr, int fq) const {
        const int row0 = u.r0 + wr * 64 + fr, col0 = u.c0 + wc * 32 + 8 * fq;
#pragma unroll
        for (int ai = 0; ai < 2; ++ai) {
            float r[4][2][8];
#pragma unroll
            for (int m = 0; m < 4; ++m)
#pragma unroll
                for (int bj = 0; bj < 2; ++bj) { const size_t ro = (size_t)(row0 + ai * 128 + m * 16) * D + col0 + bj * 128;
                    if (res32) { const f32x4 a = *(const f32x4*)(res32 + ro), b = *(const f32x4*)(res32 + ro + 4); r[m][bj][0] = a[0]; r[m][bj][1] = a[1]; r[m][bj][2] = a[2]; r[m][bj][3] = a[3]; r[m][bj][4] = b[0]; r[m][bj][5] = b[1]; r[m][bj][6] = b[2]; r[m][bj][7] = b[3]; }
                    else unpack8(*(const u32x4*)(res16 + ro), r[m][bj]); }
#pragma unroll
            for (int m = 0; m < 4; ++m)
#pragma unroll
                for (int bj = 0; bj < 2; ++bj) { const size_t ro = (size_t)(row0 + ai * 128 + m * 16) * D + col0 + bj * 128; const f32x4 v0 = acc[ai][bj][m][0], v1 = acc[ai][bj][m][1];
                    u32x4 w; w.x = cvt_pk_bf16(r[m][bj][0] + v0[0], r[m][bj][1] + v0[1]); w.y = cvt_pk_bf16(r[m][bj][2] + v0[2], r[m][bj][3] + v0[3]);
                    w.z = cvt_pk_bf16(r[m][bj][4] + v1[0], r[m][bj][5] + v1[1]); w.w = cvt_pk_bf16(r[m][bj][6] + v1[2], r[m][bj][7] + v1[3]);
                    *(u32x4*)(out + ro) = w; }
        }
    }
};
struct EpiSwiglu {
    static constexpr bool PERM = true;
    bf16* O;
    __device__ __forceinline__ void operator()(const f32x4 (&acc)[2][2][4][2], const Unit& u, int wr, int wc, int fr, int fq) const {
        const int row0 = u.r0 + wr * 64 + fr, col0 = u.c0 + wc * 32 + 8 * fq;
#pragma unroll
        for (int ai = 0; ai < 2; ++ai)
#pragma unroll
            for (int m = 0; m < 4; ++m) { bf16* rowp = O + (size_t)(row0 + ai * 128 + m * 16) * DE + col0;
                const f32x4 g0 = acc[ai][0][m][0], g1 = acc[ai][0][m][1], u0 = acc[ai][1][m][0], u1 = acc[ai][1][m][1];
                u32x4 w; w.x = cvt_pk_bf16(siluf_(g0[0]) * u0[0], siluf_(g0[1]) * u0[1]); w.y = cvt_pk_bf16(siluf_(g0[2]) * u0[2], siluf_(g0[3]) * u0[3]);
                w.z = cvt_pk_bf16(siluf_(g1[0]) * u1[0], siluf_(g1[1]) * u1[1]); w.w = cvt_pk_bf16(siluf_(g1[2]) * u1[2], siluf_(g1[3]) * u1[3]);
                *(u32x4*)rowp = w; }
    }
};
struct EpiScatter {
    static constexpr bool PERM = true;
    bf16* Y; const int* row_code; const float* row_w;
    __device__ __forceinline__ void operator()(const f32x4 (&acc)[2][2][4][2], const Unit& u, int wr, int wc, int fr, int fq) const {
        const int row0 = u.r0 + wr * 64 + fr, col0 = u.c0 + wc * 32 + 8 * fq;
#pragma unroll
        for (int ai = 0; ai < 2; ++ai)
#pragma unroll
            for (int m = 0; m < 4; ++m) { const int row = row0 + ai * 128 + m * 16; const int code = row_code[row]; const float rw = row_w[row];
                if (code >= 0) { bf16* rowp = Y + (size_t)(code & 1) * ((size_t)M * D) + (size_t)(code >> 1) * D + col0;
#pragma unroll
                    for (int bj = 0; bj < 2; ++bj) { const f32x4 v0 = acc[ai][bj][m][0] * rw, v1 = acc[ai][bj][m][1] * rw;
                        u32x4 w; w.x = cvt_pk_bf16(v0[0], v0[1]); w.y = cvt_pk_bf16(v0[2], v0[3]); w.z = cvt_pk_bf16(v1[0], v1[1]); w.w = cvt_pk_bf16(v1[2], v1[3]);
                        *(u32x4*)(rowp + bj * 128) = w; } } }
    }
};

struct SchedH {
    pg8::TileOrder to; const char* A; const char* B;
    __device__ __forceinline__ bool next(int i, Unit& u) const { int pm, pn; if (!to.next(i, pm, pn)) return false;
        u.A = A + (size_t)pm * 256 * D * 2; u.B = B + (size_t)pn * 256 * D * 2; u.r0 = pm * 256; u.c0 = pn * 256; return true; }
};
struct SchedBranch {
    pg8::TileOrder to; const char* YS; const char* WBR;
    __device__ __forceinline__ bool next(int i, Unit& u) const { int pm, q; if (!to.next(i >> 2, pm, q)) return false; const int br = i & 3;
        u.A = YS + ((size_t)pm * 256 * 2048 + br * 512) * 2; u.B = WBR + ((size_t)br * D * 512 + (size_t)q * 256 * 512) * 2; u.r0 = pm * 256; u.c0 = br * 1024 + q * 256; return true; }
};
struct SchedOut {
    pg8::TileOrder to; const char* A; const char* B;
    __device__ __forceinline__ bool next(int i, Unit& u) const { int pm, pn; if (!to.next(i, pm, pn)) return false;
        u.A = A + (size_t)pm * 256 * D * 2; u.B = B + (size_t)pn * 256 * D * 2; u.r0 = pm * 256; u.c0 = pn * 256; return true; }
};
struct SchedMoe {
    int nux, nrank, rank, nk, x, NX; const LAS int* cum; const LAS int* rb0; const char* A; size_t a_blk; const char* W; size_t w_e, w_pn; int cmul;
    __device__ __forceinline__ bool next(int i, Unit& u) const { const int ui = i * nrank + rank; if (ui >= nux) return false;
        int k = 0; while (k + 1 < nk && cum[k + 1] <= ui) ++k;
        const int local = ui - cum[k], rb = rb0[k] + (local >> 2), pn = local & 3, e = x + NX * k;
        u.A = A + (size_t)rb * a_blk; u.B = W + (size_t)e * w_e + (size_t)pn * w_pn; u.r0 = rb * 256; u.c0 = pn * cmul; return true; }
};

struct Params { const float* in[25]; float* out; unsigned char* ws; int ph_lo, ph_hi; };
enum { I_X = 0, I_MIXNW, I_WIN, I_GCONV, I_GALOG, I_GDT, I_GNW, I_CCW, I_CCB, I_CLNW, I_CLNB, I_GLNW, I_GLNB, I_GWS, I_GBS, I_SCW, I_WBR, I_WOUT, I_MOENW, I_RGRP, I_REXP, I_WG, I_WU, I_WD, I_FNW };
constexpr int PH_PER_LAYER = 12, PH_FINAL = 24, PH_TOTAL = 25;

__device__ __forceinline__ void transpose_item(const float* __restrict__ W, int ldw, int srccol, bf16* __restrict__ WT, int ldt, int k0, int n0, int lane) {
    const int kq = lane & 7, nq = lane >> 3;
    f32x4 v[8][2];
#pragma unroll
    for (int r = 0; r < 8; ++r) { const float* s = W + (size_t)(k0 + 8 * kq + r) * ldw + srccol + 8 * nq; v[r][0] = *(const f32x4*)s; v[r][1] = *(const f32x4*)(s + 4); }
#pragma unroll
    for (int e = 0; e < 8; ++e) { u32x4 o; o.x = pk2(v[0][e >> 2][e & 3], v[1][e >> 2][e & 3]); o.y = pk2(v[2][e >> 2][e & 3], v[3][e >> 2][e & 3]); o.z = pk2(v[4][e >> 2][e & 3], v[5][e >> 2][e & 3]); o.w = pk2(v[6][e >> 2][e & 3], v[7][e >> 2][e & 3]);
        *(u32x4*)(WT + (size_t)(n0 + 8 * nq + e) * ldt + k0 + 8 * kq) = o; }
}
__device__ __forceinline__ void prep_static_weights(const Params& p, int gw, int NGW, int lane) {
    constexpr int I_IN = 16 * (DH / 64), I_BR = 8 * 16, I_OUT = 16 * 16, PER_L = I_IN + 4 * I_BR + I_OUT;
    for (int it = gw; it < NLAYER * PER_L; it += NGW) {
        const int l = it / PER_L; int r = it % PER_L;
        if (r < I_IN) { const int kb = r / (DH / 64), nb = r % (DH / 64), n0 = nb * 64;
            transpose_item(p.in[I_WIN] + (size_t)l * D * DIN, DIN, n0 + (n0 >= 2048 ? 8 : 0), (bf16*)(p.ws + WS_WIN + l * WIN_L), D, kb * 64, n0, lane); continue; }
        r -= I_IN;
        if (r < 4 * I_BR) { const int br = r / I_BR, q = r % I_BR, kb = q / 16, nb = q % 16;
            transpose_item(p.in[I_WBR] + ((size_t)l * 4 + br) * 512 * D, D, nb * 64, (bf16*)(p.ws + WS_WBR + l * WBR_L) + (size_t)br * D * 512, 512, kb * 64, nb * 64, lane); continue; }
        r -= 4 * I_BR;
        { const int kb = r / 16, nb = r % 16;
            transpose_item(p.in[I_WOUT] + (size_t)l * D * D, D, nb * 64, (bf16*)(p.ws + WS_WOUT + l * WOUT_L), D, kb * 64, nb * 64, lane); }
    }
}
__device__ __forceinline__ void prep_moe_weights(const Params& p, int layer, int gw, int NGW, int lane) {
    constexpr int I_GU = 16 * 16, I_D = 8 * 16, PER_E = I_GU + I_D;
    for (int it = gw; it < NE * PER_E; it += NGW) {
        const int e = it / PER_E; int r = it % PER_E;
        if (r < I_GU) { const int kb = r / 16, nb = r % 16, n0 = nb * 64, pn = n0 >> 8, half = (n0 >> 7) & 1, j0 = n0 & 127;
            const float* src = p.in[half ? I_WU : I_WG] + ((size_t)layer * NE + e) * D * DE;
            transpose_item(src, DE, 128 * pn + j0, (bf16*)(p.ws + WS_MOEW + e * WGU_E), D, kb * 64, n0, lane); continue; }
        r -= I_GU;
        { const int kb = r / 16, nb = r % 16;
            transpose_item(p.in[I_WD] + ((size_t)layer * NE + e) * DE * D, D, nb * 64, (bf16*)(p.ws + WS_WD + e * WD_E), DE, kb * 64, nb * 64, lane); }
    }
}

template <int MODE>
__device__ __forceinline__ void norm_phase(const Params& p, int layer, LAS unsigned char* lds, int gw, int NGW, int tid, int lane) {
    const float* nwp = (MODE == 2) ? p.in[I_FNW] : p.in[I_MIXNW] + layer * D;
    f32x4 nw[4];
#pragma unroll
    for (int j = 0; j < 4; ++j) nw[j] = *(const f32x4*)(nwp + 4 * lane + 256 * j);
    f32x4 ws0[16], ws1[16];
    if (MODE != 2) { const float* wi = p.in[I_WIN] + (size_t)layer * D * DIN + 2048;
#pragma unroll
        for (int j = 0; j < 4; ++j)
#pragma unroll
            for (int c = 0; c < 4; ++c) { const float* wr = wi + (size_t)(4 * lane + 256 * j + c) * DIN; ws0[j * 4 + c] = *(const f32x4*)wr; ws1[j * 4 + c] = *(const f32x4*)(wr + 4); } }
    const bf16* Y0 = (const bf16*)(p.ws + WS_Y); const bf16* Y1 = Y0 + (size_t)M * D;
    bf16* XN = (bf16*)(p.ws + WS_XN); float* SMALL = (float*)(p.ws + WS_SMALL);
    const float* xbase = p.in[I_X]; const bf16* xb16 = (const bf16*)(p.ws + WS_X1B); bf16* x2b = (bf16*)p.out;
    f32x4 vn[4]; u32x2 an[4], bn[4], xn16[4];
#define NP_LOAD(mm) do { _Pragma("unroll") for (int j = 0; j < 4; ++j) { \
        if (MODE == 0) vn[j] = *(const f32x4*)(xbase + (size_t)(mm) * D + 4 * lane + 256 * j); \
        else { xn16[j] = *(const u32x2*)(xb16 + (size_t)(mm) * D + 4 * lane + 256 * j); an[j] = *(const u32x2*)(Y0 + (size_t)(mm) * D + 4 * lane + 256 * j); bn[j] = *(const u32x2*)(Y1 + (size_t)(mm) * D + 4 * lane + 256 * j); } } } while (0)
    if (gw < M) NP_LOAD(gw);
    for (int m = gw; m < M; m += NGW) {
        f32x4 v[4]; float ss = 0.f;
#pragma unroll
        for (int j = 0; j < 4; ++j) {
            if (MODE == 0) v[j] = vn[j];
            else { v[j][0] = bf_lo(xn16[j].x) + bf_lo(an[j].x) + bf_lo(bn[j].x); v[j][1] = bf_hi(xn16[j].x) + bf_hi(an[j].x) + bf_hi(bn[j].x); v[j][2] = bf_lo(xn16[j].y) + bf_lo(an[j].y) + bf_lo(bn[j].y); v[j][3] = bf_hi(xn16[j].y) + bf_hi(an[j].y) + bf_hi(bn[j].y); } }
        if (m + NGW < M) NP_LOAD(m + NGW);
#pragma unroll
        for (int j = 0; j < 4; ++j) ss += (v[j][0] * v[j][0] + v[j][1] * v[j][1]) + (v[j][2] * v[j][2] + v[j][3] * v[j][3]);
        const float rs = __builtin_amdgcn_rsqf(wave_sum(ss) * (1.0f / D) + EPS);
        if (MODE == 2) {
#pragma unroll
            for (int j = 0; j < 4; ++j) *(f32x4*)(p.out + (size_t)m * D + 4 * lane + 256 * j) = v[j] * rs * nw[j];
            continue;
        }
        if (MODE == 1) {
#pragma unroll
            for (int j = 0; j < 4; ++j) { u32x2 o; o.x = pk2(v[j][0], v[j][1]); o.y = pk2(v[j][2], v[j][3]); *(u32x2*)(x2b + (size_t)m * D + 4 * lane + 256 * j) = o; }
        }
        f32x4 s0 = (f32x4){0.f, 0.f, 0.f, 0.f}, s1 = s0;
#pragma unroll
        for (int j = 0; j < 4; ++j) { v[j] = v[j] * rs * nw[j];
            u32x2 o; o.x = pk2(v[j][0], v[j][1]); o.y = pk2(v[j][2], v[j][3]); *(u32x2*)(XN + (size_t)m * D + 4 * lane + 256 * j) = o;
#pragma unroll
            for (int c = 0; c < 4; ++c) { s0 += ws0[j * 4 + c] * v[j][c]; s1 += ws1[j * 4 + c] * v[j][c]; } }
        const bool b0 = lane & 1, b1 = lane & 2, b2 = lane & 4;
        f32x4 a;
#pragma unroll
        for (int i = 0; i < 4; ++i) { const float send = b0 ? s0[i] : s1[i]; const float recv = __shfl_xor(send, 1); a[i] = (b0 ? s1[i] : s0[i]) + recv; }
        float bb[2];
#pragma unroll
        for (int i = 0; i < 2; ++i) { const float send = b1 ? a[i] : a[2 + i]; const float recv = __shfl_xor(send, 2); bb[i] = (b1 ? a[2 + i] : a[i]) + recv; }
        float cc; { const float send = b2 ? bb[0] : bb[1]; const float recv = __shfl_xor(send, 4); cc = (b2 ? bb[1] : bb[0]) + recv; }
        cc += __shfl_xor(cc, 8); cc += __shfl_xor(cc, 16); cc += __shfl_xor(cc, 32);
        if (lane < 8) SMALL[(size_t)m * 8 + ((lane >> 2) & 1) + 2 * ((lane >> 1) & 1) + 4 * (lane & 1)] = cc;
    }
#undef NP_LOAD
    __syncthreads();
}

__device__ __forceinline__ void shortconv_unit(const Params& p, int layer, int tid, int unit) {
    const bf16* H = (const bf16*)(p.ws + WS_H); bf16* YS = (bf16*)(p.ws + WS_YS);
    const float* cw = p.in[I_SCW] + (size_t)layer * 3 * 512;
#pragma unroll 2
    for (int k = 0; k < 16; ++k) { const int it = unit * 8192 + k * 512 + tid;
        const int m = it >> 6, c8 = (it & 63) * 8, t = m & (T - 1);
        u32x4 rc[3], rx[3];
#pragma unroll
        for (int j = 0; j < 3; ++j) { const bool ok = (t - 2 + j >= 0); const bf16* r = H + (size_t)(ok ? m - 2 + j : m) * DH + HSC + c8; rc[j] = *(const u32x4*)(r + 512); rx[j] = *(const u32x4*)(r + 1024); if (!ok) rc[j] = (u32x4){0u, 0u, 0u, 0u}; }
        const u32x4 rb = *(const u32x4*)(H + (size_t)m * DH + HSC + c8);
        float acc[8];
#pragma unroll
        for (int i = 0; i < 8; ++i) acc[i] = 0.f;
#pragma unroll
        for (int j = 0; j < 3; ++j) { float cg[8], xv[8]; unpack8(rc[j], cg); unpack8(rx[j], xv);
#pragma unroll
            for (int i = 0; i < 8; ++i) acc[i] += cw[j * 512 + c8 + i] * (cg[i] * xv[i]); }
        float bg[8]; unpack8(rb, bg);
#pragma unroll
        for (int i = 0; i < 8; ++i) acc[i] *= bg[i];
        *(u32x4*)(YS + (size_t)m * 2048 + 1536 + c8) = pack8(acc);
    }
}
__device__ __forceinline__ int queue_pop(unsigned* counter, LAS unsigned char* lds, int tid) {
    LAS int* slot = (LAS int*)(lds + LDSCTL_OFF + LC_MISC);
    __syncthreads();
    if (tid == 0) slot[0] = (int)__hip_atomic_fetch_add(counter, 1u, __ATOMIC_RELAXED, __HIP_MEMORY_SCOPE_AGENT);
    __syncthreads();
    return slot[0];
}
__device__ __forceinline__ void conformer(const Params& p, int layer, LAS unsigned char* lds, int tid, int wave, int lane, unsigned* counter) {
    const bf16* H = (const bf16*)(p.ws + WS_H); bf16* YS = (bf16*)(p.ws + WS_YS);
    LAS bf16* yt = (LAS bf16*)lds;
    LAS float* zt = (LAS float*)(lds + 98304);
    const float* cwp = p.in[I_CCW] + (size_t)layer * 31 * 512;
    float cw[31];
#pragma unroll
    for (int j = 0; j < 31; ++j) cw[j] = cwp[j * 512 + tid];
    const float cb = p.in[I_CCB][layer * 512 + tid];
    float lw[8], lb[8];
#pragma unroll
    for (int i = 0; i < 8; ++i) { lw[i] = p.in[I_CLNW][layer * 512 + lane * 8 + i]; lb[i] = p.in[I_CLNB][layer * 512 + lane * 8 + i]; }
    for (;;) {
        const int unit = queue_pop(counter, lds, tid); if (unit >= M / 64) break;
        const int m0 = unit * 64, t0 = m0 & (T - 1);
        for (int base = 0; base < 94 * 64; base += 512 * 4) {
            u32x4 ra[4], rg[4];
#pragma unroll
            for (int k = 0; k < 4; ++k) { const int it = base + k * 512 + tid; const int r = it >> 6, c8 = (it & 63) * 8, dt = r - 30; const bool ok = (it < 94 * 64) && (t0 + dt >= 0);
                const bf16* s = H + (size_t)(ok ? m0 + dt : m0) * DH + HCONF + c8; ra[k] = *(const u32x4*)s; rg[k] = *(const u32x4*)(s + 512); }
#pragma unroll
            for (int k = 0; k < 4; ++k) { const int it = base + k * 512 + tid; const int r = it >> 6, c8 = (it & 63) * 8, dt = r - 30;
                if (it < 94 * 64) { u32x4 o = (u32x4){0u, 0u, 0u, 0u};
                    if (t0 + dt >= 0) { float a[8], g[8]; unpack8(ra[k], a); unpack8(rg[k], g);
#pragma unroll
                        for (int i = 0; i < 8; ++i) a[i] *= sigmoidf_(g[i]);
                        o = pack8(a); }
                    *(LAS u32x4*)(yt + r * 512 + c8) = o; } }
        }
        __syncthreads();
        for (int sb = 0; sb < 8; ++sb) {
            LAS float* zb = zt + (sb & 1) * 4096;
            float z[8];
#pragma unroll
            for (int i = 0; i < 8; ++i) z[i] = cb;
#pragma unroll
            for (int r = 0; r < 38; ++r) { const float yv = bf2f(yt[(sb * 8 + r) * 512 + tid]);
#pragma unroll
                for (int i = 0; i < 8; ++i) { const int j = r - i; if (j >= 0 && j < 31) z[i] += cw[j] * yv; } }
#pragma unroll
            for (int i = 0; i < 8; ++i) zb[i * 512 + tid] = z[i];
            __syncthreads();
            { const LAS float* zr = zb + wave * 512 + lane * 8; float v[8]; const f32x4 a = *(const LAS f32x4*)zr, b = *(const LAS f32x4*)(zr + 4);
                v[0] = a[0]; v[1] = a[1]; v[2] = a[2]; v[3] = a[3]; v[4] = b[0]; v[5] = b[1]; v[6] = b[2]; v[7] = b[3];
                float s = 0.f;
#pragma unroll
                for (int i = 0; i < 8; ++i) s += v[i];
                const float mean = wave_sum(s) * (1.0f / 512.0f); float q = 0.f;
#pragma unroll
                for (int i = 0; i < 8; ++i) { v[i] -= mean; q += v[i] * v[i]; }
                const float rstd = __builtin_amdgcn_rsqf(wave_sum(q) * (1.0f / 512.0f) + EPS);
#pragma unroll
                for (int i = 0; i < 8; ++i) v[i] = siluf_(v[i] * rstd * lw[i] + lb[i]);
                *(u32x4*)(YS + (size_t)(m0 + sb * 8 + wave) * 2048 + 512 + lane * 8) = pack8(v); }
        }
    }
}
__device__ __forceinline__ f32x4 mfma16(bf16x8 a, bf16x8 b, f32x4 c) { return __builtin_amdgcn_mfma_f32_16x16x32_bf16(a, b, c, 0, 0, 0); }
typedef short bf16x4 __attribute__((ext_vector_type(4)));
__device__ __forceinline__ bf16x8 ld_frag16(const LAS unsigned char* p) { return *(const LAS bf16x8*)p; }
__device__ __forceinline__ bf16x8 ld_frag8x2(const LAS unsigned char* p) { const bf16x4 a = *(const LAS bf16x4*)p, b = *(const LAS bf16x4*)(p + 32); return __builtin_shufflevector(a, b, 0, 1, 2, 3, 4, 5, 6, 7); }
__device__ __forceinline__ bf16x8 pack_frag(const f32x4 lo, const f32x4 hi) { u32x4 w; w.x = cvt_pk_bf16(lo[0], lo[1]); w.y = cvt_pk_bf16(lo[2], lo[3]); w.z = cvt_pk_bf16(hi[0], hi[1]); w.w = cvt_pk_bf16(hi[2], hi[3]); return __builtin_bit_cast(bf16x8, w); }
constexpr int GM_W = 0, GM_VT = 34816, GM_ST = 69632;
__device__ __forceinline__ void gmlp(const Params& p, int layer, LAS unsigned char* lds, int tid, int wave, int lane, unsigned* counter) {
    const bf16* H = (const bf16*)(p.ws + WS_H); bf16* YS = (bf16*)(p.ws + WS_YS);
    LAS float* st = (LAS float*)(lds + GM_ST);
    const float* lnw = p.in[I_GLNW] + layer * 512; const float* lnb = p.in[I_GLNB] + layer * 512;
    const int q = lane >> 4, li = lane & 15;
    for (;;) {
        const int unit = queue_pop(counter, lds, tid); if (unit >= M / 128) break;
        const int m0 = unit * 128;
        u32x4 rv[16];
#pragma unroll
        for (int k = 0; k < 16; ++k) rv[k] = *(const u32x4*)(H + (size_t)(m0 + wave * 16 + k) * DH + HGMLP + 512 + lane * 8);
#pragma unroll
        for (int k = 0; k < 16; ++k) { const int tk = wave * 16 + k;
            float v[8]; unpack8(rv[k], v);
            float s = 0.f;
#pragma unroll
            for (int i = 0; i < 8; ++i) { v[i] = gelu_tanh(v[i]); s += v[i]; }
            const float mean = wave_sum(s) * (1.0f / 512.0f); float qq = 0.f;
#pragma unroll
            for (int i = 0; i < 8; ++i) { const float d = v[i] - mean; qq += d * d; }
            const float rstd = 1.0f / sqrtf(wave_sum(qq) * (1.0f / 512.0f) + EPS);
            if (lane == 0) { st[tk * 2] = mean; st[tk * 2 + 1] = rstd; }
        }
        __syncthreads();
        for (int g = 0; g < 4; ++g) {
            u32x4 rg[4];
#pragma unroll
            for (int k = 0; k < 4; ++k) { const int it = tid + 512 * k; rg[k] = *(const u32x4*)(H + (size_t)(m0 + (it >> 4)) * DH + HGMLP + 512 + g * 128 + (it & 15) * 8); }
#pragma unroll
            for (int k = 0; k < 4; ++k) { const int it = tid + 512 * k; const int tk = it >> 4, c8 = (it & 15) * 8;
                float v[8]; unpack8(rg[k], v);
                const float mean = st[tk * 2], rstd = st[tk * 2 + 1];
#pragma unroll
                for (int i = 0; i < 8; ++i) *(LAS bf16*)(lds + GM_VT + (c8 + i) * 272 + 2 * tk) = (bf16)f2bf((gelu_tanh(v[i]) - mean) * rstd * lnw[g * 128 + c8 + i] + lnb[g * 128 + c8 + i]); }
            const float* ws = p.in[I_GWS] + ((size_t)layer * 4 + g) * 128 * 128;
            f32x4 wa[4], wb[4];
#pragma unroll
            for (int k = 0; k < 4; ++k) { const int it = tid + 512 * k; wa[k] = *(const f32x4*)(ws + (it >> 4) * 128 + (it & 15) * 8); wb[k] = *(const f32x4*)(ws + (it >> 4) * 128 + (it & 15) * 8 + 4); }
#pragma unroll
            for (int k = 0; k < 4; ++k) { const int it = tid + 512 * k; const int i = it >> 4, j8 = (it & 15) * 8;
                const f32x4 a = wa[k], b = wb[k];
                float w[8] = {a[0], a[1], a[2], a[3], b[0], b[1], b[2], b[3]};
#pragma unroll
                for (int e = 0; e < 8; ++e) w[e] = (j8 + e <= i) ? w[e] : 0.f;
                *(LAS u32x4*)(lds + GM_W + i * 272 + j8 * 2) = pack8(w); }
            __syncthreads();
            {
                f32x4 acc[8];
#pragma unroll
                for (int ct = 0; ct < 8; ++ct) acc[ct] = (f32x4){0.f, 0.f, 0.f, 0.f};
                const int nks = (wave >> 1) + 1;
                for (int ks = 0; ks < nks; ++ks) { const bf16x8 wf = ld_frag16(lds + GM_W + (16 * wave + li) * 272 + (32 * ks + 8 * q) * 2);
#pragma unroll
                    for (int ct = 0; ct < 8; ++ct) acc[ct] = mfma16(ld_frag16(lds + GM_VT + (16 * ct + li) * 272 + (32 * ks + 8 * q) * 2), wf, acc[ct]); }
                const int i = 16 * wave + li; const float bs = p.in[I_GBS][((size_t)layer * 4 + g) * 128 + i];
                const bf16* urow = H + (size_t)(m0 + i) * DH + HGMLP + g * 128 + 4 * q; bf16* orow = YS + (size_t)(m0 + i) * 2048 + 1024 + g * 128 + 4 * q;
#pragma unroll
                for (int ct = 0; ct < 8; ++ct) { const u32x2 uw = *(const u32x2*)(urow + 16 * ct);
                    const float o0 = gelu_tanh(bf_lo(uw.x)) * (acc[ct][0] + bs), o1 = gelu_tanh(bf_hi(uw.x)) * (acc[ct][1] + bs), o2 = gelu_tanh(bf_lo(uw.y)) * (acc[ct][2] + bs), o3 = gelu_tanh(bf_hi(uw.y)) * (acc[ct][3] + bs);
                    u32x2 ow; ow.x = pk2(o0, o1); ow.y = pk2(o2, o3); *(u32x2*)(orow + 16 * ct) = ow; }
            }
            __syncthreads();
        }
    }
}
constexpr int CP_QN = 0, CP_KN = 17408, CP_KT = 34816, CP_VT = 53248, CP_KGT = 71680, CP_A32 = 90112, CP_ATT = 106496, CP_T16 = 115712, CP_TAB = 124928;
__device__ __forceinline__ void gdn_chunk_prep(const Params& p, int layer, LAS unsigned char* lds, int tid, int wave, int lane) {
    const bf16* H = (const bf16*)(p.ws + WS_H); const float* SMALL = (const float*)(p.ws + WS_SMALL);
    const float* cw = p.in[I_GCONV] + (size_t)layer * 4 * 1536;
    LAS float* tab = (LAS float*)(lds + CP_TAB);
    const int q = lane >> 4, li = lane & 15;
    for (int unit = blockIdx.x; unit < 2048; unit += gridDim.x) {
        const int n = unit & 63, hh = (unit >> 6) & 3, b = unit >> 8; const int m0 = b * T + n * 64;
        unsigned char* rec = p.ws + WS_REC + (size_t)((b * 4 + hh) * 64 + n) * REC_BYTES;
        const int i0 = wave * 8, t0 = n * 64 + i0;
        unsigned raw[3][11];
#pragma unroll
        for (int s = 0; s < 3; ++s)
#pragma unroll
            for (int r = 0; r < 11; ++r) raw[s][r] = (t0 - 3 + r >= 0) ? *(const unsigned*)(H + (size_t)(m0 + i0 - 3 + r) * DH + s * 512 + hh * 128 + 2 * lane) : 0u;
        float w0[3][4], w1[3][4];
#pragma unroll
        for (int s = 0; s < 3; ++s)
#pragma unroll
            for (int j = 0; j < 4; ++j) { const f32x2 ww = *(const f32x2*)(cw + j * 1536 + s * 512 + hh * 128 + 2 * lane); w0[s][j] = ww[0]; w1[s][j] = ww[1]; }
        __syncthreads();
        if (wave == 0) { const int m = m0 + lane; const float br = SMALL[(size_t)m * 8 + hh], ar = SMALL[(size_t)m * 8 + 4 + hh];
            float g = -__expf(p.in[I_GALOG][layer * 4 + hh]) * softplusf_(ar + p.in[I_GDT][layer * 4 + hh]);
#pragma unroll
            for (int o = 1; o < 64; o <<= 1) { const float t = __shfl_up(g, o); if (lane >= o) g += t; }
            tab[lane] = sigmoidf_(br); tab[64 + lane] = g; tab[128 + lane] = __expf(g); }
        __syncthreads();
        {
#pragma unroll
            for (int ii = 0; ii < 8; ++ii) { const int i = i0 + ii;
                float y[3][2];
#pragma unroll
                for (int s = 0; s < 3; ++s) { float a0 = 0.f, a1 = 0.f;
#pragma unroll
                    for (int j = 0; j < 4; ++j) { a0 += w0[s][j] * bf_lo(raw[s][ii + j]); a1 += w1[s][j] * bf_hi(raw[s][ii + j]); }
                    y[s][0] = siluf_(a0); y[s][1] = siluf_(a1); }
                const float sq = wave_sum(y[0][0] * y[0][0] + y[0][1] * y[0][1]), sk = wave_sum(y[1][0] * y[1][0] + y[1][1] * y[1][1]);
                const float rq = 0.08838834764831845f * __builtin_amdgcn_rsqf(sq + EPS), rk = __builtin_amdgcn_rsqf(sk + EPS);
                const float be = tab[i], bg = be * tab[128 + i];
                const float k0 = y[1][0] * rk, k1 = y[1][1] * rk;
                *(LAS unsigned*)(lds + CP_QN + i * 272 + 4 * lane) = pk2(y[0][0] * rq, y[0][1] * rq);
                *(LAS unsigned*)(lds + CP_KN + i * 272 + 4 * lane) = pk2(k0, k1);
                *(LAS bf16*)(lds + CP_KT + (2 * lane) * 144 + 2 * i) = (bf16)f2bf(k0); *(LAS bf16*)(lds + CP_KT + (2 * lane + 1) * 144 + 2 * i) = (bf16)f2bf(k1);
                *(LAS bf16*)(lds + CP_VT + (2 * lane) * 144 + 2 * i) = (bf16)f2bf(be * y[2][0]); *(LAS bf16*)(lds + CP_VT + (2 * lane + 1) * 144 + 2 * i) = (bf16)f2bf(be * y[2][1]);
                *(LAS bf16*)(lds + CP_KGT + (2 * lane) * 144 + 2 * i) = (bf16)f2bf(bg * k0); *(LAS bf16*)(lds + CP_KGT + (2 * lane + 1) * 144 + 2 * i) = (bf16)f2bf(bg * k1);
            }
        }
        __syncthreads();
        for (int jb = wave; jb < 32; jb += 8) { const int which = jb >> 4, mt = (jb >> 2) & 3, nt = jb & 3;
            f32x4 acc = (f32x4){0.f, 0.f, 0.f, 0.f};
            if (nt <= mt) {
#pragma unroll
                for (int ks = 0; ks < 4; ++ks) acc = mfma16(ld_frag16(lds + (which ? CP_QN : CP_KN) + (16 * mt + li) * 272 + (32 * ks + 8 * q) * 2), ld_frag16(lds + CP_KN + (16 * nt + li) * 272 + (32 * ks + 8 * q) * 2), acc);
            }
            const int j = 16 * nt + li; const float gj = tab[64 + j];
#pragma unroll
            for (int r = 0; r < 4; ++r) { const int i = 16 * mt + 4 * q + r; const float gi = tab[64 + i];
                if (which == 0) { ((LAS float*)(lds + CP_A32))[i * 64 + j] = (i > j) ? tab[i] * acc[r] * __expf(gi - gj) : 0.f; }
                else { *(LAS bf16*)(lds + CP_ATT + i * 144 + 2 * j) = (bf16)f2bf((i >= j) ? acc[r] * __expf(gi - gj) : 0.f); } }
        }
        __syncthreads();
        if (wave == 0) {
            float Tc[64]; const float lanef = (float)lane;
            const LAS float* A = (const LAS float*)(lds + CP_A32); asm volatile("" : "+v"(A));
            LAS unsigned char* Tw = lds + CP_T16 + 2 * lane; asm volatile("" : "+v"(Tw));
#pragma unroll
            for (int i = 0; i < 64; ++i) { float a4[4] = {fmaxf(0.f, 1.f - fabsf((float)i - lanef)), 0.f, 0.f, 0.f};
#pragma unroll
                for (int j = 0; j < i; j += 4) { const f32x4 av = *(const LAS f32x4*)(A + i * 64 + j);
#pragma unroll
                    for (int jj = 0; jj < 4; ++jj) if (j + jj < i) a4[jj] -= av[jj] * Tc[j + jj]; }
                const float a = (a4[0] + a4[1]) + (a4[2] + a4[3]);
                Tc[i] = a; *(LAS bf16*)(Tw + i * 144) = (bf16)f2bf(a); }
        } else {
            const int t2 = tid - 64;
            for (int pc = t2; pc < 1024; pc += 448) { const int row = pc >> 4, seg = pc & 15; *(u32x4*)(rec + REC_Q + pc * 16) = *(const LAS u32x4*)(lds + CP_QN + row * 272 + seg * 16); }
            for (int pc = t2; pc < 512; pc += 448) { const int row = pc >> 3, seg = pc & 7; *(u32x4*)(rec + REC_ATT + pc * 16) = *(const LAS u32x4*)(lds + CP_ATT + row * 144 + seg * 16); }
            for (int pc = t2; pc < 1024; pc += 448) { const int row = pc >> 3, seg = pc & 7; *(u32x4*)(rec + REC_KT + pc * 16) = *(const LAS u32x4*)(lds + CP_KT + row * 144 + seg * 16); }
            if (t2 < 16) *(u32x4*)(rec + REC_G + t2 * 16) = *(const LAS u32x4*)(lds + CP_TAB + 256 + t2 * 16);
        }
        __syncthreads();
        for (int jb = wave; jb < 64; jb += 8) {
            f32x4 acc = (f32x4){0.f, 0.f, 0.f, 0.f};
            if (jb < 32) { const int mt = jb >> 3, nt = jb & 7;
#pragma unroll
                for (int ks = 0; ks < 2; ++ks) acc = mfma16(ld_frag16(lds + CP_T16 + (16 * mt + li) * 144 + (32 * ks + 8 * q) * 2), ld_frag16(lds + CP_VT + (16 * nt + li) * 144 + (32 * ks + 8 * q) * 2), acc);
                u32x2 o; o.x = pk2(acc[0], acc[1]); o.y = pk2(acc[2], acc[3]);
                *(u32x2*)(rec + REC_U + (size_t)((nt * 64 + lane) * 4 + mt) * 8) = o;
            } else { const int mt = (jb - 32) >> 2, nt = (jb - 32) & 3;
#pragma unroll
                for (int ks = 0; ks < 2; ++ks) acc = mfma16(ld_frag16(lds + CP_KGT + (16 * mt + li) * 144 + (32 * ks + 8 * q) * 2), ld_frag16(lds + CP_T16 + (16 * nt + li) * 144 + (32 * ks + 8 * q) * 2), acc);
                u32x2 o; o.x = pk2(acc[0], acc[1]); o.y = pk2(acc[2], acc[3]);
                *(u32x2*)(rec + REC_W + (size_t)((16 * nt + li) * 128 + 16 * mt + 4 * q) * 2) = o;
            }
        }
    }
    __syncthreads();
}
constexpr int SC_W = 0, SC_KT = 17408, SC_G = 35840, SC_BUF = 36096;
__device__ __forceinline__ void gdn_chunk_scan(const Params& p, LAS unsigned char* lds, int tid, int wave, int lane, int bh, int half) {
    const int q = lane >> 4, li = lane & 15, sl = half * 4 + (wave & 3);
    unsigned char* rec0 = p.ws + WS_REC + (size_t)(bh * 64) * REC_BYTES;
    u32x4* S0F = (u32x4*)(p.ws + WS_OBUF) + (size_t)(bh * 64) * 8 * 4 * 64;
    u32x4 pf[4], pfg = (u32x4){0u, 0u, 0u, 0u}, pu[2];
#define SC_LOAD(nn) do { const unsigned char* r_ = rec0 + (size_t)(nn) * REC_BYTES; \
        pf[0] = *(const u32x4*)(r_ + REC_W + (size_t)tid * 16); pf[1] = *(const u32x4*)(r_ + REC_W + (size_t)(tid + 512) * 16); \
        pf[2] = *(const u32x4*)(r_ + REC_KT + (size_t)tid * 16); pf[3] = *(const u32x4*)(r_ + REC_KT + (size_t)(tid + 512) * 16); \
        if (tid < 16) pfg = *(const u32x4*)(r_ + REC_G + tid * 16); \
        pu[0] = *(const u32x4*)(r_ + REC_U + (size_t)(sl * 64 + lane) * 32); pu[1] = *(const u32x4*)(r_ + REC_U + (size_t)(sl * 64 + lane) * 32 + 16); } while (0)
#define SC_STORE(buf) do { LAS unsigned char* d_ = lds + (buf) * SC_BUF; \
        _Pragma("unroll") for (int k_ = 0; k_ < 2; ++k_) { const int pc_ = tid + 512 * k_; *(LAS u32x4*)(d_ + SC_W + (pc_ >> 4) * 272 + (pc_ & 15) * 16) = pf[k_]; \
            *(LAS u32x4*)(d_ + SC_KT + (pc_ >> 3) * 144 + (pc_ & 7) * 16) = pf[2 + k_]; } \
        if (tid < 16) *(LAS u32x4*)(d_ + SC_G + tid * 16) = pfg; } while (0)
    f32x4 S[8];
#pragma unroll
    for (int i = 0; i < 8; ++i) S[i] = (f32x4){0.f, 0.f, 0.f, 0.f};
    __syncthreads();
    SC_LOAD(0); SC_STORE(0);
    u32x4 cu[2]; cu[0] = pu[0]; cu[1] = pu[1];
    __syncthreads();
    for (int n = 0; n < 64; ++n) {
        const LAS unsigned char* L = lds + (n & 1) * SC_BUF;
        if (n + 1 < 64) SC_LOAD(n + 1);
        if (wave < 4) {
            bf16x8 Sb[4];
#pragma unroll
            for (int ks = 0; ks < 4; ++ks) { Sb[ks] = pack_frag(S[2 * ks], S[2 * ks + 1]); S0F[(size_t)((n * 8 + sl) * 4 + ks) * 64 + lane] = __builtin_bit_cast(u32x4, Sb[ks]); }
            f32x4 a1[4];
#pragma unroll
            for (int mt = 0; mt < 4; ++mt) { a1[mt] = (f32x4){0.f, 0.f, 0.f, 0.f};
#pragma unroll
                for (int ks = 0; ks < 4; ++ks) a1[mt] = mfma16(ld_frag8x2(L + SC_W + (16 * mt + li) * 272 + (32 * ks + 4 * q) * 2), Sb[ks], a1[mt]); }
            const float g63 = *(const LAS float*)(L + SC_G + 63 * 4);
            f32x4 vn[4], vd[4];
#pragma unroll
            for (int mt = 0; mt < 4; ++mt) { const f32x4 gi = *(const LAS f32x4*)(L + SC_G + (16 * mt + 4 * q) * 4);
                const unsigned ulo = (mt < 2) ? (mt == 0 ? cu[0].x : cu[0].z) : (mt == 2 ? cu[1].x : cu[1].z), uhi = (mt < 2) ? (mt == 0 ? cu[0].y : cu[0].w) : (mt == 2 ? cu[1].y : cu[1].w);
                const f32x4 uu = (f32x4){bf_lo(ulo), bf_hi(ulo), bf_lo(uhi), bf_hi(uhi)};
                vn[mt] = uu - a1[mt];
#pragma unroll
                for (int r = 0; r < 4; ++r) vd[mt][r] = vn[mt][r] * fexp(g63 - gi[r]); }
            bf16x8 Vb[2], Vd[2];
#pragma unroll
            for (int ks = 0; ks < 2; ++ks) { Vb[ks] = pack_frag(vn[2 * ks], vn[2 * ks + 1]); Vd[ks] = pack_frag(vd[2 * ks], vd[2 * ks + 1]); }
            { unsigned char* ru = rec0 + (size_t)n * REC_BYTES + REC_U + (size_t)(sl * 64 + lane) * 32;
                *(u32x4*)ru = __builtin_bit_cast(u32x4, Vb[0]); *(u32x4*)(ru + 16) = __builtin_bit_cast(u32x4, Vb[1]); }
            const float eg = fexp(g63);
#pragma unroll
            for (int mt = 0; mt < 8; ++mt) { f32x4 a4 = (f32x4){0.f, 0.f, 0.f, 0.f};
#pragma unroll
                for (int ks = 0; ks < 2; ++ks) a4 = mfma16(ld_frag8x2(L + SC_KT + (16 * mt + li) * 144 + (32 * ks + 4 * q) * 2), Vd[ks], a4);
                S[mt] = S[mt] * eg + a4; }
        }
        if (n + 1 < 64) { SC_STORE((n + 1) & 1); cu[0] = pu[0]; cu[1] = pu[1]; }
        __syncthreads();
    }
#undef SC_LOAD
#undef SC_STORE
}
constexpr int CO_Q = 0, CO_ATT = 17408, CO_G = 26624, CO_PART = 26880;
__device__ __forceinline__ void gdn_chunk_out(const Params& p, int layer, LAS unsigned char* lds, int tid, int wave, int lane) {
    const bf16* H = (const bf16*)(p.ws + WS_H); bf16* YS = (bf16*)(p.ws + WS_YS);
    const int q = lane >> 4, li = lane & 15;
    const f32x4 nw = *(const f32x4*)(p.in[I_GNW] + layer * 128 + 16 * wave + 4 * q);
    LAS float* part = (LAS float*)(lds + CO_PART);
    u32x4 rq0, rq1, ra, rg = (u32x4){0u, 0u, 0u, 0u}, sfw[4], vfw[2]; u32x2 zr[4];
#define CO_LOAD(uu) do { const int n_ = (uu) & 63, bh_ = (uu) >> 6, hh_ = bh_ & 3, b_ = bh_ >> 2; const int m0_ = b_ * T + n_ * 64; \
        const unsigned char* rec_ = p.ws + WS_REC + (size_t)(bh_ * 64 + n_) * REC_BYTES; \
        const u32x4* S0F_ = (const u32x4*)(p.ws + WS_OBUF) + (size_t)((bh_ * 64 + n_) * 8 + wave) * 4 * 64; \
        rq0 = *(const u32x4*)(rec_ + REC_Q + (size_t)tid * 16); rq1 = *(const u32x4*)(rec_ + REC_Q + (size_t)(tid + 512) * 16); ra = *(const u32x4*)(rec_ + REC_ATT + (size_t)tid * 16); \
        if (tid < 16) rg = *(const u32x4*)(rec_ + REC_G + tid * 16); \
        _Pragma("unroll") for (int ks = 0; ks < 4; ++ks) sfw[ks] = S0F_[ks * 64 + lane]; \
        vfw[0] = *(const u32x4*)(rec_ + REC_U + (size_t)(wave * 64 + lane) * 32); vfw[1] = *(const u32x4*)(rec_ + REC_U + (size_t)(wave * 64 + lane) * 32 + 16); \
        _Pragma("unroll") for (int mt = 0; mt < 4; ++mt) zr[mt] = *(const u32x2*)(H + (size_t)(m0_ + 16 * mt + li) * DH + HZ + hh_ * 128 + 16 * wave + 4 * q); } while (0)
    if ((int)blockIdx.x < 2048) CO_LOAD((int)blockIdx.x);
    for (int unit = blockIdx.x; unit < 2048; unit += gridDim.x) {
        const int n = unit & 63, bh = unit >> 6, hh = bh & 3, b = bh >> 2; const int m0 = b * T + n * 64;
        bf16x8 sf[4], vf[2]; u32x2 zc[4];
#pragma unroll
        for (int ks = 0; ks < 4; ++ks) sf[ks] = __builtin_bit_cast(bf16x8, sfw[ks]);
        vf[0] = __builtin_bit_cast(bf16x8, vfw[0]); vf[1] = __builtin_bit_cast(bf16x8, vfw[1]);
#pragma unroll
        for (int mt = 0; mt < 4; ++mt) zc[mt] = zr[mt];
        __syncthreads();
        *(LAS u32x4*)(lds + CO_Q + (tid >> 4) * 272 + (tid & 15) * 16) = rq0; *(LAS u32x4*)(lds + CO_Q + ((tid + 512) >> 4) * 272 + (tid & 15) * 16) = rq1;
        *(LAS u32x4*)(lds + CO_ATT + (tid >> 3) * 144 + (tid & 7) * 16) = ra;
        if (tid < 16) *(LAS u32x4*)(lds + CO_G + tid * 16) = rg;
        if (unit + (int)gridDim.x < 2048) CO_LOAD(unit + (int)gridDim.x);
        __syncthreads();
        f32x4 o[4]; float ss[4];
#pragma unroll
        for (int mt = 0; mt < 4; ++mt) { f32x4 a2 = (f32x4){0.f, 0.f, 0.f, 0.f}, a3 = (f32x4){0.f, 0.f, 0.f, 0.f};
#pragma unroll
            for (int ks = 0; ks < 4; ++ks) a2 = mfma16(sf[ks], ld_frag8x2(lds + CO_Q + (16 * mt + li) * 272 + (32 * ks + 4 * q) * 2), a2);
#pragma unroll
            for (int ks = 0; ks < 2; ++ks) a3 = mfma16(vf[ks], ld_frag8x2(lds + CO_ATT + (16 * mt + li) * 144 + (32 * ks + 4 * q) * 2), a3);
            const float gam = fexp(*(const LAS float*)(lds + CO_G + (16 * mt + li) * 4));
            o[mt] = a2 * gam + a3;
            float s = (o[mt][0] * o[mt][0] + o[mt][1] * o[mt][1]) + (o[mt][2] * o[mt][2] + o[mt][3] * o[mt][3]);
            s += __shfl_xor(s, 16); s += __shfl_xor(s, 32);
            if (q == 0) part[(16 * mt + li) * 8 + wave] = s; }
        __syncthreads();
#pragma unroll
        for (int mt = 0; mt < 4; ++mt) { const f32x4 pa = *(const LAS f32x4*)(part + (16 * mt + li) * 8), pb = *(const LAS f32x4*)(part + (16 * mt + li) * 8 + 4);
            ss[mt] = ((pa[0] + pa[1]) + (pa[2] + pa[3])) + ((pb[0] + pb[1]) + (pb[2] + pb[3]));
            const float rs = __builtin_amdgcn_rsqf(ss[mt] * (1.0f / 128.0f) + EPS);
            u32x2 w; w.x = pk2(o[mt][0] * rs * nw[0] * siluf_(bf_lo(zc[mt].x)), o[mt][1] * rs * nw[1] * siluf_(bf_hi(zc[mt].x)));
            w.y = pk2(o[mt][2] * rs * nw[2] * siluf_(bf_lo(zc[mt].y)), o[mt][3] * rs * nw[3] * siluf_(bf_hi(zc[mt].y)));
            *(u32x2*)(YS + (size_t)(m0 + 16 * mt + li) * 2048 + hh * 128 + 16 * wave + 4 * q) = w; }
    }
#undef CO_LOAD
    __syncthreads();
}
__device__ __forceinline__ void sum_gated(const Params& p, int gtid, int NGT) {
    const bf16* H = (const bf16*)(p.ws + WS_H); bf16* MG = (bf16*)(p.ws + WS_MERGED);
    for (int it = gtid; it < M * 128; it += NGT) { const int m = it >> 7, c8 = (it & 127) * 8; const bf16* r = H + (size_t)m * DH + HGATE + c8;
        float a[8], b[8];
        unpack8(*(const u32x4*)r, a);
#pragma unroll
        for (int br = 1; br < 4; ++br) { unpack8(*(const u32x4*)(r + br * 1024), b);
#pragma unroll
            for (int i = 0; i < 8; ++i) a[i] += b[i]; }
        *(u32x4*)(MG + (size_t)m * D + c8) = pack8(a); }
}

constexpr size_t WS_WRT = WS_MOETAB + MiB; constexpr int WRT_N = 80 * 1024;
__device__ __forceinline__ void prep_router_tables(const Params& p, int gtid, int NGT) {
    bf16* WRT = (bf16*)(p.ws + WS_WRT);
    for (int idx = gtid; idx < NLAYER * WRT_N; idx += NGT) { const int l = idx / WRT_N, n = (idx % WRT_N) >> 10, k = idx & 1023;
        const float w = (n < 64) ? p.in[I_REXP][((size_t)l * D + k) * 64 + n] : (n < 72 ? p.in[I_RGRP][((size_t)l * D + k) * 8 + (n - 64)] : 0.f);
        const unsigned hi = f2bf(w); const float wl = w - __uint_as_float(hi << 16);
        WRT[(size_t)(l * 2) * WRT_N + (idx % WRT_N)] = (bf16)hi; WRT[(size_t)(l * 2 + 1) * WRT_N + (idx % WRT_N)] = (bf16)f2bf(wl); }
}
__device__ __forceinline__ void moe_route_vb(const Params& p, int layer, LAS unsigned char* lds, int tid, int wave, int lane, int vb, const f32x4 (&nw)[4]) {
    LAS int* hist = (LAS int*)(lds + LDSCTL_OFF + LC_TAB);
    bf16* XN = (bf16*)(p.ws + WS_XN);
    int* route_e = (int*)(p.ws + WS_ROUTE); float* route_w = (float*)(p.ws + WS_ROUTE + (size_t)M * 2 * 4);
    int* cnt = (int*)(p.ws + WS_MOETAB + (size_t)NROWS_MAX * 8);
    const bf16* Wh = (const bf16*)(p.ws + WS_WRT) + (size_t)(layer * 2) * WRT_N; const bf16* Wl = Wh + WRT_N;
    const int q = lane >> 4, li = lane & 15;
    __syncthreads();
    if (tid < 64) hist[tid] = 0;
    for (int tile = 0; tile < 4; ++tile) {
        const int m0 = vb * 128 + tile * 32;
        __syncthreads();
        for (int hb = 0; hb < 2; ++hb) {
        f32x4 v[2][4];
#pragma unroll
        for (int rr = 0; rr < 2; ++rr)
#pragma unroll
            for (int j = 0; j < 4; ++j) { const u32x2 xw = *(const u32x2*)((const bf16*)(p.ws + WS_X1B) + (size_t)(m0 + wave * 4 + hb * 2 + rr) * D + 4 * lane + 256 * j); v[rr][j] = (f32x4){bf_lo(xw.x), bf_hi(xw.x), bf_lo(xw.y), bf_hi(xw.y)}; }
#pragma unroll
        for (int rr = 0; rr < 2; ++rr) { const int r = wave * 4 + hb * 2 + rr, m = m0 + r; float ss = 0.f;
#pragma unroll
            for (int j = 0; j < 4; ++j) ss += (v[rr][j][0] * v[rr][j][0] + v[rr][j][1] * v[rr][j][1]) + (v[rr][j][2] * v[rr][j][2] + v[rr][j][3] * v[rr][j][3]);
            const float rs = __builtin_amdgcn_rsqf(wave_sum(ss) * (1.0f / D) + EPS);
#pragma unroll
            for (int j = 0; j < 4; ++j) { const f32x4 x = v[rr][j] * rs * nw[j];
                u32x2 h; h.x = pk2(x[0], x[1]); h.y = pk2(x[2], x[3]);
                u32x2 l; l.x = pk2(x[0] - bf_lo(h.x), x[1] - bf_hi(h.x)); l.y = pk2(x[2] - bf_lo(h.y), x[3] - bf_hi(h.y));
                *(u32x2*)(XN + (size_t)m * D + 4 * lane + 256 * j) = h;
                const int off = r * 2048 + ((((lane >> 1) + 32 * j) ^ (r & 15)) << 4) + (lane & 1) * 8;
                *(LAS u32x2*)(lds + off) = h; *(LAS u32x2*)(lds + 65536 + off) = l; } }
        }
        __syncthreads();
        f32x4 acc[2][5];
#pragma unroll
        for (int mt = 0; mt < 2; ++mt)
#pragma unroll
            for (int nt = 0; nt < 5; ++nt) acc[mt][nt] = (f32x4){0.f, 0.f, 0.f, 0.f};
        {
            const bf16* bp = Wh + (size_t)li * 1024 + 128 * wave + 8 * q;
#pragma unroll
            for (int ks = 0; ks < 4; ++ks) {
                bf16x8 ah[2], al[2];
#pragma unroll
                for (int mt = 0; mt < 2; ++mt) { const int off = (16 * mt + li) * 2048 + (((16 * wave + 4 * ks + q) ^ li) << 4); ah[mt] = ld_frag16(lds + off); al[mt] = ld_frag16(lds + 65536 + off); }
#pragma unroll
                for (int nt = 0; nt < 5; ++nt) { const bf16x8 bh = *(const bf16x8*)(bp + nt * 16384 + 32 * ks), bl = *(const bf16x8*)(bp + WRT_N + nt * 16384 + 32 * ks);
#pragma unroll
                    for (int mt = 0; mt < 2; ++mt) { acc[mt][nt] = mfma16(ah[mt], bh, acc[mt][nt]); acc[mt][nt] = mfma16(al[mt], bh, acc[mt][nt]); acc[mt][nt] = mfma16(ah[mt], bl, acc[mt][nt]); } }
            }
        }
        __syncthreads();
        LAS float* part = (LAS float*)lds;
#pragma unroll
        for (int mt = 0; mt < 2; ++mt)
#pragma unroll
            for (int nt = 0; nt < 5; ++nt) { if (16 * nt + li < 72) {
#pragma unroll
                for (int r = 0; r < 4; ++r) part[(wave * 32 + 16 * mt + 4 * q + r) * 72 + 16 * nt + li] = acc[mt][nt][r]; } }
        __syncthreads();
        for (int r = wave * 4; r < wave * 4 + 4; ++r) { const int m = m0 + r;
            float le = 0.f, lg = 0.f;
#pragma unroll
            for (int w = 0; w < 8; ++w) { le += part[(w * 32 + r) * 72 + lane]; lg += part[(w * 32 + r) * 72 + 64 + (lane & 7)]; }
            float gv[8];
#pragma unroll
            for (int i = 0; i < 8; ++i) gv[i] = __shfl(lg, i);
            int grp = 0; float gmax = gv[0];
#pragma unroll
            for (int i = 1; i < 8; ++i) if (gv[i] > gmax) { gmax = gv[i]; grp = i; }
            float gs = 0.f;
#pragma unroll
            for (int i = 0; i < 8; ++i) gs += __expf(gv[i] - gmax);
            const float psel = 1.0f / gs;
            float ev[8];
#pragma unroll
            for (int i = 0; i < 8; ++i) ev[i] = __shfl(le, grp * 8 + i);
            int i1 = 0; float e1 = ev[0];
#pragma unroll
            for (int i = 1; i < 8; ++i) if (ev[i] > e1) { e1 = ev[i]; i1 = i; }
            int i2 = -1; float e2 = -3.0e38f;
#pragma unroll
            for (int i = 0; i < 8; ++i) if (i != i1 && ev[i] > e2) { e2 = ev[i]; i2 = i; }
            const float x2 = __expf(e2 - e1), w1 = psel / (1.0f + x2), w2 = psel * x2 / (1.0f + x2);
            if (lane == 0) { route_e[(size_t)m * 2] = grp * 8 + i1; route_e[(size_t)m * 2 + 1] = grp * 8 + i2; route_w[(size_t)m * 2] = w1; route_w[(size_t)m * 2 + 1] = w2;
                atomicAdd((int*)(hist + grp * 8 + i1), 1); atomicAdd((int*)(hist + grp * 8 + i2), 1); }
        }
    }
    __syncthreads();
    if (tid < 64) cnt[vb * 64 + tid] = hist[tid];
}
__device__ __forceinline__ void moe_route(const Params& p, int layer, LAS unsigned char* lds, int tid, int wave, int lane) {
    f32x4 nw[4];
#pragma unroll
    for (int j = 0; j < 4; ++j) nw[j] = *(const f32x4*)(p.in[I_MOENW] + layer * D + 4 * lane + 256 * j);
    for (int vb = blockIdx.x; vb < M / 128; vb += gridDim.x) moe_route_vb(p, layer, lds, tid, wave, lane, vb, nw);
    __syncthreads();
}
__device__ __forceinline__ void moe_dispatch(const Params& p, LAS unsigned char* lds, int tid, int wave, int lane) {
    LAS int* tab = (LAS int*)(lds + LDSCTL_OFF + LC_TAB);
    const bf16* XN = (const bf16*)(p.ws + WS_XN); bf16* XS = (bf16*)(p.ws + WS_XS);
    const int* route_e = (const int*)(p.ws + WS_ROUTE); const float* route_w = (const float*)(p.ws + WS_ROUTE + (size_t)M * 2 * 4);
    int* row_code = (int*)(p.ws + WS_MOETAB); float* row_w = (float*)(p.ws + WS_MOETAB + (size_t)NROWS_MAX * 4);
    const int* cnt = (const int*)(p.ws + WS_MOETAB + (size_t)NROWS_MAX * 8); int* blk_e = (int*)(p.ws + WS_MOETAB + (size_t)NROWS_MAX * 8 + 256 * 64 * 4);
    for (int vb = blockIdx.x; vb < M / 128; vb += gridDim.x) {
        __syncthreads();
        {
            const int e = tid & 63, part = tid >> 6; int run = 0, base = 0;
#pragma unroll 8
            for (int v = part * 32; v < part * 32 + 32; ++v) { const int c = cnt[v * 64 + e]; if (v < vb) base += c; run += c; }
            tab[720 + part * 64 + e] = run; tab[1240 + part * 64 + e] = base;
        }
        __syncthreads();
        if (tid < 64) { int run = 0, base = 0;
#pragma unroll
            for (int k = 0; k < 8; ++k) { run += tab[720 + k * 64 + tid]; base += tab[1240 + k * 64 + tid]; }
            tab[64 + tid] = run; tab[128 + tid] = base; }
        __syncthreads();
        if (tid == 0) { int s = 0; for (int e = 0; e < 64; ++e) { tab[e] = s; s += (tab[64 + e] + 255) / 256 * 256; } tab[704] = s; }
        if (tid < 256) tab[192 + tid] = route_e[(size_t)vb * 256 + tid];
        __syncthreads();
        if (tid < 256) { const int e = tab[192 + tid]; int rank = 0; for (int a = 0; a < tid; ++a) rank += (tab[192 + a] == e) ? 1 : 0;
            const int pos = tab[e] + tab[128 + e] + rank; tab[448 + tid] = pos;
            row_code[pos] = ((vb * 128 + (tid >> 1)) << 1) | (tid & 1); row_w[pos] = route_w[(size_t)vb * 256 + tid]; }
        if (vb < 64) { const int ps = tab[vb], tot = tab[64 + vb], pe = ps + (tot + 255) / 256 * 256;
            for (int r = ps + tot + tid; r < pe; r += 512) row_code[r] = -1;
            for (int b = ps / 256 + tid; b < pe / 256; b += 512) blk_e[b] = vb;
            if (tid == 0) { blk_e[NROWBLK_MAX + 64 + vb] = ps / 256; blk_e[NROWBLK_MAX + 128 + vb] = (pe - ps) / 256; }
            if (vb == 63 && tid == 0) blk_e[NROWBLK_MAX] = tab[704] / 256; }
        __syncthreads();
        for (int a0 = wave * 32; a0 < wave * 32 + 32; a0 += 8) {
            u32x4 r0[8], r1[8];
#pragma unroll
            for (int k = 0; k < 8; ++k) { const u32x4* src = (const u32x4*)(XN + (size_t)(vb * 128 + ((a0 + k) >> 1)) * D); r0[k] = src[lane]; r1[k] = src[lane + 64]; }
#pragma unroll
            for (int k = 0; k < 8; ++k) { u32x4* dst = (u32x4*)(XS + (size_t)tab[448 + a0 + k] * D); dst[lane] = r0[k]; dst[lane + 64] = r1[k]; } }
    }
    __syncthreads();
}

__global__ void __launch_bounds__(512, 2) fwd(Params p) {
    extern __shared__ __attribute__((aligned(16))) unsigned char lds_raw[];
    LAS unsigned char* lds = (LAS unsigned char*)lds_raw;
    const int tid0 = threadIdx.x;
    const int G = gridDim.x, NGW = G * 8, NGT = G * 512;
#define FRESH() Params pl = p; { GAS unsigned char* w_ = (GAS unsigned char*)pl.ws; GAS float* o_ = (GAS float*)pl.out; asm volatile("" : "+s"(w_), "+s"(o_)); pl.ws = (unsigned char*)w_; pl.out = (float*)o_; }     int tid = tid0; asm volatile("" : "+v"(tid)); const int lane = tid & 63, wave = __builtin_amdgcn_readfirstlane(tid >> 6); const int gw = blockIdx.x * 8 + wave, gtid = blockIdx.x * 512 + tid; (void)lane; (void)gw; (void)gtid
    for (int u = tid0; u < (LDS_BYTES - LDSCTL_OFF) / 4; u += 512) ((LAS unsigned*)(lds + LDSCTL_OFF))[u] = 0u;
    __syncthreads();
    const int lo = p.ph_lo, hi = p.ph_hi;
    XcdBarrier bar; bar.bar = (unsigned*)(p.ws + WS_CTL) + CW_BAR; bar.x = 0; bar.st = (volatile LAS unsigned*)(lds + LDSCTL_OFF + LC_BAR);
    if (hi - lo > 1) bar = xcd_barrier_post((unsigned*)(p.ws + WS_CTL) + CW_BAR, (volatile LAS unsigned*)(lds + LDSCTL_OFF + LC_BAR));
#ifndef PHASE_MASK
#define PHASE_MASK 0x1fff
#endif
#define IN(k) (((PHASE_MASK >> ((k) == PH_FINAL ? 12 : ((k) % PH_PER_LAYER))) & 1) && lo <= (k) && (k) < hi)
#define REPS(k) ((((REPEAT_MASK) >> (k)) & 1) && layer == 0 ? 2 : 1)
#define SEAM(k) do { if (IN(k) && IN((k) + 1)) xcd_barrier(bar); } while (0)

    for (int layer = 0; layer < NLAYER; ++layer) {
        const int g0 = layer * PH_PER_LAYER;

        for (int rep_ = 0; rep_ < REPS(0); ++rep_) if (IN(g0 + 0)) { if (rep_) __syncthreads(); FRESH();
            if (layer == 0) { prep_static_weights(pl, gw, NGW, lane); prep_router_tables(pl, gtid, NGT); __syncthreads(); norm_phase<0>(pl, layer, lds, gw, NGW, tid, lane); }
            else norm_phase<1>(pl, layer, lds, gw, NGW, tid, lane);
        }
        SEAM(g0 + 0);
        for (int rep_ = 0; rep_ < REPS(1); ++rep_) if (IN(g0 + 1)) { if (rep_) __syncthreads(); FRESH();
            SchedH S; S.to.init(M / 256, DH / 256, G, (int)blockIdx.x, WGM_H); S.A = (const char*)(pl.ws + WS_XN); S.B = (const char*)(pl.ws + WS_WIN + layer * WIN_L);
            EpiStoreBf16 E{(bf16*)(pl.ws + WS_H), DH};
            pg8::gemm_phase(lds, tid, D, D, D, S, E);
        }
        SEAM(g0 + 1);
        for (int rep_ = 0; rep_ < REPS(2); ++rep_) if (IN(g0 + 2)) { if (rep_) __syncthreads(); FRESH(); gdn_chunk_prep(pl, layer, lds, tid, wave, lane); }
        SEAM(g0 + 2);
        for (int rep_ = 0; rep_ < REPS(3); ++rep_) if (IN(g0 + 3)) { if (rep_) __syncthreads(); FRESH();
            if ((int)blockIdx.x < 64) gdn_chunk_scan(pl, lds, tid, wave, lane, (int)blockIdx.x >> 1, (int)blockIdx.x & 1);
            {
                unsigned* qc = (unsigned*)(pl.ws + WS_CTL) + CW_QUEUE + layer * 256;
                gmlp(pl, layer, lds, tid, wave, lane, qc);
                conformer(pl, layer, lds, tid, wave, lane, qc + 64);
                for (;;) { const int unit = queue_pop(qc + 128, lds, tid); if (unit >= M / 128) break; shortconv_unit(pl, layer, tid, unit); }
            }
        }
        SEAM(g0 + 3);
        for (int rep_ = 0; rep_ < REPS(4); ++rep_) if (IN(g0 + 4)) { if (rep_) __syncthreads(); FRESH(); gdn_chunk_out(pl, layer, lds, tid, wave, lane); }
        SEAM(g0 + 4);
        for (int rep_ = 0; rep_ < REPS(5); ++rep_) if (IN(g0 + 5)) { if (rep_) __syncthreads(); FRESH();
            SchedBranch S; S.to.init(M / 256, 4, G, (int)blockIdx.x, WGM_BR); S.YS = (const char*)(pl.ws + WS_YS); S.WBR = (const char*)(pl.ws + WS_WBR + layer * WBR_L);
            EpiGate E{(bf16*)(pl.ws + WS_H) + HGATE, (bf16*)(pl.ws + WS_MERGED)};
            pg8::gemm_phase(lds, tid, 512, 2048, 512, S, E);
        }
        for (int rep_ = 0; rep_ < REPS(6); ++rep_) if (IN(g0 + 6)) { if (rep_) __syncthreads(); FRESH();   }
        SEAM(g0 + 6);
        for (int rep_ = 0; rep_ < REPS(7); ++rep_) if (IN(g0 + 7)) { if (rep_) __syncthreads(); FRESH();
            const int NGB = G / 2;
            if ((int)blockIdx.x < NGB) {
                SchedOut S; S.to.init(M / 256, 4, NGB, (int)blockIdx.x, WGM_OUT); S.A = (const char*)(pl.ws + WS_MERGED); S.B = (const char*)(pl.ws + WS_WOUT + layer * WOUT_L);
                EpiRes E{layer == 0 ? pl.in[I_X] : nullptr, (const bf16*)pl.out, (bf16*)(pl.ws + WS_X1B)};
                pg8::gemm_phase(lds, tid, D, D, D, S, E);
            } else prep_moe_weights(pl, layer, ((int)blockIdx.x - NGB) * 8 + wave, (G - NGB) * 8, lane);
        }
        SEAM(g0 + 7);
        for (int rep_ = 0; rep_ < REPS(8); ++rep_) if (IN(g0 + 8)) { if (rep_) __syncthreads(); FRESH(); moe_route(pl, layer, lds, tid, wave, lane); }
        SEAM(g0 + 8);
        for (int rep_ = 0; rep_ < REPS(9); ++rep_) if (IN(g0 + 9)) { if (rep_) __syncthreads(); FRESH(); moe_dispatch(pl, lds, tid, wave, lane); }
        SEAM(g0 + 9);
        if (IN(g0 + 10) || IN(g0 + 11)) { FRESH();
            LAS int* tb = (LAS int*)(lds + LDSCTL_OFF + LC_TAB);
            const int* est = (const int*)(pl.ws + WS_MOETAB + (size_t)NROWS_MAX * 8 + 256 * 64 * 4) + NROWBLK_MAX + 64;
            const int NX = (G % 8 == 0) ? 8 : 1, x = (int)blockIdx.x % NX, nk = 64 / NX;
            __syncthreads();
            if (tid < nk) { tb[160 + tid] = est[x + NX * tid]; tb[240 + tid] = est[64 + x + NX * tid]; }
            __syncthreads();
            if (tid == 0) { int s = 0; for (int k = 0; k < nk; ++k) { tb[k] = s; tb[80 + k] = tb[160 + k]; s += tb[240 + k] * 4; } tb[nk] = s; }
            __syncthreads();
        }
        for (int rep_ = 0; rep_ < REPS(10); ++rep_) if (IN(g0 + 10)) { if (rep_) __syncthreads(); FRESH();
            LAS int* tb = (LAS int*)(lds + LDSCTL_OFF + LC_TAB); const int NX = (G % 8 == 0) ? 8 : 1, nk = 64 / NX;
            SchedMoe S; S.nux = tb[nk]; S.nrank = G / NX; S.rank = (int)blockIdx.x / NX; S.nk = nk; S.x = (int)blockIdx.x % NX; S.NX = NX; S.cum = tb; S.rb0 = tb + 80;
            S.A = (const char*)(pl.ws + WS_XS); S.a_blk = (size_t)256 * D * 2; S.W = (const char*)(pl.ws + WS_MOEW); S.w_e = WGU_E; S.w_pn = (size_t)256 * D * 2; S.cmul = 128;
            EpiSwiglu E{(bf16*)(pl.ws + WS_HB)};
            pg8::gemm_phase(lds, tid, D, D, D, S, E);
        }
        SEAM(g0 + 10);
        for (int rep_ = 0; rep_ < REPS(11); ++rep_) if (IN(g0 + 11)) { if (rep_) __syncthreads(); FRESH();
            LAS int* tb = (LAS int*)(lds + LDSCTL_OFF + LC_TAB); const int NX = (G % 8 == 0) ? 8 : 1, nk = 64 / NX;
            SchedMoe S; S.nux = tb[nk]; S.nrank = G / NX; S.rank = (int)blockIdx.x / NX; S.nk = nk; S.x = (int)blockIdx.x % NX; S.NX = NX; S.cum = tb; S.rb0 = tb + 80;
            S.A = (const char*)(pl.ws + WS_HB); S.a_blk = (size_t)256 * DE * 2; S.W = (const char*)(pl.ws + WS_WD); S.w_e = WD_E; S.w_pn = (size_t)256 * DE * 2; S.cmul = 256;
            EpiScatter E{(bf16*)(pl.ws + WS_Y), (const int*)(pl.ws + WS_MOETAB), (const float*)(pl.ws + WS_MOETAB + (size_t)NROWS_MAX * 4)};
            pg8::gemm_phase(lds, tid, DE, DE, DE, S, E);
        }
        SEAM(g0 + 11);
    }
    if (IN(PH_FINAL)) { FRESH(); norm_phase<2>(pl, 0, lds, gw, NGW, tid, lane); }
#undef IN
#undef SEAM
}

extern "C" void kernel_launch(void* const* d_in, const int* in_sizes, int n_in, void* d_out, int out_size, void* d_ws, size_t ws_size, hipStream_t stream) {
    static int grid = 0;
    if (grid == 0) {
        if (n_in != 25 || out_size != M * D || ws_size < WS_END) { fprintf(stderr, "kernel_launch: unexpected shapes / workspace (n_in %d out %d ws %zu, need %zu)\n", n_in, out_size, ws_size, (size_t)WS_END); grid = -1; return; }
        int dev = 0, cus = 0, per_cu = 0;
        if (hipGetDevice(&dev) != hipSuccess || hipDeviceGetAttribute(&cus, hipDeviceAttributeMultiprocessorCount, dev) != hipSuccess) { grid = -1; return; }
        if (hipFuncSetAttribute((const void*)fwd, hipFuncAttributeMaxDynamicSharedMemorySize, LDS_BYTES) != hipSuccess) { fprintf(stderr, "kernel_launch: hipFuncSetAttribute failed\n"); grid = -1; return; }
        if (hipOccupancyMaxActiveBlocksPerMultiprocessor(&per_cu, (const void*)fwd, 512, LDS_BYTES) != hipSuccess || per_cu < 1) { fprintf(stderr, "kernel_launch: occupancy query says %d\n", per_cu); }
        (void)hipGetLastError();
        grid = cus;
    }
    if (grid < 0) return;
    hipMemsetAsync((char*)d_ws + WS_CTL, 0, CTL_BYTES, stream);
    Params p{};
    for (int i = 0; i < 25; ++i) p.in[i] = (const float*)d_in[i];
    p.out = (float*)d_out; p.ws = (unsigned char*)d_ws;
#if N_LAUNCH_MODE == 1
    p.ph_lo = 0; p.ph_hi = PH_TOTAL;
    hipLaunchKernelGGL(fwd, dim3(grid), dim3(512), LDS_BYTES, stream, p);
#else
    for (int k = 0; k < PH_TOTAL; ++k) { p.ph_lo = k; p.ph_hi = k + 1; hipLaunchKernelGGL(fwd, dim3(grid), dim3(512), LDS_BYTES, stream, p); }
#endif
}
```

```cpp
#include <hip/hip_runtime.h>
#include <cstdio>
#include <cstdint>

#ifndef REPEAT_MASK
#define REPEAT_MASK 0
#endif
#ifndef TP_A
#define TP_A -1
#endif
#ifndef TP_B
#define TP_B -1
#endif
#ifndef TP_SCALE
#define TP_SCALE 1
#endif
#ifndef WGM_H
#define WGM_H 4
#endif
#ifndef WGM_BR
#define WGM_BR 4
#endif
#ifndef WGM_OUT
#define WGM_OUT 4
#endif
#ifndef N_LAUNCH_MODE
#define N_LAUNCH_MODE 1
#endif

#define LAS __attribute__((address_space(3)))
#define GAS __attribute__((address_space(1)))
typedef unsigned short bf16;
typedef short bf16x8 __attribute__((ext_vector_type(8)));
typedef float f32x4 __attribute__((ext_vector_type(4)));
typedef float f32x2 __attribute__((ext_vector_type(2)));
typedef unsigned u32x4 __attribute__((ext_vector_type(4)));
typedef unsigned u32x2 __attribute__((ext_vector_type(2)));

constexpr int NB = 8, T = 4096, D = 1024, M = NB * T, NLAYER = 2;
constexpr int DIN = 9736, DH = 9728;
constexpr int HQ = 0, HK = 512, HV = 1024, HZ = 1536, HCONF = 2048, HGMLP = 3072, HSC = 4096, HGATE = 5632;
constexpr int NE = 64, DE = 512;
constexpr float EPS = 1e-6f;
constexpr int NROWBLK_MAX = 320, NROWS_MAX = NROWBLK_MAX * 256;

constexpr size_t MiB = 1u << 20;
constexpr size_t WS_CTL = 0, CTL_BYTES = 1 * MiB;
constexpr size_t WS_WIN = 2 * MiB;
constexpr size_t WIN_L = (size_t)DH * D * 2;
constexpr size_t WS_WBR = 40 * MiB;
constexpr size_t WBR_L = (size_t)4 * D * 512 * 2;
constexpr size_t WS_WOUT = 48 * MiB;
constexpr size_t WOUT_L = (size_t)D * D * 2;
constexpr size_t WS_XN = 52 * MiB;
constexpr size_t WS_SMALL = 116 * MiB;
constexpr size_t WS_ROUTE = 117 * MiB;
constexpr size_t WS_MOETAB = 118 * MiB;
constexpr size_t WS_YS = 120 * MiB;
constexpr size_t WS_X1B = 120 * MiB;
constexpr size_t WS_REC = 248 * MiB;
constexpr size_t WS_MERGED = WS_REC;
constexpr size_t WS_OBUF = WS_XN;
constexpr int REC_W = 0, REC_Q = 16384, REC_ATT = 32768, REC_KT = 40960, REC_U = 57344, REC_G = 73728, REC_BYTES = 73984;
static_assert(WS_REC + (size_t)2048 * REC_BYTES <= 410 * MiB, "chunk records");
constexpr size_t WS_H = 410 * MiB;
constexpr size_t WS_MOEW = 410 * MiB;
constexpr size_t WGU_E = (size_t)1024 * 1024 * 2, WD_E = (size_t)1024 * 512 * 2;
constexpr size_t WS_WD = WS_MOEW + 64 * WGU_E;
constexpr size_t WS_XS = 602 * MiB;
constexpr size_t WS_HB = 762 * MiB;
constexpr size_t WS_Y = 842 * MiB;
constexpr size_t WS_END = 1018 * MiB;
static_assert(WS_H + (size_t)M * DH * 2 <= WS_END && WS_Y + (size_t)2 * M * D * 2 <= WS_END, "ws map");

constexpr int CW_BAR = 4096;
constexpr int CW_QUEUE = 16384;
constexpr int STAGE_LDS = 131072, LDSCTL_OFF = 131072, LDS_BYTES = 147456;
constexpr int LC_BAR = 0;
constexpr int LC_MISC = 64;
constexpr int LC_TAB = 1024;

__device__ __forceinline__ float bf_lo(unsigned w) { return __uint_as_float(w << 16); }
__device__ __forceinline__ float bf_hi(unsigned w) { return __uint_as_float(w & 0xffff0000u); }
__device__ __forceinline__ float bf2f(bf16 b) { return __uint_as_float(((unsigned)b) << 16); }
__device__ __forceinline__ unsigned f2bf(float f) { unsigned u = __float_as_uint(f); return (u + 0x7fffu + ((u >> 16) & 1u)) >> 16; }
__device__ __forceinline__ unsigned pk2(float lo, float hi) { return f2bf(lo) | (f2bf(hi) << 16); }
__device__ __forceinline__ void unpack8(const u32x4 v, float (&f)[8]) {
    f[0] = bf_lo(v.x); f[1] = bf_hi(v.x); f[2] = bf_lo(v.y); f[3] = bf_hi(v.y); f[4] = bf_lo(v.z); f[5] = bf_hi(v.z); f[6] = bf_lo(v.w); f[7] = bf_hi(v.w);
}
__device__ __forceinline__ u32x4 pack8(const float (&f)[8]) { u32x4 o; o.x = pk2(f[0], f[1]); o.y = pk2(f[2], f[3]); o.z = pk2(f[4], f[5]); o.w = pk2(f[6], f[7]); return o; }
template <int CTRL> __device__ __forceinline__ float dpp_mov(float v) { return __builtin_bit_cast(float, __builtin_amdgcn_update_dpp(0, __builtin_bit_cast(int, v), CTRL, 0xf, 0xf, false)); }
__device__ __forceinline__ float wave_sum(float v) {
    v += dpp_mov<0xB1>(v); v += dpp_mov<0x4E>(v); v += dpp_mov<0x141>(v); v += dpp_mov<0x140>(v);
    const int vi = __builtin_bit_cast(int, v);
    const float a = __builtin_bit_cast(float, __builtin_amdgcn_readlane(vi, 0)), b = __builtin_bit_cast(float, __builtin_amdgcn_readlane(vi, 16)), c = __builtin_bit_cast(float, __builtin_amdgcn_readlane(vi, 32)), d = __builtin_bit_cast(float, __builtin_amdgcn_readlane(vi, 48));
    return (a + b) + (c + d);
}
__device__ __forceinline__ void lds_sync() { asm volatile("s_waitcnt lgkmcnt(0)" ::: "memory"); __builtin_amdgcn_s_barrier(); asm volatile("" ::: "memory"); }
__device__ __forceinline__ float fexp(float x) { return __builtin_amdgcn_exp2f(x * 1.4426950408889634f); }
__device__ __forceinline__ float frcp(float x) { return __builtin_amdgcn_rcpf(x); }
__device__ __forceinline__ float sigmoidf_(float x) { return frcp(1.0f + fexp(-x)); }
__device__ __forceinline__ float siluf_(float x) { return x * frcp(1.0f + fexp(-x)); }
__device__ __forceinline__ float gelu_tanh(float x) { const float u = 0.7978845608028654f * (x + 0.044715f * x * x * x); return x * frcp(1.0f + fexp(-2.0f * u)); }
__device__ __forceinline__ float softplusf_(float x) { return fmaxf(x, 0.f) + log1pf(__expf(-fabsf(x))); }

#define XB_TMO      128
#define XB_XCNT(j)  (256  + 64 * (j))
#define XB_XSUB(j)  (1280 + 64 * (j))
#define XB_XGEN(j)  (2304 + 64 * (j))
#define XB_TOP      3328
#define XB_TOPGEN   3392
#define XCD_BAR_WORDS 3456
#define XB_SPIN_CAP (1u << 18)
__device__ __forceinline__ unsigned xb_ld(unsigned* p)              { return __hip_atomic_load(p, __ATOMIC_RELAXED, __HIP_MEMORY_SCOPE_AGENT); }
__device__ __forceinline__ unsigned xb_add(unsigned* p, unsigned v) { return __hip_atomic_fetch_add(p, v, __ATOMIC_RELAXED, __HIP_MEMORY_SCOPE_AGENT); }
__device__ __forceinline__ unsigned xb_xcc_id() { return (unsigned)__builtin_amdgcn_s_getreg((3 << 11) | 20) & 0xFu; }
#define XB_SPIN(cond, bar) do { unsigned _sp = 0; while (cond) { __builtin_amdgcn_s_sleep(1); \
    if ((++_sp & 255u) == 0u) { if (xb_ld(&(bar)[XB_TMO])) break; if (_sp > XB_SPIN_CAP) { atomicAdd(&(bar)[XB_TMO], 1u); break; } } } } while (0)
struct XcdBarrier { unsigned* bar; unsigned x; volatile LAS unsigned* st; };
__device__ __forceinline__ XcdBarrier xcd_barrier_post(unsigned* bar, volatile LAS unsigned* st) {
    XcdBarrier b; b.bar = bar; b.x = xb_xcc_id(); b.st = st;
    if (threadIdx.x == 0) (void)xb_add(&bar[XB_XCNT(b.x)], 1u);
    return b;
}
__device__ __forceinline__ void xcd_barrier_complete(unsigned* bar, unsigned x, unsigned& nloc, unsigned& nx) {
    const unsigned G = gridDim.x * gridDim.y * gridDim.z;
    unsigned sum, cnt, mine, sp = 0u;
    for (;;) {
        sum = 0u; cnt = 0u; mine = 0u;
#pragma unroll
        for (unsigned j = 0; j < 16; ++j) { const unsigned c = xb_ld(&bar[XB_XCNT(j)]); sum += c; cnt += (c > 0u) ? 1u : 0u; mine = (j == x) ? c : mine; }
        if (sum == G) break;
        __builtin_amdgcn_s_sleep(1);
        if ((++sp & 255u) == 0u) { if (xb_ld(&bar[XB_TMO])) break; if (sp > XB_SPIN_CAP) { atomicAdd(&bar[XB_TMO], 1u); break; } }
    }
    nloc = mine > 0u ? mine : 1u; nx = cnt > 0u ? cnt : 1u;
}
__device__ __forceinline__ void xcd_barrier(const XcdBarrier& b) {
    asm volatile("s_waitcnt vmcnt(0)" ::: "memory");
    __syncthreads();
    if (threadIdx.x == 0) {
        unsigned* bar = b.bar;
        __builtin_amdgcn_s_waitcnt(0);
        unsigned nloc = b.st[0], nx = b.st[1];
        if (nloc == 0u) { xcd_barrier_complete(bar, b.x, nloc, nx); b.st[0] = nloc; b.st[1] = nx; }
        const unsigned old = xb_add(&bar[XB_XSUB(b.x)], 1u);
        const unsigned gen = old / nloc;
        if (old + 1u == (gen + 1u) * nloc) {
            __builtin_amdgcn_fence(__ATOMIC_RELEASE, "agent");
            asm volatile("s_waitcnt vmcnt(0)" ::: "memory");
            const unsigned og = xb_add(&bar[XB_TOP], 1u);
            const unsigned tg = og / nx;
            if (og + 1u == (tg + 1u) * nx) xb_add(&bar[XB_TOPGEN], 1u);
            else XB_SPIN(xb_ld(&bar[XB_TOPGEN]) == tg, bar);
            __builtin_amdgcn_fence(__ATOMIC_ACQUIRE, "agent");
            xb_add(&bar[XB_XGEN(b.x)], 1u);
            asm volatile("s_waitcnt vmcnt(0)" ::: "memory");
        } else {
            XB_SPIN(xb_ld(&bar[XB_XGEN(b.x)]) == gen, bar);
            __builtin_amdgcn_fence(__ATOMIC_ACQUIRE, "agent");
            asm volatile("s_waitcnt vmcnt(0)" ::: "memory");
        }
    }
    __syncthreads();
}

namespace pg8 {
constexpr int BM = 256, BK = 64, HALF = 128, HTB = HALF * BK * 2, STAGE_BYTES = 8 * HTB, NXCD = 8, WGM = 8;
__host__ __device__ __forceinline__ int lds_byte(int r, int c) { const int st = (r >> 4) * 2 + (c >> 5), rr = r & 15, cc = c & 31, ob = rr * 64 + cc * 2; return st * 1024 + (ob ^ (((ob >> 9) & 1) << 5)); }
__host__ __device__ __forceinline__ void stage_rc(int b, int& R, int& C) { const int st = b / 1024, sb = b % 1024, swz = sb ^ (((sb >> 9) & 1) << 5); R = (st >> 1) * 16 + swz / 64; C = (st & 1) * 32 + (swz % 64) / 2; }
__host__ __device__ __forceinline__ int perm32(int rho) { const int n = rho >> 4, i = rho & 15; return 8 * (i >> 2) + 4 * n + (i & 3); }

struct Unit { const char* A; const char* B; int r0, c0; };

struct TileOrder {
    int nM, nN, nwg, G, c, wgm;
    __device__ void init(int nM_, int nN_, int G_, int c_, int wgm_ = WGM) { nM = nM_; nN = nN_; nwg = nM * nN; G = G_; c = c_; wgm = wgm_; }
    __device__ bool next(int i, int& pm, int& pn) const {
        const long L = (long)i * G + c; if (L >= nwg) return false;
        int wgid = (int)L; { const int q = nwg / NXCD, r = nwg % NXCD, xcd = wgid % NXCD, off = wgid / NXCD; wgid = (xcd < r ? xcd * (q + 1) : r * (q + 1) + (xcd - r) * q) + off; }
        const int nig = wgm * nN, gid = wgid / nig, fm = gid * wgm, gsz = (nM - fm) < wgm ? (nM - fm) : wgm;
        pm = fm + ((wgid % nig) % gsz); pn = (wgid % nig) / gsz; return true;
    }
};
__device__ __forceinline__ unsigned cvt_pk_bf16(float lo, float hi) { unsigned r; asm volatile("v_cvt_pk_bf16_f32 %0, %1, %2" : "=v"(r) : "v"(lo), "v"(hi)); return r; }

template <class Epi, class Sched>
__device__ __forceinline__ void gemm_phase(LAS unsigned char* lds, const int tid, const int K, const int lda, const int ldb, const Sched& S, const Epi& E) {
    const int wid = __builtin_amdgcn_readfirstlane(tid >> 6), lane = tid & 63, wr = wid >> 2, wc = wid & 3, fr = lane & 15, fq = lane >> 4;
    const int nt = K / BK;
    unsigned voffA[2], voffB[2];
#pragma unroll
    for (int i = 0; i < 2; ++i) { int R, C; stage_rc(tid * 16 + i * 8192, R, C); const int Rb = Epi::PERM ? ((R & ~31) + perm32(R & 31)) : R;
        voffA[i] = (unsigned)(R * lda + C) * 2u; voffB[i] = (unsigned)(Rb * ldb + C) * 2u; }
    const size_t kstep = (size_t)(BK * 2);
    const size_t hstepA = (size_t)HALF * lda * 2, hstepB = (size_t)HALF * ldb * 2;
    const unsigned ldsw = (unsigned)wid * 1024u;
    const int aoff = lds_byte(wr * 64 + fr, fq * 8), boff = lds_byte(wc * 32 + fr, fq * 8);
#define PG8_SA(b, h) (((b) * 2 + (h)) * HTB)
#define PG8_SB(b, h) ((4 + (b) * 2 + (h)) * HTB)
#define PG8_STAGE(bufoff, gbase, voff) do { _Pragma("unroll") for (int _i = 0; _i < 2; ++_i) \
        __builtin_amdgcn_global_load_lds((const unsigned*)((const char*)(gbase) + (voff)[_i]), (LAS unsigned*)(lds + (bufoff) + ldsw + _i * 8192), 16, 0, 0); } while (0)
#define PG8_LDA(dst, b, h) do { _Pragma("unroll") for (int m = 0; m < 4; ++m) _Pragma("unroll") for (int k = 0; k < 2; ++k) dst[m][k] = *(const LAS bf16x8*)(lds + PG8_SA(b, h) + aoff + m * 2048 + k * 1024); } while (0)
#define PG8_LDB(dst, b, h) do { _Pragma("unroll") for (int n = 0; n < 2; ++n) _Pragma("unroll") for (int k = 0; k < 2; ++k) dst[n][k] = *(const LAS bf16x8*)(lds + PG8_SB(b, h) + boff + n * 2048 + k * 1024); } while (0)
#define PG8_MMA(ai, bj, At, Bt) do { __builtin_amdgcn_s_setprio(1); _Pragma("unroll") for (int m = 0; m < 4; ++m) _Pragma("unroll") for (int n = 0; n < 2; ++n) _Pragma("unroll") for (int k = 0; k < 2; ++k) \
        acc[ai][bj][m][n] = __builtin_amdgcn_mfma_f32_16x16x32_bf16(Bt[n][k], At[m][k], acc[ai][bj][m][n], 0, 0, 0); __builtin_amdgcn_s_setprio(0); } while (0)
#define PG8_WAIT_V(n) asm volatile("s_waitcnt vmcnt(" #n ")" ::: "memory")
#define PG8_WAIT_L(n) asm volatile("s_waitcnt lgkmcnt(" #n ")" ::: "memory")
#define PG8_BAR __builtin_amdgcn_s_barrier()
#define PG8_SCHED __builtin_amdgcn_sched_barrier(0)
    Unit cur, nxt; int ui = 0;
    if (!S.next(0, cur)) return;
    f32x4 acc[2][2][4][2];
#pragma unroll
    for (int a = 0; a < 2; ++a)
#pragma unroll
        for (int b = 0; b < 2; ++b)
#pragma unroll
            for (int m = 0; m < 4; ++m)
#pragma unroll
                for (int n = 0; n < 2; ++n) acc[a][b][m][n] = (f32x4){0.f, 0.f, 0.f, 0.f};
    bf16x8 At[4][2], B0[2][2], B1[2][2];
    const char* cA = cur.A; const char* cB = cur.B;
    PG8_STAGE(PG8_SB(0, 0), cB, voffB); PG8_STAGE(PG8_SB(0, 1), cB + hstepB, voffB); PG8_STAGE(PG8_SA(0, 0), cA, voffA); PG8_STAGE(PG8_SA(0, 1), cA + hstepA, voffA);
    if (wr == 1) PG8_BAR;
    PG8_WAIT_V(2); PG8_BAR;
    PG8_STAGE(PG8_SB(1, 0), cB + kstep, voffB); PG8_STAGE(PG8_SA(1, 0), cA + kstep, voffA); PG8_STAGE(PG8_SB(1, 1), cB + hstepB + kstep, voffB);
    PG8_WAIT_V(6); PG8_BAR;
    for (;;) {
        const bool has_next = S.next(ui + 1, nxt);
        const char* nA = has_next ? nxt.A : cA; const char* nB = has_next ? nxt.B : cB;
        for (int t = 0; t < nt; t += 2) {
            const bool last = (t == nt - 2);
            const char* a1 = cA + (size_t)(t + 1) * kstep;
            const char* a2 = last ? nA : cA + (size_t)(t + 2) * kstep; const char* b2 = last ? nB : cB + (size_t)(t + 2) * kstep;
            const char* a3 = a2 + kstep; const char* b3 = b2 + kstep;
            PG8_LDB(B0, 0, 0); PG8_LDB(B1, 0, 1); PG8_SCHED; PG8_LDA(At, 0, 0); PG8_STAGE(PG8_SA(1, 1), a1 + hstepA, voffA);
            PG8_WAIT_V(8); PG8_WAIT_L(0); PG8_BAR; PG8_MMA(0, 0, At, B0); PG8_MMA(0, 1, At, B1); PG8_BAR; PG8_SCHED;
            PG8_LDA(At, 0, 1); PG8_STAGE(PG8_SB(0, 0), b2, voffB); PG8_STAGE(PG8_SB(0, 1), b2 + hstepB, voffB); PG8_STAGE(PG8_SA(0, 0), a2, voffA);
            PG8_WAIT_V(8); PG8_WAIT_L(0); PG8_BAR; PG8_MMA(1, 0, At, B0); PG8_MMA(1, 1, At, B1); PG8_BAR; PG8_SCHED;
            PG8_LDB(B0, 1, 0); PG8_LDB(B1, 1, 1); PG8_SCHED; PG8_LDA(At, 1, 0); PG8_STAGE(PG8_SA(0, 1), a2 + hstepA, voffA);
            PG8_WAIT_V(8); PG8_WAIT_L(0); PG8_BAR; PG8_MMA(0, 0, At, B0); PG8_MMA(0, 1, At, B1); PG8_BAR; PG8_SCHED;
            PG8_LDA(At, 1, 1); PG8_STAGE(PG8_SB(1, 0), b3, voffB); PG8_STAGE(PG8_SB(1, 1), b3 + hstepB, voffB); PG8_STAGE(PG8_SA(1, 0), a3, voffA);
            PG8_WAIT_V(8); PG8_WAIT_L(0); PG8_BAR; PG8_MMA(1, 0, At, B0); PG8_MMA(1, 1, At, B1); PG8_BAR; PG8_SCHED;
        }
        if (wr == 0) PG8_BAR;
        E(acc, cur, wr, wc, fr, fq);
        if (!has_next) break;
#pragma unroll
        for (int a = 0; a < 2; ++a)
#pragma unroll
            for (int b = 0; b < 2; ++b)
#pragma unroll
                for (int m = 0; m < 4; ++m)
#pragma unroll
                    for (int n = 0; n < 2; ++n) acc[a][b][m][n] = (f32x4){0.f, 0.f, 0.f, 0.f};
        cur = nxt; cA = nA; cB = nB; ++ui;
        if (wr == 1) PG8_BAR;
    }
    PG8_WAIT_V(0);
    PG8_BAR;
#undef PG8_SA
#undef PG8_SB
#undef PG8_STAGE
#undef PG8_LDA
#undef PG8_LDB
#undef PG8_MMA
#undef PG8_WAIT_V
#undef PG8_WAIT_L
#undef PG8_BAR
#undef PG8_SCHED
}
}
using pg8::Unit;
using pg8::cvt_pk_bf16;

struct EpiStoreBf16 {
    static constexpr bool PERM = true;
    bf16* O; int ldc;
    __device__ __forceinline__ void operator()(const f32x4 (&acc)[2][2][4][2], const Unit& u, int wr, int wc, int fr, int fq) const {
        const int row0 = u.r0 + wr * 64 + fr, col0 = u.c0 + wc * 32 + 8 * fq;
#pragma unroll
        for (int ai = 0; ai < 2; ++ai)
#pragma unroll
            for (int m = 0; m < 4; ++m) { bf16* rowp = O + (size_t)(row0 + ai * 128 + m * 16) * ldc + col0;
#pragma unroll
                for (int bj = 0; bj < 2; ++bj) { const f32x4 v0 = acc[ai][bj][m][0], v1 = acc[ai][bj][m][1];
                    u32x4 w; w.x = cvt_pk_bf16(v0[0], v0[1]); w.y = cvt_pk_bf16(v0[2], v0[3]); w.z = cvt_pk_bf16(v1[0], v1[1]); w.w = cvt_pk_bf16(v1[2], v1[3]);
                    *(u32x4*)(rowp + bj * 128) = w; } }
    }
};
struct EpiGate {
    static constexpr bool PERM = true;
    const bf16* Hg; bf16* MG;
    __device__ __forceinline__ void operator()(const f32x4 (&acc)[2][2][4][2], const Unit& u, int wr, int wc, int fr, int fq) const {
        const int row0 = u.r0 + wr * 64 + fr, gcol0 = u.c0 + wc * 32 + 8 * fq, mcol0 = (u.c0 & 1023) + wc * 32 + 8 * fq; const bool first = u.c0 < 1024;
#pragma unroll
        for (int ai = 0; ai < 2; ++ai) {
            u32x4 gw[4][2], mw[4][2];
#pragma unroll
            for (int m = 0; m < 4; ++m)
#pragma unroll
                for (int bj = 0; bj < 2; ++bj) { gw[m][bj] = *(const u32x4*)(Hg + (size_t)(row0 + ai * 128 + m * 16) * DH + gcol0 + bj * 128);
                    mw[m][bj] = first ? (u32x4){0u, 0u, 0u, 0u} : *(const u32x4*)(MG + (size_t)(row0 + ai * 128 + m * 16) * D + mcol0 + bj * 128); }
#pragma unroll
            for (int m = 0; m < 4; ++m) { bf16* mrow = MG + (size_t)(row0 + ai * 128 + m * 16) * D + mcol0;
#pragma unroll
                for (int bj = 0; bj < 2; ++bj) { const f32x4 v0 = acc[ai][bj][m][0], v1 = acc[ai][bj][m][1];
                    float g[8], pm[8]; unpack8(gw[m][bj], g); unpack8(mw[m][bj], pm);
                    u32x4 w; w.x = cvt_pk_bf16(pm[0] + sigmoidf_(g[0]) * v0[0], pm[1] + sigmoidf_(g[1]) * v0[1]); w.y = cvt_pk_bf16(pm[2] + sigmoidf_(g[2]) * v0[2], pm[3] + sigmoidf_(g[3]) * v0[3]);
                    w.z = cvt_pk_bf16(pm[4] + sigmoidf_(g[4]) * v1[0], pm[5] + sigmoidf_(g[5]) * v1[1]); w.w = cvt_pk_bf16(pm[6] + sigmoidf_(g[6]) * v1[2], pm[7] + sigmoidf_(g[7]) * v1[3]);
                    *(u32x4*)(mrow + bj * 128) = w; } }
        }
    }
};
struct EpiRes {
    static constexpr bool PERM = true;
    const float* res32; const bf16* res16; bf16* out;
    __device__ __forceinline__ void operator()(const f32x4 (&acc)[2][2][4][2], const Unit& u, int wr, int wc, int fr, int fq) const {
        const int row0 = u.r0 + wr * 64 + fr, col0 = u.c0 + wc * 32 + 8 * fq;
#pragma unroll
        for (int ai = 0; ai < 2; ++ai) {
            float r[4][2][8];
#pragma unroll
            for (int m = 0; m < 4; ++m)
#pragma unroll
                for (int bj = 0; bj < 2; ++bj) { const size_t ro = (size_t)(row0 + ai * 128 + m * 16) * D + col0 + bj * 128;
                    if (res32) { const f32x4 a = *(const f32x4*)(res32 + ro), b = *(const f32x4*)(res32 + ro + 4); r[m][bj][0] = a[0]; r[m][bj][1] = a[1]; r[m][bj][2] = a[2]; r[m][bj][3] = a[3]; r[m][bj][4] = b[0]; r[m][bj][5] = b[1]; r[m][bj][6] = b[2]; r[m][bj][7] = b[3]; }
                    else unpack8(*(const u32x4*)(res16 + ro), r[m][bj]); }
#pragma unroll
            for (int m = 0; m < 4; ++m)
#pragma unroll
                for (int bj = 0; bj < 2; ++bj) { const size_t ro = (size_t)(row0 + ai * 128 + m * 16) * D + col0 + bj * 128; const f32x4 v0 = acc[ai][bj][m][0], v1 = acc[ai][bj][m][1];
                    u32x4 w; w.x = cvt_pk_bf16(r[m][bj][0] + v0[0], r[m][bj][1] + v0[1]); w.y = cvt_pk_bf16(r[m][bj][2] + v0[2], r[m][bj][3] + v0[3]);
                    w.z = cvt_pk_bf16(r[m][bj][4] + v1[0], r[m][bj][5] + v1[1]); w.w = cvt_pk_bf16(r[m][bj][6] + v1[2], r[m][bj][7] + v1[3]);
                    *(u32x4*)(out + ro) = w; }
        }
    }
};
struct EpiSwiglu {
    static constexpr bool PERM = true;
    bf16* O;
    __device__ __forceinline__ void operator()(const f32x4 (&acc)[2][2][4][2], const Unit& u, int wr, int wc, int fr, int fq) const {
        const int row0 = u.r0 + wr * 64 + fr, col0 = u.c0 + wc * 32 + 8 * fq;
#pragma unroll
        for (int ai = 0; ai < 2; ++ai)
#pragma unroll
            for (int m = 0; m < 4; ++m) { bf16* rowp = O + (size_t)(row0 + ai * 128 + m * 16) * DE + col0;
                const f32x4 g0 = acc[ai][0][m][0], g1 = acc[ai][0][m][1], u0 = acc[ai][1][m][0], u1 = acc[ai][1][m][1];
                u32x4 w; w.x = cvt_pk_bf16(siluf_(g0[0]) * u0[0], siluf_(g0[1]) * u0[1]); w.y = cvt_pk_bf16(siluf_(g0[2]) * u0[2], siluf_(g0[3]) * u0[3]);
                w.z = cvt_pk_bf16(siluf_(g1[0]) * u1[0], siluf_(g1[1]) * u1[1]); w.w = cvt_pk_bf16(siluf_(g1[2]) * u1[2], siluf_(g1[3]) * u1[3]);
                *(u32x4*)rowp = w; }
    }
};
struct EpiScatter {
    static constexpr bool PERM = true;
    bf16* Y; const int* row_code; const float* row_w;
    __device__ __forceinline__ void operator()(const f32x4 (&acc)[2][2][4][2], const Unit& u, int wr, int wc, int fr, int fq) const {
        const int row0 = u.r0 + wr * 64 + fr, col0 = u.c0 + wc * 32 + 8 * fq;
#pragma unroll
        for (int ai = 0; ai < 2; ++ai)
#pragma unroll
            for (int m = 0; m < 4; ++m) { const int row = row0 + ai * 128 + m * 16; const int code = row_code[row]; const float rw = row_w[row];
                if (code >= 0) { bf16* rowp = Y + (size_t)(code & 1) * ((size_t)M * D) + (size_t)(code >> 1) * D + col0;
#pragma unroll
                    for (int bj = 0; bj < 2; ++bj) { const f32x4 v0 = acc[ai][bj][m][0] * rw, v1 = acc[ai][bj][m][1] * rw;
                        u32x4 w; w.x = cvt_pk_bf16(v0[0], v0[1]); w.y = cvt_pk_bf16(v0[2], v0[3]); w.z = cvt_pk_bf16(v1[0], v1[1]); w.w = cvt_pk_bf16(v1[2], v1[3]);
                        *(u32x4*)(rowp + bj * 128) = w; } } }
    }
};

struct SchedH {
    pg8::TileOrder to; const char* A; const char* B;
    __device__ __forceinline__ bool next(int i, Unit& u) const { int pm, pn; if (!to.next(i, pm, pn)) return false;
        u.A = A + (size_t)pm * 256 * D * 2; u.B = B + (size_t)pn * 256 * D * 2; u.r0 = pm * 256; u.c0 = pn * 256; return true; }
};
struct SchedBranch {
    pg8::TileOrder to; const char* YS; const char* WBR;
    __device__ __forceinline__ bool next(int i, Unit& u) const { int pm, q; if (!to.next(i >> 2, pm, q)) return false; const int br = i & 3;
        u.A = YS + ((size_t)pm * 256 * 2048 + br * 512) * 2; u.B = WBR + ((size_t)br * D * 512 + (size_t)q * 256 * 512) * 2; u.r0 = pm * 256; u.c0 = br * 1024 + q * 256; return true; }
};
struct SchedOut {
    pg8::TileOrder to; const char* A; const char* B;
    __device__ __forceinline__ bool next(int i, Unit& u) const { int pm, pn; if (!to.next(i, pm, pn)) return false;
        u.A = A + (size_t)pm * 256 * D * 2; u.B = B + (size_t)pn * 256 * D * 2; u.r0 = pm * 256; u.c0 = pn * 256; return true; }
};
struct SchedMoe {
    int nux, nrank, rank, nk, x, NX; const LAS int* cum; const LAS int* rb0; const char* A; size_t a_blk; const char* W; size_t w_e, w_pn; int cmul;
    __device__ __forceinline__ bool next(int i, Unit& u) const { const int ui = i * nrank + rank; if (ui >= nux) return false;
        int k = 0; while (k + 1 < nk && cum[k + 1] <= ui) ++k;
        const int local = ui - cum[k], rb = rb0[k] + (local >> 2), pn = local & 3, e = x + NX * k;
        u.A = A + (size_t)rb * a_blk; u.B = W + (size_t)e * w_e + (size_t)pn * w_pn; u.r0 = rb * 256; u.c0 = pn * cmul; return true; }
};

struct Params { const float* in[25]; float* out; unsigned char* ws; int ph_lo, ph_hi; };
enum { I_X = 0, I_MIXNW, I_WIN, I_GCONV, I_GALOG, I_GDT, I_GNW, I_CCW, I_CCB, I_CLNW, I_CLNB, I_GLNW, I_GLNB, I_GWS, I_GBS, I_SCW, I_WBR, I_WOUT, I_MOENW, I_RGRP, I_REXP, I_WG, I_WU, I_WD, I_FNW };
constexpr int PH_PER_LAYER = 12, PH_FINAL = 24, PH_TOTAL = 25;
#define TSF(slot, cond) do { if (TP_A >= 0 && blockIdx.x == 0 && tid == 0 && (cond)) __hip_atomic_store((unsigned long long*)(p.ws + WS_CTL + 131072) + (slot), (unsigned long long)__builtin_amdgcn_s_memrealtime(), __ATOMIC_RELAXED, __HIP_MEMORY_SCOPE_AGENT); } while (0)

__device__ __forceinline__ void transpose_item(const float* __restrict__ W, int ldw, int srccol, bf16* __restrict__ WT, int ldt, int k0, int n0, int lane) {
    const int kq = lane & 7, nq = lane >> 3;
    f32x4 v[8][2];
#pragma unroll
    for (int r = 0; r < 8; ++r) { const float* s = W + (size_t)(k0 + 8 * kq + r) * ldw + srccol + 8 * nq; v[r][0] = *(const f32x4*)s; v[r][1] = *(const f32x4*)(s + 4); }
#pragma unroll
    for (int e = 0; e < 8; ++e) { u32x4 o; o.x = pk2(v[0][e >> 2][e & 3], v[1][e >> 2][e & 3]); o.y = pk2(v[2][e >> 2][e & 3], v[3][e >> 2][e & 3]); o.z = pk2(v[4][e >> 2][e & 3], v[5][e >> 2][e & 3]); o.w = pk2(v[6][e >> 2][e & 3], v[7][e >> 2][e & 3]);
        *(u32x4*)(WT + (size_t)(n0 + 8 * nq + e) * ldt + k0 + 8 * kq) = o; }
}
__device__ __forceinline__ void prep_static_weights(const Params& p, int gw, int NGW, int lane) {
    constexpr int I_IN = 16 * (DH / 64), I_BR = 8 * 16, I_OUT = 16 * 16, PER_L = I_IN + 4 * I_BR + I_OUT;
    for (int it = gw; it < NLAYER * PER_L; it += NGW) {
        const int l = it / PER_L; int r = it % PER_L;
        if (r < I_IN) { const int kb = r / (DH / 64), nb = r % (DH / 64), n0 = nb * 64;
            transpose_item(p.in[I_WIN] + (size_t)l * D * DIN, DIN, n0 + (n0 >= 2048 ? 8 : 0), (bf16*)(p.ws + WS_WIN + l * WIN_L), D, kb * 64, n0, lane); continue; }
        r -= I_IN;
        if (r < 4 * I_BR) { const int br = r / I_BR, q = r % I_BR, kb = q / 16, nb = q % 16;
            transpose_item(p.in[I_WBR] + ((size_t)l * 4 + br) * 512 * D, D, nb * 64, (bf16*)(p.ws + WS_WBR + l * WBR_L) + (size_t)br * D * 512, 512, kb * 64, nb * 64, lane); continue; }
        r -= 4 * I_BR;
        { const int kb = r / 16, nb = r % 16;
            transpose_item(p.in[I_WOUT] + (size_t)l * D * D, D, nb * 64, (bf16*)(p.ws + WS_WOUT + l * WOUT_L), D, kb * 64, nb * 64, lane); }
    }
}
__device__ __forceinline__ void prep_moe_weights(const Params& p, int layer, int gw, int NGW, int lane) {
    constexpr int I_GU = 16 * 16, I_D = 8 * 16, PER_E = I_GU + I_D;
    for (int it = gw; it < NE * PER_E; it += NGW) {
        const int e = it / PER_E; int r = it % PER_E;
        if (r < I_GU) { const int kb = r / 16, nb = r % 16, n0 = nb * 64, pn = n0 >> 8, half = (n0 >> 7) & 1, j0 = n0 & 127;
            const float* src = p.in[half ? I_WU : I_WG] + ((size_t)layer * NE + e) * D * DE;
            transpose_item(src, DE, 128 * pn + j0, (bf16*)(p.ws + WS_MOEW + e * WGU_E), D, kb * 64, n0, lane); continue; }
        r -= I_GU;
        { const int kb = r / 16, nb = r % 16;
            transpose_item(p.in[I_WD] + ((size_t)layer * NE + e) * DE * D, D, nb * 64, (bf16*)(p.ws + WS_WD + e * WD_E), DE, kb * 64, nb * 64, lane); }
    }
}

template <int MODE>
__device__ __forceinline__ void norm_phase(const Params& p, int layer, LAS unsigned char* lds, int gw, int NGW, int tid, int lane) {
    const float* nwp = (MODE == 2) ? p.in[I_FNW] : p.in[I_MIXNW] + layer * D;
    f32x4 nw[4];
#pragma unroll
    for (int j = 0; j < 4; ++j) nw[j] = *(const f32x4*)(nwp + 4 * lane + 256 * j);
    f32x4 ws0[16], ws1[16];
    if (MODE != 2) { const float* wi = p.in[I_WIN] + (size_t)layer * D * DIN + 2048;
#pragma unroll
        for (int j = 0; j < 4; ++j)
#pragma unroll
            for (int c = 0; c < 4; ++c) { const float* wr = wi + (size_t)(4 * lane + 256 * j + c) * DIN; ws0[j * 4 + c] = *(const f32x4*)wr; ws1[j * 4 + c] = *(const f32x4*)(wr + 4); } }
    const bf16* Y0 = (const bf16*)(p.ws + WS_Y); const bf16* Y1 = Y0 + (size_t)M * D;
    bf16* XN = (bf16*)(p.ws + WS_XN); float* SMALL = (float*)(p.ws + WS_SMALL);
    const float* xbase = p.in[I_X]; const bf16* xb16 = (const bf16*)(p.ws + WS_X1B); bf16* x2b = (bf16*)p.out;
    f32x4 vn[4]; u32x2 an[4], bn[4], xn16[4];
#define NP_LOAD(mm) do { _Pragma("unroll") for (int j = 0; j < 4; ++j) { \
        if (MODE == 0) vn[j] = *(const f32x4*)(xbase + (size_t)(mm) * D + 4 * lane + 256 * j); \
        else { xn16[j] = *(const u32x2*)(xb16 + (size_t)(mm) * D + 4 * lane + 256 * j); an[j] = *(const u32x2*)(Y0 + (size_t)(mm) * D + 4 * lane + 256 * j); bn[j] = *(const u32x2*)(Y1 + (size_t)(mm) * D + 4 * lane + 256 * j); } } } while (0)
    if (gw < M) NP_LOAD(gw);
    for (int m = gw; m < M; m += NGW) {
        f32x4 v[4]; float ss = 0.f;
#pragma unroll
        for (int j = 0; j < 4; ++j) {
            if (MODE == 0) v[j] = vn[j];
            else { v[j][0] = bf_lo(xn16[j].x) + bf_lo(an[j].x) + bf_lo(bn[j].x); v[j][1] = bf_hi(xn16[j].x) + bf_hi(an[j].x) + bf_hi(bn[j].x); v[j][2] = bf_lo(xn16[j].y) + bf_lo(an[j].y) + bf_lo(bn[j].y); v[j][3] = bf_hi(xn16[j].y) + bf_hi(an[j].y) + bf_hi(bn[j].y); } }
        if (m + NGW < M) NP_LOAD(m + NGW);
#pragma unroll
        for (int j = 0; j < 4; ++j) ss += (v[j][0] * v[j][0] + v[j][1] * v[j][1]) + (v[j][2] * v[j][2] + v[j][3] * v[j][3]);
        const float rs = __builtin_amdgcn_rsqf(wave_sum(ss) * (1.0f / D) + EPS);
        if (MODE == 2) {
#pragma unroll
            for (int j = 0; j < 4; ++j) *(f32x4*)(p.out + (size_t)m * D + 4 * lane + 256 * j) = v[j] * rs * nw[j];
            continue;
        }
        if (MODE == 1) {
#pragma unroll
            for (int j = 0; j < 4; ++j) { u32x2 o; o.x = pk2(v[j][0], v[j][1]); o.y = pk2(v[j][2], v[j][3]); *(u32x2*)(x2b + (size_t)m * D + 4 * lane + 256 * j) = o; }
        }
        f32x4 s0 = (f32x4){0.f, 0.f, 0.f, 0.f}, s1 = s0;
#pragma unroll
        for (int j = 0; j < 4; ++j) { v[j] = v[j] * rs * nw[j];
            u32x2 o; o.x = pk2(v[j][0], v[j][1]); o.y = pk2(v[j][2], v[j][3]); *(u32x2*)(XN + (size_t)m * D + 4 * lane + 256 * j) = o;
#pragma unroll
            for (int c = 0; c < 4; ++c) { s0 += ws0[j * 4 + c] * v[j][c]; s1 += ws1[j * 4 + c] * v[j][c]; } }
        const bool b0 = lane & 1, b1 = lane & 2, b2 = lane & 4;
        f32x4 a;
#pragma unroll
        for (int i = 0; i < 4; ++i) { const float send = b0 ? s0[i] : s1[i]; const float recv = __shfl_xor(send, 1); a[i] = (b0 ? s1[i] : s0[i]) + recv; }
        float bb[2];
#pragma unroll
        for (int i = 0; i < 2; ++i) { const float send = b1 ? a[i] : a[2 + i]; const float recv = __shfl_xor(send, 2); bb[i] = (b1 ? a[2 + i] : a[i]) + recv; }
        float cc; { const float send = b2 ? bb[0] : bb[1]; const float recv = __shfl_xor(send, 4); cc = (b2 ? bb[1] : bb[0]) + recv; }
        cc += __shfl_xor(cc, 8); cc += __shfl_xor(cc, 16); cc += __shfl_xor(cc, 32);
        if (lane < 8) SMALL[(size_t)m * 8 + ((lane >> 2) & 1) + 2 * ((lane >> 1) & 1) + 4 * (lane & 1)] = cc;
    }
#undef NP_LOAD
    lds_sync();
}

struct ScW { float w[3][8]; };
__device__ __forceinline__ void shortconv_unit(const Params& p, const ScW& cw, int tid, int unit) {
    const bf16* H = (const bf16*)(p.ws + WS_H); bf16* YS = (bf16*)(p.ws + WS_YS);
    const int c8 = (tid & 63) * 8, m0 = unit * 64 + (tid >> 6) * 8, t0 = m0 & (T - 1);
    const bf16* base = H + (size_t)m0 * DH + HSC + c8;
    u32x4 rc[10], rx[10], rb[8];
#pragma unroll
    for (int r = 0; r < 10; ++r) { const bool ok = (r >= 2) || (t0 != 0); const bf16* s = base + (ptrdiff_t)(ok ? r - 2 : 0) * DH; rc[r] = *(const u32x4*)(s + 512); rx[r] = *(const u32x4*)(s + 1024); if (!ok) rc[r] = (u32x4){0u, 0u, 0u, 0u}; }
#pragma unroll
    for (int r = 0; r < 8; ++r) rb[r] = *(const u32x4*)(base + (size_t)r * DH);
    float cx[10][8];
#pragma unroll
    for (int r = 0; r < 10; ++r) { float cg[8], xv[8]; unpack8(rc[r], cg); unpack8(rx[r], xv);
#pragma unroll
        for (int i = 0; i < 8; ++i) cx[r][i] = cg[i] * xv[i]; }
#pragma unroll
    for (int r = 0; r < 8; ++r) { float bg[8], acc[8]; unpack8(rb[r], bg);
#pragma unroll
        for (int i = 0; i < 8; ++i) acc[i] = bg[i] * (cw.w[0][i] * cx[r][i] + cw.w[1][i] * cx[r + 1][i] + cw.w[2][i] * cx[r + 2][i]);
        *(u32x4*)(YS + (size_t)(m0 + r) * 2048 + 1536 + c8) = pack8(acc); }
}
__device__ __forceinline__ int queue_pop(unsigned* counter, LAS unsigned char* lds, int tid) {
    LAS int* slot = (LAS int*)(lds + LDSCTL_OFF + LC_MISC);
    lds_sync();
    if (tid == 0) slot[0] = (int)__hip_atomic_fetch_add(counter, 1u, __ATOMIC_RELAXED, __HIP_MEMORY_SCOPE_AGENT);
    lds_sync();
    return slot[0];
}
__device__ __forceinline__ void conformer(const Params& p, int layer, LAS unsigned char* lds, int tid, int wave, int lane, unsigned* counter) {
    const bf16* H = (const bf16*)(p.ws + WS_H); bf16* YS = (bf16*)(p.ws + WS_YS);
    LAS bf16* yt = (LAS bf16*)lds;
    LAS float* zt = (LAS float*)(lds + 98304);
    const float* cwp = p.in[I_CCW] + (size_t)layer * 31 * 512;
    float cw[31];
#pragma unroll
    for (int j = 0; j < 31; ++j) cw[j] = cwp[j * 512 + tid];
    const float cb = p.in[I_CCB][layer * 512 + tid];
    float lw[8], lb[8];
#pragma unroll
    for (int i = 0; i < 8; ++i) { lw[i] = p.in[I_CLNW][layer * 512 + lane * 8 + i]; lb[i] = p.in[I_CLNB][layer * 512 + lane * 8 + i]; }
    for (;;) {
        const int unit = queue_pop(counter, lds, tid); if (unit >= M / 64) break;
        const int m0 = unit * 64, t0 = m0 & (T - 1);
        for (int base = 0; base < 94 * 64; base += 512 * 4) {
            u32x4 ra[4], rg[4];
#pragma unroll
            for (int k = 0; k < 4; ++k) { const int it = base + k * 512 + tid; const int r = it >> 6, c8 = (it & 63) * 8, dt = r - 30; const bool ok = (it < 94 * 64) && (t0 + dt >= 0);
                const bf16* s = H + (size_t)(ok ? m0 + dt : m0) * DH + HCONF + c8; ra[k] = *(const u32x4*)s; rg[k] = *(const u32x4*)(s + 512); }
#pragma unroll
            for (int k = 0; k < 4; ++k) { const int it = base + k * 512 + tid; const int r = it >> 6, c8 = (it & 63) * 8, dt = r - 30;
                if (it < 94 * 64) { u32x4 o = (u32x4){0u, 0u, 0u, 0u};
                    if (t0 + dt >= 0) { float a[8], g[8]; unpack8(ra[k], a); unpack8(rg[k], g);
#pragma unroll
                        for (int i = 0; i < 8; ++i) a[i] *= sigmoidf_(g[i]);
                        o = pack8(a); }
                    *(LAS u32x4*)(yt + r * 512 + c8) = o; } }
        }
        lds_sync();
        for (int sb = 0; sb < 8; ++sb) {
            LAS float* zb = zt + (sb & 1) * 4096;
            float z[8];
#pragma unroll
            for (int i = 0; i < 8; ++i) z[i] = cb;
#pragma unroll
            for (int r = 0; r < 38; ++r) { const float yv = bf2f(yt[(sb * 8 + r) * 512 + tid]);
#pragma unroll
                for (int i = 0; i < 8; ++i) { const int j = r - i; if (j >= 0 && j < 31) z[i] += cw[j] * yv; } }
#pragma unroll
            for (int i = 0; i < 8; ++i) zb[i * 512 + tid] = z[i];
            lds_sync();
            { const LAS float* zr = zb + wave * 512 + lane * 8; float v[8]; const f32x4 a = *(const LAS f32x4*)zr, b = *(const LAS f32x4*)(zr + 4);
                v[0] = a[0]; v[1] = a[1]; v[2] = a[2]; v[3] = a[3]; v[4] = b[0]; v[5] = b[1]; v[6] = b[2]; v[7] = b[3];
                float s = 0.f;
#pragma unroll
                for (int i = 0; i < 8; ++i) s += v[i];
                const float mean = wave_sum(s) * (1.0f / 512.0f); float q = 0.f;
#pragma unroll
                for (int i = 0; i < 8; ++i) { v[i] -= mean; q += v[i] * v[i]; }
                const float rstd = __builtin_amdgcn_rsqf(wave_sum(q) * (1.0f / 512.0f) + EPS);
#pragma unroll
                for (int i = 0; i < 8; ++i) v[i] = siluf_(v[i] * rstd * lw[i] + lb[i]);
                *(u32x4*)(YS + (size_t)(m0 + sb * 8 + wave) * 2048 + 512 + lane * 8) = pack8(v); }
        }
    }
}
__device__ __forceinline__ f32x4 mfma16(bf16x8 a, bf16x8 b, f32x4 c) { return __builtin_amdgcn_mfma_f32_16x16x32_bf16(a, b, c, 0, 0, 0); }
typedef short bf16x4 __attribute__((ext_vector_type(4)));
__device__ __forceinline__ bf16x8 ld_frag16(const LAS unsigned char* p) { return *(const LAS bf16x8*)p; }
__device__ __forceinline__ bf16x8 ld_frag8x2(const LAS unsigned char* p) { const bf16x4 a = *(const LAS bf16x4*)p, b = *(const LAS bf16x4*)(p + 32); return __builtin_shufflevector(a, b, 0, 1, 2, 3, 4, 5, 6, 7); }
__device__ __forceinline__ bf16x8 pack_frag(const f32x4 lo, const f32x4 hi) { u32x4 w; w.x = cvt_pk_bf16(lo[0], lo[1]); w.y = cvt_pk_bf16(lo[2], lo[3]); w.z = cvt_pk_bf16(hi[0], hi[1]); w.w = cvt_pk_bf16(hi[2], hi[3]); return __builtin_bit_cast(bf16x8, w); }
constexpr int GM_W = 0, GM_VT = 34816, GM_ST = 69632;
__device__ __forceinline__ void gmlp(const Params& p, int layer, LAS unsigned char* lds, int tid, int wave, int lane, unsigned* counter) {
    const bf16* H = (const bf16*)(p.ws + WS_H); bf16* YS = (bf16*)(p.ws + WS_YS);
    LAS float* st = (LAS float*)(lds + GM_ST);
    const float* lnw = p.in[I_GLNW] + layer * 512; const float* lnb = p.in[I_GLNB] + layer * 512;
    const int q = lane >> 4, li = lane & 15;
    for (;;) {
        const int unit = queue_pop(counter, lds, tid); if (unit >= M / 128) break;
        const int m0 = unit * 128;
        u32x4 rv[16];
#pragma unroll
        for (int k = 0; k < 16; ++k) rv[k] = *(const u32x4*)(H + (size_t)(m0 + wave * 16 + k) * DH + HGMLP + 512 + lane * 8);
#pragma unroll
        for (int k = 0; k < 16; ++k) { const int tk = wave * 16 + k;
            float v[8]; unpack8(rv[k], v);
            float s = 0.f;
#pragma unroll
            for (int i = 0; i < 8; ++i) { v[i] = gelu_tanh(v[i]); s += v[i]; }
            const float mean = wave_sum(s) * (1.0f / 512.0f); float qq = 0.f;
#pragma unroll
            for (int i = 0; i < 8; ++i) { const float d = v[i] - mean; qq += d * d; }
            const float rstd = 1.0f / sqrtf(wave_sum(qq) * (1.0f / 512.0f) + EPS);
            if (lane == 0) { st[tk * 2] = mean; st[tk * 2 + 1] = rstd; }
        }
        lds_sync();
        for (int g = 0; g < 4; ++g) {
            u32x4 rg[4];
#pragma unroll
            for (int k = 0; k < 4; ++k) { const int it = tid + 512 * k; rg[k] = *(const u32x4*)(H + (size_t)(m0 + (it >> 4)) * DH + HGMLP + 512 + g * 128 + (it & 15) * 8); }
#pragma unroll
            for (int k = 0; k < 4; ++k) { const int it = tid + 512 * k; const int tk = it >> 4, c8 = (it & 15) * 8;
                float v[8]; unpack8(rg[k], v);
                const float mean = st[tk * 2], rstd = st[tk * 2 + 1];
#pragma unroll
                for (int i = 0; i < 8; ++i) *(LAS bf16*)(lds + GM_VT + (c8 + i) * 272 + 2 * tk) = (bf16)f2bf((gelu_tanh(v[i]) - mean) * rstd * lnw[g * 128 + c8 + i] + lnb[g * 128 + c8 + i]); }
            const float* ws = p.in[I_GWS] + ((size_t)layer * 4 + g) * 128 * 128;
            f32x4 wa[4], wb[4];
#pragma unroll
            for (int k = 0; k < 4; ++k) { const int it = tid + 512 * k; wa[k] = *(const f32x4*)(ws + (it >> 4) * 128 + (it & 15) * 8); wb[k] = *(const f32x4*)(ws + (it >> 4) * 128 + (it & 15) * 8 + 4); }
#pragma unroll
            for (int k = 0; k < 4; ++k) { const int it = tid + 512 * k; const int i = it >> 4, j8 = (it & 15) * 8;
                const f32x4 a = wa[k], b = wb[k];
                float w[8] = {a[0], a[1], a[2], a[3], b[0], b[1], b[2], b[3]};
#pragma unroll
                for (int e = 0; e < 8; ++e) w[e] = (j8 + e <= i) ? w[e] : 0.f;
                *(LAS u32x4*)(lds + GM_W + i * 272 + j8 * 2) = pack8(w); }
            lds_sync();
            {
                f32x4 acc[8];
#pragma unroll
                for (int ct = 0; ct < 8; ++ct) acc[ct] = (f32x4){0.f, 0.f, 0.f, 0.f};
                const int nks = (wave >> 1) + 1;
                for (int ks = 0; ks < nks; ++ks) { const bf16x8 wf = ld_frag16(lds + GM_W + (16 * wave + li) * 272 + (32 * ks + 8 * q) * 2);
#pragma unroll
                    for (int ct = 0; ct < 8; ++ct) acc[ct] = mfma16(ld_frag16(lds + GM_VT + (16 * ct + li) * 272 + (32 * ks + 8 * q) * 2), wf, acc[ct]); }
                const int i = 16 * wave + li; const float bs = p.in[I_GBS][((size_t)layer * 4 + g) * 128 + i];
                const bf16* urow = H + (size_t)(m0 + i) * DH + HGMLP + g * 128 + 4 * q; bf16* orow = YS + (size_t)(m0 + i) * 2048 + 1024 + g * 128 + 4 * q;
#pragma unroll
                for (int ct = 0; ct < 8; ++ct) { const u32x2 uw = *(const u32x2*)(urow + 16 * ct);
                    const float o0 = gelu_tanh(bf_lo(uw.x)) * (acc[ct][0] + bs), o1 = gelu_tanh(bf_hi(uw.x)) * (acc[ct][1] + bs), o2 = gelu_tanh(bf_lo(uw.y)) * (acc[ct][2] + bs), o3 = gelu_tanh(bf_hi(uw.y)) * (acc[ct][3] + bs);
                    u32x2 ow; ow.x = pk2(o0, o1); ow.y = pk2(o2, o3); *(u32x2*)(orow + 16 * ct) = ow; }
            }
            lds_sync();
        }
    }
}
constexpr int CP_QN = 0, CP_KN = 17408, CP_KT = 34816, CP_VT = 53248, CP_KGT = 71680, CP_A32 = 90112, CP_ATT = 106496, CP_T16 = 115712, CP_TAB = 124928;
__device__ __forceinline__ void gdn_chunk_prep(const Params& p, int layer, LAS unsigned char* lds, int tid, int wave, int lane) {
    const bf16* H = (const bf16*)(p.ws + WS_H); const float* SMALL = (const float*)(p.ws + WS_SMALL);
    const float* cw = p.in[I_GCONV] + (size_t)layer * 4 * 1536;
    LAS float* tab = (LAS float*)(lds + CP_TAB);
    const int q = lane >> 4, li = lane & 15;
    for (int unit = blockIdx.x; unit < 2048; unit += gridDim.x) {
        const int n = unit & 63, hh = (unit >> 6) & 3, b = unit >> 8; const int m0 = b * T + n * 64;
        unsigned char* rec = p.ws + WS_REC + (size_t)((b * 4 + hh) * 64 + n) * REC_BYTES;
        const int i0 = wave * 8, t0 = n * 64 + i0;
        unsigned raw[3][11];
#pragma unroll
        for (int s = 0; s < 3; ++s)
#pragma unroll
            for (int r = 0; r < 11; ++r) raw[s][r] = (t0 - 3 + r >= 0) ? *(const unsigned*)(H + (size_t)(m0 + i0 - 3 + r) * DH + s * 512 + hh * 128 + 2 * lane) : 0u;
        float w0[3][4], w1[3][4];
#pragma unroll
        for (int s = 0; s < 3; ++s)
#pragma unroll
            for (int j = 0; j < 4; ++j) { const f32x2 ww = *(const f32x2*)(cw + j * 1536 + s * 512 + hh * 128 + 2 * lane); w0[s][j] = ww[0]; w1[s][j] = ww[1]; }
        lds_sync();
        if (wave == 0) { const int m = m0 + lane; const float br = SMALL[(size_t)m * 8 + hh], ar = SMALL[(size_t)m * 8 + 4 + hh];
            float g = -__expf(p.in[I_GALOG][layer * 4 + hh]) * softplusf_(ar + p.in[I_GDT][layer * 4 + hh]);
#pragma unroll
            for (int o = 1; o < 64; o <<= 1) { const float t = __shfl_up(g, o); if (lane >= o) g += t; }
            tab[lane] = sigmoidf_(br); tab[64 + lane] = g; tab[128 + lane] = __expf(g); }
        lds_sync();
        {
            float tk[2][8], tv[2][8], tg[2][8];
#pragma unroll
            for (int ii = 0; ii < 8; ++ii) { const int i = i0 + ii;
                float y[3][2];
#pragma unroll
                for (int s = 0; s < 3; ++s) { float a0 = 0.f, a1 = 0.f;
#pragma unroll
                    for (int j = 0; j < 4; ++j) { a0 += w0[s][j] * bf_lo(raw[s][ii + j]); a1 += w1[s][j] * bf_hi(raw[s][ii + j]); }
                    y[s][0] = siluf_(a0); y[s][1] = siluf_(a1); }
                const float sq = wave_sum(y[0][0] * y[0][0] + y[0][1] * y[0][1]), sk = wave_sum(y[1][0] * y[1][0] + y[1][1] * y[1][1]);
                const float rq = 0.08838834764831845f * __builtin_amdgcn_rsqf(sq + EPS), rk = __builtin_amdgcn_rsqf(sk + EPS);
                const float be = tab[i], bg = be * tab[128 + i];
                const float k0 = y[1][0] * rk, k1 = y[1][1] * rk;
                *(LAS unsigned*)(lds + CP_QN + i * 272 + 4 * lane) = pk2(y[0][0] * rq, y[0][1] * rq);
                *(LAS unsigned*)(lds + CP_KN + i * 272 + 4 * lane) = pk2(k0, k1);
                tk[0][ii] = k0; tk[1][ii] = k1; tv[0][ii] = be * y[2][0]; tv[1][ii] = be * y[2][1]; tg[0][ii] = bg * k0; tg[1][ii] = bg * k1;
            }
#pragma unroll
            for (int c = 0; c < 2; ++c) {
                *(LAS u32x4*)(lds + CP_KT + (2 * lane + c) * 144 + 2 * i0) = pack8(tk[c]);
                *(LAS u32x4*)(lds + CP_VT + (2 * lane + c) * 144 + 2 * i0) = pack8(tv[c]);
                *(LAS u32x4*)(lds + CP_KGT + (2 * lane + c) * 144 + 2 * i0) = pack8(tg[c]);
            }
        }
        lds_sync();
        for (int jb = wave; jb < 32; jb += 8) { const int which = jb >> 4, mt = (jb >> 2) & 3, nt = jb & 3;
            f32x4 acc = (f32x4){0.f, 0.f, 0.f, 0.f};
            if (nt <= mt) {
#pragma unroll
                for (int ks = 0; ks < 4; ++ks) acc = mfma16(ld_frag16(lds + (which ? CP_QN : CP_KN) + (16 * mt + li) * 272 + (32 * ks + 8 * q) * 2), ld_frag16(lds + CP_KN + (16 * nt + li) * 272 + (32 * ks + 8 * q) * 2), acc);
            }
            const int j = 16 * nt + li; const float gj = tab[64 + j];
#pragma unroll
            for (int r = 0; r < 4; ++r) { const int i = 16 * mt + 4 * q + r; const float gi = tab[64 + i];
                if (which == 0) { ((LAS float*)(lds + CP_A32))[i * 64 + j] = (i > j) ? tab[i] * acc[r] * __expf(gi - gj) : 0.f; }
                else { *(LAS bf16*)(lds + CP_ATT + i * 144 + 2 * j) = (bf16)f2bf((i >= j) ? acc[r] * __expf(gi - gj) : 0.f); } }
        }
        lds_sync();
        if (wave == 0) {
            float Tc[64]; const float lanef = (float)lane;
            const LAS float* A = (const LAS float*)(lds + CP_A32); asm volatile("" : "+v"(A));
            LAS unsigned char* Tw = lds + CP_T16 + 2 * lane; asm volatile("" : "+v"(Tw));
#pragma unroll
            for (int i = 0; i < 64; ++i) { float a4[4] = {fmaxf(0.f, 1.f - fabsf((float)i - lanef)), 0.f, 0.f, 0.f};
#pragma unroll
                for (int j = 0; j < i; j += 4) { const f32x4 av = *(const LAS f32x4*)(A + i * 64 + j);
#pragma unroll
                    for (int jj = 0; jj < 4; ++jj) if (j + jj < i) a4[jj] -= av[jj] * Tc[j + jj]; }
                const float a = (a4[0] + a4[1]) + (a4[2] + a4[3]);
                Tc[i] = a; *(LAS bf16*)(Tw + i * 144) = (bf16)f2bf(a); }
        } else {
            const int t2 = tid - 64;
            for (int pc = t2; pc < 1024; pc += 448) { const int row = pc >> 4, seg = pc & 15; *(u32x4*)(rec + REC_Q + pc * 16) = *(const LAS u32x4*)(lds + CP_QN + row * 272 + seg * 16); }
            for (int pc = t2; pc < 512; pc += 448) { const int row = pc >> 3, seg = pc & 7; *(u32x4*)(rec + REC_ATT + pc * 16) = *(const LAS u32x4*)(lds + CP_ATT + row * 144 + seg * 16); }
            for (int pc = t2; pc < 1024; pc += 448) { const int row = pc >> 3, seg = pc & 7; *(u32x4*)(rec + REC_KT + pc * 16) = *(const LAS u32x4*)(lds + CP_KT + row * 144 + seg * 16); }
            if (t2 < 16) *(u32x4*)(rec + REC_G + t2 * 16) = *(const LAS u32x4*)(lds + CP_TAB + 256 + t2 * 16);
        }
        lds_sync();
        for (int jb = wave; jb < 64; jb += 8) {
            f32x4 acc = (f32x4){0.f, 0.f, 0.f, 0.f};
            if (jb < 32) { const int mt = jb >> 3, nt = jb & 7;
#pragma unroll
                for (int ks = 0; ks < 2; ++ks) acc = mfma16(ld_frag16(lds + CP_T16 + (16 * mt + li) * 144 + (32 * ks + 8 * q) * 2), ld_frag16(lds + CP_VT + (16 * nt + li) * 144 + (32 * ks + 8 * q) * 2), acc);
                u32x2 o; o.x = pk2(acc[0], acc[1]); o.y = pk2(acc[2], acc[3]);
                *(u32x2*)(rec + REC_U + (size_t)((nt * 64 + lane) * 4 + mt) * 8) = o;
            } else { const int mt = (jb - 32) >> 2, nt = (jb - 32) & 3;
#pragma unroll
                for (int ks = 0; ks < 2; ++ks) acc = mfma16(ld_frag16(lds + CP_KGT + (16 * mt + li) * 144 + (32 * ks + 8 * q) * 2), ld_frag16(lds + CP_T16 + (16 * nt + li) * 144 + (32 * ks + 8 * q) * 2), acc);
                u32x2 o; o.x = pk2(acc[0], acc[1]); o.y = pk2(acc[2], acc[3]);
                *(u32x2*)(rec + REC_W + (size_t)((16 * nt + li) * 128 + 16 * mt + 4 * q) * 2) = o;
            }
        }
    }
    lds_sync();
}
constexpr int SC_W = 0, SC_KT = 17408, SC_G = 35840, SC_BUF = 36096;
__device__ __forceinline__ void gdn_chunk_scan(const Params& p, LAS unsigned char* lds, int tid, int wave, int lane, int bh, int half) {
    const int q = lane >> 4, li = lane & 15, sl = half * 4 + (wave & 3);
    unsigned char* rec0 = p.ws + WS_REC + (size_t)(bh * 64) * REC_BYTES;
    u32x4* S0F = (u32x4*)(p.ws + WS_OBUF) + (size_t)(bh * 64) * 8 * 4 * 64;
    u32x4 pf[4], pfg = (u32x4){0u, 0u, 0u, 0u}, pu[2];
#define SC_LOAD(nn) do { const unsigned char* r_ = rec0 + (size_t)(nn) * REC_BYTES; \
        pf[0] = *(const u32x4*)(r_ + REC_W + (size_t)tid * 16); pf[1] = *(const u32x4*)(r_ + REC_W + (size_t)(tid + 512) * 16); \
        pf[2] = *(const u32x4*)(r_ + REC_KT + (size_t)tid * 16); pf[3] = *(const u32x4*)(r_ + REC_KT + (size_t)(tid + 512) * 16); \
        if (tid < 16) pfg = *(const u32x4*)(r_ + REC_G + tid * 16); \
        pu[0] = *(const u32x4*)(r_ + REC_U + (size_t)(sl * 64 + lane) * 32); pu[1] = *(const u32x4*)(r_ + REC_U + (size_t)(sl * 64 + lane) * 32 + 16); } while (0)
#define SC_STORE(buf) do { LAS unsigned char* d_ = lds + (buf) * SC_BUF; \
        _Pragma("unroll") for (int k_ = 0; k_ < 2; ++k_) { const int pc_ = tid + 512 * k_; *(LAS u32x4*)(d_ + SC_W + (pc_ >> 4) * 272 + (pc_ & 15) * 16) = pf[k_]; \
            *(LAS u32x4*)(d_ + SC_KT + (pc_ >> 3) * 144 + (pc_ & 7) * 16) = pf[2 + k_]; } \
        if (tid < 16) *(LAS u32x4*)(d_ + SC_G + tid * 16) = pfg; } while (0)
    f32x4 S[8];
#pragma unroll
    for (int i = 0; i < 8; ++i) S[i] = (f32x4){0.f, 0.f, 0.f, 0.f};
    lds_sync();
    SC_LOAD(0); SC_STORE(0);
    u32x4 cu[2]; cu[0] = pu[0]; cu[1] = pu[1];
    lds_sync();
    for (int n = 0; n < 64; ++n) {
        const LAS unsigned char* L = lds + (n & 1) * SC_BUF;
        if (n + 1 < 64) SC_LOAD(n + 1);
        if (wave < 4) {
            bf16x8 wf[4][4]; f32x4 gi[4];
#pragma unroll
            for (int mt = 0; mt < 4; ++mt)
#pragma unroll
                for (int ks = 0; ks < 4; ++ks) wf[mt][ks] = ld_frag8x2(L + SC_W + (16 * mt + li) * 272 + (32 * ks + 4 * q) * 2);
            const float g63 = *(const LAS float*)(L + SC_G + 63 * 4);
#pragma unroll
            for (int mt = 0; mt < 4; ++mt) gi[mt] = *(const LAS f32x4*)(L + SC_G + (16 * mt + 4 * q) * 4);
            __builtin_amdgcn_sched_barrier(0);
            bf16x8 Sb[4];
#pragma unroll
            for (int ks = 0; ks < 4; ++ks) { Sb[ks] = pack_frag(S[2 * ks], S[2 * ks + 1]); S0F[(size_t)((n * 8 + sl) * 4 + ks) * 64 + lane] = __builtin_bit_cast(u32x4, Sb[ks]); }
            f32x4 a1[4];
#pragma unroll
            for (int mt = 0; mt < 4; ++mt) a1[mt] = (f32x4){0.f, 0.f, 0.f, 0.f};
#pragma unroll
            for (int ks = 0; ks < 4; ++ks)
#pragma unroll
                for (int mt = 0; mt < 4; ++mt) a1[mt] = mfma16(wf[mt][ks], Sb[ks], a1[mt]);
            __builtin_amdgcn_sched_barrier(0);
            bf16x8 kf[8][2];
#pragma unroll
            for (int mt = 0; mt < 8; ++mt)
#pragma unroll
                for (int ks = 0; ks < 2; ++ks) kf[mt][ks] = ld_frag8x2(L + SC_KT + (16 * mt + li) * 144 + (32 * ks + 4 * q) * 2);
            const float eg = fexp(g63);
#pragma unroll
            for (int mt = 0; mt < 8; ++mt) S[mt] = S[mt] * eg;
            __builtin_amdgcn_sched_barrier(0);
            f32x4 vn[4], vd[4];
#pragma unroll
            for (int mt = 0; mt < 4; ++mt) {
                const unsigned ulo = (mt < 2) ? (mt == 0 ? cu[0].x : cu[0].z) : (mt == 2 ? cu[1].x : cu[1].z), uhi = (mt < 2) ? (mt == 0 ? cu[0].y : cu[0].w) : (mt == 2 ? cu[1].y : cu[1].w);
                const f32x4 uu = (f32x4){bf_lo(ulo), bf_hi(ulo), bf_lo(uhi), bf_hi(uhi)};
                vn[mt] = uu - a1[mt];
#pragma unroll
                for (int r = 0; r < 4; ++r) vd[mt][r] = vn[mt][r] * fexp(g63 - gi[mt][r]); }
            bf16x8 Vb[2], Vd[2];
#pragma unroll
            for (int ks = 0; ks < 2; ++ks) { Vb[ks] = pack_frag(vn[2 * ks], vn[2 * ks + 1]); Vd[ks] = pack_frag(vd[2 * ks], vd[2 * ks + 1]); }
            { unsigned char* ru = rec0 + (size_t)n * REC_BYTES + REC_U + (size_t)(sl * 64 + lane) * 32;
                *(u32x4*)ru = __builtin_bit_cast(u32x4, Vb[0]); *(u32x4*)(ru + 16) = __builtin_bit_cast(u32x4, Vb[1]); }
#pragma unroll
            for (int ks = 0; ks < 2; ++ks)
#pragma unroll
                for (int mt = 0; mt < 8; ++mt) S[mt] = mfma16(kf[mt][ks], Vd[ks], S[mt]);
        }
        if (n + 1 < 64) { SC_STORE((n + 1) & 1); cu[0] = pu[0]; cu[1] = pu[1]; }
        lds_sync();
    }
#undef SC_LOAD
#undef SC_STORE
}
constexpr int CO_Q = 0, CO_ATT = 17408, CO_G = 26624, CO_PART = 26880;
__device__ __forceinline__ void gdn_chunk_out(const Params& p, int layer, LAS unsigned char* lds, int tid, int wave, int lane) {
    const bf16* H = (const bf16*)(p.ws + WS_H); bf16* YS = (bf16*)(p.ws + WS_YS);
    const int q = lane >> 4, li = lane & 15;
    const f32x4 nw = *(const f32x4*)(p.in[I_GNW] + layer * 128 + 16 * wave + 4 * q);
    LAS float* part = (LAS float*)(lds + CO_PART);
    u32x4 rq0, rq1, ra, rg = (u32x4){0u, 0u, 0u, 0u}, sfw[4], vfw[2]; u32x2 zr[4];
#define CO_LOAD(uu) do { const int n_ = (uu) & 63, bh_ = (uu) >> 6, hh_ = bh_ & 3, b_ = bh_ >> 2; const int m0_ = b_ * T + n_ * 64; \
        const unsigned char* rec_ = p.ws + WS_REC + (size_t)(bh_ * 64 + n_) * REC_BYTES; \
        const u32x4* S0F_ = (const u32x4*)(p.ws + WS_OBUF) + (size_t)((bh_ * 64 + n_) * 8 + wave) * 4 * 64; \
        rq0 = *(const u32x4*)(rec_ + REC_Q + (size_t)tid * 16); rq1 = *(const u32x4*)(rec_ + REC_Q + (size_t)(tid + 512) * 16); ra = *(const u32x4*)(rec_ + REC_ATT + (size_t)tid * 16); \
        if (tid < 16) rg = *(const u32x4*)(rec_ + REC_G + tid * 16); \
        _Pragma("unroll") for (int ks = 0; ks < 4; ++ks) sfw[ks] = S0F_[ks * 64 + lane]; \
        vfw[0] = *(const u32x4*)(rec_ + REC_U + (size_t)(wave * 64 + lane) * 32); vfw[1] = *(const u32x4*)(rec_ + REC_U + (size_t)(wave * 64 + lane) * 32 + 16); \
        _Pragma("unroll") for (int mt = 0; mt < 4; ++mt) zr[mt] = *(const u32x2*)(H + (size_t)(m0_ + 16 * mt + li) * DH + HZ + hh_ * 128 + 16 * wave + 4 * q); } while (0)
    if ((int)blockIdx.x < 2048) CO_LOAD((int)blockIdx.x);
    for (int unit = blockIdx.x; unit < 2048; unit += gridDim.x) {
        const int n = unit & 63, bh = unit >> 6, hh = bh & 3, b = bh >> 2; const int m0 = b * T + n * 64;
        bf16x8 sf[4], vf[2]; u32x2 zc[4];
#pragma unroll
        for (int ks = 0; ks < 4; ++ks) sf[ks] = __builtin_bit_cast(bf16x8, sfw[ks]);
        vf[0] = __builtin_bit_cast(bf16x8, vfw[0]); vf[1] = __builtin_bit_cast(bf16x8, vfw[1]);
#pragma unroll
        for (int mt = 0; mt < 4; ++mt) zc[mt] = zr[mt];
        lds_sync();
        *(LAS u32x4*)(lds + CO_Q + (tid >> 4) * 272 + (tid & 15) * 16) = rq0; *(LAS u32x4*)(lds + CO_Q + ((tid + 512) >> 4) * 272 + (tid & 15) * 16) = rq1;
        *(LAS u32x4*)(lds + CO_ATT + (tid >> 3) * 144 + (tid & 7) * 16) = ra;
        if (tid < 16) *(LAS u32x4*)(lds + CO_G + tid * 16) = rg;
        if (unit + (int)gridDim.x < 2048) CO_LOAD(unit + (int)gridDim.x);
        lds_sync();
        f32x4 o[4]; float ss[4];
#pragma unroll
        for (int mt = 0; mt < 4; ++mt) { f32x4 a2 = (f32x4){0.f, 0.f, 0.f, 0.f}, a3 = (f32x4){0.f, 0.f, 0.f, 0.f};
#pragma unroll
            for (int ks = 0; ks < 4; ++ks) a2 = mfma16(sf[ks], ld_frag8x2(lds + CO_Q + (16 * mt + li) * 272 + (32 * ks + 4 * q) * 2), a2);
#pragma unroll
            for (int ks = 0; ks < 2; ++ks) a3 = mfma16(vf[ks], ld_frag8x2(lds + CO_ATT + (16 * mt + li) * 144 + (32 * ks + 4 * q) * 2), a3);
            const float gam = fexp(*(const LAS float*)(lds + CO_G + (16 * mt + li) * 4));
            o[mt] = a2 * gam + a3;
            float s = (o[mt][0] * o[mt][0] + o[mt][1] * o[mt][1]) + (o[mt][2] * o[mt][2] + o[mt][3] * o[mt][3]);
            s += __shfl_xor(s, 16); s += __shfl_xor(s, 32);
            if (q == 0) part[(16 * mt + li) * 8 + wave] = s; }
        lds_sync();
#pragma unroll
        for (int mt = 0; mt < 4; ++mt) { const f32x4 pa = *(const LAS f32x4*)(part + (16 * mt + li) * 8), pb = *(const LAS f32x4*)(part + (16 * mt + li) * 8 + 4);
            ss[mt] = ((pa[0] + pa[1]) + (pa[2] + pa[3])) + ((pb[0] + pb[1]) + (pb[2] + pb[3]));
            const float rs = __builtin_amdgcn_rsqf(ss[mt] * (1.0f / 128.0f) + EPS);
            u32x2 w; w.x = pk2(o[mt][0] * rs * nw[0] * siluf_(bf_lo(zc[mt].x)), o[mt][1] * rs * nw[1] * siluf_(bf_hi(zc[mt].x)));
            w.y = pk2(o[mt][2] * rs * nw[2] * siluf_(bf_lo(zc[mt].y)), o[mt][3] * rs * nw[3] * siluf_(bf_hi(zc[mt].y)));
            *(u32x2*)(YS + (size_t)(m0 + 16 * mt + li) * 2048 + hh * 128 + 16 * wave + 4 * q) = w; }
    }
#undef CO_LOAD
    lds_sync();
}
__device__ __forceinline__ void sum_gated(const Params& p, int gtid, int NGT) {
    const bf16* H = (const bf16*)(p.ws + WS_H); bf16* MG = (bf16*)(p.ws + WS_MERGED);
    for (int it = gtid; it < M * 128; it += NGT) { const int m = it >> 7, c8 = (it & 127) * 8; const bf16* r = H + (size_t)m * DH + HGATE + c8;
        float a[8], b[8];
        unpack8(*(const u32x4*)r, a);
#pragma unroll
        for (int br = 1; br < 4; ++br) { unpack8(*(const u32x4*)(r + br * 1024), b);
#pragma unroll
            for (int i = 0; i < 8; ++i) a[i] += b[i]; }
        *(u32x4*)(MG + (size_t)m * D + c8) = pack8(a); }
}

constexpr size_t WS_WRT = WS_MOETAB + MiB; constexpr int WRT_N = 80 * 1024;
__device__ __forceinline__ void prep_router_tables(const Params& p, int gtid, int NGT) {
    bf16* WRT = (bf16*)(p.ws + WS_WRT);
    for (int idx = gtid; idx < NLAYER * WRT_N; idx += NGT) { const int l = idx / WRT_N, n = (idx % WRT_N) >> 10, k = idx & 1023;
        const float w = (n < 64) ? p.in[I_REXP][((size_t)l * D + k) * 64 + n] : (n < 72 ? p.in[I_RGRP][((size_t)l * D + k) * 8 + (n - 64)] : 0.f);
        const unsigned hi = f2bf(w); const float wl = w - __uint_as_float(hi << 16);
        WRT[(size_t)(l * 2) * WRT_N + (idx % WRT_N)] = (bf16)hi; WRT[(size_t)(l * 2 + 1) * WRT_N + (idx % WRT_N)] = (bf16)f2bf(wl); }
}
__device__ __forceinline__ void moe_route_vb(const Params& p, int layer, LAS unsigned char* lds, int tid, int wave, int lane, int vb, const f32x4 (&nw)[4]) {
    LAS int* hist = (LAS int*)(lds + LDSCTL_OFF + LC_TAB);
    bf16* XN = (bf16*)(p.ws + WS_XN);
    int* route_e = (int*)(p.ws + WS_ROUTE); float* route_w = (float*)(p.ws + WS_ROUTE + (size_t)M * 2 * 4);
    int* cnt = (int*)(p.ws + WS_MOETAB + (size_t)NROWS_MAX * 8);
    const bf16* Wh = (const bf16*)(p.ws + WS_WRT) + (size_t)(layer * 2) * WRT_N; const bf16* Wl = Wh + WRT_N;
    const int q = lane >> 4, li = lane & 15;
    lds_sync();
    if (tid < 64) hist[tid] = 0;
    for (int tile = 0; tile < 4; ++tile) {
        const int m0 = vb * 128 + tile * 32;
        lds_sync();
        for (int hb = 0; hb < 2; ++hb) {
        f32x4 v[2][4];
#pragma unroll
        for (int rr = 0; rr < 2; ++rr)
#pragma unroll
            for (int j = 0; j < 4; ++j) { const u32x2 xw = *(const u32x2*)((const bf16*)(p.ws + WS_X1B) + (size_t)(m0 + wave * 4 + hb * 2 + rr) * D + 4 * lane + 256 * j); v[rr][j] = (f32x4){bf_lo(xw.x), bf_hi(xw.x), bf_lo(xw.y), bf_hi(xw.y)}; }
#pragma unroll
        for (int rr = 0; rr < 2; ++rr) { const int r = wave * 4 + hb * 2 + rr, m = m0 + r; float ss = 0.f;
#pragma unroll
            for (int j = 0; j < 4; ++j) ss += (v[rr][j][0] * v[rr][j][0] + v[rr][j][1] * v[rr][j][1]) + (v[rr][j][2] * v[rr][j][2] + v[rr][j][3] * v[rr][j][3]);
            const float rs = __builtin_amdgcn_rsqf(wave_sum(ss) * (1.0f / D) + EPS);
#pragma unroll
            for (int j = 0; j < 4; ++j) { const f32x4 x = v[rr][j] * rs * nw[j];
                u32x2 h; h.x = pk2(x[0], x[1]); h.y = pk2(x[2], x[3]);
                u32x2 l; l.x = pk2(x[0] - bf_lo(h.x), x[1] - bf_hi(h.x)); l.y = pk2(x[2] - bf_lo(h.y), x[3] - bf_hi(h.y));
                *(u32x2*)(XN + (size_t)m * D + 4 * lane + 256 * j) = h;
                const int off = r * 2048 + ((((lane >> 1) + 32 * j) ^ (r & 15)) << 4) + (lane & 1) * 8;
                *(LAS u32x2*)(lds + off) = h; *(LAS u32x2*)(lds + 65536 + off) = l; } }
        }
        lds_sync();
        f32x4 acc[2][5];
#pragma unroll
        for (int mt = 0; mt < 2; ++mt)
#pragma unroll
            for (int nt = 0; nt < 5; ++nt) acc[mt][nt] = (f32x4){0.f, 0.f, 0.f, 0.f};
        {
            const bf16* bp = Wh + (size_t)li * 1024 + 128 * wave + 8 * q;
#pragma unroll
            for (int ks = 0; ks < 4; ++ks) {
                bf16x8 ah[2], al[2];
#pragma unroll
                for (int mt = 0; mt < 2; ++mt) { const int off = (16 * mt + li) * 2048 + (((16 * wave + 4 * ks + q) ^ li) << 4); ah[mt] = ld_frag16(lds + off); al[mt] = ld_frag16(lds + 65536 + off); }
#pragma unroll
                for (int nt = 0; nt < 5; ++nt) { const bf16x8 bh = *(const bf16x8*)(bp + nt * 16384 + 32 * ks), bl = *(const bf16x8*)(bp + WRT_N + nt * 16384 + 32 * ks);
#pragma unroll
                    for (int mt = 0; mt < 2; ++mt) { acc[mt][nt] = mfma16(ah[mt], bh, acc[mt][nt]); acc[mt][nt] = mfma16(al[mt], bh, acc[mt][nt]); acc[mt][nt] = mfma16(ah[mt], bl, acc[mt][nt]); } }
            }
        }
        lds_sync();
        LAS float* part = (LAS float*)lds;
#pragma unroll
        for (int mt = 0; mt < 2; ++mt)
#pragma unroll
            for (int nt = 0; nt < 5; ++nt) { if (16 * nt + li < 72) {
#pragma unroll
                for (int r = 0; r < 4; ++r) part[(wave * 32 + 16 * mt + 4 * q + r) * 72 + 16 * nt + li] = acc[mt][nt][r]; } }
        lds_sync();
        for (int r = wave * 4; r < wave * 4 + 4; ++r) { const int m = m0 + r;
            float le = 0.f, lg = 0.f;
#pragma unroll
            for (int w = 0; w < 8; ++w) { le += part[(w * 32 + r) * 72 + lane]; lg += part[(w * 32 + r) * 72 + 64 + (lane & 7)]; }
            float gv[8];
#pragma unroll
            for (int i = 0; i < 8; ++i) gv[i] = __shfl(lg, i);
            int grp = 0; float gmax = gv[0];
#pragma unroll
            for (int i = 1; i < 8; ++i) if (gv[i] > gmax) { gmax = gv[i]; grp = i; }
            float gs = 0.f;
#pragma unroll
            for (int i = 0; i < 8; ++i) gs += __expf(gv[i] - gmax);
            const float psel = 1.0f / gs;
            float ev[8];
#pragma unroll
            for (int i = 0; i < 8; ++i) ev[i] = __shfl(le, grp * 8 + i);
            int i1 = 0; float e1 = ev[0];
#pragma unroll
            for (int i = 1; i < 8; ++i) if (ev[i] > e1) { e1 = ev[i]; i1 = i; }
            int i2 = -1; float e2 = -3.0e38f;
#pragma unroll
            for (int i = 0; i < 8; ++i) if (i != i1 && ev[i] > e2) { e2 = ev[i]; i2 = i; }
            const float x2 = __expf(e2 - e1), w1 = psel / (1.0f + x2), w2 = psel * x2 / (1.0f + x2);
            if (lane == 0) { route_e[(size_t)m * 2] = grp * 8 + i1; route_e[(size_t)m * 2 + 1] = grp * 8 + i2; route_w[(size_t)m * 2] = w1; route_w[(size_t)m * 2 + 1] = w2;
                atomicAdd((int*)(hist + grp * 8 + i1), 1); atomicAdd((int*)(hist + grp * 8 + i2), 1); }
        }
    }
    lds_sync();
    if (tid < 64) cnt[vb * 64 + tid] = hist[tid];
}
__device__ __forceinline__ void moe_route(const Params& p, int layer, LAS unsigned char* lds, int tid, int wave, int lane) {
    f32x4 nw[4];
#pragma unroll
    for (int j = 0; j < 4; ++j) nw[j] = *(const f32x4*)(p.in[I_MOENW] + layer * D + 4 * lane + 256 * j);
    for (int vb = blockIdx.x; vb < M / 128; vb += gridDim.x) moe_route_vb(p, layer, lds, tid, wave, lane, vb, nw);
    lds_sync();
}
__device__ __forceinline__ void moe_dispatch(const Params& p, LAS unsigned char* lds, int tid, int wave, int lane) {
    LAS int* tab = (LAS int*)(lds + LDSCTL_OFF + LC_TAB);
    const bf16* XN = (const bf16*)(p.ws + WS_XN); bf16* XS = (bf16*)(p.ws + WS_XS);
    const int* route_e = (const int*)(p.ws + WS_ROUTE); const float* route_w = (const float*)(p.ws + WS_ROUTE + (size_t)M * 2 * 4);
    int* row_code = (int*)(p.ws + WS_MOETAB); float* row_w = (float*)(p.ws + WS_MOETAB + (size_t)NROWS_MAX * 4);
    const int* cnt = (const int*)(p.ws + WS_MOETAB + (size_t)NROWS_MAX * 8); int* blk_e = (int*)(p.ws + WS_MOETAB + (size_t)NROWS_MAX * 8 + 256 * 64 * 4);
    for (int vb = blockIdx.x; vb < M / 128; vb += gridDim.x) {
        lds_sync();
        {
            const int e = tid & 63, part = tid >> 6; int run = 0, base = 0;
#pragma unroll 8
            for (int v = part * 32; v < part * 32 + 32; ++v) { const int c = cnt[v * 64 + e]; if (v < vb) base += c; run += c; }
            tab[720 + part * 64 + e] = run; tab[1240 + part * 64 + e] = base;
        }
        lds_sync();
        if (tid < 64) { int run = 0, base = 0;
#pragma unroll
            for (int k = 0; k < 8; ++k) { run += tab[720 + k * 64 + tid]; base += tab[1240 + k * 64 + tid]; }
            tab[64 + tid] = run; tab[128 + tid] = base; }
        lds_sync();
        if (tid == 0) { int s = 0; for (int e = 0; e < 64; ++e) { tab[e] = s; s += (tab[64 + e] + 255) / 256 * 256; } tab[704] = s; }
        if (tid < 256) tab[192 + tid] = route_e[(size_t)vb * 256 + tid];
        lds_sync();
        if (tid < 256) { const int e = tab[192 + tid]; int rank = 0; for (int a = 0; a < tid; ++a) rank += (tab[192 + a] == e) ? 1 : 0;
            const int pos = tab[e] + tab[128 + e] + rank; tab[448 + tid] = pos;
            row_code[pos] = ((vb * 128 + (tid >> 1)) << 1) | (tid & 1); row_w[pos] = route_w[(size_t)vb * 256 + tid]; }
        if (vb < 64) { const int ps = tab[vb], tot = tab[64 + vb], pe = ps + (tot + 255) / 256 * 256;
            for (int r = ps + tot + tid; r < pe; r += 512) row_code[r] = -1;
            for (int b = ps / 256 + tid; b < pe / 256; b += 512) blk_e[b] = vb;
            if (tid == 0) { blk_e[NROWBLK_MAX + 64 + vb] = ps / 256; blk_e[NROWBLK_MAX + 128 + vb] = (pe - ps) / 256; }
            if (vb == 63 && tid == 0) blk_e[NROWBLK_MAX] = tab[704] / 256; }
        lds_sync();
        for (int a0 = wave * 32; a0 < wave * 32 + 32; a0 += 8) {
            u32x4 r0[8], r1[8];
#pragma unroll
            for (int k = 0; k < 8; ++k) { const u32x4* src = (const u32x4*)(XN + (size_t)(vb * 128 + ((a0 + k) >> 1)) * D); r0[k] = src[lane]; r1[k] = src[lane + 64]; }
#pragma unroll
            for (int k = 0; k < 8; ++k) { u32x4* dst = (u32x4*)(XS + (size_t)tab[448 + a0 + k] * D); dst[lane] = r0[k]; dst[lane + 64] = r1[k]; } }
    }
    lds_sync();
}

__global__ void __launch_bounds__(512, 2) fwd(Params p) {
    extern __shared__ __attribute__((aligned(16))) unsigned char lds_raw[];
    LAS unsigned char* lds = (LAS unsigned char*)lds_raw;
    const int tid0 = threadIdx.x;
    const int G = gridDim.x, NGW = G * 8, NGT = G * 512;
#define FRESH() Params pl = p; { GAS unsigned char* w_ = (GAS unsigned char*)pl.ws; GAS float* o_ = (GAS float*)pl.out; asm volatile("" : "+s"(w_), "+s"(o_)); pl.ws = (unsigned char*)w_; pl.out = (float*)o_; }     int tid = tid0; asm volatile("" : "+v"(tid)); const int lane = tid & 63, wave = __builtin_amdgcn_readfirstlane(tid >> 6); const int gw = blockIdx.x * 8 + wave, gtid = blockIdx.x * 512 + tid; (void)lane; (void)gw; (void)gtid
    for (int u = tid0; u < (LDS_BYTES - LDSCTL_OFF) / 4; u += 512) ((LAS unsigned*)(lds + LDSCTL_OFF))[u] = 0u;
    __syncthreads();
    const int lo = p.ph_lo, hi = p.ph_hi;
    XcdBarrier bar; bar.bar = (unsigned*)(p.ws + WS_CTL) + CW_BAR; bar.x = 0; bar.st = (volatile LAS unsigned*)(lds + LDSCTL_OFF + LC_BAR);
    if (hi - lo > 1) bar = xcd_barrier_post((unsigned*)(p.ws + WS_CTL) + CW_BAR, (volatile LAS unsigned*)(lds + LDSCTL_OFF + LC_BAR));
#ifndef PHASE_MASK
#define PHASE_MASK 0x1fff
#endif
#define IN(k) (((PHASE_MASK >> ((k) == PH_FINAL ? 12 : ((k) % PH_PER_LAYER))) & 1) && lo <= (k) && (k) < hi)
#define REPS(k) ((((REPEAT_MASK) >> (k)) & 1) && layer == 0 ? 2 : 1)
#define TSG(slot, blk) do { if (TP_A >= 0 && (int)blockIdx.x == (blk) && tid0 == 0) __hip_atomic_store((unsigned long long*)(p.ws + WS_CTL + 131072) + (slot), (unsigned long long)__builtin_amdgcn_s_memrealtime(), __ATOMIC_RELAXED, __HIP_MEMORY_SCOPE_AGENT); } while (0)
#define TS(k) TSG(k, 0)
#define SEAM(k) do { if (IN(k) && IN((k) + 1)) xcd_barrier(bar); TS((k) + 1); } while (0)

    TS(0);
    for (int layer = 0; layer < NLAYER; ++layer) {
        const int g0 = layer * PH_PER_LAYER;

        for (int rep_ = 0; rep_ < REPS(0); ++rep_) if (IN(g0 + 0)) { if (rep_) __syncthreads(); FRESH();
            if (layer == 0) { prep_static_weights(pl, gw, NGW, lane); prep_router_tables(pl, gtid, NGT); __syncthreads(); norm_phase<0>(pl, layer, lds, gw, NGW, tid, lane); }
            else norm_phase<1>(pl, layer, lds, gw, NGW, tid, lane);
        }
        SEAM(g0 + 0);
        for (int rep_ = 0; rep_ < REPS(1); ++rep_) if (IN(g0 + 1)) { if (rep_) __syncthreads(); FRESH();
            SchedH S; S.to.init(M / 256, DH / 256, G, (int)blockIdx.x, WGM_H); S.A = (const char*)(pl.ws + WS_XN); S.B = (const char*)(pl.ws + WS_WIN + layer * WIN_L);
            EpiStoreBf16 E{(bf16*)(pl.ws + WS_H), DH};
            pg8::gemm_phase(lds, tid, D, D, D, S, E);
        }
        SEAM(g0 + 1);
        for (int rep_ = 0; rep_ < REPS(2); ++rep_) if (IN(g0 + 2)) { if (rep_) __syncthreads(); FRESH(); gdn_chunk_prep(pl, layer, lds, tid, wave, lane); }
        SEAM(g0 + 2);
        for (int rep_ = 0; rep_ < REPS(3); ++rep_) if (IN(g0 + 3)) { if (rep_) __syncthreads(); FRESH();
            if ((int)blockIdx.x < 64) gdn_chunk_scan(pl, lds, tid, wave, lane, (int)blockIdx.x >> 1, (int)blockIdx.x & 1);
            if (layer == 0) { TSG(100, 0); TSG(105, 255); }
            {
                unsigned* qc = (unsigned*)(pl.ws + WS_CTL) + CW_QUEUE + layer * 256;
                gmlp(pl, layer, lds, tid, wave, lane, qc);
                if (layer == 0) { TSG(101, 0); TSG(106, 255); }
                conformer(pl, layer, lds, tid, wave, lane, qc + 64);
                if (layer == 0) { TSG(102, 0); TSG(107, 255); }
                { ScW scw; const float* cwp = pl.in[I_SCW] + (size_t)layer * 3 * 512 + (tid & 63) * 8;
#pragma unroll
                    for (int j = 0; j < 3; ++j) { const f32x4 a = *(const f32x4*)(cwp + j * 512), b = *(const f32x4*)(cwp + j * 512 + 4); scw.w[j][0] = a[0]; scw.w[j][1] = a[1]; scw.w[j][2] = a[2]; scw.w[j][3] = a[3]; scw.w[j][4] = b[0]; scw.w[j][5] = b[1]; scw.w[j][6] = b[2]; scw.w[j][7] = b[3]; }
                    for (;;) { const int unit = queue_pop(qc + 128, lds, tid); if (unit >= M / 64) break; shortconv_unit(pl, scw, tid, unit); } }
                if (layer == 0) { TSG(103, 0); TSG(108, 255); }
            }
        }
        SEAM(g0 + 3);
        for (int rep_ = 0; rep_ < REPS(4); ++rep_) if (IN(g0 + 4)) { if (rep_) __syncthreads(); FRESH(); gdn_chunk_out(pl, layer, lds, tid, wave, lane); }
        SEAM(g0 + 4);
        for (int rep_ = 0; rep_ < REPS(5); ++rep_) if (IN(g0 + 5)) { if (rep_) __syncthreads(); FRESH();
            SchedBranch S; S.to.init(M / 256, 4, G, (int)blockIdx.x, WGM_BR); S.YS = (const char*)(pl.ws + WS_YS); S.WBR = (const char*)(pl.ws + WS_WBR + layer * WBR_L);
            EpiGate E{(bf16*)(pl.ws + WS_H) + HGATE, (bf16*)(pl.ws + WS_MERGED)};
            pg8::gemm_phase(lds, tid, 512, 2048, 512, S, E);
        }
        for (int rep_ = 0; rep_ < REPS(6); ++rep_) if (IN(g0 + 6)) { if (rep_) __syncthreads(); FRESH();   }
        SEAM(g0 + 6);
        for (int rep_ = 0; rep_ < REPS(7); ++rep_) if (IN(g0 + 7)) { if (rep_) __syncthreads(); FRESH();
            const int NGB = G / 2;
            if ((int)blockIdx.x < NGB) {
                SchedOut S; S.to.init(M / 256, 4, NGB, (int)blockIdx.x, WGM_OUT); S.A = (const char*)(pl.ws + WS_MERGED); S.B = (const char*)(pl.ws + WS_WOUT + layer * WOUT_L);
                EpiRes E{layer == 0 ? pl.in[I_X] : nullptr, (const bf16*)pl.out, (bf16*)(pl.ws + WS_X1B)};
                pg8::gemm_phase(lds, tid, D, D, D, S, E);
            } else prep_moe_weights(pl, layer, ((int)blockIdx.x - NGB) * 8 + wave, (G - NGB) * 8, lane);
            if (layer == 0) { TSG(110, 0); TSG(111, 255); }
        }
        SEAM(g0 + 7);
        for (int rep_ = 0; rep_ < REPS(8); ++rep_) if (IN(g0 + 8)) { if (rep_) __syncthreads(); FRESH(); moe_route(pl, layer, lds, tid, wave, lane); }
        SEAM(g0 + 8);
        for (int rep_ = 0; rep_ < REPS(9); ++rep_) if (IN(g0 + 9)) { if (rep_) __syncthreads(); FRESH(); moe_dispatch(pl, lds, tid, wave, lane); }
        SEAM(g0 + 9);
        if (IN(g0 + 10) || IN(g0 + 11)) { FRESH();
            LAS int* tb = (LAS int*)(lds + LDSCTL_OFF + LC_TAB);
            const int* est = (const int*)(pl.ws + WS_MOETAB + (size_t)NROWS_MAX * 8 + 256 * 64 * 4) + NROWBLK_MAX + 64;
            const int NX = (G % 8 == 0) ? 8 : 1, x = (int)blockIdx.x % NX, nk = 64 / NX;
            __syncthreads();
            if (tid < nk) { tb[160 + tid] = est[x + NX * tid]; tb[240 + tid] = est[64 + x + NX * tid]; }
            __syncthreads();
            if (tid == 0) { int s = 0; for (int k = 0; k < nk; ++k) { tb[k] = s; tb[80 + k] = tb[160 + k]; s += tb[240 + k] * 4; } tb[nk] = s; }
            __syncthreads();
        }
        for (int rep_ = 0; rep_ < REPS(10); ++rep_) if (IN(g0 + 10)) { if (rep_) __syncthreads(); FRESH();
            LAS int* tb = (LAS int*)(lds + LDSCTL_OFF + LC_TAB); const int NX = (G % 8 == 0) ? 8 : 1, nk = 64 / NX;
            SchedMoe S; S.nux = tb[nk]; S.nrank = G / NX; S.rank = (int)blockIdx.x / NX; S.nk = nk; S.x = (int)blockIdx.x % NX; S.NX = NX; S.cum = tb; S.rb0 = tb + 80;
            S.A = (const char*)(pl.ws + WS_XS); S.a_blk = (size_t)256 * D * 2; S.W = (const char*)(pl.ws + WS_MOEW); S.w_e = WGU_E; S.w_pn = (size_t)256 * D * 2; S.cmul = 128;
            EpiSwiglu E{(bf16*)(pl.ws + WS_HB)};
            pg8::gemm_phase(lds, tid, D, D, D, S, E);
        }
        SEAM(g0 + 10);
        for (int rep_ = 0; rep_ < REPS(11); ++rep_) if (IN(g0 + 11)) { if (rep_) __syncthreads(); FRESH();
            LAS int* tb = (LAS int*)(lds + LDSCTL_OFF + LC_TAB); const int NX = (G % 8 == 0) ? 8 : 1, nk = 64 / NX;
            SchedMoe S; S.nux = tb[nk]; S.nrank = G / NX; S.rank = (int)blockIdx.x / NX; S.nk = nk; S.x = (int)blockIdx.x % NX; S.NX = NX; S.cum = tb; S.rb0 = tb + 80;
            S.A = (const char*)(pl.ws + WS_HB); S.a_blk = (size_t)256 * DE * 2; S.W = (const char*)(pl.ws + WS_WD); S.w_e = WD_E; S.w_pn = (size_t)256 * DE * 2; S.cmul = 256;
            EpiScatter E{(bf16*)(pl.ws + WS_Y), (const int*)(pl.ws + WS_MOETAB), (const float*)(pl.ws + WS_MOETAB + (size_t)NROWS_MAX * 4)};
            pg8::gemm_phase(lds, tid, DE, DE, DE, S, E);
        }
        SEAM(g0 + 11);
    }
    if (IN(PH_FINAL)) { FRESH(); norm_phase<2>(pl, 0, lds, gw, NGW, tid, lane); }
    TS(PH_TOTAL);
    if (TP_A >= 0 && blockIdx.x == 0 && tid0 == 0) {
        unsigned long long* tr = (unsigned long long*)(p.ws + WS_CTL + 131072);
        const unsigned long long ta = __hip_atomic_load(tr + TP_A, __ATOMIC_RELAXED, __HIP_MEMORY_SCOPE_AGENT), tb = __hip_atomic_load(tr + TP_B, __ATOMIC_RELAXED, __HIP_MEMORY_SCOPE_AGENT);
        unsigned long long wait_ticks = (tb > ta ? tb - ta : 0ull) * TP_SCALE;
        if (wait_ticks > 1000000ull) wait_ticks = 1000000ull;
        const unsigned long long t0 = __builtin_amdgcn_s_memrealtime();
        while (__builtin_amdgcn_s_memrealtime() - t0 < wait_ticks) __builtin_amdgcn_s_sleep(8);
    }
#undef IN
#undef SEAM
}

extern "C" void kernel_launch(void* const* d_in, const int* in_sizes, int n_in, void* d_out, int out_size, void* d_ws, size_t ws_size, hipStream_t stream) {
    static int grid = 0;
    if (grid == 0) {
        if (n_in != 25 || out_size != M * D || ws_size < WS_END) { fprintf(stderr, "kernel_launch: unexpected shapes / workspace (n_in %d out %d ws %zu, need %zu)\n", n_in, out_size, ws_size, (size_t)WS_END); grid = -1; return; }
        int dev = 0, cus = 0, per_cu = 0;
        if (hipGetDevice(&dev) != hipSuccess || hipDeviceGetAttribute(&cus, hipDeviceAttributeMultiprocessorCount, dev) != hipSuccess) { grid = -1; return; }
        if (hipFuncSetAttribute((const void*)fwd, hipFuncAttributeMaxDynamicSharedMemorySize, LDS_BYTES) != hipSuccess) { fprintf(stderr, "kernel_launch: hipFuncSetAttribute failed\n"); grid = -1; return; }
        if (hipOccupancyMaxActiveBlocksPerMultiprocessor(&per_cu, (const void*)fwd, 512, LDS_BYTES) != hipSuccess || per_cu < 1) { fprintf(stderr, "kernel_launch: occupancy query says %d\n", per_cu); }
        (void)hipGetLastError();
        grid = cus;
    }
    if (grid < 0) return;
    hipMemsetAsync((char*)d_ws + WS_CTL, 0, CTL_BYTES, stream);
    Params p{};
    for (int i = 0; i < 25; ++i) p.in[i] = (const float*)d_in[i];
    p.out = (float*)d_out; p.ws = (unsigned char*)d_ws;
#if N_LAUNCH_MODE == 1
    p.ph_lo = 0; p.ph_hi = PH_TOTAL;
    hipLaunchKernelGGL(fwd, dim3(grid), dim3(512), LDS_BYTES, stream, p);
#else
    for (int k = 0; k < PH_TOTAL; ++k) { p.ph_lo = k; p.ph_hi = k + 1; hipLaunchKernelGGL(fwd, dim3(grid), dim3(512), LDS_BYTES, stream, p); }
#endif
}
```

```cpp
#include <hip/hip_runtime.h>
#include <cstdio>
#include <cstdint>

#ifndef REPEAT_MASK
#define REPEAT_MASK 0
#endif
#ifndef TP_A
#define TP_A -1
#endif
#ifndef TP_B
#define TP_B -1
#endif
#ifndef TP_SCALE
#define TP_SCALE 1
#endif
#ifndef WGM_H
#define WGM_H 4
#endif
#ifndef WGM_BR
#define WGM_BR 2
#endif
#ifndef WGM_OUT
#define WGM_OUT 4
#endif
#ifndef N_LAUNCH_MODE
#define N_LAUNCH_MODE 1
#endif

#define LAS __attribute__((address_space(3)))
#define GAS __attribute__((address_space(1)))
typedef unsigned short bf16;
typedef short bf16x8 __attribute__((ext_vector_type(8)));
typedef float f32x4 __attribute__((ext_vector_type(4)));
typedef float f32x2 __attribute__((ext_vector_type(2)));
typedef unsigned u32x4 __attribute__((ext_vector_type(4)));
typedef unsigned u32x2 __attribute__((ext_vector_type(2)));

constexpr int NB = 8, T = 4096, D = 1024, M = NB * T, NLAYER = 2;
constexpr int DIN = 9736, DH = 9728;
constexpr int HQ = 0, HK = 512, HV = 1024, HZ = 1536, HCONF = 2048, HGMLP = 3072, HSC = 4096, HGATE = 5632;
constexpr int PGDN = 2048, PCONF = 1024, PGMLP = 1024, PSC = 1536, PGATE = 4096;
constexpr size_t HB_GDN = 0, HB_CONF = (size_t)M * HCONF, HB_GMLP = (size_t)M * HGMLP, HB_SC = (size_t)M * HSC, HB_GATE = (size_t)M * HGATE;
constexpr int NE = 64, DE = 512;
constexpr float EPS = 1e-6f;
constexpr int NROWBLK_MAX = 320, NROWS_MAX = NROWBLK_MAX * 256;

constexpr size_t MiB = 1u << 20;
constexpr size_t WS_CTL = 0, CTL_BYTES = 1 * MiB;
constexpr size_t WS_WIN = 2 * MiB;
constexpr size_t WIN_L = (size_t)DH * D * 2;
constexpr size_t WS_WBR = 40 * MiB;
constexpr size_t WBR_L = (size_t)4 * D * 512 * 2;
constexpr size_t WS_WOUT = 48 * MiB;
constexpr size_t WOUT_L = (size_t)D * D * 2;
constexpr size_t WS_XN = 52 * MiB;
constexpr size_t WS_SMALL = 116 * MiB;
constexpr size_t WS_ROUTE = 117 * MiB;
constexpr size_t WS_MOETAB = 118 * MiB;
constexpr size_t WS_YS = 120 * MiB;
constexpr size_t WS_X1B = 120 * MiB;
constexpr size_t WS_REC = 248 * MiB;
constexpr size_t WS_MERGED = WS_REC;
constexpr size_t WS_OBUF = WS_XN;
constexpr int REC_W = 0, REC_Q = 16384, REC_ATT = 32768, REC_KT = 40960, REC_U = 57344, REC_G = 73728, REC_BYTES = 73984;
static_assert(WS_REC + (size_t)2048 * REC_BYTES <= 410 * MiB, "chunk records");
constexpr size_t WS_H = 410 * MiB;
constexpr size_t WS_MOEW = 410 * MiB;
constexpr size_t WGU_E = (size_t)1024 * 1024 * 2, WD_E = (size_t)1024 * 512 * 2;
constexpr size_t WS_WD = WS_MOEW + 64 * WGU_E;
constexpr size_t WS_XS = 602 * MiB;
constexpr size_t WS_HB = 762 * MiB;
constexpr size_t WS_Y = 842 * MiB;
constexpr size_t WS_END = 1018 * MiB;
static_assert(WS_H + (size_t)M * DH * 2 <= WS_END && WS_Y + (size_t)2 * M * D * 2 <= WS_END, "ws map");

constexpr int CW_BAR = 4096;
constexpr int CW_QUEUE = 16384;
constexpr int STAGE_LDS = 131072, LDSCTL_OFF = 131072, LDS_BYTES = 147456;
constexpr int LC_BAR = 0;
constexpr int LC_MISC = 64;
constexpr int LC_TAB = 1024;

__device__ __forceinline__ float bf_lo(unsigned w) { return __uint_as_float(w << 16); }
__device__ __forceinline__ float bf_hi(unsigned w) { return __uint_as_float(w & 0xffff0000u); }
__device__ __forceinline__ float bf2f(bf16 b) { return __uint_as_float(((unsigned)b) << 16); }
typedef __bf16 bf16x2_t __attribute__((ext_vector_type(2)));
__device__ __forceinline__ unsigned pk2(float lo, float hi) { const f32x2 v = {lo, hi}; return __builtin_bit_cast(unsigned, __builtin_convertvector(v, bf16x2_t)); }
__device__ __forceinline__ unsigned f2bf(float f) { return pk2(f, 0.f) & 0xffffu; }
__device__ __forceinline__ void unpack8(const u32x4 v, float (&f)[8]) {
    f[0] = bf_lo(v.x); f[1] = bf_hi(v.x); f[2] = bf_lo(v.y); f[3] = bf_hi(v.y); f[4] = bf_lo(v.z); f[5] = bf_hi(v.z); f[6] = bf_lo(v.w); f[7] = bf_hi(v.w);
}
__device__ __forceinline__ u32x4 pack8(const float (&f)[8]) { u32x4 o; o.x = pk2(f[0], f[1]); o.y = pk2(f[2], f[3]); o.z = pk2(f[4], f[5]); o.w = pk2(f[6], f[7]); return o; }
template <int CTRL> __device__ __forceinline__ float dpp_mov(float v) { return __builtin_bit_cast(float, __builtin_amdgcn_update_dpp(0, __builtin_bit_cast(int, v), CTRL, 0xf, 0xf, false)); }
__device__ __forceinline__ float wave_sum(float v) {
    v += dpp_mov<0xB1>(v); v += dpp_mov<0x4E>(v); v += dpp_mov<0x141>(v); v += dpp_mov<0x140>(v);
    const int vi = __builtin_bit_cast(int, v);
    const float a = __builtin_bit_cast(float, __builtin_amdgcn_readlane(vi, 0)), b = __builtin_bit_cast(float, __builtin_amdgcn_readlane(vi, 16)), c = __builtin_bit_cast(float, __builtin_amdgcn_readlane(vi, 32)), d = __builtin_bit_cast(float, __builtin_amdgcn_readlane(vi, 48));
    return (a + b) + (c + d);
}
__device__ __forceinline__ void lds_sync() { asm volatile("s_waitcnt lgkmcnt(0)" ::: "memory"); __builtin_amdgcn_s_barrier(); asm volatile("" ::: "memory"); }
__device__ __forceinline__ float fexp(float x) { return __builtin_amdgcn_exp2f(x * 1.4426950408889634f); }
__device__ __forceinline__ float frcp(float x) { return __builtin_amdgcn_rcpf(x); }
__device__ __forceinline__ float sigmoidf_(float x) { return frcp(1.0f + fexp(-x)); }
__device__ __forceinline__ float siluf_(float x) { return x * frcp(1.0f + fexp(-x)); }
__device__ __forceinline__ float gelu_tanh(float x) { const float a = __builtin_fmaf(x * x, -0.10294324f, -2.3022082f); return x * frcp(1.0f + __builtin_amdgcn_exp2f(x * a)); }
__device__ __forceinline__ float softplusf_(float x) { return fmaxf(x, 0.f) + log1pf(__expf(-fabsf(x))); }

#define XB_TMO      128
#define XB_XCNT(j)  (256  + 64 * (j))
#define XB_XSUB(j)  (1280 + 64 * (j))
#define XB_XGEN(j)  (2304 + 64 * (j))
#define XB_TOP      3328
#define XB_TOPGEN   3392
#define XCD_BAR_WORDS 3456
#define XB_SPIN_CAP (1u << 18)
__device__ __forceinline__ unsigned xb_ld(unsigned* p)              { return __hip_atomic_load(p, __ATOMIC_RELAXED, __HIP_MEMORY_SCOPE_AGENT); }
__device__ __forceinline__ unsigned xb_add(unsigned* p, unsigned v) { return __hip_atomic_fetch_add(p, v, __ATOMIC_RELAXED, __HIP_MEMORY_SCOPE_AGENT); }
__device__ __forceinline__ unsigned xb_xcc_id() { return (unsigned)__builtin_amdgcn_s_getreg((3 << 11) | 20) & 0xFu; }
#define XB_SPIN(cond, bar) do { unsigned _sp = 0; while (cond) { __builtin_amdgcn_s_sleep(1); \
    if ((++_sp & 255u) == 0u) { if (xb_ld(&(bar)[XB_TMO])) break; if (_sp > XB_SPIN_CAP) { atomicAdd(&(bar)[XB_TMO], 1u); break; } } } } while (0)
struct XcdBarrier { unsigned* bar; unsigned x; volatile LAS unsigned* st; };
__device__ __forceinline__ XcdBarrier xcd_barrier_post(unsigned* bar, volatile LAS unsigned* st) {
    XcdBarrier b; b.bar = bar; b.x = xb_xcc_id(); b.st = st;
    if (threadIdx.x == 0) (void)xb_add(&bar[XB_XCNT(b.x)], 1u);
    return b;
}
__device__ __forceinline__ void xcd_barrier_complete(unsigned* bar, unsigned x, unsigned& nloc, unsigned& nx) {
    const unsigned G = gridDim.x * gridDim.y * gridDim.z;
    unsigned sum, cnt, mine, sp = 0u;
    for (;;) {
        sum = 0u; cnt = 0u; mine = 0u;
#pragma unroll
        for (unsigned j = 0; j < 16; ++j) { const unsigned c = xb_ld(&bar[XB_XCNT(j)]); sum += c; cnt += (c > 0u) ? 1u : 0u; mine = (j == x) ? c : mine; }
        if (sum == G) break;
        __builtin_amdgcn_s_sleep(1);
        if ((++sp & 255u) == 0u) { if (xb_ld(&bar[XB_TMO])) break; if (sp > XB_SPIN_CAP) { atomicAdd(&bar[XB_TMO], 1u); break; } }
    }
    nloc = mine > 0u ? mine : 1u; nx = cnt > 0u ? cnt : 1u;
}
__device__ __forceinline__ void xcd_barrier(const XcdBarrier& b) {
    asm volatile("s_waitcnt vmcnt(0)" ::: "memory");
    __syncthreads();
    if (threadIdx.x == 0) {
        unsigned* bar = b.bar;
        __builtin_amdgcn_s_waitcnt(0);
        unsigned nloc = b.st[0], nx = b.st[1];
        if (nloc == 0u) { xcd_barrier_complete(bar, b.x, nloc, nx); b.st[0] = nloc; b.st[1] = nx; }
        const unsigned old = xb_add(&bar[XB_XSUB(b.x)], 1u);
        const unsigned gen = old / nloc;
        if (old + 1u == (gen + 1u) * nloc) {
            __builtin_amdgcn_fence(__ATOMIC_RELEASE, "agent");
            asm volatile("s_waitcnt vmcnt(0)" ::: "memory");
            const unsigned og = xb_add(&bar[XB_TOP], 1u);
            const unsigned tg = og / nx;
            if (og + 1u == (tg + 1u) * nx) xb_add(&bar[XB_TOPGEN], 1u);
            else XB_SPIN(xb_ld(&bar[XB_TOPGEN]) == tg, bar);
            __builtin_amdgcn_fence(__ATOMIC_ACQUIRE, "agent");
            xb_add(&bar[XB_XGEN(b.x)], 1u);
            asm volatile("s_waitcnt vmcnt(0)" ::: "memory");
        } else {
            XB_SPIN(xb_ld(&bar[XB_XGEN(b.x)]) == gen, bar);
            __builtin_amdgcn_fence(__ATOMIC_ACQUIRE, "agent");
            asm volatile("s_waitcnt vmcnt(0)" ::: "memory");
        }
    }
    __syncthreads();
}

namespace pg8 {
constexpr int BM = 256, BK = 64, HALF = 128, HTB = HALF * BK * 2, STAGE_BYTES = 8 * HTB, NXCD = 8, WGM = 8;
__host__ __device__ __forceinline__ int lds_byte(int r, int c) { const int st = (r >> 4) * 2 + (c >> 5), rr = r & 15, cc = c & 31, ob = rr * 64 + cc * 2; return st * 1024 + (ob ^ (((ob >> 9) & 1) << 5)); }
__host__ __device__ __forceinline__ void stage_rc(int b, int& R, int& C) { const int st = b / 1024, sb = b % 1024, swz = sb ^ (((sb >> 9) & 1) << 5); R = (st >> 1) * 16 + swz / 64; C = (st & 1) * 32 + (swz % 64) / 2; }
__host__ __device__ __forceinline__ int perm32(int rho) { const int n = rho >> 4, i = rho & 15; return 8 * (i >> 2) + 4 * n + (i & 3); }

struct Unit { const char* A; const char* B; int r0, c0; };

struct TileOrder {
    int nM, nN, nwg, G, c, wgm;
    __device__ void init(int nM_, int nN_, int G_, int c_, int wgm_ = WGM) { nM = nM_; nN = nN_; nwg = nM * nN; G = G_; c = c_; wgm = wgm_; }
    __device__ bool next(int i, int& pm, int& pn) const {
        const long L = (long)i * G + c; if (L >= nwg) return false;
        int wgid = (int)L; { const int q = nwg / NXCD, r = nwg % NXCD, xcd = wgid % NXCD, off = wgid / NXCD; wgid = (xcd < r ? xcd * (q + 1) : r * (q + 1) + (xcd - r) * q) + off; }
        const int nig = wgm * nN, gid = wgid / nig, fm = gid * wgm, gsz = (nM - fm) < wgm ? (nM - fm) : wgm;
        pm = fm + ((wgid % nig) % gsz); pn = (wgid % nig) / gsz; return true;
    }
};
__device__ __forceinline__ unsigned cvt_pk_bf16(float lo, float hi) { unsigned r; asm volatile("v_cvt_pk_bf16_f32 %0, %1, %2" : "=v"(r) : "v"(lo), "v"(hi)); return r; }

template <class Epi, class Sched>
__device__ __forceinline__ void gemm_phase(LAS unsigned char* lds, const int tid, const int K, const int lda, const int ldb, const Sched& S, const Epi& E) {
    const int wid = __builtin_amdgcn_readfirstlane(tid >> 6), lane = tid & 63, wr = wid >> 2, wc = wid & 3, fr = lane & 15, fq = lane >> 4;
    const int nt = K / BK;
    unsigned voffA[2], voffB[2];
#pragma unroll
    for (int i = 0; i < 2; ++i) { int R, C; stage_rc(tid * 16 + i * 8192, R, C); const int Rb = Epi::PERM ? ((R & ~31) + perm32(R & 31)) : R;
        voffA[i] = (unsigned)(R * lda + C) * 2u; voffB[i] = (unsigned)(Rb * ldb + C) * 2u; }
    const size_t kstep = (size_t)(BK * 2);
    const size_t hstepA = (size_t)HALF * lda * 2, hstepB = (size_t)HALF * ldb * 2;
    const unsigned ldsw = (unsigned)wid * 1024u;
    const int aoff = lds_byte(wr * 64 + fr, fq * 8), boff = lds_byte(wc * 32 + fr, fq * 8);
#define PG8_SA(b, h) (((b) * 2 + (h)) * HTB)
#define PG8_SB(b, h) ((4 + (b) * 2 + (h)) * HTB)
#define PG8_STAGE(bufoff, gbase, voff) do { _Pragma("unroll") for (int _i = 0; _i < 2; ++_i) \
        __builtin_amdgcn_global_load_lds((const unsigned*)((const char*)(gbase) + (voff)[_i]), (LAS unsigned*)(lds + (bufoff) + ldsw + _i * 8192), 16, 0, 0); } while (0)
#define PG8_LDA(dst, b, h) do { _Pragma("unroll") for (int m = 0; m < 4; ++m) _Pragma("unroll") for (int k = 0; k < 2; ++k) dst[m][k] = *(const LAS bf16x8*)(lds + PG8_SA(b, h) + aoff + m * 2048 + k * 1024); } while (0)
#define PG8_LDB(dst, b, h) do { _Pragma("unroll") for (int n = 0; n < 2; ++n) _Pragma("unroll") for (int k = 0; k < 2; ++k) dst[n][k] = *(const LAS bf16x8*)(lds + PG8_SB(b, h) + boff + n * 2048 + k * 1024); } while (0)
#define PG8_MMA(ai, bj, At, Bt) do { __builtin_amdgcn_s_setprio(1); _Pragma("unroll") for (int m = 0; m < 4; ++m) _Pragma("unroll") for (int n = 0; n < 2; ++n) _Pragma("unroll") for (int k = 0; k < 2; ++k) \
        acc[ai][bj][m][n] = __builtin_amdgcn_mfma_f32_16x16x32_bf16(Bt[n][k], At[m][k], acc[ai][bj][m][n], 0, 0, 0); __builtin_amdgcn_s_setprio(0); } while (0)
#define PG8_WAIT_V(n) asm volatile("s_waitcnt vmcnt(" #n ")" ::: "memory")
#define PG8_WAIT_L(n) asm volatile("s_waitcnt lgkmcnt(" #n ")" ::: "memory")
#define PG8_BAR __builtin_amdgcn_s_barrier()
#define PG8_SCHED __builtin_amdgcn_sched_barrier(0)
    Unit cur, nxt; int ui = 0;
    if (!S.next(0, cur)) return;
    f32x4 acc[2][2][4][2];
#pragma unroll
    for (int a = 0; a < 2; ++a)
#pragma unroll
        for (int b = 0; b < 2; ++b)
#pragma unroll
            for (int m = 0; m < 4; ++m)
#pragma unroll
                for (int n = 0; n < 2; ++n) acc[a][b][m][n] = (f32x4){0.f, 0.f, 0.f, 0.f};
    bf16x8 At[4][2], B0[2][2], B1[2][2];
    const char* cA = cur.A; const char* cB = cur.B;
    PG8_STAGE(PG8_SB(0, 0), cB, voffB); PG8_STAGE(PG8_SB(0, 1), cB + hstepB, voffB); PG8_STAGE(PG8_SA(0, 0), cA, voffA); PG8_STAGE(PG8_SA(0, 1), cA + hstepA, voffA);
    if (wr == 1) PG8_BAR;
    PG8_WAIT_V(2); PG8_BAR;
    PG8_STAGE(PG8_SB(1, 0), cB + kstep, voffB); PG8_STAGE(PG8_SA(1, 0), cA + kstep, voffA); PG8_STAGE(PG8_SB(1, 1), cB + hstepB + kstep, voffB);
    PG8_WAIT_V(6); PG8_BAR;
    for (;;) {
        const bool has_next = S.next(ui + 1, nxt);
        const char* nA = has_next ? nxt.A : cA; const char* nB = has_next ? nxt.B : cB;
        for (int t = 0; t < nt; t += 2) {
            const bool last = (t == nt - 2);
            const char* a1 = cA + (size_t)(t + 1) * kstep;
            const char* a2 = last ? nA : cA + (size_t)(t + 2) * kstep; const char* b2 = last ? nB : cB + (size_t)(t + 2) * kstep;
            const char* a3 = a2 + kstep; const char* b3 = b2 + kstep;
            PG8_LDB(B0, 0, 0); PG8_LDB(B1, 0, 1); PG8_SCHED; PG8_LDA(At, 0, 0); PG8_STAGE(PG8_SA(1, 1), a1 + hstepA, voffA);
            PG8_WAIT_V(8); PG8_WAIT_L(0); PG8_BAR; PG8_MMA(0, 0, At, B0); PG8_MMA(0, 1, At, B1); PG8_BAR; PG8_SCHED;
            PG8_LDA(At, 0, 1); PG8_STAGE(PG8_SB(0, 0), b2, voffB); PG8_STAGE(PG8_SB(0, 1), b2 + hstepB, voffB); PG8_STAGE(PG8_SA(0, 0), a2, voffA);
            PG8_WAIT_V(8); PG8_WAIT_L(0); PG8_BAR; PG8_MMA(1, 0, At, B0); PG8_MMA(1, 1, At, B1); PG8_BAR; PG8_SCHED;
            PG8_LDB(B0, 1, 0); PG8_LDB(B1, 1, 1); PG8_SCHED; PG8_LDA(At, 1, 0); PG8_STAGE(PG8_SA(0, 1), a2 + hstepA, voffA);
            PG8_WAIT_V(8); PG8_WAIT_L(0); PG8_BAR; PG8_MMA(0, 0, At, B0); PG8_MMA(0, 1, At, B1); PG8_BAR; PG8_SCHED;
            PG8_LDA(At, 1, 1); PG8_STAGE(PG8_SB(1, 0), b3, voffB); PG8_STAGE(PG8_SB(1, 1), b3 + hstepB, voffB); PG8_STAGE(PG8_SA(1, 0), a3, voffA);
            PG8_WAIT_V(8); PG8_WAIT_L(0); PG8_BAR; PG8_MMA(1, 0, At, B0); PG8_MMA(1, 1, At, B1); PG8_BAR; PG8_SCHED;
        }
        if (wr == 0) PG8_BAR;
        E(acc, cur, wr, wc, fr, fq);
        if (!has_next) break;
#pragma unroll
        for (int a = 0; a < 2; ++a)
#pragma unroll
            for (int b = 0; b < 2; ++b)
#pragma unroll
                for (int m = 0; m < 4; ++m)
#pragma unroll
                    for (int n = 0; n < 2; ++n) acc[a][b][m][n] = (f32x4){0.f, 0.f, 0.f, 0.f};
        cur = nxt; cA = nA; cB = nB; ++ui;
        if (wr == 1) PG8_BAR;
    }
    PG8_WAIT_V(0);
    PG8_BAR;
#undef PG8_SA
#undef PG8_SB
#undef PG8_STAGE
#undef PG8_LDA
#undef PG8_LDB
#undef PG8_MMA
#undef PG8_WAIT_V
#undef PG8_WAIT_L
#undef PG8_BAR
#undef PG8_SCHED
}
template <class Epi, class Sched>
__device__ __forceinline__ void gemm_phase_gather(LAS unsigned char* lds, const int tid, const int K, const int ldb, const Sched& S, const Epi& E, const char* Ab, const unsigned xn_off, const unsigned zero_off, const int* __restrict__ row_code) {
    const int wid = __builtin_amdgcn_readfirstlane(tid >> 6), lane = tid & 63, wr = wid >> 2, wc = wid & 3, fr = lane & 15, fq = lane >> 4;
    const int nt = K / BK;
    unsigned voffB[2]; int R0, C0;
    stage_rc(tid * 16, R0, C0);
#pragma unroll
    for (int i = 0; i < 2; ++i) { int R, C; stage_rc(tid * 16 + i * 8192, R, C); const int Rb = Epi::PERM ? ((R & ~31) + perm32(R & 31)) : R;
        voffB[i] = (unsigned)(Rb * ldb + C) * 2u; }
    const unsigned rowB = (unsigned)K * 2u;
#define PG8_ROWOFF(dst, r0_) do { _Pragma("unroll") for (int h_ = 0; h_ < 2; ++h_) _Pragma("unroll") for (int i_ = 0; i_ < 2; ++i_) { const int code_ = row_code[(r0_) + 128 * h_ + 64 * i_ + R0]; \
        dst[h_][i_] = (code_ < 0 ? zero_off : xn_off + (unsigned)(code_ >> 1) * rowB) + (unsigned)C0 * 2u; } } while (0)
    unsigned vAc[2][2];
    const size_t kstep = (size_t)(BK * 2);
    const size_t hstepB = (size_t)HALF * ldb * 2;
    const unsigned ldsw = (unsigned)wid * 1024u;
    const int aoff = lds_byte(wr * 64 + fr, fq * 8), boff = lds_byte(wc * 32 + fr, fq * 8);
#define PG8_SA(b, h) (((b) * 2 + (h)) * HTB)
#define PG8_SB(b, h) ((4 + (b) * 2 + (h)) * HTB)
#define PG8_STAGE(bufoff, gbase, voff) do { _Pragma("unroll") for (int _i = 0; _i < 2; ++_i) \
        __builtin_amdgcn_global_load_lds((const unsigned*)((const char*)(gbase) + (voff)[_i]), (LAS unsigned*)(lds + (bufoff) + ldsw + _i * 8192), 16, 0, 0); } while (0)
#define PG8_LDA(dst, b, h) do { _Pragma("unroll") for (int m = 0; m < 4; ++m) _Pragma("unroll") for (int k = 0; k < 2; ++k) dst[m][k] = *(const LAS bf16x8*)(lds + PG8_SA(b, h) + aoff + m * 2048 + k * 1024); } while (0)
#define PG8_LDB(dst, b, h) do { _Pragma("unroll") for (int n = 0; n < 2; ++n) _Pragma("unroll") for (int k = 0; k < 2; ++k) dst[n][k] = *(const LAS bf16x8*)(lds + PG8_SB(b, h) + boff + n * 2048 + k * 1024); } while (0)
#define PG8_MMA(ai, bj, At, Bt) do { __builtin_amdgcn_s_setprio(1); _Pragma("unroll") for (int m = 0; m < 4; ++m) _Pragma("unroll") for (int n = 0; n < 2; ++n) _Pragma("unroll") for (int k = 0; k < 2; ++k) \
        acc[ai][bj][m][n] = __builtin_amdgcn_mfma_f32_16x16x32_bf16(Bt[n][k], At[m][k], acc[ai][bj][m][n], 0, 0, 0); __builtin_amdgcn_s_setprio(0); } while (0)
#define PG8_WAIT_V(n) asm volatile("s_waitcnt vmcnt(" #n ")" ::: "memory")
#define PG8_WAIT_L(n) asm volatile("s_waitcnt lgkmcnt(" #n ")" ::: "memory")
#define PG8_BAR __builtin_amdgcn_s_barrier()
#define PG8_SCHED __builtin_amdgcn_sched_barrier(0)
    Unit cur, nxt; int ui = 0;
    if (!S.next(0, cur)) return;
    f32x4 acc[2][2][4][2];
#pragma unroll
    for (int a = 0; a < 2; ++a)
#pragma unroll
        for (int b = 0; b < 2; ++b)
#pragma unroll
            for (int m = 0; m < 4; ++m)
#pragma unroll
                for (int n = 0; n < 2; ++n) acc[a][b][m][n] = (f32x4){0.f, 0.f, 0.f, 0.f};
    bf16x8 At[4][2], B0[2][2], B1[2][2];
    const char* const cA = Ab; const char* cB = cur.B;
    PG8_ROWOFF(vAc, cur.r0);
    PG8_STAGE(PG8_SB(0, 0), cB, voffB); PG8_STAGE(PG8_SB(0, 1), cB + hstepB, voffB); PG8_STAGE(PG8_SA(0, 0), cA, vAc[0]); PG8_STAGE(PG8_SA(0, 1), cA, vAc[1]);
    if (wr == 1) PG8_BAR;
    PG8_WAIT_V(2); PG8_BAR;
    PG8_STAGE(PG8_SB(1, 0), cB + kstep, voffB); PG8_STAGE(PG8_SA(1, 0), cA + kstep, vAc[0]); PG8_STAGE(PG8_SB(1, 1), cB + hstepB + kstep, voffB);
    PG8_WAIT_V(6); PG8_BAR;
    for (;;) {
        const bool has_next = S.next(ui + 1, nxt);
        const char* nB = has_next ? nxt.B : cB;
        LAS int* const slot = (LAS int*)(lds + LDSCTL_OFF + 8192 + ((ui + 1) & 1) * 1024);
        if (has_next && wid == 0) __builtin_amdgcn_global_load_lds((const unsigned*)(row_code + nxt.r0 + 4 * lane), (LAS unsigned*)slot, 16, 0, 0);
        for (int t = 0; t < nt; t += 2) {
            const bool last = (t == nt - 2);
            const char* a1 = cA + (size_t)(t + 1) * kstep;
            const char* a2 = last ? cA : cA + (size_t)(t + 2) * kstep; const char* b2 = last ? nB : cB + (size_t)(t + 2) * kstep;
            const char* a3 = a2 + kstep; const char* b3 = b2 + kstep;
            PG8_LDB(B0, 0, 0); PG8_LDB(B1, 0, 1); PG8_SCHED; PG8_LDA(At, 0, 0); PG8_STAGE(PG8_SA(1, 1), a1, vAc[1]);
            if (last && has_next) {
#pragma unroll
                for (int h_ = 0; h_ < 2; ++h_)
#pragma unroll
                    for (int i_ = 0; i_ < 2; ++i_) { const int code_ = slot[128 * h_ + 64 * i_ + R0]; vAc[h_][i_] = (code_ < 0 ? zero_off : xn_off + (unsigned)(code_ >> 1) * rowB) + (unsigned)C0 * 2u; } }
            PG8_WAIT_V(8); PG8_WAIT_L(0); PG8_BAR; PG8_MMA(0, 0, At, B0); PG8_MMA(0, 1, At, B1); PG8_BAR; PG8_SCHED;
            PG8_LDA(At, 0, 1); PG8_STAGE(PG8_SB(0, 0), b2, voffB); PG8_STAGE(PG8_SB(0, 1), b2 + hstepB, voffB); PG8_STAGE(PG8_SA(0, 0), a2, vAc[0]);
            PG8_WAIT_V(8); PG8_WAIT_L(0); PG8_BAR; PG8_MMA(1, 0, At, B0); PG8_MMA(1, 1, At, B1); PG8_BAR; PG8_SCHED;
            PG8_LDB(B0, 1, 0); PG8_LDB(B1, 1, 1); PG8_SCHED; PG8_LDA(At, 1, 0); PG8_STAGE(PG8_SA(0, 1), a2, vAc[1]);
            PG8_WAIT_V(8); PG8_WAIT_L(0); PG8_BAR; PG8_MMA(0, 0, At, B0); PG8_MMA(0, 1, At, B1); PG8_BAR; PG8_SCHED;
            PG8_LDA(At, 1, 1); PG8_STAGE(PG8_SB(1, 0), b3, voffB); PG8_STAGE(PG8_SB(1, 1), b3 + hstepB, voffB); PG8_STAGE(PG8_SA(1, 0), a3, vAc[0]);
            PG8_WAIT_V(8); PG8_WAIT_L(0); PG8_BAR; PG8_MMA(1, 0, At, B0); PG8_MMA(1, 1, At, B1); PG8_BAR; PG8_SCHED;
        }
        if (wr == 0) PG8_BAR;
        E(acc, cur, wr, wc, fr, fq);
        if (!has_next) break;
#pragma unroll
        for (int a = 0; a < 2; ++a)
#pragma unroll
            for (int b = 0; b < 2; ++b)
#pragma unroll
                for (int m = 0; m < 4; ++m)
#pragma unroll
                    for (int n = 0; n < 2; ++n) acc[a][b][m][n] = (f32x4){0.f, 0.f, 0.f, 0.f};
        cur = nxt; cB = nB; ++ui;
        if (wr == 1) PG8_BAR;
    }
    PG8_WAIT_V(0);
    PG8_BAR;
#undef PG8_ROWOFF
#undef PG8_SA
#undef PG8_SB
#undef PG8_STAGE
#undef PG8_LDA
#undef PG8_LDB
#undef PG8_MMA
#undef PG8_WAIT_V
#undef PG8_WAIT_L
#undef PG8_BAR
#undef PG8_SCHED
}
}
using pg8::Unit;
using pg8::cvt_pk_bf16;

struct EpiStoreBf16 {
    static constexpr bool PERM = true;
    bf16* Ob; int unused;
    __device__ __forceinline__ void operator()(const f32x4 (&acc)[2][2][4][2], const Unit& u, int wr, int wc, int fr, int fq) const {
        if (u.c0 >= HGATE) {
            bf16* T = Ob + HB_GATE + ((size_t)(u.r0 >> 8) * 16 + ((u.c0 - HGATE) >> 8)) * 65536 + (size_t)(((wr * 4 + wc) * 64 + fq * 16 + fr) * 8);
#pragma unroll
            for (int ai = 0; ai < 2; ++ai)
#pragma unroll
                for (int m = 0; m < 4; ++m)
#pragma unroll
                    for (int bj = 0; bj < 2; ++bj) { const f32x4 v0 = acc[ai][bj][m][0], v1 = acc[ai][bj][m][1];
                        u32x4 w; w.x = cvt_pk_bf16(v0[0], v0[1]); w.y = cvt_pk_bf16(v0[2], v0[3]); w.z = cvt_pk_bf16(v1[0], v1[1]); w.w = cvt_pk_bf16(v1[2], v1[3]);
                        *(u32x4*)(T + ((ai * 4 + m) * 2 + bj) * 4096) = w; }
            return;
        }
        const int cs = u.c0 < HCONF ? 0 : (u.c0 < HGMLP ? HCONF : (u.c0 < HSC ? HGMLP : HSC));
        const int ldc = u.c0 < HCONF ? PGDN : (u.c0 < HGMLP ? PCONF : (u.c0 < HSC ? PGMLP : PSC));
        bf16* O = Ob + (size_t)M * cs;
        const int row0 = u.r0 + wr * 64 + fr, col0 = (u.c0 - cs) + wc * 32 + 8 * fq;
#pragma unroll
        for (int ai = 0; ai < 2; ++ai)
#pragma unroll
            for (int m = 0; m < 4; ++m) { bf16* rowp = O + (size_t)(row0 + ai * 128 + m * 16) * ldc + col0;
#pragma unroll
                for (int bj = 0; bj < 2; ++bj) { const f32x4 v0 = acc[ai][bj][m][0], v1 = acc[ai][bj][m][1];
                    u32x4 w; w.x = cvt_pk_bf16(v0[0], v0[1]); w.y = cvt_pk_bf16(v0[2], v0[3]); w.z = cvt_pk_bf16(v1[0], v1[1]); w.w = cvt_pk_bf16(v1[2], v1[3]);
                    *(u32x4*)(rowp + bj * 128) = w; } }
    }
};
struct EpiGate {
    static constexpr bool PERM = true;
    const bf16* Hg; bf16* MG; bf16* SC;
    __device__ __forceinline__ void operator()(const f32x4 (&acc)[2][2][4][2], const Unit& u, int wr, int wc, int fr, int fq) const {
        const int row0 = u.r0 + wr * 64 + fr, mcol0 = (u.c0 & 1023) + wc * 32 + 8 * fq; const bool first = u.c0 < 1024;
        const bf16* Tg = Hg + ((size_t)(u.r0 >> 8) * 16 + (u.c0 >> 8)) * 65536 + (size_t)(((wr * 4 + wc) * 64 + fq * 16 + fr) * 8);
        bf16* Tm = SC + ((size_t)(u.r0 >> 8) * 4 + ((u.c0 >> 8) & 3)) * 65536 + (size_t)(((wr * 4 + wc) * 64 + fq * 16 + fr) * 8); const bool lastbr = u.c0 >= 3072;
#pragma unroll
        for (int ai = 0; ai < 2; ++ai) {
            u32x4 gw[4][2], mw[4][2];
#pragma unroll
            for (int m = 0; m < 4; ++m)
#pragma unroll
                for (int bj = 0; bj < 2; ++bj) { gw[m][bj] = *(const u32x4*)(Tg + ((ai * 4 + m) * 2 + bj) * 4096);
                    mw[m][bj] = first ? (u32x4){0u, 0u, 0u, 0u} : *(const u32x4*)(Tm + ((ai * 4 + m) * 2 + bj) * 4096); }
#pragma unroll
            for (int m = 0; m < 4; ++m) { bf16* mrow = MG + (size_t)(row0 + ai * 128 + m * 16) * D + mcol0;
#pragma unroll
                for (int bj = 0; bj < 2; ++bj) { const f32x4 v0 = acc[ai][bj][m][0], v1 = acc[ai][bj][m][1];
                    float g[8], pm[8]; unpack8(gw[m][bj], g); unpack8(mw[m][bj], pm);
                    u32x4 w; w.x = cvt_pk_bf16(pm[0] + sigmoidf_(g[0]) * v0[0], pm[1] + sigmoidf_(g[1]) * v0[1]); w.y = cvt_pk_bf16(pm[2] + sigmoidf_(g[2]) * v0[2], pm[3] + sigmoidf_(g[3]) * v0[3]);
                    w.z = cvt_pk_bf16(pm[4] + sigmoidf_(g[4]) * v1[0], pm[5] + sigmoidf_(g[5]) * v1[1]); w.w = cvt_pk_bf16(pm[6] + sigmoidf_(g[6]) * v1[2], pm[7] + sigmoidf_(g[7]) * v1[3]);
                    if (lastbr) *(u32x4*)(mrow + bj * 128) = w; else *(u32x4*)(Tm + ((ai * 4 + m) * 2 + bj) * 4096) = w; } }
        }
    }
};
struct EpiRes {
    static constexpr bool PERM = true;
    const float* res32; const bf16* res16; bf16* out;
    __device__ __forceinline__ void operator()(const f32x4 (&acc)[2][2][4][2], const Unit& u, int wr, int wc, int fr, int fq) const {
        const int row0 = u.r0 + wr * 64 + fr, col0 = u.c0 + wc * 32 + 8 * fq;
#pragma unroll
        for (int ai = 0; ai < 2; ++ai) {
            float r[4][2][8];
#pragma unroll
            for (int m = 0; m < 4; ++m)
#pragma unroll
                for (int bj = 0; bj < 2; ++bj) { const size_t ro = (size_t)(row0 + ai * 128 + m * 16) * D + col0 + bj * 128;
                    if (res32) { const f32x4 a = *(const f32x4*)(res32 + ro), b = *(const f32x4*)(res32 + ro + 4); r[m][bj][0] = a[0]; r[m][bj][1] = a[1]; r[m][bj][2] = a[2]; r[m][bj][3] = a[3]; r[m][bj][4] = b[0]; r[m][bj][5] = b[1]; r[m][bj][6] = b[2]; r[m][bj][7] = b[3]; }
                    else unpack8(*(const u32x4*)(res16 + ro), r[m][bj]); }
#pragma unroll
            for (int m = 0; m < 4; ++m)
#pragma unroll
                for (int bj = 0; bj < 2; ++bj) { const size_t ro = (size_t)(row0 + ai * 128 + m * 16) * D + col0 + bj * 128; const f32x4 v0 = acc[ai][bj][m][0], v1 = acc[ai][bj][m][1];
                    u32x4 w; w.x = cvt_pk_bf16(r[m][bj][0] + v0[0], r[m][bj][1] + v0[1]); w.y = cvt_pk_bf16(r[m][bj][2] + v0[2], r[m][bj][3] + v0[3]);
                    w.z = cvt_pk_bf16(r[m][bj][4] + v1[0], r[m][bj][5] + v1[1]); w.w = cvt_pk_bf16(r[m][bj][6] + v1[2], r[m][bj][7] + v1[3]);
                    *(u32x4*)(out + ro) = w; }
        }
    }
};
struct EpiSwiglu {
    static constexpr bool PERM = true;
    bf16* O;
    __device__ __forceinline__ void operator()(const f32x4 (&acc)[2][2][4][2], const Unit& u, int wr, int wc, int fr, int fq) const {
        const int row0 = u.r0 + wr * 64 + fr, col0 = u.c0 + wc * 32 + 8 * fq;
#pragma unroll
        for (int ai = 0; ai < 2; ++ai)
#pragma unroll
            for (int m = 0; m < 4; ++m) { bf16* rowp = O + (size_t)(row0 + ai * 128 + m * 16) * DE + col0;
                const f32x4 g0 = acc[ai][0][m][0], g1 = acc[ai][0][m][1], u0 = acc[ai][1][m][0], u1 = acc[ai][1][m][1];
                u32x4 w; w.x = cvt_pk_bf16(siluf_(g0[0]) * u0[0], siluf_(g0[1]) * u0[1]); w.y = cvt_pk_bf16(siluf_(g0[2]) * u0[2], siluf_(g0[3]) * u0[3]);
                w.z = cvt_pk_bf16(siluf_(g1[0]) * u1[0], siluf_(g1[1]) * u1[1]); w.w = cvt_pk_bf16(siluf_(g1[2]) * u1[2], siluf_(g1[3]) * u1[3]);
                *(u32x4*)rowp = w; }
    }
};
struct EpiScatter {
    static constexpr bool PERM = true;
    bf16* Y; const int* row_code; const float* row_w;
    __device__ __forceinline__ void operator()(const f32x4 (&acc)[2][2][4][2], const Unit& u, int wr, int wc, int fr, int fq) const {
        const int row0 = u.r0 + wr * 64 + fr, col0 = u.c0 + wc * 32 + 8 * fq;
        int codes[2][4]; float rws[2][4];
#pragma unroll
        for (int ai = 0; ai < 2; ++ai)
#pragma unroll
            for (int m = 0; m < 4; ++m) { codes[ai][m] = row_code[row0 + ai * 128 + m * 16]; rws[ai][m] = row_w[row0 + ai * 128 + m * 16]; }
        __builtin_amdgcn_sched_barrier(0);
#pragma unroll
        for (int ai = 0; ai < 2; ++ai)
#pragma unroll
            for (int m = 0; m < 4; ++m) { const int code = codes[ai][m]; const float rw = rws[ai][m];
                if (code >= 0) { bf16* rowp = Y + (size_t)(code & 1) * ((size_t)M * D) + (size_t)(code >> 1) * D + col0;
#pragma unroll
                    for (int bj = 0; bj < 2; ++bj) { const f32x4 v0 = acc[ai][bj][m][0] * rw, v1 = acc[ai][bj][m][1] * rw;
                        u32x4 w; w.x = cvt_pk_bf16(v0[0], v0[1]); w.y = cvt_pk_bf16(v0[2], v0[3]); w.z = cvt_pk_bf16(v1[0], v1[1]); w.w = cvt_pk_bf16(v1[2], v1[3]);
                        *(u32x4*)(rowp + bj * 128) = w; } } }
    }
};

struct SchedH {
    pg8::TileOrder to; const char* A; const char* B;
    __device__ __forceinline__ bool next(int i, Unit& u) const { int pm, pn; if (!to.next(i, pm, pn)) return false;
        u.A = A + (size_t)pm * 256 * D * 2; u.B = B + (size_t)pn * 256 * D * 2; u.r0 = pm * 256; u.c0 = pn * 256; return true; }
};
struct SchedBranch {
    pg8::TileOrder to; const char* YS; const char* WBR;
    __device__ __forceinline__ bool next(int i, Unit& u) const { int pm, q; if (!to.next(i >> 2, pm, q)) return false; const int br = i & 3;
        u.A = YS + ((size_t)br * M * 512 + (size_t)pm * 256 * 512) * 2; u.B = WBR + ((size_t)br * D * 512 + (size_t)q * 256 * 512) * 2; u.r0 = pm * 256; u.c0 = br * 1024 + q * 256; return true; }
};
struct SchedOut {
    pg8::TileOrder to; const char* A; const char* B;
    __device__ __forceinline__ bool next(int i, Unit& u) const { int pm, pn; if (!to.next(i, pm, pn)) return false;
        u.A = A + (size_t)pm * 256 * D * 2; u.B = B + (size_t)pn * 256 * D * 2; u.r0 = pm * 256; u.c0 = pn * 256; return true; }
};
struct SchedMoe {
    int nux, nrank, rank, nk, x, NX; const LAS int* cum; const LAS int* rb0; const char* A; size_t a_blk; const char* W; size_t w_e, w_pn; int cmul;
    __device__ __forceinline__ bool next(int i, Unit& u) const { const int ui = i * nrank + rank; if (ui >= nux) return false;
        int k = 0; while (k + 1 < nk && cum[k + 1] <= ui) ++k;
        const int local = ui - cum[k], rb = rb0[k] + (local >> 2), pn = local & 3, e = x + NX * k;
        u.A = A + (size_t)rb * a_blk; u.B = W + (size_t)e * w_e + (size_t)pn * w_pn; u.r0 = rb * 256; u.c0 = pn * cmul; return true; }
};

struct Params { const float* in[25]; float* out; unsigned char* ws; int ph_lo, ph_hi; };
enum { I_X = 0, I_MIXNW, I_WIN, I_GCONV, I_GALOG, I_GDT, I_GNW, I_CCW, I_CCB, I_CLNW, I_CLNB, I_GLNW, I_GLNB, I_GWS, I_GBS, I_SCW, I_WBR, I_WOUT, I_MOENW, I_RGRP, I_REXP, I_WG, I_WU, I_WD, I_FNW };
constexpr int PH_PER_LAYER = 12, PH_FINAL = 24, PH_TOTAL = 25;
#define TSF(slot, cond) do { if (TP_A >= 0 && blockIdx.x == 0 && tid == 0 && (cond)) __hip_atomic_store((unsigned long long*)(p.ws + WS_CTL + 131072) + (slot), (unsigned long long)__builtin_amdgcn_s_memrealtime(), __ATOMIC_RELAXED, __HIP_MEMORY_SCOPE_AGENT); } while (0)

__device__ __forceinline__ void transpose_item(const float* __restrict__ W, int ldw, int srccol, bf16* __restrict__ WT, int ldt, int k0, int n0, int lane) {
    const int kq = lane & 7, nq = lane >> 3;
    f32x4 v[8][2];
#pragma unroll
    for (int r = 0; r < 8; ++r) { const float* s = W + (size_t)(k0 + 8 * kq + r) * ldw + srccol + 8 * nq; v[r][0] = *(const f32x4*)s; v[r][1] = *(const f32x4*)(s + 4); }
#pragma unroll
    for (int e = 0; e < 8; ++e) { u32x4 o; o.x = pk2(v[0][e >> 2][e & 3], v[1][e >> 2][e & 3]); o.y = pk2(v[2][e >> 2][e & 3], v[3][e >> 2][e & 3]); o.z = pk2(v[4][e >> 2][e & 3], v[5][e >> 2][e & 3]); o.w = pk2(v[6][e >> 2][e & 3], v[7][e >> 2][e & 3]);
        *(u32x4*)(WT + (size_t)(n0 + 8 * nq + e) * ldt + k0 + 8 * kq) = o; }
}
struct TItem { const float* src; bf16* dst; int ldw, ldt; };
__device__ __forceinline__ void titem_load(const TItem& t, f32x4 (&v)[8][2]) {
#pragma unroll
    for (int r = 0; r < 8; ++r) { const float* s = t.src + (size_t)r * t.ldw; v[r][0] = *(const f32x4*)s; v[r][1] = *(const f32x4*)(s + 4); }
}
__device__ __forceinline__ void titem_store(const TItem& t, const f32x4 (&v)[8][2]) {
#pragma unroll
    for (int e = 0; e < 8; ++e) { u32x4 o; o.x = pk2(v[0][e >> 2][e & 3], v[1][e >> 2][e & 3]); o.y = pk2(v[2][e >> 2][e & 3], v[3][e >> 2][e & 3]); o.z = pk2(v[4][e >> 2][e & 3], v[5][e >> 2][e & 3]); o.w = pk2(v[6][e >> 2][e & 3], v[7][e >> 2][e & 3]);
        *(u32x4*)(t.dst + (size_t)e * t.ldt) = o; }
}
__device__ __forceinline__ TItem moe_item(const Params& p, int layer, int it, int lane) {
    constexpr int I_GU = 16 * 16, I_D = 8 * 16, PER_E = I_GU + I_D;
    const int kq = lane & 7, nq = lane >> 3; const int e = it / PER_E; int r = it % PER_E; TItem t;
    if (r < I_GU) { const int kb = r / 16, nb = r % 16, n0 = nb * 64, pn = n0 >> 8, half = (n0 >> 7) & 1, j0 = n0 & 127;
        t.src = p.in[half ? I_WU : I_WG] + ((size_t)layer * NE + e) * D * DE + (size_t)(kb * 64 + 8 * kq) * DE + 128 * pn + j0 + 8 * nq; t.ldw = DE;
        t.dst = (bf16*)(p.ws + WS_MOEW + e * WGU_E) + (size_t)(n0 + 8 * nq) * D + kb * 64 + 8 * kq; t.ldt = D; }
    else { r -= I_GU; const int kb = r / 16, nb = r % 16;
        t.src = p.in[I_WD] + ((size_t)layer * NE + e) * DE * D + (size_t)(kb * 64 + 8 * kq) * D + nb * 64 + 8 * nq; t.ldw = D;
        t.dst = (bf16*)(p.ws + WS_WD + e * WD_E) + (size_t)(nb * 64 + 8 * nq) * DE + kb * 64 + 8 * kq; t.ldt = DE; }
    return t;
}
__device__ __forceinline__ void prep_moe_weights(const Params& p, int layer, int gw, int NGW, int lane) {
    constexpr int NIT = NE * (16 * 16 + 8 * 16);
    for (int it = gw; it < NIT; it += 2 * NGW) {
        const TItem ta = moe_item(p, layer, it, lane); const bool two = it + NGW < NIT; const TItem tb = moe_item(p, layer, two ? it + NGW : it, lane);
        f32x4 va[8][2], vb[8][2];
        titem_load(ta, va); titem_load(tb, vb);
        titem_store(ta, va); if (two) titem_store(tb, vb);
    }
}

__device__ __forceinline__ TItem static_item(const Params& p, int l, int it, int lane) {
    constexpr int I_IN = 16 * (DH / 64), I_BR = 8 * 16;
    const int kq = lane & 7, nq = lane >> 3; int r = it; TItem t;
    if (r < I_IN) { const int kb = r / (DH / 64), nb = r % (DH / 64), n0 = nb * 64;
        t.src = p.in[I_WIN] + (size_t)l * D * DIN + (size_t)(kb * 64 + 8 * kq) * DIN + n0 + (n0 >= 2048 ? 8 : 0) + 8 * nq; t.ldw = DIN;
        t.dst = (bf16*)(p.ws + WS_WIN + l * WIN_L) + (size_t)(n0 + 8 * nq) * D + kb * 64 + 8 * kq; t.ldt = D; return t; }
    r -= I_IN;
    if (r < 4 * I_BR) { const int br = r / I_BR, q = r % I_BR, kb = q / 16, nb = q % 16;
        t.src = p.in[I_WBR] + ((size_t)l * 4 + br) * 512 * D + (size_t)(kb * 64 + 8 * kq) * D + nb * 64 + 8 * nq; t.ldw = D;
        t.dst = (bf16*)(p.ws + WS_WBR + l * WBR_L) + (size_t)br * D * 512 + (size_t)(nb * 64 + 8 * nq) * 512 + kb * 64 + 8 * kq; t.ldt = 512; return t; }
    r -= 4 * I_BR;
    { const int kb = r / 16, nb = r % 16;
        t.src = p.in[I_WOUT] + (size_t)l * D * D + (size_t)(kb * 64 + 8 * kq) * D + nb * 64 + 8 * nq; t.ldw = D;
        t.dst = (bf16*)(p.ws + WS_WOUT + l * WOUT_L) + (size_t)(nb * 64 + 8 * nq) * D + kb * 64 + 8 * kq; t.ldt = D; return t; }
}
__device__ __forceinline__ void prep_static_weights(const Params& p, int l, int gw, int NGW, int lane) {
    constexpr int PER_L = 16 * (DH / 64) + 4 * 8 * 16 + 16 * 16;
    for (int it = gw; it < PER_L; it += 2 * NGW) {
        const TItem ta = static_item(p, l, it, lane); const bool two = it + NGW < PER_L; const TItem tb = static_item(p, l, two ? it + NGW : it, lane);
        f32x4 va[8][2], vb[8][2];
        titem_load(ta, va); titem_load(tb, vb);
        titem_store(ta, va); if (two) titem_store(tb, vb);
    }
}

template <int MODE>
__device__ __forceinline__ void norm_phase(const Params& p, int layer, LAS unsigned char* lds, int gw, int NGW, int tid, int lane) {
    const float* nwp = (MODE == 2) ? p.in[I_FNW] : p.in[I_MIXNW] + layer * D;
    f32x4 nw[4];
#pragma unroll
    for (int j = 0; j < 4; ++j) nw[j] = *(const f32x4*)(nwp + 4 * lane + 256 * j);
    f32x4 ws0[16], ws1[16];
    if (MODE != 2) { const float* wi = p.in[I_WIN] + (size_t)layer * D * DIN + 2048;
#pragma unroll
        for (int j = 0; j < 4; ++j)
#pragma unroll
            for (int c = 0; c < 4; ++c) { const float* wr = wi + (size_t)(4 * lane + 256 * j + c) * DIN; ws0[j * 4 + c] = *(const f32x4*)wr; ws1[j * 4 + c] = *(const f32x4*)(wr + 4); } }
    const bf16* Y0 = (const bf16*)(p.ws + WS_Y); const bf16* Y1 = Y0 + (size_t)M * D;
    bf16* XN = (bf16*)(p.ws + WS_XN); float* SMALL = (float*)(p.ws + WS_SMALL);
    const float* xbase = p.in[I_X]; const bf16* xb16 = (const bf16*)(p.ws + WS_X1B); bf16* x2b = (bf16*)p.out;
    f32x4 vn[4]; u32x2 an[4], bn[4], xn16[4];
#define NP_LOAD(mm) do { _Pragma("unroll") for (int j = 0; j < 4; ++j) { \
        if (MODE == 0) vn[j] = *(const f32x4*)(xbase + (size_t)(mm) * D + 4 * lane + 256 * j); \
        else { xn16[j] = *(const u32x2*)(xb16 + (size_t)(mm) * D + 4 * lane + 256 * j); an[j] = *(const u32x2*)(Y0 + (size_t)(mm) * D + 4 * lane + 256 * j); bn[j] = *(const u32x2*)(Y1 + (size_t)(mm) * D + 4 * lane + 256 * j); } } } while (0)
    if (gw < M) NP_LOAD(gw);
    for (int m = gw; m < M; m += NGW) {
        f32x4 v[4]; float ss = 0.f;
#pragma unroll
        for (int j = 0; j < 4; ++j) {
            if (MODE == 0) v[j] = vn[j];
            else { v[j][0] = bf_lo(xn16[j].x) + bf_lo(an[j].x) + bf_lo(bn[j].x); v[j][1] = bf_hi(xn16[j].x) + bf_hi(an[j].x) + bf_hi(bn[j].x); v[j][2] = bf_lo(xn16[j].y) + bf_lo(an[j].y) + bf_lo(bn[j].y); v[j][3] = bf_hi(xn16[j].y) + bf_hi(an[j].y) + bf_hi(bn[j].y); } }
        if (m + NGW < M) NP_LOAD(m + NGW);
#pragma unroll
        for (int j = 0; j < 4; ++j) ss += (v[j][0] * v[j][0] + v[j][1] * v[j][1]) + (v[j][2] * v[j][2] + v[j][3] * v[j][3]);
        const float rs = __builtin_amdgcn_rsqf(wave_sum(ss) * (1.0f / D) + EPS);
        if (MODE == 2) {
#pragma unroll
            for (int j = 0; j < 4; ++j) *(f32x4*)(p.out + (size_t)m * D + 4 * lane + 256 * j) = v[j] * rs * nw[j];
            continue;
        }
        if (MODE == 1) {
#pragma unroll
            for (int j = 0; j < 4; ++j) { u32x2 o; o.x = pk2(v[j][0], v[j][1]); o.y = pk2(v[j][2], v[j][3]); *(u32x2*)(x2b + (size_t)m * D + 4 * lane + 256 * j) = o; }
        }
        f32x4 s0 = (f32x4){0.f, 0.f, 0.f, 0.f}, s1 = s0;
#pragma unroll
        for (int j = 0; j < 4; ++j) { v[j] = v[j] * rs * nw[j];
            u32x2 o; o.x = pk2(v[j][0], v[j][1]); o.y = pk2(v[j][2], v[j][3]); *(u32x2*)(XN + (size_t)m * D + 4 * lane + 256 * j) = o;
#pragma unroll
            for (int c = 0; c < 4; ++c) { s0 += ws0[j * 4 + c] * v[j][c]; s1 += ws1[j * 4 + c] * v[j][c]; } }
        const bool b0 = lane & 1, b1 = lane & 2, b2 = lane & 4;
        f32x4 a;
#pragma unroll
        for (int i = 0; i < 4; ++i) { const float send = b0 ? s0[i] : s1[i]; const float recv = __shfl_xor(send, 1); a[i] = (b0 ? s1[i] : s0[i]) + recv; }
        float bb[2];
#pragma unroll
        for (int i = 0; i < 2; ++i) { const float send = b1 ? a[i] : a[2 + i]; const float recv = __shfl_xor(send, 2); bb[i] = (b1 ? a[2 + i] : a[i]) + recv; }
        float cc; { const float send = b2 ? bb[0] : bb[1]; const float recv = __shfl_xor(send, 4); cc = (b2 ? bb[1] : bb[0]) + recv; }
        cc += __shfl_xor(cc, 8); cc += __shfl_xor(cc, 16); cc += __shfl_xor(cc, 32);
        if (lane < 8) SMALL[(size_t)m * 8 + ((lane >> 2) & 1) + 2 * ((lane >> 1) & 1) + 4 * (lane & 1)] = cc;
    }
#undef NP_LOAD
    lds_sync();
}

struct ScW { float w[3][8]; };
__device__ __forceinline__ void shortconv_unit(const Params& p, const ScW& cw, int tid, int unit) {
    const bf16* H = (const bf16*)(p.ws + WS_H); bf16* YS = (bf16*)(p.ws + WS_YS);
    const int c8 = (tid & 63) * 8, m0 = unit * 64 + (tid >> 6) * 8, t0 = m0 & (T - 1);
    const bf16* base = H + HB_SC + (size_t)m0 * PSC + c8;
    u32x4 rc[10], rx[10], rb[8];
#pragma unroll
    for (int r = 0; r < 10; ++r) { const bool ok = (r >= 2) || (t0 != 0); const bf16* s = base + (ptrdiff_t)(ok ? r - 2 : 0) * PSC; rc[r] = *(const u32x4*)(s + 512); rx[r] = *(const u32x4*)(s + 1024); if (!ok) rc[r] = (u32x4){0u, 0u, 0u, 0u}; }
#pragma unroll
    for (int r = 0; r < 8; ++r) rb[r] = *(const u32x4*)(base + (size_t)r * PSC);
    float cx[10][8];
#pragma unroll
    for (int r = 0; r < 10; ++r) { float cg[8], xv[8]; unpack8(rc[r], cg); unpack8(rx[r], xv);
#pragma unroll
        for (int i = 0; i < 8; ++i) cx[r][i] = cg[i] * xv[i]; }
#pragma unroll
    for (int r = 0; r < 8; ++r) { float bg[8], acc[8]; unpack8(rb[r], bg);
#pragma unroll
        for (int i = 0; i < 8; ++i) acc[i] = bg[i] * (cw.w[0][i] * cx[r][i] + cw.w[1][i] * cx[r + 1][i] + cw.w[2][i] * cx[r + 2][i]);
        *(u32x4*)(YS + (size_t)3 * M * 512 + (size_t)(m0 + r) * 512 + c8) = pack8(acc); }
}
__device__ __forceinline__ int queue_pop(unsigned* counter, LAS unsigned char* lds, int tid) {
    LAS int* slot = (LAS int*)(lds + LDSCTL_OFF + LC_MISC);
    lds_sync();
    if (tid == 0) slot[0] = (int)__hip_atomic_fetch_add(counter, 1u, __ATOMIC_RELAXED, __HIP_MEMORY_SCOPE_AGENT);
    lds_sync();
    return slot[0];
}
__device__ __forceinline__ void conformer(const Params& p, int layer, LAS unsigned char* lds, int tid, int wave, int lane, unsigned* counter) {
    const bf16* H = (const bf16*)(p.ws + WS_H); bf16* YS = (bf16*)(p.ws + WS_YS);
    LAS bf16* yt = (LAS bf16*)lds; LAS float* z16 = (LAS float*)(lds + 96256);
    const f32x4 lw0 = *(const f32x4*)(p.in[I_CLNW] + layer * 512 + 4 * lane), lw1 = *(const f32x4*)(p.in[I_CLNW] + layer * 512 + 256 + 4 * lane);
    const f32x4 lb0 = *(const f32x4*)(p.in[I_CLNB] + layer * 512 + 4 * lane), lb1 = *(const f32x4*)(p.in[I_CLNB] + layer * 512 + 256 + 4 * lane);
    for (;;) {
        const int unit = queue_pop(counter, lds, tid); if (unit >= M / 64) break;
        const int m0 = unit * 64, t0 = m0 & (T - 1);
        int tv = tid; asm volatile("" : "+v"(tv));
        const int cp = tv & 255, hq = tv >> 8, ln = tv & 63;
        const float* cwp = p.in[I_CCW] + (size_t)layer * 31 * 512 + 2 * cp;
        {   u32x4 ra[12], rg[12];
#pragma unroll
            for (int k = 0; k < 12; ++k) { const int it = k * 512 + tv; const int r = it >> 6, c8 = (it & 63) * 8, dt = r - 30; const bool ok = (it < 94 * 64) && (t0 + dt >= 0);
                const bf16* s = H + HB_CONF + (size_t)(ok ? m0 + dt : m0) * PCONF + c8; ra[k] = *(const u32x4*)s; rg[k] = *(const u32x4*)(s + 512); }
#pragma unroll
            for (int k = 0; k < 12; ++k) { const int it = k * 512 + tv; const int r = it >> 6, c8 = (it & 63) * 8, dt = r - 30;
                if (it < 94 * 64) { float a[8], g[8]; unpack8(ra[k], a); unpack8(rg[k], g);
#pragma unroll
                    for (int i = 0; i < 8; ++i) a[i] *= sigmoidf_(g[i]);
                    u32x4 o = pack8(a); if (t0 + dt < 0) o = (u32x4){0u, 0u, 0u, 0u};
                    *(LAS u32x4*)(yt + r * 512 + c8) = o; } }
        }
        f32x2 cw2[31];
#pragma unroll
        for (int j = 0; j < 31; ++j) cw2[j] = *(const f32x2*)(cwp + j * 512);
        const f32x2 cb2 = *(const f32x2*)(p.in[I_CCB] + layer * 512 + 2 * cp);
        lds_sync();
#pragma unroll 1
        for (int tq = 0; tq < 4; ++tq) {
            f32x2 y2[38];
#pragma unroll
            for (int r = 0; r < 38; ++r) { const unsigned w = *(const LAS unsigned*)(yt + (tq * 16 + hq * 8 + r) * 512 + 2 * cp); y2[r] = (f32x2){bf_lo(w), bf_hi(w)}; }
            f32x2 z[8];
#pragma unroll
            for (int i = 0; i < 8; ++i) z[i] = cb2;
#pragma unroll
            for (int j = 0; j < 31; ++j)
#pragma unroll
                for (int i = 0; i < 8; ++i) z[i] = __builtin_elementwise_fma(cw2[j], y2[i + j], z[i]);
#pragma unroll
            for (int i = 0; i < 8; ++i) *(LAS f32x2*)(z16 + (hq * 8 + i) * 512 + 2 * cp) = z[i];
            lds_sync();
            {   f32x4 za[2], zb[2]; float mean[2], rstd[2];
#pragma unroll
                for (int k = 0; k < 2; ++k) { za[k] = *(const LAS f32x4*)(z16 + (wave * 2 + k) * 512 + 4 * ln); zb[k] = *(const LAS f32x4*)(z16 + (wave * 2 + k) * 512 + 256 + 4 * ln); }
#pragma unroll
                for (int k = 0; k < 2; ++k) mean[k] = wave_sum(((za[k][0] + za[k][1]) + (za[k][2] + za[k][3])) + ((zb[k][0] + zb[k][1]) + (zb[k][2] + zb[k][3]))) * (1.0f / 512.0f);
#pragma unroll
                for (int k = 0; k < 2; ++k) { za[k] = za[k] - mean[k]; zb[k] = zb[k] - mean[k];
                    const f32x4 qa = za[k] * za[k], qb = zb[k] * zb[k];
                    rstd[k] = __builtin_amdgcn_rsqf(wave_sum(((qa[0] + qa[1]) + (qa[2] + qa[3])) + ((qb[0] + qb[1]) + (qb[2] + qb[3]))) * (1.0f / 512.0f) + EPS); }
#pragma unroll
                for (int k = 0; k < 2; ++k) { const f32x4 va = za[k] * rstd[k] * lw0 + lb0, vb = zb[k] * rstd[k] * lw1 + lb1;
                    bf16* orow = YS + (size_t)1 * M * 512 + (size_t)(m0 + tq * 16 + wave * 2 + k) * 512 + 4 * ln;
                    u32x2 oa, ob; oa.x = pk2(siluf_(va[0]), siluf_(va[1])); oa.y = pk2(siluf_(va[2]), siluf_(va[3])); ob.x = pk2(siluf_(vb[0]), siluf_(vb[1])); ob.y = pk2(siluf_(vb[2]), siluf_(vb[3]));
                    *(u32x2*)orow = oa; *(u32x2*)(orow + 256) = ob; }
            }
            lds_sync();
        }
    }
}
__device__ __forceinline__ f32x4 mfma16(bf16x8 a, bf16x8 b, f32x4 c) { return __builtin_amdgcn_mfma_f32_16x16x32_bf16(a, b, c, 0, 0, 0); }
typedef short bf16x4 __attribute__((ext_vector_type(4)));
__device__ __forceinline__ bf16x8 ld_frag16(const LAS unsigned char* p) { return *(const LAS bf16x8*)p; }
__device__ __forceinline__ bf16x8 ld_frag8x2(const LAS unsigned char* p) { const bf16x4 a = *(const LAS bf16x4*)p, b = *(const LAS bf16x4*)(p + 32); return __builtin_shufflevector(a, b, 0, 1, 2, 3, 4, 5, 6, 7); }
__device__ __forceinline__ bf16x8 pack_frag(const f32x4 lo, const f32x4 hi) { u32x4 w; w.x = cvt_pk_bf16(lo[0], lo[1]); w.y = cvt_pk_bf16(lo[2], lo[3]); w.z = cvt_pk_bf16(hi[0], hi[1]); w.w = cvt_pk_bf16(hi[2], hi[3]); return __builtin_bit_cast(bf16x8, w); }
constexpr int GM_W = 0, GM_VT = 34816, GM_ST = 69632;
__device__ __forceinline__ void gmlp(const Params& p, int layer, LAS unsigned char* lds, int tid, int wave, int lane, unsigned* counter) {
    const bf16* H = (const bf16*)(p.ws + WS_H); bf16* YS = (bf16*)(p.ws + WS_YS);
    const int q = lane >> 4, li = lane & 15;
    float lw[8], lb[8];
#pragma unroll
    for (int i = 0; i < 8; ++i) { lw[i] = p.in[I_GLNW][layer * 512 + lane * 8 + i]; lb[i] = p.in[I_GLNB][layer * 512 + lane * 8 + i]; }
    for (;;) {
        const int unit = queue_pop(counter, lds, tid); if (unit >= M / 128) break;
        const int m0 = unit * 128;
        const bf16* Hv = H + HB_GMLP + (size_t)m0 * PGMLP + 512;
        u32x4 rv[16];
#pragma unroll
        for (int k = 0; k < 16; ++k) rv[k] = *(const u32x4*)(Hv + (size_t)(wave * 16 + k) * PGMLP + lane * 8);
#pragma unroll
        for (int k = 0; k < 16; ++k) {
            float v[8]; unpack8(rv[k], v);
            float s = 0.f;
#pragma unroll
            for (int i = 0; i < 8; ++i) { v[i] = gelu_tanh(v[i]); s += v[i]; }
            const float mean = wave_sum(s) * (1.0f / 512.0f); float qq = 0.f;
#pragma unroll
            for (int i = 0; i < 8; ++i) { v[i] -= mean; qq += v[i] * v[i]; }
            const float rstd = __builtin_amdgcn_rsqf(wave_sum(qq) * (1.0f / 512.0f) + EPS);
#pragma unroll
            for (int i = 0; i < 8; ++i) v[i] = v[i] * rstd * lw[i] + lb[i];
            rv[k] = pack8(v);
        }
        for (int g = 0; g < 4; ++g) {
            const float* ws = p.in[I_GWS] + ((size_t)layer * 4 + g) * 128 * 128;
            f32x4 wa[4], wb[4]; u32x2 uw[8];
#pragma unroll
            for (int k = 0; k < 4; ++k) { const int it = tid + 512 * k; wa[k] = *(const f32x4*)(ws + (it >> 4) * 128 + (it & 15) * 8); wb[k] = *(const f32x4*)(ws + (it >> 4) * 128 + (it & 15) * 8 + 4); }
            { const bf16* urow = H + HB_GMLP + (size_t)(m0 + 16 * wave + li) * PGMLP + g * 128 + 4 * q;
#pragma unroll
                for (int ct = 0; ct < 8; ++ct) uw[ct] = *(const u32x2*)(urow + 16 * ct); }
            if (q == g) {
#pragma unroll
                for (int i = 0; i < 8; ++i)
#pragma unroll
                    for (int h = 0; h < 2; ++h) { u32x4 o;
                        const unsigned sel = (i & 1) ? 0x07060302u : 0x05040100u;
#define GM_EL(t) (((i >> 1) == 0) ? rv[8 * h + (t)].x : ((i >> 1) == 1) ? rv[8 * h + (t)].y : ((i >> 1) == 2) ? rv[8 * h + (t)].z : rv[8 * h + (t)].w)
                        o.x = __builtin_amdgcn_perm(GM_EL(1), GM_EL(0), sel); o.y = __builtin_amdgcn_perm(GM_EL(3), GM_EL(2), sel); o.z = __builtin_amdgcn_perm(GM_EL(5), GM_EL(4), sel); o.w = __builtin_amdgcn_perm(GM_EL(7), GM_EL(6), sel);
#undef GM_EL
                        *(LAS u32x4*)(lds + GM_VT + (8 * li + i) * 272 + (((2 * wave + h) ^ li) << 4)) = o; }
            }
#pragma unroll
            for (int k = 0; k < 4; ++k) { const int it = tid + 512 * k; const int i = it >> 4, j8 = (it & 15) * 8;
                const f32x4 a = wa[k], b = wb[k];
                float w[8] = {a[0], a[1], a[2], a[3], b[0], b[1], b[2], b[3]};
#pragma unroll
                for (int e = 0; e < 8; ++e) w[e] = (j8 + e <= i) ? w[e] : 0.f;
                *(LAS u32x4*)(lds + GM_W + i * 272 + j8 * 2) = pack8(w); }
            lds_sync();
            {
                f32x4 acc[8];
#pragma unroll
                for (int ct = 0; ct < 8; ++ct) acc[ct] = (f32x4){0.f, 0.f, 0.f, 0.f};
                const int nks = (wave >> 1) + 1;
                for (int ks = 0; ks < nks; ++ks) { const bf16x8 wf = ld_frag16(lds + GM_W + (16 * wave + li) * 272 + (32 * ks + 8 * q) * 2);
#pragma unroll
                    for (int ct = 0; ct < 8; ++ct) acc[ct] = mfma16(ld_frag16(lds + GM_VT + (16 * ct + li) * 272 + (((4 * ks + q) ^ ((2 * ct + (li >> 3)) & 15)) << 4)), wf, acc[ct]); }
                const int i = 16 * wave + li; const float bs = p.in[I_GBS][((size_t)layer * 4 + g) * 128 + i];
                bf16* orow = YS + (size_t)2 * M * 512 + (size_t)(m0 + i) * 512 + g * 128 + 4 * q;
#pragma unroll
                for (int ct = 0; ct < 8; ++ct) { const u32x2 u_ = uw[ct];
                    const float o0 = gelu_tanh(bf_lo(u_.x)) * (acc[ct][0] + bs), o1 = gelu_tanh(bf_hi(u_.x)) * (acc[ct][1] + bs), o2 = gelu_tanh(bf_lo(u_.y)) * (acc[ct][2] + bs), o3 = gelu_tanh(bf_hi(u_.y)) * (acc[ct][3] + bs);
                    u32x2 ow; ow.x = pk2(o0, o1); ow.y = pk2(o2, o3); *(u32x2*)(orow + 16 * ct) = ow; }
            }
            lds_sync();
        }
    }
}
constexpr int CP_QN = 0, CP_KN = 17408, CP_KT = 34816, CP_VT = 53248, CP_KGT = 71680, CP_A32 = 90112, CP_ATT = 106496, CP_T16 = 115712, CP_TAB = 124928;
__device__ __forceinline__ f32x4 mfma_f32(float a, float b, f32x4 c) { return __builtin_amdgcn_mfma_f32_16x16x4f32(a, b, c, 0, 0, 0); }
__device__ __forceinline__ void gdn_chunk_prep(const Params& p, int layer, LAS unsigned char* lds, int tid, int wave, int lane) {
    const bf16* H = (const bf16*)(p.ws + WS_H); const float* SMALL = (const float*)(p.ws + WS_SMALL);
    const float* cw = p.in[I_GCONV] + (size_t)layer * 4 * 1536;
    LAS float* tab = (LAS float*)(lds + CP_TAB);
    const int q = lane >> 4, li = lane & 15;
    unsigned raw[3][11]; float br_ = 0.f, ar_ = 0.f;
#define CP_FETCH(uu) do { const int n_ = (uu) & 63, hh_ = ((uu) >> 6) & 3, b_ = (uu) >> 8; const int m0_ = b_ * T + n_ * 64, i0_ = wave * 8, t0_ = n_ * 64 + i0_; \
        _Pragma("unroll") for (int s = 0; s < 3; ++s) _Pragma("unroll") for (int r = 0; r < 11; ++r) raw[s][r] = (t0_ - 3 + r >= 0) ? *(const unsigned*)(H + HB_GDN + (size_t)(m0_ + i0_ - 3 + r) * PGDN + s * 512 + hh_ * 128 + 2 * lane) : 0u; \
        br_ = SMALL[(size_t)(m0_ + lane) * 8 + hh_]; ar_ = SMALL[(size_t)(m0_ + lane) * 8 + 4 + hh_]; } while (0)
    if ((int)blockIdx.x < 2048) CP_FETCH((int)blockIdx.x);
    for (int unit = blockIdx.x; unit < 2048; unit += gridDim.x) {
        const int n = unit & 63, hh = (unit >> 6) & 3, b = unit >> 8;
        unsigned char* rec = p.ws + WS_REC + (size_t)((b * 4 + hh) * 64 + n) * REC_BYTES;
        const int i0 = wave * 8;
        float w0[3][4], w1[3][4];
#pragma unroll
        for (int s = 0; s < 3; ++s)
#pragma unroll
            for (int j = 0; j < 4; ++j) { const f32x2 ww = *(const f32x2*)(cw + j * 1536 + s * 512 + hh * 128 + 2 * lane); w0[s][j] = ww[0]; w1[s][j] = ww[1]; }
        const float beta_l = sigmoidf_(br_);
        float g_l = -__expf(p.in[I_GALOG][layer * 4 + hh]) * softplusf_(ar_ + p.in[I_GDT][layer * 4 + hh]);
#pragma unroll
        for (int o = 1; o < 64; o <<= 1) { const float t = __shfl_up(g_l, o); if (lane >= o) g_l += t; }
        const float gam_l = __expf(g_l);
        lds_sync();
        if (wave == 0) { tab[lane] = beta_l; tab[64 + lane] = g_l; tab[128 + lane] = gam_l; }
        {
            float tk[2][8], tv[2][8], tg[2][8];
#pragma unroll
            for (int ii = 0; ii < 8; ++ii) { const int i = i0 + ii;
                float y[3][2];
#pragma unroll
                for (int s = 0; s < 3; ++s) { float a0 = 0.f, a1 = 0.f;
#pragma unroll
                    for (int j = 0; j < 4; ++j) { a0 += w0[s][j] * bf_lo(raw[s][ii + j]); a1 += w1[s][j] * bf_hi(raw[s][ii + j]); }
                    y[s][0] = siluf_(a0); y[s][1] = siluf_(a1); }
                const float sq = wave_sum(y[0][0] * y[0][0] + y[0][1] * y[0][1]), sk = wave_sum(y[1][0] * y[1][0] + y[1][1] * y[1][1]);
                const float rq = 0.08838834764831845f * __builtin_amdgcn_rsqf(sq + EPS), rk = __builtin_amdgcn_rsqf(sk + EPS);
                const float be = __builtin_bit_cast(float, __builtin_amdgcn_readlane(__builtin_bit_cast(int, beta_l), i)), bg = be * __builtin_bit_cast(float, __builtin_amdgcn_readlane(__builtin_bit_cast(int, gam_l), i));
                const float k0 = y[1][0] * rk, k1 = y[1][1] * rk;
                *(LAS unsigned*)(lds + CP_QN + i * 272 + 4 * lane) = pk2(y[0][0] * rq, y[0][1] * rq);
                *(LAS unsigned*)(lds + CP_KN + i * 272 + 4 * lane) = pk2(k0, k1);
                tk[0][ii] = k0; tk[1][ii] = k1; tv[0][ii] = be * y[2][0]; tv[1][ii] = be * y[2][1]; tg[0][ii] = bg * k0; tg[1][ii] = bg * k1;
            }
#pragma unroll
            for (int c = 0; c < 2; ++c) {
                *(LAS u32x4*)(lds + CP_KT + (2 * lane + c) * 144 + 2 * i0) = pack8(tk[c]);
                *(LAS u32x4*)(lds + CP_VT + (2 * lane + c) * 144 + 2 * i0) = pack8(tv[c]);
                *(LAS u32x4*)(lds + CP_KGT + (2 * lane + c) * 144 + 2 * i0) = pack8(tg[c]);
            }
        }
        __builtin_amdgcn_sched_barrier(0);
        if (unit + (int)gridDim.x < 2048) CP_FETCH(unit + (int)gridDim.x);
        lds_sync();
        for (int jb = wave; jb < 16; jb += 8) { const int which = 0, mt = (jb >> 2) & 3, nt = jb & 3;
            f32x4 acc = (f32x4){0.f, 0.f, 0.f, 0.f};
            if (nt <= mt) {
#pragma unroll
                for (int ks = 0; ks < 4; ++ks) acc = mfma16(ld_frag16(lds + (which ? CP_QN : CP_KN) + (16 * mt + li) * 272 + (32 * ks + 8 * q) * 2), ld_frag16(lds + CP_KN + (16 * nt + li) * 272 + (32 * ks + 8 * q) * 2), acc);
            }
            const int j = 16 * nt + li; const float gj = tab[64 + j];
#pragma unroll
            for (int r = 0; r < 4; ++r) { const int i = 16 * mt + 4 * q + r; const float gi = tab[64 + i];
                if (which == 0) { ((LAS float*)(lds + CP_A32))[i * 64 + j] = (i > j) ? tab[i] * acc[r] * __expf(gi - gj) : 0.f; }
                else { *(LAS bf16*)(lds + CP_ATT + i * 144 + 2 * j) = (bf16)f2bf((i >= j) ? acc[r] * __expf(gi - gj) : 0.f); } }
        }
        lds_sync();
        LAS float* Tf = (LAS float*)(lds + LDSCTL_OFF + 2048); LAS float* Pf = Tf + 2048;
        if (wave == 0) {
            float Tc[32]; const float cf = (float)(lane & 31);
            const LAS float* A = (const LAS float*)(lds + CP_A32) + (lane >> 5) * (32 * 64 + 32); asm volatile("" : "+v"(A));
            LAS unsigned char* Tw = lds + CP_T16 + (lane >> 5) * (32 * 144) + 2 * lane; asm volatile("" : "+v"(Tw));
            LAS float* Tfw = Tf + (lane >> 5) * 1024 + (lane & 31); asm volatile("" : "+v"(Tfw));
            LAS unsigned char* Tz = lds + CP_T16 + 2 * lane; asm volatile("" : "+v"(Tz));
#pragma unroll
            for (int i = 0; i < 32; ++i) { float a4[4] = {fmaxf(0.f, 1.f - fabsf((float)i - cf)), 0.f, 0.f, 0.f};
#pragma unroll
                for (int j = 0; j < i; j += 4) { const f32x4 av = *(const LAS f32x4*)(A + i * 64 + j);
#pragma unroll
                    for (int jj = 0; jj < 4; ++jj) if (j + jj < i) a4[jj] -= av[jj] * Tc[j + jj]; }
                const float a = (a4[0] + a4[1]) + (a4[2] + a4[3]);
                Tc[i] = a; *(LAS bf16*)(Tw + i * 144) = (bf16)f2bf(a); Tfw[i * 32] = a;
                if (lane >= 32) *(LAS bf16*)(Tz + i * 144) = (bf16)0; }
        } else {
            for (int jq = wave - 1; jq < 16; jq += 7) { const int mt = (jq >> 2) & 3, nt = jq & 3;
                f32x4 acc = (f32x4){0.f, 0.f, 0.f, 0.f};
                if (nt <= mt) {
#pragma unroll
                    for (int ks = 0; ks < 4; ++ks) acc = mfma16(ld_frag16(lds + CP_QN + (16 * mt + li) * 272 + (32 * ks + 8 * q) * 2), ld_frag16(lds + CP_KN + (16 * nt + li) * 272 + (32 * ks + 8 * q) * 2), acc);
                }
                const int j = 16 * nt + li; const float gj = tab[64 + j];
#pragma unroll
                for (int r = 0; r < 4; ++r) { const int i = 16 * mt + 4 * q + r; const float gi = tab[64 + i];
                    *(LAS bf16*)(lds + CP_ATT + i * 144 + 2 * j) = (bf16)f2bf((i >= j) ? acc[r] * __expf(gi - gj) : 0.f); }
            }
            const int t2 = tid - 64;
            for (int pc = t2; pc < 1024; pc += 448) { const int row = pc >> 4, seg = pc & 15; *(u32x4*)(rec + REC_Q + pc * 16) = *(const LAS u32x4*)(lds + CP_QN + row * 272 + seg * 16); }
            for (int pc = t2; pc < 1024; pc += 448) { const int row = pc >> 3, seg = pc & 7; *(u32x4*)(rec + REC_KT + pc * 16) = *(const LAS u32x4*)(lds + CP_KT + row * 144 + seg * 16); }
            if (t2 < 16) *(u32x4*)(rec + REC_G + t2 * 16) = *(const LAS u32x4*)(lds + CP_TAB + 256 + t2 * 16);
        }
        lds_sync();
        *(u32x4*)(rec + REC_ATT + tid * 16) = *(const LAS u32x4*)(lds + CP_ATT + (tid >> 3) * 144 + (tid & 7) * 16);
        if (wave < 4) {
            const int mt = wave >> 1, nt = wave & 1; float av[8], bv[8];
#pragma unroll
            for (int ks = 0; ks < 8; ++ks) { av[ks] = ((const LAS float*)(lds + CP_A32))[(32 + 16 * mt + li) * 64 + 4 * ks + q]; bv[ks] = Tf[(4 * ks + q) * 32 + 16 * nt + li]; }
            f32x4 acc = (f32x4){0.f, 0.f, 0.f, 0.f};
#pragma unroll
            for (int ks = 0; ks < 8; ++ks) acc = mfma_f32(av[ks], bv[ks], acc);
#pragma unroll
            for (int r = 0; r < 4; ++r) Pf[(16 * mt + 4 * q + r) * 32 + 16 * nt + li] = acc[r];
        }
        lds_sync();
        if (wave < 4) {
            const int mt = wave >> 1, nt = wave & 1; float av[8], bv[8];
#pragma unroll
            for (int ks = 0; ks < 8; ++ks) { av[ks] = Tf[1024 + (16 * mt + li) * 32 + 4 * ks + q]; bv[ks] = Pf[(4 * ks + q) * 32 + 16 * nt + li]; }
            f32x4 acc = (f32x4){0.f, 0.f, 0.f, 0.f};
#pragma unroll
            for (int ks = 0; ks < 8; ++ks) acc = mfma_f32(av[ks], bv[ks], acc);
#pragma unroll
            for (int r = 0; r < 4; ++r) *(LAS bf16*)(lds + CP_T16 + (32 + 16 * mt + 4 * q + r) * 144 + 2 * (16 * nt + li)) = (bf16)f2bf(-acc[r]);
        }
        lds_sync();
        for (int jb = wave; jb < 64; jb += 8) {
            f32x4 acc = (f32x4){0.f, 0.f, 0.f, 0.f};
            if (jb < 32) { const int mt = jb >> 3, nt = jb & 7;
#pragma unroll
                for (int ks = 0; ks < 2; ++ks) acc = mfma16(ld_frag16(lds + CP_T16 + (16 * mt + li) * 144 + (32 * ks + 8 * q) * 2), ld_frag16(lds + CP_VT + (16 * nt + li) * 144 + (32 * ks + 8 * q) * 2), acc);
                u32x2 o; o.x = pk2(acc[0], acc[1]); o.y = pk2(acc[2], acc[3]);
                *(u32x2*)(rec + REC_U + (size_t)((nt * 64 + lane) * 4 + mt) * 8) = o;
            } else { const int mt = (jb - 32) >> 2, nt = (jb - 32) & 3;
#pragma unroll
                for (int ks = 0; ks < 2; ++ks) acc = mfma16(ld_frag16(lds + CP_KGT + (16 * mt + li) * 144 + (32 * ks + 8 * q) * 2), ld_frag16(lds + CP_T16 + (16 * nt + li) * 144 + (32 * ks + 8 * q) * 2), acc);
                u32x2 o; o.x = pk2(acc[0], acc[1]); o.y = pk2(acc[2], acc[3]);
                *(u32x2*)(rec + REC_W + (size_t)((16 * nt + li) * 128 + 16 * mt + 4 * q) * 2) = o;
            }
        }
    }
#undef CP_FETCH
    lds_sync();
}
constexpr int SC_W = 0, SC_KT = 17408, SC_G = 35840, SC_BUF = 36096;
__device__ __forceinline__ void gdn_chunk_scan(const Params& p, LAS unsigned char* lds, int tid, int wave, int lane, int bh, int half) {
    const int q = lane >> 4, li = lane & 15, sl = half * 4 + (wave & 3);
    unsigned char* rec0 = p.ws + WS_REC + (size_t)(bh * 64) * REC_BYTES;
    u32x4* S0F = (u32x4*)(p.ws + WS_OBUF) + (size_t)(bh * 64) * 8 * 4 * 64;
    struct Pf { u32x4 f[4], g, u[2]; };
    Pf pa, pb; pa.g = (u32x4){0u, 0u, 0u, 0u}; pb.g = pa.g;
#define SC_LOAD(P, nn) do { const unsigned char* r_ = rec0 + (size_t)(nn) * REC_BYTES; \
        P.f[0] = *(const u32x4*)(r_ + REC_W + (size_t)tid * 16); P.f[1] = *(const u32x4*)(r_ + REC_W + (size_t)(tid + 512) * 16); \
        P.f[2] = *(const u32x4*)(r_ + REC_KT + (size_t)tid * 16); P.f[3] = *(const u32x4*)(r_ + REC_KT + (size_t)(tid + 512) * 16); \
        if (tid < 16) P.g = *(const u32x4*)(r_ + REC_G + tid * 16); \
        P.u[0] = *(const u32x4*)(r_ + REC_U + (size_t)(sl * 64 + lane) * 32); P.u[1] = *(const u32x4*)(r_ + REC_U + (size_t)(sl * 64 + lane) * 32 + 16); } while (0)
#define SC_STORE(P, buf) do { LAS unsigned char* d_ = lds + (buf) * SC_BUF; \
        _Pragma("unroll") for (int k_ = 0; k_ < 2; ++k_) { const int pc_ = tid + 512 * k_; *(LAS u32x4*)(d_ + SC_W + (pc_ >> 4) * 272 + (pc_ & 15) * 16) = P.f[k_]; \
            *(LAS u32x4*)(d_ + SC_KT + (pc_ >> 3) * 144 + (pc_ & 7) * 16) = P.f[2 + k_]; } \
        if (tid < 16) *(LAS u32x4*)(d_ + SC_G + tid * 16) = P.g; } while (0)
    f32x4 S[8];
#pragma unroll
    for (int i = 0; i < 8; ++i) S[i] = (f32x4){0.f, 0.f, 0.f, 0.f};
    u32x4 cu[2];
    auto chunk_step = [&](const int n, const LAS unsigned char* L) __attribute__((always_inline)) {
        if (wave < 4) {
            bf16x8 wf[4][4]; f32x4 gi[4];
#pragma unroll
            for (int mt = 0; mt < 4; ++mt)
#pragma unroll
                for (int ks = 0; ks < 4; ++ks) wf[mt][ks] = ld_frag8x2(L + SC_W + (16 * mt + li) * 272 + (32 * ks + 4 * q) * 2);
            const float g63 = *(const LAS float*)(L + SC_G + 63 * 4);
#pragma unroll
            for (int mt = 0; mt < 4; ++mt) gi[mt] = *(const LAS f32x4*)(L + SC_G + (16 * mt + 4 * q) * 4);
            __builtin_amdgcn_sched_barrier(0);
            bf16x8 Sb[4];
#pragma unroll
            for (int ks = 0; ks < 4; ++ks) { Sb[ks] = pack_frag(S[2 * ks], S[2 * ks + 1]); S0F[(size_t)((n * 8 + sl) * 4 + ks) * 64 + lane] = __builtin_bit_cast(u32x4, Sb[ks]); }
            f32x4 a1[4];
#pragma unroll
            for (int mt = 0; mt < 4; ++mt) a1[mt] = (f32x4){0.f, 0.f, 0.f, 0.f};
#pragma unroll
            for (int ks = 0; ks < 4; ++ks)
#pragma unroll
                for (int mt = 0; mt < 4; ++mt) a1[mt] = mfma16(wf[mt][ks], Sb[ks], a1[mt]);
            __builtin_amdgcn_sched_barrier(0);
            bf16x8 kf[8][2];
#pragma unroll
            for (int mt = 0; mt < 8; ++mt)
#pragma unroll
                for (int ks = 0; ks < 2; ++ks) kf[mt][ks] = ld_frag8x2(L + SC_KT + (16 * mt + li) * 144 + (32 * ks + 4 * q) * 2);
            const float eg = fexp(g63);
#pragma unroll
            for (int mt = 0; mt < 8; ++mt) S[mt] = S[mt] * eg;
            __builtin_amdgcn_sched_barrier(0);
            f32x4 vn[4], vd[4];
#pragma unroll
            for (int mt = 0; mt < 4; ++mt) {
                const unsigned ulo = (mt < 2) ? (mt == 0 ? cu[0].x : cu[0].z) : (mt == 2 ? cu[1].x : cu[1].z), uhi = (mt < 2) ? (mt == 0 ? cu[0].y : cu[0].w) : (mt == 2 ? cu[1].y : cu[1].w);
                const f32x4 uu = (f32x4){bf_lo(ulo), bf_hi(ulo), bf_lo(uhi), bf_hi(uhi)};
                vn[mt] = uu - a1[mt];
#pragma unroll
                for (int r = 0; r < 4; ++r) vd[mt][r] = vn[mt][r] * fexp(g63 - gi[mt][r]); }
            bf16x8 Vb[2], Vd[2];
#pragma unroll
            for (int ks = 0; ks < 2; ++ks) { Vb[ks] = pack_frag(vn[2 * ks], vn[2 * ks + 1]); Vd[ks] = pack_frag(vd[2 * ks], vd[2 * ks + 1]); }
            { unsigned char* ru = rec0 + (size_t)n * REC_BYTES + REC_U + (size_t)(sl * 64 + lane) * 32;
                *(u32x4*)ru = __builtin_bit_cast(u32x4, Vb[0]); *(u32x4*)(ru + 16) = __builtin_bit_cast(u32x4, Vb[1]); }
#pragma unroll
            for (int ks = 0; ks < 2; ++ks)
#pragma unroll
                for (int mt = 0; mt < 8; ++mt) S[mt] = mfma16(kf[mt][ks], Vd[ks], S[mt]);
        }
    };
    lds_sync();
    SC_LOAD(pa, 0); SC_STORE(pa, 0); cu[0] = pa.u[0]; cu[1] = pa.u[1];
    SC_LOAD(pa, 1);
    lds_sync();
#pragma unroll 1
    for (int n = 0; n < 64; n += 2) {
        SC_LOAD(pb, (n + 2 < 64 ? n + 2 : 63));
        chunk_step(n, lds);
        SC_STORE(pa, 1); cu[0] = pa.u[0]; cu[1] = pa.u[1];
        SC_LOAD(pa, (n + 3 < 64 ? n + 3 : 63));
        lds_sync();
        chunk_step(n + 1, lds + SC_BUF);
        SC_STORE(pb, 0); cu[0] = pb.u[0]; cu[1] = pb.u[1];
        lds_sync();
    }
#undef SC_LOAD
#undef SC_STORE
}
constexpr int CO_Q = 0, CO_ATT = 17408, CO_G = 26624, CO_PART = 26880;
__device__ __forceinline__ void gdn_chunk_out(const Params& p, int layer, LAS unsigned char* lds, int tid, int wave, int lane) {
    const bf16* H = (const bf16*)(p.ws + WS_H); bf16* YS = (bf16*)(p.ws + WS_YS);
    const int q = lane >> 4, li = lane & 15;
    const f32x4 nw = *(const f32x4*)(p.in[I_GNW] + layer * 128 + 16 * wave + 4 * q);
    LAS float* part = (LAS float*)(lds + CO_PART);
    u32x4 rq0, rq1, ra, rg = (u32x4){0u, 0u, 0u, 0u}, sfw[4], vfw[2]; u32x2 zr[4];
#define CO_LOAD(uu) do { const int n_ = (uu) & 63, bh_ = (uu) >> 6, hh_ = bh_ & 3, b_ = bh_ >> 2; const int m0_ = b_ * T + n_ * 64; \
        const unsigned char* rec_ = p.ws + WS_REC + (size_t)(bh_ * 64 + n_) * REC_BYTES; \
        const u32x4* S0F_ = (const u32x4*)(p.ws + WS_OBUF) + (size_t)((bh_ * 64 + n_) * 8 + wave) * 4 * 64; \
        rq0 = *(const u32x4*)(rec_ + REC_Q + (size_t)tid * 16); rq1 = *(const u32x4*)(rec_ + REC_Q + (size_t)(tid + 512) * 16); ra = *(const u32x4*)(rec_ + REC_ATT + (size_t)tid * 16); \
        if (tid < 16) rg = *(const u32x4*)(rec_ + REC_G + tid * 16); \
        _Pragma("unroll") for (int ks = 0; ks < 4; ++ks) sfw[ks] = S0F_[ks * 64 + lane]; \
        vfw[0] = *(const u32x4*)(rec_ + REC_U + (size_t)(wave * 64 + lane) * 32); vfw[1] = *(const u32x4*)(rec_ + REC_U + (size_t)(wave * 64 + lane) * 32 + 16); \
        _Pragma("unroll") for (int mt = 0; mt < 4; ++mt) zr[mt] = *(const u32x2*)(H + HB_GDN + (size_t)(m0_ + 16 * mt + li) * PGDN + HZ + hh_ * 128 + 16 * wave + 4 * q); } while (0)
    if ((int)blockIdx.x < 2048) CO_LOAD((int)blockIdx.x);
    for (int unit = blockIdx.x; unit < 2048; unit += gridDim.x) {
        const int n = unit & 63, bh = unit >> 6, hh = bh & 3, b = bh >> 2; const int m0 = b * T + n * 64;
        bf16x8 sf[4], vf[2]; u32x2 zc[4];
#pragma unroll
        for (int ks = 0; ks < 4; ++ks) sf[ks] = __builtin_bit_cast(bf16x8, sfw[ks]);
        vf[0] = __builtin_bit_cast(bf16x8, vfw[0]); vf[1] = __builtin_bit_cast(bf16x8, vfw[1]);
#pragma unroll
        for (int mt = 0; mt < 4; ++mt) zc[mt] = zr[mt];
        lds_sync();
        *(LAS u32x4*)(lds + CO_Q + (tid >> 4) * 272 + (tid & 15) * 16) = rq0; *(LAS u32x4*)(lds + CO_Q + ((tid + 512) >> 4) * 272 + (tid & 15) * 16) = rq1;
        *(LAS u32x4*)(lds + CO_ATT + (tid >> 3) * 144 + (tid & 7) * 16) = ra;
        if (tid < 16) *(LAS u32x4*)(lds + CO_G + tid * 16) = rg;
        if (unit + (int)gridDim.x < 2048) CO_LOAD(unit + (int)gridDim.x);
        lds_sync();
        f32x4 o[4]; float ss[4];
#pragma unroll
        for (int mt = 0; mt < 4; ++mt) { f32x4 a2 = (f32x4){0.f, 0.f, 0.f, 0.f}, a3 = (f32x4){0.f, 0.f, 0.f, 0.f};
#pragma unroll
            for (int ks = 0; ks < 4; ++ks) a2 = mfma16(sf[ks], ld_frag8x2(lds + CO_Q + (16 * mt + li) * 272 + (32 * ks + 4 * q) * 2), a2);
#pragma unroll
            for (int ks = 0; ks < 2; ++ks) a3 = mfma16(vf[ks], ld_frag8x2(lds + CO_ATT + (16 * mt + li) * 144 + (32 * ks + 4 * q) * 2), a3);
            const float gam = fexp(*(const LAS float*)(lds + CO_G + (16 * mt + li) * 4));
            o[mt] = a2 * gam + a3;
            float s = (o[mt][0] * o[mt][0] + o[mt][1] * o[mt][1]) + (o[mt][2] * o[mt][2] + o[mt][3] * o[mt][3]);
            s += __shfl_xor(s, 16); s += __shfl_xor(s, 32);
            if (q == 0) part[(16 * mt + li) * 8 + wave] = s; }
        lds_sync();
#pragma unroll
        for (int mt = 0; mt < 4; ++mt) { const f32x4 pa = *(const LAS f32x4*)(part + (16 * mt + li) * 8), pb = *(const LAS f32x4*)(part + (16 * mt + li) * 8 + 4);
            ss[mt] = ((pa[0] + pa[1]) + (pa[2] + pa[3])) + ((pb[0] + pb[1]) + (pb[2] + pb[3]));
            const float rs = __builtin_amdgcn_rsqf(ss[mt] * (1.0f / 128.0f) + EPS);
            u32x2 w; w.x = pk2(o[mt][0] * rs * nw[0] * siluf_(bf_lo(zc[mt].x)), o[mt][1] * rs * nw[1] * siluf_(bf_hi(zc[mt].x)));
            w.y = pk2(o[mt][2] * rs * nw[2] * siluf_(bf_lo(zc[mt].y)), o[mt][3] * rs * nw[3] * siluf_(bf_hi(zc[mt].y)));
            *(u32x2*)(YS + (size_t)(m0 + 16 * mt + li) * 512 + hh * 128 + 16 * wave + 4 * q) = w; }
    }
#undef CO_LOAD
    lds_sync();
}
constexpr size_t WS_WRT = WS_MOETAB + MiB; constexpr int WRT_N = 80 * 1024;
__device__ __forceinline__ void prep_router_tables(const Params& p, int gtid, int NGT) {
    bf16* WRT = (bf16*)(p.ws + WS_WRT);
    for (int idx = gtid; idx < NLAYER * WRT_N; idx += NGT) { const int l = idx / WRT_N, n = (idx % WRT_N) >> 10, k = idx & 1023;
        const float w = (n < 64) ? p.in[I_REXP][((size_t)l * D + k) * 64 + n] : (n < 72 ? p.in[I_RGRP][((size_t)l * D + k) * 8 + (n - 64)] : 0.f);
        const unsigned hi = f2bf(w); const float wl = w - __uint_as_float(hi << 16);
        WRT[(size_t)(l * 2) * WRT_N + (idx % WRT_N)] = (bf16)hi; WRT[(size_t)(l * 2 + 1) * WRT_N + (idx % WRT_N)] = (bf16)f2bf(wl); }
}
__device__ __forceinline__ void moe_route_vb(const Params& p, int layer, LAS unsigned char* lds, int tid, int wave, int lane_, int vb, const f32x4 (&nw)[4]) {
    LAS int* hist = (LAS int*)(lds + LDSCTL_OFF + LC_TAB);
    bf16* XN = (bf16*)(p.ws + WS_XN);
    int* route_e = (int*)(p.ws + WS_ROUTE); float* route_w = (float*)(p.ws + WS_ROUTE + (size_t)M * 2 * 4);
    int* cnt = (int*)(p.ws + WS_MOETAB + (size_t)NROWS_MAX * 8);
    const bf16* Wh = (const bf16*)(p.ws + WS_WRT) + (size_t)(layer * 2) * WRT_N; const bf16* Wl = Wh + WRT_N;
    lds_sync();
    if (tid < 64) hist[tid] = 0;
    u32x2 xr[4][4];
#define RT_LOADX(tt) do { _Pragma("unroll") for (int rr = 0; rr < 4; ++rr) _Pragma("unroll") for (int j = 0; j < 4; ++j) \
        xr[rr][j] = *(const u32x2*)((const bf16*)(p.ws + WS_X1B) + (size_t)(vb * 128 + (tt) * 32 + wave * 4 + rr) * D + 4 * lane_ + 256 * j); } while (0)
    RT_LOADX(0);
#pragma unroll
    for (int tile = 0; tile < 4; ++tile) {
        const int m0 = vb * 128 + tile * 32;
        int lane = lane_; asm volatile("" : "+v"(lane));
        const int q = lane >> 4, li = lane & 15;
        lds_sync();
        bf16x8 b0h[5], b0l[5], b1h[5], b1l[5];
        const bf16* bp = Wh + (size_t)li * 1024 + 128 * wave + 8 * q;
#define RT_LOADB(dh, dl, ks) do { _Pragma("unroll") for (int nt = 0; nt < 5; ++nt) { dh[nt] = *(const bf16x8*)(bp + nt * 16384 + 32 * (ks)); dl[nt] = *(const bf16x8*)(bp + WRT_N + nt * 16384 + 32 * (ks)); } } while (0)
#define RT_MMA(dh, dl, ks) do { bf16x8 ah[2], al[2]; \
            _Pragma("unroll") for (int mt = 0; mt < 2; ++mt) { const int off = (16 * mt + li) * 2048 + (((16 * wave + 4 * (ks) + q) ^ li) << 4); ah[mt] = ld_frag16(lds + off); al[mt] = ld_frag16(lds + 65536 + off); } \
            _Pragma("unroll") for (int nt = 0; nt < 5; ++nt) _Pragma("unroll") for (int mt = 0; mt < 2; ++mt) { acc[mt][nt] = mfma16(ah[mt], dh[nt], acc[mt][nt]); acc[mt][nt] = mfma16(al[mt], dh[nt], acc[mt][nt]); acc[mt][nt] = mfma16(ah[mt], dl[nt], acc[mt][nt]); } } while (0)
        RT_LOADB(b0h, b0l, 0); RT_LOADB(b1h, b1l, 1);
        __builtin_amdgcn_sched_barrier(0);
        {
#pragma unroll
            for (int rr = 0; rr < 4; ++rr) { const int r = wave * 4 + rr, m = m0 + r; float ss = 0.f; f32x4 v[4];
#pragma unroll
                for (int j = 0; j < 4; ++j) { v[j] = (f32x4){bf_lo(xr[rr][j].x), bf_hi(xr[rr][j].x), bf_lo(xr[rr][j].y), bf_hi(xr[rr][j].y)}; ss += (v[j][0] * v[j][0] + v[j][1] * v[j][1]) + (v[j][2] * v[j][2] + v[j][3] * v[j][3]); }
                const float rs = __builtin_amdgcn_rsqf(wave_sum(ss) * (1.0f / D) + EPS);
#pragma unroll
                for (int j = 0; j < 4; ++j) { const f32x4 x = v[j] * rs * nw[j];
                    u32x2 h; h.x = pk2(x[0], x[1]); h.y = pk2(x[2], x[3]);
                    u32x2 l; l.x = pk2(x[0] - bf_lo(h.x), x[1] - bf_hi(h.x)); l.y = pk2(x[2] - bf_lo(h.y), x[3] - bf_hi(h.y));
                    *(u32x2*)(XN + (size_t)m * D + 4 * lane + 256 * j) = h;
                    const int off = r * 2048 + ((((lane >> 1) + 32 * j) ^ (r & 15)) << 4) + (lane & 1) * 8;
                    *(LAS u32x2*)(lds + off) = h; *(LAS u32x2*)(lds + 65536 + off) = l; } }
        }
        lds_sync();
        f32x4 acc[2][5];
#pragma unroll
        for (int mt = 0; mt < 2; ++mt)
#pragma unroll
            for (int nt = 0; nt < 5; ++nt) acc[mt][nt] = (f32x4){0.f, 0.f, 0.f, 0.f};
        RT_MMA(b0h, b0l, 0); __builtin_amdgcn_sched_barrier(0); RT_LOADB(b0h, b0l, 2); __builtin_amdgcn_sched_barrier(0);
        RT_MMA(b1h, b1l, 1); __builtin_amdgcn_sched_barrier(0); RT_LOADB(b1h, b1l, 3); __builtin_amdgcn_sched_barrier(0);
        if (tile < 3) RT_LOADX(tile + 1);
        __builtin_amdgcn_sched_barrier(0);
        RT_MMA(b0h, b0l, 2); RT_MMA(b1h, b1l, 3);
#undef RT_LOADB
#undef RT_MMA
        lds_sync();
        LAS float* part = (LAS float*)lds;
#pragma unroll
        for (int mt = 0; mt < 2; ++mt)
#pragma unroll
            for (int nt = 0; nt < 5; ++nt) { if (16 * nt + li < 72) {
#pragma unroll
                for (int r = 0; r < 4; ++r) part[(wave * 32 + 16 * mt + 4 * q + r) * 72 + 16 * nt + li] = acc[mt][nt][r]; } }
        lds_sync();
        float le4[4], lg4[4];
#pragma unroll
        for (int rr = 0; rr < 4; ++rr) { const int r = wave * 4 + rr; float le = 0.f, lg = 0.f;
#pragma unroll
            for (int w = 0; w < 8; ++w) { le += part[(w * 32 + r) * 72 + lane]; lg += part[(w * 32 + r) * 72 + 64 + (lane & 7)]; }
            le4[rr] = le; lg4[rr] = lg; }
#pragma unroll
        for (int rr = 0; rr < 4; ++rr) { const int r = wave * 4 + rr, m = m0 + r; const int lgi = __builtin_bit_cast(int, lg4[rr]), lei = __builtin_bit_cast(int, le4[rr]);
            float gv[8];
#pragma unroll
            for (int i = 0; i < 8; ++i) gv[i] = __builtin_bit_cast(float, __builtin_amdgcn_readlane(lgi, i));
            int grp = 0; float gmax = gv[0];
#pragma unroll
            for (int i = 1; i < 8; ++i) if (gv[i] > gmax) { gmax = gv[i]; grp = i; }
            float gs = 0.f;
#pragma unroll
            for (int i = 0; i < 8; ++i) gs += __expf(gv[i] - gmax);
            const float psel = 1.0f / gs;
            float ev[8];
#pragma unroll
            for (int i = 0; i < 8; ++i) ev[i] = __builtin_bit_cast(float, __builtin_amdgcn_readlane(lei, grp * 8 + i));
            int i1 = 0; float e1 = ev[0];
#pragma unroll
            for (int i = 1; i < 8; ++i) if (ev[i] > e1) { e1 = ev[i]; i1 = i; }
            int i2 = -1; float e2 = -3.0e38f;
#pragma unroll
            for (int i = 0; i < 8; ++i) if (i != i1 && ev[i] > e2) { e2 = ev[i]; i2 = i; }
            const float x2 = __expf(e2 - e1), w1 = psel / (1.0f + x2), w2 = psel * x2 / (1.0f + x2);
            if (lane == 0) { route_e[(size_t)m * 2] = grp * 8 + i1; route_e[(size_t)m * 2 + 1] = grp * 8 + i2; route_w[(size_t)m * 2] = w1; route_w[(size_t)m * 2 + 1] = w2;
                atomicAdd((int*)(hist + grp * 8 + i1), 1); atomicAdd((int*)(hist + grp * 8 + i2), 1); }
        }
    }
#undef RT_LOADX
    lds_sync();
    if (tid < 64) cnt[vb * 64 + tid] = hist[tid];
}
__device__ __forceinline__ void moe_route(const Params& p, int layer, LAS unsigned char* lds, int tid, int wave, int lane) {
    f32x4 nw[4];
#pragma unroll
    for (int j = 0; j < 4; ++j) nw[j] = *(const f32x4*)(p.in[I_MOENW] + layer * D + 4 * lane + 256 * j);
    for (int vb = blockIdx.x; vb < M / 128; vb += gridDim.x) moe_route_vb(p, layer, lds, tid, wave, lane, vb, nw);
    lds_sync();
}
__device__ __forceinline__ void moe_dispatch(const Params& p, LAS unsigned char* lds, int tid, int wave, int lane) {
    LAS int* tab = (LAS int*)(lds + LDSCTL_OFF + LC_TAB);
    const bf16* XN = (const bf16*)(p.ws + WS_XN); bf16* XS = (bf16*)(p.ws + WS_XS);
    const int* route_e = (const int*)(p.ws + WS_ROUTE); const float* route_w = (const float*)(p.ws + WS_ROUTE + (size_t)M * 2 * 4);
    int* row_code = (int*)(p.ws + WS_MOETAB); float* row_w = (float*)(p.ws + WS_MOETAB + (size_t)NROWS_MAX * 4);
    const int* cnt = (const int*)(p.ws + WS_MOETAB + (size_t)NROWS_MAX * 8); int* blk_e = (int*)(p.ws + WS_MOETAB + (size_t)NROWS_MAX * 8 + 256 * 64 * 4);
    for (int vb = blockIdx.x; vb < M / 128; vb += gridDim.x) {
        lds_sync();
        {
            const int e = tid & 63, part = tid >> 6; int run = 0, base = 0;
#pragma unroll 8
            for (int v = part * 32; v < part * 32 + 32; ++v) { const int c = cnt[v * 64 + e]; if (v < vb) base += c; run += c; }
            tab[720 + part * 64 + e] = run; tab[1240 + part * 64 + e] = base;
        }
        lds_sync();
        if (tid < 64) { int run = 0, base = 0;
#pragma unroll
            for (int k = 0; k < 8; ++k) { run += tab[720 + k * 64 + tid]; base += tab[1240 + k * 64 + tid]; }
            tab[64 + tid] = run; tab[128 + tid] = base; }
        lds_sync();
        if (tid == 0) { int s = 0; for (int e = 0; e < 64; ++e) { tab[e] = s; s += (tab[64 + e] + 255) / 256 * 256; } tab[704] = s; }
        if (tid < 256) tab[192 + tid] = route_e[(size_t)vb * 256 + tid];
        lds_sync();
        if (tid < 256) { const int e = tab[192 + tid]; int rank = 0; for (int a = 0; a < tid; ++a) rank += (tab[192 + a] == e) ? 1 : 0;
            const int pos = tab[e] + tab[128 + e] + rank; tab[448 + tid] = pos;
            row_code[pos] = ((vb * 128 + (tid >> 1)) << 1) | (tid & 1); row_w[pos] = route_w[(size_t)vb * 256 + tid]; }
        if (vb < 64) { const int ps = tab[vb], tot = tab[64 + vb], pe = ps + (tot + 255) / 256 * 256;
            for (int r = ps + tot + tid; r < pe; r += 512) row_code[r] = -1;
            for (int b = ps / 256 + tid; b < pe / 256; b += 512) blk_e[b] = vb;
            if (tid == 0) { blk_e[NROWBLK_MAX + 64 + vb] = ps / 256; blk_e[NROWBLK_MAX + 128 + vb] = (pe - ps) / 256; }
            if (vb == 63 && tid == 0) blk_e[NROWBLK_MAX] = tab[704] / 256; }
        lds_sync();
    }
    lds_sync();
}

__global__ void __launch_bounds__(512, 2) fwd(Params p) {
    extern __shared__ __attribute__((aligned(16))) unsigned char lds_raw[];
    LAS unsigned char* lds = (LAS unsigned char*)lds_raw;
    const int tid0 = threadIdx.x;
    const int G = gridDim.x, NGW = G * 8, NGT = G * 512;
#define FRESH() Params pl = p; { GAS unsigned char* w_ = (GAS unsigned char*)pl.ws; GAS float* o_ = (GAS float*)pl.out; asm volatile("" : "+s"(w_), "+s"(o_)); pl.ws = (unsigned char*)w_; pl.out = (float*)o_; }     int tid = tid0; asm volatile("" : "+v"(tid)); const int lane = tid & 63, wave = __builtin_amdgcn_readfirstlane(tid >> 6); const int gw = blockIdx.x * 8 + wave, gtid = blockIdx.x * 512 + tid; (void)lane; (void)gw; (void)gtid
    for (int u = tid0; u < (LDS_BYTES - LDSCTL_OFF) / 4; u += 512) ((LAS unsigned*)(lds + LDSCTL_OFF))[u] = 0u;
    __syncthreads();
    const int lo = p.ph_lo, hi = p.ph_hi;
    XcdBarrier bar; bar.bar = (unsigned*)(p.ws + WS_CTL) + CW_BAR; bar.x = 0; bar.st = (volatile LAS unsigned*)(lds + LDSCTL_OFF + LC_BAR);
    if (hi - lo > 1) bar = xcd_barrier_post((unsigned*)(p.ws + WS_CTL) + CW_BAR, (volatile LAS unsigned*)(lds + LDSCTL_OFF + LC_BAR));
#ifndef PHASE_MASK
#define PHASE_MASK 0x1fff
#endif
#define IN(k) (((PHASE_MASK >> ((k) == PH_FINAL ? 12 : ((k) % PH_PER_LAYER))) & 1) && lo <= (k) && (k) < hi)
#define REPS(k) ((((REPEAT_MASK) >> (k)) & 1) && layer == 0 ? 2 : 1)
#define TSG(slot, blk) do { if (TP_A >= 0 && (int)blockIdx.x == (blk) && tid0 == 0) __hip_atomic_store((unsigned long long*)(p.ws + WS_CTL + 131072) + (slot), (unsigned long long)__builtin_amdgcn_s_memrealtime(), __ATOMIC_RELAXED, __HIP_MEMORY_SCOPE_AGENT); } while (0)
#define TS(k) TSG(k, 0)
#define SEAM(k) do { if (IN(k) && IN((k) + 1)) xcd_barrier(bar); TS((k) + 1); } while (0)

    TS(0);
    for (int layer = 0; layer < NLAYER; ++layer) {
        const int g0 = layer * PH_PER_LAYER;

        for (int rep_ = 0; rep_ < REPS(0); ++rep_) if (IN(g0 + 0)) { if (rep_) __syncthreads(); FRESH();
            if (layer == 0) { prep_static_weights(pl, 0, gw, NGW, lane); prep_router_tables(pl, gtid, NGT); __syncthreads(); norm_phase<0>(pl, layer, lds, gw, NGW, tid, lane); }
            else norm_phase<1>(pl, layer, lds, gw, NGW, tid, lane);
        }
        SEAM(g0 + 0);
        for (int rep_ = 0; rep_ < REPS(1); ++rep_) if (IN(g0 + 1)) { if (rep_) __syncthreads(); FRESH();
            SchedH S; S.to.init(M / 256, DH / 256, G, (int)blockIdx.x, WGM_H); S.A = (const char*)(pl.ws + WS_XN); S.B = (const char*)(pl.ws + WS_WIN + layer * WIN_L);
            EpiStoreBf16 E{(bf16*)(pl.ws + WS_H), 0};
            pg8::gemm_phase(lds, tid, D, D, D, S, E);
        }
        SEAM(g0 + 1);
        for (int rep_ = 0; rep_ < REPS(2); ++rep_) if (IN(g0 + 2)) { if (rep_) __syncthreads(); FRESH(); gdn_chunk_prep(pl, layer, lds, tid, wave, lane); }
        SEAM(g0 + 2);
        for (int rep_ = 0; rep_ < REPS(3); ++rep_) if (IN(g0 + 3)) { if (rep_) __syncthreads(); FRESH();
            if ((int)blockIdx.x < 64) gdn_chunk_scan(pl, lds, tid, wave, lane, (int)blockIdx.x >> 1, (int)blockIdx.x & 1);
            if (layer == 0) { TSG(100, 0); TSG(105, 255); }
            {
                unsigned* qc = (unsigned*)(pl.ws + WS_CTL) + CW_QUEUE + layer * 256;
                gmlp(pl, layer, lds, tid, wave, lane, qc);
                if (layer == 0) { TSG(101, 0); TSG(106, 255); }
                conformer(pl, layer, lds, tid, wave, lane, qc + 64);
                if (layer == 0) { TSG(102, 0); TSG(107, 255); }
                { ScW scw; const float* cwp = pl.in[I_SCW] + (size_t)layer * 3 * 512 + (tid & 63) * 8;
#pragma unroll
                    for (int j = 0; j < 3; ++j) { const f32x4 a = *(const f32x4*)(cwp + j * 512), b = *(const f32x4*)(cwp + j * 512 + 4); scw.w[j][0] = a[0]; scw.w[j][1] = a[1]; scw.w[j][2] = a[2]; scw.w[j][3] = a[3]; scw.w[j][4] = b[0]; scw.w[j][5] = b[1]; scw.w[j][6] = b[2]; scw.w[j][7] = b[3]; }
                    for (;;) { const int unit = queue_pop(qc + 128, lds, tid); if (unit >= M / 64) break; shortconv_unit(pl, scw, tid, unit); } }
                if (layer == 0) { TSG(103, 0); TSG(108, 255); }
            }
        }
        SEAM(g0 + 3);
        for (int rep_ = 0; rep_ < REPS(4); ++rep_) if (IN(g0 + 4)) { if (rep_) __syncthreads(); FRESH(); gdn_chunk_out(pl, layer, lds, tid, wave, lane); }
        SEAM(g0 + 4);
        for (int rep_ = 0; rep_ < REPS(5); ++rep_) if (IN(g0 + 5)) { if (rep_) __syncthreads(); FRESH();
            SchedBranch S; S.to.init(M / 256, 4, G, (int)blockIdx.x, WGM_BR); S.YS = (const char*)(pl.ws + WS_YS); S.WBR = (const char*)(pl.ws + WS_WBR + layer * WBR_L);
            EpiGate E{(bf16*)(pl.ws + WS_H) + HB_GATE, (bf16*)(pl.ws + WS_MERGED), (bf16*)(pl.ws + WS_MERGED + 64 * MiB)};
            pg8::gemm_phase(lds, tid, 512, 512, 512, S, E);
        }
        for (int rep_ = 0; rep_ < REPS(6); ++rep_) if (IN(g0 + 6)) { if (rep_) __syncthreads(); FRESH();   }
        SEAM(g0 + 6);
        for (int rep_ = 0; rep_ < REPS(7); ++rep_) if (IN(g0 + 7)) { if (rep_) __syncthreads(); FRESH();
            const int NGB = G / 2;
            if ((int)blockIdx.x < NGB) {
                SchedOut S; S.to.init(M / 256, 4, NGB, (int)blockIdx.x, WGM_OUT); S.A = (const char*)(pl.ws + WS_MERGED); S.B = (const char*)(pl.ws + WS_WOUT + layer * WOUT_L);
                EpiRes E{layer == 0 ? pl.in[I_X] : nullptr, (const bf16*)pl.out, (bf16*)(pl.ws + WS_X1B)};
                pg8::gemm_phase(lds, tid, D, D, D, S, E);
            } else { prep_moe_weights(pl, layer, ((int)blockIdx.x - NGB) * 8 + wave, (G - NGB) * 8, lane);
                if (layer + 1 < NLAYER) prep_static_weights(pl, layer + 1, ((int)blockIdx.x - NGB) * 8 + wave, (G - NGB) * 8, lane); }
            if (layer == 0) { TSG(110, 0); TSG(111, 255); }
        }
        SEAM(g0 + 7);
        for (int rep_ = 0; rep_ < REPS(8); ++rep_) if (IN(g0 + 8)) { if (rep_) __syncthreads(); FRESH(); moe_route(pl, layer, lds, tid, wave, lane); }
        SEAM(g0 + 8);
        for (int rep_ = 0; rep_ < REPS(9); ++rep_) if (IN(g0 + 9)) { if (rep_) __syncthreads(); FRESH(); moe_dispatch(pl, lds, tid, wave, lane); }
        SEAM(g0 + 9);
        if (IN(g0 + 10) || IN(g0 + 11)) { FRESH();
            LAS int* tb = (LAS int*)(lds + LDSCTL_OFF + LC_TAB);
            const int* est = (const int*)(pl.ws + WS_MOETAB + (size_t)NROWS_MAX * 8 + 256 * 64 * 4) + NROWBLK_MAX + 64;
            const int NX = (G % 8 == 0) ? 8 : 1, x = (int)blockIdx.x % NX, nk = 64 / NX;
            __syncthreads();
            if (tid < nk) { tb[160 + tid] = est[x + NX * tid]; tb[240 + tid] = est[64 + x + NX * tid]; }
            __syncthreads();
            if (tid == 0) { int s = 0; for (int k = 0; k < nk; ++k) { tb[k] = s; tb[80 + k] = tb[160 + k]; s += tb[240 + k] * 4; } tb[nk] = s; }
            __syncthreads();
        }
        for (int rep_ = 0; rep_ < REPS(10); ++rep_) if (IN(g0 + 10)) { if (rep_) __syncthreads(); FRESH();
            LAS int* tb = (LAS int*)(lds + LDSCTL_OFF + LC_TAB); const int NX = (G % 8 == 0) ? 8 : 1, nk = 64 / NX;
            SchedMoe S; S.nux = tb[nk]; S.nrank = G / NX; S.rank = (int)blockIdx.x / NX; S.nk = nk; S.x = (int)blockIdx.x % NX; S.NX = NX; S.cum = tb; S.rb0 = tb + 80;
            S.A = (const char*)(pl.ws + WS_XS); S.a_blk = (size_t)256 * D * 2; S.W = (const char*)(pl.ws + WS_MOEW); S.w_e = WGU_E; S.w_pn = (size_t)256 * D * 2; S.cmul = 128;
            EpiSwiglu E{(bf16*)(pl.ws + WS_HB)};
            pg8::gemm_phase_gather(lds, tid, D, D, S, E, (const char*)pl.ws, (unsigned)WS_XN, (unsigned)(WS_CTL + 512 * 1024), (const int*)(pl.ws + WS_MOETAB));
        }
        SEAM(g0 + 10);
        for (int rep_ = 0; rep_ < REPS(11); ++rep_) if (IN(g0 + 11)) { if (rep_) __syncthreads(); FRESH();
            LAS int* tb = (LAS int*)(lds + LDSCTL_OFF + LC_TAB); const int NX = (G % 8 == 0) ? 8 : 1, nk = 64 / NX;
            SchedMoe S; S.nux = tb[nk]; S.nrank = G / NX; S.rank = (int)blockIdx.x / NX; S.nk = nk; S.x = (int)blockIdx.x % NX; S.NX = NX; S.cum = tb; S.rb0 = tb + 80;
            S.A = (const char*)(pl.ws + WS_HB); S.a_blk = (size_t)256 * DE * 2; S.W = (const char*)(pl.ws + WS_WD); S.w_e = WD_E; S.w_pn = (size_t)256 * DE * 2; S.cmul = 256;
            EpiScatter E{(bf16*)(pl.ws + WS_Y), (const int*)(pl.ws + WS_MOETAB), (const float*)(pl.ws + WS_MOETAB + (size_t)NROWS_MAX * 4)};
            pg8::gemm_phase(lds, tid, DE, DE, DE, S, E);
        }
        SEAM(g0 + 11);
    }
    if (IN(PH_FINAL)) { FRESH(); norm_phase<2>(pl, 0, lds, gw, NGW, tid, lane); }
    TS(PH_TOTAL);
    if (TP_A >= 0 && blockIdx.x == 0 && tid0 == 0) {
        unsigned long long* tr = (unsigned long long*)(p.ws + WS_CTL + 131072);
        const unsigned long long ta = __hip_atomic_load(tr + TP_A, __ATOMIC_RELAXED, __HIP_MEMORY_SCOPE_AGENT), tb = __hip_atomic_load(tr + TP_B, __ATOMIC_RELAXED, __HIP_MEMORY_SCOPE_AGENT);
        unsigned long long wait_ticks = (tb > ta ? tb - ta : 0ull) * TP_SCALE;
        if (wait_ticks > 1000000ull) wait_ticks = 1000000ull;
        const unsigned long long t0 = __builtin_amdgcn_s_memrealtime();
        while (__builtin_amdgcn_s_memrealtime() - t0 < wait_ticks) __builtin_amdgcn_s_sleep(8);
    }
#undef IN
#undef SEAM
}

extern "C" void kernel_launch(void* const* d_in, const int* in_sizes, int n_in, void* d_out, int out_size, void* d_ws, size_t ws_size, hipStream_t stream) {
    static int grid = 0;
    if (grid == 0) {
        if (n_in != 25 || out_size != M * D || ws_size < WS_END) { fprintf(stderr, "kernel_launch: unexpected shapes / workspace (n_in %d out %d ws %zu, need %zu)\n", n_in, out_size, ws_size, (size_t)WS_END); grid = -1; return; }
        int dev = 0, cus = 0, per_cu = 0;
        if (hipGetDevice(&dev) != hipSuccess || hipDeviceGetAttribute(&cus, hipDeviceAttributeMultiprocessorCount, dev) != hipSuccess) { grid = -1; return; }
        if (hipFuncSetAttribute((const void*)fwd, hipFuncAttributeMaxDynamicSharedMemorySize, LDS_BYTES) != hipSuccess) { fprintf(stderr, "kernel_launch: hipFuncSetAttribute failed\n"); grid = -1; return; }
        if (hipOccupancyMaxActiveBlocksPerMultiprocessor(&per_cu, (const void*)fwd, 512, LDS_BYTES) != hipSuccess || per_cu < 1) { fprintf(stderr, "kernel_launch: occupancy query says %d\n", per_cu); }
        (void)hipGetLastError();
        grid = cus;
    }
    if (grid < 0) return;
    hipMemsetAsync((char*)d_ws + WS_CTL, 0, CTL_BYTES, stream);
    Params p{};
    for (int i = 0; i < 25; ++i) p.in[i] = (const float*)d_in[i];
    p.out = (float*)d_out; p.ws = (unsigned char*)d_ws;
#if N_LAUNCH_MODE == 1
    p.ph_lo = 0; p.ph_hi = PH_TOTAL;
    hipLaunchKernelGGL(fwd, dim3(grid), dim3(512), LDS_BYTES, stream, p);
#else
    for (int k = 0; k < PH_TOTAL; ++k) { p.ph_lo = k; p.ph_hi = k + 1; hipLaunchKernelGGL(fwd, dim3(grid), dim3(512), LDS_BYTES, stream, p); }
#endif
}
```
